# Optimizing an MI355X kernel written in HIP

```python
import jax, jax.numpy as jnp
from jax import lax
import numpy as np

D_MODEL = 2048
BATCH = 8
SEQ = 4096
DEPTH = 1

RET_HEADS = 8
RET_HEAD_DIM = 128
RET_WIDTH = RET_HEADS * RET_HEAD_DIM
RET_CHUNK = 128
MLA_HEADS = 8
MLA_NOPE_DIM = 128
MLA_ROPE_DIM = 64
MLA_V_DIM = 128
MLA_Q_RANK = 512
MLA_KV_RANK = 512
MLA_WIDTH = MLA_HEADS * MLA_V_DIM
MLA_QK_DIM = MLA_NOPE_DIM + MLA_ROPE_DIM
Q_BLOCK = 128
MIX_WIDTH = RET_WIDTH + MLA_WIDTH
IN_COLS = 4 * RET_WIDTH + MLA_Q_RANK + MLA_KV_RANK + MLA_ROPE_DIM
D_FF = -(-(8 * D_MODEL) // (3 * 256)) * 256
N_MOD = 6
ROPE_BASE = 10000.0
EPS = 1e-6

kernel_name = "hybrid_retention_mla_adaln_block"


def rmsnorm(x, w):
    xf = x.astype(jnp.float32)
    y = xf * lax.rsqrt(jnp.mean(xf * xf, axis=-1, keepdims=True) + EPS)
    return (y * w.astype(jnp.float32)).astype(x.dtype)


def rope_tables(positions, dim):
    inv_freq = ROPE_BASE ** (-jnp.arange(0, dim, 2, dtype=jnp.float32) / dim)
    ang = positions.astype(jnp.float32)[..., None] * inv_freq
    return jnp.cos(ang), jnp.sin(ang)


def apply_rope(t, cos, sin):
    tf = t.astype(jnp.float32)
    t1, t2 = jnp.split(tf, 2, axis=-1)
    return jnp.concatenate([t1 * cos - t2 * sin, t2 * cos + t1 * sin], axis=-1).astype(t.dtype)


def retention_one_direction(q, k, v, log_gamma, inclusive):
    C = q.shape[3]
    idx = jnp.arange(C, dtype=jnp.float32)
    diff = idx[:, None] - idx[None, :]
    mask = (diff >= 0) if inclusive else (diff > 0)
    lg = log_gamma[:, None, None]
    intra_decay = jnp.where(mask, jnp.exp(jnp.where(mask, diff, 0.0) * lg), 0.0)
    scores = jnp.einsum('bhncd,bhnsd->bhncs', q, k) * intra_decay[None, :, None]
    intra = jnp.einsum('bhncs,bhnse->bhnce', scores, v)
    zeta = jnp.exp((C - 1 - idx)[None, :] * log_gamma[:, None])
    xi = jnp.exp((idx + 1)[None, :] * log_gamma[:, None])
    chunk_kv = jnp.einsum('bhnsd,bhnse->bhnde', k * zeta[None, :, None, :, None], v)
    chunk_decay = jnp.exp(C * log_gamma)[None, :, None, None]

    def step(state, kv):
        return state * chunk_decay + kv, state

    _, prev = lax.scan(step, jnp.zeros_like(chunk_kv[:, :, 0]), jnp.moveaxis(chunk_kv, 2, 0))
    prev = jnp.moveaxis(prev, 0, 2)
    cross = jnp.einsum('bhncd,bhnde->bhnce', q * xi[None, :, None, :, None], prev)
    return intra + cross


def bidirectional_retention(q, k, v, log_gamma_fb):
    B, S, H, d = q.shape
    nc = S // RET_CHUNK

    def to_chunks(t):
        return t.astype(jnp.float32).reshape(B, nc, RET_CHUNK, H, d).transpose(0, 3, 1, 2, 4)

    def from_chunks(t):
        return t.transpose(0, 2, 3, 1, 4).reshape(B, S, H, d)

    fwd = retention_one_direction(to_chunks(q), to_chunks(k), to_chunks(v), log_gamma_fb[0], True)
    qb, kb, vb = (jnp.flip(t, axis=1) for t in (q, k, v))
    bwd = retention_one_direction(to_chunks(qb), to_chunks(kb), to_chunks(vb), log_gamma_fb[1], False)
    return from_chunks(fwd) + jnp.flip(from_chunks(bwd), axis=1)


def mla_attention(q_nope, q_rope, k_nope, k_rope, v):
    B, S, H, _ = q_nope.shape
    nq = S // Q_BLOCK
    scale = MLA_QK_DIM ** -0.5

    def block(args):
        qn, qr = args
        s = (jnp.einsum('bqhd,bkhd->bhqk', qn, k_nope)
             + jnp.einsum('bqhr,bkr->bhqk', qr, k_rope)).astype(jnp.float32) * scale
        p = jax.nn.softmax(s, axis=-1).astype(v.dtype)
        return jnp.einsum('bhqk,bkhd->bqhd', p, v)

    def to_blocks(t):
        return jnp.moveaxis(t.reshape(B, nq, Q_BLOCK, *t.shape[2:]), 1, 0)

    out = lax.map(block, (to_blocks(q_nope), to_blocks(q_rope)))
    return jnp.moveaxis(out, 0, 1).reshape(B, S, H * MLA_V_DIM)


def setup_inputs(seed: int = 0) -> dict:
    key = jax.random.key(seed)
    ks = jax.random.split(key, 24)
    f32 = jnp.float32

    def w(k, shape, fan_in, gain=1.0):
        return jax.random.normal(k, shape, f32) * (gain * fan_in ** -0.5)

    def gain(k, shape):
        return 1.0 + 0.02 * jax.random.normal(k, shape, f32)

    x = jax.random.normal(ks[0], (BATCH, SEQ, D_MODEL), f32)
    c = jax.random.normal(ks[1], (BATCH, D_MODEL), f32)
    positions = (jnp.arange(SEQ, dtype=jnp.int32)[None, :]
                 + jax.random.randint(ks[2], (BATCH, 1), 0, 1024, dtype=jnp.int32))
    gamma_ms = 1.0 - 2.0 ** (-5.0 - np.arange(RET_HEADS, dtype=np.float32))
    a0 = jnp.asarray(np.log(-np.log(gamma_ms)), f32)
    ret_decay = a0[None, None, :] + 0.05 * jax.random.normal(ks[3], (DEPTH, 2, RET_HEADS), f32)
    return {
        "x": x,
        "c": c,
        "positions": positions,
        "ada_w": w(ks[4], (DEPTH, D_MODEL, N_MOD * D_MODEL), D_MODEL, 0.5),
        "ada_b": 0.01 * jax.random.normal(ks[5], (DEPTH, N_MOD * D_MODEL), f32),
        "norm1_w": gain(ks[6], (DEPTH, D_MODEL)),
        "w_in": w(ks[7], (DEPTH, D_MODEL, IN_COLS), D_MODEL),
        "ret_decay": ret_decay,
        "ret_gn_w": gain(ks[8], (DEPTH, RET_WIDTH)),
        "ret_gn_b": 0.01 * jax.random.normal(ks[9], (DEPTH, RET_WIDTH), f32),
        "mla_q_norm_w": gain(ks[10], (DEPTH, MLA_Q_RANK)),
        "w_uq": w(ks[11], (DEPTH, MLA_Q_RANK, MLA_HEADS * MLA_QK_DIM), MLA_Q_RANK),
        "mla_kv_norm_w": gain(ks[12], (DEPTH, MLA_KV_RANK)),
        "w_ukv": w(ks[13], (DEPTH, MLA_KV_RANK, MLA_HEADS * (MLA_NOPE_DIM + MLA_V_DIM)), MLA_KV_RANK),
        "mla_out_w": gain(ks[14], (DEPTH, MLA_WIDTH)),
        "w_o": w(ks[15], (DEPTH, MIX_WIDTH, D_MODEL), MIX_WIDTH),
        "norm2_w": gain(ks[16], (DEPTH, D_MODEL)),
        "w_gate": w(ks[17], (DEPTH, D_MODEL, D_FF), D_MODEL),
        "w_up": w(ks[18], (DEPTH, D_MODEL, D_FF), D_MODEL),
        "w_down": w(ks[19], (DEPTH, D_FF, D_MODEL), D_FF),
        "final_norm_w": gain(ks[20], (D_MODEL,)),
    }


def reference(x, c, positions, ada_w, ada_b, norm1_w, w_in, ret_decay, ret_gn_w, ret_gn_b,
              mla_q_norm_w, w_uq, mla_kv_norm_w, w_ukv, mla_out_w, w_o, norm2_w,
              w_gate, w_up, w_down, final_norm_w):
    B, S, _ = x.shape
    cos_r, sin_r = rope_tables(positions, RET_HEAD_DIM)
    cos_m, sin_m = rope_tables(positions, MLA_ROPE_DIM)
    c_act = jax.nn.silu(c)
    split_at = list(np.cumsum([RET_WIDTH, RET_WIDTH, RET_WIDTH, RET_WIDTH, MLA_Q_RANK, MLA_KV_RANK]))

    for l in range(DEPTH):
        mod = (c_act @ ada_w[l] + ada_b[l])[:, None, :]
        shift_a, scale_a, gate_a, shift_f, scale_f, gate_f = jnp.split(mod, N_MOD, axis=-1)

        h = rmsnorm(x, norm1_w[l]) * (1.0 + scale_a) + shift_a
        proj = h @ w_in[l]
        q_r, k_r, v_r, g_r, cq, ckv, k_rope = jnp.split(proj, split_at, axis=-1)

        hs = (B, S, RET_HEADS, RET_HEAD_DIM)
        q_r = apply_rope(q_r.reshape(hs), cos_r[:, :, None], sin_r[:, :, None])
        k_r = apply_rope(k_r.reshape(hs), cos_r[:, :, None], sin_r[:, :, None]) * (RET_HEAD_DIM ** -0.5)
        log_gamma = -jnp.exp(ret_decay[l].astype(jnp.float32))
        y_r = bidirectional_retention(q_r, k_r, v_r.reshape(hs), log_gamma)
        mu = jnp.mean(y_r, axis=-1, keepdims=True)
        var = jnp.mean(jnp.square(y_r - mu), axis=-1, keepdims=True)
        y_r = ((y_r - mu) * lax.rsqrt(var + EPS)).reshape(B, S, RET_WIDTH)
        y_r = y_r * ret_gn_w[l].astype(jnp.float32) + ret_gn_b[l].astype(jnp.float32)
        ret_out = (jax.nn.silu(g_r.astype(jnp.float32)) * y_r).astype(x.dtype)

        q_m = (rmsnorm(cq, mla_q_norm_w[l]) @ w_uq[l]).reshape(B, S, MLA_HEADS, MLA_QK_DIM)
        q_nope, q_rope = jnp.split(q_m, [MLA_NOPE_DIM], axis=-1)
        q_rope = apply_rope(q_rope, cos_m[:, :, None], sin_m[:, :, None])
        kv = (rmsnorm(ckv, mla_kv_norm_w[l]) @ w_ukv[l]).reshape(B, S, MLA_HEADS, MLA_NOPE_DIM + MLA_V_DIM)
        k_nope, v_m = jnp.split(kv, [MLA_NOPE_DIM], axis=-1)
        k_rope = apply_rope(k_rope, cos_m, sin_m)
        mla_out = rmsnorm(mla_attention(q_nope, q_rope, k_nope, k_rope, v_m), mla_out_w[l])

        mixed = jnp.concatenate([ret_out, mla_out], axis=-1) @ w_o[l]
        x = x + gate_a * mixed

        h = rmsnorm(x, norm2_w[l]) * (1.0 + scale_f) + shift_f
        ff = (jax.nn.silu(h @ w_gate[l]) * (h @ w_up[l])) @ w_down[l]
        x = x + gate_f * ff

    return rmsnorm(x, final_norm_w)
```

```cpp
#include <hip/hip_runtime.h>
#include <hip/hip_cooperative_groups.h>
#include <cstdio>
#include <cstdint>
#include <cmath>
namespace cg = cooperative_groups;
namespace pg8 {
#define PG8_LAS __attribute__((address_space(3)))
typedef unsigned short bf16_t;
typedef short bf16x8 __attribute__((ext_vector_type(8)));
typedef float f32x4 __attribute__((ext_vector_type(4)));
typedef unsigned u32x4 __attribute__((ext_vector_type(4)));
constexpr int BM = 256, BK = 64, HALF = 128, HTB = HALF * BK * 2  , STAGE_BYTES = 8 * HTB, NXCD = 8, WGM = 8;

__host__ __device__ __forceinline__ int lds_byte(int r, int c) { const int st = (r >> 4) * 2 + (c >> 5), rr = r & 15, cc = c & 31, ob = rr * 64 + cc * 2; return st * 1024 + (ob ^ (((ob >> 9) & 1) << 5)); }
__host__ __device__ __forceinline__ void stage_rc(int b, int& R, int& C) { const int st = b / 1024, sb = b % 1024, swz = sb ^ (((sb >> 9) & 1) << 5); R = (st >> 1) * 16 + swz / 64; C = (st & 1) * 32 + (swz % 64) / 2; }
__host__ __device__ __forceinline__ int perm32(int rho) { const int n = rho >> 4, i = rho & 15; return 8 * (i >> 2) + 4 * n + (i & 3); }

struct Unit { int pm, pn; };
struct Gemm { const bf16_t* A; const bf16_t* Bt; int M, N, K; };

struct StaticOrder {
    int nM, nN, nwg, G, c;
    __host__ __device__ void init(int M, int N, int G_, int c_) { nM = M / BM; nN = N / BM; nwg = nM * nN; G = G_; c = c_; }
    __host__ __device__ bool next(int i, Unit& u) const {
        const long L = (long)i * G + c; if (L >= nwg) return false;
        int wgid = (int)L; { const int q = nwg / NXCD, r = nwg % NXCD, xcd = wgid % NXCD, off = wgid / NXCD; wgid = (xcd < r ? xcd * (q + 1) : r * (q + 1) + (xcd - r) * q) + off; }
        const int nig = WGM * nN, gid = wgid / nig, fm = gid * WGM, gsz = (nM - fm) < WGM ? (nM - fm) : WGM;
        u.pm = fm + ((wgid % nig) % gsz); u.pn = (wgid % nig) / gsz; return true;
    }
    __device__ __forceinline__ void a_ready(const Unit&) const {}
    __device__ __forceinline__ void done(const Unit&) const {}
};

#ifndef PROBE_COARSE_ACT
#define PROBE_COARSE_ACT 0
#endif
__device__ __forceinline__ unsigned coarse2(unsigned w) { return PROBE_COARSE_ACT ? ((w + ((w >> 1) & 0x00010001u)) & 0xfffefffeu) : w; }
__device__ __forceinline__ unsigned cvt_pk_bf16(float lo, float hi) { unsigned r; asm volatile("v_cvt_pk_bf16_f32 %0, %1, %2" : "=v"(r) : "v"(lo), "v"(hi)); return coarse2(r); }
typedef float f32x2 __attribute__((ext_vector_type(2)));

typedef unsigned u32x2 __attribute__((ext_vector_type(2)));
__device__ __forceinline__ float silu_f(float v) { return v / (1.f + __expf(-v)); }
__device__ __forceinline__ u32x4 pack8(f32x4 a, f32x4 b) { u32x4 w; w.x = cvt_pk_bf16(a[0], a[1]); w.y = cvt_pk_bf16(a[2], a[3]); w.z = cvt_pk_bf16(b[0], b[1]); w.w = cvt_pk_bf16(b[2], b[3]); return w; }
__device__ __forceinline__ void rope8(f32x4& a, f32x4& b, const f32x4 c, const f32x4 s) {
    float t1, t2;
    t1 = a[0]; t2 = a[1]; a[0] = t1 * c[0] - t2 * s[0]; a[1] = t2 * c[0] + t1 * s[0];
    t1 = a[2]; t2 = a[3]; a[2] = t1 * c[1] - t2 * s[1]; a[3] = t2 * c[1] + t1 * s[1];
    t1 = b[0]; t2 = b[1]; b[0] = t1 * c[2] - t2 * s[2]; b[1] = t2 * c[2] + t1 * s[2];
    t1 = b[2]; t2 = b[3]; b[2] = t1 * c[3] - t2 * s[3]; b[3] = t2 * c[3] + t1 * s[3];
}
constexpr float NORM_EPS = 1e-6f;

struct EpiIn {
    static constexpr bool PERM = true, AFTER_DRAIN = false;
    bf16_t *Qr, *Kr, *Vr, *Gr, *CQ, *CKV, *Kbuf; const float *cosr, *sinr, *cosm, *sinm; float *ssq_q, *ssq_kv;
    __device__ __forceinline__ void operator()(const f32x4 (&acc)[2][2][4][2], const Unit& u, int wr, int wc, int fr, int fq) const {
        const int pn = u.pn, row0 = u.pm * BM + wr * 64 + fr, cl = wc * 32 + 8 * fq;
        if (pn < 8) {
            bf16_t* O = pn < 4 ? Qr : Kr; const float sc = pn < 4 ? 1.f : 0.08838834764831845f; const int colt = (pn & 3) * 256 + cl;
#pragma unroll
            for (int ai = 0; ai < 2; ++ai)
#pragma unroll
                for (int m = 0; m < 4; ++m) { const int row = row0 + ai * HALF + m * 16;
                    const f32x4 c4 = *(const f32x4*)(cosr + (size_t)row * 64 + (cl >> 1)), s4 = *(const f32x4*)(sinr + (size_t)row * 64 + (cl >> 1));
#pragma unroll
                    for (int bj = 0; bj < 2; ++bj) { f32x4 a = acc[ai][bj][m][0], b = acc[ai][bj][m][1]; rope8(a, b, c4, s4); a = a * sc; b = b * sc;
                        *(u32x4*)(O + (size_t)row * 1024 + colt + bj * HALF) = pack8(a, b); } }
        } else if (pn < 16) {
            const bool isg = pn >= 12; bf16_t* O = isg ? Gr : Vr; const int colt = (pn & 3) * 256 + cl;
#pragma unroll
            for (int ai = 0; ai < 2; ++ai)
#pragma unroll
                for (int m = 0; m < 4; ++m) { const int row = row0 + ai * HALF + m * 16;
#pragma unroll
                    for (int bj = 0; bj < 2; ++bj) { f32x4 a = acc[ai][bj][m][0], b = acc[ai][bj][m][1];
                        if (isg) {
#pragma unroll
                            for (int i = 0; i < 4; ++i) { a[i] = silu_f(a[i]); b[i] = silu_f(b[i]); } }
                        *(u32x4*)(O + (size_t)row * 1024 + colt + bj * HALF) = pack8(a, b); } }
        } else if (pn < 20) {
            bf16_t* O = pn < 18 ? CQ : CKV; float* sq = pn < 18 ? ssq_q : ssq_kv; const int colt = (pn & 1) * 256 + cl;
#pragma unroll
            for (int ai = 0; ai < 2; ++ai)
#pragma unroll
                for (int m = 0; m < 4; ++m) { const int row = row0 + ai * HALF + m * 16; float s = 0.f;
#pragma unroll
                    for (int bj = 0; bj < 2; ++bj) { const f32x4 a = acc[ai][bj][m][0], b = acc[ai][bj][m][1];
                        s += (a[0] * a[0] + a[1] * a[1]) + (a[2] * a[2] + a[3] * a[3]) + (b[0] * b[0] + b[1] * b[1]) + (b[2] * b[2] + b[3] * b[3]);
                        *(u32x4*)(O + (size_t)row * 512 + colt + bj * HALF) = pack8(a, b); }
                    s += __shfl_xor(s, 16); s += __shfl_xor(s, 32);
                    if (fq == 0) atomicAdd(sq + row, s); }
        } else {
            if (wc < 2) {
#pragma unroll
                for (int ai = 0; ai < 2; ++ai)
#pragma unroll
                    for (int m = 0; m < 4; ++m) { const int row = row0 + ai * HALF + m * 16;
                        const f32x4 c4 = *(const f32x4*)(cosm + (size_t)row * 32 + (cl >> 1)), s4 = *(const f32x4*)(sinm + (size_t)row * 32 + (cl >> 1));
                        f32x4 a = acc[ai][0][m][0], b = acc[ai][0][m][1]; rope8(a, b, c4, s4); const u32x4 w = pack8(a, b);
#pragma unroll
                        for (int h = 0; h < 8; ++h) *(u32x4*)(Kbuf + (size_t)row * 1536 + h * 192 + 128 + cl) = w; }
            }
        }
    }
};
struct EpiUpQ {
    static constexpr bool PERM = true, AFTER_DRAIN = false;
    const float* ssq; bf16_t* Qm; const float *cosm, *sinm;
    __device__ __forceinline__ void operator()(const f32x4 (&acc)[2][2][4][2], const Unit& u, int wr, int wc, int fr, int fq) const {
        const int row0 = u.pm * BM + wr * 64 + fr, cl = wc * 32 + 8 * fq;
#pragma unroll
        for (int ai = 0; ai < 2; ++ai)
#pragma unroll
            for (int m = 0; m < 4; ++m) { const int row = row0 + ai * HALF + m * 16; const float rstd = rsqrtf(ssq[row] * (1.f / 512.f) + NORM_EPS);
#pragma unroll
                for (int bj = 0; bj < 2; ++bj) { const int c = u.pn * 256 + bj * HALF + cl, d = c % 192; f32x4 a = acc[ai][bj][m][0] * rstd, b = acc[ai][bj][m][1] * rstd;
                    if (d >= 128) { const int fi = (d - 128) >> 1; const f32x4 c4 = *(const f32x4*)(cosm + (size_t)row * 32 + fi), s4 = *(const f32x4*)(sinm + (size_t)row * 32 + fi); rope8(a, b, c4, s4); }
                    *(u32x4*)(Qm + (size_t)row * 1536 + c) = pack8(a, b); } }
    }
};
struct EpiUpKV {
    static constexpr bool PERM = true, AFTER_DRAIN = false;
    const float* ssq; bf16_t *Kbuf, *Vm;
    __device__ __forceinline__ void operator()(const f32x4 (&acc)[2][2][4][2], const Unit& u, int wr, int wc, int fr, int fq) const {
        const int row0 = u.pm * BM + wr * 64 + fr, cl = wc * 32 + 8 * fq;
#pragma unroll
        for (int ai = 0; ai < 2; ++ai)
#pragma unroll
            for (int m = 0; m < 4; ++m) { const int row = row0 + ai * HALF + m * 16; const float rstd = rsqrtf(ssq[row] * (1.f / 512.f) + NORM_EPS);
                *(u32x4*)(Kbuf + (size_t)row * 1536 + u.pn * 192 + cl) = pack8(acc[ai][0][m][0] * rstd, acc[ai][0][m][1] * rstd);
                *(u32x4*)(Vm + (size_t)row * 1024 + u.pn * 128 + cl) = pack8(acc[ai][1][m][0] * rstd, acc[ai][1][m][1] * rstd); }
    }
};
struct EpiGateRes {
    static constexpr bool PERM = true, AFTER_DRAIN = false;
    const float* x; const float* gate; float* out;
    __device__ __forceinline__ void operator()(const f32x4 (&acc)[2][2][4][2], const Unit& u, int wr, int wc, int fr, int fq) const {
        const int row0 = u.pm * BM + wr * 64 + fr, cl = wc * 32 + 8 * fq, b = u.pm >> 4;
#pragma unroll
        for (int bj = 0; bj < 2; ++bj) { const int c = u.pn * 256 + bj * HALF + cl;
            const f32x4 g0 = *(const f32x4*)(gate + (size_t)b * 12288 + c), g1 = *(const f32x4*)(gate + (size_t)b * 12288 + c + 4);
#pragma unroll
            for (int ai = 0; ai < 2; ++ai)
#pragma unroll
                for (int m = 0; m < 4; ++m) { const size_t off = (size_t)(row0 + ai * HALF + m * 16) * 2048 + c;
                    const f32x4 x0 = *(const f32x4*)(x + off), x1 = *(const f32x4*)(x + off + 4);
                    *(f32x4*)(out + off) = x0 + g0 * acc[ai][bj][m][0]; *(f32x4*)(out + off + 4) = x1 + g1 * acc[ai][bj][m][1]; } }
    }
};
struct EpiGU {
    static constexpr bool PERM = true, AFTER_DRAIN = false;
    bf16_t* Aff;
    __device__ __forceinline__ void operator()(const f32x4 (&acc)[2][2][4][2], const Unit& u, int wr, int wc, int fr, int fq) const {
        const int row0 = u.pm * BM + wr * 64 + fr, cl = wc * 32 + 8 * fq;
#pragma unroll
        for (int ai = 0; ai < 2; ++ai)
#pragma unroll
            for (int m = 0; m < 4; ++m) { const int row = row0 + ai * HALF + m * 16; f32x4 a, b;
#pragma unroll
                for (int i = 0; i < 4; ++i) { a[i] = silu_f(acc[ai][0][m][0][i]) * acc[ai][1][m][0][i]; b[i] = silu_f(acc[ai][0][m][1][i]) * acc[ai][1][m][1][i]; }
                *(u32x4*)(Aff + (size_t)row * 5632 + u.pn * 128 + cl) = pack8(a, b); }
    }
};


struct EpiWoRes {
    static constexpr bool PERM = true, AFTER_DRAIN = false;
    const float* x; const float* mod; const float* w2; float* out; bf16_t* H2; float* ssq1;
    __device__ __forceinline__ void operator()(const f32x4 (&acc)[2][2][4][2], const Unit& u, int wr, int wc, int fr, int fq) const {
        const int row0 = u.pm * BM + wr * 64 + fr, cl = wc * 32 + 8 * fq, b = u.pm >> 4; const float* mb = mod + (size_t)b * 12288;
        float ss[2][4];
#pragma unroll
        for (int ai = 0; ai < 2; ++ai)
#pragma unroll
            for (int m = 0; m < 4; ++m) ss[ai][m] = 0.f;
#pragma unroll
        for (int bj = 0; bj < 2; ++bj) { const int c = u.pn * 256 + bj * HALF + cl;
            const f32x4 g0 = *(const f32x4*)(mb + 2 * 2048 + c), g1 = *(const f32x4*)(mb + 2 * 2048 + c + 4);
            const f32x4 s0 = *(const f32x4*)(w2 + c) * (*(const f32x4*)(mb + 4 * 2048 + c) + 1.f), s1 = *(const f32x4*)(w2 + c + 4) * (*(const f32x4*)(mb + 4 * 2048 + c + 4) + 1.f);
#pragma unroll
            for (int ai = 0; ai < 2; ++ai)
#pragma unroll
                for (int m = 0; m < 4; ++m) { const size_t off = (size_t)(row0 + ai * HALF + m * 16) * 2048 + c;
                    const f32x4 a = *(const f32x4*)(x + off) + g0 * acc[ai][bj][m][0], bb = *(const f32x4*)(x + off + 4) + g1 * acc[ai][bj][m][1];
                    *(f32x4*)(out + off) = a; *(f32x4*)(out + off + 4) = bb;
                    *(u32x4*)(H2 + off) = pack8(a * s0, bb * s1);
                    ss[ai][m] += (a[0] * a[0] + a[1] * a[1]) + (a[2] * a[2] + a[3] * a[3]) + (bb[0] * bb[0] + bb[1] * bb[1]) + (bb[2] * bb[2] + bb[3] * bb[3]); } }
#pragma unroll
        for (int ai = 0; ai < 2; ++ai)
#pragma unroll
            for (int m = 0; m < 4; ++m) { float s = ss[ai][m]; s += __shfl_xor(s, 16); s += __shfl_xor(s, 32); if (fq == 0) atomicAdd(ssq1 + row0 + ai * HALF + m * 16, s); }
    }
};
struct EpiGU2 {
    static constexpr bool PERM = true, AFTER_DRAIN = false;
    bf16_t* Aff; const float* ssq1; const float* biasf;
    __device__ __forceinline__ void operator()(const f32x4 (&acc)[2][2][4][2], const Unit& u, int wr, int wc, int fr, int fq) const {
        const int row0 = u.pm * BM + wr * 64 + fr, cl = wc * 32 + 8 * fq, b = u.pm >> 4; const float* bp = biasf + (size_t)b * 11264 + u.pn * 256 + cl;
        const f32x4 bg0 = *(const f32x4*)(bp), bg1 = *(const f32x4*)(bp + 4), bu0 = *(const f32x4*)(bp + 128), bu1 = *(const f32x4*)(bp + 132);
#pragma unroll
        for (int ai = 0; ai < 2; ++ai)
#pragma unroll
            for (int m = 0; m < 4; ++m) { const int row = row0 + ai * HALF + m * 16; const float rstd = rsqrtf(ssq1[row] * (1.f / 2048.f) + NORM_EPS);
                const f32x4 g0 = acc[ai][0][m][0] * rstd + bg0, g1 = acc[ai][0][m][1] * rstd + bg1, u0 = acc[ai][1][m][0] * rstd + bu0, u1 = acc[ai][1][m][1] * rstd + bu1; f32x4 a, bb;
#pragma unroll
                for (int i = 0; i < 4; ++i) { a[i] = silu_f(g0[i]) * u0[i]; bb[i] = silu_f(g1[i]) * u1[i]; }
                *(u32x4*)(Aff + (size_t)row * 5632 + u.pn * 128 + cl) = pack8(a, bb); }
    }
};

template <class Epi, class Sched, bool ALIGN_EPI = false, bool SP2 = false>
__device__ __forceinline__ void gemm_phase(PG8_LAS unsigned char* lds, const Gemm g, const Sched& S, const Epi& E) {
    const int tid = threadIdx.x, wid = __builtin_amdgcn_readfirstlane(tid >> 6), lane = tid & 63, wr = wid >> 2, wc = wid & 3, fr = lane & 15, fq = lane >> 4;
    const int K = g.K, nt = K / BK;
    unsigned voffA[2], voffB[2];
#pragma unroll
    for (int i = 0; i < 2; ++i) { int R, C; stage_rc(tid * 16 + i * 8192, R, C); const int Rb = Epi::PERM ? ((R & ~31) + perm32(R & 31)) : R;
        voffA[i] = (unsigned)(R * K + C) * 2u; voffB[i] = (unsigned)(Rb * K + C) * 2u; }
    const size_t kstep = (size_t)(BK * 2);
    const size_t hstep = (size_t)HALF * K * 2;
    const size_t tstep = 2 * hstep;
    const unsigned ldsw = (unsigned)wid * 1024u;
    const int aoff = lds_byte(wr * 64 + fr, fq * 8), boff = lds_byte(wc * 32 + fr, fq * 8);
#define PG8_SA(b, h) (((b) * 2 + (h)) * HTB)
#define PG8_SB(b, h) ((4 + (b) * 2 + (h)) * HTB)
#define PG8_STAGE(bufoff, gbase, voff) do { _Pragma("unroll") for (int _i = 0; _i < 2; ++_i) \
        __builtin_amdgcn_global_load_lds((const unsigned*)((const char*)(gbase) + (voff)[_i]), (PG8_LAS unsigned*)(lds + (bufoff) + ldsw + _i * 8192), 16, 0, 0); } while (0)
#define PG8_LDA(dst, b, h) do { _Pragma("unroll") for (int m = 0; m < 4; ++m) _Pragma("unroll") for (int k = 0; k < 2; ++k) dst[m][k] = *(const PG8_LAS bf16x8*)(lds + PG8_SA(b, h) + aoff + m * 2048 + k * 1024); } while (0)
#define PG8_LDB(dst, b, h) do { _Pragma("unroll") for (int n = 0; n < 2; ++n) _Pragma("unroll") for (int k = 0; k < 2; ++k) dst[n][k] = *(const PG8_LAS bf16x8*)(lds + PG8_SB(b, h) + boff + n * 2048 + k * 1024); } while (0)
#define PG8_MMA(ai, bj, At, Bt) do { __builtin_amdgcn_s_setprio(1); _Pragma("unroll") for (int m = 0; m < 4; ++m) _Pragma("unroll") for (int n = 0; n < 2; ++n) _Pragma("unroll") for (int k = 0; k < 2; ++k) \
        acc[ai][bj][m][n] = __builtin_amdgcn_mfma_f32_16x16x32_bf16(Bt[n][k], At[m][k], acc[ai][bj][m][n], 0, 0, 0); __builtin_amdgcn_s_setprio(0); } while (0)
#define PG8_WAIT_V(n) asm volatile("s_waitcnt vmcnt(" #n ")" ::: "memory")
#define PG8_WAIT_L(n) asm volatile("s_waitcnt lgkmcnt(" #n ")" ::: "memory")
#define PG8_BAR __builtin_amdgcn_s_barrier()
#define PG8_SCHED __builtin_amdgcn_sched_barrier(0)
    Unit cur, nxt; int ui = 0;
    if (!S.next(0, cur)) return;
    f32x4 acc[2][2][4][2];
#pragma unroll
    for (int a = 0; a < 2; ++a)
#pragma unroll
        for (int b = 0; b < 2; ++b)
#pragma unroll
            for (int m = 0; m < 4; ++m)
#pragma unroll
                for (int n = 0; n < 2; ++n) acc[a][b][m][n] = (f32x4){0.f, 0.f, 0.f, 0.f};
    bf16x8 At[4][2], B0[2][2], B1[2][2];
    const char* cA = (const char*)g.A + (size_t)cur.pm * tstep; const char* cB = (const char*)g.Bt + (size_t)cur.pn * tstep;
    S.a_ready(cur);
    if constexpr (SP2) {
        PG8_STAGE(PG8_SB(0, 0), cB, voffB); PG8_STAGE(PG8_SB(0, 1), cB + hstep, voffB); PG8_STAGE(PG8_SA(0, 0), cA, voffA); PG8_STAGE(PG8_SA(0, 1), cA + hstep, voffA);
        if (wr == 1) PG8_BAR;
        PG8_WAIT_V(2); PG8_BAR;
        PG8_STAGE(PG8_SB(1, 0), cB + kstep, voffB); PG8_STAGE(PG8_SA(1, 0), cA + kstep, voffA); PG8_STAGE(PG8_SB(1, 1), cB + hstep + kstep, voffB);
        PG8_WAIT_V(6); PG8_BAR;
    } else {
        PG8_STAGE(PG8_SB(0, 0), cB, voffB); PG8_STAGE(PG8_SA(0, 0), cA, voffA); PG8_STAGE(PG8_SB(0, 1), cB + hstep, voffB); PG8_STAGE(PG8_SA(0, 1), cA + hstep, voffA);
        if (wr == 1) PG8_BAR;
        PG8_WAIT_V(4); PG8_BAR;
        PG8_STAGE(PG8_SB(1, 0), cB + kstep, voffB); PG8_STAGE(PG8_SA(1, 0), cA + kstep, voffA); PG8_STAGE(PG8_SB(1, 1), cB + hstep + kstep, voffB);
        PG8_WAIT_V(6); PG8_BAR;
    }
    for (;;) {
        const bool has_next = S.next(ui + 1, nxt);
        const char* nA = has_next ? (const char*)g.A + (size_t)nxt.pm * tstep : cA; const char* nB = has_next ? (const char*)g.Bt + (size_t)nxt.pn * tstep : cB;
        for (int t = 0; t < nt; t += 2) {
            const bool last = (t == nt - 2);
            const char* a1 = cA + (size_t)(t + 1) * kstep;
            const char* a2 = last ? nA : cA + (size_t)(t + 2) * kstep; const char* b2 = last ? nB : cB + (size_t)(t + 2) * kstep;
            const char* a3 = a2 + kstep; const char* b3 = b2 + kstep;
            if (last && has_next) S.a_ready(nxt);
            if constexpr (SP2) {
            PG8_LDB(B0, 0, 0); PG8_LDB(B1, 0, 1); PG8_SCHED; PG8_LDA(At, 0, 0); PG8_STAGE(PG8_SA(1, 1), a1 + hstep, voffA);
            PG8_WAIT_V(8); PG8_WAIT_L(0); PG8_BAR; PG8_MMA(0, 0, At, B0); PG8_MMA(0, 1, At, B1); PG8_BAR; PG8_SCHED;
            PG8_LDA(At, 0, 1); PG8_STAGE(PG8_SB(0, 0), b2, voffB); PG8_STAGE(PG8_SB(0, 1), b2 + hstep, voffB); PG8_STAGE(PG8_SA(0, 0), a2, voffA);
            PG8_WAIT_V(8); PG8_WAIT_L(0); PG8_BAR; PG8_MMA(1, 0, At, B0); PG8_MMA(1, 1, At, B1); PG8_BAR; PG8_SCHED;
            PG8_LDB(B0, 1, 0); PG8_LDB(B1, 1, 1); PG8_SCHED; PG8_LDA(At, 1, 0); PG8_STAGE(PG8_SA(0, 1), a2 + hstep, voffA);
            PG8_WAIT_V(8); PG8_WAIT_L(0); PG8_BAR; PG8_MMA(0, 0, At, B0); PG8_MMA(0, 1, At, B1); PG8_BAR; PG8_SCHED;
            PG8_LDA(At, 1, 1); PG8_STAGE(PG8_SB(1, 0), b3, voffB); PG8_STAGE(PG8_SB(1, 1), b3 + hstep, voffB); PG8_STAGE(PG8_SA(1, 0), a3, voffA);
            PG8_WAIT_V(8); PG8_WAIT_L(0); PG8_BAR; PG8_MMA(1, 0, At, B0); PG8_MMA(1, 1, At, B1); PG8_BAR; PG8_SCHED;
            } else {
            PG8_LDB(B0, 0, 0); PG8_SCHED; PG8_LDA(At, 0, 0); PG8_STAGE(PG8_SA(1, 1), a1 + hstep, voffA);
            PG8_WAIT_L(8); PG8_BAR; PG8_WAIT_L(0); PG8_MMA(0, 0, At, B0); PG8_BAR; PG8_SCHED;
            PG8_LDB(B1, 0, 1); PG8_STAGE(PG8_SB(0, 0), b2, voffB);
            PG8_BAR; PG8_WAIT_L(0); PG8_MMA(0, 1, At, B1); PG8_BAR;
            PG8_LDA(At, 0, 1); PG8_STAGE(PG8_SA(0, 0), a2, voffA);
            PG8_BAR; PG8_WAIT_L(0); PG8_MMA(1, 0, At, B0); PG8_BAR; PG8_SCHED;
            PG8_STAGE(PG8_SB(0, 1), b2 + hstep, voffB);
            PG8_WAIT_V(6); PG8_BAR; PG8_MMA(1, 1, At, B1); PG8_BAR;
            PG8_LDB(B0, 1, 0); PG8_SCHED; PG8_LDA(At, 1, 0); PG8_STAGE(PG8_SA(0, 1), a2 + hstep, voffA);
            PG8_WAIT_L(8); PG8_BAR; PG8_WAIT_L(0); PG8_MMA(0, 0, At, B0); PG8_BAR; PG8_SCHED;
            PG8_LDB(B1, 1, 1); PG8_STAGE(PG8_SB(1, 0), b3, voffB);
            PG8_BAR; PG8_WAIT_L(0); PG8_MMA(0, 1, At, B1); PG8_BAR;
            PG8_LDA(At, 1, 1); PG8_STAGE(PG8_SA(1, 0), a3, voffA);
            PG8_BAR; PG8_WAIT_L(0); PG8_MMA(1, 0, At, B0); PG8_BAR; PG8_SCHED;
            PG8_STAGE(PG8_SB(1, 1), b3 + hstep, voffB);
            PG8_WAIT_V(6); PG8_BAR; PG8_MMA(1, 1, At, B1); PG8_BAR;
            }
        }
        if constexpr (ALIGN_EPI) { if (wr == 0) PG8_BAR; }
        if constexpr (!Epi::AFTER_DRAIN) { E(acc, cur, wr, wc, fr, fq); S.done(cur); }
        if (!has_next) break;
#pragma unroll
        for (int a = 0; a < 2; ++a)
#pragma unroll
            for (int b = 0; b < 2; ++b)
#pragma unroll
                for (int m = 0; m < 4; ++m)
#pragma unroll
                    for (int n = 0; n < 2; ++n) acc[a][b][m][n] = (f32x4){0.f, 0.f, 0.f, 0.f};
        cur = nxt; cA = nA; cB = nB; ++ui;
        if constexpr (ALIGN_EPI) { if (wr == 1) PG8_BAR; }
    }
    PG8_WAIT_V(0);
    if constexpr (!ALIGN_EPI) { if (wr == 0) PG8_BAR; }
    PG8_BAR;
    if constexpr (Epi::AFTER_DRAIN) { E.fused(acc, cur, wr, wc, fr, fq, lds, wid, lane); S.done(cur); }
#undef PG8_SA
#undef PG8_SB
#undef PG8_STAGE
#undef PG8_LDA
#undef PG8_LDB
#undef PG8_MMA
#undef PG8_WAIT_V
#undef PG8_WAIT_L
#undef PG8_BAR
#undef PG8_SCHED
}
}

namespace att {
typedef unsigned short bf16_t;
using bf16x8 = __attribute__((ext_vector_type(8))) short;
using s16x4  = __attribute__((ext_vector_type(4))) short;
using f32x16 = __attribute__((ext_vector_type(16))) float;
using f32x4  = __attribute__((ext_vector_type(4))) float;
using u32x4  = __attribute__((ext_vector_type(4))) unsigned;
using u32x2  = __attribute__((ext_vector_type(2))) unsigned;
constexpr int NW = 8, QBLK = 32, KVBLK = 64;
constexpr int LDQ = 1536, LDK = 1536, LDV = 1024, LDO = 1024;
constexpr float SCALE = 0.07216878364870323f;
constexpr float THR = 8.f;
constexpr int NQR = 4;
constexpr int SHM_V = KVBLK * 128 * 2, SHM_K = KVBLK * 192 * 2, SHM_ATTN = 2 * SHM_V + 2 * SHM_K + NW * 64 * 4;
#define AKSWZ(row, colB) ((row) * 384 + ((colB) ^ (((row) & 7) << 4)))
#define KSWZ128(row, colB) ((row) * 256 + ((colB) ^ (((row) & 7) << 4)))
#define SBAR() __builtin_amdgcn_sched_barrier(0)
#define GAS __attribute__((address_space(1)))
__device__ __forceinline__ const GAS char* uniform_ptr(const void* p) { const unsigned long long v = (unsigned long long)p; const unsigned lo = __builtin_amdgcn_readfirstlane((unsigned)v), hi = __builtin_amdgcn_readfirstlane((unsigned)(v >> 32)); return (const GAS char*)(((unsigned long long)hi << 32) | lo); }
__device__ __forceinline__ int crow(int r, int hi) { return (r & 3) + 8 * (r >> 2) + 4 * hi; }
__device__ __forceinline__ unsigned cvtpk(float lo, float hi) { unsigned r; asm volatile("v_cvt_pk_bf16_f32 %0, %1, %2" : "=v"(r) : "v"(lo), "v"(hi)); return pg8::coarse2(r); }
__device__ __forceinline__ float swap_sum(float v) { auto rr = __builtin_amdgcn_permlane32_swap(__float_as_uint(v), __float_as_uint(v), false, false); return __uint_as_float(rr[0]) + __uint_as_float(rr[1]); }

__device__ __forceinline__ void partialSM(f32x16& p0, f32x16& p1, float& m_reg, float& mn, float& alpha) {
  constexpr float C = SCALE * 1.4426950408889634f;
  float pmax = p0[0];
#pragma unroll
  for (int r = 1; r < 16; ++r) pmax = fmaxf(pmax, p0[r]);
#pragma unroll
  for (int r = 0; r < 16; ++r) pmax = fmaxf(pmax, p1[r]);
  { auto rr = __builtin_amdgcn_permlane32_swap(__float_as_uint(pmax), __float_as_uint(pmax), false, false);
    pmax = fmaxf(__uint_as_float(rr[0]), __uint_as_float(rr[1])); }
  if (__builtin_expect(__all(pmax - m_reg <= THR / SCALE), 1)) { mn = m_reg; alpha = 1.f; }
  else { mn = fmaxf(m_reg, pmax); alpha = __builtin_amdgcn_exp2f((m_reg - mn) * C); m_reg = mn; }
  float mnC = -mn * C;
#pragma unroll
  for (int r = 0; r < 16; ++r) p0[r] = fmaf(p0[r], C, mnC);
#pragma unroll
  for (int r = 0; r < 16; ++r) p1[r] = fmaf(p1[r], C, mnC);
#pragma unroll
  for (int r = 0; r < 16; ++r) p0[r] = __builtin_amdgcn_exp2f(p0[r]);
}
#define PK4(P, BASE, OUT) do { unsigned a0 = cvtpk(P[BASE + 0], P[BASE + 1]), a1 = cvtpk(P[BASE + 2], P[BASE + 3]);   \
    unsigned b0 = cvtpk(P[BASE + 4], P[BASE + 5]), b1 = cvtpk(P[BASE + 6], P[BASE + 7]);                              \
    auto r0 = __builtin_amdgcn_permlane32_swap(a0, b0, false, false); auto r1 = __builtin_amdgcn_permlane32_swap(a1, b1, false, false); \
    u32x4 w = {r0[0], r1[0], r0[1], r1[1]}; OUT = *reinterpret_cast<bf16x8*>(&w); } while (0)
__device__ __forceinline__ void finishSM(f32x16& p0, f32x16& p1, float alpha, float& l_reg, bf16x8& pa0, bf16x8& pa1, bf16x8& pa2, bf16x8& pa3) {
#pragma unroll
  for (int r = 0; r < 16; ++r) p1[r] = __builtin_amdgcn_exp2f(p1[r]);
  float ps = 0;
#pragma unroll
  for (int r = 0; r < 16; ++r) ps += p0[r];
#pragma unroll
  for (int r = 0; r < 16; ++r) ps += p1[r];
  ps = swap_sum(ps);
  l_reg = l_reg * alpha + ps;
  PK4(p0, 0, pa0); PK4(p0, 8, pa1); PK4(p1, 0, pa2); PK4(p1, 8, pa3);
}
__device__ __forceinline__ void qkt192(f32x16& p0, f32x16& p1, const char* Ks, const bf16x8 (&qr)[NQR], const char* Qs, int r32, int hi) {
  p0 = f32x16{}; p1 = f32x16{};
#pragma unroll
  for (int d0 = 0; d0 < 12; ++d0) { int cb = (d0 * 16 + hi * 8) * 2;
    bf16x8 b0 = *reinterpret_cast<const bf16x8*>(Ks + AKSWZ(r32, cb));
    bf16x8 b1 = *reinterpret_cast<const bf16x8*>(Ks + AKSWZ(32 + r32, cb));
    bf16x8 qv; if (d0 < NQR) qv = qr[d0 < NQR ? d0 : 0]; else qv = *reinterpret_cast<const bf16x8*>(Qs + (d0 - NQR) * 1024);
    p0 = __builtin_amdgcn_mfma_f32_32x32x16_bf16(b0, qv, p0, 0, 0, 0);
    p1 = __builtin_amdgcn_mfma_f32_32x32x16_bf16(b1, qv, p1, 0, 0, 0); }
}
__device__ __forceinline__ void qkt128(f32x16& p0, f32x16& p1, const char* Ks, const bf16x8 (&qr)[8], int r32, int hi) {
  p0 = f32x16{}; p1 = f32x16{};
#pragma unroll
  for (int d0 = 0; d0 < 8; ++d0) { int cb = (d0 * 16 + hi * 8) * 2;
    bf16x8 b0 = *reinterpret_cast<const bf16x8*>(Ks + KSWZ128(r32, cb));
    bf16x8 b1 = *reinterpret_cast<const bf16x8*>(Ks + KSWZ128(32 + r32, cb));
    p0 = __builtin_amdgcn_mfma_f32_32x32x16_bf16(b0, qr[d0], p0, 0, 0, 0);
    p1 = __builtin_amdgcn_mfma_f32_32x32x16_bf16(b1, qr[d0], p1, 0, 0, 0); }
}
__device__ __forceinline__ int v_st(int k, int c) { const int kk = (k & ~0xC) | ((k & 4) << 1) | ((k & 8) >> 1); return ((kk >> 3) * 4 + (c >> 5)) * 512 + ((kk & 7) * 32 + (c & 31)) * 2; }
__device__ __forceinline__ int v_rd_base(int lane) { return ((lane & 3) << 3) | (((lane >> 2) & 3) << 6) | (((lane >> 4) & 1) << 5) | (((lane >> 5) & 1) << 8); }
constexpr int v_rd_off(int d0, int ks, int half) { return d0 * 512 + ks * 4096 + half * 2048; }
template <int OFF> __device__ __forceinline__ s16x4 tr_read(int vb) {
  s16x4 r; asm volatile("ds_read_b64_tr_b16 %0, %1 offset:%2" : "=&v"(r) : "v"(vb), "i"(OFF) : "memory"); return r;
}
#define PKLH(L, H) (bf16x8){L[0], L[1], L[2], L[3], H[0], H[1], H[2], H[3]}
template <int D0> __device__ __forceinline__ void pv_one(f32x16& od, int vb, bf16x8 pa0, bf16x8 pa1, bf16x8 pa2, bf16x8 pa3) {
  const s16x4 l0 = tr_read<v_rd_off(D0, 0, 0)>(vb), h0 = tr_read<v_rd_off(D0, 0, 1)>(vb), l1 = tr_read<v_rd_off(D0, 1, 0)>(vb), h1 = tr_read<v_rd_off(D0, 1, 1)>(vb);
  const s16x4 l2 = tr_read<v_rd_off(D0, 2, 0)>(vb), h2 = tr_read<v_rd_off(D0, 2, 1)>(vb), l3 = tr_read<v_rd_off(D0, 3, 0)>(vb), h3 = tr_read<v_rd_off(D0, 3, 1)>(vb);
  asm volatile("s_waitcnt lgkmcnt(0)" ::: "memory"); SBAR();
  od = __builtin_amdgcn_mfma_f32_32x32x16_bf16(pa0, PKLH(l0, h0), od, 0, 0, 0);
  od = __builtin_amdgcn_mfma_f32_32x32x16_bf16(pa1, PKLH(l1, h1), od, 0, 0, 0);
  od = __builtin_amdgcn_mfma_f32_32x32x16_bf16(pa2, PKLH(l2, h2), od, 0, 0, 0);
  od = __builtin_amdgcn_mfma_f32_32x32x16_bf16(pa3, PKLH(l3, h3), od, 0, 0, 0);
}
__device__ __forceinline__ void pv_d0(f32x16* o, int vb, bf16x8 pa0, bf16x8 pa1, bf16x8 pa2, bf16x8 pa3) {
  pv_one<0>(o[0], vb, pa0, pa1, pa2, pa3); pv_one<1>(o[1], vb, pa0, pa1, pa2, pa3); pv_one<2>(o[2], vb, pa0, pa1, pa2, pa3); pv_one<3>(o[3], vb, pa0, pa1, pa2, pa3);
}
template <int D0> __device__ __forceinline__ void pvT_one(f32x16& od, int vb, bf16x8 pa0, bf16x8 pa1, bf16x8 pa2, bf16x8 pa3) {
  const s16x4 l0 = tr_read<v_rd_off(D0, 0, 0)>(vb), h0 = tr_read<v_rd_off(D0, 0, 1)>(vb), l1 = tr_read<v_rd_off(D0, 1, 0)>(vb), h1 = tr_read<v_rd_off(D0, 1, 1)>(vb);
  const s16x4 l2 = tr_read<v_rd_off(D0, 2, 0)>(vb), h2 = tr_read<v_rd_off(D0, 2, 1)>(vb), l3 = tr_read<v_rd_off(D0, 3, 0)>(vb), h3 = tr_read<v_rd_off(D0, 3, 1)>(vb);
  asm volatile("s_waitcnt lgkmcnt(0)" ::: "memory"); SBAR();
  od = __builtin_amdgcn_mfma_f32_32x32x16_bf16(PKLH(l0, h0), pa0, od, 0, 0, 0);
  od = __builtin_amdgcn_mfma_f32_32x32x16_bf16(PKLH(l1, h1), pa1, od, 0, 0, 0);
  od = __builtin_amdgcn_mfma_f32_32x32x16_bf16(PKLH(l2, h2), pa2, od, 0, 0, 0);
  od = __builtin_amdgcn_mfma_f32_32x32x16_bf16(PKLH(l3, h3), pa3, od, 0, 0, 0);
}

__device__ __forceinline__ void attn_unit(const bf16_t* __restrict__ Qb, const bf16_t* __restrict__ Kh, const bf16_t* __restrict__ Vh, bf16_t* __restrict__ Ob, int seq, char* lds, int ldsaddr) {
  const int tid = threadIdx.x, wid = tid >> 6, lane = tid & 63, r32 = lane & 31, hi = lane >> 5;
  char* V_lds = lds; char* K_lds = lds + 2 * SHM_V;
  float* ws = (float*)(lds + 2 * SHM_V + 2 * SHM_K) + wid * 64; float* li_l = ws; float* al_l = ws + 32;
  float m_reg = -1e30f, l_reg = 0; f32x16 o[4] = {}; bf16x8 qr[NQR];
  const bf16_t* Qw = Qb + (long)(wid * QBLK + r32) * LDQ + hi * 8;
  char* Qs = lds + SHM_ATTN + wid * ((12 - NQR) * 1024) + lane * 16;
#pragma unroll
  for (int d0 = 0; d0 < NQR; ++d0) qr[d0] = *reinterpret_cast<const bf16x8*>(Qw + d0 * 16);
#pragma unroll
  for (int d0 = NQR; d0 < 12; ++d0) *(bf16x8*)(Qs + (d0 - NQR) * 1024) = *reinterpret_cast<const bf16x8*>(Qw + d0 * 16);
  const int sr = tid >> 4, sc = (tid & 15) * 8, vst0 = v_st(sr, sc), vst1 = v_st(32 + sr, sc);
  unsigned kg0, kg1, kg2; int kl0, kl1, kl2;
  { int p = tid;        int kr = p / 24, kc = (p % 24) * 8; kg0 = (unsigned)(kr * LDK + kc) * 2u; kl0 = AKSWZ(kr, kc * 2);
    p = tid + 512;      kr = p / 24; kc = (p % 24) * 8;     kg1 = (unsigned)(kr * LDK + kc) * 2u; kl1 = AKSWZ(kr, kc * 2);
    p = tid + 1024;     kr = p / 24; kc = (p % 24) * 8;     kg2 = (unsigned)(kr * LDK + kc) * 2u; kl2 = AKSWZ(kr, kc * 2); }
  const unsigned vg0 = (unsigned)(sr * LDV + sc) * 2u, vg1 = (unsigned)((32 + sr) * LDV + sc) * 2u;
  const int vb0 = ldsaddr + v_rd_base(lane);
  bf16x8 vs0, vs1, ks0, ks1, ks2;
#define SLOAD(k0) do { const GAS char* vb_ = uniform_ptr((const char*)Vh + (size_t)(k0) * (LDV * 2)); const GAS char* kb_ = uniform_ptr((const char*)Kh + (size_t)(k0) * (LDK * 2)); \
    vs0 = *(const GAS bf16x8*)(vb_ + vg0); vs1 = *(const GAS bf16x8*)(vb_ + vg1); \
    ks0 = *(const GAS bf16x8*)(kb_ + kg0); ks1 = *(const GAS bf16x8*)(kb_ + kg1); ks2 = *(const GAS bf16x8*)(kb_ + kg2); } while (0)
#define SWRITE(b) do { *(bf16x8*)(V_lds + (b) * SHM_V + vst0) = vs0; *(bf16x8*)(V_lds + (b) * SHM_V + vst1) = vs1; \
    *(bf16x8*)(K_lds + (b) * SHM_K + kl0) = ks0; *(bf16x8*)(K_lds + (b) * SHM_K + kl1) = ks1; *(bf16x8*)(K_lds + (b) * SHM_K + kl2) = ks2; } while (0)
#define SWAIT() asm volatile("s_waitcnt vmcnt(0)" ::: "memory")
#define RESC(a) do { if (__any((a) < 1.f)) { if (hi == 0) al_l[r32] = (a); asm volatile("s_waitcnt lgkmcnt(0)" ::: "memory"); \
    _Pragma("unroll") for (int d = 0; d < 4; ++d) _Pragma("unroll") for (int r = 0; r < 16; ++r) o[d][r] *= al_l[crow(r, hi)]; } } while (0)
  f32x16 pA0, pA1, pB0, pB1; float mnA, mnB, alA, alB; bf16x8 pa0, pa1, pa2, pa3; const int NT = seq / KVBLK;
  __syncthreads();
  SLOAD(0); SWAIT(); SWRITE(0); __syncthreads();
  qkt192(pA0, pA1, K_lds, qr, Qs, r32, hi); partialSM(pA0, pA1, m_reg, mnA, alA);
  SLOAD(KVBLK);
  SWAIT(); SWRITE(1); __syncthreads();
  for (int j = 1; j + 1 < NT; j += 2) {
    SBAR(); qkt192(pB0, pB1, K_lds + SHM_K, qr, Qs, r32, hi);
    finishSM(pA0, pA1, alA, l_reg, pa0, pa1, pa2, pa3); SBAR();
    SLOAD((j + 1) * KVBLK); SBAR();
    pv_d0(o, vb0, pa0, pa1, pa2, pa3); partialSM(pB0, pB1, m_reg, mnB, alB);
    __syncthreads(); SWAIT(); SWRITE(0);
    RESC(alB); __syncthreads();
    SBAR(); qkt192(pA0, pA1, K_lds, qr, Qs, r32, hi);
    finishSM(pB0, pB1, alB, l_reg, pa0, pa1, pa2, pa3); SBAR();
    SLOAD((j + 2) * KVBLK); SBAR();
    pv_d0(o, vb0 + SHM_V, pa0, pa1, pa2, pa3); partialSM(pA0, pA1, m_reg, mnA, alA);
    __syncthreads(); SWAIT(); SWRITE(1);
    RESC(alA); __syncthreads();
  }
  SBAR(); qkt192(pB0, pB1, K_lds + SHM_K, qr, Qs, r32, hi);
  finishSM(pA0, pA1, alA, l_reg, pa0, pa1, pa2, pa3); SBAR();
  pv_d0(o, vb0, pa0, pa1, pa2, pa3); partialSM(pB0, pB1, m_reg, mnB, alB);
  __syncthreads(); RESC(alB);
  finishSM(pB0, pB1, alB, l_reg, pa0, pa1, pa2, pa3); SBAR();
  pv_d0(o, vb0 + SHM_V, pa0, pa1, pa2, pa3);
  if (hi == 0) li_l[r32] = l_reg; asm volatile("s_waitcnt lgkmcnt(0)" ::: "memory");
  float rli[16];
#pragma unroll
  for (int r = 0; r < 16; ++r) rli[r] = __builtin_amdgcn_rcpf(li_l[crow(r, hi)]);
  bf16_t* Ow = Ob + (long)(wid * QBLK) * LDO;
#pragma unroll
  for (int r = 0; r < 16; ++r) { int orow = crow(r, hi);
#pragma unroll
    for (int d0 = 0; d0 < 4; ++d0) Ow[(long)orow * LDO + d0 * 32 + r32] = (bf16_t)(cvtpk(o[d0][r] * rli[r], 0.f) & 0xffffu); }
#undef SLOAD
#undef SWRITE
#undef SWAIT
#undef RESC
}

__device__ __forceinline__ bf16x8 scale8(bf16x8 v, float s) {
  u32x4 w = *reinterpret_cast<u32x4*>(&v), o;
#pragma unroll
  for (int i = 0; i < 4; ++i) o[i] = cvtpk(__uint_as_float(w[i] << 16) * s, __uint_as_float(w[i] & 0xffff0000u) * s);
  return *reinterpret_cast<bf16x8*>(&o);
}
__device__ __forceinline__ s16x4 trr(int addr) { s16x4 r; asm volatile("ds_read_b64_tr_b16 %0, %1" : "=&v"(r) : "v"(addr) : "memory"); return r; }

__device__ __forceinline__ void chunk_kv_unit(const bf16_t* __restrict__ Kc, const bf16_t* __restrict__ Vc, bf16_t* __restrict__ CKf, bf16_t* __restrict__ CKb, float lgf, float lgb, char* lds, int ldsaddr) {
  const int tid = threadIdx.x, wid = tid >> 6, lane = tid & 63, r32 = lane & 31, hi = lane >> 5;
  const int dir = wid >> 2, db = wid & 3, d = 32 * db + r32;
  __syncthreads();
  { const int sr = tid >> 4, sc = (tid & 15) * 8;
#pragma unroll
    for (int i = 0; i < 4; ++i) { const int row = sr + 32 * i;
      *(bf16x8*)(lds + (row >> 6) * 16384 + v_st(row & 63, sc)) = *reinterpret_cast<const bf16x8*>(Vc + (long)row * 1024 + sc); } }
  bf16x8 kb[8];
  int hio = hi; asm volatile("" : "+v"(hio));
  const GAS char* kg = uniform_ptr(Kc); const unsigned kofs = (unsigned)((hio * 8) * 1024 + d) * 2u;
#pragma unroll
  for (int ks = 0; ks < 8; ++ks) { u32x4 w;
#pragma unroll
    for (int i = 0; i < 4; ++i) { const int s0 = ks * 16 + hio * 8 + 2 * i;
      const float k0 = __uint_as_float((unsigned)*(const GAS unsigned short*)(kg + kofs + (ks * 16 + 2 * i) * 2048) << 16), k1 = __uint_as_float((unsigned)*(const GAS unsigned short*)(kg + kofs + (ks * 16 + 2 * i + 1) * 2048) << 16);
      const float z0 = __builtin_amdgcn_exp2f(dir ? lgb * (float)s0 : lgf * (float)(127 - s0)), z1 = __builtin_amdgcn_exp2f(dir ? lgb * (float)(s0 + 1) : lgf * (float)(126 - s0));
      w[i] = cvtpk(k0 * z0, k1 * z1); }
    kb[ks] = *reinterpret_cast<bf16x8*>(&w); }
  __syncthreads();
  f32x16 acc[4] = {};
  const int vb = ldsaddr + v_rd_base(lane);
  pvT_one<0>(acc[0], vb, kb[0], kb[1], kb[2], kb[3]); pvT_one<1>(acc[1], vb, kb[0], kb[1], kb[2], kb[3]); pvT_one<2>(acc[2], vb, kb[0], kb[1], kb[2], kb[3]); pvT_one<3>(acc[3], vb, kb[0], kb[1], kb[2], kb[3]);
  pvT_one<0>(acc[0], vb + 16384, kb[4], kb[5], kb[6], kb[7]); pvT_one<1>(acc[1], vb + 16384, kb[4], kb[5], kb[6], kb[7]); pvT_one<2>(acc[2], vb + 16384, kb[4], kb[5], kb[6], kb[7]); pvT_one<3>(acc[3], vb + 16384, kb[4], kb[5], kb[6], kb[7]);
  bf16_t* CK = dir ? CKb : CKf;
#pragma unroll
  for (int eb = 0; eb < 4; ++eb)
#pragma unroll
    for (int r = 0; r < 16; ++r) CK[(32 * eb + crow(r, hi)) * 128 + d] = (bf16_t)(cvtpk(acc[eb][r], 0.f) & 0xffffu);
}

#ifndef PROBE_COMP
#define PROBE_COMP 0
#endif
__device__ __forceinline__ void ret_out_unit(const bf16_t* __restrict__ Qc, const bf16_t* __restrict__ Kc, const bf16_t* __restrict__ Vc, const bf16_t* __restrict__ Gc,
                                             const bf16_t* __restrict__ STf, const bf16_t* __restrict__ STb, const float* __restrict__ gnw, const float* __restrict__ gnb,
                                             bf16_t* __restrict__ Oc, float lgf, float lgb, char* lds, int ldsaddr, float* dump = nullptr) {
  const int tid = threadIdx.x, ht = tid & 255, wq = (tid >> 6) & 3, lane = tid & 63, r32 = lane & 31, hi = lane >> 5;
  __syncthreads();
  { const int sr = ht >> 4, sc = (ht & 15) * 8;
#pragma unroll
    for (int i = 0; i < 8; ++i) { const int row = sr + 16 * i, tile = row >> 6, key = row & 63;
      *(bf16x8*)(lds + tile * 16384 + KSWZ128(key, sc * 2)) = *reinterpret_cast<const bf16x8*>(Kc + (long)row * 1024 + sc);
      *(bf16x8*)(lds + 32768 + tile * 16384 + v_st(key, sc)) = *reinterpret_cast<const bf16x8*>(Vc + (long)row * 1024 + sc); } }
  const int c = 32 * wq + r32;
  bf16x8 qr[8];
#pragma unroll
  for (int d0 = 0; d0 < 8; ++d0) qr[d0] = *reinterpret_cast<const bf16x8*>(Qc + (long)c * 1024 + d0 * 16 + hi * 8);
  __syncthreads();
  f32x16 pA0, pA1, pB0, pB1;
  qkt128(pA0, pA1, lds, qr, r32, hi); qkt128(pB0, pB1, lds + 16384, qr, r32, hi);
  int cdec = c; asm volatile("" : "+v"(cdec));
#define DEC(P, JB) do { _Pragma("unroll") for (int r = 0; r < 16; ++r) { const int dl = cdec - ((JB) + crow(r, hi)); \
    P[r] *= __builtin_amdgcn_exp2f(dl >= 0 ? lgf * (float)dl : lgb * (float)(-dl)); } } while (0)
  DEC(pA0, 0); DEC(pA1, 32); DEC(pB0, 64); DEC(pB1, 96);
#undef DEC
  bf16x8 xa0, xa1, xa2, xa3, xb0, xb1, xb2, xb3;
  PK4(pA0, 0, xa0); PK4(pA0, 8, xa1); PK4(pA1, 0, xa2); PK4(pA1, 8, xa3);
  PK4(pB0, 0, xb0); PK4(pB0, 8, xb1); PK4(pB1, 0, xb2); PK4(pB1, 8, xb3);
  f32x16 o[4] = {};
  const int vb = ldsaddr + 32768 + v_rd_base(lane);
  if (PROBE_COMP == 0 || (PROBE_COMP & 1)) {
  pvT_one<0>(o[0], vb, xa0, xa1, xa2, xa3); pvT_one<1>(o[1], vb, xa0, xa1, xa2, xa3); pvT_one<2>(o[2], vb, xa0, xa1, xa2, xa3); pvT_one<3>(o[3], vb, xa0, xa1, xa2, xa3);
  pvT_one<0>(o[0], vb + 16384, xb0, xb1, xb2, xb3); pvT_one<1>(o[1], vb + 16384, xb0, xb1, xb2, xb3); pvT_one<2>(o[2], vb + 16384, xb0, xb1, xb2, xb3); pvT_one<3>(o[3], vb + 16384, xb0, xb1, xb2, xb3);
  }
#pragma unroll
  for (int dir = 0; dir < 2; ++dir) {
    if (PROBE_COMP != 0 && !((PROBE_COMP >> (1 + dir)) & 1)) continue;
    const float xi = __builtin_amdgcn_exp2f(dir == 0 ? lgf * (float)(c + 1) : lgb * (float)(128 - c));
    const bf16_t* ST = dir == 0 ? STf : STb;
    bf16x8 qs[8];
#pragma unroll
    for (int d0 = 0; d0 < 8; ++d0) qs[d0] = scale8(qr[d0], xi);
    const GAS char* stb = uniform_ptr(ST); const unsigned so = (unsigned)(r32 * 128 + hi * 8) * 2u;
#pragma unroll
    for (int eb = 0; eb < 4; ++eb) {
      bf16x8 A[8];
      SBAR();
#pragma unroll
      for (int d0 = 0; d0 < 8; ++d0) A[d0] = *(const GAS bf16x8*)(stb + so + (eb * 32 * 128 + d0 * 16) * 2);
#pragma unroll
      for (int d0 = 0; d0 < 8; ++d0) o[eb] = __builtin_amdgcn_mfma_f32_32x32x16_bf16(A[d0], qs[d0], o[eb], 0, 0, 0);
      SBAR();
    }
  }
  if (PROBE_COMP != 0) {
#pragma unroll
    for (int eb = 0; eb < 4; ++eb)
#pragma unroll
      for (int g = 0; g < 4; ++g) *(f32x4*)(dump + (long)c * 1024 + 32 * eb + 8 * g + 4 * hi) = (f32x4){o[eb][4 * g], o[eb][4 * g + 1], o[eb][4 * g + 2], o[eb][4 * g + 3]};
    return; }
  float s = 0.f;
#pragma unroll
  for (int eb = 0; eb < 4; ++eb)
#pragma unroll
    for (int r = 0; r < 16; ++r) s += o[eb][r];
  const float mu = swap_sum(s) * (1.f / 128.f);
  float q = 0.f;
#pragma unroll
  for (int eb = 0; eb < 4; ++eb)
#pragma unroll
    for (int r = 0; r < 16; ++r) { const float d = o[eb][r] - mu; q += d * d; }
  const float rstd = rsqrtf(swap_sum(q) * (1.f / 128.f) + 1e-6f);
#pragma unroll
  for (int eb = 0; eb < 4; ++eb)
#pragma unroll
    for (int g = 0; g < 4; ++g) { const int e0 = 32 * eb + 8 * g + 4 * hi;
      const f32x4 w4 = *(const f32x4*)(gnw + e0), b4 = *(const f32x4*)(gnb + e0);
      const u32x2 gg = *(const u32x2*)(Gc + (long)c * 1024 + e0);
      const float g0 = __uint_as_float(gg.x << 16), g1 = __uint_as_float(gg.x & 0xffff0000u), g2 = __uint_as_float(gg.y << 16), g3 = __uint_as_float(gg.y & 0xffff0000u);
      const float y0 = ((o[eb][4 * g] - mu) * rstd * w4[0] + b4[0]) * g0, y1 = ((o[eb][4 * g + 1] - mu) * rstd * w4[1] + b4[1]) * g1;
      const float y2 = ((o[eb][4 * g + 2] - mu) * rstd * w4[2] + b4[2]) * g2, y3 = ((o[eb][4 * g + 3] - mu) * rstd * w4[3] + b4[3]) * g3;
      u32x2 w; w.x = cvtpk(y0, y1); w.y = cvtpk(y2, y3);
      *(u32x2*)(Oc + (long)c * 2048 + e0) = w; }
}

__device__ __forceinline__ void ret_brute_unit(const bf16_t* __restrict__ Qh, const bf16_t* __restrict__ Kh, const bf16_t* __restrict__ Vh, const bf16_t* __restrict__ Gc,
                                               const float* __restrict__ gnw, const float* __restrict__ gnb, bf16_t* __restrict__ Oc, int t0, float lgf, float lgb, char* lds, const float* dump = nullptr) {
  const int tid = threadIdx.x, qi = tid >> 2, part = tid & 3, t = t0 + qi;
  float q[32], acc[32];
#pragma unroll
  for (int i = 0; i < 32; ++i) { q[i] = __uint_as_float((unsigned)Qh[(long)t * 1024 + part * 32 + i] << 16); acc[i] = 0.f; }
  for (int s0 = 0; s0 < 4096; s0 += 64) {
    { const int rel = s0 < t0 ? 1 : (s0 >= t0 + 128 ? 2 : 0); if (PROBE_COMP != 0 && ((PROBE_COMP >> rel) & 1)) continue; }
    __syncthreads();
    for (int c = tid; c < 64 * 16; c += 512) { const int r = c >> 4, c8 = (c & 15) * 8;
      *(bf16x8*)(lds + (r * 128 + c8) * 2) = *reinterpret_cast<const bf16x8*>(Kh + (long)(s0 + r) * 1024 + c8);
      *(bf16x8*)(lds + 16384 + (r * 128 + c8) * 2) = *reinterpret_cast<const bf16x8*>(Vh + (long)(s0 + r) * 1024 + c8); }
    __syncthreads();
    for (int j = 0; j < 64; ++j) { const int s = s0 + j; float d = 0.f;
      const unsigned short* kr = (const unsigned short*)(lds + (j * 128 + part * 32) * 2); const unsigned short* vr = (const unsigned short*)(lds + 16384 + (j * 128 + part * 32) * 2);
#pragma unroll
      for (int i = 0; i < 32; ++i) d += q[i] * __uint_as_float((unsigned)kr[i] << 16);
      d += __shfl_xor(d, 1); d += __shfl_xor(d, 2);
      const int dl = t - s; const float w = d * __builtin_amdgcn_exp2f(dl >= 0 ? lgf * (float)dl : lgb * (float)(-dl));
#pragma unroll
      for (int i = 0; i < 32; ++i) acc[i] += w * __uint_as_float((unsigned)vr[i] << 16); }
  }
  if (PROBE_COMP != 0) {
#pragma unroll
    for (int i = 0; i < 32; ++i) acc[i] += dump[(long)qi * 1024 + part * 32 + i]; }
  float sm = 0.f;
#pragma unroll
  for (int i = 0; i < 32; ++i) sm += acc[i];
  sm += __shfl_xor(sm, 1); sm += __shfl_xor(sm, 2); const float mu = sm * (1.f / 128.f);
  float qq = 0.f;
#pragma unroll
  for (int i = 0; i < 32; ++i) { const float dd = acc[i] - mu; qq += dd * dd; }
  qq += __shfl_xor(qq, 1); qq += __shfl_xor(qq, 2); const float rstd = rsqrtf(qq * (1.f / 128.f) + 1e-6f);
#pragma unroll
  for (int i = 0; i < 32; ++i) { const int e = part * 32 + i; const float g = __uint_as_float((unsigned)Gc[(long)qi * 1024 + e] << 16);
    Oc[(long)qi * 2048 + e] = (bf16_t)(cvtpk(((acc[i] - mu) * rstd * gnw[e] + gnb[e]) * g, 0.f) & 0xffffu); }
}
#undef SBAR
}


#ifndef PROBE_BRUTE_RET
#define PROBE_BRUTE_RET 0
#endif
#ifndef MK_SPLIT
#define MK_SPLIT 0
#endif
#define LAS __attribute__((address_space(3)))
#define GASX __attribute__((address_space(1)))
typedef unsigned short bf16_t;
typedef unsigned v4u __attribute__((ext_vector_type(4)));
typedef unsigned v2u __attribute__((ext_vector_type(2)));
typedef float f32x4 __attribute__((ext_vector_type(4)));
typedef short bf16x8 __attribute__((ext_vector_type(8)));

constexpr int BATCH = 8, SEQ = 4096, DM = 2048, T = BATCH * SEQ;
constexpr int INC = 5184, INCP = 5376, DFF = 5632, NMODC = 6 * DM;
constexpr int NPH = 11;
constexpr size_t MiB = 1u << 20;
constexpr size_t WS_CTL = 0, CTL_ZERO_BYTES = 2 * MiB;
constexpr size_t OFF_MOD = 0, OFF_SSQQ = 512 * 1024, OFF_SSQKV = 640 * 1024, OFF_SSQ1 = 768 * 1024, OFF_BIASF = 1024 * 1024;
constexpr size_t WS_COSR = 2 * MiB, WS_SINR = 10 * MiB, WS_COSM = 18 * MiB, WS_SINM = 22 * MiB;
constexpr size_t WS_WIN = 26 * MiB, WS_WUQ = 47 * MiB, WS_WUKV = 49 * MiB, WS_WO = 51 * MiB, WS_WGU = 59 * MiB, WS_WDN = 103 * MiB;
constexpr size_t WS_H = 128 * MiB;
constexpr size_t WS_QR = 256 * MiB, WS_KR = 320 * MiB, WS_VR = 384 * MiB, WS_GR = 448 * MiB;
constexpr size_t WS_CQ = 512 * MiB, WS_CKV = 544 * MiB;
constexpr size_t WS_QM = 576 * MiB, WS_KB = 672 * MiB, WS_VM = 768 * MiB, WS_OAT = 832 * MiB, WS_END = 896 * MiB;
constexpr size_t WS_CAT = 576 * MiB;
constexpr size_t WS_AFF = 256 * MiB;
static_assert(WS_AFF + (size_t)T * DFF * 2 <= WS_END && WS_CAT + (size_t)T * 2048 * 2 <= WS_VM, "d_ws map");
constexpr int LDS_BYTES = 150528;

#define LDS_WAIT() asm volatile("s_waitcnt lgkmcnt(0)" ::: "memory")
__device__ __forceinline__ unsigned f2bf(float f) { unsigned u = __builtin_bit_cast(unsigned, f); return (u + 0x7fffu + ((u >> 16) & 1u)) >> 16; }
__device__ __forceinline__ unsigned pk2(float lo, float hi) { return f2bf(lo) | (f2bf(hi) << 16); }
__device__ __forceinline__ unsigned pk2a(float lo, float hi) { return pg8::coarse2(pk2(lo, hi)); }
__device__ __forceinline__ float wave_sum(float v) {
#pragma unroll
    for (int o = 1; o < 64; o <<= 1) v += __shfl_xor(v, o);
    return v;
}
__device__ __forceinline__ int dest_row(int mapid, int n) {
    switch (mapid) {
    case 1: if (n < 2048) { const int j = n & 127; return (n & ~127) + (j < 64 ? 2 * j : 2 * (j - 64) + 1); }
            if (n < 5120) return n;
            { const int j = n - 5120; return 5120 + (j < 32 ? 2 * j : 2 * (j - 32) + 1); }
    case 2: { const int d = n % 192; if (d < 128) return n; const int j = d - 128; return n - d + 128 + (j < 32 ? 2 * j : 2 * (j - 32) + 1); }
    case 3: return (n >> 7) * 256 + (n & 127);
    case 4: return (n >> 7) * 256 + 128 + (n & 127);
    default: return n;
    }
}
__device__ __forceinline__ void transpose_item(const float* __restrict__ W, int K, int N, bf16_t* __restrict__ WT, const float* __restrict__ kscale, int mapid, LAS float* scr, int item, int lane) {
    const int nblk = N / 32, kb = item / nblk, nb = item % nblk, k0 = 64 * kb, n0 = 32 * nb;
#pragma unroll 8
    for (int i = 0; i < 32; ++i) { const int kk = 2 * i + (lane >> 5); float v = W[(size_t)(k0 + kk) * N + n0 + (lane & 31)]; if (kscale) v *= kscale[k0 + kk]; scr[kk * 33 + (lane & 31)] = v; }
    LDS_WAIT(); asm volatile("" ::: "memory");
    const int c = lane & 7;
#pragma unroll
    for (int j = 0; j < 4; ++j) { const int n = (lane >> 3) + 8 * j; const LAS float* s = scr + (8 * c) * 33 + n;
        v4u o; o.x = pk2(s[0 * 33], s[1 * 33]); o.y = pk2(s[2 * 33], s[3 * 33]); o.z = pk2(s[4 * 33], s[5 * 33]); o.w = pk2(s[6 * 33], s[7 * 33]);
        *(v4u*)(WT + (size_t)dest_row(mapid, n0 + n) * K + k0 + 8 * c) = o; }
    LDS_WAIT(); asm volatile("" ::: "memory");
}
__device__ __forceinline__ void norm_row(const float* xrow, const float* __restrict__ w, const float* __restrict__ shift, const float* __restrict__ scale, bf16_t* ob, float* of, int lane) {
    const f32x4* xr = (const f32x4*)xrow + lane;
    f32x4 v[8]; float s = 0.f;
#pragma unroll
    for (int j = 0; j < 8; ++j) { v[j] = xr[64 * j]; s += (v[j].x * v[j].x + v[j].y * v[j].y) + (v[j].z * v[j].z + v[j].w * v[j].w); }
    const float rstd = rsqrtf(wave_sum(s) * (1.f / 2048.f) + 1e-6f);
#pragma unroll
    for (int j = 0; j < 8; ++j) { const int col = 4 * lane + 256 * j; f32x4 y = v[j] * rstd * *(const f32x4*)(w + col);
        if (shift) y = y * (*(const f32x4*)(scale + col) + 1.f) + *(const f32x4*)(shift + col);
        if (ob) { v2u o; o.x = pk2a(y.x, y.y); o.y = pk2a(y.z, y.w); *(v2u*)(ob + col) = o; } else *(f32x4*)(of + col) = y; }
}

struct Args { const float* in[21]; float* out; unsigned char* ws; float inv_r[64]; float inv_m[32]; int ph_lo, ph_hi; };
static_assert(sizeof(Args) == 21 * 8 + 16 + 96 * 4 + 8, "Args has no padding");

__global__ void __launch_bounds__(512, 2) mk_fwd(Args a) {
    extern __shared__ __attribute__((aligned(16))) unsigned char smem[];
    cg::grid_group grid = cg::this_grid();
    const int tid = threadIdx.x, lane = tid & 63, wave = __builtin_amdgcn_readfirstlane(tid >> 6);
    const int G = gridDim.x, bx = blockIdx.x, vcu = (G % 8 == 0) ? (bx % 8) * (G / 8) + bx / 8 : bx;
    const int gw = vcu * 8 + wave, NGW = G * 8;
    LAS unsigned char* lds3 = (LAS unsigned char*)smem; char* ldsg = (char*)smem; const int ldsaddr = (int)(unsigned)(uintptr_t)lds3;
    float* out = a.out;
#define WSB() size_t wz_ = 0; asm volatile("" : "+s"(wz_)); unsigned char* ws = a.ws + wz_
#define INP(name, k) const float* name = a.in[k] + wz_
#define WSF(name, off) float* name = (float*)(ws + (off))
#define WSH(name, off) bf16_t* name = (bf16_t*)(ws + (off))
    const int lo = a.ph_lo, hi = a.ph_hi;
#ifndef PH_MASK
#define PH_MASK 0x7ff
#endif
#define IN(k) (((PH_MASK >> (k)) & 1) && lo <= (k) && (k) < hi)
#define SEAM(k) do { if (IN(k) && IN((k) + 1)) { asm volatile("s_waitcnt vmcnt(0) lgkmcnt(0)" ::: "memory"); grid.sync(); \
    __builtin_amdgcn_fence(__ATOMIC_ACQUIRE, "agent"); asm volatile("s_waitcnt vmcnt(0)" ::: "memory"); } } while (0)

    if (IN(0)) {
        WSB(); WSF(mod, WS_CTL + OFF_MOD); WSF(cosr, WS_COSR); WSF(sinr, WS_SINR); WSF(cosm, WS_COSM); WSF(sinm, WS_SINM);
        WSH(Win, WS_WIN); WSH(Wuq, WS_WUQ); WSH(Wukv, WS_WUKV); WSH(Wo, WS_WO); WSH(Wgu, WS_WGU); WSH(Wdn, WS_WDN);
        INP(cin, 1); INP(ada_w, 3); INP(ada_b, 4); INP(w_in, 6); INP(mla_q_norm_w, 10); INP(w_uq, 11); INP(mla_kv_norm_w, 12); INP(w_ukv, 13); INP(w_o, 15); INP(w_gate, 17); INP(w_up, 18); INP(w_down, 19);
        const int* positions = (const int*)a.in[2] + wz_;
        {
            LAS float* cs = (LAS float*)lds3;
            for (int i = tid; i < 8 * 2048; i += 512) { const int b = i >> 11, k = i & 2047; const float v = cin[i]; cs[k * 8 + b] = v / (1.f + __expf(-v)); }
            __syncthreads();
            for (int task = gw; task < 192 * 16; task += NGW) { const int cb = task % 192, ks = task / 192, col = cb * 64 + lane;
                float acc[8]; const float bias = ks == 0 ? ada_b[col] : 0.f;
#pragma unroll
                for (int b = 0; b < 8; ++b) acc[b] = bias;
                const float* wp = ada_w + (size_t)(ks * 128) * NMODC + col;
                for (int k8 = 0; k8 < 128; k8 += 8) { float wv[8];
#pragma unroll
                    for (int i = 0; i < 8; ++i) wv[i] = wp[(size_t)(k8 + i) * NMODC];
#pragma unroll
                    for (int i = 0; i < 8; ++i) { const LAS f32x4* c4 = (const LAS f32x4*)(cs + (ks * 128 + k8 + i) * 8); const f32x4 c0 = c4[0], c1 = c4[1];
                        acc[0] += c0.x * wv[i]; acc[1] += c0.y * wv[i]; acc[2] += c0.z * wv[i]; acc[3] += c0.w * wv[i]; acc[4] += c1.x * wv[i]; acc[5] += c1.y * wv[i]; acc[6] += c1.z * wv[i]; acc[7] += c1.w * wv[i]; } }
#pragma unroll
                for (int b = 0; b < 8; ++b) atomicAdd(mod + (size_t)b * NMODC + col, acc[b]); }
            __syncthreads();
        }
        {
            LAS float* scr = (LAS float*)(lds3 + wave * 16384);
            constexpr int I_IN = 32 * (INC / 32), I_UQ = 8 * 48, I_UKV = 8 * 64, I_O = 32 * 64, I_G = 32 * (DFF / 32), I_D = (DFF / 64) * 64;
            constexpr int NITEMS = I_IN + I_UQ + I_UKV + I_O + 2 * I_G + I_D;
            for (int it = gw; it < NITEMS; it += NGW) { int r = it;
                if (r < I_IN) { transpose_item(w_in, 2048, INC, Win, nullptr, 1, scr, r, lane); continue; } r -= I_IN;
                if (r < I_UQ) { transpose_item(w_uq, 512, 1536, Wuq, mla_q_norm_w, 2, scr, r, lane); continue; } r -= I_UQ;
                if (r < I_UKV) { transpose_item(w_ukv, 512, 2048, Wukv, mla_kv_norm_w, 0, scr, r, lane); continue; } r -= I_UKV;
                if (r < I_O) { transpose_item(w_o, 2048, 2048, Wo, nullptr, 0, scr, r, lane); continue; } r -= I_O;
                if (r < I_G) { transpose_item(w_gate, 2048, DFF, Wgu, nullptr, 3, scr, r, lane); continue; } r -= I_G;
                if (r < I_G) { transpose_item(w_up, 2048, DFF, Wgu, nullptr, 4, scr, r, lane); continue; } r -= I_G;
                transpose_item(w_down, DFF, 2048, Wdn, nullptr, 0, scr, r, lane); }
            for (int i = bx * 512 + tid; i < (INCP - INC) * 2048 / 8; i += G * 512) *(v4u*)(Win + (size_t)INC * 2048 + (size_t)i * 8) = (v4u){0u, 0u, 0u, 0u};
        }
        {
            for (int i = bx * 512 + tid; i < T * 96; i += G * 512) { const int t = i / 96, j = i % 96; const float pos = (float)positions[t];
                const float inv = j < 64 ? a.inv_r[j] : a.inv_m[j - 64]; const float ang = pos * inv;
                double rev = (double)ang * 0.15915494309189535; rev -= __builtin_rint(rev);
                const double qd = __builtin_rint(rev * 4.0); const double y = (rev - qd * 0.25) * 6.283185307179586; const double y2 = y * y;
                const double sy = y * (1.0 + y2 * (-1.0 / 6 + y2 * (1.0 / 120 + y2 * (-1.0 / 5040 + y2 * (1.0 / 362880 + y2 * (-1.0 / 39916800 + y2 * (1.0 / 6227020800.0)))))));
                const double cy = 1.0 + y2 * (-0.5 + y2 * (1.0 / 24 + y2 * (-1.0 / 720 + y2 * (1.0 / 40320 + y2 * (-1.0 / 3628800 + y2 * (1.0 / 479001600.0 + y2 * (-1.0 / 87178291200.0)))))));
                const int qi = (int)qd & 3;
                const float cv = (float)(qi == 0 ? cy : qi == 1 ? -sy : qi == 2 ? -cy : sy), sv = (float)(qi == 0 ? sy : qi == 1 ? cy : qi == 2 ? -sy : -cy);
                if (j < 64) { cosr[(size_t)t * 64 + j] = cv; sinr[(size_t)t * 64 + j] = sv; } else { cosm[(size_t)t * 32 + j - 64] = cv; sinm[(size_t)t * 32 + j - 64] = sv; } }
        }
    }
    SEAM(0);
    if (IN(1)) { WSB(); WSF(mod, WS_CTL + OFF_MOD); WSH(H, WS_H); INP(x, 0); INP(norm1_w, 5);
        for (int m = gw; m < T; m += NGW) { const int b = m >> 12; norm_row(x + (size_t)m * DM, norm1_w, mod + (size_t)b * NMODC, mod + (size_t)b * NMODC + DM, H + (size_t)m * DM, nullptr, lane); }
        {
            WSH(Wgu, WS_WGU); WSF(biasf, WS_CTL + OFF_BIASF); LAS float* sh = (LAS float*)lds3;
            __syncthreads();
            for (int i = tid; i < 8 * 2048; i += 512) { const int b = i >> 11, k = i & 2047; sh[k * 8 + b] = mod[(size_t)b * NMODC + 3 * DM + k]; }
            __syncthreads();
            for (int n = gw; n < 2 * DFF; n += NGW) { float acc[8];
#pragma unroll
                for (int b = 0; b < 8; ++b) acc[b] = 0.f;
#pragma unroll 1
                for (int j = 0; j < 4; ++j) { const int k0 = lane * 8 + 512 * j; const v4u w = *(const v4u*)(Wgu + (size_t)n * 2048 + k0);
#pragma unroll 1
                    for (int q = 0; q < 4; ++q) { const unsigned wq = q == 0 ? w.x : q == 1 ? w.y : q == 2 ? w.z : w.w; const float w0 = __uint_as_float(wq << 16), w1 = __uint_as_float(wq & 0xffff0000u);
                        const LAS f32x4* c4 = (const LAS f32x4*)(sh + (k0 + 2 * q) * 8); const f32x4 a0 = c4[0], a1 = c4[1], b0 = c4[2], b1 = c4[3];
                        acc[0] += a0.x * w0 + b0.x * w1; acc[1] += a0.y * w0 + b0.y * w1; acc[2] += a0.z * w0 + b0.z * w1; acc[3] += a0.w * w0 + b0.w * w1;
                        acc[4] += a1.x * w0 + b1.x * w1; acc[5] += a1.y * w0 + b1.y * w1; acc[6] += a1.z * w0 + b1.z * w1; acc[7] += a1.w * w0 + b1.w * w1; } }
#pragma unroll
                for (int b = 0; b < 8; ++b) { const float t = wave_sum(acc[b]); if (lane == 0) biasf[(size_t)b * (2 * DFF) + n] = t; } }
            __syncthreads();
        }
    }
    SEAM(1);
    if (IN(2)) {
        WSB(); WSH(H, WS_H); WSH(Win, WS_WIN); WSH(Qr, WS_QR); WSH(Kr, WS_KR); WSH(Vr, WS_VR); WSH(Gr, WS_GR); WSH(CQ, WS_CQ); WSH(CKV, WS_CKV); WSH(Kbuf, WS_KB);
        WSF(cosr, WS_COSR); WSF(sinr, WS_SINR); WSF(cosm, WS_COSM); WSF(sinm, WS_SINM); WSF(ssq_q, WS_CTL + OFF_SSQQ); WSF(ssq_kv, WS_CTL + OFF_SSQKV);
        pg8::Gemm g{H, Win, T, INCP, DM}; pg8::StaticOrder S; S.init(T, INCP, G, bx);
        pg8::EpiIn E{Qr, Kr, Vr, Gr, CQ, CKV, Kbuf, cosr, sinr, cosm, sinm, ssq_q, ssq_kv};
        pg8::gemm_phase<pg8::EpiIn, pg8::StaticOrder, true, true>(lds3, g, S, E);
    }
    SEAM(2);
    if (IN(3)) {
        WSB(); WSH(CQ, WS_CQ); WSH(CKV, WS_CKV); WSH(Wuq, WS_WUQ); WSH(Wukv, WS_WUKV); WSH(Qm, WS_QM); WSH(Kbuf, WS_KB); WSH(Vm, WS_VM); WSH(Kr, WS_KR); WSH(Vr, WS_VR); WSH(CK, WS_H);
        WSF(cosm, WS_COSM); WSF(sinm, WS_SINM); WSF(ssq_q, WS_CTL + OFF_SSQQ); WSF(ssq_kv, WS_CTL + OFF_SSQKV); INP(ret_decay, 7);
        { pg8::Gemm g{CQ, Wuq, T, 1536, 512}; pg8::StaticOrder S; S.init(T, 1536, G, bx); pg8::EpiUpQ E{ssq_q, Qm, cosm, sinm};
          pg8::gemm_phase<pg8::EpiUpQ, pg8::StaticOrder, true, true>(lds3, g, S, E); }
        { pg8::Gemm g{CKV, Wukv, T, 2048, 512}; pg8::StaticOrder S; S.init(T, 2048, G, bx); pg8::EpiUpKV E{ssq_kv, Kbuf, Vm};
          pg8::gemm_phase<pg8::EpiUpKV, pg8::StaticOrder, true, true>(lds3, g, S, E); }
        for (int u = vcu; u < 2048; u += G) { const int n = u & 31, h = (u >> 5) & 7, b = u >> 8; const size_t t0 = (size_t)b * SEQ + n * 128;
            const float lgf = -__expf(ret_decay[h]) * 1.4426950408889634f, lgb = -__expf(ret_decay[8 + h]) * 1.4426950408889634f;
            att::chunk_kv_unit(Kr + t0 * 1024 + h * 128, Vr + t0 * 1024 + h * 128, CK + ((size_t)(b * 8 + h) * 32 + n) * 16384, CK + ((size_t)(64 + b * 8 + h) * 32 + n) * 16384, lgf, lgb, ldsg, ldsaddr); }
        __syncthreads();
    }
    SEAM(3);
    if (IN(4)) {
        WSB(); WSH(Qm, WS_QM); WSH(Kbuf, WS_KB); WSH(Vm, WS_VM); WSH(Oat, WS_OAT); WSH(CK, WS_H); INP(ret_decay, 7);
        for (int u = vcu; u < 1024; u += G) { const int qb = u & 15, h = (u >> 4) & 7, b = u >> 7; const size_t r0 = (size_t)b * SEQ;
            att::attn_unit(Qm + (r0 + qb * 256) * 1536 + h * 192, Kbuf + r0 * 1536 + h * 192, Vm + r0 * 1024 + h * 128, Oat + (r0 + qb * 256) * 1024 + h * 128, SEQ, ldsg, ldsaddr); }
#ifndef NO_SCAN
        for (int idx = bx * 512 + tid; idx < 2 * 64 * 2048; idx += G * 512) { const int dir = idx >> 17, bh = (idx >> 11) & 63, e8 = idx & 2047, h = bh & 7;
            const float cd = __builtin_amdgcn_exp2f(-__expf(ret_decay[dir * 8 + h]) * 1.4426950408889634f * 128.f);
            bf16_t* base = CK + ((size_t)(dir * 64 + bh) * 32) * 16384 + e8 * 8; float st[8];
#pragma unroll
            for (int i = 0; i < 8; ++i) st[i] = 0.f;
            for (int s8 = 0; s8 < 32; s8 += 8) { v4u kv[8];
#pragma unroll
                for (int i = 0; i < 8; ++i) { const int m = dir ? 31 - (s8 + i) : s8 + i; kv[i] = *(const v4u*)(base + (size_t)m * 16384); }
#pragma unroll
                for (int i = 0; i < 8; ++i) { const int m = dir ? 31 - (s8 + i) : s8 + i; v4u o;
                    o.x = pk2a(st[0], st[1]); o.y = pk2a(st[2], st[3]); o.z = pk2a(st[4], st[5]); o.w = pk2a(st[6], st[7]);
                    *(v4u*)(base + (size_t)m * 16384) = o;
#pragma unroll
                    for (int q = 0; q < 4; ++q) { const unsigned w = kv[i][q]; st[2 * q] = st[2 * q] * cd + __uint_as_float(w << 16); st[2 * q + 1] = st[2 * q + 1] * cd + __uint_as_float(w & 0xffff0000u); } } }
        }
#endif
    }
    SEAM(4);
    if (IN(5)) {
        WSB(); WSH(Qr, WS_QR); WSH(Kr, WS_KR); WSH(Vr, WS_VR); WSH(Gr, WS_GR); WSH(CK, WS_H); WSH(Cat, WS_CAT); WSH(Oat, WS_OAT); INP(ret_decay, 7); INP(ret_gn_w, 8); INP(ret_gn_b, 9); INP(mla_out_w, 14);
#if PROBE_BRUTE_RET
        float* dumpb = (float*)(ws + 704 * MiB);
        for (int up = vcu; up < 1024; up += G) {
            if (PROBE_COMP != 0) { const int u = up * 2 + (wave >> 2); const int n = u & 31, h = (u >> 5) & 7, b = u >> 8; const size_t t0 = (size_t)b * SEQ + n * 128;
                const float lgf = -__expf(ret_decay[h]) * 1.4426950408889634f, lgb = -__expf(ret_decay[8 + h]) * 1.4426950408889634f; const int hf = wave >> 2;
                att::ret_out_unit(Qr + t0 * 1024 + h * 128, Kr + t0 * 1024 + h * 128, Vr + t0 * 1024 + h * 128, Gr + t0 * 1024 + h * 128,
                                  CK + ((size_t)(b * 8 + h) * 32 + n) * 16384, CK + ((size_t)(64 + b * 8 + h) * 32 + n) * 16384, ret_gn_w + h * 128, ret_gn_b + h * 128,
                                  Cat + t0 * 2048 + h * 128, lgf, lgb, ldsg + hf * 65536, ldsaddr + hf * 65536, dumpb + t0 * 1024 + h * 128);
                __threadfence(); __syncthreads(); }
            for (int k2 = 0; k2 < 2; ++k2) { const int u = up * 2 + k2; const int n = u & 31, h = (u >> 5) & 7, b = u >> 8; const size_t r0 = (size_t)b * SEQ, t0 = r0 + n * 128;
                const float lgf = -__expf(ret_decay[h]) * 1.4426950408889634f, lgb = -__expf(ret_decay[8 + h]) * 1.4426950408889634f;
                att::ret_brute_unit(Qr + r0 * 1024 + h * 128, Kr + r0 * 1024 + h * 128, Vr + r0 * 1024 + h * 128, Gr + t0 * 1024 + h * 128, ret_gn_w + h * 128, ret_gn_b + h * 128, Cat + t0 * 2048 + h * 128, n * 128, lgf, lgb, ldsg, dumpb + t0 * 1024 + h * 128); } }
        __syncthreads();
        for (int up = vcu; up < 0; up += G) { const int u = up * 2 + (wave >> 2);
#else
        for (int up = vcu; up < 1024; up += G) { const int u = up * 2 + (wave >> 2);
#endif
            const int n = u & 31, h = (u >> 5) & 7, b = u >> 8; const size_t t0 = (size_t)b * SEQ + n * 128;
            const float lgf = -__expf(ret_decay[h]) * 1.4426950408889634f, lgb = -__expf(ret_decay[8 + h]) * 1.4426950408889634f; const int hf = wave >> 2;
            att::ret_out_unit(Qr + t0 * 1024 + h * 128, Kr + t0 * 1024 + h * 128, Vr + t0 * 1024 + h * 128, Gr + t0 * 1024 + h * 128,
                              CK + ((size_t)(b * 8 + h) * 32 + n) * 16384, CK + ((size_t)(64 + b * 8 + h) * 32 + n) * 16384, ret_gn_w + h * 128, ret_gn_b + h * 128,
                              Cat + t0 * 2048 + h * 128, lgf, lgb, ldsg + hf * 65536, ldsaddr + hf * 65536); }
        for (int m = gw; m < T; m += NGW) {
            const bf16_t* orow = Oat + (size_t)m * 1024; float v[16]; float s = 0.f;
#pragma unroll
            for (int j = 0; j < 2; ++j) { const v4u w = *(const v4u*)(orow + lane * 8 + 512 * j);
#pragma unroll
                for (int q = 0; q < 4; ++q) { v[j * 8 + 2 * q] = __uint_as_float(w[q] << 16); v[j * 8 + 2 * q + 1] = __uint_as_float(w[q] & 0xffff0000u); } }
#pragma unroll
            for (int i = 0; i < 16; ++i) s += v[i] * v[i];
            const float rstd = rsqrtf(wave_sum(s) * (1.f / 1024.f) + 1e-6f);
#pragma unroll
            for (int j = 0; j < 2; ++j) { const int col = lane * 8 + 512 * j; const f32x4 w0 = *(const f32x4*)(mla_out_w + col), w1 = *(const f32x4*)(mla_out_w + col + 4); v4u o;
                o.x = pk2a(v[j * 8 + 0] * rstd * w0.x, v[j * 8 + 1] * rstd * w0.y); o.y = pk2a(v[j * 8 + 2] * rstd * w0.z, v[j * 8 + 3] * rstd * w0.w);
                o.z = pk2a(v[j * 8 + 4] * rstd * w1.x, v[j * 8 + 5] * rstd * w1.y); o.w = pk2a(v[j * 8 + 6] * rstd * w1.z, v[j * 8 + 7] * rstd * w1.w);
                *(v4u*)(Cat + (size_t)m * 2048 + 1024 + col) = o; } }
        __syncthreads();
    }
    SEAM(5);
    if (IN(6)) {
        WSB(); WSH(Cat, WS_CAT); WSH(Wo, WS_WO); WSF(mod, WS_CTL + OFF_MOD); WSH(H, WS_H); WSF(ssq1, WS_CTL + OFF_SSQ1); INP(x, 0); INP(norm2_w, 16);
        pg8::Gemm g{Cat, Wo, T, 2048, 2048}; pg8::StaticOrder S; S.init(T, 2048, G, bx); pg8::EpiWoRes E{x, mod, norm2_w, out, H, ssq1};
        pg8::gemm_phase<pg8::EpiWoRes, pg8::StaticOrder, true, true>(lds3, g, S, E);
    }
    SEAM(6);
    if (IN(8)) {
        WSB(); WSH(H, WS_H); WSH(Wgu, WS_WGU); WSH(Aff, WS_AFF); WSF(ssq1, WS_CTL + OFF_SSQ1); WSF(biasf, WS_CTL + OFF_BIASF);
        pg8::Gemm g{H, Wgu, T, 2 * DFF, DM}; pg8::StaticOrder S; S.init(T, 2 * DFF, G, bx); pg8::EpiGU2 E{Aff, ssq1, biasf};
        pg8::gemm_phase<pg8::EpiGU2, pg8::StaticOrder, true, true>(lds3, g, S, E);
    }
    SEAM(8);
    if (IN(9)) {
        WSB(); WSH(Aff, WS_AFF); WSH(Wdn, WS_WDN); WSF(mod, WS_CTL + OFF_MOD);
        pg8::Gemm g{Aff, Wdn, T, 2048, DFF}; pg8::StaticOrder S; S.init(T, 2048, G, bx); pg8::EpiGateRes E{out, mod + 5 * DM, out};
        pg8::gemm_phase<pg8::EpiGateRes, pg8::StaticOrder, true, true>(lds3, g, S, E);
    }
    SEAM(9);
    if (IN(10)) { WSB(); (void)ws; INP(final_norm_w, 20);
        for (int m = gw; m < T; m += NGW) norm_row(out + (size_t)m * DM, final_norm_w, nullptr, nullptr, nullptr, out + (size_t)m * DM, lane); }
#undef IN
#undef SEAM
}

extern "C" void kernel_launch(void* const* d_in, const int* in_sizes, int n_in, void* d_out, int out_size, void* d_ws, size_t ws_size, hipStream_t stream) {
    static int grid = 0;
    if (grid == 0) {
        if (n_in != 21 || in_sizes[0] != T * DM || out_size != T * DM || ws_size < WS_END) { fprintf(stderr, "kernel_launch: shape/workspace mismatch (n_in %d, ws %zu < %zu)\n", n_in, ws_size, (size_t)WS_END); grid = -1; return; }
        int dev = 0, cus = 0, per_cu = 0;
        (void)hipGetDevice(&dev); (void)hipDeviceGetAttribute(&cus, hipDeviceAttributeMultiprocessorCount, dev);
        if (hipFuncSetAttribute((const void*)mk_fwd, hipFuncAttributeMaxDynamicSharedMemorySize, LDS_BYTES) != hipSuccess) { fprintf(stderr, "kernel_launch: hipFuncSetAttribute failed\n"); grid = -1; return; }
        if (hipOccupancyMaxActiveBlocksPerMultiprocessor(&per_cu, (const void*)mk_fwd, 512, LDS_BYTES) != hipSuccess || per_cu < 1) { fprintf(stderr, "kernel_launch: occupancy query gave %d\n", per_cu); per_cu = 1; }
        (void)hipGetLastError();
        grid = cus * per_cu;
    }
    if (grid < 0) return;
    (void)hipMemsetAsync((char*)d_ws + WS_CTL, 0, CTL_ZERO_BYTES, stream);
    Args a{};
    for (int i = 0; i < 21; ++i) a.in[i] = (const float*)d_in[i];
    a.out = (float*)d_out; a.ws = (unsigned char*)d_ws;
    for (int i = 0; i < 64; ++i) a.inv_r[i] = powf(10000.0f, -((float)(2 * i)) / 128.0f);
    for (int i = 0; i < 32; ++i) a.inv_m[i] = powf(10000.0f, -((float)(2 * i)) / 64.0f);
#if MK_SPLIT
    for (int p = 0; p < NPH; ++p) { a.ph_lo = p; a.ph_hi = p + 1; hipLaunchKernelGGL(mk_fwd, dim3(grid), dim3(512), LDS_BYTES, stream, a); }
#else
    a.ph_lo = 0; a.ph_hi = NPH;
    void* args[] = {&a};
    hipError_t e = hipLaunchCooperativeKernel((const void*)mk_fwd, dim3(grid), dim3(512), args, LDS_BYTES, stream);
    if (e != hipSuccess) fprintf(stderr, "kernel_launch: cooperative launch failed: %s (grid %d)\n", hipGetErrorString(e), grid);
#endif
}
```

```cpp
#include <hip/hip_runtime.h>
#include <hip/hip_cooperative_groups.h>
#include <cstdio>
#include <cstdint>
#include <cmath>
namespace cg = cooperative_groups;
namespace pg8 {
#define PG8_LAS __attribute__((address_space(3)))
typedef unsigned short bf16_t;
typedef short bf16x8 __attribute__((ext_vector_type(8)));
typedef float f32x4 __attribute__((ext_vector_type(4)));
typedef unsigned u32x4 __attribute__((ext_vector_type(4)));
constexpr int BM = 256, BK = 64, HALF = 128, HTB = HALF * BK * 2  , STAGE_BYTES = 8 * HTB, NXCD = 8, WGM = 8;

__host__ __device__ __forceinline__ int lds_byte(int r, int c) { const int st = (r >> 4) * 2 + (c >> 5), rr = r & 15, cc = c & 31, ob = rr * 64 + cc * 2; return st * 1024 + (ob ^ (((ob >> 9) & 1) << 5)); }
__host__ __device__ __forceinline__ void stage_rc(int b, int& R, int& C) { const int st = b / 1024, sb = b % 1024, swz = sb ^ (((sb >> 9) & 1) << 5); R = (st >> 1) * 16 + swz / 64; C = (st & 1) * 32 + (swz % 64) / 2; }
__host__ __device__ __forceinline__ int perm32(int rho) { const int n = rho >> 4, i = rho & 15; return 8 * (i >> 2) + 4 * n + (i & 3); }

struct Unit { int pm, pn; };
struct Gemm { const bf16_t* A; const bf16_t* Bt; int M, N, K; };

struct StaticOrder {
    int nM, nN, nwg, G, c;
    __host__ __device__ void init(int M, int N, int G_, int c_) { nM = M / BM; nN = N / BM; nwg = nM * nN; G = G_; c = c_; }
    __host__ __device__ bool next(int i, Unit& u) const {
        const long L = (long)i * G + c; if (L >= nwg) return false;
        int wgid = (int)L; { const int q = nwg / NXCD, r = nwg % NXCD, xcd = wgid % NXCD, off = wgid / NXCD; wgid = (xcd < r ? xcd * (q + 1) : r * (q + 1) + (xcd - r) * q) + off; }
        const int nig = WGM * nN, gid = wgid / nig, fm = gid * WGM, gsz = (nM - fm) < WGM ? (nM - fm) : WGM;
        u.pm = fm + ((wgid % nig) % gsz); u.pn = (wgid % nig) / gsz; return true;
    }
    __device__ __forceinline__ void a_ready(const Unit&) const {}
    __device__ __forceinline__ void done(const Unit&) const {}
};

#ifndef PROBE_COARSE_ACT
#define PROBE_COARSE_ACT 0
#endif
__device__ __forceinline__ unsigned coarse2(unsigned w) { return PROBE_COARSE_ACT ? ((w + ((w >> 1) & 0x00010001u)) & 0xfffefffeu) : w; }
__device__ __forceinline__ unsigned cvt_pk_bf16(float lo, float hi) { unsigned r; asm volatile("v_cvt_pk_bf16_f32 %0, %1, %2" : "=v"(r) : "v"(lo), "v"(hi)); return coarse2(r); }
typedef float f32x2 __attribute__((ext_vector_type(2)));

typedef unsigned u32x2 __attribute__((ext_vector_type(2)));
__device__ __forceinline__ float silu_f(float v) { return v * __builtin_amdgcn_rcpf(1.f + __builtin_amdgcn_exp2f(v * -1.4426950408889634f)); }
__device__ __forceinline__ u32x4 pack8(f32x4 a, f32x4 b) { u32x4 w; w.x = cvt_pk_bf16(a[0], a[1]); w.y = cvt_pk_bf16(a[2], a[3]); w.z = cvt_pk_bf16(b[0], b[1]); w.w = cvt_pk_bf16(b[2], b[3]); return w; }
__device__ __forceinline__ void rope8(f32x4& a, f32x4& b, const f32x4 c, const f32x4 s) {
    float t1, t2;
    t1 = a[0]; t2 = a[1]; a[0] = t1 * c[0] - t2 * s[0]; a[1] = t2 * c[0] + t1 * s[0];
    t1 = a[2]; t2 = a[3]; a[2] = t1 * c[1] - t2 * s[1]; a[3] = t2 * c[1] + t1 * s[1];
    t1 = b[0]; t2 = b[1]; b[0] = t1 * c[2] - t2 * s[2]; b[1] = t2 * c[2] + t1 * s[2];
    t1 = b[2]; t2 = b[3]; b[2] = t1 * c[3] - t2 * s[3]; b[3] = t2 * c[3] + t1 * s[3];
}
constexpr float NORM_EPS = 1e-6f;

struct EpiIn {
    static constexpr bool PERM = true, AFTER_DRAIN = false;
    bf16_t *Qr, *Kr, *Vr, *Gr, *CQ, *CKV, *Kbuf; const float *cosr, *sinr, *cosm, *sinm; float *ssq_q, *ssq_kv;
    __device__ __forceinline__ void operator()(const f32x4 (&acc)[2][2][4][2], const Unit& u, int wr, int wc, int fr, int fq) const {
        const int pn = u.pn, row0 = u.pm * BM + wr * 64 + fr, cl = wc * 32 + 8 * fq;
        if (pn < 8) {
            bf16_t* O = pn < 4 ? Qr : Kr; const float sc = pn < 4 ? 1.f : 0.08838834764831845f; const int colt = (pn & 3) * 256 + cl;
#pragma unroll
            for (int ai = 0; ai < 2; ++ai)
#pragma unroll
                for (int m = 0; m < 4; ++m) { const int row = row0 + ai * HALF + m * 16;
                    const f32x4 c4 = *(const f32x4*)(cosr + (size_t)row * 64 + (cl >> 1)), s4 = *(const f32x4*)(sinr + (size_t)row * 64 + (cl >> 1));
#pragma unroll
                    for (int bj = 0; bj < 2; ++bj) { f32x4 a = acc[ai][bj][m][0], b = acc[ai][bj][m][1]; rope8(a, b, c4, s4); a = a * sc; b = b * sc;
                        *(u32x4*)(O + (size_t)row * 1024 + colt + bj * HALF) = pack8(a, b); } }
        } else if (pn < 16) {
            const bool isg = pn >= 12; bf16_t* O = isg ? Gr : Vr; const int colt = (pn & 3) * 256 + cl;
#pragma unroll
            for (int ai = 0; ai < 2; ++ai)
#pragma unroll
                for (int m = 0; m < 4; ++m) { const int row = row0 + ai * HALF + m * 16;
#pragma unroll
                    for (int bj = 0; bj < 2; ++bj) { f32x4 a = acc[ai][bj][m][0], b = acc[ai][bj][m][1];
                        if (isg) {
#pragma unroll
                            for (int i = 0; i < 4; ++i) { a[i] = silu_f(a[i]); b[i] = silu_f(b[i]); } }
                        *(u32x4*)(O + (size_t)row * 1024 + colt + bj * HALF) = pack8(a, b); } }
        } else if (pn < 20) {
            bf16_t* O = pn < 18 ? CQ : CKV; float* sq = pn < 18 ? ssq_q : ssq_kv; const int colt = (pn & 1) * 256 + cl;
#pragma unroll
            for (int ai = 0; ai < 2; ++ai)
#pragma unroll
                for (int m = 0; m < 4; ++m) { const int row = row0 + ai * HALF + m * 16; float s = 0.f;
#pragma unroll
                    for (int bj = 0; bj < 2; ++bj) { const f32x4 a = acc[ai][bj][m][0], b = acc[ai][bj][m][1];
                        s += (a[0] * a[0] + a[1] * a[1]) + (a[2] * a[2] + a[3] * a[3]) + (b[0] * b[0] + b[1] * b[1]) + (b[2] * b[2] + b[3] * b[3]);
                        *(u32x4*)(O + (size_t)row * 512 + colt + bj * HALF) = pack8(a, b); }
                    s += __shfl_xor(s, 16); s += __shfl_xor(s, 32);
                    if (fq == 0) atomicAdd(sq + row, s); }
        } else {
            if (wc < 2) {
#pragma unroll
                for (int ai = 0; ai < 2; ++ai)
#pragma unroll
                    for (int m = 0; m < 4; ++m) { const int row = row0 + ai * HALF + m * 16;
                        const f32x4 c4 = *(const f32x4*)(cosm + (size_t)row * 32 + (cl >> 1)), s4 = *(const f32x4*)(sinm + (size_t)row * 32 + (cl >> 1));
                        f32x4 a = acc[ai][0][m][0], b = acc[ai][0][m][1]; rope8(a, b, c4, s4); const u32x4 w = pack8(a, b);
#pragma unroll
                        for (int h = 0; h < 8; ++h) *(u32x4*)(Kbuf + (size_t)row * 1536 + h * 192 + 128 + cl) = w; }
            }
        }
    }
};
struct EpiUpQ {
    static constexpr bool PERM = true, AFTER_DRAIN = false;
    const float* ssq; bf16_t* Qm; const float *cosm, *sinm;
    __device__ __forceinline__ void operator()(const f32x4 (&acc)[2][2][4][2], const Unit& u, int wr, int wc, int fr, int fq) const {
        const int row0 = u.pm * BM + wr * 64 + fr, cl = wc * 32 + 8 * fq;
#pragma unroll
        for (int ai = 0; ai < 2; ++ai)
#pragma unroll
            for (int m = 0; m < 4; ++m) { const int row = row0 + ai * HALF + m * 16; const float rstd = rsqrtf(ssq[row] * (1.f / 512.f) + NORM_EPS);
#pragma unroll
                for (int bj = 0; bj < 2; ++bj) { const int c = u.pn * 256 + bj * HALF + cl, d = c % 192; f32x4 a = acc[ai][bj][m][0] * rstd, b = acc[ai][bj][m][1] * rstd;
                    if (d >= 128) { const int fi = (d - 128) >> 1; const f32x4 c4 = *(const f32x4*)(cosm + (size_t)row * 32 + fi), s4 = *(const f32x4*)(sinm + (size_t)row * 32 + fi); rope8(a, b, c4, s4); }
                    *(u32x4*)(Qm + (size_t)row * 1536 + c) = pack8(a, b); } }
    }
};
struct EpiUpKV {
    static constexpr bool PERM = true, AFTER_DRAIN = false;
    const float* ssq; bf16_t *Kbuf, *Vm;
    __device__ __forceinline__ void operator()(const f32x4 (&acc)[2][2][4][2], const Unit& u, int wr, int wc, int fr, int fq) const {
        const int row0 = u.pm * BM + wr * 64 + fr, cl = wc * 32 + 8 * fq;
#pragma unroll
        for (int ai = 0; ai < 2; ++ai)
#pragma unroll
            for (int m = 0; m < 4; ++m) { const int row = row0 + ai * HALF + m * 16; const float rstd = rsqrtf(ssq[row] * (1.f / 512.f) + NORM_EPS);
                *(u32x4*)(Kbuf + (size_t)row * 1536 + u.pn * 192 + cl) = pack8(acc[ai][0][m][0] * rstd, acc[ai][0][m][1] * rstd);
                *(u32x4*)(Vm + (size_t)row * 1024 + u.pn * 128 + cl) = pack8(acc[ai][1][m][0] * rstd, acc[ai][1][m][1] * rstd); }
    }
};
struct EpiGateRes {
    static constexpr bool PERM = true, AFTER_DRAIN = false;
    const float* x; const float* gate; float* out;
    __device__ __forceinline__ void operator()(const f32x4 (&acc)[2][2][4][2], const Unit& u, int wr, int wc, int fr, int fq) const {
        const int row0 = u.pm * BM + wr * 64 + fr, cl = wc * 32 + 8 * fq, b = u.pm >> 4;
#pragma unroll
        for (int bj = 0; bj < 2; ++bj) { const int c = u.pn * 256 + bj * HALF + cl;
            const f32x4 g0 = *(const f32x4*)(gate + (size_t)b * 12288 + c), g1 = *(const f32x4*)(gate + (size_t)b * 12288 + c + 4);
#pragma unroll
            for (int ai = 0; ai < 2; ++ai)
#pragma unroll
                for (int m = 0; m < 4; ++m) { const size_t off = (size_t)(row0 + ai * HALF + m * 16) * 2048 + c;
                    const f32x4 x0 = *(const f32x4*)(x + off), x1 = *(const f32x4*)(x + off + 4);
                    *(f32x4*)(out + off) = x0 + g0 * acc[ai][bj][m][0]; *(f32x4*)(out + off + 4) = x1 + g1 * acc[ai][bj][m][1]; } }
    }
};
struct EpiGU {
    static constexpr bool PERM = true, AFTER_DRAIN = false;
    bf16_t* Aff;
    __device__ __forceinline__ void operator()(const f32x4 (&acc)[2][2][4][2], const Unit& u, int wr, int wc, int fr, int fq) const {
        const int row0 = u.pm * BM + wr * 64 + fr, cl = wc * 32 + 8 * fq;
#pragma unroll
        for (int ai = 0; ai < 2; ++ai)
#pragma unroll
            for (int m = 0; m < 4; ++m) { const int row = row0 + ai * HALF + m * 16; f32x4 a, b;
#pragma unroll
                for (int i = 0; i < 4; ++i) { a[i] = silu_f(acc[ai][0][m][0][i]) * acc[ai][1][m][0][i]; b[i] = silu_f(acc[ai][0][m][1][i]) * acc[ai][1][m][1][i]; }
                *(u32x4*)(Aff + (size_t)row * 5632 + u.pn * 128 + cl) = pack8(a, b); }
    }
};

template <class Epi, class Sched, bool ALIGN_EPI = false, bool SP2 = false>
__device__ __forceinline__ void gemm_phase(PG8_LAS unsigned char* lds, const Gemm g, const Sched& S, const Epi& E) {
    const int tid = threadIdx.x, wid = __builtin_amdgcn_readfirstlane(tid >> 6), lane = tid & 63, wr = wid >> 2, wc = wid & 3, fr = lane & 15, fq = lane >> 4;
    const int K = g.K, nt = K / BK;
    unsigned voffA[2], voffB[2];
#pragma unroll
    for (int i = 0; i < 2; ++i) { int R, C; stage_rc(tid * 16 + i * 8192, R, C); const int Rb = Epi::PERM ? ((R & ~31) + perm32(R & 31)) : R;
        voffA[i] = (unsigned)(R * K + C) * 2u; voffB[i] = (unsigned)(Rb * K + C) * 2u; }
    const size_t kstep = (size_t)(BK * 2);
    const size_t hstep = (size_t)HALF * K * 2;
    const size_t tstep = 2 * hstep;
    const unsigned ldsw = (unsigned)wid * 1024u;
    const int aoff = lds_byte(wr * 64 + fr, fq * 8), boff = lds_byte(wc * 32 + fr, fq * 8);
#define PG8_SA(b, h) (((b) * 2 + (h)) * HTB)
#define PG8_SB(b, h) ((4 + (b) * 2 + (h)) * HTB)
#define PG8_STAGE(bufoff, gbase, voff) do { _Pragma("unroll") for (int _i = 0; _i < 2; ++_i) \
        __builtin_amdgcn_global_load_lds((const unsigned*)((const char*)(gbase) + (voff)[_i]), (PG8_LAS unsigned*)(lds + (bufoff) + ldsw + _i * 8192), 16, 0, 0); } while (0)
#define PG8_LDA(dst, b, h) do { _Pragma("unroll") for (int m = 0; m < 4; ++m) _Pragma("unroll") for (int k = 0; k < 2; ++k) dst[m][k] = *(const PG8_LAS bf16x8*)(lds + PG8_SA(b, h) + aoff + m * 2048 + k * 1024); } while (0)
#define PG8_LDB(dst, b, h) do { _Pragma("unroll") for (int n = 0; n < 2; ++n) _Pragma("unroll") for (int k = 0; k < 2; ++k) dst[n][k] = *(const PG8_LAS bf16x8*)(lds + PG8_SB(b, h) + boff + n * 2048 + k * 1024); } while (0)
#define PG8_MMA(ai, bj, At, Bt) do { __builtin_amdgcn_s_setprio(1); _Pragma("unroll") for (int m = 0; m < 4; ++m) _Pragma("unroll") for (int n = 0; n < 2; ++n) _Pragma("unroll") for (int k = 0; k < 2; ++k) \
        acc[ai][bj][m][n] = __builtin_amdgcn_mfma_f32_16x16x32_bf16(Bt[n][k], At[m][k], acc[ai][bj][m][n], 0, 0, 0); __builtin_amdgcn_s_setprio(0); } while (0)
#define PG8_WAIT_V(n) asm volatile("s_waitcnt vmcnt(" #n ")" ::: "memory")
#define PG8_WAIT_L(n) asm volatile("s_waitcnt lgkmcnt(" #n ")" ::: "memory")
#define PG8_BAR __builtin_amdgcn_s_barrier()
#define PG8_SCHED __builtin_amdgcn_sched_barrier(0)
    Unit cur, nxt; int ui = 0;
    if (!S.next(0, cur)) return;
    f32x4 acc[2][2][4][2];
#pragma unroll
    for (int a = 0; a < 2; ++a)
#pragma unroll
        for (int b = 0; b < 2; ++b)
#pragma unroll
            for (int m = 0; m < 4; ++m)
#pragma unroll
                for (int n = 0; n < 2; ++n) acc[a][b][m][n] = (f32x4){0.f, 0.f, 0.f, 0.f};
    bf16x8 At[4][2], B0[2][2], B1[2][2];
    const char* cA = (const char*)g.A + (size_t)cur.pm * tstep; const char* cB = (const char*)g.Bt + (size_t)cur.pn * tstep;
    S.a_ready(cur);
    if constexpr (SP2) {
        PG8_STAGE(PG8_SB(0, 0), cB, voffB); PG8_STAGE(PG8_SB(0, 1), cB + hstep, voffB); PG8_STAGE(PG8_SA(0, 0), cA, voffA); PG8_STAGE(PG8_SA(0, 1), cA + hstep, voffA);
        if (wr == 1) PG8_BAR;
        PG8_WAIT_V(2); PG8_BAR;
        PG8_STAGE(PG8_SB(1, 0), cB + kstep, voffB); PG8_STAGE(PG8_SA(1, 0), cA + kstep, voffA); PG8_STAGE(PG8_SB(1, 1), cB + hstep + kstep, voffB);
        PG8_WAIT_V(6); PG8_BAR;
    } else {
        PG8_STAGE(PG8_SB(0, 0), cB, voffB); PG8_STAGE(PG8_SA(0, 0), cA, voffA); PG8_STAGE(PG8_SB(0, 1), cB + hstep, voffB); PG8_STAGE(PG8_SA(0, 1), cA + hstep, voffA);
        if (wr == 1) PG8_BAR;
        PG8_WAIT_V(4); PG8_BAR;
        PG8_STAGE(PG8_SB(1, 0), cB + kstep, voffB); PG8_STAGE(PG8_SA(1, 0), cA + kstep, voffA); PG8_STAGE(PG8_SB(1, 1), cB + hstep + kstep, voffB);
        PG8_WAIT_V(6); PG8_BAR;
    }
    for (;;) {
        const bool has_next = S.next(ui + 1, nxt);
        const char* nA = has_next ? (const char*)g.A + (size_t)nxt.pm * tstep : cA; const char* nB = has_next ? (const char*)g.Bt + (size_t)nxt.pn * tstep : cB;
        for (int t = 0; t < nt; t += 2) {
            const bool last = (t == nt - 2);
            const char* a1 = cA + (size_t)(t + 1) * kstep;
            const char* a2 = last ? nA : cA + (size_t)(t + 2) * kstep; const char* b2 = last ? nB : cB + (size_t)(t + 2) * kstep;
            const char* a3 = a2 + kstep; const char* b3 = b2 + kstep;
            if (last && has_next) S.a_ready(nxt);
            if constexpr (SP2) {
            PG8_LDB(B0, 0, 0); PG8_LDB(B1, 0, 1); PG8_SCHED; PG8_LDA(At, 0, 0); PG8_STAGE(PG8_SA(1, 1), a1 + hstep, voffA);
            PG8_WAIT_V(8); PG8_WAIT_L(0); PG8_BAR; PG8_MMA(0, 0, At, B0); PG8_MMA(0, 1, At, B1); PG8_BAR; PG8_SCHED;
            PG8_LDA(At, 0, 1); PG8_STAGE(PG8_SB(0, 0), b2, voffB); PG8_STAGE(PG8_SB(0, 1), b2 + hstep, voffB); PG8_STAGE(PG8_SA(0, 0), a2, voffA);
            PG8_WAIT_V(8); PG8_WAIT_L(0); PG8_BAR; PG8_MMA(1, 0, At, B0); PG8_MMA(1, 1, At, B1); PG8_BAR; PG8_SCHED;
            PG8_LDB(B0, 1, 0); PG8_LDB(B1, 1, 1); PG8_SCHED; PG8_LDA(At, 1, 0); PG8_STAGE(PG8_SA(0, 1), a2 + hstep, voffA);
            PG8_WAIT_V(8); PG8_WAIT_L(0); PG8_BAR; PG8_MMA(0, 0, At, B0); PG8_MMA(0, 1, At, B1); PG8_BAR; PG8_SCHED;
            PG8_LDA(At, 1, 1); PG8_STAGE(PG8_SB(1, 0), b3, voffB); PG8_STAGE(PG8_SB(1, 1), b3 + hstep, voffB); PG8_STAGE(PG8_SA(1, 0), a3, voffA);
            PG8_WAIT_V(8); PG8_WAIT_L(0); PG8_BAR; PG8_MMA(1, 0, At, B0); PG8_MMA(1, 1, At, B1); PG8_BAR; PG8_SCHED;
            } else {
            PG8_LDB(B0, 0, 0); PG8_SCHED; PG8_LDA(At, 0, 0); PG8_STAGE(PG8_SA(1, 1), a1 + hstep, voffA);
            PG8_WAIT_L(8); PG8_BAR; PG8_WAIT_L(0); PG8_MMA(0, 0, At, B0); PG8_BAR; PG8_SCHED;
            PG8_LDB(B1, 0, 1); PG8_STAGE(PG8_SB(0, 0), b2, voffB);
            PG8_BAR; PG8_WAIT_L(0); PG8_MMA(0, 1, At, B1); PG8_BAR;
            PG8_LDA(At, 0, 1); PG8_STAGE(PG8_SA(0, 0), a2, voffA);
            PG8_BAR; PG8_WAIT_L(0); PG8_MMA(1, 0, At, B0); PG8_BAR; PG8_SCHED;
            PG8_STAGE(PG8_SB(0, 1), b2 + hstep, voffB);
            PG8_WAIT_V(6); PG8_BAR; PG8_MMA(1, 1, At, B1); PG8_BAR;
            PG8_LDB(B0, 1, 0); PG8_SCHED; PG8_LDA(At, 1, 0); PG8_STAGE(PG8_SA(0, 1), a2 + hstep, voffA);
            PG8_WAIT_L(8); PG8_BAR; PG8_WAIT_L(0); PG8_MMA(0, 0, At, B0); PG8_BAR; PG8_SCHED;
            PG8_LDB(B1, 1, 1); PG8_STAGE(PG8_SB(1, 0), b3, voffB);
            PG8_BAR; PG8_WAIT_L(0); PG8_MMA(0, 1, At, B1); PG8_BAR;
            PG8_LDA(At, 1, 1); PG8_STAGE(PG8_SA(1, 0), a3, voffA);
            PG8_BAR; PG8_WAIT_L(0); PG8_MMA(1, 0, At, B0); PG8_BAR; PG8_SCHED;
            PG8_STAGE(PG8_SB(1, 1), b3 + hstep, voffB);
            PG8_WAIT_V(6); PG8_BAR; PG8_MMA(1, 1, At, B1); PG8_BAR;
            }
        }
        if constexpr (ALIGN_EPI) { if (wr == 0) PG8_BAR; }
        if constexpr (!Epi::AFTER_DRAIN) { E(acc, cur, wr, wc, fr, fq); S.done(cur); }
        if (!has_next) break;
#pragma unroll
        for (int a = 0; a < 2; ++a)
#pragma unroll
            for (int b = 0; b < 2; ++b)
#pragma unroll
                for (int m = 0; m < 4; ++m)
#pragma unroll
                    for (int n = 0; n < 2; ++n) acc[a][b][m][n] = (f32x4){0.f, 0.f, 0.f, 0.f};
        cur = nxt; cA = nA; cB = nB; ++ui;
        if constexpr (ALIGN_EPI) { if (wr == 1) PG8_BAR; }
    }
    PG8_WAIT_V(0);
    if constexpr (!ALIGN_EPI) { if (wr == 0) PG8_BAR; }
    PG8_BAR;
    if constexpr (Epi::AFTER_DRAIN) { E.fused(acc, cur, wr, wc, fr, fq, lds, wid, lane); S.done(cur); }
#undef PG8_SA
#undef PG8_SB
#undef PG8_STAGE
#undef PG8_LDA
#undef PG8_LDB
#undef PG8_MMA
#undef PG8_WAIT_V
#undef PG8_WAIT_L
#undef PG8_BAR
#undef PG8_SCHED
}
}

namespace att {
typedef unsigned short bf16_t;
using bf16x8 = __attribute__((ext_vector_type(8))) short;
using s16x4  = __attribute__((ext_vector_type(4))) short;
using f32x16 = __attribute__((ext_vector_type(16))) float;
using f32x4  = __attribute__((ext_vector_type(4))) float;
using u32x4  = __attribute__((ext_vector_type(4))) unsigned;
using u32x2  = __attribute__((ext_vector_type(2))) unsigned;
constexpr int NW = 8, QBLK = 32, KVBLK = 64;
constexpr int LDQ = 1536, LDK = 1536, LDV = 1024, LDO = 1024;
constexpr float SCALE = 0.07216878364870323f;
constexpr float THR = 8.f;
constexpr int NQR = 8;
constexpr int SHM_V = KVBLK * 128 * 2, SHM_K = KVBLK * 192 * 2, SHM_ATTN = 2 * SHM_V + 2 * SHM_K + NW * 64 * 4;
#define AKSWZ(row, colB) ((row) * 384 + ((colB) ^ (((row) & 7) << 4)))
#define KSWZ128(row, colB) ((row) * 256 + ((colB) ^ (((row) & 7) << 4)))
#define SBAR() __builtin_amdgcn_sched_barrier(0)
#define GAS __attribute__((address_space(1)))
__device__ __forceinline__ const GAS char* uniform_ptr(const void* p) { const unsigned long long v = (unsigned long long)p; const unsigned lo = __builtin_amdgcn_readfirstlane((unsigned)v), hi = __builtin_amdgcn_readfirstlane((unsigned)(v >> 32)); return (const GAS char*)(((unsigned long long)hi << 32) | lo); }
__device__ __forceinline__ int crow(int r, int hi) { return (r & 3) + 8 * (r >> 2) + 4 * hi; }
__device__ __forceinline__ unsigned cvtpk(float lo, float hi) { unsigned r; asm volatile("v_cvt_pk_bf16_f32 %0, %1, %2" : "=v"(r) : "v"(lo), "v"(hi)); return pg8::coarse2(r); }
__device__ __forceinline__ float swap_sum(float v) { auto rr = __builtin_amdgcn_permlane32_swap(__float_as_uint(v), __float_as_uint(v), false, false); return __uint_as_float(rr[0]) + __uint_as_float(rr[1]); }

__device__ __forceinline__ void partialSM(f32x16& p0, f32x16& p1, float& m_reg, float& mn, float& alpha) {
  constexpr float C = SCALE * 1.4426950408889634f;
  float pmax = p0[0];
#pragma unroll
  for (int r = 1; r < 16; ++r) pmax = fmaxf(pmax, p0[r]);
#pragma unroll
  for (int r = 0; r < 16; ++r) pmax = fmaxf(pmax, p1[r]);
  { auto rr = __builtin_amdgcn_permlane32_swap(__float_as_uint(pmax), __float_as_uint(pmax), false, false);
    pmax = fmaxf(__uint_as_float(rr[0]), __uint_as_float(rr[1])); }
  if (__builtin_expect(__all(pmax - m_reg <= THR / SCALE), 1)) { mn = m_reg; alpha = 1.f; }
  else { mn = fmaxf(m_reg, pmax); alpha = __builtin_amdgcn_exp2f((m_reg - mn) * C); m_reg = mn; }
  float mnC = -mn * C;
#pragma unroll
  for (int r = 0; r < 16; ++r) p0[r] = fmaf(p0[r], C, mnC);
#pragma unroll
  for (int r = 0; r < 16; ++r) p1[r] = fmaf(p1[r], C, mnC);
#pragma unroll
  for (int r = 0; r < 16; ++r) p0[r] = __builtin_amdgcn_exp2f(p0[r]);
}
#define PK4(P, BASE, OUT) do { unsigned a0 = cvtpk(P[BASE + 0], P[BASE + 1]), a1 = cvtpk(P[BASE + 2], P[BASE + 3]);   \
    unsigned b0 = cvtpk(P[BASE + 4], P[BASE + 5]), b1 = cvtpk(P[BASE + 6], P[BASE + 7]);                              \
    auto r0 = __builtin_amdgcn_permlane32_swap(a0, b0, false, false); auto r1 = __builtin_amdgcn_permlane32_swap(a1, b1, false, false); \
    u32x4 w = {r0[0], r1[0], r0[1], r1[1]}; OUT = *reinterpret_cast<bf16x8*>(&w); } while (0)
__device__ __forceinline__ void finishSM(f32x16& p0, f32x16& p1, float alpha, float& l_reg, bf16x8& pa0, bf16x8& pa1, bf16x8& pa2, bf16x8& pa3) {
#pragma unroll
  for (int r = 0; r < 16; ++r) p1[r] = __builtin_amdgcn_exp2f(p1[r]);
  float ps = 0;
#pragma unroll
  for (int r = 0; r < 16; ++r) ps += p0[r];
#pragma unroll
  for (int r = 0; r < 16; ++r) ps += p1[r];
  ps = swap_sum(ps);
  l_reg = l_reg * alpha + ps;
  PK4(p0, 0, pa0); PK4(p0, 8, pa1); PK4(p1, 0, pa2); PK4(p1, 8, pa3);
}
__device__ __forceinline__ void qkt192(f32x16& p0, f32x16& p1, const char* Ks, const bf16x8 (&qr)[NQR], const char* Qs, int r32, int hi) {
  p0 = f32x16{}; p1 = f32x16{};
#pragma unroll
  for (int d0 = 0; d0 < 12; ++d0) { int cb = (d0 * 16 + hi * 8) * 2;
    bf16x8 b0 = *reinterpret_cast<const bf16x8*>(Ks + AKSWZ(r32, cb));
    bf16x8 b1 = *reinterpret_cast<const bf16x8*>(Ks + AKSWZ(32 + r32, cb));
    bf16x8 qv; if (d0 < NQR) qv = qr[d0 < NQR ? d0 : 0]; else qv = *reinterpret_cast<const bf16x8*>(Qs + (d0 - NQR) * 1024);
    p0 = __builtin_amdgcn_mfma_f32_32x32x16_bf16(b0, qv, p0, 0, 0, 0);
    p1 = __builtin_amdgcn_mfma_f32_32x32x16_bf16(b1, qv, p1, 0, 0, 0); }
}
__device__ __forceinline__ void qkt128(f32x16& p0, f32x16& p1, const char* Ks, const bf16x8 (&qr)[8], int r32, int hi) {
  p0 = f32x16{}; p1 = f32x16{};
#pragma unroll
  for (int d0 = 0; d0 < 8; ++d0) { int cb = (d0 * 16 + hi * 8) * 2;
    bf16x8 b0 = *reinterpret_cast<const bf16x8*>(Ks + KSWZ128(r32, cb));
    bf16x8 b1 = *reinterpret_cast<const bf16x8*>(Ks + KSWZ128(32 + r32, cb));
    p0 = __builtin_amdgcn_mfma_f32_32x32x16_bf16(b0, qr[d0], p0, 0, 0, 0);
    p1 = __builtin_amdgcn_mfma_f32_32x32x16_bf16(b1, qr[d0], p1, 0, 0, 0); }
}
__device__ __forceinline__ int v_st(int k, int c) { const int kk = (k & ~0xC) | ((k & 4) << 1) | ((k & 8) >> 1); return ((kk >> 3) * 4 + (c >> 5)) * 512 + ((kk & 7) * 32 + (c & 31)) * 2; }
__device__ __forceinline__ int v_rd_base(int lane) { return ((lane & 3) << 3) | (((lane >> 2) & 3) << 6) | (((lane >> 4) & 1) << 5) | (((lane >> 5) & 1) << 8); }
constexpr int v_rd_off(int d0, int ks, int half) { return d0 * 512 + ks * 4096 + half * 2048; }
template <int OFF> __device__ __forceinline__ s16x4 tr_read(int vb) {
  s16x4 r; asm volatile("ds_read_b64_tr_b16 %0, %1 offset:%2" : "=&v"(r) : "v"(vb), "i"(OFF) : "memory"); return r;
}
#define PKLH(L, H) (bf16x8){L[0], L[1], L[2], L[3], H[0], H[1], H[2], H[3]}
template <int D0> __device__ __forceinline__ void pv_one(f32x16& od, int vb, bf16x8 pa0, bf16x8 pa1, bf16x8 pa2, bf16x8 pa3) {
  const s16x4 l0 = tr_read<v_rd_off(D0, 0, 0)>(vb), h0 = tr_read<v_rd_off(D0, 0, 1)>(vb), l1 = tr_read<v_rd_off(D0, 1, 0)>(vb), h1 = tr_read<v_rd_off(D0, 1, 1)>(vb);
  const s16x4 l2 = tr_read<v_rd_off(D0, 2, 0)>(vb), h2 = tr_read<v_rd_off(D0, 2, 1)>(vb), l3 = tr_read<v_rd_off(D0, 3, 0)>(vb), h3 = tr_read<v_rd_off(D0, 3, 1)>(vb);
  asm volatile("s_waitcnt lgkmcnt(0)" ::: "memory"); SBAR();
  od = __builtin_amdgcn_mfma_f32_32x32x16_bf16(pa0, PKLH(l0, h0), od, 0, 0, 0);
  od = __builtin_amdgcn_mfma_f32_32x32x16_bf16(pa1, PKLH(l1, h1), od, 0, 0, 0);
  od = __builtin_amdgcn_mfma_f32_32x32x16_bf16(pa2, PKLH(l2, h2), od, 0, 0, 0);
  od = __builtin_amdgcn_mfma_f32_32x32x16_bf16(pa3, PKLH(l3, h3), od, 0, 0, 0);
}
__device__ __forceinline__ void pv_d0(f32x16* o, int vb, bf16x8 pa0, bf16x8 pa1, bf16x8 pa2, bf16x8 pa3) {
  pv_one<0>(o[0], vb, pa0, pa1, pa2, pa3); pv_one<1>(o[1], vb, pa0, pa1, pa2, pa3); pv_one<2>(o[2], vb, pa0, pa1, pa2, pa3); pv_one<3>(o[3], vb, pa0, pa1, pa2, pa3);
}
template <int D0> __device__ __forceinline__ void pvT_one(f32x16& od, int vb, bf16x8 pa0, bf16x8 pa1, bf16x8 pa2, bf16x8 pa3) {
  const s16x4 l0 = tr_read<v_rd_off(D0, 0, 0)>(vb), h0 = tr_read<v_rd_off(D0, 0, 1)>(vb), l1 = tr_read<v_rd_off(D0, 1, 0)>(vb), h1 = tr_read<v_rd_off(D0, 1, 1)>(vb);
  const s16x4 l2 = tr_read<v_rd_off(D0, 2, 0)>(vb), h2 = tr_read<v_rd_off(D0, 2, 1)>(vb), l3 = tr_read<v_rd_off(D0, 3, 0)>(vb), h3 = tr_read<v_rd_off(D0, 3, 1)>(vb);
  asm volatile("s_waitcnt lgkmcnt(0)" ::: "memory"); SBAR();
  od = __builtin_amdgcn_mfma_f32_32x32x16_bf16(PKLH(l0, h0), pa0, od, 0, 0, 0);
  od = __builtin_amdgcn_mfma_f32_32x32x16_bf16(PKLH(l1, h1), pa1, od, 0, 0, 0);
  od = __builtin_amdgcn_mfma_f32_32x32x16_bf16(PKLH(l2, h2), pa2, od, 0, 0, 0);
  od = __builtin_amdgcn_mfma_f32_32x32x16_bf16(PKLH(l3, h3), pa3, od, 0, 0, 0);
}

__device__ __forceinline__ void attn_unit(const bf16_t* __restrict__ Qb, const bf16_t* __restrict__ Kh, const bf16_t* __restrict__ Vh, bf16_t* __restrict__ Ob, int seq, char* lds, int ldsaddr) {
  const int tid = threadIdx.x, wid = tid >> 6, lane = tid & 63, r32 = lane & 31, hi = lane >> 5;
  char* V_lds = lds; char* K_lds = lds + 2 * SHM_V;
  float* ws = (float*)(lds + 2 * SHM_V + 2 * SHM_K) + wid * 64; float* li_l = ws; float* al_l = ws + 32;
  float m_reg = -1e30f, l_reg = 0; f32x16 o[4] = {}; bf16x8 qr[NQR];
  const bf16_t* Qw = Qb + (long)(wid * QBLK + r32) * LDQ + hi * 8;
  char* Qs = lds + SHM_ATTN + wid * ((12 - NQR) * 1024) + lane * 16;
#pragma unroll
  for (int d0 = 0; d0 < NQR; ++d0) qr[d0] = *reinterpret_cast<const bf16x8*>(Qw + d0 * 16);
#pragma unroll
  for (int d0 = NQR; d0 < 12; ++d0) *(bf16x8*)(Qs + (d0 - NQR) * 1024) = *reinterpret_cast<const bf16x8*>(Qw + d0 * 16);
  const int sr = tid >> 4, sc = (tid & 15) * 8, vst0 = v_st(sr, sc), vst1 = v_st(32 + sr, sc);
  unsigned kg0, kg1, kg2; int kl0, kl1, kl2;
  { int p = tid;        int kr = p / 24, kc = (p % 24) * 8; kg0 = (unsigned)(kr * LDK + kc) * 2u; kl0 = AKSWZ(kr, kc * 2);
    p = tid + 512;      kr = p / 24; kc = (p % 24) * 8;     kg1 = (unsigned)(kr * LDK + kc) * 2u; kl1 = AKSWZ(kr, kc * 2);
    p = tid + 1024;     kr = p / 24; kc = (p % 24) * 8;     kg2 = (unsigned)(kr * LDK + kc) * 2u; kl2 = AKSWZ(kr, kc * 2); }
  const unsigned vg0 = (unsigned)(sr * LDV + sc) * 2u, vg1 = (unsigned)((32 + sr) * LDV + sc) * 2u;
  const int vb0 = ldsaddr + v_rd_base(lane);
  bf16x8 vs0, vs1, ks0, ks1, ks2;
#define SLOAD(k0) do { const GAS char* vb_ = uniform_ptr((const char*)Vh + (size_t)(k0) * (LDV * 2)); const GAS char* kb_ = uniform_ptr((const char*)Kh + (size_t)(k0) * (LDK * 2)); \
    vs0 = *(const GAS bf16x8*)(vb_ + vg0); vs1 = *(const GAS bf16x8*)(vb_ + vg1); \
    ks0 = *(const GAS bf16x8*)(kb_ + kg0); ks1 = *(const GAS bf16x8*)(kb_ + kg1); ks2 = *(const GAS bf16x8*)(kb_ + kg2); } while (0)
#define SWRITE(b) do { *(bf16x8*)(V_lds + (b) * SHM_V + vst0) = vs0; *(bf16x8*)(V_lds + (b) * SHM_V + vst1) = vs1; \
    *(bf16x8*)(K_lds + (b) * SHM_K + kl0) = ks0; *(bf16x8*)(K_lds + (b) * SHM_K + kl1) = ks1; *(bf16x8*)(K_lds + (b) * SHM_K + kl2) = ks2; } while (0)
#define SWAIT() asm volatile("s_waitcnt vmcnt(0)" ::: "memory")
#define RESC(a) do { if (__any((a) < 1.f)) { if (hi == 0) al_l[r32] = (a); asm volatile("s_waitcnt lgkmcnt(0)" ::: "memory"); \
    _Pragma("unroll") for (int d = 0; d < 4; ++d) _Pragma("unroll") for (int r = 0; r < 16; ++r) o[d][r] *= al_l[crow(r, hi)]; } } while (0)
  f32x16 pA0, pA1, pB0, pB1; float mnA, mnB, alA, alB; bf16x8 pa0, pa1, pa2, pa3; const int NT = seq / KVBLK;
  __syncthreads();
  SLOAD(0); SWAIT(); SWRITE(0); __syncthreads();
  qkt192(pA0, pA1, K_lds, qr, Qs, r32, hi); partialSM(pA0, pA1, m_reg, mnA, alA);
  SLOAD(KVBLK);
  SWAIT(); SWRITE(1); __syncthreads();
  for (int j = 1; j + 1 < NT; j += 2) {
    SBAR(); qkt192(pB0, pB1, K_lds + SHM_K, qr, Qs, r32, hi);
    finishSM(pA0, pA1, alA, l_reg, pa0, pa1, pa2, pa3); SBAR();
    SLOAD((j + 1) * KVBLK); SBAR();
    pv_d0(o, vb0, pa0, pa1, pa2, pa3); partialSM(pB0, pB1, m_reg, mnB, alB);
    __syncthreads(); SWAIT(); SWRITE(0);
    RESC(alB); __syncthreads();
    SBAR(); qkt192(pA0, pA1, K_lds, qr, Qs, r32, hi);
    finishSM(pB0, pB1, alB, l_reg, pa0, pa1, pa2, pa3); SBAR();
    SLOAD((j + 2) * KVBLK); SBAR();
    pv_d0(o, vb0 + SHM_V, pa0, pa1, pa2, pa3); partialSM(pA0, pA1, m_reg, mnA, alA);
    __syncthreads(); SWAIT(); SWRITE(1);
    RESC(alA); __syncthreads();
  }
  SBAR(); qkt192(pB0, pB1, K_lds + SHM_K, qr, Qs, r32, hi);
  finishSM(pA0, pA1, alA, l_reg, pa0, pa1, pa2, pa3); SBAR();
  pv_d0(o, vb0, pa0, pa1, pa2, pa3); partialSM(pB0, pB1, m_reg, mnB, alB);
  __syncthreads(); RESC(alB);
  finishSM(pB0, pB1, alB, l_reg, pa0, pa1, pa2, pa3); SBAR();
  pv_d0(o, vb0 + SHM_V, pa0, pa1, pa2, pa3);
  if (hi == 0) li_l[r32] = l_reg; asm volatile("s_waitcnt lgkmcnt(0)" ::: "memory");
  float rli[16];
#pragma unroll
  for (int r = 0; r < 16; ++r) rli[r] = __builtin_amdgcn_rcpf(li_l[crow(r, hi)]);
  bf16_t* Ow = Ob + (long)(wid * QBLK) * LDO;
#pragma unroll
  for (int r = 0; r < 16; ++r) { int orow = crow(r, hi);
#pragma unroll
    for (int d0 = 0; d0 < 4; ++d0) Ow[(long)orow * LDO + d0 * 32 + r32] = (bf16_t)(cvtpk(o[d0][r] * rli[r], 0.f) & 0xffffu); }
#undef SLOAD
#undef SWRITE
#undef SWAIT
#undef RESC
}

__device__ __forceinline__ bf16x8 scale8(bf16x8 v, float s) {
  u32x4 w = *reinterpret_cast<u32x4*>(&v), o;
#pragma unroll
  for (int i = 0; i < 4; ++i) o[i] = cvtpk(__uint_as_float(w[i] << 16) * s, __uint_as_float(w[i] & 0xffff0000u) * s);
  return *reinterpret_cast<bf16x8*>(&o);
}
__device__ __forceinline__ s16x4 trr(int addr) { s16x4 r; asm volatile("ds_read_b64_tr_b16 %0, %1" : "=&v"(r) : "v"(addr) : "memory"); return r; }

__device__ __forceinline__ void chunk_kv_unit(const bf16_t* __restrict__ Kc, const bf16_t* __restrict__ Vc, bf16_t* __restrict__ CKf, bf16_t* __restrict__ CKb, float lgf, float lgb, char* lds, int ldsaddr) {
  const int tid = threadIdx.x, wid = tid >> 6, lane = tid & 63, r32 = lane & 31, hi = lane >> 5;
  const int dir = wid >> 2, db = wid & 3, d = 32 * db + r32;
  __syncthreads();
  { const int sr = tid >> 4, sc = (tid & 15) * 8;
#pragma unroll
    for (int i = 0; i < 4; ++i) { const int row = sr + 32 * i;
      *(bf16x8*)(lds + (row >> 6) * 16384 + v_st(row & 63, sc)) = *reinterpret_cast<const bf16x8*>(Vc + (long)row * 1024 + sc); } }
  bf16x8 kb[8];
  int hio = hi; asm volatile("" : "+v"(hio));
  const GAS char* kg = uniform_ptr(Kc); const unsigned kofs = (unsigned)((hio * 8) * 1024 + d) * 2u;
#pragma unroll
  for (int ks = 0; ks < 8; ++ks) { u32x4 w;
#pragma unroll
    for (int i = 0; i < 4; ++i) { const int s0 = ks * 16 + hio * 8 + 2 * i;
      const float k0 = __uint_as_float((unsigned)*(const GAS unsigned short*)(kg + kofs + (ks * 16 + 2 * i) * 2048) << 16), k1 = __uint_as_float((unsigned)*(const GAS unsigned short*)(kg + kofs + (ks * 16 + 2 * i + 1) * 2048) << 16);
      const float z0 = __builtin_amdgcn_exp2f(dir ? lgb * (float)s0 : lgf * (float)(127 - s0)), z1 = __builtin_amdgcn_exp2f(dir ? lgb * (float)(s0 + 1) : lgf * (float)(126 - s0));
      w[i] = cvtpk(k0 * z0, k1 * z1); }
    kb[ks] = *reinterpret_cast<bf16x8*>(&w); }
  __syncthreads();
  f32x16 acc[4] = {};
  const int vb = ldsaddr + v_rd_base(lane);
  pvT_one<0>(acc[0], vb, kb[0], kb[1], kb[2], kb[3]); pvT_one<1>(acc[1], vb, kb[0], kb[1], kb[2], kb[3]); pvT_one<2>(acc[2], vb, kb[0], kb[1], kb[2], kb[3]); pvT_one<3>(acc[3], vb, kb[0], kb[1], kb[2], kb[3]);
  pvT_one<0>(acc[0], vb + 16384, kb[4], kb[5], kb[6], kb[7]); pvT_one<1>(acc[1], vb + 16384, kb[4], kb[5], kb[6], kb[7]); pvT_one<2>(acc[2], vb + 16384, kb[4], kb[5], kb[6], kb[7]); pvT_one<3>(acc[3], vb + 16384, kb[4], kb[5], kb[6], kb[7]);
  bf16_t* CK = dir ? CKb : CKf;
#pragma unroll
  for (int eb = 0; eb < 4; ++eb)
#pragma unroll
    for (int r = 0; r < 16; ++r) CK[(32 * eb + crow(r, hi)) * 128 + d] = (bf16_t)(cvtpk(acc[eb][r], 0.f) & 0xffffu);
}

#ifndef PROBE_COMP
#define PROBE_COMP 0
#endif
__device__ __forceinline__ void ret_out_unit(const bf16_t* __restrict__ Qc, const bf16_t* __restrict__ Kc, const bf16_t* __restrict__ Vc, const bf16_t* __restrict__ Gc,
                                             const bf16_t* __restrict__ STf, const bf16_t* __restrict__ STb, const float* __restrict__ gnw, const float* __restrict__ gnb,
                                             bf16_t* __restrict__ Oc, float lgf, float lgb, char* lds, int ldsaddr, float* dump = nullptr) {
  const int tid = threadIdx.x, ht = tid & 255, wq = (tid >> 6) & 3, lane = tid & 63, r32 = lane & 31, hi = lane >> 5;
  __syncthreads();
  { const int sr = ht >> 4, sc = (ht & 15) * 8;
#pragma unroll
    for (int i = 0; i < 8; ++i) { const int row = sr + 16 * i, tile = row >> 6, key = row & 63;
      *(bf16x8*)(lds + tile * 16384 + KSWZ128(key, sc * 2)) = *reinterpret_cast<const bf16x8*>(Kc + (long)row * 1024 + sc);
      *(bf16x8*)(lds + 32768 + tile * 16384 + v_st(key, sc)) = *reinterpret_cast<const bf16x8*>(Vc + (long)row * 1024 + sc); } }
  const int c = 32 * wq + r32;
  bf16x8 qr[8];
#pragma unroll
  for (int d0 = 0; d0 < 8; ++d0) qr[d0] = *reinterpret_cast<const bf16x8*>(Qc + (long)c * 1024 + d0 * 16 + hi * 8);
  __syncthreads();
  f32x16 pA0, pA1, pB0, pB1;
  qkt128(pA0, pA1, lds, qr, r32, hi); qkt128(pB0, pB1, lds + 16384, qr, r32, hi);
  int cdec = c; asm volatile("" : "+v"(cdec));
#define DEC(P, JB) do { _Pragma("unroll") for (int r = 0; r < 16; ++r) { const int dl = cdec - ((JB) + crow(r, hi)); \
    P[r] *= __builtin_amdgcn_exp2f(dl >= 0 ? lgf * (float)dl : lgb * (float)(-dl)); } } while (0)
  DEC(pA0, 0); DEC(pA1, 32); DEC(pB0, 64); DEC(pB1, 96);
#undef DEC
  bf16x8 xa0, xa1, xa2, xa3, xb0, xb1, xb2, xb3;
  PK4(pA0, 0, xa0); PK4(pA0, 8, xa1); PK4(pA1, 0, xa2); PK4(pA1, 8, xa3);
  PK4(pB0, 0, xb0); PK4(pB0, 8, xb1); PK4(pB1, 0, xb2); PK4(pB1, 8, xb3);
  f32x16 o[4] = {};
  const int vb = ldsaddr + 32768 + v_rd_base(lane);
  if (PROBE_COMP == 0 || (PROBE_COMP & 1)) {
  pvT_one<0>(o[0], vb, xa0, xa1, xa2, xa3); pvT_one<1>(o[1], vb, xa0, xa1, xa2, xa3); pvT_one<2>(o[2], vb, xa0, xa1, xa2, xa3); pvT_one<3>(o[3], vb, xa0, xa1, xa2, xa3);
  pvT_one<0>(o[0], vb + 16384, xb0, xb1, xb2, xb3); pvT_one<1>(o[1], vb + 16384, xb0, xb1, xb2, xb3); pvT_one<2>(o[2], vb + 16384, xb0, xb1, xb2, xb3); pvT_one<3>(o[3], vb + 16384, xb0, xb1, xb2, xb3);
  }
#pragma unroll
  for (int dir = 0; dir < 2; ++dir) {
    if (PROBE_COMP != 0 && !((PROBE_COMP >> (1 + dir)) & 1)) continue;
    const float xi = __builtin_amdgcn_exp2f(dir == 0 ? lgf * (float)(c + 1) : lgb * (float)(128 - c));
    const bf16_t* ST = dir == 0 ? STf : STb;
    bf16x8 qs[8];
#pragma unroll
    for (int d0 = 0; d0 < 8; ++d0) qs[d0] = scale8(qr[d0], xi);
    const GAS char* stb = uniform_ptr(ST); const unsigned so = (unsigned)(r32 * 128 + hi * 8) * 2u;
#pragma unroll
    for (int eb = 0; eb < 4; ++eb) {
      bf16x8 A[8];
      SBAR();
#pragma unroll
      for (int d0 = 0; d0 < 8; ++d0) A[d0] = *(const GAS bf16x8*)(stb + so + (eb * 32 * 128 + d0 * 16) * 2);
#pragma unroll
      for (int d0 = 0; d0 < 8; ++d0) o[eb] = __builtin_amdgcn_mfma_f32_32x32x16_bf16(A[d0], qs[d0], o[eb], 0, 0, 0);
      SBAR();
    }
  }
  if (PROBE_COMP != 0) {
#pragma unroll
    for (int eb = 0; eb < 4; ++eb)
#pragma unroll
      for (int g = 0; g < 4; ++g) *(f32x4*)(dump + (long)c * 1024 + 32 * eb + 8 * g + 4 * hi) = (f32x4){o[eb][4 * g], o[eb][4 * g + 1], o[eb][4 * g + 2], o[eb][4 * g + 3]};
    return; }
  float s = 0.f;
#pragma unroll
  for (int eb = 0; eb < 4; ++eb)
#pragma unroll
    for (int r = 0; r < 16; ++r) s += o[eb][r];
  const float mu = swap_sum(s) * (1.f / 128.f);
  float q = 0.f;
#pragma unroll
  for (int eb = 0; eb < 4; ++eb)
#pragma unroll
    for (int r = 0; r < 16; ++r) { const float d = o[eb][r] - mu; q += d * d; }
  const float rstd = rsqrtf(swap_sum(q) * (1.f / 128.f) + 1e-6f);
#pragma unroll
  for (int eb = 0; eb < 4; ++eb)
#pragma unroll
    for (int g = 0; g < 4; ++g) { const int e0 = 32 * eb + 8 * g + 4 * hi;
      const f32x4 w4 = *(const f32x4*)(gnw + e0), b4 = *(const f32x4*)(gnb + e0);
      const u32x2 gg = *(const u32x2*)(Gc + (long)c * 1024 + e0);
      const float g0 = __uint_as_float(gg.x << 16), g1 = __uint_as_float(gg.x & 0xffff0000u), g2 = __uint_as_float(gg.y << 16), g3 = __uint_as_float(gg.y & 0xffff0000u);
      const float y0 = ((o[eb][4 * g] - mu) * rstd * w4[0] + b4[0]) * g0, y1 = ((o[eb][4 * g + 1] - mu) * rstd * w4[1] + b4[1]) * g1;
      const float y2 = ((o[eb][4 * g + 2] - mu) * rstd * w4[2] + b4[2]) * g2, y3 = ((o[eb][4 * g + 3] - mu) * rstd * w4[3] + b4[3]) * g3;
      u32x2 w; w.x = cvtpk(y0, y1); w.y = cvtpk(y2, y3);
      *(u32x2*)(Oc + (long)c * 2048 + e0) = w; }
}

__device__ __forceinline__ void ret_brute_unit(const bf16_t* __restrict__ Qh, const bf16_t* __restrict__ Kh, const bf16_t* __restrict__ Vh, const bf16_t* __restrict__ Gc,
                                               const float* __restrict__ gnw, const float* __restrict__ gnb, bf16_t* __restrict__ Oc, int t0, float lgf, float lgb, char* lds, const float* dump = nullptr) {
  const int tid = threadIdx.x, qi = tid >> 2, part = tid & 3, t = t0 + qi;
  float q[32], acc[32];
#pragma unroll
  for (int i = 0; i < 32; ++i) { q[i] = __uint_as_float((unsigned)Qh[(long)t * 1024 + part * 32 + i] << 16); acc[i] = 0.f; }
  for (int s0 = 0; s0 < 4096; s0 += 64) {
    { const int rel = s0 < t0 ? 1 : (s0 >= t0 + 128 ? 2 : 0); if (PROBE_COMP != 0 && ((PROBE_COMP >> rel) & 1)) continue; }
    __syncthreads();
    for (int c = tid; c < 64 * 16; c += 512) { const int r = c >> 4, c8 = (c & 15) * 8;
      *(bf16x8*)(lds + (r * 128 + c8) * 2) = *reinterpret_cast<const bf16x8*>(Kh + (long)(s0 + r) * 1024 + c8);
      *(bf16x8*)(lds + 16384 + (r * 128 + c8) * 2) = *reinterpret_cast<const bf16x8*>(Vh + (long)(s0 + r) * 1024 + c8); }
    __syncthreads();
    for (int j = 0; j < 64; ++j) { const int s = s0 + j; float d = 0.f;
      const unsigned short* kr = (const unsigned short*)(lds + (j * 128 + part * 32) * 2); const unsigned short* vr = (const unsigned short*)(lds + 16384 + (j * 128 + part * 32) * 2);
#pragma unroll
      for (int i = 0; i < 32; ++i) d += q[i] * __uint_as_float((unsigned)kr[i] << 16);
      d += __shfl_xor(d, 1); d += __shfl_xor(d, 2);
      const int dl = t - s; const float w = d * __builtin_amdgcn_exp2f(dl >= 0 ? lgf * (float)dl : lgb * (float)(-dl));
#pragma unroll
      for (int i = 0; i < 32; ++i) acc[i] += w * __uint_as_float((unsigned)vr[i] << 16); }
  }
  if (PROBE_COMP != 0) {
#pragma unroll
    for (int i = 0; i < 32; ++i) acc[i] += dump[(long)qi * 1024 + part * 32 + i]; }
  float sm = 0.f;
#pragma unroll
  for (int i = 0; i < 32; ++i) sm += acc[i];
  sm += __shfl_xor(sm, 1); sm += __shfl_xor(sm, 2); const float mu = sm * (1.f / 128.f);
  float qq = 0.f;
#pragma unroll
  for (int i = 0; i < 32; ++i) { const float dd = acc[i] - mu; qq += dd * dd; }
  qq += __shfl_xor(qq, 1); qq += __shfl_xor(qq, 2); const float rstd = rsqrtf(qq * (1.f / 128.f) + 1e-6f);
#pragma unroll
  for (int i = 0; i < 32; ++i) { const int e = part * 32 + i; const float g = __uint_as_float((unsigned)Gc[(long)qi * 1024 + e] << 16);
    Oc[(long)qi * 2048 + e] = (bf16_t)(cvtpk(((acc[i] - mu) * rstd * gnw[e] + gnb[e]) * g, 0.f) & 0xffffu); }
}
#undef SBAR
}


#ifndef PROBE_BRUTE_RET
#define PROBE_BRUTE_RET 0
#endif
#ifndef MK_SPLIT
#define MK_SPLIT 0
#endif
#define LAS __attribute__((address_space(3)))
#define GASX __attribute__((address_space(1)))
typedef unsigned short bf16_t;
typedef unsigned v4u __attribute__((ext_vector_type(4)));
typedef unsigned v2u __attribute__((ext_vector_type(2)));
typedef float f32x4 __attribute__((ext_vector_type(4)));
typedef short bf16x8 __attribute__((ext_vector_type(8)));

constexpr int BATCH = 8, SEQ = 4096, DM = 2048, T = BATCH * SEQ;
constexpr int INC = 5184, INCP = 5376, DFF = 5632, NMODC = 6 * DM;
constexpr int NPH = 11;
constexpr size_t MiB = 1u << 20;
constexpr size_t WS_CTL = 0, CTL_ZERO_BYTES = 2 * MiB;
constexpr size_t OFF_MOD = 0, OFF_SSQQ = 512 * 1024, OFF_SSQKV = 640 * 1024;
constexpr size_t WS_COSR = 2 * MiB, WS_SINR = 10 * MiB, WS_COSM = 18 * MiB, WS_SINM = 22 * MiB;
constexpr size_t WS_WIN = 26 * MiB, WS_WUQ = 47 * MiB, WS_WUKV = 49 * MiB, WS_WO = 51 * MiB, WS_WGU = 59 * MiB, WS_WDN = 103 * MiB;
constexpr size_t WS_H = 128 * MiB;
constexpr size_t WS_QR = 256 * MiB, WS_KR = 320 * MiB, WS_VR = 384 * MiB, WS_GR = 448 * MiB;
constexpr size_t WS_CQ = 512 * MiB, WS_CKV = 544 * MiB;
constexpr size_t WS_QM = 576 * MiB, WS_KB = 672 * MiB, WS_VM = 768 * MiB, WS_OAT = 832 * MiB, WS_END = 896 * MiB;
constexpr size_t WS_CAT = 576 * MiB;
constexpr size_t WS_AFF = 256 * MiB;
static_assert(WS_AFF + (size_t)T * DFF * 2 <= WS_END && WS_CAT + (size_t)T * 2048 * 2 <= WS_VM, "d_ws map");
constexpr int LDS_BYTES = 150528;

#define LDS_WAIT() asm volatile("s_waitcnt lgkmcnt(0)" ::: "memory")
__device__ __forceinline__ unsigned f2bf(float f) { unsigned u = __builtin_bit_cast(unsigned, f); return (u + 0x7fffu + ((u >> 16) & 1u)) >> 16; }
__device__ __forceinline__ unsigned pk2(float lo, float hi) { return f2bf(lo) | (f2bf(hi) << 16); }
__device__ __forceinline__ unsigned pk2a(float lo, float hi) { return pg8::coarse2(pk2(lo, hi)); }
__device__ __forceinline__ float wave_sum(float v) {
#pragma unroll
    for (int o = 1; o < 64; o <<= 1) v += __shfl_xor(v, o);
    return v;
}
__device__ __forceinline__ int dest_row(int mapid, int n) {
    switch (mapid) {
    case 1: if (n < 2048) { const int j = n & 127; return (n & ~127) + (j < 64 ? 2 * j : 2 * (j - 64) + 1); }
            if (n < 5120) return n;
            { const int j = n - 5120; return 5120 + (j < 32 ? 2 * j : 2 * (j - 32) + 1); }
    case 2: { const int d = n % 192; if (d < 128) return n; const int j = d - 128; return n - d + 128 + (j < 32 ? 2 * j : 2 * (j - 32) + 1); }
    case 3: return (n >> 7) * 256 + (n & 127);
    case 4: return (n >> 7) * 256 + 128 + (n & 127);
    default: return n;
    }
}
__device__ __forceinline__ void transpose_item(const float* __restrict__ W, int K, int N, bf16_t* __restrict__ WT, const float* __restrict__ kscale, int mapid, LAS float* scr, int item, int lane) {
    const int nblk = N / 32, kb = item / nblk, nb = item % nblk, k0 = 64 * kb, n0 = 32 * nb;
#pragma unroll 8
    for (int i = 0; i < 32; ++i) { const int kk = 2 * i + (lane >> 5); float v = W[(size_t)(k0 + kk) * N + n0 + (lane & 31)]; if (kscale) v *= kscale[k0 + kk]; scr[kk * 33 + (lane & 31)] = v; }
    LDS_WAIT(); asm volatile("" ::: "memory");
    const int c = lane & 7;
#pragma unroll
    for (int j = 0; j < 4; ++j) { const int n = (lane >> 3) + 8 * j; const LAS float* s = scr + (8 * c) * 33 + n;
        v4u o; o.x = pk2(s[0 * 33], s[1 * 33]); o.y = pk2(s[2 * 33], s[3 * 33]); o.z = pk2(s[4 * 33], s[5 * 33]); o.w = pk2(s[6 * 33], s[7 * 33]);
        *(v4u*)(WT + (size_t)dest_row(mapid, n0 + n) * K + k0 + 8 * c) = o; }
    LDS_WAIT(); asm volatile("" ::: "memory");
}
__device__ __forceinline__ void norm_row(const float* xrow, const float* __restrict__ w, const float* __restrict__ shift, const float* __restrict__ scale, bf16_t* ob, float* of, int lane) {
    const f32x4* xr = (const f32x4*)xrow + lane;
    f32x4 v[8]; float s = 0.f;
#pragma unroll
    for (int j = 0; j < 8; ++j) { v[j] = xr[64 * j]; s += (v[j].x * v[j].x + v[j].y * v[j].y) + (v[j].z * v[j].z + v[j].w * v[j].w); }
    const float rstd = rsqrtf(wave_sum(s) * (1.f / 2048.f) + 1e-6f);
#pragma unroll
    for (int j = 0; j < 8; ++j) { const int col = 4 * lane + 256 * j; f32x4 y = v[j] * rstd * *(const f32x4*)(w + col);
        if (shift) y = y * (*(const f32x4*)(scale + col) + 1.f) + *(const f32x4*)(shift + col);
        if (ob) { v2u o; o.x = pk2a(y.x, y.y); o.y = pk2a(y.z, y.w); *(v2u*)(ob + col) = o; } else *(f32x4*)(of + col) = y; }
}

struct Args { const float* in[21]; float* out; unsigned char* ws; float inv_r[64]; float inv_m[32]; int ph_lo, ph_hi; };
static_assert(sizeof(Args) == 21 * 8 + 16 + 96 * 4 + 8, "Args has no padding");

__global__ void __launch_bounds__(512, 2) mk_fwd(Args a) {
    extern __shared__ __attribute__((aligned(16))) unsigned char smem[];
    cg::grid_group grid = cg::this_grid();
    const int tid = threadIdx.x, lane = tid & 63, wave = __builtin_amdgcn_readfirstlane(tid >> 6);
    const int G = gridDim.x, bx = blockIdx.x, vcu = (G % 8 == 0) ? (bx % 8) * (G / 8) + bx / 8 : bx;
    const int gw = vcu * 8 + wave, NGW = G * 8;
    LAS unsigned char* lds3 = (LAS unsigned char*)smem; char* ldsg = (char*)smem; const int ldsaddr = (int)(unsigned)(uintptr_t)lds3;
    float* out = a.out;
#define WSB() size_t wz_ = 0; asm volatile("" : "+s"(wz_)); unsigned char* ws = a.ws + wz_
#define INP(name, k) const float* name = a.in[k] + wz_
#define WSF(name, off) float* name = (float*)(ws + (off))
#define WSH(name, off) bf16_t* name = (bf16_t*)(ws + (off))
    const int lo = a.ph_lo, hi = a.ph_hi;
#ifndef PH_MASK
#define PH_MASK 0x7ff
#endif
#define IN(k) (((PH_MASK >> (k)) & 1) && lo <= (k) && (k) < hi)
#define SEAM(k) do { if (IN(k) && IN((k) + 1)) { asm volatile("s_waitcnt vmcnt(0) lgkmcnt(0)" ::: "memory"); grid.sync(); \
    __builtin_amdgcn_fence(__ATOMIC_ACQUIRE, "agent"); asm volatile("s_waitcnt vmcnt(0)" ::: "memory"); } } while (0)

    if (IN(0)) {
        WSB(); WSF(mod, WS_CTL + OFF_MOD); WSF(cosr, WS_COSR); WSF(sinr, WS_SINR); WSF(cosm, WS_COSM); WSF(sinm, WS_SINM);
        WSH(Win, WS_WIN); WSH(Wuq, WS_WUQ); WSH(Wukv, WS_WUKV); WSH(Wo, WS_WO); WSH(Wgu, WS_WGU); WSH(Wdn, WS_WDN);
        INP(cin, 1); INP(ada_w, 3); INP(ada_b, 4); INP(w_in, 6); INP(mla_q_norm_w, 10); INP(w_uq, 11); INP(mla_kv_norm_w, 12); INP(w_ukv, 13); INP(w_o, 15); INP(w_gate, 17); INP(w_up, 18); INP(w_down, 19);
        const int* positions = (const int*)a.in[2] + wz_;
        {
            LAS float* cs = (LAS float*)lds3;
            for (int i = tid; i < 8 * 2048; i += 512) { const int b = i >> 11, k = i & 2047; const float v = cin[i]; cs[k * 8 + b] = v / (1.f + __expf(-v)); }
            __syncthreads();
            for (int task = gw; task < 192 * 16; task += NGW) { const int cb = task % 192, ks = task / 192, col = cb * 64 + lane;
                float acc[8]; const float bias = ks == 0 ? ada_b[col] : 0.f;
#pragma unroll
                for (int b = 0; b < 8; ++b) acc[b] = bias;
                const float* wp = ada_w + (size_t)(ks * 128) * NMODC + col;
                for (int k8 = 0; k8 < 128; k8 += 8) { float wv[8];
#pragma unroll
                    for (int i = 0; i < 8; ++i) wv[i] = wp[(size_t)(k8 + i) * NMODC];
#pragma unroll
                    for (int i = 0; i < 8; ++i) { const LAS f32x4* c4 = (const LAS f32x4*)(cs + (ks * 128 + k8 + i) * 8); const f32x4 c0 = c4[0], c1 = c4[1];
                        acc[0] += c0.x * wv[i]; acc[1] += c0.y * wv[i]; acc[2] += c0.z * wv[i]; acc[3] += c0.w * wv[i]; acc[4] += c1.x * wv[i]; acc[5] += c1.y * wv[i]; acc[6] += c1.z * wv[i]; acc[7] += c1.w * wv[i]; } }
#pragma unroll
                for (int b = 0; b < 8; ++b) atomicAdd(mod + (size_t)b * NMODC + col, acc[b]); }
            __syncthreads();
        }
        {
            LAS float* scr = (LAS float*)(lds3 + wave * 16384);
            constexpr int I_IN = 32 * (INC / 32), I_UQ = 8 * 48, I_UKV = 8 * 64, I_O = 32 * 64, I_G = 32 * (DFF / 32), I_D = (DFF / 64) * 64;
            constexpr int NITEMS = I_IN + I_UQ + I_UKV + I_O + 2 * I_G + I_D;
            for (int it = gw; it < NITEMS; it += NGW) { int r = it;
                if (r < I_IN) { transpose_item(w_in, 2048, INC, Win, nullptr, 1, scr, r, lane); continue; } r -= I_IN;
                if (r < I_UQ) { transpose_item(w_uq, 512, 1536, Wuq, mla_q_norm_w, 2, scr, r, lane); continue; } r -= I_UQ;
                if (r < I_UKV) { transpose_item(w_ukv, 512, 2048, Wukv, mla_kv_norm_w, 0, scr, r, lane); continue; } r -= I_UKV;
                if (r < I_O) { transpose_item(w_o, 2048, 2048, Wo, nullptr, 0, scr, r, lane); continue; } r -= I_O;
                if (r < I_G) { transpose_item(w_gate, 2048, DFF, Wgu, nullptr, 3, scr, r, lane); continue; } r -= I_G;
                if (r < I_G) { transpose_item(w_up, 2048, DFF, Wgu, nullptr, 4, scr, r, lane); continue; } r -= I_G;
                transpose_item(w_down, DFF, 2048, Wdn, nullptr, 0, scr, r, lane); }
            for (int i = bx * 512 + tid; i < (INCP - INC) * 2048 / 8; i += G * 512) *(v4u*)(Win + (size_t)INC * 2048 + (size_t)i * 8) = (v4u){0u, 0u, 0u, 0u};
        }
        {
            for (int i = bx * 512 + tid; i < T * 96; i += G * 512) { const int t = i / 96, j = i % 96; const float pos = (float)positions[t];
                const float inv = j < 64 ? a.inv_r[j] : a.inv_m[j - 64]; const float ang = pos * inv;
                double rev = (double)ang * 0.15915494309189535; rev -= __builtin_rint(rev);
                const double qd = __builtin_rint(rev * 4.0); const double y = (rev - qd * 0.25) * 6.283185307179586; const double y2 = y * y;
                const double sy = y * (1.0 + y2 * (-1.0 / 6 + y2 * (1.0 / 120 + y2 * (-1.0 / 5040 + y2 * (1.0 / 362880 + y2 * (-1.0 / 39916800 + y2 * (1.0 / 6227020800.0)))))));
                const double cy = 1.0 + y2 * (-0.5 + y2 * (1.0 / 24 + y2 * (-1.0 / 720 + y2 * (1.0 / 40320 + y2 * (-1.0 / 3628800 + y2 * (1.0 / 479001600.0 + y2 * (-1.0 / 87178291200.0)))))));
                const int qi = (int)qd & 3;
                const float cv = (float)(qi == 0 ? cy : qi == 1 ? -sy : qi == 2 ? -cy : sy), sv = (float)(qi == 0 ? sy : qi == 1 ? cy : qi == 2 ? -sy : -cy);
                if (j < 64) { cosr[(size_t)t * 64 + j] = cv; sinr[(size_t)t * 64 + j] = sv; } else { cosm[(size_t)t * 32 + j - 64] = cv; sinm[(size_t)t * 32 + j - 64] = sv; } }
        }
    }
    SEAM(0);
    if (IN(1)) { WSB(); WSF(mod, WS_CTL + OFF_MOD); WSH(H, WS_H); INP(x, 0); INP(norm1_w, 5);
        for (int m = gw; m < T; m += NGW) { const int b = m >> 12; norm_row(x + (size_t)m * DM, norm1_w, mod + (size_t)b * NMODC, mod + (size_t)b * NMODC + DM, H + (size_t)m * DM, nullptr, lane); } }
    SEAM(1);
    if (IN(2)) {
        WSB(); WSH(H, WS_H); WSH(Win, WS_WIN); WSH(Qr, WS_QR); WSH(Kr, WS_KR); WSH(Vr, WS_VR); WSH(Gr, WS_GR); WSH(CQ, WS_CQ); WSH(CKV, WS_CKV); WSH(Kbuf, WS_KB);
        WSF(cosr, WS_COSR); WSF(sinr, WS_SINR); WSF(cosm, WS_COSM); WSF(sinm, WS_SINM); WSF(ssq_q, WS_CTL + OFF_SSQQ); WSF(ssq_kv, WS_CTL + OFF_SSQKV);
        pg8::Gemm g{H, Win, T, INCP, DM}; pg8::StaticOrder S; S.init(T, INCP, G, bx);
        pg8::EpiIn E{Qr, Kr, Vr, Gr, CQ, CKV, Kbuf, cosr, sinr, cosm, sinm, ssq_q, ssq_kv};
        pg8::gemm_phase<pg8::EpiIn, pg8::StaticOrder, true, true>(lds3, g, S, E);
    }
    SEAM(2);
    if (IN(3)) {
        WSB(); WSH(CQ, WS_CQ); WSH(CKV, WS_CKV); WSH(Wuq, WS_WUQ); WSH(Wukv, WS_WUKV); WSH(Qm, WS_QM); WSH(Kbuf, WS_KB); WSH(Vm, WS_VM); WSH(Kr, WS_KR); WSH(Vr, WS_VR); WSH(CK, WS_H);
        WSF(cosm, WS_COSM); WSF(sinm, WS_SINM); WSF(ssq_q, WS_CTL + OFF_SSQQ); WSF(ssq_kv, WS_CTL + OFF_SSQKV); INP(ret_decay, 7);
        { pg8::Gemm g{CQ, Wuq, T, 1536, 512}; pg8::StaticOrder S; S.init(T, 1536, G, bx); pg8::EpiUpQ E{ssq_q, Qm, cosm, sinm};
          pg8::gemm_phase<pg8::EpiUpQ, pg8::StaticOrder, true, true>(lds3, g, S, E); }
        { pg8::Gemm g{CKV, Wukv, T, 2048, 512}; pg8::StaticOrder S; S.init(T, 2048, G, bx); pg8::EpiUpKV E{ssq_kv, Kbuf, Vm};
          pg8::gemm_phase<pg8::EpiUpKV, pg8::StaticOrder, true, true>(lds3, g, S, E); }
        for (int u = vcu; u < 2048; u += G) { const int n = u & 31, h = (u >> 5) & 7, b = u >> 8; const size_t t0 = (size_t)b * SEQ + n * 128;
            const float lgf = -__expf(ret_decay[h]) * 1.4426950408889634f, lgb = -__expf(ret_decay[8 + h]) * 1.4426950408889634f;
            att::chunk_kv_unit(Kr + t0 * 1024 + h * 128, Vr + t0 * 1024 + h * 128, CK + ((size_t)(b * 8 + h) * 32 + n) * 16384, CK + ((size_t)(64 + b * 8 + h) * 32 + n) * 16384, lgf, lgb, ldsg, ldsaddr); }
        __syncthreads();
    }
    SEAM(3);
    if (IN(4)) {
        WSB(); WSH(Qm, WS_QM); WSH(Kbuf, WS_KB); WSH(Vm, WS_VM); WSH(Oat, WS_OAT); WSH(CK, WS_H); INP(ret_decay, 7);
        for (int u = vcu; u < 1024; u += G) { const int qb = u & 15, h = (u >> 4) & 7, b = u >> 7; const size_t r0 = (size_t)b * SEQ;
            att::attn_unit(Qm + (r0 + qb * 256) * 1536 + h * 192, Kbuf + r0 * 1536 + h * 192, Vm + r0 * 1024 + h * 128, Oat + (r0 + qb * 256) * 1024 + h * 128, SEQ, ldsg, ldsaddr); }
#ifndef NO_SCAN
        for (int idx = bx * 512 + tid; idx < 2 * 64 * 2048; idx += G * 512) { const int dir = idx >> 17, bh = (idx >> 11) & 63, e8 = idx & 2047, h = bh & 7;
            const float cd = __builtin_amdgcn_exp2f(-__expf(ret_decay[dir * 8 + h]) * 1.4426950408889634f * 128.f);
            bf16_t* base = CK + ((size_t)(dir * 64 + bh) * 32) * 16384 + e8 * 8; float st[8];
#pragma unroll
            for (int i = 0; i < 8; ++i) st[i] = 0.f;
            for (int s8 = 0; s8 < 32; s8 += 8) { v4u kv[8];
#pragma unroll
                for (int i = 0; i < 8; ++i) { const int m = dir ? 31 - (s8 + i) : s8 + i; kv[i] = *(const v4u*)(base + (size_t)m * 16384); }
#pragma unroll
                for (int i = 0; i < 8; ++i) { const int m = dir ? 31 - (s8 + i) : s8 + i; v4u o;
                    o.x = pk2a(st[0], st[1]); o.y = pk2a(st[2], st[3]); o.z = pk2a(st[4], st[5]); o.w = pk2a(st[6], st[7]);
                    *(v4u*)(base + (size_t)m * 16384) = o;
#pragma unroll
                    for (int q = 0; q < 4; ++q) { const unsigned w = kv[i][q]; st[2 * q] = st[2 * q] * cd + __uint_as_float(w << 16); st[2 * q + 1] = st[2 * q + 1] * cd + __uint_as_float(w & 0xffff0000u); } } }
        }
#endif
    }
    SEAM(4);
    if (IN(5)) {
        WSB(); WSH(Qr, WS_QR); WSH(Kr, WS_KR); WSH(Vr, WS_VR); WSH(Gr, WS_GR); WSH(CK, WS_H); WSH(Cat, WS_CAT); WSH(Oat, WS_OAT); INP(ret_decay, 7); INP(ret_gn_w, 8); INP(ret_gn_b, 9); INP(mla_out_w, 14);
#if PROBE_BRUTE_RET
        float* dumpb = (float*)(ws + 704 * MiB);
        for (int up = vcu; up < 1024; up += G) {
            if (PROBE_COMP != 0) { const int u = up * 2 + (wave >> 2); const int n = u & 31, h = (u >> 5) & 7, b = u >> 8; const size_t t0 = (size_t)b * SEQ + n * 128;
                const float lgf = -__expf(ret_decay[h]) * 1.4426950408889634f, lgb = -__expf(ret_decay[8 + h]) * 1.4426950408889634f; const int hf = wave >> 2;
                att::ret_out_unit(Qr + t0 * 1024 + h * 128, Kr + t0 * 1024 + h * 128, Vr + t0 * 1024 + h * 128, Gr + t0 * 1024 + h * 128,
                                  CK + ((size_t)(b * 8 + h) * 32 + n) * 16384, CK + ((size_t)(64 + b * 8 + h) * 32 + n) * 16384, ret_gn_w + h * 128, ret_gn_b + h * 128,
                                  Cat + t0 * 2048 + h * 128, lgf, lgb, ldsg + hf * 65536, ldsaddr + hf * 65536, dumpb + t0 * 1024 + h * 128);
                __threadfence(); __syncthreads(); }
            for (int k2 = 0; k2 < 2; ++k2) { const int u = up * 2 + k2; const int n = u & 31, h = (u >> 5) & 7, b = u >> 8; const size_t r0 = (size_t)b * SEQ, t0 = r0 + n * 128;
                const float lgf = -__expf(ret_decay[h]) * 1.4426950408889634f, lgb = -__expf(ret_decay[8 + h]) * 1.4426950408889634f;
                att::ret_brute_unit(Qr + r0 * 1024 + h * 128, Kr + r0 * 1024 + h * 128, Vr + r0 * 1024 + h * 128, Gr + t0 * 1024 + h * 128, ret_gn_w + h * 128, ret_gn_b + h * 128, Cat + t0 * 2048 + h * 128, n * 128, lgf, lgb, ldsg, dumpb + t0 * 1024 + h * 128); } }
        __syncthreads();
        for (int up = vcu; up < 0; up += G) { const int u = up * 2 + (wave >> 2);
#else
        for (int up = vcu; up < 1024; up += G) { const int u = up * 2 + (wave >> 2);
#endif
            const int n = u & 31, h = (u >> 5) & 7, b = u >> 8; const size_t t0 = (size_t)b * SEQ + n * 128;
            const float lgf = -__expf(ret_decay[h]) * 1.4426950408889634f, lgb = -__expf(ret_decay[8 + h]) * 1.4426950408889634f; const int hf = wave >> 2;
            att::ret_out_unit(Qr + t0 * 1024 + h * 128, Kr + t0 * 1024 + h * 128, Vr + t0 * 1024 + h * 128, Gr + t0 * 1024 + h * 128,
                              CK + ((size_t)(b * 8 + h) * 32 + n) * 16384, CK + ((size_t)(64 + b * 8 + h) * 32 + n) * 16384, ret_gn_w + h * 128, ret_gn_b + h * 128,
                              Cat + t0 * 2048 + h * 128, lgf, lgb, ldsg + hf * 65536, ldsaddr + hf * 65536); }
        for (int m = gw; m < T; m += NGW) {
            const bf16_t* orow = Oat + (size_t)m * 1024; float v[16]; float s = 0.f;
#pragma unroll
            for (int j = 0; j < 2; ++j) { const v4u w = *(const v4u*)(orow + lane * 8 + 512 * j);
#pragma unroll
                for (int q = 0; q < 4; ++q) { v[j * 8 + 2 * q] = __uint_as_float(w[q] << 16); v[j * 8 + 2 * q + 1] = __uint_as_float(w[q] & 0xffff0000u); } }
#pragma unroll
            for (int i = 0; i < 16; ++i) s += v[i] * v[i];
            const float rstd = rsqrtf(wave_sum(s) * (1.f / 1024.f) + 1e-6f);
#pragma unroll
            for (int j = 0; j < 2; ++j) { const int col = lane * 8 + 512 * j; const f32x4 w0 = *(const f32x4*)(mla_out_w + col), w1 = *(const f32x4*)(mla_out_w + col + 4); v4u o;
                o.x = pk2a(v[j * 8 + 0] * rstd * w0.x, v[j * 8 + 1] * rstd * w0.y); o.y = pk2a(v[j * 8 + 2] * rstd * w0.z, v[j * 8 + 3] * rstd * w0.w);
                o.z = pk2a(v[j * 8 + 4] * rstd * w1.x, v[j * 8 + 5] * rstd * w1.y); o.w = pk2a(v[j * 8 + 6] * rstd * w1.z, v[j * 8 + 7] * rstd * w1.w);
                *(v4u*)(Cat + (size_t)m * 2048 + 1024 + col) = o; } }
        __syncthreads();
    }
    SEAM(5);
    if (IN(6)) {
        WSB(); WSH(Cat, WS_CAT); WSH(Wo, WS_WO); WSF(mod, WS_CTL + OFF_MOD); INP(x, 0);
        pg8::Gemm g{Cat, Wo, T, 2048, 2048}; pg8::StaticOrder S; S.init(T, 2048, G, bx); pg8::EpiGateRes E{x, mod + 2 * DM, out};
        pg8::gemm_phase<pg8::EpiGateRes, pg8::StaticOrder, true, true>(lds3, g, S, E);
    }
    SEAM(6);
    if (IN(7)) { WSB(); WSF(mod, WS_CTL + OFF_MOD); WSH(H, WS_H); INP(norm2_w, 16);
        for (int m = gw; m < T; m += NGW) { const int b = m >> 12; norm_row(out + (size_t)m * DM, norm2_w, mod + (size_t)b * NMODC + 3 * DM, mod + (size_t)b * NMODC + 4 * DM, H + (size_t)m * DM, nullptr, lane); } }
    SEAM(7);
    if (IN(8)) {
        WSB(); WSH(H, WS_H); WSH(Wgu, WS_WGU); WSH(Aff, WS_AFF);
        pg8::Gemm g{H, Wgu, T, 2 * DFF, DM}; pg8::StaticOrder S; S.init(T, 2 * DFF, G, bx); pg8::EpiGU E{Aff};
        pg8::gemm_phase<pg8::EpiGU, pg8::StaticOrder, true, true>(lds3, g, S, E);
    }
    SEAM(8);
    if (IN(9)) {
        WSB(); WSH(Aff, WS_AFF); WSH(Wdn, WS_WDN); WSF(mod, WS_CTL + OFF_MOD);
        pg8::Gemm g{Aff, Wdn, T, 2048, DFF}; pg8::StaticOrder S; S.init(T, 2048, G, bx); pg8::EpiGateRes E{out, mod + 5 * DM, out};
        pg8::gemm_phase<pg8::EpiGateRes, pg8::StaticOrder, true, true>(lds3, g, S, E);
    }
    SEAM(9);
    if (IN(10)) { WSB(); (void)ws; INP(final_norm_w, 20);
        for (int m = gw; m < T; m += NGW) norm_row(out + (size_t)m * DM, final_norm_w, nullptr, nullptr, nullptr, out + (size_t)m * DM, lane); }
#undef IN
#undef SEAM
}

extern "C" void kernel_launch(void* const* d_in, const int* in_sizes, int n_in, void* d_out, int out_size, void* d_ws, size_t ws_size, hipStream_t stream) {
    static int grid = 0;
    if (grid == 0) {
        if (n_in != 21 || in_sizes[0] != T * DM || out_size != T * DM || ws_size < WS_END) { fprintf(stderr, "kernel_launch: shape/workspace mismatch (n_in %d, ws %zu < %zu)\n", n_in, ws_size, (size_t)WS_END); grid = -1; return; }
        int dev = 0, cus = 0, per_cu = 0;
        (void)hipGetDevice(&dev); (void)hipDeviceGetAttribute(&cus, hipDeviceAttributeMultiprocessorCount, dev);
        if (hipFuncSetAttribute((const void*)mk_fwd, hipFuncAttributeMaxDynamicSharedMemorySize, LDS_BYTES) != hipSuccess) { fprintf(stderr, "kernel_launch: hipFuncSetAttribute failed\n"); grid = -1; return; }
        if (hipOccupancyMaxActiveBlocksPerMultiprocessor(&per_cu, (const void*)mk_fwd, 512, LDS_BYTES) != hipSuccess || per_cu < 1) { fprintf(stderr, "kernel_launch: occupancy query gave %d\n", per_cu); per_cu = 1; }
        (void)hipGetLastError();
        grid = cus * per_cu;
    }
    if (grid < 0) return;
    (void)hipMemsetAsync((char*)d_ws + WS_CTL, 0, CTL_ZERO_BYTES, stream);
    Args a{};
    for (int i = 0; i < 21; ++i) a.in[i] = (const float*)d_in[i];
    a.out = (float*)d_out; a.ws = (unsigned char*)d_ws;
    for (int i = 0; i < 64; ++i) a.inv_r[i] = powf(10000.0f, -((float)(2 * i)) / 128.0f);
    for (int i = 0; i < 32; ++i) a.inv_m[i] = powf(10000.0f, -((float)(2 * i)) / 64.0f);
#if MK_SPLIT
    for (int p = 0; p < NPH; ++p) { a.ph_lo = p; a.ph_hi = p + 1; hipLaunchKernelGGL(mk_fwd, dim3(grid), dim3(512), LDS_BYTES, stream, a); }
#else
    a.ph_lo = 0; a.ph_hi = NPH;
    void* args[] = {&a};
    hipError_t e = hipLaunchCooperativeKernel((const void*)mk_fwd, dim3(grid), dim3(512), args, LDS_BYTES, stream);
    if (e != hipSuccess) fprintf(stderr, "kernel_launch: cooperative launch failed: %s (grid %d)\n", hipGetErrorString(e), grid);
#endif
}
```

```cpp
#include <hip/hip_runtime.h>
#include <hip/hip_cooperative_groups.h>
#include <cstdio>
#include <cstdint>
#include <cmath>
namespace cg = cooperative_groups;
namespace pg8 {
#define PG8_LAS __attribute__((address_space(3)))
typedef unsigned short bf16_t;
typedef short bf16x8 __attribute__((ext_vector_type(8)));
typedef float f32x4 __attribute__((ext_vector_type(4)));
typedef unsigned u32x4 __attribute__((ext_vector_type(4)));
constexpr int BM = 256, BK = 64, HALF = 128, HTB = HALF * BK * 2  , STAGE_BYTES = 8 * HTB, NXCD = 8, WGM = 8;

__host__ __device__ __forceinline__ int lds_byte(int r, int c) { const int st = (r >> 4) * 2 + (c >> 5), rr = r & 15, cc = c & 31, ob = rr * 64 + cc * 2; return st * 1024 + (ob ^ (((ob >> 9) & 1) << 5)); }
__host__ __device__ __forceinline__ void stage_rc(int b, int& R, int& C) { const int st = b / 1024, sb = b % 1024, swz = sb ^ (((sb >> 9) & 1) << 5); R = (st >> 1) * 16 + swz / 64; C = (st & 1) * 32 + (swz % 64) / 2; }
__host__ __device__ __forceinline__ int perm32(int rho) { const int n = rho >> 4, i = rho & 15; return 8 * (i >> 2) + 4 * n + (i & 3); }

struct Unit { int pm, pn; };
struct Gemm { const bf16_t* A; const bf16_t* Bt; int M, N, K; };

struct StaticOrder {
    int nM, nN, nwg, G, c;
    __host__ __device__ void init(int M, int N, int G_, int c_) { nM = M / BM; nN = N / BM; nwg = nM * nN; G = G_; c = c_; }
    __host__ __device__ bool next(int i, Unit& u) const {
        const long L = (long)i * G + c; if (L >= nwg) return false;
        int wgid = (int)L; { const int q = nwg / NXCD, r = nwg % NXCD, xcd = wgid % NXCD, off = wgid / NXCD; wgid = (xcd < r ? xcd * (q + 1) : r * (q + 1) + (xcd - r) * q) + off; }
        const int nig = WGM * nN, gid = wgid / nig, fm = gid * WGM, gsz = (nM - fm) < WGM ? (nM - fm) : WGM;
        u.pm = fm + ((wgid % nig) % gsz); u.pn = (wgid % nig) / gsz; return true;
    }
    __device__ __forceinline__ void a_ready(const Unit&) const {}
    __device__ __forceinline__ void done(const Unit&) const {}
};

#ifndef PROBE_COARSE_ACT
#define PROBE_COARSE_ACT 0
#endif
__device__ __forceinline__ unsigned coarse2(unsigned w) { return PROBE_COARSE_ACT ? ((w + ((w >> 1) & 0x00010001u)) & 0xfffefffeu) : w; }
__device__ __forceinline__ unsigned cvt_pk_bf16(float lo, float hi) { unsigned r; asm volatile("v_cvt_pk_bf16_f32 %0, %1, %2" : "=v"(r) : "v"(lo), "v"(hi)); return coarse2(r); }
typedef float f32x2 __attribute__((ext_vector_type(2)));

typedef unsigned u32x2 __attribute__((ext_vector_type(2)));
__device__ __forceinline__ float silu_f(float v) { return v * __builtin_amdgcn_rcpf(1.f + __builtin_amdgcn_exp2f(v * -1.4426950408889634f)); }
__device__ __forceinline__ u32x4 pack8(f32x4 a, f32x4 b) { u32x4 w; w.x = cvt_pk_bf16(a[0], a[1]); w.y = cvt_pk_bf16(a[2], a[3]); w.z = cvt_pk_bf16(b[0], b[1]); w.w = cvt_pk_bf16(b[2], b[3]); return w; }
__device__ __forceinline__ void rope8(f32x4& a, f32x4& b, const f32x4 c, const f32x4 s) {
    float t1, t2;
    t1 = a[0]; t2 = a[1]; a[0] = t1 * c[0] - t2 * s[0]; a[1] = t2 * c[0] + t1 * s[0];
    t1 = a[2]; t2 = a[3]; a[2] = t1 * c[1] - t2 * s[1]; a[3] = t2 * c[1] + t1 * s[1];
    t1 = b[0]; t2 = b[1]; b[0] = t1 * c[2] - t2 * s[2]; b[1] = t2 * c[2] + t1 * s[2];
    t1 = b[2]; t2 = b[3]; b[2] = t1 * c[3] - t2 * s[3]; b[3] = t2 * c[3] + t1 * s[3];
}
constexpr float NORM_EPS = 1e-6f;

struct EpiIn {
    static constexpr bool PERM = true, AFTER_DRAIN = false;
    bf16_t *Qr, *Kr, *Vr, *Gr, *CQ, *CKV, *Kbuf; const float *cosr, *sinr, *cosm, *sinm; float *ssq_q, *ssq_kv;
    __device__ __forceinline__ void operator()(const f32x4 (&acc)[2][2][4][2], const Unit& u, int wr, int wc, int fr, int fq) const {
        const int pn = u.pn, row0 = u.pm * BM + wr * 64 + fr, cl = wc * 32 + 8 * fq;
        if (pn < 8) {
            bf16_t* O = pn < 4 ? Qr : Kr; const float sc = pn < 4 ? 1.f : 0.08838834764831845f; const int colt = (pn & 3) * 256 + cl;
#pragma unroll
            for (int ai = 0; ai < 2; ++ai)
#pragma unroll
                for (int m = 0; m < 4; ++m) { const int row = row0 + ai * HALF + m * 16;
                    const f32x4 c4 = *(const f32x4*)(cosr + (size_t)row * 64 + (cl >> 1)), s4 = *(const f32x4*)(sinr + (size_t)row * 64 + (cl >> 1));
#pragma unroll
                    for (int bj = 0; bj < 2; ++bj) { f32x4 a = acc[ai][bj][m][0], b = acc[ai][bj][m][1]; rope8(a, b, c4, s4); a = a * sc; b = b * sc;
                        *(u32x4*)(O + (size_t)row * 1024 + colt + bj * HALF) = pack8(a, b); } }
        } else if (pn < 16) {
            const bool isg = pn >= 12; bf16_t* O = isg ? Gr : Vr; const int colt = (pn & 3) * 256 + cl;
#pragma unroll
            for (int ai = 0; ai < 2; ++ai)
#pragma unroll
                for (int m = 0; m < 4; ++m) { const int row = row0 + ai * HALF + m * 16;
#pragma unroll
                    for (int bj = 0; bj < 2; ++bj) { f32x4 a = acc[ai][bj][m][0], b = acc[ai][bj][m][1];
                        if (isg) {
#pragma unroll
                            for (int i = 0; i < 4; ++i) { a[i] = silu_f(a[i]); b[i] = silu_f(b[i]); } }
                        *(u32x4*)(O + (size_t)row * 1024 + colt + bj * HALF) = pack8(a, b); } }
        } else if (pn < 20) {
            bf16_t* O = pn < 18 ? CQ : CKV; float* sq = pn < 18 ? ssq_q : ssq_kv; const int colt = (pn & 1) * 256 + cl;
#pragma unroll
            for (int ai = 0; ai < 2; ++ai)
#pragma unroll
                for (int m = 0; m < 4; ++m) { const int row = row0 + ai * HALF + m * 16; float s = 0.f;
#pragma unroll
                    for (int bj = 0; bj < 2; ++bj) { const f32x4 a = acc[ai][bj][m][0], b = acc[ai][bj][m][1];
                        s += (a[0] * a[0] + a[1] * a[1]) + (a[2] * a[2] + a[3] * a[3]) + (b[0] * b[0] + b[1] * b[1]) + (b[2] * b[2] + b[3] * b[3]);
                        *(u32x4*)(O + (size_t)row * 512 + colt + bj * HALF) = pack8(a, b); }
                    s += __shfl_xor(s, 16); s += __shfl_xor(s, 32);
                    if (fq == 0) atomicAdd(sq + row, s); }
        } else {
            if (wc < 2) {
#pragma unroll
                for (int ai = 0; ai < 2; ++ai)
#pragma unroll
                    for (int m = 0; m < 4; ++m) { const int row = row0 + ai * HALF + m * 16;
                        const f32x4 c4 = *(const f32x4*)(cosm + (size_t)row * 32 + (cl >> 1)), s4 = *(const f32x4*)(sinm + (size_t)row * 32 + (cl >> 1));
                        f32x4 a = acc[ai][0][m][0], b = acc[ai][0][m][1]; rope8(a, b, c4, s4); const u32x4 w = pack8(a, b);
#pragma unroll
                        for (int h = 0; h < 8; ++h) *(u32x4*)(Kbuf + (size_t)row * 1536 + h * 192 + 128 + cl) = w; }
            }
        }
    }
};
struct EpiUpQ {
    static constexpr bool PERM = true, AFTER_DRAIN = false;
    const float* ssq; bf16_t* Qm; const float *cosm, *sinm;
    __device__ __forceinline__ void operator()(const f32x4 (&acc)[2][2][4][2], const Unit& u, int wr, int wc, int fr, int fq) const {
        const int row0 = u.pm * BM + wr * 64 + fr, cl = wc * 32 + 8 * fq;
#pragma unroll
        for (int ai = 0; ai < 2; ++ai)
#pragma unroll
            for (int m = 0; m < 4; ++m) { const int row = row0 + ai * HALF + m * 16; const float rstd = rsqrtf(ssq[row] * (1.f / 512.f) + NORM_EPS);
#pragma unroll
                for (int bj = 0; bj < 2; ++bj) { const int c = u.pn * 256 + bj * HALF + cl, d = c % 192; f32x4 a = acc[ai][bj][m][0] * rstd, b = acc[ai][bj][m][1] * rstd;
                    if (d >= 128) { const int fi = (d - 128) >> 1; const f32x4 c4 = *(const f32x4*)(cosm + (size_t)row * 32 + fi), s4 = *(const f32x4*)(sinm + (size_t)row * 32 + fi); rope8(a, b, c4, s4); }
                    *(u32x4*)(Qm + (size_t)row * 1536 + c) = pack8(a, b); } }
    }
};
struct EpiUpKV {
    static constexpr bool PERM = true, AFTER_DRAIN = false;
    const float* ssq; bf16_t *Kbuf, *Vm;
    __device__ __forceinline__ void operator()(const f32x4 (&acc)[2][2][4][2], const Unit& u, int wr, int wc, int fr, int fq) const {
        const int row0 = u.pm * BM + wr * 64 + fr, cl = wc * 32 + 8 * fq;
#pragma unroll
        for (int ai = 0; ai < 2; ++ai)
#pragma unroll
            for (int m = 0; m < 4; ++m) { const int row = row0 + ai * HALF + m * 16; const float rstd = rsqrtf(ssq[row] * (1.f / 512.f) + NORM_EPS);
                *(u32x4*)(Kbuf + (size_t)row * 1536 + u.pn * 192 + cl) = pack8(acc[ai][0][m][0] * rstd, acc[ai][0][m][1] * rstd);
                *(u32x4*)(Vm + (size_t)row * 1024 + u.pn * 128 + cl) = pack8(acc[ai][1][m][0] * rstd, acc[ai][1][m][1] * rstd); }
    }
};
struct EpiGateRes {
    static constexpr bool PERM = true, AFTER_DRAIN = false;
    const float* x; const float* gate; float* out;
    __device__ __forceinline__ void operator()(const f32x4 (&acc)[2][2][4][2], const Unit& u, int wr, int wc, int fr, int fq) const {
        const int row0 = u.pm * BM + wr * 64 + fr, cl = wc * 32 + 8 * fq, b = u.pm >> 4;
#pragma unroll
        for (int bj = 0; bj < 2; ++bj) { const int c = u.pn * 256 + bj * HALF + cl;
            const f32x4 g0 = *(const f32x4*)(gate + (size_t)b * 12288 + c), g1 = *(const f32x4*)(gate + (size_t)b * 12288 + c + 4);
#pragma unroll
            for (int ai = 0; ai < 2; ++ai)
#pragma unroll
                for (int m = 0; m < 4; ++m) { const size_t off = (size_t)(row0 + ai * HALF + m * 16) * 2048 + c;
                    const f32x4 x0 = *(const f32x4*)(x + off), x1 = *(const f32x4*)(x + off + 4);
                    *(f32x4*)(out + off) = x0 + g0 * acc[ai][bj][m][0]; *(f32x4*)(out + off + 4) = x1 + g1 * acc[ai][bj][m][1]; } }
    }
};
struct EpiGU {
    static constexpr bool PERM = true, AFTER_DRAIN = false;
    bf16_t* Aff;
    __device__ __forceinline__ void operator()(const f32x4 (&acc)[2][2][4][2], const Unit& u, int wr, int wc, int fr, int fq) const {
        const int row0 = u.pm * BM + wr * 64 + fr, cl = wc * 32 + 8 * fq;
#pragma unroll
        for (int ai = 0; ai < 2; ++ai)
#pragma unroll
            for (int m = 0; m < 4; ++m) { const int row = row0 + ai * HALF + m * 16; f32x4 a, b;
#pragma unroll
                for (int i = 0; i < 4; ++i) { a[i] = silu_f(acc[ai][0][m][0][i]) * acc[ai][1][m][0][i]; b[i] = silu_f(acc[ai][0][m][1][i]) * acc[ai][1][m][1][i]; }
                *(u32x4*)(Aff + (size_t)row * 5632 + u.pn * 128 + cl) = pack8(a, b); }
    }
};

template <class Epi, class Sched, bool ALIGN_EPI = false, bool SP2 = false>
__device__ __forceinline__ void gemm_phase(PG8_LAS unsigned char* lds, const Gemm g, const Sched& S, const Epi& E) {
    const int tid = threadIdx.x, wid = __builtin_amdgcn_readfirstlane(tid >> 6), lane = tid & 63, wr = wid >> 2, wc = wid & 3, fr = lane & 15, fq = lane >> 4;
    const int K = g.K, nt = K / BK;
    unsigned voffA[2], voffB[2];
#pragma unroll
    for (int i = 0; i < 2; ++i) { int R, C; stage_rc(tid * 16 + i * 8192, R, C); const int Rb = Epi::PERM ? ((R & ~31) + perm32(R & 31)) : R;
        voffA[i] = (unsigned)(R * K + C) * 2u; voffB[i] = (unsigned)(Rb * K + C) * 2u; }
    const size_t kstep = (size_t)(BK * 2);
    const size_t hstep = (size_t)HALF * K * 2;
    const size_t tstep = 2 * hstep;
    const unsigned ldsw = (unsigned)wid * 1024u;
    const int aoff = lds_byte(wr * 64 + fr, fq * 8), boff = lds_byte(wc * 32 + fr, fq * 8);
#define PG8_SA(b, h) (((b) * 2 + (h)) * HTB)
#define PG8_SB(b, h) ((4 + (b) * 2 + (h)) * HTB)
#define PG8_STAGE(bufoff, gbase, voff) do { _Pragma("unroll") for (int _i = 0; _i < 2; ++_i) \
        __builtin_amdgcn_global_load_lds((const unsigned*)((const char*)(gbase) + (voff)[_i]), (PG8_LAS unsigned*)(lds + (bufoff) + ldsw + _i * 8192), 16, 0, 0); } while (0)
#define PG8_LDA(dst, b, h) do { _Pragma("unroll") for (int m = 0; m < 4; ++m) _Pragma("unroll") for (int k = 0; k < 2; ++k) dst[m][k] = *(const PG8_LAS bf16x8*)(lds + PG8_SA(b, h) + aoff + m * 2048 + k * 1024); } while (0)
#define PG8_LDB(dst, b, h) do { _Pragma("unroll") for (int n = 0; n < 2; ++n) _Pragma("unroll") for (int k = 0; k < 2; ++k) dst[n][k] = *(const PG8_LAS bf16x8*)(lds + PG8_SB(b, h) + boff + n * 2048 + k * 1024); } while (0)
#define PG8_MMA(ai, bj, At, Bt) do { __builtin_amdgcn_s_setprio(1); _Pragma("unroll") for (int m = 0; m < 4; ++m) _Pragma("unroll") for (int n = 0; n < 2; ++n) _Pragma("unroll") for (int k = 0; k < 2; ++k) \
        acc[ai][bj][m][n] = __builtin_amdgcn_mfma_f32_16x16x32_bf16(Bt[n][k], At[m][k], acc[ai][bj][m][n], 0, 0, 0); __builtin_amdgcn_s_setprio(0); } while (0)
#define PG8_WAIT_V(n) asm volatile("s_waitcnt vmcnt(" #n ")" ::: "memory")
#define PG8_WAIT_L(n) asm volatile("s_waitcnt lgkmcnt(" #n ")" ::: "memory")
#define PG8_BAR __builtin_amdgcn_s_barrier()
#define PG8_SCHED __builtin_amdgcn_sched_barrier(0)
    Unit cur, nxt; int ui = 0;
    if (!S.next(0, cur)) return;
    f32x4 acc[2][2][4][2];
#pragma unroll
    for (int a = 0; a < 2; ++a)
#pragma unroll
        for (int b = 0; b < 2; ++b)
#pragma unroll
            for (int m = 0; m < 4; ++m)
#pragma unroll
                for (int n = 0; n < 2; ++n) acc[a][b][m][n] = (f32x4){0.f, 0.f, 0.f, 0.f};
    bf16x8 At[4][2], B0[2][2], B1[2][2];
    const char* cA = (const char*)g.A + (size_t)cur.pm * tstep; const char* cB = (const char*)g.Bt + (size_t)cur.pn * tstep;
    S.a_ready(cur);
    if constexpr (SP2) {
        PG8_STAGE(PG8_SB(0, 0), cB, voffB); PG8_STAGE(PG8_SB(0, 1), cB + hstep, voffB); PG8_STAGE(PG8_SA(0, 0), cA, voffA); PG8_STAGE(PG8_SA(0, 1), cA + hstep, voffA);
        if (wr == 1) PG8_BAR;
        PG8_WAIT_V(2); PG8_BAR;
        PG8_STAGE(PG8_SB(1, 0), cB + kstep, voffB); PG8_STAGE(PG8_SA(1, 0), cA + kstep, voffA); PG8_STAGE(PG8_SB(1, 1), cB + hstep + kstep, voffB);
        PG8_WAIT_V(6); PG8_BAR;
    } else {
        PG8_STAGE(PG8_SB(0, 0), cB, voffB); PG8_STAGE(PG8_SA(0, 0), cA, voffA); PG8_STAGE(PG8_SB(0, 1), cB + hstep, voffB); PG8_STAGE(PG8_SA(0, 1), cA + hstep, voffA);
        if (wr == 1) PG8_BAR;
        PG8_WAIT_V(4); PG8_BAR;
        PG8_STAGE(PG8_SB(1, 0), cB + kstep, voffB); PG8_STAGE(PG8_SA(1, 0), cA + kstep, voffA); PG8_STAGE(PG8_SB(1, 1), cB + hstep + kstep, voffB);
        PG8_WAIT_V(6); PG8_BAR;
    }
    for (;;) {
        const bool has_next = S.next(ui + 1, nxt);
        const char* nA = has_next ? (const char*)g.A + (size_t)nxt.pm * tstep : cA; const char* nB = has_next ? (const char*)g.Bt + (size_t)nxt.pn * tstep : cB;
        for (int t = 0; t < nt; t += 2) {
            const bool last = (t == nt - 2);
            const char* a1 = cA + (size_t)(t + 1) * kstep;
            const char* a2 = last ? nA : cA + (size_t)(t + 2) * kstep; const char* b2 = last ? nB : cB + (size_t)(t + 2) * kstep;
            const char* a3 = a2 + kstep; const char* b3 = b2 + kstep;
            if (last && has_next) S.a_ready(nxt);
            if constexpr (SP2) {
            PG8_LDB(B0, 0, 0); PG8_LDB(B1, 0, 1); PG8_SCHED; PG8_LDA(At, 0, 0); PG8_STAGE(PG8_SA(1, 1), a1 + hstep, voffA);
            PG8_WAIT_V(8); PG8_WAIT_L(0); PG8_BAR; PG8_MMA(0, 0, At, B0); PG8_MMA(0, 1, At, B1); PG8_BAR; PG8_SCHED;
            PG8_LDA(At, 0, 1); PG8_STAGE(PG8_SB(0, 0), b2, voffB); PG8_STAGE(PG8_SB(0, 1), b2 + hstep, voffB); PG8_STAGE(PG8_SA(0, 0), a2, voffA);
            PG8_WAIT_V(8); PG8_WAIT_L(0); PG8_BAR; PG8_MMA(1, 0, At, B0); PG8_MMA(1, 1, At, B1); PG8_BAR; PG8_SCHED;
            PG8_LDB(B0, 1, 0); PG8_LDB(B1, 1, 1); PG8_SCHED; PG8_LDA(At, 1, 0); PG8_STAGE(PG8_SA(0, 1), a2 + hstep, voffA);
            PG8_WAIT_V(8); PG8_WAIT_L(0); PG8_BAR; PG8_MMA(0, 0, At, B0); PG8_MMA(0, 1, At, B1); PG8_BAR; PG8_SCHED;
            PG8_LDA(At, 1, 1); PG8_STAGE(PG8_SB(1, 0), b3, voffB); PG8_STAGE(PG8_SB(1, 1), b3 + hstep, voffB); PG8_STAGE(PG8_SA(1, 0), a3, voffA);
            PG8_WAIT_V(8); PG8_WAIT_L(0); PG8_BAR; PG8_MMA(1, 0, At, B0); PG8_MMA(1, 1, At, B1); PG8_BAR; PG8_SCHED;
            } else {
            PG8_LDB(B0, 0, 0); PG8_SCHED; PG8_LDA(At, 0, 0); PG8_STAGE(PG8_SA(1, 1), a1 + hstep, voffA);
            PG8_WAIT_L(8); PG8_BAR; PG8_WAIT_L(0); PG8_MMA(0, 0, At, B0); PG8_BAR; PG8_SCHED;
            PG8_LDB(B1, 0, 1); PG8_STAGE(PG8_SB(0, 0), b2, voffB);
            PG8_BAR; PG8_WAIT_L(0); PG8_MMA(0, 1, At, B1); PG8_BAR;
            PG8_LDA(At, 0, 1); PG8_STAGE(PG8_SA(0, 0), a2, voffA);
            PG8_BAR; PG8_WAIT_L(0); PG8_MMA(1, 0, At, B0); PG8_BAR; PG8_SCHED;
            PG8_STAGE(PG8_SB(0, 1), b2 + hstep, voffB);
            PG8_WAIT_V(6); PG8_BAR; PG8_MMA(1, 1, At, B1); PG8_BAR;
            PG8_LDB(B0, 1, 0); PG8_SCHED; PG8_LDA(At, 1, 0); PG8_STAGE(PG8_SA(0, 1), a2 + hstep, voffA);
            PG8_WAIT_L(8); PG8_BAR; PG8_WAIT_L(0); PG8_MMA(0, 0, At, B0); PG8_BAR; PG8_SCHED;
            PG8_LDB(B1, 1, 1); PG8_STAGE(PG8_SB(1, 0), b3, voffB);
            PG8_BAR; PG8_WAIT_L(0); PG8_MMA(0, 1, At, B1); PG8_BAR;
            PG8_LDA(At, 1, 1); PG8_STAGE(PG8_SA(1, 0), a3, voffA);
            PG8_BAR; PG8_WAIT_L(0); PG8_MMA(1, 0, At, B0); PG8_BAR; PG8_SCHED;
            PG8_STAGE(PG8_SB(1, 1), b3 + hstep, voffB);
            PG8_WAIT_V(6); PG8_BAR; PG8_MMA(1, 1, At, B1); PG8_BAR;
            }
        }
        if constexpr (ALIGN_EPI) { if (wr == 0) PG8_BAR; }
        if constexpr (!Epi::AFTER_DRAIN) { E(acc, cur, wr, wc, fr, fq); S.done(cur); }
        if (!has_next) break;
#pragma unroll
        for (int a = 0; a < 2; ++a)
#pragma unroll
            for (int b = 0; b < 2; ++b)
#pragma unroll
                for (int m = 0; m < 4; ++m)
#pragma unroll
                    for (int n = 0; n < 2; ++n) acc[a][b][m][n] = (f32x4){0.f, 0.f, 0.f, 0.f};
        cur = nxt; cA = nA; cB = nB; ++ui;
        if constexpr (ALIGN_EPI) { if (wr == 1) PG8_BAR; }
    }
    PG8_WAIT_V(0);
    if constexpr (!ALIGN_EPI) { if (wr == 0) PG8_BAR; }
    PG8_BAR;
    if constexpr (Epi::AFTER_DRAIN) { E.fused(acc, cur, wr, wc, fr, fq, lds, wid, lane); S.done(cur); }
#undef PG8_SA
#undef PG8_SB
#undef PG8_STAGE
#undef PG8_LDA
#undef PG8_LDB
#undef PG8_MMA
#undef PG8_WAIT_V
#undef PG8_WAIT_L
#undef PG8_BAR
#undef PG8_SCHED
}
}

namespace att {
typedef unsigned short bf16_t;
using bf16x8 = __attribute__((ext_vector_type(8))) short;
using s16x4  = __attribute__((ext_vector_type(4))) short;
using f32x16 = __attribute__((ext_vector_type(16))) float;
using f32x4  = __attribute__((ext_vector_type(4))) float;
using u32x4  = __attribute__((ext_vector_type(4))) unsigned;
using u32x2  = __attribute__((ext_vector_type(2))) unsigned;
constexpr int NW = 8, QBLK = 32, KVBLK = 64;
constexpr int LDQ = 1536, LDK = 1536, LDV = 1024, LDO = 1024;
constexpr float SCALE = 0.07216878364870323f;
constexpr float THR = 8.f;
constexpr int NQR = 8;
constexpr int SHM_V = KVBLK * 128 * 2, SHM_K = KVBLK * 192 * 2, SHM_ATTN = 2 * SHM_V + 2 * SHM_K + NW * 64 * 4;
#define AKSWZ(row, colB) ((row) * 384 + ((colB) ^ (((row) & 7) << 4)))
#define KSWZ128(row, colB) ((row) * 256 + ((colB) ^ (((row) & 7) << 4)))
#define SBAR() __builtin_amdgcn_sched_barrier(0)
#define GAS __attribute__((address_space(1)))
__device__ __forceinline__ const GAS char* uniform_ptr(const void* p) { const unsigned long long v = (unsigned long long)p; const unsigned lo = __builtin_amdgcn_readfirstlane((unsigned)v), hi = __builtin_amdgcn_readfirstlane((unsigned)(v >> 32)); return (const GAS char*)(((unsigned long long)hi << 32) | lo); }
__device__ __forceinline__ int crow(int r, int hi) { return (r & 3) + 8 * (r >> 2) + 4 * hi; }
__device__ __forceinline__ unsigned cvtpk(float lo, float hi) { unsigned r; asm volatile("v_cvt_pk_bf16_f32 %0, %1, %2" : "=v"(r) : "v"(lo), "v"(hi)); return pg8::coarse2(r); }
__device__ __forceinline__ float swap_sum(float v) { auto rr = __builtin_amdgcn_permlane32_swap(__float_as_uint(v), __float_as_uint(v), false, false); return __uint_as_float(rr[0]) + __uint_as_float(rr[1]); }

__device__ __forceinline__ void partialSM(f32x16& p0, f32x16& p1, float& m_reg, float& mn, float& alpha) {
  constexpr float C = SCALE * 1.4426950408889634f;
  float pmax = p0[0];
#pragma unroll
  for (int r = 1; r < 16; ++r) pmax = fmaxf(pmax, p0[r]);
#pragma unroll
  for (int r = 0; r < 16; ++r) pmax = fmaxf(pmax, p1[r]);
  { auto rr = __builtin_amdgcn_permlane32_swap(__float_as_uint(pmax), __float_as_uint(pmax), false, false);
    pmax = fmaxf(__uint_as_float(rr[0]), __uint_as_float(rr[1])); }
  if (__builtin_expect(__all(pmax - m_reg <= THR / SCALE), 1)) { mn = m_reg; alpha = 1.f; }
  else { mn = fmaxf(m_reg, pmax); alpha = __builtin_amdgcn_exp2f((m_reg - mn) * C); m_reg = mn; }
  float mnC = -mn * C;
#pragma unroll
  for (int r = 0; r < 16; ++r) p0[r] = fmaf(p0[r], C, mnC);
#pragma unroll
  for (int r = 0; r < 16; ++r) p1[r] = fmaf(p1[r], C, mnC);
#pragma unroll
  for (int r = 0; r < 16; ++r) p0[r] = __builtin_amdgcn_exp2f(p0[r]);
}
#define PK4(P, BASE, OUT) do { unsigned a0 = cvtpk(P[BASE + 0], P[BASE + 1]), a1 = cvtpk(P[BASE + 2], P[BASE + 3]);   \
    unsigned b0 = cvtpk(P[BASE + 4], P[BASE + 5]), b1 = cvtpk(P[BASE + 6], P[BASE + 7]);                              \
    auto r0 = __builtin_amdgcn_permlane32_swap(a0, b0, false, false); auto r1 = __builtin_amdgcn_permlane32_swap(a1, b1, false, false); \
    u32x4 w = {r0[0], r1[0], r0[1], r1[1]}; OUT = *reinterpret_cast<bf16x8*>(&w); } while (0)
__device__ __forceinline__ void finishSM(f32x16& p0, f32x16& p1, float alpha, float& l_reg, bf16x8& pa0, bf16x8& pa1, bf16x8& pa2, bf16x8& pa3) {
#pragma unroll
  for (int r = 0; r < 16; ++r) p1[r] = __builtin_amdgcn_exp2f(p1[r]);
  float ps = 0;
#pragma unroll
  for (int r = 0; r < 16; ++r) ps += p0[r];
#pragma unroll
  for (int r = 0; r < 16; ++r) ps += p1[r];
  ps = swap_sum(ps);
  l_reg = l_reg * alpha + ps;
  PK4(p0, 0, pa0); PK4(p0, 8, pa1); PK4(p1, 0, pa2); PK4(p1, 8, pa3);
}
__device__ __forceinline__ void qkt192(f32x16& p0, f32x16& p1, const char* Ks, const bf16x8 (&qr)[NQR], const char* Qs, int r32, int hi) {
  p0 = f32x16{}; p1 = f32x16{};
#pragma unroll
  for (int d0 = 0; d0 < 12; ++d0) { int cb = (d0 * 16 + hi * 8) * 2;
    bf16x8 b0 = *reinterpret_cast<const bf16x8*>(Ks + AKSWZ(r32, cb));
    bf16x8 b1 = *reinterpret_cast<const bf16x8*>(Ks + AKSWZ(32 + r32, cb));
    bf16x8 qv; if (d0 < NQR) qv = qr[d0 < NQR ? d0 : 0]; else qv = *reinterpret_cast<const bf16x8*>(Qs + (d0 - NQR) * 1024);
    p0 = __builtin_amdgcn_mfma_f32_32x32x16_bf16(b0, qv, p0, 0, 0, 0);
    p1 = __builtin_amdgcn_mfma_f32_32x32x16_bf16(b1, qv, p1, 0, 0, 0); }
}
__device__ __forceinline__ void qkt128(f32x16& p0, f32x16& p1, const char* Ks, const bf16x8 (&qr)[8], int r32, int hi) {
  p0 = f32x16{}; p1 = f32x16{};
#pragma unroll
  for (int d0 = 0; d0 < 8; ++d0) { int cb = (d0 * 16 + hi * 8) * 2;
    bf16x8 b0 = *reinterpret_cast<const bf16x8*>(Ks + KSWZ128(r32, cb));
    bf16x8 b1 = *reinterpret_cast<const bf16x8*>(Ks + KSWZ128(32 + r32, cb));
    p0 = __builtin_amdgcn_mfma_f32_32x32x16_bf16(b0, qr[d0], p0, 0, 0, 0);
    p1 = __builtin_amdgcn_mfma_f32_32x32x16_bf16(b1, qr[d0], p1, 0, 0, 0); }
}
__device__ __forceinline__ int v_st(int k, int c) { const int kk = (k & ~0xC) | ((k & 4) << 1) | ((k & 8) >> 1); return ((kk >> 3) * 4 + (c >> 5)) * 512 + ((kk & 7) * 32 + (c & 31)) * 2; }
__device__ __forceinline__ int v_rd_base(int lane) { return ((lane & 3) << 3) | (((lane >> 2) & 3) << 6) | (((lane >> 4) & 1) << 5) | (((lane >> 5) & 1) << 8); }
constexpr int v_rd_off(int d0, int ks, int half) { return d0 * 512 + ks * 4096 + half * 2048; }
template <int OFF> __device__ __forceinline__ s16x4 tr_read(int vb) {
  s16x4 r; asm volatile("ds_read_b64_tr_b16 %0, %1 offset:%2" : "=&v"(r) : "v"(vb), "i"(OFF) : "memory"); return r;
}
#define PKLH(L, H) (bf16x8){L[0], L[1], L[2], L[3], H[0], H[1], H[2], H[3]}
template <int D0> __device__ __forceinline__ void pv_one(f32x16& od, int vb, bf16x8 pa0, bf16x8 pa1, bf16x8 pa2, bf16x8 pa3) {
  const s16x4 l0 = tr_read<v_rd_off(D0, 0, 0)>(vb), h0 = tr_read<v_rd_off(D0, 0, 1)>(vb), l1 = tr_read<v_rd_off(D0, 1, 0)>(vb), h1 = tr_read<v_rd_off(D0, 1, 1)>(vb);
  const s16x4 l2 = tr_read<v_rd_off(D0, 2, 0)>(vb), h2 = tr_read<v_rd_off(D0, 2, 1)>(vb), l3 = tr_read<v_rd_off(D0, 3, 0)>(vb), h3 = tr_read<v_rd_off(D0, 3, 1)>(vb);
  asm volatile("s_waitcnt lgkmcnt(0)" ::: "memory"); SBAR();
  od = __builtin_amdgcn_mfma_f32_32x32x16_bf16(pa0, PKLH(l0, h0), od, 0, 0, 0);
  od = __builtin_amdgcn_mfma_f32_32x32x16_bf16(pa1, PKLH(l1, h1), od, 0, 0, 0);
  od = __builtin_amdgcn_mfma_f32_32x32x16_bf16(pa2, PKLH(l2, h2), od, 0, 0, 0);
  od = __builtin_amdgcn_mfma_f32_32x32x16_bf16(pa3, PKLH(l3, h3), od, 0, 0, 0);
}
__device__ __forceinline__ void pv_d0(f32x16* o, int vb, bf16x8 pa0, bf16x8 pa1, bf16x8 pa2, bf16x8 pa3) {
  pv_one<0>(o[0], vb, pa0, pa1, pa2, pa3); pv_one<1>(o[1], vb, pa0, pa1, pa2, pa3); pv_one<2>(o[2], vb, pa0, pa1, pa2, pa3); pv_one<3>(o[3], vb, pa0, pa1, pa2, pa3);
}
template <int D0> __device__ __forceinline__ void pvT_one(f32x16& od, int vb, bf16x8 pa0, bf16x8 pa1, bf16x8 pa2, bf16x8 pa3) {
  const s16x4 l0 = tr_read<v_rd_off(D0, 0, 0)>(vb), h0 = tr_read<v_rd_off(D0, 0, 1)>(vb), l1 = tr_read<v_rd_off(D0, 1, 0)>(vb), h1 = tr_read<v_rd_off(D0, 1, 1)>(vb);
  const s16x4 l2 = tr_read<v_rd_off(D0, 2, 0)>(vb), h2 = tr_read<v_rd_off(D0, 2, 1)>(vb), l3 = tr_read<v_rd_off(D0, 3, 0)>(vb), h3 = tr_read<v_rd_off(D0, 3, 1)>(vb);
  asm volatile("s_waitcnt lgkmcnt(0)" ::: "memory"); SBAR();
  od = __builtin_amdgcn_mfma_f32_32x32x16_bf16(PKLH(l0, h0), pa0, od, 0, 0, 0);
  od = __builtin_amdgcn_mfma_f32_32x32x16_bf16(PKLH(l1, h1), pa1, od, 0, 0, 0);
  od = __builtin_amdgcn_mfma_f32_32x32x16_bf16(PKLH(l2, h2), pa2, od, 0, 0, 0);
  od = __builtin_amdgcn_mfma_f32_32x32x16_bf16(PKLH(l3, h3), pa3, od, 0, 0, 0);
}

__device__ __forceinline__ void attn_unit(const bf16_t* __restrict__ Qb, const bf16_t* __restrict__ Kh, const bf16_t* __restrict__ Vh, bf16_t* __restrict__ Ob, int seq, char* lds, int ldsaddr) {
  const int tid = threadIdx.x, wid = tid >> 6, lane = tid & 63, r32 = lane & 31, hi = lane >> 5;
  char* V_lds = lds; char* K_lds = lds + 2 * SHM_V;
  float* ws = (float*)(lds + 2 * SHM_V + 2 * SHM_K) + wid * 64; float* li_l = ws; float* al_l = ws + 32;
  float m_reg = -1e30f, l_reg = 0; f32x16 o[4] = {}; bf16x8 qr[NQR];
  const bf16_t* Qw = Qb + (long)(wid * QBLK + r32) * LDQ + hi * 8;
  char* Qs = lds + SHM_ATTN + wid * ((12 - NQR) * 1024) + lane * 16;
#pragma unroll
  for (int d0 = 0; d0 < NQR; ++d0) qr[d0] = *reinterpret_cast<const bf16x8*>(Qw + d0 * 16);
#pragma unroll
  for (int d0 = NQR; d0 < 12; ++d0) *(bf16x8*)(Qs + (d0 - NQR) * 1024) = *reinterpret_cast<const bf16x8*>(Qw + d0 * 16);
  const int sr = tid >> 4, sc = (tid & 15) * 8, vst0 = v_st(sr, sc), vst1 = v_st(32 + sr, sc);
  unsigned kg0, kg1, kg2; int kl0, kl1, kl2;
  { int p = tid;        int kr = p / 24, kc = (p % 24) * 8; kg0 = (unsigned)(kr * LDK + kc) * 2u; kl0 = AKSWZ(kr, kc * 2);
    p = tid + 512;      kr = p / 24; kc = (p % 24) * 8;     kg1 = (unsigned)(kr * LDK + kc) * 2u; kl1 = AKSWZ(kr, kc * 2);
    p = tid + 1024;     kr = p / 24; kc = (p % 24) * 8;     kg2 = (unsigned)(kr * LDK + kc) * 2u; kl2 = AKSWZ(kr, kc * 2); }
  const unsigned vg0 = (unsigned)(sr * LDV + sc) * 2u, vg1 = (unsigned)((32 + sr) * LDV + sc) * 2u;
  const int vb0 = ldsaddr + v_rd_base(lane);
  bf16x8 vs0, vs1, ks0, ks1, ks2;
#define SLOAD(k0) do { const GAS char* vb_ = uniform_ptr((const char*)Vh + (size_t)(k0) * (LDV * 2)); const GAS char* kb_ = uniform_ptr((const char*)Kh + (size_t)(k0) * (LDK * 2)); \
    vs0 = *(const GAS bf16x8*)(vb_ + vg0); vs1 = *(const GAS bf16x8*)(vb_ + vg1); \
    ks0 = *(const GAS bf16x8*)(kb_ + kg0); ks1 = *(const GAS bf16x8*)(kb_ + kg1); ks2 = *(const GAS bf16x8*)(kb_ + kg2); } while (0)
#define SWRITE(b) do { *(bf16x8*)(V_lds + (b) * SHM_V + vst0) = vs0; *(bf16x8*)(V_lds + (b) * SHM_V + vst1) = vs1; \
    *(bf16x8*)(K_lds + (b) * SHM_K + kl0) = ks0; *(bf16x8*)(K_lds + (b) * SHM_K + kl1) = ks1; *(bf16x8*)(K_lds + (b) * SHM_K + kl2) = ks2; } while (0)
#define SWAIT() asm volatile("s_waitcnt vmcnt(0)" ::: "memory")
#define RESC(a) do { if (__any((a) < 1.f)) { if (hi == 0) al_l[r32] = (a); asm volatile("s_waitcnt lgkmcnt(0)" ::: "memory"); \
    _Pragma("unroll") for (int d = 0; d < 4; ++d) _Pragma("unroll") for (int r = 0; r < 16; ++r) o[d][r] *= al_l[crow(r, hi)]; } } while (0)
  f32x16 pA0, pA1, pB0, pB1; float mnA, mnB, alA, alB; bf16x8 pa0, pa1, pa2, pa3; const int NT = seq / KVBLK;
  __syncthreads();
  SLOAD(0); SWAIT(); SWRITE(0); __syncthreads();
  qkt192(pA0, pA1, K_lds, qr, Qs, r32, hi); partialSM(pA0, pA1, m_reg, mnA, alA);
  SLOAD(KVBLK);
  SWAIT(); SWRITE(1); __syncthreads();
  for (int j = 1; j + 1 < NT; j += 2) {
    SBAR(); qkt192(pB0, pB1, K_lds + SHM_K, qr, Qs, r32, hi);
    finishSM(pA0, pA1, alA, l_reg, pa0, pa1, pa2, pa3); SBAR();
    SLOAD((j + 1) * KVBLK); SBAR();
    pv_d0(o, vb0, pa0, pa1, pa2, pa3); partialSM(pB0, pB1, m_reg, mnB, alB);
    __syncthreads(); SWAIT(); SWRITE(0);
    RESC(alB); __syncthreads();
    SBAR(); qkt192(pA0, pA1, K_lds, qr, Qs, r32, hi);
    finishSM(pB0, pB1, alB, l_reg, pa0, pa1, pa2, pa3); SBAR();
    SLOAD((j + 2) * KVBLK); SBAR();
    pv_d0(o, vb0 + SHM_V, pa0, pa1, pa2, pa3); partialSM(pA0, pA1, m_reg, mnA, alA);
    __syncthreads(); SWAIT(); SWRITE(1);
    RESC(alA); __syncthreads();
  }
  SBAR(); qkt192(pB0, pB1, K_lds + SHM_K, qr, Qs, r32, hi);
  finishSM(pA0, pA1, alA, l_reg, pa0, pa1, pa2, pa3); SBAR();
  pv_d0(o, vb0, pa0, pa1, pa2, pa3); partialSM(pB0, pB1, m_reg, mnB, alB);
  __syncthreads(); RESC(alB);
  finishSM(pB0, pB1, alB, l_reg, pa0, pa1, pa2, pa3); SBAR();
  pv_d0(o, vb0 + SHM_V, pa0, pa1, pa2, pa3);
  if (hi == 0) li_l[r32] = l_reg; asm volatile("s_waitcnt lgkmcnt(0)" ::: "memory");
  float rli[16];
#pragma unroll
  for (int r = 0; r < 16; ++r) rli[r] = __builtin_amdgcn_rcpf(li_l[crow(r, hi)]);
  bf16_t* Ow = Ob + (long)(wid * QBLK) * LDO;
#pragma unroll
  for (int r = 0; r < 16; ++r) { int orow = crow(r, hi);
#pragma unroll
    for (int d0 = 0; d0 < 4; ++d0) Ow[(long)orow * LDO + d0 * 32 + r32] = (bf16_t)(cvtpk(o[d0][r] * rli[r], 0.f) & 0xffffu); }
#undef SLOAD
#undef SWRITE
#undef SWAIT
#undef RESC
}

__device__ __forceinline__ bf16x8 scale8(bf16x8 v, float s) {
  u32x4 w = *reinterpret_cast<u32x4*>(&v), o;
#pragma unroll
  for (int i = 0; i < 4; ++i) o[i] = cvtpk(__uint_as_float(w[i] << 16) * s, __uint_as_float(w[i] & 0xffff0000u) * s);
  return *reinterpret_cast<bf16x8*>(&o);
}
__device__ __forceinline__ s16x4 trr(int addr) { s16x4 r; asm volatile("ds_read_b64_tr_b16 %0, %1" : "=&v"(r) : "v"(addr) : "memory"); return r; }

__device__ __forceinline__ void chunk_kv_unit(const bf16_t* __restrict__ Kc, const bf16_t* __restrict__ Vc, bf16_t* __restrict__ CKf, bf16_t* __restrict__ CKb, float lgf, float lgb, char* lds, int ldsaddr) {
  const int tid = threadIdx.x, wid = tid >> 6, lane = tid & 63, r32 = lane & 31, hi = lane >> 5;
  const int dir = wid >> 2, db = wid & 3, d = 32 * db + r32;
  __syncthreads();
  { const int sr = tid >> 4, sc = (tid & 15) * 8;
#pragma unroll
    for (int i = 0; i < 4; ++i) { const int row = sr + 32 * i;
      *(bf16x8*)(lds + (row >> 6) * 16384 + v_st(row & 63, sc)) = *reinterpret_cast<const bf16x8*>(Vc + (long)row * 1024 + sc); } }
  bf16x8 kb[8];
  int hio = hi; asm volatile("" : "+v"(hio));
  const GAS char* kg = uniform_ptr(Kc); const unsigned kofs = (unsigned)((hio * 8) * 1024 + d) * 2u;
#pragma unroll
  for (int ks = 0; ks < 8; ++ks) { u32x4 w;
#pragma unroll
    for (int i = 0; i < 4; ++i) { const int s0 = ks * 16 + hio * 8 + 2 * i;
      const float k0 = __uint_as_float((unsigned)*(const GAS unsigned short*)(kg + kofs + (ks * 16 + 2 * i) * 2048) << 16), k1 = __uint_as_float((unsigned)*(const GAS unsigned short*)(kg + kofs + (ks * 16 + 2 * i + 1) * 2048) << 16);
      const float z0 = __builtin_amdgcn_exp2f(dir ? lgb * (float)s0 : lgf * (float)(127 - s0)), z1 = __builtin_amdgcn_exp2f(dir ? lgb * (float)(s0 + 1) : lgf * (float)(126 - s0));
      w[i] = cvtpk(k0 * z0, k1 * z1); }
    kb[ks] = *reinterpret_cast<bf16x8*>(&w); }
  __syncthreads();
  f32x16 acc[4] = {};
  const int vb = ldsaddr + v_rd_base(lane);
  pvT_one<0>(acc[0], vb, kb[0], kb[1], kb[2], kb[3]); pvT_one<1>(acc[1], vb, kb[0], kb[1], kb[2], kb[3]); pvT_one<2>(acc[2], vb, kb[0], kb[1], kb[2], kb[3]); pvT_one<3>(acc[3], vb, kb[0], kb[1], kb[2], kb[3]);
  pvT_one<0>(acc[0], vb + 16384, kb[4], kb[5], kb[6], kb[7]); pvT_one<1>(acc[1], vb + 16384, kb[4], kb[5], kb[6], kb[7]); pvT_one<2>(acc[2], vb + 16384, kb[4], kb[5], kb[6], kb[7]); pvT_one<3>(acc[3], vb + 16384, kb[4], kb[5], kb[6], kb[7]);
  bf16_t* CK = dir ? CKb : CKf;
#pragma unroll
  for (int eb = 0; eb < 4; ++eb)
#pragma unroll
    for (int r = 0; r < 16; ++r) CK[(32 * eb + crow(r, hi)) * 128 + d] = (bf16_t)(cvtpk(acc[eb][r], 0.f) & 0xffffu);
}

#ifndef PROBE_COMP
#define PROBE_COMP 0
#endif
__device__ __forceinline__ void ret_out_unit(const bf16_t* __restrict__ Qc, const bf16_t* __restrict__ Kc, const bf16_t* __restrict__ Vc, const bf16_t* __restrict__ Gc,
                                             const bf16_t* __restrict__ STf, const bf16_t* __restrict__ STb, const float* __restrict__ gnw, const float* __restrict__ gnb,
                                             bf16_t* __restrict__ Oc, float lgf, float lgb, char* lds, int ldsaddr, float* dump = nullptr) {
  const int tid = threadIdx.x, ht = tid & 255, wq = (tid >> 6) & 3, lane = tid & 63, r32 = lane & 31, hi = lane >> 5;
  __syncthreads();
  { const int sr = ht >> 4, sc = (ht & 15) * 8;
#pragma unroll
    for (int i = 0; i < 8; ++i) { const int row = sr + 16 * i, tile = row >> 6, key = row & 63;
      *(bf16x8*)(lds + tile * 16384 + KSWZ128(key, sc * 2)) = *reinterpret_cast<const bf16x8*>(Kc + (long)row * 1024 + sc);
      *(bf16x8*)(lds + 32768 + tile * 16384 + v_st(key, sc)) = *reinterpret_cast<const bf16x8*>(Vc + (long)row * 1024 + sc); } }
  const int c = 32 * wq + r32;
  bf16x8 qr[8];
#pragma unroll
  for (int d0 = 0; d0 < 8; ++d0) qr[d0] = *reinterpret_cast<const bf16x8*>(Qc + (long)c * 1024 + d0 * 16 + hi * 8);
  __syncthreads();
  f32x16 pA0, pA1, pB0, pB1;
  qkt128(pA0, pA1, lds, qr, r32, hi); qkt128(pB0, pB1, lds + 16384, qr, r32, hi);
  int cdec = c; asm volatile("" : "+v"(cdec));
#define DEC(P, JB) do { _Pragma("unroll") for (int r = 0; r < 16; ++r) { const int dl = cdec - ((JB) + crow(r, hi)); \
    P[r] *= __builtin_amdgcn_exp2f(dl >= 0 ? lgf * (float)dl : lgb * (float)(-dl)); } } while (0)
  DEC(pA0, 0); DEC(pA1, 32); DEC(pB0, 64); DEC(pB1, 96);
#undef DEC
  bf16x8 xa0, xa1, xa2, xa3, xb0, xb1, xb2, xb3;
  PK4(pA0, 0, xa0); PK4(pA0, 8, xa1); PK4(pA1, 0, xa2); PK4(pA1, 8, xa3);
  PK4(pB0, 0, xb0); PK4(pB0, 8, xb1); PK4(pB1, 0, xb2); PK4(pB1, 8, xb3);
  f32x16 o[4] = {};
  const int vb = ldsaddr + 32768 + v_rd_base(lane);
  if (PROBE_COMP == 0 || (PROBE_COMP & 1)) {
  pvT_one<0>(o[0], vb, xa0, xa1, xa2, xa3); pvT_one<1>(o[1], vb, xa0, xa1, xa2, xa3); pvT_one<2>(o[2], vb, xa0, xa1, xa2, xa3); pvT_one<3>(o[3], vb, xa0, xa1, xa2, xa3);
  pvT_one<0>(o[0], vb + 16384, xb0, xb1, xb2, xb3); pvT_one<1>(o[1], vb + 16384, xb0, xb1, xb2, xb3); pvT_one<2>(o[2], vb + 16384, xb0, xb1, xb2, xb3); pvT_one<3>(o[3], vb + 16384, xb0, xb1, xb2, xb3);
  }
#pragma unroll
  for (int dir = 0; dir < 2; ++dir) {
    if (PROBE_COMP != 0 && !((PROBE_COMP >> (1 + dir)) & 1)) continue;
    const float xi = __builtin_amdgcn_exp2f(dir == 0 ? lgf * (float)(c + 1) : lgb * (float)(128 - c));
    const bf16_t* ST = dir == 0 ? STf : STb;
    bf16x8 qs[8];
#pragma unroll
    for (int d0 = 0; d0 < 8; ++d0) qs[d0] = scale8(qr[d0], xi);
    const GAS char* stb = uniform_ptr(ST); const unsigned so = (unsigned)(r32 * 128 + hi * 8) * 2u;
#pragma unroll
    for (int eb = 0; eb < 4; ++eb) {
      bf16x8 A[8];
      SBAR();
#pragma unroll
      for (int d0 = 0; d0 < 8; ++d0) A[d0] = *(const GAS bf16x8*)(stb + so + (eb * 32 * 128 + d0 * 16) * 2);
#pragma unroll
      for (int d0 = 0; d0 < 8; ++d0) o[eb] = __builtin_amdgcn_mfma_f32_32x32x16_bf16(A[d0], qs[d0], o[eb], 0, 0, 0);
      SBAR();
    }
  }
  if (PROBE_COMP != 0) {
#pragma unroll
    for (int eb = 0; eb < 4; ++eb)
#pragma unroll
      for (int g = 0; g < 4; ++g) *(f32x4*)(dump + (long)c * 1024 + 32 * eb + 8 * g + 4 * hi) = (f32x4){o[eb][4 * g], o[eb][4 * g + 1], o[eb][4 * g + 2], o[eb][4 * g + 3]};
    return; }
  float s = 0.f;
#pragma unroll
  for (int eb = 0; eb < 4; ++eb)
#pragma unroll
    for (int r = 0; r < 16; ++r) s += o[eb][r];
  const float mu = swap_sum(s) * (1.f / 128.f);
  float q = 0.f;
#pragma unroll
  for (int eb = 0; eb < 4; ++eb)
#pragma unroll
    for (int r = 0; r < 16; ++r) { const float d = o[eb][r] - mu; q += d * d; }
  const float rstd = rsqrtf(swap_sum(q) * (1.f / 128.f) + 1e-6f);
#pragma unroll
  for (int eb = 0; eb < 4; ++eb)
#pragma unroll
    for (int g = 0; g < 4; ++g) { const int e0 = 32 * eb + 8 * g + 4 * hi;
      const f32x4 w4 = *(const f32x4*)(gnw + e0), b4 = *(const f32x4*)(gnb + e0);
      const u32x2 gg = *(const u32x2*)(Gc + (long)c * 1024 + e0);
      const float g0 = __uint_as_float(gg.x << 16), g1 = __uint_as_float(gg.x & 0xffff0000u), g2 = __uint_as_float(gg.y << 16), g3 = __uint_as_float(gg.y & 0xffff0000u);
      const float y0 = ((o[eb][4 * g] - mu) * rstd * w4[0] + b4[0]) * g0, y1 = ((o[eb][4 * g + 1] - mu) * rstd * w4[1] + b4[1]) * g1;
      const float y2 = ((o[eb][4 * g + 2] - mu) * rstd * w4[2] + b4[2]) * g2, y3 = ((o[eb][4 * g + 3] - mu) * rstd * w4[3] + b4[3]) * g3;
      u32x2 w; w.x = cvtpk(y0, y1); w.y = cvtpk(y2, y3);
      *(u32x2*)(Oc + (long)c * 2048 + e0) = w; }
}

__device__ __forceinline__ void ret_brute_unit(const bf16_t* __restrict__ Qh, const bf16_t* __restrict__ Kh, const bf16_t* __restrict__ Vh, const bf16_t* __restrict__ Gc,
                                               const float* __restrict__ gnw, const float* __restrict__ gnb, bf16_t* __restrict__ Oc, int t0, float lgf, float lgb, char* lds, const float* dump = nullptr) {
  const int tid = threadIdx.x, qi = tid >> 2, part = tid & 3, t = t0 + qi;
  float q[32], acc[32];
#pragma unroll
  for (int i = 0; i < 32; ++i) { q[i] = __uint_as_float((unsigned)Qh[(long)t * 1024 + part * 32 + i] << 16); acc[i] = 0.f; }
  for (int s0 = 0; s0 < 4096; s0 += 64) {
    { const int rel = s0 < t0 ? 1 : (s0 >= t0 + 128 ? 2 : 0); if (PROBE_COMP != 0 && ((PROBE_COMP >> rel) & 1)) continue; }
    __syncthreads();
    for (int c = tid; c < 64 * 16; c += 512) { const int r = c >> 4, c8 = (c & 15) * 8;
      *(bf16x8*)(lds + (r * 128 + c8) * 2) = *reinterpret_cast<const bf16x8*>(Kh + (long)(s0 + r) * 1024 + c8);
      *(bf16x8*)(lds + 16384 + (r * 128 + c8) * 2) = *reinterpret_cast<const bf16x8*>(Vh + (long)(s0 + r) * 1024 + c8); }
    __syncthreads();
    for (int j = 0; j < 64; ++j) { const int s = s0 + j; float d = 0.f;
      const unsigned short* kr = (const unsigned short*)(lds + (j * 128 + part * 32) * 2); const unsigned short* vr = (const unsigned short*)(lds + 16384 + (j * 128 + part * 32) * 2);
#pragma unroll
      for (int i = 0; i < 32; ++i) d += q[i] * __uint_as_float((unsigned)kr[i] << 16);
      d += __shfl_xor(d, 1); d += __shfl_xor(d, 2);
      const int dl = t - s; const float w = d * __builtin_amdgcn_exp2f(dl >= 0 ? lgf * (float)dl : lgb * (float)(-dl));
#pragma unroll
      for (int i = 0; i < 32; ++i) acc[i] += w * __uint_as_float((unsigned)vr[i] << 16); }
  }
  if (PROBE_COMP != 0) {
#pragma unroll
    for (int i = 0; i < 32; ++i) acc[i] += dump[(long)qi * 1024 + part * 32 + i]; }
  float sm = 0.f;
#pragma unroll
  for (int i = 0; i < 32; ++i) sm += acc[i];
  sm += __shfl_xor(sm, 1); sm += __shfl_xor(sm, 2); const float mu = sm * (1.f / 128.f);
  float qq = 0.f;
#pragma unroll
  for (int i = 0; i < 32; ++i) { const float dd = acc[i] - mu; qq += dd * dd; }
  qq += __shfl_xor(qq, 1); qq += __shfl_xor(qq, 2); const float rstd = rsqrtf(qq * (1.f / 128.f) + 1e-6f);
#pragma unroll
  for (int i = 0; i < 32; ++i) { const int e = part * 32 + i; const float g = __uint_as_float((unsigned)Gc[(long)qi * 1024 + e] << 16);
    Oc[(long)qi * 2048 + e] = (bf16_t)(cvtpk(((acc[i] - mu) * rstd * gnw[e] + gnb[e]) * g, 0.f) & 0xffffu); }
}
#undef SBAR
}


#ifndef PROBE_BRUTE_RET
#define PROBE_BRUTE_RET 0
#endif
#ifndef MK_SPLIT
#define MK_SPLIT 0
#endif
#define LAS __attribute__((address_space(3)))
#define GASX __attribute__((address_space(1)))
typedef unsigned short bf16_t;
typedef unsigned v4u __attribute__((ext_vector_type(4)));
typedef unsigned v2u __attribute__((ext_vector_type(2)));
typedef float f32x4 __attribute__((ext_vector_type(4)));
typedef short bf16x8 __attribute__((ext_vector_type(8)));

constexpr int BATCH = 8, SEQ = 4096, DM = 2048, T = BATCH * SEQ;
constexpr int INC = 5184, INCP = 5376, DFF = 5632, NMODC = 6 * DM;
constexpr int NPH = 11;
constexpr size_t MiB = 1u << 20;
constexpr size_t WS_CTL = 0, CTL_ZERO_BYTES = 2 * MiB;
constexpr size_t OFF_MOD = 0, OFF_SSQQ = 512 * 1024, OFF_SSQKV = 640 * 1024;
constexpr size_t WS_COSR = 2 * MiB, WS_SINR = 10 * MiB, WS_COSM = 18 * MiB, WS_SINM = 22 * MiB;
constexpr size_t WS_WIN = 26 * MiB, WS_WUQ = 47 * MiB, WS_WUKV = 49 * MiB, WS_WO = 51 * MiB, WS_WGU = 59 * MiB, WS_WDN = 103 * MiB;
constexpr size_t WS_H = 128 * MiB;
constexpr size_t WS_QR = 256 * MiB, WS_KR = 320 * MiB, WS_VR = 384 * MiB, WS_GR = 448 * MiB;
constexpr size_t WS_CQ = 512 * MiB, WS_CKV = 544 * MiB;
constexpr size_t WS_QM = 576 * MiB, WS_KB = 672 * MiB, WS_VM = 768 * MiB, WS_OAT = 832 * MiB, WS_END = 896 * MiB;
constexpr size_t WS_CAT = 576 * MiB;
constexpr size_t WS_AFF = 256 * MiB;
static_assert(WS_AFF + (size_t)T * DFF * 2 <= WS_END && WS_CAT + (size_t)T * 2048 * 2 <= WS_VM, "d_ws map");
constexpr int LDS_BAR_OFF = 150528;
constexpr size_t OFF_XBAR = 1536 * 1024;
constexpr int LDS_BYTES = 150528 + 64;

#define LDS_WAIT() asm volatile("s_waitcnt lgkmcnt(0)" ::: "memory")
__device__ __forceinline__ unsigned f2bf(float f) { unsigned u = __builtin_bit_cast(unsigned, f); return (u + 0x7fffu + ((u >> 16) & 1u)) >> 16; }
__device__ __forceinline__ unsigned pk2(float lo, float hi) { return f2bf(lo) | (f2bf(hi) << 16); }
__device__ __forceinline__ unsigned pk2a(float lo, float hi) { return pg8::coarse2(pk2(lo, hi)); }
__device__ __forceinline__ float wave_sum(float v) {
#pragma unroll
    for (int o = 1; o < 64; o <<= 1) v += __shfl_xor(v, o);
    return v;
}
__device__ __forceinline__ int dest_row(int mapid, int n) {
    switch (mapid) {
    case 1: if (n < 2048) { const int j = n & 127; return (n & ~127) + (j < 64 ? 2 * j : 2 * (j - 64) + 1); }
            if (n < 5120) return n;
            { const int j = n - 5120; return 5120 + (j < 32 ? 2 * j : 2 * (j - 32) + 1); }
    case 2: { const int d = n % 192; if (d < 128) return n; const int j = d - 128; return n - d + 128 + (j < 32 ? 2 * j : 2 * (j - 32) + 1); }
    case 3: return (n >> 7) * 256 + (n & 127);
    case 4: return (n >> 7) * 256 + 128 + (n & 127);
    default: return n;
    }
}
__device__ __forceinline__ void transpose_item(const float* __restrict__ W, int K, int N, bf16_t* __restrict__ WT, const float* __restrict__ kscale, int mapid, LAS float* scr, int item, int lane) {
    const int nblk = N / 32, kb = item / nblk, nb = item % nblk, k0 = 64 * kb, n0 = 32 * nb;
#pragma unroll 8
    for (int i = 0; i < 32; ++i) { const int kk = 2 * i + (lane >> 5); float v = W[(size_t)(k0 + kk) * N + n0 + (lane & 31)]; if (kscale) v *= kscale[k0 + kk]; scr[kk * 33 + (lane & 31)] = v; }
    LDS_WAIT(); asm volatile("" ::: "memory");
    const int c = lane & 7;
#pragma unroll
    for (int j = 0; j < 4; ++j) { const int n = (lane >> 3) + 8 * j; const LAS float* s = scr + (8 * c) * 33 + n;
        v4u o; o.x = pk2(s[0 * 33], s[1 * 33]); o.y = pk2(s[2 * 33], s[3 * 33]); o.z = pk2(s[4 * 33], s[5 * 33]); o.w = pk2(s[6 * 33], s[7 * 33]);
        *(v4u*)(WT + (size_t)dest_row(mapid, n0 + n) * K + k0 + 8 * c) = o; }
    LDS_WAIT(); asm volatile("" ::: "memory");
}
__device__ __forceinline__ void norm_row(const float* xrow, const float* __restrict__ w, const float* __restrict__ shift, const float* __restrict__ scale, bf16_t* ob, float* of, int lane) {
    const f32x4* xr = (const f32x4*)xrow + lane;
    f32x4 v[8]; float s = 0.f;
#pragma unroll
    for (int j = 0; j < 8; ++j) { v[j] = xr[64 * j]; s += (v[j].x * v[j].x + v[j].y * v[j].y) + (v[j].z * v[j].z + v[j].w * v[j].w); }
    const float rstd = rsqrtf(wave_sum(s) * (1.f / 2048.f) + 1e-6f);
#pragma unroll
    for (int j = 0; j < 8; ++j) { const int col = 4 * lane + 256 * j; f32x4 y = v[j] * rstd * *(const f32x4*)(w + col);
        if (shift) y = y * (*(const f32x4*)(scale + col) + 1.f) + *(const f32x4*)(shift + col);
        if (ob) { v2u o; o.x = pk2a(y.x, y.y); o.y = pk2a(y.z, y.w); *(v2u*)(ob + col) = o; } else *(f32x4*)(of + col) = y; }
}

#define XB_TMO      128
#define XB_XCNT(j)  (256  + 64 * (j))
#define XB_XSUB(j)  (1280 + 64 * (j))
#define XB_XGEN(j)  (2304 + 64 * (j))
#define XB_TOP      3328
#define XB_TOPGEN   3392
#define XCD_BAR_WORDS 3456
#define XB_SPIN_CAP (1u << 18)

__device__ __forceinline__ unsigned xb_ld(unsigned* p)              { return __hip_atomic_load(p, __ATOMIC_RELAXED, __HIP_MEMORY_SCOPE_AGENT); }
__device__ __forceinline__ unsigned xb_add(unsigned* p, unsigned v) { return __hip_atomic_fetch_add(p, v, __ATOMIC_RELAXED, __HIP_MEMORY_SCOPE_AGENT); }
__device__ __forceinline__ unsigned xb_xcc_id() { return (unsigned)__builtin_amdgcn_s_getreg((3 << 11) | 20) & 0xFu; }
#define XB_SPIN(cond, bar) do { unsigned _sp = 0; while (cond) { __builtin_amdgcn_s_sleep(1); \
    if ((++_sp & 255u) == 0u) { if (xb_ld(&(bar)[XB_TMO])) break; if (_sp > XB_SPIN_CAP) { atomicAdd(&(bar)[XB_TMO], 1u); break; } } } } while (0)

struct XcdBarrier {
    unsigned* bar; unsigned x;
    volatile LAS unsigned* st;
};

__device__ __forceinline__ XcdBarrier xcd_barrier_post(unsigned* bar, volatile LAS unsigned* st) {
    XcdBarrier b; b.bar = bar; b.x = xb_xcc_id(); b.st = st;
    if (threadIdx.x == 0) (void)xb_add(&bar[XB_XCNT(b.x)], 1u);
    return b;
}
__device__ __forceinline__ void xcd_barrier_complete(unsigned* bar, unsigned x, unsigned& nloc, unsigned& nx) {
    const unsigned G = gridDim.x * gridDim.y * gridDim.z;
    unsigned sum, cnt, mine, sp = 0u;
    for (;;) {
        sum = 0u; cnt = 0u; mine = 0u;
#pragma unroll
        for (unsigned j = 0; j < 16; ++j) { const unsigned c = xb_ld(&bar[XB_XCNT(j)]); sum += c; cnt += (c > 0u) ? 1u : 0u; mine = (j == x) ? c : mine; }
        if (sum == G) break;
        __builtin_amdgcn_s_sleep(1);
        if ((++sp & 255u) == 0u) { if (xb_ld(&bar[XB_TMO])) break; if (sp > XB_SPIN_CAP) { atomicAdd(&bar[XB_TMO], 1u); break; } }
    }
    nloc = mine > 0u ? mine : 1u; nx = cnt > 0u ? cnt : 1u;
}

__device__ __forceinline__ void xcd_barrier(const XcdBarrier& b) {
    asm volatile("s_waitcnt vmcnt(0)" ::: "memory");
    __syncthreads();
    if (threadIdx.x == 0) {
        unsigned* bar = b.bar;
        __builtin_amdgcn_s_waitcnt(0);
        unsigned nloc = b.st[0], nx = b.st[1];
        if (nloc == 0u) { xcd_barrier_complete(bar, b.x, nloc, nx); b.st[0] = nloc; b.st[1] = nx; }
        const unsigned old = xb_add(&bar[XB_XSUB(b.x)], 1u);
        const unsigned gen = old / nloc;
        if (old + 1u == (gen + 1u) * nloc) {
            __builtin_amdgcn_fence(__ATOMIC_RELEASE, "agent");
            asm volatile("s_waitcnt vmcnt(0)" ::: "memory");
            const unsigned og = xb_add(&bar[XB_TOP], 1u);
            const unsigned tg = og / nx;
            if (og + 1u == (tg + 1u) * nx) xb_add(&bar[XB_TOPGEN], 1u);
            else XB_SPIN(xb_ld(&bar[XB_TOPGEN]) == tg, bar);
            __builtin_amdgcn_fence(__ATOMIC_ACQUIRE, "agent");
            xb_add(&bar[XB_XGEN(b.x)], 1u);
            asm volatile("s_waitcnt vmcnt(0)" ::: "memory");
        } else {
            XB_SPIN(xb_ld(&bar[XB_XGEN(b.x)]) == gen, bar);
            __builtin_amdgcn_fence(__ATOMIC_ACQUIRE, "agent");
            asm volatile("s_waitcnt vmcnt(0)" ::: "memory");
        }
    }
    __syncthreads();
}

struct Args { const float* in[21]; float* out; unsigned char* ws; float inv_r[64]; float inv_m[32]; int ph_lo, ph_hi; };
static_assert(sizeof(Args) == 21 * 8 + 16 + 96 * 4 + 8, "Args has no padding");

__global__ void __launch_bounds__(512, 2) mk_fwd(Args a) {
    extern __shared__ __attribute__((aligned(16))) unsigned char smem[];
    cg::grid_group grid = cg::this_grid();
    const int tid = threadIdx.x, lane = tid & 63, wave = __builtin_amdgcn_readfirstlane(tid >> 6);
    const int G = gridDim.x, bx = blockIdx.x, vcu = (G % 8 == 0) ? (bx % 8) * (G / 8) + bx / 8 : bx;
    const int gw = vcu * 8 + wave, NGW = G * 8;
    LAS unsigned char* lds3 = (LAS unsigned char*)smem; char* ldsg = (char*)smem; const int ldsaddr = (int)(unsigned)(uintptr_t)lds3;
    float* out = a.out;
#define WSB() size_t wz_ = 0; asm volatile("" : "+s"(wz_)); unsigned char* ws = a.ws + wz_
#define INP(name, k) const float* name = a.in[k] + wz_
#define WSF(name, off) float* name = (float*)(ws + (off))
#define WSH(name, off) bf16_t* name = (bf16_t*)(ws + (off))
    const int lo = a.ph_lo, hi = a.ph_hi;
    if (tid < 16) ((LAS unsigned*)(lds3 + LDS_BAR_OFF))[tid] = 0u;
    __syncthreads();
    XcdBarrier xbar = xcd_barrier_post((unsigned*)(a.ws + WS_CTL + OFF_XBAR), (volatile LAS unsigned*)(lds3 + LDS_BAR_OFF));
#ifndef PH_MASK
#define PH_MASK 0x7ff
#endif
#define IN(k) (((PH_MASK >> (k)) & 1) && lo <= (k) && (k) < hi)
#define SEAM(k) do { if (IN(k) && IN((k) + 1)) { asm volatile("s_waitcnt vmcnt(0) lgkmcnt(0)" ::: "memory"); grid.sync(); \
    __builtin_amdgcn_fence(__ATOMIC_ACQUIRE, "agent"); asm volatile("s_waitcnt vmcnt(0)" ::: "memory"); } } while (0)
#define SEAMX(k) do { if (IN(k) && IN((k) + 1)) xcd_barrier(xbar); } while (0)

    if (IN(0)) {
        WSB(); WSF(mod, WS_CTL + OFF_MOD); WSF(cosr, WS_COSR); WSF(sinr, WS_SINR); WSF(cosm, WS_COSM); WSF(sinm, WS_SINM);
        WSH(Win, WS_WIN); WSH(Wuq, WS_WUQ); WSH(Wukv, WS_WUKV); WSH(Wo, WS_WO); WSH(Wgu, WS_WGU); WSH(Wdn, WS_WDN);
        INP(cin, 1); INP(ada_w, 3); INP(ada_b, 4); INP(w_in, 6); INP(mla_q_norm_w, 10); INP(w_uq, 11); INP(mla_kv_norm_w, 12); INP(w_ukv, 13); INP(w_o, 15); INP(w_gate, 17); INP(w_up, 18); INP(w_down, 19);
        const int* positions = (const int*)a.in[2] + wz_;
        {
            LAS float* cs = (LAS float*)lds3;
            for (int i = tid; i < 8 * 2048; i += 512) { const int b = i >> 11, k = i & 2047; const float v = cin[i]; cs[k * 8 + b] = v / (1.f + __expf(-v)); }
            __syncthreads();
            for (int task = gw; task < 192 * 16; task += NGW) { const int cb = task % 192, ks = task / 192, col = cb * 64 + lane;
                float acc[8]; const float bias = ks == 0 ? ada_b[col] : 0.f;
#pragma unroll
                for (int b = 0; b < 8; ++b) acc[b] = bias;
                const float* wp = ada_w + (size_t)(ks * 128) * NMODC + col;
                for (int k8 = 0; k8 < 128; k8 += 8) { float wv[8];
#pragma unroll
                    for (int i = 0; i < 8; ++i) wv[i] = wp[(size_t)(k8 + i) * NMODC];
#pragma unroll
                    for (int i = 0; i < 8; ++i) { const LAS f32x4* c4 = (const LAS f32x4*)(cs + (ks * 128 + k8 + i) * 8); const f32x4 c0 = c4[0], c1 = c4[1];
                        acc[0] += c0.x * wv[i]; acc[1] += c0.y * wv[i]; acc[2] += c0.z * wv[i]; acc[3] += c0.w * wv[i]; acc[4] += c1.x * wv[i]; acc[5] += c1.y * wv[i]; acc[6] += c1.z * wv[i]; acc[7] += c1.w * wv[i]; } }
#pragma unroll
                for (int b = 0; b < 8; ++b) atomicAdd(mod + (size_t)b * NMODC + col, acc[b]); }
            __syncthreads();
        }
        {
            LAS float* scr = (LAS float*)(lds3 + wave * 16384);
            constexpr int I_IN = 32 * (INC / 32), I_UQ = 8 * 48, I_UKV = 8 * 64, I_O = 32 * 64, I_G = 32 * (DFF / 32), I_D = (DFF / 64) * 64;
            constexpr int NITEMS = I_IN + I_UQ + I_UKV + I_O + 2 * I_G + I_D;
            for (int it = gw; it < NITEMS; it += NGW) { int r = it;
                if (r < I_IN) { transpose_item(w_in, 2048, INC, Win, nullptr, 1, scr, r, lane); continue; } r -= I_IN;
                if (r < I_UQ) { transpose_item(w_uq, 512, 1536, Wuq, mla_q_norm_w, 2, scr, r, lane); continue; } r -= I_UQ;
                if (r < I_UKV) { transpose_item(w_ukv, 512, 2048, Wukv, mla_kv_norm_w, 0, scr, r, lane); continue; } r -= I_UKV;
                if (r < I_O) { transpose_item(w_o, 2048, 2048, Wo, nullptr, 0, scr, r, lane); continue; } r -= I_O;
                if (r < I_G) { transpose_item(w_gate, 2048, DFF, Wgu, nullptr, 3, scr, r, lane); continue; } r -= I_G;
                if (r < I_G) { transpose_item(w_up, 2048, DFF, Wgu, nullptr, 4, scr, r, lane); continue; } r -= I_G;
                transpose_item(w_down, DFF, 2048, Wdn, nullptr, 0, scr, r, lane); }
            for (int i = bx * 512 + tid; i < (INCP - INC) * 2048 / 8; i += G * 512) *(v4u*)(Win + (size_t)INC * 2048 + (size_t)i * 8) = (v4u){0u, 0u, 0u, 0u};
        }
        {
            for (int i = bx * 512 + tid; i < T * 96; i += G * 512) { const int t = i / 96, j = i % 96; const float pos = (float)positions[t];
                const float inv = j < 64 ? a.inv_r[j] : a.inv_m[j - 64]; const float ang = pos * inv;
                double rev = (double)ang * 0.15915494309189535; rev -= __builtin_rint(rev);
                const double qd = __builtin_rint(rev * 4.0); const double y = (rev - qd * 0.25) * 6.283185307179586; const double y2 = y * y;
                const double sy = y * (1.0 + y2 * (-1.0 / 6 + y2 * (1.0 / 120 + y2 * (-1.0 / 5040 + y2 * (1.0 / 362880 + y2 * (-1.0 / 39916800 + y2 * (1.0 / 6227020800.0)))))));
                const double cy = 1.0 + y2 * (-0.5 + y2 * (1.0 / 24 + y2 * (-1.0 / 720 + y2 * (1.0 / 40320 + y2 * (-1.0 / 3628800 + y2 * (1.0 / 479001600.0 + y2 * (-1.0 / 87178291200.0)))))));
                const int qi = (int)qd & 3;
                const float cv = (float)(qi == 0 ? cy : qi == 1 ? -sy : qi == 2 ? -cy : sy), sv = (float)(qi == 0 ? sy : qi == 1 ? cy : qi == 2 ? -sy : -cy);
                if (j < 64) { cosr[(size_t)t * 64 + j] = cv; sinr[(size_t)t * 64 + j] = sv; } else { cosm[(size_t)t * 32 + j - 64] = cv; sinm[(size_t)t * 32 + j - 64] = sv; } }
        }
    }
    SEAM(0);
    if (IN(1)) { WSB(); WSF(mod, WS_CTL + OFF_MOD); WSH(H, WS_H); INP(x, 0); INP(norm1_w, 5);
        for (int m = gw; m < T; m += NGW) { const int b = m >> 12; norm_row(x + (size_t)m * DM, norm1_w, mod + (size_t)b * NMODC, mod + (size_t)b * NMODC + DM, H + (size_t)m * DM, nullptr, lane); } }
    SEAMX(1);
    if (IN(2)) {
        WSB(); WSH(H, WS_H); WSH(Win, WS_WIN); WSH(Qr, WS_QR); WSH(Kr, WS_KR); WSH(Vr, WS_VR); WSH(Gr, WS_GR); WSH(CQ, WS_CQ); WSH(CKV, WS_CKV); WSH(Kbuf, WS_KB);
        WSF(cosr, WS_COSR); WSF(sinr, WS_SINR); WSF(cosm, WS_COSM); WSF(sinm, WS_SINM); WSF(ssq_q, WS_CTL + OFF_SSQQ); WSF(ssq_kv, WS_CTL + OFF_SSQKV);
        pg8::Gemm g{H, Win, T, INCP, DM}; pg8::StaticOrder S; S.init(T, INCP, G, bx);
        pg8::EpiIn E{Qr, Kr, Vr, Gr, CQ, CKV, Kbuf, cosr, sinr, cosm, sinm, ssq_q, ssq_kv};
        pg8::gemm_phase<pg8::EpiIn, pg8::StaticOrder, true, true>(lds3, g, S, E);
    }
    SEAMX(2);
    if (IN(3)) {
        WSB(); WSH(CQ, WS_CQ); WSH(CKV, WS_CKV); WSH(Wuq, WS_WUQ); WSH(Wukv, WS_WUKV); WSH(Qm, WS_QM); WSH(Kbuf, WS_KB); WSH(Vm, WS_VM); WSH(Kr, WS_KR); WSH(Vr, WS_VR); WSH(CK, WS_H);
        WSF(cosm, WS_COSM); WSF(sinm, WS_SINM); WSF(ssq_q, WS_CTL + OFF_SSQQ); WSF(ssq_kv, WS_CTL + OFF_SSQKV); INP(ret_decay, 7);
        { pg8::Gemm g{CQ, Wuq, T, 1536, 512}; pg8::StaticOrder S; S.init(T, 1536, G, bx); pg8::EpiUpQ E{ssq_q, Qm, cosm, sinm};
          pg8::gemm_phase<pg8::EpiUpQ, pg8::StaticOrder, true, true>(lds3, g, S, E); }
        { pg8::Gemm g{CKV, Wukv, T, 2048, 512}; pg8::StaticOrder S; S.init(T, 2048, G, bx); pg8::EpiUpKV E{ssq_kv, Kbuf, Vm};
          pg8::gemm_phase<pg8::EpiUpKV, pg8::StaticOrder, true, true>(lds3, g, S, E); }
        for (int u = vcu; u < 2048; u += G) { const int n = u & 31, h = (u >> 5) & 7, b = u >> 8; const size_t t0 = (size_t)b * SEQ + n * 128;
            const float lgf = -__expf(ret_decay[h]) * 1.4426950408889634f, lgb = -__expf(ret_decay[8 + h]) * 1.4426950408889634f;
            att::chunk_kv_unit(Kr + t0 * 1024 + h * 128, Vr + t0 * 1024 + h * 128, CK + ((size_t)(b * 8 + h) * 32 + n) * 16384, CK + ((size_t)(64 + b * 8 + h) * 32 + n) * 16384, lgf, lgb, ldsg, ldsaddr); }
        __syncthreads();
    }
    SEAMX(3);
    if (IN(4)) {
        WSB(); WSH(Qm, WS_QM); WSH(Kbuf, WS_KB); WSH(Vm, WS_VM); WSH(Oat, WS_OAT); WSH(CK, WS_H); INP(ret_decay, 7);
        for (int u = vcu; u < 1024; u += G) { const int qb = u & 15, h = (u >> 4) & 7, b = u >> 7; const size_t r0 = (size_t)b * SEQ;
            att::attn_unit(Qm + (r0 + qb * 256) * 1536 + h * 192, Kbuf + r0 * 1536 + h * 192, Vm + r0 * 1024 + h * 128, Oat + (r0 + qb * 256) * 1024 + h * 128, SEQ, ldsg, ldsaddr); }
#ifndef NO_SCAN
        for (int idx = bx * 512 + tid; idx < 2 * 64 * 2048; idx += G * 512) { const int dir = idx >> 17, bh = (idx >> 11) & 63, e8 = idx & 2047, h = bh & 7;
            const float cd = __builtin_amdgcn_exp2f(-__expf(ret_decay[dir * 8 + h]) * 1.4426950408889634f * 128.f);
            bf16_t* base = CK + ((size_t)(dir * 64 + bh) * 32) * 16384 + e8 * 8; float st[8];
#pragma unroll
            for (int i = 0; i < 8; ++i) st[i] = 0.f;
            for (int s8 = 0; s8 < 32; s8 += 8) { v4u kv[8];
#pragma unroll
                for (int i = 0; i < 8; ++i) { const int m = dir ? 31 - (s8 + i) : s8 + i; kv[i] = *(const v4u*)(base + (size_t)m * 16384); }
#pragma unroll
                for (int i = 0; i < 8; ++i) { const int m = dir ? 31 - (s8 + i) : s8 + i; v4u o;
                    o.x = pk2a(st[0], st[1]); o.y = pk2a(st[2], st[3]); o.z = pk2a(st[4], st[5]); o.w = pk2a(st[6], st[7]);
                    *(v4u*)(base + (size_t)m * 16384) = o;
#pragma unroll
                    for (int q = 0; q < 4; ++q) { const unsigned w = kv[i][q]; st[2 * q] = st[2 * q] * cd + __uint_as_float(w << 16); st[2 * q + 1] = st[2 * q + 1] * cd + __uint_as_float(w & 0xffff0000u); } } }
        }
#endif
    }
    SEAMX(4);
    if (IN(5)) {
        WSB(); WSH(Qr, WS_QR); WSH(Kr, WS_KR); WSH(Vr, WS_VR); WSH(Gr, WS_GR); WSH(CK, WS_H); WSH(Cat, WS_CAT); WSH(Oat, WS_OAT); INP(ret_decay, 7); INP(ret_gn_w, 8); INP(ret_gn_b, 9); INP(mla_out_w, 14);
#if PROBE_BRUTE_RET
        float* dumpb = (float*)(ws + 704 * MiB);
        for (int up = vcu; up < 1024; up += G) {
            if (PROBE_COMP != 0) { const int u = up * 2 + (wave >> 2); const int n = u & 31, h = (u >> 5) & 7, b = u >> 8; const size_t t0 = (size_t)b * SEQ + n * 128;
                const float lgf = -__expf(ret_decay[h]) * 1.4426950408889634f, lgb = -__expf(ret_decay[8 + h]) * 1.4426950408889634f; const int hf = wave >> 2;
                att::ret_out_unit(Qr + t0 * 1024 + h * 128, Kr + t0 * 1024 + h * 128, Vr + t0 * 1024 + h * 128, Gr + t0 * 1024 + h * 128,
                                  CK + ((size_t)(b * 8 + h) * 32 + n) * 16384, CK + ((size_t)(64 + b * 8 + h) * 32 + n) * 16384, ret_gn_w + h * 128, ret_gn_b + h * 128,
                                  Cat + t0 * 2048 + h * 128, lgf, lgb, ldsg + hf * 65536, ldsaddr + hf * 65536, dumpb + t0 * 1024 + h * 128);
                __threadfence(); __syncthreads(); }
            for (int k2 = 0; k2 < 2; ++k2) { const int u = up * 2 + k2; const int n = u & 31, h = (u >> 5) & 7, b = u >> 8; const size_t r0 = (size_t)b * SEQ, t0 = r0 + n * 128;
                const float lgf = -__expf(ret_decay[h]) * 1.4426950408889634f, lgb = -__expf(ret_decay[8 + h]) * 1.4426950408889634f;
                att::ret_brute_unit(Qr + r0 * 1024 + h * 128, Kr + r0 * 1024 + h * 128, Vr + r0 * 1024 + h * 128, Gr + t0 * 1024 + h * 128, ret_gn_w + h * 128, ret_gn_b + h * 128, Cat + t0 * 2048 + h * 128, n * 128, lgf, lgb, ldsg, dumpb + t0 * 1024 + h * 128); } }
        __syncthreads();
        for (int up = vcu; up < 0; up += G) { const int u = up * 2 + (wave >> 2);
#else
        for (int up = vcu; up < 1024; up += G) { const int u = up * 2 + (wave >> 2);
#endif
            const int n = u & 31, h = (u >> 5) & 7, b = u >> 8; const size_t t0 = (size_t)b * SEQ + n * 128;
            const float lgf = -__expf(ret_decay[h]) * 1.4426950408889634f, lgb = -__expf(ret_decay[8 + h]) * 1.4426950408889634f; const int hf = wave >> 2;
            att::ret_out_unit(Qr + t0 * 1024 + h * 128, Kr + t0 * 1024 + h * 128, Vr + t0 * 1024 + h * 128, Gr + t0 * 1024 + h * 128,
                              CK + ((size_t)(b * 8 + h) * 32 + n) * 16384, CK + ((size_t)(64 + b * 8 + h) * 32 + n) * 16384, ret_gn_w + h * 128, ret_gn_b + h * 128,
                              Cat + t0 * 2048 + h * 128, lgf, lgb, ldsg + hf * 65536, ldsaddr + hf * 65536); }
        for (int m = gw; m < T; m += NGW) {
            const bf16_t* orow = Oat + (size_t)m * 1024; float v[16]; float s = 0.f;
#pragma unroll
            for (int j = 0; j < 2; ++j) { const v4u w = *(const v4u*)(orow + lane * 8 + 512 * j);
#pragma unroll
                for (int q = 0; q < 4; ++q) { v[j * 8 + 2 * q] = __uint_as_float(w[q] << 16); v[j * 8 + 2 * q + 1] = __uint_as_float(w[q] & 0xffff0000u); } }
#pragma unroll
            for (int i = 0; i < 16; ++i) s += v[i] * v[i];
            const float rstd = rsqrtf(wave_sum(s) * (1.f / 1024.f) + 1e-6f);
#pragma unroll
            for (int j = 0; j < 2; ++j) { const int col = lane * 8 + 512 * j; const f32x4 w0 = *(const f32x4*)(mla_out_w + col), w1 = *(const f32x4*)(mla_out_w + col + 4); v4u o;
                o.x = pk2a(v[j * 8 + 0] * rstd * w0.x, v[j * 8 + 1] * rstd * w0.y); o.y = pk2a(v[j * 8 + 2] * rstd * w0.z, v[j * 8 + 3] * rstd * w0.w);
                o.z = pk2a(v[j * 8 + 4] * rstd * w1.x, v[j * 8 + 5] * rstd * w1.y); o.w = pk2a(v[j * 8 + 6] * rstd * w1.z, v[j * 8 + 7] * rstd * w1.w);
                *(v4u*)(Cat + (size_t)m * 2048 + 1024 + col) = o; } }
        __syncthreads();
    }
    SEAMX(5);
    if (IN(6)) {
        WSB(); WSH(Cat, WS_CAT); WSH(Wo, WS_WO); WSF(mod, WS_CTL + OFF_MOD); INP(x, 0);
        pg8::Gemm g{Cat, Wo, T, 2048, 2048}; pg8::StaticOrder S; S.init(T, 2048, G, bx); pg8::EpiGateRes E{x, mod + 2 * DM, out};
        pg8::gemm_phase<pg8::EpiGateRes, pg8::StaticOrder, true, true>(lds3, g, S, E);
    }
    SEAMX(6);
    if (IN(7)) { WSB(); WSF(mod, WS_CTL + OFF_MOD); WSH(H, WS_H); INP(norm2_w, 16);
        for (int m = gw; m < T; m += NGW) { const int b = m >> 12; norm_row(out + (size_t)m * DM, norm2_w, mod + (size_t)b * NMODC + 3 * DM, mod + (size_t)b * NMODC + 4 * DM, H + (size_t)m * DM, nullptr, lane); } }
    SEAMX(7);
    if (IN(8)) {
        WSB(); WSH(H, WS_H); WSH(Wgu, WS_WGU); WSH(Aff, WS_AFF);
        pg8::Gemm g{H, Wgu, T, 2 * DFF, DM}; pg8::StaticOrder S; S.init(T, 2 * DFF, G, bx); pg8::EpiGU E{Aff};
        pg8::gemm_phase<pg8::EpiGU, pg8::StaticOrder, true, true>(lds3, g, S, E);
    }
    SEAMX(8);
    if (IN(9)) {
        WSB(); WSH(Aff, WS_AFF); WSH(Wdn, WS_WDN); WSF(mod, WS_CTL + OFF_MOD);
        pg8::Gemm g{Aff, Wdn, T, 2048, DFF}; pg8::StaticOrder S; S.init(T, 2048, G, bx); pg8::EpiGateRes E{out, mod + 5 * DM, out};
        pg8::gemm_phase<pg8::EpiGateRes, pg8::StaticOrder, true, true>(lds3, g, S, E);
    }
    SEAMX(9);
    if (IN(10)) { WSB(); (void)ws; INP(final_norm_w, 20);
        for (int m = gw; m < T; m += NGW) norm_row(out + (size_t)m * DM, final_norm_w, nullptr, nullptr, nullptr, out + (size_t)m * DM, lane); }
#undef IN
#undef SEAM
}

extern "C" void kernel_launch(void* const* d_in, const int* in_sizes, int n_in, void* d_out, int out_size, void* d_ws, size_t ws_size, hipStream_t stream) {
    static int grid = 0;
    if (grid == 0) {
        if (n_in != 21 || in_sizes[0] != T * DM || out_size != T * DM || ws_size < WS_END) { fprintf(stderr, "kernel_launch: shape/workspace mismatch (n_in %d, ws %zu < %zu)\n", n_in, ws_size, (size_t)WS_END); grid = -1; return; }
        int dev = 0, cus = 0, per_cu = 0;
        (void)hipGetDevice(&dev); (void)hipDeviceGetAttribute(&cus, hipDeviceAttributeMultiprocessorCount, dev);
        if (hipFuncSetAttribute((const void*)mk_fwd, hipFuncAttributeMaxDynamicSharedMemorySize, LDS_BYTES) != hipSuccess) { fprintf(stderr, "kernel_launch: hipFuncSetAttribute failed\n"); grid = -1; return; }
        if (hipOccupancyMaxActiveBlocksPerMultiprocessor(&per_cu, (const void*)mk_fwd, 512, LDS_BYTES) != hipSuccess || per_cu < 1) { fprintf(stderr, "kernel_launch: occupancy query gave %d\n", per_cu); per_cu = 1; }
        (void)hipGetLastError();
        grid = cus * per_cu;
    }
    if (grid < 0) return;
    (void)hipMemsetAsync((char*)d_ws + WS_CTL, 0, CTL_ZERO_BYTES, stream);
    Args a{};
    for (int i = 0; i < 21; ++i) a.in[i] = (const float*)d_in[i];
    a.out = (float*)d_out; a.ws = (unsigned char*)d_ws;
    for (int i = 0; i < 64; ++i) a.inv_r[i] = powf(10000.0f, -((float)(2 * i)) / 128.0f);
    for (int i = 0; i < 32; ++i) a.inv_m[i] = powf(10000.0f, -((float)(2 * i)) / 64.0f);
#if MK_SPLIT
    for (int p = 0; p < NPH; ++p) { a.ph_lo = p; a.ph_hi = p + 1; hipLaunchKernelGGL(mk_fwd, dim3(grid), dim3(512), LDS_BYTES, stream, a); }
#else
    a.ph_lo = 0; a.ph_hi = NPH;
    void* args[] = {&a};
    hipError_t e = hipLaunchCooperativeKernel((const void*)mk_fwd, dim3(grid), dim3(512), args, LDS_BYTES, stream);
    if (e != hipSuccess) fprintf(stderr, "kernel_launch: cooperative launch failed: %s (grid %d)\n", hipGetErrorString(e), grid);
#endif
}
```

```cpp
#include <hip/hip_runtime.h>
#include <hip/hip_cooperative_groups.h>
#include <cstdio>
#include <cstdint>
#include <cmath>
namespace cg = cooperative_groups;
namespace pg8 {
#define PG8_LAS __attribute__((address_space(3)))
typedef unsigned short bf16_t;
typedef short bf16x8 __attribute__((ext_vector_type(8)));
typedef float f32x4 __attribute__((ext_vector_type(4)));
typedef unsigned u32x4 __attribute__((ext_vector_type(4)));
constexpr int BM = 256, BK = 64, HALF = 128, HTB = HALF * BK * 2  , STAGE_BYTES = 8 * HTB, NXCD = 8, WGM = 8;

__host__ __device__ __forceinline__ int lds_byte(int r, int c) { const int st = (r >> 4) * 2 + (c >> 5), rr = r & 15, cc = c & 31, ob = rr * 64 + cc * 2; return st * 1024 + (ob ^ (((ob >> 9) & 1) << 5)); }
__host__ __device__ __forceinline__ void stage_rc(int b, int& R, int& C) { const int st = b / 1024, sb = b % 1024, swz = sb ^ (((sb >> 9) & 1) << 5); R = (st >> 1) * 16 + swz / 64; C = (st & 1) * 32 + (swz % 64) / 2; }
__host__ __device__ __forceinline__ int perm32(int rho) { const int n = rho >> 4, i = rho & 15; return 8 * (i >> 2) + 4 * n + (i & 3); }

struct Unit { int pm, pn; };
struct Gemm { const bf16_t* A; const bf16_t* Bt; int M, N, K; };

struct StaticOrder {
    int nM, nN, nwg, G, c;
    __host__ __device__ void init(int M, int N, int G_, int c_) { nM = M / BM; nN = N / BM; nwg = nM * nN; G = G_; c = c_; }
    __host__ __device__ bool next(int i, Unit& u) const {
        const long L = (long)i * G + c; if (L >= nwg) return false;
        int wgid = (int)L; { const int q = nwg / NXCD, r = nwg % NXCD, xcd = wgid % NXCD, off = wgid / NXCD; wgid = (xcd < r ? xcd * (q + 1) : r * (q + 1) + (xcd - r) * q) + off; }
        const int nig = WGM * nN, gid = wgid / nig, fm = gid * WGM, gsz = (nM - fm) < WGM ? (nM - fm) : WGM;
        u.pm = fm + ((wgid % nig) % gsz); u.pn = (wgid % nig) / gsz; return true;
    }
    __device__ __forceinline__ void a_ready(const Unit&) const {}
    __device__ __forceinline__ void done(const Unit&) const {}
};

#ifndef PROBE_COARSE_ACT
#define PROBE_COARSE_ACT 0
#endif
__device__ __forceinline__ unsigned coarse2(unsigned w) { return PROBE_COARSE_ACT ? ((w + ((w >> 1) & 0x00010001u)) & 0xfffefffeu) : w; }
__device__ __forceinline__ unsigned cvt_pk_bf16(float lo, float hi) { unsigned r; asm volatile("v_cvt_pk_bf16_f32 %0, %1, %2" : "=v"(r) : "v"(lo), "v"(hi)); return coarse2(r); }
typedef float f32x2 __attribute__((ext_vector_type(2)));

typedef unsigned u32x2 __attribute__((ext_vector_type(2)));
__device__ __forceinline__ float silu_f(float v) { return v * __builtin_amdgcn_rcpf(1.f + __builtin_amdgcn_exp2f(v * -1.4426950408889634f)); }
__device__ __forceinline__ u32x4 pack8(f32x4 a, f32x4 b) { u32x4 w; w.x = cvt_pk_bf16(a[0], a[1]); w.y = cvt_pk_bf16(a[2], a[3]); w.z = cvt_pk_bf16(b[0], b[1]); w.w = cvt_pk_bf16(b[2], b[3]); return w; }
__device__ __forceinline__ void rope8(f32x4& a, f32x4& b, const f32x4 c, const f32x4 s) {
    float t1, t2;
    t1 = a[0]; t2 = a[1]; a[0] = t1 * c[0] - t2 * s[0]; a[1] = t2 * c[0] + t1 * s[0];
    t1 = a[2]; t2 = a[3]; a[2] = t1 * c[1] - t2 * s[1]; a[3] = t2 * c[1] + t1 * s[1];
    t1 = b[0]; t2 = b[1]; b[0] = t1 * c[2] - t2 * s[2]; b[1] = t2 * c[2] + t1 * s[2];
    t1 = b[2]; t2 = b[3]; b[2] = t1 * c[3] - t2 * s[3]; b[3] = t2 * c[3] + t1 * s[3];
}
constexpr float NORM_EPS = 1e-6f;

struct EpiIn {
    static constexpr bool PERM = true, AFTER_DRAIN = false;
    bf16_t *Qr, *Kr, *Vr, *Gr, *CQ, *CKV, *Kbuf; const float *cosr, *sinr, *cosm, *sinm; float *ssq_q, *ssq_kv;
    __device__ __forceinline__ void operator()(const f32x4 (&acc)[2][2][4][2], const Unit& u, int wr, int wc, int fr, int fq) const {
        const int pn = u.pn, row0 = u.pm * BM + wr * 64 + fr, cl = wc * 32 + 8 * fq;
        if (pn < 8) {
            bf16_t* O = pn < 4 ? Qr : Kr; const float sc = pn < 4 ? 1.f : 0.08838834764831845f; const int colt = (pn & 3) * 256 + cl;
#pragma unroll
            for (int ai = 0; ai < 2; ++ai)
#pragma unroll
                for (int m = 0; m < 4; ++m) { const int row = row0 + ai * HALF + m * 16;
                    const f32x4 c4 = *(const f32x4*)(cosr + (size_t)row * 64 + (cl >> 1)), s4 = *(const f32x4*)(sinr + (size_t)row * 64 + (cl >> 1));
#pragma unroll
                    for (int bj = 0; bj < 2; ++bj) { f32x4 a = acc[ai][bj][m][0], b = acc[ai][bj][m][1]; rope8(a, b, c4, s4); a = a * sc; b = b * sc;
                        *(u32x4*)(O + (size_t)row * 1024 + colt + bj * HALF) = pack8(a, b); } }
        } else if (pn < 16) {
            const bool isg = pn >= 12; bf16_t* O = isg ? Gr : Vr; const int colt = (pn & 3) * 256 + cl;
#pragma unroll
            for (int ai = 0; ai < 2; ++ai)
#pragma unroll
                for (int m = 0; m < 4; ++m) { const int row = row0 + ai * HALF + m * 16;
#pragma unroll
                    for (int bj = 0; bj < 2; ++bj) { f32x4 a = acc[ai][bj][m][0], b = acc[ai][bj][m][1];
                        if (isg) {
#pragma unroll
                            for (int i = 0; i < 4; ++i) { a[i] = silu_f(a[i]); b[i] = silu_f(b[i]); } }
                        *(u32x4*)(O + (size_t)row * 1024 + colt + bj * HALF) = pack8(a, b); } }
        } else if (pn < 20) {
            bf16_t* O = pn < 18 ? CQ : CKV; float* sq = pn < 18 ? ssq_q : ssq_kv; const int colt = (pn & 1) * 256 + cl;
#pragma unroll
            for (int ai = 0; ai < 2; ++ai)
#pragma unroll
                for (int m = 0; m < 4; ++m) { const int row = row0 + ai * HALF + m * 16; float s = 0.f;
#pragma unroll
                    for (int bj = 0; bj < 2; ++bj) { const f32x4 a = acc[ai][bj][m][0], b = acc[ai][bj][m][1];
                        s += (a[0] * a[0] + a[1] * a[1]) + (a[2] * a[2] + a[3] * a[3]) + (b[0] * b[0] + b[1] * b[1]) + (b[2] * b[2] + b[3] * b[3]);
                        *(u32x4*)(O + (size_t)row * 512 + colt + bj * HALF) = pack8(a, b); }
                    s += __shfl_xor(s, 16); s += __shfl_xor(s, 32);
                    if (fq == 0) atomicAdd(sq + row, s); }
        } else {
            if (wc < 2) {
#pragma unroll
                for (int ai = 0; ai < 2; ++ai)
#pragma unroll
                    for (int m = 0; m < 4; ++m) { const int row = row0 + ai * HALF + m * 16;
                        const f32x4 c4 = *(const f32x4*)(cosm + (size_t)row * 32 + (cl >> 1)), s4 = *(const f32x4*)(sinm + (size_t)row * 32 + (cl >> 1));
                        f32x4 a = acc[ai][0][m][0], b = acc[ai][0][m][1]; rope8(a, b, c4, s4); const u32x4 w = pack8(a, b);
#pragma unroll
                        for (int h = 0; h < 8; ++h) *(u32x4*)(Kbuf + (size_t)row * 1536 + h * 192 + 128 + cl) = w; }
            }
        }
    }
};
struct EpiUpQ {
    static constexpr bool PERM = true, AFTER_DRAIN = false;
    const float* ssq; bf16_t* Qm; const float *cosm, *sinm;
    __device__ __forceinline__ void operator()(const f32x4 (&acc)[2][2][4][2], const Unit& u, int wr, int wc, int fr, int fq) const {
        const int row0 = u.pm * BM + wr * 64 + fr, cl = wc * 32 + 8 * fq;
#pragma unroll
        for (int ai = 0; ai < 2; ++ai)
#pragma unroll
            for (int m = 0; m < 4; ++m) { const int row = row0 + ai * HALF + m * 16; const float rstd = rsqrtf(ssq[row] * (1.f / 512.f) + NORM_EPS);
#pragma unroll
                for (int bj = 0; bj < 2; ++bj) { const int c = u.pn * 256 + bj * HALF + cl, d = c % 192; f32x4 a = acc[ai][bj][m][0] * rstd, b = acc[ai][bj][m][1] * rstd;
                    if (d >= 128) { const int fi = (d - 128) >> 1; const f32x4 c4 = *(const f32x4*)(cosm + (size_t)row * 32 + fi), s4 = *(const f32x4*)(sinm + (size_t)row * 32 + fi); rope8(a, b, c4, s4); }
                    *(u32x4*)(Qm + (size_t)row * 1536 + c) = pack8(a, b); } }
    }
};
struct EpiUpKV {
    static constexpr bool PERM = true, AFTER_DRAIN = false;
    const float* ssq; bf16_t *Kbuf, *Vm;
    __device__ __forceinline__ void operator()(const f32x4 (&acc)[2][2][4][2], const Unit& u, int wr, int wc, int fr, int fq) const {
        const int row0 = u.pm * BM + wr * 64 + fr, cl = wc * 32 + 8 * fq;
#pragma unroll
        for (int ai = 0; ai < 2; ++ai)
#pragma unroll
            for (int m = 0; m < 4; ++m) { const int row = row0 + ai * HALF + m * 16; const float rstd = rsqrtf(ssq[row] * (1.f / 512.f) + NORM_EPS);
                *(u32x4*)(Kbuf + (size_t)row * 1536 + u.pn * 192 + cl) = pack8(acc[ai][0][m][0] * rstd, acc[ai][0][m][1] * rstd);
                *(u32x4*)(Vm + (size_t)row * 1024 + u.pn * 128 + cl) = pack8(acc[ai][1][m][0] * rstd, acc[ai][1][m][1] * rstd); }
    }
};
struct EpiGateRes {
    static constexpr bool PERM = true, AFTER_DRAIN = false;
    const float* x; const float* gate; float* out;
    __device__ __forceinline__ void operator()(const f32x4 (&acc)[2][2][4][2], const Unit& u, int wr, int wc, int fr, int fq) const {
        const int row0 = u.pm * BM + wr * 64 + fr, cl = wc * 32 + 8 * fq, b = u.pm >> 4;
#pragma unroll
        for (int bj = 0; bj < 2; ++bj) { const int c = u.pn * 256 + bj * HALF + cl;
            const f32x4 g0 = *(const f32x4*)(gate + (size_t)b * 12288 + c), g1 = *(const f32x4*)(gate + (size_t)b * 12288 + c + 4);
#pragma unroll
            for (int ai = 0; ai < 2; ++ai)
#pragma unroll
                for (int m = 0; m < 4; ++m) { const size_t off = (size_t)(row0 + ai * HALF + m * 16) * 2048 + c;
                    const f32x4 x0 = *(const f32x4*)(x + off), x1 = *(const f32x4*)(x + off + 4);
                    *(f32x4*)(out + off) = x0 + g0 * acc[ai][bj][m][0]; *(f32x4*)(out + off + 4) = x1 + g1 * acc[ai][bj][m][1]; } }
    }
};
struct EpiGU {
    static constexpr bool PERM = true, AFTER_DRAIN = false;
    bf16_t* Aff;
    __device__ __forceinline__ void operator()(const f32x4 (&acc)[2][2][4][2], const Unit& u, int wr, int wc, int fr, int fq) const {
        const int row0 = u.pm * BM + wr * 64 + fr, cl = wc * 32 + 8 * fq;
#pragma unroll
        for (int ai = 0; ai < 2; ++ai)
#pragma unroll
            for (int m = 0; m < 4; ++m) { const int row = row0 + ai * HALF + m * 16; f32x4 a, b;
#pragma unroll
                for (int i = 0; i < 4; ++i) { a[i] = silu_f(acc[ai][0][m][0][i]) * acc[ai][1][m][0][i]; b[i] = silu_f(acc[ai][0][m][1][i]) * acc[ai][1][m][1][i]; }
                *(u32x4*)(Aff + (size_t)row * 5632 + u.pn * 128 + cl) = pack8(a, b); }
    }
};

template <class Epi, class Sched, bool ALIGN_EPI = false, bool SP2 = false>
__device__ __forceinline__ void gemm_phase(PG8_LAS unsigned char* lds, const Gemm g, const Sched& S, const Epi& E) {
    const int tid = threadIdx.x, wid = __builtin_amdgcn_readfirstlane(tid >> 6), lane = tid & 63, wr = wid >> 2, wc = wid & 3, fr = lane & 15, fq = lane >> 4;
    const int K = g.K, nt = K / BK;
    unsigned voffA[2], voffB[2];
#pragma unroll
    for (int i = 0; i < 2; ++i) { int R, C; stage_rc(tid * 16 + i * 8192, R, C); const int Rb = Epi::PERM ? ((R & ~31) + perm32(R & 31)) : R;
        voffA[i] = (unsigned)(R * K + C) * 2u; voffB[i] = (unsigned)(Rb * K + C) * 2u; }
    const size_t kstep = (size_t)(BK * 2);
    const size_t hstep = (size_t)HALF * K * 2;
    const size_t tstep = 2 * hstep;
    const unsigned ldsw = (unsigned)wid * 1024u;
    const int aoff = lds_byte(wr * 64 + fr, fq * 8), boff = lds_byte(wc * 32 + fr, fq * 8);
#define PG8_SA(b, h) (((b) * 2 + (h)) * HTB)
#define PG8_SB(b, h) ((4 + (b) * 2 + (h)) * HTB)
#define PG8_STAGE(bufoff, gbase, voff) do { _Pragma("unroll") for (int _i = 0; _i < 2; ++_i) \
        __builtin_amdgcn_global_load_lds((const unsigned*)((const char*)(gbase) + (voff)[_i]), (PG8_LAS unsigned*)(lds + (bufoff) + ldsw + _i * 8192), 16, 0, 0); } while (0)
#define PG8_LDA(dst, b, h) do { _Pragma("unroll") for (int m = 0; m < 4; ++m) _Pragma("unroll") for (int k = 0; k < 2; ++k) dst[m][k] = *(const PG8_LAS bf16x8*)(lds + PG8_SA(b, h) + aoff + m * 2048 + k * 1024); } while (0)
#define PG8_LDB(dst, b, h) do { _Pragma("unroll") for (int n = 0; n < 2; ++n) _Pragma("unroll") for (int k = 0; k < 2; ++k) dst[n][k] = *(const PG8_LAS bf16x8*)(lds + PG8_SB(b, h) + boff + n * 2048 + k * 1024); } while (0)
#define PG8_MMA(ai, bj, At, Bt) do { __builtin_amdgcn_s_setprio(1); _Pragma("unroll") for (int m = 0; m < 4; ++m) _Pragma("unroll") for (int n = 0; n < 2; ++n) _Pragma("unroll") for (int k = 0; k < 2; ++k) \
        acc[ai][bj][m][n] = __builtin_amdgcn_mfma_f32_16x16x32_bf16(Bt[n][k], At[m][k], acc[ai][bj][m][n], 0, 0, 0); __builtin_amdgcn_s_setprio(0); } while (0)
#define PG8_WAIT_V(n) asm volatile("s_waitcnt vmcnt(" #n ")" ::: "memory")
#define PG8_WAIT_L(n) asm volatile("s_waitcnt lgkmcnt(" #n ")" ::: "memory")
#define PG8_BAR __builtin_amdgcn_s_barrier()
#define PG8_SCHED __builtin_amdgcn_sched_barrier(0)
    Unit cur, nxt; int ui = 0;
    if (!S.next(0, cur)) return;
    f32x4 acc[2][2][4][2];
#pragma unroll
    for (int a = 0; a < 2; ++a)
#pragma unroll
        for (int b = 0; b < 2; ++b)
#pragma unroll
            for (int m = 0; m < 4; ++m)
#pragma unroll
                for (int n = 0; n < 2; ++n) acc[a][b][m][n] = (f32x4){0.f, 0.f, 0.f, 0.f};
    bf16x8 At[4][2], B0[2][2], B1[2][2];
    const char* cA = (const char*)g.A + (size_t)cur.pm * tstep; const char* cB = (const char*)g.Bt + (size_t)cur.pn * tstep;
    S.a_ready(cur);
    if constexpr (SP2) {
        PG8_STAGE(PG8_SB(0, 0), cB, voffB); PG8_STAGE(PG8_SB(0, 1), cB + hstep, voffB); PG8_STAGE(PG8_SA(0, 0), cA, voffA); PG8_STAGE(PG8_SA(0, 1), cA + hstep, voffA);
        if (wr == 1) PG8_BAR;
        PG8_WAIT_V(2); PG8_BAR;
        PG8_STAGE(PG8_SB(1, 0), cB + kstep, voffB); PG8_STAGE(PG8_SA(1, 0), cA + kstep, voffA); PG8_STAGE(PG8_SB(1, 1), cB + hstep + kstep, voffB);
        PG8_WAIT_V(6); PG8_BAR;
    } else {
        PG8_STAGE(PG8_SB(0, 0), cB, voffB); PG8_STAGE(PG8_SA(0, 0), cA, voffA); PG8_STAGE(PG8_SB(0, 1), cB + hstep, voffB); PG8_STAGE(PG8_SA(0, 1), cA + hstep, voffA);
        if (wr == 1) PG8_BAR;
        PG8_WAIT_V(4); PG8_BAR;
        PG8_STAGE(PG8_SB(1, 0), cB + kstep, voffB); PG8_STAGE(PG8_SA(1, 0), cA + kstep, voffA); PG8_STAGE(PG8_SB(1, 1), cB + hstep + kstep, voffB);
        PG8_WAIT_V(6); PG8_BAR;
    }
    for (;;) {
        const bool has_next = S.next(ui + 1, nxt);
        const char* nA = has_next ? (const char*)g.A + (size_t)nxt.pm * tstep : cA; const char* nB = has_next ? (const char*)g.Bt + (size_t)nxt.pn * tstep : cB;
        for (int t = 0; t < nt; t += 2) {
            const bool last = (t == nt - 2);
            const char* a1 = cA + (size_t)(t + 1) * kstep;
            const char* a2 = last ? nA : cA + (size_t)(t + 2) * kstep; const char* b2 = last ? nB : cB + (size_t)(t + 2) * kstep;
            const char* a3 = a2 + kstep; const char* b3 = b2 + kstep;
            if (last && has_next) S.a_ready(nxt);
            if constexpr (SP2) {
            PG8_LDB(B0, 0, 0); PG8_LDB(B1, 0, 1); PG8_SCHED; PG8_LDA(At, 0, 0); PG8_STAGE(PG8_SA(1, 1), a1 + hstep, voffA);
            PG8_WAIT_V(8); PG8_WAIT_L(0); PG8_BAR; PG8_MMA(0, 0, At, B0); PG8_MMA(0, 1, At, B1); PG8_BAR; PG8_SCHED;
            PG8_LDA(At, 0, 1); PG8_STAGE(PG8_SB(0, 0), b2, voffB); PG8_STAGE(PG8_SB(0, 1), b2 + hstep, voffB); PG8_STAGE(PG8_SA(0, 0), a2, voffA);
            PG8_WAIT_V(8); PG8_WAIT_L(0); PG8_BAR; PG8_MMA(1, 0, At, B0); PG8_MMA(1, 1, At, B1); PG8_BAR; PG8_SCHED;
            PG8_LDB(B0, 1, 0); PG8_LDB(B1, 1, 1); PG8_SCHED; PG8_LDA(At, 1, 0); PG8_STAGE(PG8_SA(0, 1), a2 + hstep, voffA);
            PG8_WAIT_V(8); PG8_WAIT_L(0); PG8_BAR; PG8_MMA(0, 0, At, B0); PG8_MMA(0, 1, At, B1); PG8_BAR; PG8_SCHED;
            PG8_LDA(At, 1, 1); PG8_STAGE(PG8_SB(1, 0), b3, voffB); PG8_STAGE(PG8_SB(1, 1), b3 + hstep, voffB); PG8_STAGE(PG8_SA(1, 0), a3, voffA);
            PG8_WAIT_V(8); PG8_WAIT_L(0); PG8_BAR; PG8_MMA(1, 0, At, B0); PG8_MMA(1, 1, At, B1); PG8_BAR; PG8_SCHED;
            } else {
            PG8_LDB(B0, 0, 0); PG8_SCHED; PG8_LDA(At, 0, 0); PG8_STAGE(PG8_SA(1, 1), a1 + hstep, voffA);
            PG8_WAIT_L(8); PG8_BAR; PG8_WAIT_L(0); PG8_MMA(0, 0, At, B0); PG8_BAR; PG8_SCHED;
            PG8_LDB(B1, 0, 1); PG8_STAGE(PG8_SB(0, 0), b2, voffB);
            PG8_BAR; PG8_WAIT_L(0); PG8_MMA(0, 1, At, B1); PG8_BAR;
            PG8_LDA(At, 0, 1); PG8_STAGE(PG8_SA(0, 0), a2, voffA);
            PG8_BAR; PG8_WAIT_L(0); PG8_MMA(1, 0, At, B0); PG8_BAR; PG8_SCHED;
            PG8_STAGE(PG8_SB(0, 1), b2 + hstep, voffB);
            PG8_WAIT_V(6); PG8_BAR; PG8_MMA(1, 1, At, B1); PG8_BAR;
            PG8_LDB(B0, 1, 0); PG8_SCHED; PG8_LDA(At, 1, 0); PG8_STAGE(PG8_SA(0, 1), a2 + hstep, voffA);
            PG8_WAIT_L(8); PG8_BAR; PG8_WAIT_L(0); PG8_MMA(0, 0, At, B0); PG8_BAR; PG8_SCHED;
            PG8_LDB(B1, 1, 1); PG8_STAGE(PG8_SB(1, 0), b3, voffB);
            PG8_BAR; PG8_WAIT_L(0); PG8_MMA(0, 1, At, B1); PG8_BAR;
            PG8_LDA(At, 1, 1); PG8_STAGE(PG8_SA(1, 0), a3, voffA);
            PG8_BAR; PG8_WAIT_L(0); PG8_MMA(1, 0, At, B0); PG8_BAR; PG8_SCHED;
            PG8_STAGE(PG8_SB(1, 1), b3 + hstep, voffB);
            PG8_WAIT_V(6); PG8_BAR; PG8_MMA(1, 1, At, B1); PG8_BAR;
            }
        }
        if constexpr (ALIGN_EPI) { if (wr == 0) PG8_BAR; }
        if constexpr (!Epi::AFTER_DRAIN) { E(acc, cur, wr, wc, fr, fq); S.done(cur); }
        if (!has_next) break;
#pragma unroll
        for (int a = 0; a < 2; ++a)
#pragma unroll
            for (int b = 0; b < 2; ++b)
#pragma unroll
                for (int m = 0; m < 4; ++m)
#pragma unroll
                    for (int n = 0; n < 2; ++n) acc[a][b][m][n] = (f32x4){0.f, 0.f, 0.f, 0.f};
        cur = nxt; cA = nA; cB = nB; ++ui;
        if constexpr (ALIGN_EPI) { if (wr == 1) PG8_BAR; }
    }
    PG8_WAIT_V(0);
    if constexpr (!ALIGN_EPI) { if (wr == 0) PG8_BAR; }
    PG8_BAR;
    if constexpr (Epi::AFTER_DRAIN) { E.fused(acc, cur, wr, wc, fr, fq, lds, wid, lane); S.done(cur); }
#undef PG8_SA
#undef PG8_SB
#undef PG8_STAGE
#undef PG8_LDA
#undef PG8_LDB
#undef PG8_MMA
#undef PG8_WAIT_V
#undef PG8_WAIT_L
#undef PG8_BAR
#undef PG8_SCHED
}
}

namespace att {
typedef unsigned short bf16_t;
using bf16x8 = __attribute__((ext_vector_type(8))) short;
using s16x4  = __attribute__((ext_vector_type(4))) short;
using f32x16 = __attribute__((ext_vector_type(16))) float;
using f32x4  = __attribute__((ext_vector_type(4))) float;
using u32x4  = __attribute__((ext_vector_type(4))) unsigned;
using u32x2  = __attribute__((ext_vector_type(2))) unsigned;
constexpr int NW = 8, QBLK = 32, KVBLK = 64;
constexpr int LDQ = 1536, LDK = 1536, LDV = 1024, LDO = 1024;
constexpr float SCALE = 0.07216878364870323f;
constexpr float THR = 8.f;
constexpr int NQR = 8;
constexpr int SHM_V = KVBLK * 128 * 2, SHM_K = KVBLK * 192 * 2, SHM_ATTN = 2 * SHM_V + 2 * SHM_K + NW * 64 * 4;
#define AKSWZ(row, colB) ((row) * 384 + ((colB) ^ (((row) & 7) << 4)))
#define KSWZ128(row, colB) ((row) * 256 + ((colB) ^ (((row) & 7) << 4)))
#define SBAR() __builtin_amdgcn_sched_barrier(0)
#define GAS __attribute__((address_space(1)))
__device__ __forceinline__ const GAS char* uniform_ptr(const void* p) { const unsigned long long v = (unsigned long long)p; const unsigned lo = __builtin_amdgcn_readfirstlane((unsigned)v), hi = __builtin_amdgcn_readfirstlane((unsigned)(v >> 32)); return (const GAS char*)(((unsigned long long)hi << 32) | lo); }
__device__ __forceinline__ int crow(int r, int hi) { return (r & 3) + 8 * (r >> 2) + 4 * hi; }
__device__ __forceinline__ unsigned cvtpk(float lo, float hi) { unsigned r; asm volatile("v_cvt_pk_bf16_f32 %0, %1, %2" : "=v"(r) : "v"(lo), "v"(hi)); return pg8::coarse2(r); }
__device__ __forceinline__ float swap_sum(float v) { auto rr = __builtin_amdgcn_permlane32_swap(__float_as_uint(v), __float_as_uint(v), false, false); return __uint_as_float(rr[0]) + __uint_as_float(rr[1]); }

__device__ __forceinline__ void partialSM(f32x16& p0, f32x16& p1, float& m_reg, float& mn, float& alpha) {
  constexpr float C = SCALE * 1.4426950408889634f;
  float pmax = p0[0];
#pragma unroll
  for (int r = 1; r < 16; ++r) pmax = fmaxf(pmax, p0[r]);
#pragma unroll
  for (int r = 0; r < 16; ++r) pmax = fmaxf(pmax, p1[r]);
  { auto rr = __builtin_amdgcn_permlane32_swap(__float_as_uint(pmax), __float_as_uint(pmax), false, false);
    pmax = fmaxf(__uint_as_float(rr[0]), __uint_as_float(rr[1])); }
  if (__builtin_expect(__all(pmax - m_reg <= THR / SCALE), 1)) { mn = m_reg; alpha = 1.f; }
  else { mn = fmaxf(m_reg, pmax); alpha = __builtin_amdgcn_exp2f((m_reg - mn) * C); m_reg = mn; }
  float mnC = -mn * C;
#pragma unroll
  for (int r = 0; r < 16; ++r) p0[r] = fmaf(p0[r], C, mnC);
#pragma unroll
  for (int r = 0; r < 16; ++r) p1[r] = fmaf(p1[r], C, mnC);
#pragma unroll
  for (int r = 0; r < 16; ++r) p0[r] = __builtin_amdgcn_exp2f(p0[r]);
}
#define PK4(P, BASE, OUT) do { unsigned a0 = cvtpk(P[BASE + 0], P[BASE + 1]), a1 = cvtpk(P[BASE + 2], P[BASE + 3]);   \
    unsigned b0 = cvtpk(P[BASE + 4], P[BASE + 5]), b1 = cvtpk(P[BASE + 6], P[BASE + 7]);                              \
    auto r0 = __builtin_amdgcn_permlane32_swap(a0, b0, false, false); auto r1 = __builtin_amdgcn_permlane32_swap(a1, b1, false, false); \
    u32x4 w = {r0[0], r1[0], r0[1], r1[1]}; OUT = *reinterpret_cast<bf16x8*>(&w); } while (0)
__device__ __forceinline__ void finishSM(f32x16& p0, f32x16& p1, float alpha, float& l_reg, bf16x8& pa0, bf16x8& pa1, bf16x8& pa2, bf16x8& pa3) {
#pragma unroll
  for (int r = 0; r < 16; ++r) p1[r] = __builtin_amdgcn_exp2f(p1[r]);
  float ps = 0;
#pragma unroll
  for (int r = 0; r < 16; ++r) ps += p0[r];
#pragma unroll
  for (int r = 0; r < 16; ++r) ps += p1[r];
  ps = swap_sum(ps);
  l_reg = l_reg * alpha + ps;
  PK4(p0, 0, pa0); PK4(p0, 8, pa1); PK4(p1, 0, pa2); PK4(p1, 8, pa3);
}
__device__ __forceinline__ void qkt192(f32x16& p0, f32x16& p1, const char* Ks, const bf16x8 (&qr)[NQR], const char* Qs, int r32, int hi) {
  p0 = f32x16{}; p1 = f32x16{};
#pragma unroll
  for (int d0 = 0; d0 < 12; ++d0) { int cb = (d0 * 16 + hi * 8) * 2;
    bf16x8 b0 = *reinterpret_cast<const bf16x8*>(Ks + AKSWZ(r32, cb));
    bf16x8 b1 = *reinterpret_cast<const bf16x8*>(Ks + AKSWZ(32 + r32, cb));
    bf16x8 qv; if (d0 < NQR) qv = qr[d0 < NQR ? d0 : 0]; else qv = *reinterpret_cast<const bf16x8*>(Qs + (d0 - NQR) * 1024);
    p0 = __builtin_amdgcn_mfma_f32_32x32x16_bf16(b0, qv, p0, 0, 0, 0);
    p1 = __builtin_amdgcn_mfma_f32_32x32x16_bf16(b1, qv, p1, 0, 0, 0); }
}
__device__ __forceinline__ void qkt128(f32x16& p0, f32x16& p1, const char* Ks, const bf16x8 (&qr)[8], int r32, int hi) {
  p0 = f32x16{}; p1 = f32x16{};
#pragma unroll
  for (int d0 = 0; d0 < 8; ++d0) { int cb = (d0 * 16 + hi * 8) * 2;
    bf16x8 b0 = *reinterpret_cast<const bf16x8*>(Ks + KSWZ128(r32, cb));
    bf16x8 b1 = *reinterpret_cast<const bf16x8*>(Ks + KSWZ128(32 + r32, cb));
    p0 = __builtin_amdgcn_mfma_f32_32x32x16_bf16(b0, qr[d0], p0, 0, 0, 0);
    p1 = __builtin_amdgcn_mfma_f32_32x32x16_bf16(b1, qr[d0], p1, 0, 0, 0); }
}
__device__ __forceinline__ int v_st(int k, int c) { const int kk = (k & ~0xC) | ((k & 4) << 1) | ((k & 8) >> 1); return ((kk >> 3) * 4 + (c >> 5)) * 512 + ((kk & 7) * 32 + (c & 31)) * 2; }
__device__ __forceinline__ int v_rd_base(int lane) { return ((lane & 3) << 3) | (((lane >> 2) & 3) << 6) | (((lane >> 4) & 1) << 5) | (((lane >> 5) & 1) << 8); }
constexpr int v_rd_off(int d0, int ks, int half) { return d0 * 512 + ks * 4096 + half * 2048; }
template <int OFF> __device__ __forceinline__ s16x4 tr_read(int vb) {
  s16x4 r; asm volatile("ds_read_b64_tr_b16 %0, %1 offset:%2" : "=&v"(r) : "v"(vb), "i"(OFF) : "memory"); return r;
}
#define PKLH(L, H) (bf16x8){L[0], L[1], L[2], L[3], H[0], H[1], H[2], H[3]}
template <int D0> __device__ __forceinline__ void pv_one(f32x16& od, int vb, bf16x8 pa0, bf16x8 pa1, bf16x8 pa2, bf16x8 pa3) {
  const s16x4 l0 = tr_read<v_rd_off(D0, 0, 0)>(vb), h0 = tr_read<v_rd_off(D0, 0, 1)>(vb), l1 = tr_read<v_rd_off(D0, 1, 0)>(vb), h1 = tr_read<v_rd_off(D0, 1, 1)>(vb);
  const s16x4 l2 = tr_read<v_rd_off(D0, 2, 0)>(vb), h2 = tr_read<v_rd_off(D0, 2, 1)>(vb), l3 = tr_read<v_rd_off(D0, 3, 0)>(vb), h3 = tr_read<v_rd_off(D0, 3, 1)>(vb);
  asm volatile("s_waitcnt lgkmcnt(0)" ::: "memory"); SBAR();
  od = __builtin_amdgcn_mfma_f32_32x32x16_bf16(pa0, PKLH(l0, h0), od, 0, 0, 0);
  od = __builtin_amdgcn_mfma_f32_32x32x16_bf16(pa1, PKLH(l1, h1), od, 0, 0, 0);
  od = __builtin_amdgcn_mfma_f32_32x32x16_bf16(pa2, PKLH(l2, h2), od, 0, 0, 0);
  od = __builtin_amdgcn_mfma_f32_32x32x16_bf16(pa3, PKLH(l3, h3), od, 0, 0, 0);
}
__device__ __forceinline__ void pv_d0(f32x16* o, int vb, bf16x8 pa0, bf16x8 pa1, bf16x8 pa2, bf16x8 pa3) {
  pv_one<0>(o[0], vb, pa0, pa1, pa2, pa3); pv_one<1>(o[1], vb, pa0, pa1, pa2, pa3); pv_one<2>(o[2], vb, pa0, pa1, pa2, pa3); pv_one<3>(o[3], vb, pa0, pa1, pa2, pa3);
}
template <int D0> __device__ __forceinline__ void pvT_one(f32x16& od, int vb, bf16x8 pa0, bf16x8 pa1, bf16x8 pa2, bf16x8 pa3) {
  const s16x4 l0 = tr_read<v_rd_off(D0, 0, 0)>(vb), h0 = tr_read<v_rd_off(D0, 0, 1)>(vb), l1 = tr_read<v_rd_off(D0, 1, 0)>(vb), h1 = tr_read<v_rd_off(D0, 1, 1)>(vb);
  const s16x4 l2 = tr_read<v_rd_off(D0, 2, 0)>(vb), h2 = tr_read<v_rd_off(D0, 2, 1)>(vb), l3 = tr_read<v_rd_off(D0, 3, 0)>(vb), h3 = tr_read<v_rd_off(D0, 3, 1)>(vb);
  asm volatile("s_waitcnt lgkmcnt(0)" ::: "memory"); SBAR();
  od = __builtin_amdgcn_mfma_f32_32x32x16_bf16(PKLH(l0, h0), pa0, od, 0, 0, 0);
  od = __builtin_amdgcn_mfma_f32_32x32x16_bf16(PKLH(l1, h1), pa1, od, 0, 0, 0);
  od = __builtin_amdgcn_mfma_f32_32x32x16_bf16(PKLH(l2, h2), pa2, od, 0, 0, 0);
  od = __builtin_amdgcn_mfma_f32_32x32x16_bf16(PKLH(l3, h3), pa3, od, 0, 0, 0);
}

__device__ __forceinline__ void attn_unit(const bf16_t* __restrict__ Qb, const bf16_t* __restrict__ Kh, const bf16_t* __restrict__ Vh, bf16_t* __restrict__ Ob, int seq, char* lds, int ldsaddr) {
  const int tid = threadIdx.x, wid = tid >> 6, lane = tid & 63, r32 = lane & 31, hi = lane >> 5;
  char* V_lds = lds; char* K_lds = lds + 2 * SHM_V;
  float* ws = (float*)(lds + 2 * SHM_V + 2 * SHM_K) + wid * 64; float* li_l = ws; float* al_l = ws + 32;
  float m_reg = -1e30f, l_reg = 0; f32x16 o[4] = {}; bf16x8 qr[NQR];
  const bf16_t* Qw = Qb + (long)(wid * QBLK + r32) * LDQ + hi * 8;
  char* Qs = lds + SHM_ATTN + wid * ((12 - NQR) * 1024) + lane * 16;
#pragma unroll
  for (int d0 = 0; d0 < NQR; ++d0) qr[d0] = *reinterpret_cast<const bf16x8*>(Qw + d0 * 16);
#pragma unroll
  for (int d0 = NQR; d0 < 12; ++d0) *(bf16x8*)(Qs + (d0 - NQR) * 1024) = *reinterpret_cast<const bf16x8*>(Qw + d0 * 16);
  const int sr = tid >> 4, sc = (tid & 15) * 8, vst0 = v_st(sr, sc), vst1 = v_st(32 + sr, sc);
  unsigned kg0, kg1, kg2; int kl0, kl1, kl2;
  { int p = tid;        int kr = p / 24, kc = (p % 24) * 8; kg0 = (unsigned)(kr * LDK + kc) * 2u; kl0 = AKSWZ(kr, kc * 2);
    p = tid + 512;      kr = p / 24; kc = (p % 24) * 8;     kg1 = (unsigned)(kr * LDK + kc) * 2u; kl1 = AKSWZ(kr, kc * 2);
    p = tid + 1024;     kr = p / 24; kc = (p % 24) * 8;     kg2 = (unsigned)(kr * LDK + kc) * 2u; kl2 = AKSWZ(kr, kc * 2); }
  const unsigned vg0 = (unsigned)(sr * LDV + sc) * 2u, vg1 = (unsigned)((32 + sr) * LDV + sc) * 2u;
  const int vb0 = ldsaddr + v_rd_base(lane);
  bf16x8 vs0, vs1, ks0, ks1, ks2;
#define SLOAD(k0) do { const GAS char* vb_ = uniform_ptr((const char*)Vh + (size_t)(k0) * (LDV * 2)); const GAS char* kb_ = uniform_ptr((const char*)Kh + (size_t)(k0) * (LDK * 2)); \
    vs0 = *(const GAS bf16x8*)(vb_ + vg0); vs1 = *(const GAS bf16x8*)(vb_ + vg1); \
    ks0 = *(const GAS bf16x8*)(kb_ + kg0); ks1 = *(const GAS bf16x8*)(kb_ + kg1); ks2 = *(const GAS bf16x8*)(kb_ + kg2); } while (0)
#define SWRITE(b) do { *(bf16x8*)(V_lds + (b) * SHM_V + vst0) = vs0; *(bf16x8*)(V_lds + (b) * SHM_V + vst1) = vs1; \
    *(bf16x8*)(K_lds + (b) * SHM_K + kl0) = ks0; *(bf16x8*)(K_lds + (b) * SHM_K + kl1) = ks1; *(bf16x8*)(K_lds + (b) * SHM_K + kl2) = ks2; } while (0)
#define SWAIT() asm volatile("s_waitcnt vmcnt(0)" ::: "memory")
#define RESC(a) do { if (__any((a) < 1.f)) { if (hi == 0) al_l[r32] = (a); asm volatile("s_waitcnt lgkmcnt(0)" ::: "memory"); \
    _Pragma("unroll") for (int d = 0; d < 4; ++d) _Pragma("unroll") for (int r = 0; r < 16; ++r) o[d][r] *= al_l[crow(r, hi)]; } } while (0)
  f32x16 pA0, pA1, pB0, pB1; float mnA, mnB, alA, alB; bf16x8 pa0, pa1, pa2, pa3; const int NT = seq / KVBLK;
  __syncthreads();
  SLOAD(0); SWAIT(); SWRITE(0); __syncthreads();
  qkt192(pA0, pA1, K_lds, qr, Qs, r32, hi); partialSM(pA0, pA1, m_reg, mnA, alA);
  SLOAD(KVBLK);
  SWAIT(); SWRITE(1); __syncthreads();
  for (int j = 1; j + 1 < NT; j += 2) {
    SBAR(); qkt192(pB0, pB1, K_lds + SHM_K, qr, Qs, r32, hi);
    finishSM(pA0, pA1, alA, l_reg, pa0, pa1, pa2, pa3); SBAR();
    SLOAD((j + 1) * KVBLK); SBAR();
    pv_d0(o, vb0, pa0, pa1, pa2, pa3); partialSM(pB0, pB1, m_reg, mnB, alB);
    __syncthreads(); SWAIT(); SWRITE(0);
    RESC(alB); __syncthreads();
    SBAR(); qkt192(pA0, pA1, K_lds, qr, Qs, r32, hi);
    finishSM(pB0, pB1, alB, l_reg, pa0, pa1, pa2, pa3); SBAR();
    SLOAD((j + 2) * KVBLK); SBAR();
    pv_d0(o, vb0 + SHM_V, pa0, pa1, pa2, pa3); partialSM(pA0, pA1, m_reg, mnA, alA);
    __syncthreads(); SWAIT(); SWRITE(1);
    RESC(alA); __syncthreads();
  }
  SBAR(); qkt192(pB0, pB1, K_lds + SHM_K, qr, Qs, r32, hi);
  finishSM(pA0, pA1, alA, l_reg, pa0, pa1, pa2, pa3); SBAR();
  pv_d0(o, vb0, pa0, pa1, pa2, pa3); partialSM(pB0, pB1, m_reg, mnB, alB);
  __syncthreads(); RESC(alB);
  finishSM(pB0, pB1, alB, l_reg, pa0, pa1, pa2, pa3); SBAR();
  pv_d0(o, vb0 + SHM_V, pa0, pa1, pa2, pa3);
  if (hi == 0) li_l[r32] = l_reg; asm volatile("s_waitcnt lgkmcnt(0)" ::: "memory");
  float rli[16];
#pragma unroll
  for (int r = 0; r < 16; ++r) rli[r] = __builtin_amdgcn_rcpf(li_l[crow(r, hi)]);
  bf16_t* Ow = Ob + (long)(wid * QBLK) * LDO;
#pragma unroll
  for (int r = 0; r < 16; ++r) { int orow = crow(r, hi);
#pragma unroll
    for (int d0 = 0; d0 < 4; ++d0) Ow[(long)orow * LDO + d0 * 32 + r32] = (bf16_t)(cvtpk(o[d0][r] * rli[r], 0.f) & 0xffffu); }
#undef SLOAD
#undef SWRITE
#undef SWAIT
#undef RESC
}

__device__ __forceinline__ bf16x8 scale8(bf16x8 v, float s) {
  u32x4 w = *reinterpret_cast<u32x4*>(&v), o;
#pragma unroll
  for (int i = 0; i < 4; ++i) o[i] = cvtpk(__uint_as_float(w[i] << 16) * s, __uint_as_float(w[i] & 0xffff0000u) * s);
  return *reinterpret_cast<bf16x8*>(&o);
}
__device__ __forceinline__ s16x4 trr(int addr) { s16x4 r; asm volatile("ds_read_b64_tr_b16 %0, %1" : "=&v"(r) : "v"(addr) : "memory"); return r; }

__device__ __forceinline__ void chunk_kv_unit(const bf16_t* __restrict__ Kc, const bf16_t* __restrict__ Vc, bf16_t* __restrict__ CKf, bf16_t* __restrict__ CKb, float lgf, float lgb, char* lds, int ldsaddr) {
  const int tid = threadIdx.x, wid = tid >> 6, lane = tid & 63, r32 = lane & 31, hi = lane >> 5;
  const int dir = wid >> 2, db = wid & 3, d = 32 * db + r32;
  __syncthreads();
  { const int sr = tid >> 4, sc = (tid & 15) * 8;
#pragma unroll
    for (int i = 0; i < 4; ++i) { const int row = sr + 32 * i;
      *(bf16x8*)(lds + (row >> 6) * 16384 + v_st(row & 63, sc)) = *reinterpret_cast<const bf16x8*>(Vc + (long)row * 1024 + sc); } }
  bf16x8 kb[8];
  int hio = hi; asm volatile("" : "+v"(hio));
  const GAS char* kg = uniform_ptr(Kc); const unsigned kofs = (unsigned)((hio * 8) * 1024 + d) * 2u;
#pragma unroll
  for (int ks = 0; ks < 8; ++ks) { u32x4 w;
#pragma unroll
    for (int i = 0; i < 4; ++i) { const int s0 = ks * 16 + hio * 8 + 2 * i;
      const float k0 = __uint_as_float((unsigned)*(const GAS unsigned short*)(kg + kofs + (ks * 16 + 2 * i) * 2048) << 16), k1 = __uint_as_float((unsigned)*(const GAS unsigned short*)(kg + kofs + (ks * 16 + 2 * i + 1) * 2048) << 16);
      const float z0 = __builtin_amdgcn_exp2f(dir ? lgb * (float)s0 : lgf * (float)(127 - s0)), z1 = __builtin_amdgcn_exp2f(dir ? lgb * (float)(s0 + 1) : lgf * (float)(126 - s0));
      w[i] = cvtpk(k0 * z0, k1 * z1); }
    kb[ks] = *reinterpret_cast<bf16x8*>(&w); }
  __syncthreads();
  f32x16 acc[4] = {};
  const int vb = ldsaddr + v_rd_base(lane);
  pvT_one<0>(acc[0], vb, kb[0], kb[1], kb[2], kb[3]); pvT_one<1>(acc[1], vb, kb[0], kb[1], kb[2], kb[3]); pvT_one<2>(acc[2], vb, kb[0], kb[1], kb[2], kb[3]); pvT_one<3>(acc[3], vb, kb[0], kb[1], kb[2], kb[3]);
  pvT_one<0>(acc[0], vb + 16384, kb[4], kb[5], kb[6], kb[7]); pvT_one<1>(acc[1], vb + 16384, kb[4], kb[5], kb[6], kb[7]); pvT_one<2>(acc[2], vb + 16384, kb[4], kb[5], kb[6], kb[7]); pvT_one<3>(acc[3], vb + 16384, kb[4], kb[5], kb[6], kb[7]);
  bf16_t* CK = dir ? CKb : CKf;
#pragma unroll
  for (int eb = 0; eb < 4; ++eb)
#pragma unroll
    for (int r = 0; r < 16; ++r) CK[(32 * eb + crow(r, hi)) * 128 + d] = (bf16_t)(cvtpk(acc[eb][r], 0.f) & 0xffffu);
}

#ifndef PROBE_COMP
#define PROBE_COMP 0
#endif
__device__ __forceinline__ void ret_out_unit(const bf16_t* __restrict__ Qc, const bf16_t* __restrict__ Kc, const bf16_t* __restrict__ Vc, const bf16_t* __restrict__ Gc,
                                             const bf16_t* __restrict__ STf, const bf16_t* __restrict__ STb, const float* __restrict__ gnw, const float* __restrict__ gnb,
                                             bf16_t* __restrict__ Oc, float lgf, float lgb, char* lds, int ldsaddr, float* dump = nullptr) {
  const int tid = threadIdx.x, ht = tid & 255, wq = (tid >> 6) & 3, lane = tid & 63, r32 = lane & 31, hi = lane >> 5;
  __syncthreads();
  { const int sr = ht >> 4, sc = (ht & 15) * 8;
#pragma unroll
    for (int i = 0; i < 8; ++i) { const int row = sr + 16 * i, tile = row >> 6, key = row & 63;
      *(bf16x8*)(lds + tile * 16384 + KSWZ128(key, sc * 2)) = *reinterpret_cast<const bf16x8*>(Kc + (long)row * 1024 + sc);
      *(bf16x8*)(lds + 32768 + tile * 16384 + v_st(key, sc)) = *reinterpret_cast<const bf16x8*>(Vc + (long)row * 1024 + sc); } }
  const int c = 32 * wq + r32;
  bf16x8 qr[8];
#pragma unroll
  for (int d0 = 0; d0 < 8; ++d0) qr[d0] = *reinterpret_cast<const bf16x8*>(Qc + (long)c * 1024 + d0 * 16 + hi * 8);
  __syncthreads();
  f32x16 pA0, pA1, pB0, pB1;
  qkt128(pA0, pA1, lds, qr, r32, hi); qkt128(pB0, pB1, lds + 16384, qr, r32, hi);
  int cdec = c; asm volatile("" : "+v"(cdec));
#define DEC(P, JB) do { _Pragma("unroll") for (int r = 0; r < 16; ++r) { const int dl = cdec - ((JB) + crow(r, hi)); \
    P[r] *= __builtin_amdgcn_exp2f(dl >= 0 ? lgf * (float)dl : lgb * (float)(-dl)); } } while (0)
  DEC(pA0, 0); DEC(pA1, 32); DEC(pB0, 64); DEC(pB1, 96);
#undef DEC
  bf16x8 xa0, xa1, xa2, xa3, xb0, xb1, xb2, xb3;
  PK4(pA0, 0, xa0); PK4(pA0, 8, xa1); PK4(pA1, 0, xa2); PK4(pA1, 8, xa3);
  PK4(pB0, 0, xb0); PK4(pB0, 8, xb1); PK4(pB1, 0, xb2); PK4(pB1, 8, xb3);
  f32x16 o[4] = {};
  const int vb = ldsaddr + 32768 + v_rd_base(lane);
  if (PROBE_COMP == 0 || (PROBE_COMP & 1)) {
  pvT_one<0>(o[0], vb, xa0, xa1, xa2, xa3); pvT_one<1>(o[1], vb, xa0, xa1, xa2, xa3); pvT_one<2>(o[2], vb, xa0, xa1, xa2, xa3); pvT_one<3>(o[3], vb, xa0, xa1, xa2, xa3);
  pvT_one<0>(o[0], vb + 16384, xb0, xb1, xb2, xb3); pvT_one<1>(o[1], vb + 16384, xb0, xb1, xb2, xb3); pvT_one<2>(o[2], vb + 16384, xb0, xb1, xb2, xb3); pvT_one<3>(o[3], vb + 16384, xb0, xb1, xb2, xb3);
  }
#pragma unroll
  for (int dir = 0; dir < 2; ++dir) {
    if (PROBE_COMP != 0 && !((PROBE_COMP >> (1 + dir)) & 1)) continue;
    const float xi = __builtin_amdgcn_exp2f(dir == 0 ? lgf * (float)(c + 1) : lgb * (float)(128 - c));
    const bf16_t* ST = dir == 0 ? STf : STb;
    bf16x8 qs[8];
#pragma unroll
    for (int d0 = 0; d0 < 8; ++d0) qs[d0] = scale8(qr[d0], xi);
    const GAS char* stb = uniform_ptr(ST); const unsigned so = (unsigned)(r32 * 128 + hi * 8) * 2u;
#pragma unroll
    for (int eb = 0; eb < 4; ++eb) {
      bf16x8 A[8];
      SBAR();
#pragma unroll
      for (int d0 = 0; d0 < 8; ++d0) A[d0] = *(const GAS bf16x8*)(stb + so + (eb * 32 * 128 + d0 * 16) * 2);
#pragma unroll
      for (int d0 = 0; d0 < 8; ++d0) o[eb] = __builtin_amdgcn_mfma_f32_32x32x16_bf16(A[d0], qs[d0], o[eb], 0, 0, 0);
      SBAR();
    }
  }
  if (PROBE_COMP != 0) {
#pragma unroll
    for (int eb = 0; eb < 4; ++eb)
#pragma unroll
      for (int g = 0; g < 4; ++g) *(f32x4*)(dump + (long)c * 1024 + 32 * eb + 8 * g + 4 * hi) = (f32x4){o[eb][4 * g], o[eb][4 * g + 1], o[eb][4 * g + 2], o[eb][4 * g + 3]};
    return; }
  float s = 0.f;
#pragma unroll
  for (int eb = 0; eb < 4; ++eb)
#pragma unroll
    for (int r = 0; r < 16; ++r) s += o[eb][r];
  const float mu = swap_sum(s) * (1.f / 128.f);
  float q = 0.f;
#pragma unroll
  for (int eb = 0; eb < 4; ++eb)
#pragma unroll
    for (int r = 0; r < 16; ++r) { const float d = o[eb][r] - mu; q += d * d; }
  const float rstd = rsqrtf(swap_sum(q) * (1.f / 128.f) + 1e-6f);
#pragma unroll
  for (int eb = 0; eb < 4; ++eb)
#pragma unroll
    for (int g = 0; g < 4; ++g) { const int e0 = 32 * eb + 8 * g + 4 * hi;
      const f32x4 w4 = *(const f32x4*)(gnw + e0), b4 = *(const f32x4*)(gnb + e0);
      const u32x2 gg = *(const u32x2*)(Gc + (long)c * 1024 + e0);
      const float g0 = __uint_as_float(gg.x << 16), g1 = __uint_as_float(gg.x & 0xffff0000u), g2 = __uint_as_float(gg.y << 16), g3 = __uint_as_float(gg.y & 0xffff0000u);
      const float y0 = ((o[eb][4 * g] - mu) * rstd * w4[0] + b4[0]) * g0, y1 = ((o[eb][4 * g + 1] - mu) * rstd * w4[1] + b4[1]) * g1;
      const float y2 = ((o[eb][4 * g + 2] - mu) * rstd * w4[2] + b4[2]) * g2, y3 = ((o[eb][4 * g + 3] - mu) * rstd * w4[3] + b4[3]) * g3;
      u32x2 w; w.x = cvtpk(y0, y1); w.y = cvtpk(y2, y3);
      *(u32x2*)(Oc + (long)c * 2048 + e0) = w; }
}

__device__ __forceinline__ void ret_brute_unit(const bf16_t* __restrict__ Qh, const bf16_t* __restrict__ Kh, const bf16_t* __restrict__ Vh, const bf16_t* __restrict__ Gc,
                                               const float* __restrict__ gnw, const float* __restrict__ gnb, bf16_t* __restrict__ Oc, int t0, float lgf, float lgb, char* lds, const float* dump = nullptr) {
  const int tid = threadIdx.x, qi = tid >> 2, part = tid & 3, t = t0 + qi;
  float q[32], acc[32];
#pragma unroll
  for (int i = 0; i < 32; ++i) { q[i] = __uint_as_float((unsigned)Qh[(long)t * 1024 + part * 32 + i] << 16); acc[i] = 0.f; }
  for (int s0 = 0; s0 < 4096; s0 += 64) {
    { const int rel = s0 < t0 ? 1 : (s0 >= t0 + 128 ? 2 : 0); if (PROBE_COMP != 0 && ((PROBE_COMP >> rel) & 1)) continue; }
    __syncthreads();
    for (int c = tid; c < 64 * 16; c += 512) { const int r = c >> 4, c8 = (c & 15) * 8;
      *(bf16x8*)(lds + (r * 128 + c8) * 2) = *reinterpret_cast<const bf16x8*>(Kh + (long)(s0 + r) * 1024 + c8);
      *(bf16x8*)(lds + 16384 + (r * 128 + c8) * 2) = *reinterpret_cast<const bf16x8*>(Vh + (long)(s0 + r) * 1024 + c8); }
    __syncthreads();
    for (int j = 0; j < 64; ++j) { const int s = s0 + j; float d = 0.f;
      const unsigned short* kr = (const unsigned short*)(lds + (j * 128 + part * 32) * 2); const unsigned short* vr = (const unsigned short*)(lds + 16384 + (j * 128 + part * 32) * 2);
#pragma unroll
      for (int i = 0; i < 32; ++i) d += q[i] * __uint_as_float((unsigned)kr[i] << 16);
      d += __shfl_xor(d, 1); d += __shfl_xor(d, 2);
      const int dl = t - s; const float w = d * __builtin_amdgcn_exp2f(dl >= 0 ? lgf * (float)dl : lgb * (float)(-dl));
#pragma unroll
      for (int i = 0; i < 32; ++i) acc[i] += w * __uint_as_float((unsigned)vr[i] << 16); }
  }
  if (PROBE_COMP != 0) {
#pragma unroll
    for (int i = 0; i < 32; ++i) acc[i] += dump[(long)qi * 1024 + part * 32 + i]; }
  float sm = 0.f;
#pragma unroll
  for (int i = 0; i < 32; ++i) sm += acc[i];
  sm += __shfl_xor(sm, 1); sm += __shfl_xor(sm, 2); const float mu = sm * (1.f / 128.f);
  float qq = 0.f;
#pragma unroll
  for (int i = 0; i < 32; ++i) { const float dd = acc[i] - mu; qq += dd * dd; }
  qq += __shfl_xor(qq, 1); qq += __shfl_xor(qq, 2); const float rstd = rsqrtf(qq * (1.f / 128.f) + 1e-6f);
#pragma unroll
  for (int i = 0; i < 32; ++i) { const int e = part * 32 + i; const float g = __uint_as_float((unsigned)Gc[(long)qi * 1024 + e] << 16);
    Oc[(long)qi * 2048 + e] = (bf16_t)(cvtpk(((acc[i] - mu) * rstd * gnw[e] + gnb[e]) * g, 0.f) & 0xffffu); }
}
#undef SBAR
}


#ifndef PROBE_BRUTE_RET
#define PROBE_BRUTE_RET 0
#endif
#ifndef MK_SPLIT
#define MK_SPLIT 0
#endif
#define LAS __attribute__((address_space(3)))
#define GASX __attribute__((address_space(1)))
typedef unsigned short bf16_t;
typedef unsigned v4u __attribute__((ext_vector_type(4)));
typedef unsigned v2u __attribute__((ext_vector_type(2)));
typedef float f32x4 __attribute__((ext_vector_type(4)));
typedef short bf16x8 __attribute__((ext_vector_type(8)));

constexpr int BATCH = 8, SEQ = 4096, DM = 2048, T = BATCH * SEQ;
constexpr int INC = 5184, INCP = 5376, DFF = 5632, NMODC = 6 * DM;
constexpr int NPH = 11;
constexpr size_t MiB = 1u << 20;
constexpr size_t WS_CTL = 0, CTL_ZERO_BYTES = 2 * MiB;
constexpr size_t OFF_MOD = 0, OFF_SSQQ = 512 * 1024, OFF_SSQKV = 640 * 1024;
constexpr size_t WS_COSR = 2 * MiB, WS_SINR = 10 * MiB, WS_COSM = 18 * MiB, WS_SINM = 22 * MiB;
constexpr size_t WS_WIN = 26 * MiB, WS_WUQ = 47 * MiB, WS_WUKV = 49 * MiB, WS_WO = 51 * MiB, WS_WGU = 59 * MiB, WS_WDN = 103 * MiB;
constexpr size_t WS_H = 128 * MiB;
constexpr size_t WS_QR = 256 * MiB, WS_KR = 320 * MiB, WS_VR = 384 * MiB, WS_GR = 448 * MiB;
constexpr size_t WS_CQ = 512 * MiB, WS_CKV = 544 * MiB;
constexpr size_t WS_QM = 576 * MiB, WS_KB = 672 * MiB, WS_VM = 768 * MiB, WS_OAT = 832 * MiB, WS_END = 896 * MiB;
constexpr size_t WS_CAT = 576 * MiB;
constexpr size_t WS_AFF = 256 * MiB;
static_assert(WS_AFF + (size_t)T * DFF * 2 <= WS_END && WS_CAT + (size_t)T * 2048 * 2 <= WS_VM, "d_ws map");
constexpr int LDS_BAR_OFF = 150528;
constexpr size_t OFF_XBAR = 1536 * 1024;
constexpr int LDS_BYTES = 150528 + 64;

#define LDS_WAIT() asm volatile("s_waitcnt lgkmcnt(0)" ::: "memory")
__device__ __forceinline__ unsigned f2bf(float f) { unsigned u = __builtin_bit_cast(unsigned, f); return (u + 0x7fffu + ((u >> 16) & 1u)) >> 16; }
__device__ __forceinline__ unsigned pk2(float lo, float hi) { return f2bf(lo) | (f2bf(hi) << 16); }
__device__ __forceinline__ unsigned pk2a(float lo, float hi) { return pg8::coarse2(pk2(lo, hi)); }
__device__ __forceinline__ float wave_sum(float v) {
#pragma unroll
    for (int o = 1; o < 64; o <<= 1) v += __shfl_xor(v, o);
    return v;
}
__device__ __forceinline__ int dest_row(int mapid, int n) {
    switch (mapid) {
    case 1: if (n < 2048) { const int j = n & 127; return (n & ~127) + (j < 64 ? 2 * j : 2 * (j - 64) + 1); }
            if (n < 5120) return n;
            { const int j = n - 5120; return 5120 + (j < 32 ? 2 * j : 2 * (j - 32) + 1); }
    case 2: { const int d = n % 192; if (d < 128) return n; const int j = d - 128; return n - d + 128 + (j < 32 ? 2 * j : 2 * (j - 32) + 1); }
    case 3: return (n >> 7) * 256 + (n & 127);
    case 4: return (n >> 7) * 256 + 128 + (n & 127);
    default: return n;
    }
}
__device__ __forceinline__ void transpose_item(const float* __restrict__ W, int K, int N, bf16_t* __restrict__ WT, const float* __restrict__ kscale, int mapid, LAS float* scr, int item, int lane) {
    const int nblk = N / 32, kb = item / nblk, nb = item % nblk, k0 = 64 * kb, n0 = 32 * nb;
#pragma unroll 8
    for (int i = 0; i < 32; ++i) { const int kk = 2 * i + (lane >> 5); float v = W[(size_t)(k0 + kk) * N + n0 + (lane & 31)]; if (kscale) v *= kscale[k0 + kk]; scr[kk * 33 + (lane & 31)] = v; }
    LDS_WAIT(); asm volatile("" ::: "memory");
    const int c = lane & 7;
#pragma unroll
    for (int j = 0; j < 4; ++j) { const int n = (lane >> 3) + 8 * j; const LAS float* s = scr + (8 * c) * 33 + n;
        v4u o; o.x = pk2(s[0 * 33], s[1 * 33]); o.y = pk2(s[2 * 33], s[3 * 33]); o.z = pk2(s[4 * 33], s[5 * 33]); o.w = pk2(s[6 * 33], s[7 * 33]);
        *(v4u*)(WT + (size_t)dest_row(mapid, n0 + n) * K + k0 + 8 * c) = o; }
    LDS_WAIT(); asm volatile("" ::: "memory");
}
__device__ __forceinline__ void norm_row(const float* xrow, const float* __restrict__ w, const float* __restrict__ shift, const float* __restrict__ scale, bf16_t* ob, float* of, int lane) {
    const f32x4* xr = (const f32x4*)xrow + lane;
    f32x4 v[8]; float s = 0.f;
#pragma unroll
    for (int j = 0; j < 8; ++j) { v[j] = xr[64 * j]; s += (v[j].x * v[j].x + v[j].y * v[j].y) + (v[j].z * v[j].z + v[j].w * v[j].w); }
    const float rstd = rsqrtf(wave_sum(s) * (1.f / 2048.f) + 1e-6f);
#pragma unroll
    for (int j = 0; j < 8; ++j) { const int col = 4 * lane + 256 * j; f32x4 y = v[j] * rstd * *(const f32x4*)(w + col);
        if (shift) y = y * (*(const f32x4*)(scale + col) + 1.f) + *(const f32x4*)(shift + col);
        if (ob) { v2u o; o.x = pk2a(y.x, y.y); o.y = pk2a(y.z, y.w); *(v2u*)(ob + col) = o; } else *(f32x4*)(of + col) = y; }
}

#define XB_TMO      128
#define XB_XCNT(j)  (256  + 64 * (j))
#define XB_XSUB(j)  (1280 + 64 * (j))
#define XB_XGEN(j)  (2304 + 64 * (j))
#define XB_TOP      3328
#define XB_TOPGEN   3392
#define XCD_BAR_WORDS 3456
#define XB_SPIN_CAP (1u << 18)

__device__ __forceinline__ unsigned xb_ld(unsigned* p)              { return __hip_atomic_load(p, __ATOMIC_RELAXED, __HIP_MEMORY_SCOPE_AGENT); }
__device__ __forceinline__ unsigned xb_add(unsigned* p, unsigned v) { return __hip_atomic_fetch_add(p, v, __ATOMIC_RELAXED, __HIP_MEMORY_SCOPE_AGENT); }
__device__ __forceinline__ unsigned xb_xcc_id() { return (unsigned)__builtin_amdgcn_s_getreg((3 << 11) | 20) & 0xFu; }
#define XB_SPIN(cond, bar) do { unsigned _sp = 0; while (cond) { __builtin_amdgcn_s_sleep(1); \
    if ((++_sp & 255u) == 0u) { if (xb_ld(&(bar)[XB_TMO])) break; if (_sp > XB_SPIN_CAP) { atomicAdd(&(bar)[XB_TMO], 1u); break; } } } } while (0)

struct XcdBarrier {
    unsigned* bar; unsigned x;
    volatile LAS unsigned* st;
};

__device__ __forceinline__ XcdBarrier xcd_barrier_post(unsigned* bar, volatile LAS unsigned* st) {
    XcdBarrier b; b.bar = bar; b.x = xb_xcc_id(); b.st = st;
    if (threadIdx.x == 0) (void)xb_add(&bar[XB_XCNT(b.x)], 1u);
    return b;
}
__device__ __forceinline__ void xcd_barrier_complete(unsigned* bar, unsigned x, unsigned& nloc, unsigned& nx) {
    const unsigned G = gridDim.x * gridDim.y * gridDim.z;
    unsigned sum, cnt, mine, sp = 0u;
    for (;;) {
        sum = 0u; cnt = 0u; mine = 0u;
#pragma unroll
        for (unsigned j = 0; j < 16; ++j) { const unsigned c = xb_ld(&bar[XB_XCNT(j)]); sum += c; cnt += (c > 0u) ? 1u : 0u; mine = (j == x) ? c : mine; }
        if (sum == G) break;
        __builtin_amdgcn_s_sleep(1);
        if ((++sp & 255u) == 0u) { if (xb_ld(&bar[XB_TMO])) break; if (sp > XB_SPIN_CAP) { atomicAdd(&bar[XB_TMO], 1u); break; } }
    }
    nloc = mine > 0u ? mine : 1u; nx = cnt > 0u ? cnt : 1u;
}

__device__ __forceinline__ void xcd_barrier(const XcdBarrier& b) {
    asm volatile("s_waitcnt vmcnt(0)" ::: "memory");
    __syncthreads();
    if (threadIdx.x == 0) {
        unsigned* bar = b.bar;
        __builtin_amdgcn_s_waitcnt(0);
        unsigned nloc = b.st[0], nx = b.st[1];
        if (nloc == 0u) { xcd_barrier_complete(bar, b.x, nloc, nx); b.st[0] = nloc; b.st[1] = nx; }
        const unsigned old = xb_add(&bar[XB_XSUB(b.x)], 1u);
        const unsigned gen = old / nloc;
        if (old + 1u == (gen + 1u) * nloc) {
            __builtin_amdgcn_fence(__ATOMIC_RELEASE, "agent");
            asm volatile("s_waitcnt vmcnt(0)" ::: "memory");
            const unsigned og = xb_add(&bar[XB_TOP], 1u);
            const unsigned tg = og / nx;
            if (og + 1u == (tg + 1u) * nx) xb_add(&bar[XB_TOPGEN], 1u);
            else XB_SPIN(xb_ld(&bar[XB_TOPGEN]) == tg, bar);
            __builtin_amdgcn_fence(__ATOMIC_ACQUIRE, "agent");
            xb_add(&bar[XB_XGEN(b.x)], 1u);
            asm volatile("s_waitcnt vmcnt(0)" ::: "memory");
        } else {
            XB_SPIN(xb_ld(&bar[XB_XGEN(b.x)]) == gen, bar);
            __builtin_amdgcn_fence(__ATOMIC_ACQUIRE, "agent");
            asm volatile("s_waitcnt vmcnt(0)" ::: "memory");
        }
    }
    __syncthreads();
}

struct Args { const float* in[21]; float* out; unsigned char* ws; float inv_r[64]; float inv_m[32]; int ph_lo, ph_hi; };
static_assert(sizeof(Args) == 21 * 8 + 16 + 96 * 4 + 8, "Args has no padding");

__global__ void __launch_bounds__(512, 2) mk_fwd(Args a) {
    extern __shared__ __attribute__((aligned(16))) unsigned char smem[];
    cg::grid_group grid = cg::this_grid();
    const int tid = threadIdx.x, lane = tid & 63, wave = __builtin_amdgcn_readfirstlane(tid >> 6);
    const int G = gridDim.x, bx = blockIdx.x, vcu = (G % 8 == 0) ? (bx % 8) * (G / 8) + bx / 8 : bx;
    const int gw = vcu * 8 + wave, NGW = G * 8;
    LAS unsigned char* lds3 = (LAS unsigned char*)smem; char* ldsg = (char*)smem; const int ldsaddr = (int)(unsigned)(uintptr_t)lds3;
    float* out = a.out;
#define WSB() size_t wz_ = 0; asm volatile("" : "+s"(wz_)); unsigned char* ws = a.ws + wz_
#define INP(name, k) const float* name = a.in[k] + wz_
#define WSF(name, off) float* name = (float*)(ws + (off))
#define WSH(name, off) bf16_t* name = (bf16_t*)(ws + (off))
    const int lo = a.ph_lo, hi = a.ph_hi;
    if (tid < 16) ((LAS unsigned*)(lds3 + LDS_BAR_OFF))[tid] = 0u;
    __syncthreads();
    XcdBarrier xbar = xcd_barrier_post((unsigned*)(a.ws + WS_CTL + OFF_XBAR), (volatile LAS unsigned*)(lds3 + LDS_BAR_OFF));
#ifndef PH_MASK
#define PH_MASK 0x7ff
#endif
#define IN(k) (((PH_MASK >> (k)) & 1) && lo <= (k) && (k) < hi)
#define SEAM(k) do { if (IN(k) && IN((k) + 1)) { asm volatile("s_waitcnt vmcnt(0) lgkmcnt(0)" ::: "memory"); grid.sync(); \
    __builtin_amdgcn_fence(__ATOMIC_ACQUIRE, "agent"); asm volatile("s_waitcnt vmcnt(0)" ::: "memory"); } } while (0)
#define SEAMX(k) do { if (IN(k) && IN((k) + 1)) xcd_barrier(xbar); } while (0)

    if (IN(0)) {
        WSB(); WSF(mod, WS_CTL + OFF_MOD); WSF(cosr, WS_COSR); WSF(sinr, WS_SINR); WSF(cosm, WS_COSM); WSF(sinm, WS_SINM);
        WSH(Win, WS_WIN); WSH(Wuq, WS_WUQ); WSH(Wukv, WS_WUKV); WSH(Wo, WS_WO); WSH(Wgu, WS_WGU); WSH(Wdn, WS_WDN);
        INP(cin, 1); INP(ada_w, 3); INP(ada_b, 4); INP(w_in, 6); INP(mla_q_norm_w, 10); INP(w_uq, 11); INP(mla_kv_norm_w, 12); INP(w_ukv, 13); INP(w_o, 15); INP(w_gate, 17); INP(w_up, 18); INP(w_down, 19);
        const int* positions = (const int*)a.in[2] + wz_;
        {
            LAS float* cs = (LAS float*)lds3;
            for (int i = tid; i < 8 * 2048; i += 512) { const int b = i >> 11, k = i & 2047; const float v = cin[i]; cs[k * 8 + b] = v / (1.f + __expf(-v)); }
            __syncthreads();
            for (int task = gw; task < 192 * 16; task += NGW) { const int cb = task % 192, ks = task / 192, col = cb * 64 + lane;
                float acc[8]; const float bias = ks == 0 ? ada_b[col] : 0.f;
#pragma unroll
                for (int b = 0; b < 8; ++b) acc[b] = bias;
                const float* wp = ada_w + (size_t)(ks * 128) * NMODC + col;
                for (int k8 = 0; k8 < 128; k8 += 8) { float wv[8];
#pragma unroll
                    for (int i = 0; i < 8; ++i) wv[i] = wp[(size_t)(k8 + i) * NMODC];
#pragma unroll
                    for (int i = 0; i < 8; ++i) { const LAS f32x4* c4 = (const LAS f32x4*)(cs + (ks * 128 + k8 + i) * 8); const f32x4 c0 = c4[0], c1 = c4[1];
                        acc[0] += c0.x * wv[i]; acc[1] += c0.y * wv[i]; acc[2] += c0.z * wv[i]; acc[3] += c0.w * wv[i]; acc[4] += c1.x * wv[i]; acc[5] += c1.y * wv[i]; acc[6] += c1.z * wv[i]; acc[7] += c1.w * wv[i]; } }
#pragma unroll
                for (int b = 0; b < 8; ++b) atomicAdd(mod + (size_t)b * NMODC + col, acc[b]); }
            __syncthreads();
        }
        {
            LAS float* scr = (LAS float*)(lds3 + wave * 16384);
            constexpr int I_IN = 32 * (INC / 32), I_UQ = 8 * 48, I_UKV = 8 * 64, I_O = 32 * 64, I_G = 32 * (DFF / 32), I_D = (DFF / 64) * 64;
            constexpr int NITEMS = I_IN + I_UQ + I_UKV + I_O + 2 * I_G + I_D;
            for (int it = gw; it < NITEMS; it += NGW) { int r = it;
                if (r < I_IN) { transpose_item(w_in, 2048, INC, Win, nullptr, 1, scr, r, lane); continue; } r -= I_IN;
                if (r < I_UQ) { transpose_item(w_uq, 512, 1536, Wuq, mla_q_norm_w, 2, scr, r, lane); continue; } r -= I_UQ;
                if (r < I_UKV) { transpose_item(w_ukv, 512, 2048, Wukv, mla_kv_norm_w, 0, scr, r, lane); continue; } r -= I_UKV;
                if (r < I_O) { transpose_item(w_o, 2048, 2048, Wo, nullptr, 0, scr, r, lane); continue; } r -= I_O;
                if (r < I_G) { transpose_item(w_gate, 2048, DFF, Wgu, nullptr, 3, scr, r, lane); continue; } r -= I_G;
                if (r < I_G) { transpose_item(w_up, 2048, DFF, Wgu, nullptr, 4, scr, r, lane); continue; } r -= I_G;
                transpose_item(w_down, DFF, 2048, Wdn, nullptr, 0, scr, r, lane); }
            for (int i = bx * 512 + tid; i < (INCP - INC) * 2048 / 8; i += G * 512) *(v4u*)(Win + (size_t)INC * 2048 + (size_t)i * 8) = (v4u){0u, 0u, 0u, 0u};
        }
        {
            for (int i = bx * 512 + tid; i < T * 96; i += G * 512) { const int t = i / 96, j = i % 96; const float pos = (float)positions[t];
                const float inv = j < 64 ? a.inv_r[j] : a.inv_m[j - 64]; const float ang = pos * inv;
                double rev = (double)ang * 0.15915494309189535; rev -= __builtin_rint(rev);
                const double qd = __builtin_rint(rev * 4.0); const double y = (rev - qd * 0.25) * 6.283185307179586; const double y2 = y * y;
                const double sy = y * (1.0 + y2 * (-1.0 / 6 + y2 * (1.0 / 120 + y2 * (-1.0 / 5040 + y2 * (1.0 / 362880 + y2 * (-1.0 / 39916800 + y2 * (1.0 / 6227020800.0)))))));
                const double cy = 1.0 + y2 * (-0.5 + y2 * (1.0 / 24 + y2 * (-1.0 / 720 + y2 * (1.0 / 40320 + y2 * (-1.0 / 3628800 + y2 * (1.0 / 479001600.0 + y2 * (-1.0 / 87178291200.0)))))));
                const int qi = (int)qd & 3;
                const float cv = (float)(qi == 0 ? cy : qi == 1 ? -sy : qi == 2 ? -cy : sy), sv = (float)(qi == 0 ? sy : qi == 1 ? cy : qi == 2 ? -sy : -cy);
                if (j < 64) { cosr[(size_t)t * 64 + j] = cv; sinr[(size_t)t * 64 + j] = sv; } else { cosm[(size_t)t * 32 + j - 64] = cv; sinm[(size_t)t * 32 + j - 64] = sv; } }
        }
    }
    SEAMX(0);
    if (a.ph_hi > 1000) { SEAM(0); }
    if (IN(1)) { WSB(); WSF(mod, WS_CTL + OFF_MOD); WSH(H, WS_H); INP(x, 0); INP(norm1_w, 5);
        for (int m = gw; m < T; m += NGW) { const int b = m >> 12; norm_row(x + (size_t)m * DM, norm1_w, mod + (size_t)b * NMODC, mod + (size_t)b * NMODC + DM, H + (size_t)m * DM, nullptr, lane); } }
    SEAMX(1);
    if (IN(2)) {
        WSB(); WSH(H, WS_H); WSH(Win, WS_WIN); WSH(Qr, WS_QR); WSH(Kr, WS_KR); WSH(Vr, WS_VR); WSH(Gr, WS_GR); WSH(CQ, WS_CQ); WSH(CKV, WS_CKV); WSH(Kbuf, WS_KB);
        WSF(cosr, WS_COSR); WSF(sinr, WS_SINR); WSF(cosm, WS_COSM); WSF(sinm, WS_SINM); WSF(ssq_q, WS_CTL + OFF_SSQQ); WSF(ssq_kv, WS_CTL + OFF_SSQKV);
        pg8::Gemm g{H, Win, T, INCP, DM}; pg8::StaticOrder S; S.init(T, INCP, G, bx);
        pg8::EpiIn E{Qr, Kr, Vr, Gr, CQ, CKV, Kbuf, cosr, sinr, cosm, sinm, ssq_q, ssq_kv};
        pg8::gemm_phase<pg8::EpiIn, pg8::StaticOrder, true, true>(lds3, g, S, E);
    }
    SEAMX(2);
    if (IN(3)) {
        WSB(); WSH(CQ, WS_CQ); WSH(CKV, WS_CKV); WSH(Wuq, WS_WUQ); WSH(Wukv, WS_WUKV); WSH(Qm, WS_QM); WSH(Kbuf, WS_KB); WSH(Vm, WS_VM); WSH(Kr, WS_KR); WSH(Vr, WS_VR); WSH(CK, WS_H);
        WSF(cosm, WS_COSM); WSF(sinm, WS_SINM); WSF(ssq_q, WS_CTL + OFF_SSQQ); WSF(ssq_kv, WS_CTL + OFF_SSQKV); INP(ret_decay, 7);
        { pg8::Gemm g{CQ, Wuq, T, 1536, 512}; pg8::StaticOrder S; S.init(T, 1536, G, bx); pg8::EpiUpQ E{ssq_q, Qm, cosm, sinm};
          pg8::gemm_phase<pg8::EpiUpQ, pg8::StaticOrder, true, true>(lds3, g, S, E); }
        { pg8::Gemm g{CKV, Wukv, T, 2048, 512}; pg8::StaticOrder S; S.init(T, 2048, G, bx); pg8::EpiUpKV E{ssq_kv, Kbuf, Vm};
          pg8::gemm_phase<pg8::EpiUpKV, pg8::StaticOrder, true, true>(lds3, g, S, E); }
        for (int u = vcu; u < 2048; u += G) { const int n = u & 31, h = (u >> 5) & 7, b = u >> 8; const size_t t0 = (size_t)b * SEQ + n * 128;
            const float lgf = -__expf(ret_decay[h]) * 1.4426950408889634f, lgb = -__expf(ret_decay[8 + h]) * 1.4426950408889634f;
            att::chunk_kv_unit(Kr + t0 * 1024 + h * 128, Vr + t0 * 1024 + h * 128, CK + ((size_t)(b * 8 + h) * 32 + n) * 16384, CK + ((size_t)(64 + b * 8 + h) * 32 + n) * 16384, lgf, lgb, ldsg, ldsaddr); }
        __syncthreads();
    }
    SEAMX(3);
    if (IN(4)) {
        WSB(); WSH(Qm, WS_QM); WSH(Kbuf, WS_KB); WSH(Vm, WS_VM); WSH(Oat, WS_OAT); WSH(CK, WS_H); INP(ret_decay, 7);
        for (int u = vcu; u < 1024; u += G) { const int qb = u & 15, h = (u >> 4) & 7, b = u >> 7; const size_t r0 = (size_t)b * SEQ;
            att::attn_unit(Qm + (r0 + qb * 256) * 1536 + h * 192, Kbuf + r0 * 1536 + h * 192, Vm + r0 * 1024 + h * 128, Oat + (r0 + qb * 256) * 1024 + h * 128, SEQ, ldsg, ldsaddr); }
#ifndef NO_SCAN
        for (int idx = bx * 512 + tid; idx < 2 * 64 * 2048; idx += G * 512) { const int dir = idx >> 17, bh = (idx >> 11) & 63, e8 = idx & 2047, h = bh & 7;
            const float cd = __builtin_amdgcn_exp2f(-__expf(ret_decay[dir * 8 + h]) * 1.4426950408889634f * 128.f);
            bf16_t* base = CK + ((size_t)(dir * 64 + bh) * 32) * 16384 + e8 * 8; float st[8];
#pragma unroll
            for (int i = 0; i < 8; ++i) st[i] = 0.f;
            for (int s8 = 0; s8 < 32; s8 += 8) { v4u kv[8];
#pragma unroll
                for (int i = 0; i < 8; ++i) { const int m = dir ? 31 - (s8 + i) : s8 + i; kv[i] = *(const v4u*)(base + (size_t)m * 16384); }
#pragma unroll
                for (int i = 0; i < 8; ++i) { const int m = dir ? 31 - (s8 + i) : s8 + i; v4u o;
                    o.x = pk2a(st[0], st[1]); o.y = pk2a(st[2], st[3]); o.z = pk2a(st[4], st[5]); o.w = pk2a(st[6], st[7]);
                    *(v4u*)(base + (size_t)m * 16384) = o;
#pragma unroll
                    for (int q = 0; q < 4; ++q) { const unsigned w = kv[i][q]; st[2 * q] = st[2 * q] * cd + __uint_as_float(w << 16); st[2 * q + 1] = st[2 * q + 1] * cd + __uint_as_float(w & 0xffff0000u); } } }
        }
#endif
    }
    SEAMX(4);
    if (IN(5)) {
        WSB(); WSH(Qr, WS_QR); WSH(Kr, WS_KR); WSH(Vr, WS_VR); WSH(Gr, WS_GR); WSH(CK, WS_H); WSH(Cat, WS_CAT); WSH(Oat, WS_OAT); INP(ret_decay, 7); INP(ret_gn_w, 8); INP(ret_gn_b, 9); INP(mla_out_w, 14);
#if PROBE_BRUTE_RET
        float* dumpb = (float*)(ws + 704 * MiB);
        for (int up = vcu; up < 1024; up += G) {
            if (PROBE_COMP != 0) { const int u = up * 2 + (wave >> 2); const int n = u & 31, h = (u >> 5) & 7, b = u >> 8; const size_t t0 = (size_t)b * SEQ + n * 128;
                const float lgf = -__expf(ret_decay[h]) * 1.4426950408889634f, lgb = -__expf(ret_decay[8 + h]) * 1.4426950408889634f; const int hf = wave >> 2;
                att::ret_out_unit(Qr + t0 * 1024 + h * 128, Kr + t0 * 1024 + h * 128, Vr + t0 * 1024 + h * 128, Gr + t0 * 1024 + h * 128,
                                  CK + ((size_t)(b * 8 + h) * 32 + n) * 16384, CK + ((size_t)(64 + b * 8 + h) * 32 + n) * 16384, ret_gn_w + h * 128, ret_gn_b + h * 128,
                                  Cat + t0 * 2048 + h * 128, lgf, lgb, ldsg + hf * 65536, ldsaddr + hf * 65536, dumpb + t0 * 1024 + h * 128);
                __threadfence(); __syncthreads(); }
            for (int k2 = 0; k2 < 2; ++k2) { const int u = up * 2 + k2; const int n = u & 31, h = (u >> 5) & 7, b = u >> 8; const size_t r0 = (size_t)b * SEQ, t0 = r0 + n * 128;
                const float lgf = -__expf(ret_decay[h]) * 1.4426950408889634f, lgb = -__expf(ret_decay[8 + h]) * 1.4426950408889634f;
                att::ret_brute_unit(Qr + r0 * 1024 + h * 128, Kr + r0 * 1024 + h * 128, Vr + r0 * 1024 + h * 128, Gr + t0 * 1024 + h * 128, ret_gn_w + h * 128, ret_gn_b + h * 128, Cat + t0 * 2048 + h * 128, n * 128, lgf, lgb, ldsg, dumpb + t0 * 1024 + h * 128); } }
        __syncthreads();
        for (int up = vcu; up < 0; up += G) { const int u = up * 2 + (wave >> 2);
#else
        for (int up = vcu; up < 1024; up += G) { const int u = up * 2 + (wave >> 2);
#endif
            const int n = u & 31, h = (u >> 5) & 7, b = u >> 8; const size_t t0 = (size_t)b * SEQ + n * 128;
            const float lgf = -__expf(ret_decay[h]) * 1.4426950408889634f, lgb = -__expf(ret_decay[8 + h]) * 1.4426950408889634f; const int hf = wave >> 2;
            att::ret_out_unit(Qr + t0 * 1024 + h * 128, Kr + t0 * 1024 + h * 128, Vr + t0 * 1024 + h * 128, Gr + t0 * 1024 + h * 128,
                              CK + ((size_t)(b * 8 + h) * 32 + n) * 16384, CK + ((size_t)(64 + b * 8 + h) * 32 + n) * 16384, ret_gn_w + h * 128, ret_gn_b + h * 128,
                              Cat + t0 * 2048 + h * 128, lgf, lgb, ldsg + hf * 65536, ldsaddr + hf * 65536); }
        for (int m = gw; m < T; m += NGW) {
            const bf16_t* orow = Oat + (size_t)m * 1024; float v[16]; float s = 0.f;
#pragma unroll
            for (int j = 0; j < 2; ++j) { const v4u w = *(const v4u*)(orow + lane * 8 + 512 * j);
#pragma unroll
                for (int q = 0; q < 4; ++q) { v[j * 8 + 2 * q] = __uint_as_float(w[q] << 16); v[j * 8 + 2 * q + 1] = __uint_as_float(w[q] & 0xffff0000u); } }
#pragma unroll
            for (int i = 0; i < 16; ++i) s += v[i] * v[i];
            const float rstd = rsqrtf(wave_sum(s) * (1.f / 1024.f) + 1e-6f);
#pragma unroll
            for (int j = 0; j < 2; ++j) { const int col = lane * 8 + 512 * j; const f32x4 w0 = *(const f32x4*)(mla_out_w + col), w1 = *(const f32x4*)(mla_out_w + col + 4); v4u o;
                o.x = pk2a(v[j * 8 + 0] * rstd * w0.x, v[j * 8 + 1] * rstd * w0.y); o.y = pk2a(v[j * 8 + 2] * rstd * w0.z, v[j * 8 + 3] * rstd * w0.w);
                o.z = pk2a(v[j * 8 + 4] * rstd * w1.x, v[j * 8 + 5] * rstd * w1.y); o.w = pk2a(v[j * 8 + 6] * rstd * w1.z, v[j * 8 + 7] * rstd * w1.w);
                *(v4u*)(Cat + (size_t)m * 2048 + 1024 + col) = o; } }
        __syncthreads();
    }
    SEAMX(5);
    if (IN(6)) {
        WSB(); WSH(Cat, WS_CAT); WSH(Wo, WS_WO); WSF(mod, WS_CTL + OFF_MOD); INP(x, 0);
        pg8::Gemm g{Cat, Wo, T, 2048, 2048}; pg8::StaticOrder S; S.init(T, 2048, G, bx); pg8::EpiGateRes E{x, mod + 2 * DM, out};
        pg8::gemm_phase<pg8::EpiGateRes, pg8::StaticOrder, true, true>(lds3, g, S, E);
    }
    SEAMX(6);
    if (IN(7)) { WSB(); WSF(mod, WS_CTL + OFF_MOD); WSH(H, WS_H); INP(norm2_w, 16);
        for (int m = gw; m < T; m += NGW) { const int b = m >> 12; norm_row(out + (size_t)m * DM, norm2_w, mod + (size_t)b * NMODC + 3 * DM, mod + (size_t)b * NMODC + 4 * DM, H + (size_t)m * DM, nullptr, lane); } }
    SEAMX(7);
    if (IN(8)) {
        WSB(); WSH(H, WS_H); WSH(Wgu, WS_WGU); WSH(Aff, WS_AFF);
        pg8::Gemm g{H, Wgu, T, 2 * DFF, DM}; pg8::StaticOrder S; S.init(T, 2 * DFF, G, bx); pg8::EpiGU E{Aff};
        pg8::gemm_phase<pg8::EpiGU, pg8::StaticOrder, true, true>(lds3, g, S, E);
    }
    SEAMX(8);
    if (IN(9)) {
        WSB(); WSH(Aff, WS_AFF); WSH(Wdn, WS_WDN); WSF(mod, WS_CTL + OFF_MOD);
        pg8::Gemm g{Aff, Wdn, T, 2048, DFF}; pg8::StaticOrder S; S.init(T, 2048, G, bx); pg8::EpiGateRes E{out, mod + 5 * DM, out};
        pg8::gemm_phase<pg8::EpiGateRes, pg8::StaticOrder, true, true>(lds3, g, S, E);
    }
    SEAMX(9);
    if (IN(10)) { WSB(); (void)ws; INP(final_norm_w, 20);
        for (int m = gw; m < T; m += NGW) norm_row(out + (size_t)m * DM, final_norm_w, nullptr, nullptr, nullptr, out + (size_t)m * DM, lane); }
#undef IN
#undef SEAM
}

extern "C" void kernel_launch(void* const* d_in, const int* in_sizes, int n_in, void* d_out, int out_size, void* d_ws, size_t ws_size, hipStream_t stream) {
    static int grid = 0;
    if (grid == 0) {
        if (n_in != 21 || in_sizes[0] != T * DM || out_size != T * DM || ws_size < WS_END) { fprintf(stderr, "kernel_launch: shape/workspace mismatch (n_in %d, ws %zu < %zu)\n", n_in, ws_size, (size_t)WS_END); grid = -1; return; }
        int dev = 0, cus = 0, per_cu = 0;
        (void)hipGetDevice(&dev); (void)hipDeviceGetAttribute(&cus, hipDeviceAttributeMultiprocessorCount, dev);
        if (hipFuncSetAttribute((const void*)mk_fwd, hipFuncAttributeMaxDynamicSharedMemorySize, LDS_BYTES) != hipSuccess) { fprintf(stderr, "kernel_launch: hipFuncSetAttribute failed\n"); grid = -1; return; }
        if (hipOccupancyMaxActiveBlocksPerMultiprocessor(&per_cu, (const void*)mk_fwd, 512, LDS_BYTES) != hipSuccess || per_cu < 1) { fprintf(stderr, "kernel_launch: occupancy query gave %d\n", per_cu); per_cu = 1; }
        (void)hipGetLastError();
        grid = cus * per_cu;
    }
    if (grid < 0) return;
    (void)hipMemsetAsync((char*)d_ws + WS_CTL, 0, CTL_ZERO_BYTES, stream);
    Args a{};
    for (int i = 0; i < 21; ++i) a.in[i] = (const float*)d_in[i];
    a.out = (float*)d_out; a.ws = (unsigned char*)d_ws;
    for (int i = 0; i < 64; ++i) a.inv_r[i] = powf(10000.0f, -((float)(2 * i)) / 128.0f);
    for (int i = 0; i < 32; ++i) a.inv_m[i] = powf(10000.0f, -((float)(2 * i)) / 64.0f);
#if MK_SPLIT
    for (int p = 0; p < NPH; ++p) { a.ph_lo = p; a.ph_hi = p + 1; hipLaunchKernelGGL(mk_fwd, dim3(grid), dim3(512), LDS_BYTES, stream, a); }
#else
    a.ph_lo = 0; a.ph_hi = NPH;
    void* args[] = {&a};
    hipError_t e = hipLaunchCooperativeKernel((const void*)mk_fwd, dim3(grid), dim3(512), args, LDS_BYTES, stream);
    if (e != hipSuccess) fprintf(stderr, "kernel_launch: cooperative launch failed: %s (grid %d)\n", hipGetErrorString(e), grid);
#endif
}
```

```cpp
#include <hip/hip_runtime.h>
#include <hip/hip_cooperative_groups.h>
#include <cstdio>
#include <cstdint>
#include <cmath>
namespace cg = cooperative_groups;
namespace pg8 {
#define PG8_LAS __attribute__((address_space(3)))
typedef unsigned short bf16_t;
typedef short bf16x8 __attribute__((ext_vector_type(8)));
typedef float f32x4 __attribute__((ext_vector_type(4)));
typedef unsigned u32x4 __attribute__((ext_vector_type(4)));
constexpr int BM = 256, BK = 64, HALF = 128, HTB = HALF * BK * 2  , STAGE_BYTES = 8 * HTB, NXCD = 8, WGM = 8;

__host__ __device__ __forceinline__ int lds_byte(int r, int c) { const int st = (r >> 4) * 2 + (c >> 5), rr = r & 15, cc = c & 31, ob = rr * 64 + cc * 2; return st * 1024 + (ob ^ (((ob >> 9) & 1) << 5)); }
__host__ __device__ __forceinline__ void stage_rc(int b, int& R, int& C) { const int st = b / 1024, sb = b % 1024, swz = sb ^ (((sb >> 9) & 1) << 5); R = (st >> 1) * 16 + swz / 64; C = (st & 1) * 32 + (swz % 64) / 2; }
__host__ __device__ __forceinline__ int perm32(int rho) { const int n = rho >> 4, i = rho & 15; return 8 * (i >> 2) + 4 * n + (i & 3); }

struct Unit { int pm, pn; };
struct Gemm { const bf16_t* A; const bf16_t* Bt; int M, N, K; };

struct StaticOrder {
    int nM, nN, nwg, G, c;
    __host__ __device__ void init(int M, int N, int G_, int c_) { nM = M / BM; nN = N / BM; nwg = nM * nN; G = G_; c = c_; }
    __host__ __device__ bool next(int i, Unit& u) const {
        const long L = (long)i * G + c; if (L >= nwg) return false;
        int wgid = (int)L; { const int q = nwg / NXCD, r = nwg % NXCD, xcd = wgid % NXCD, off = wgid / NXCD; wgid = (xcd < r ? xcd * (q + 1) : r * (q + 1) + (xcd - r) * q) + off; }
        const int nig = WGM * nN, gid = wgid / nig, fm = gid * WGM, gsz = (nM - fm) < WGM ? (nM - fm) : WGM;
        u.pm = fm + ((wgid % nig) % gsz); u.pn = (wgid % nig) / gsz; return true;
    }
    __device__ __forceinline__ void a_ready(const Unit&) const {}
    __device__ __forceinline__ void done(const Unit&) const {}
};

#ifndef PROBE_COARSE_ACT
#define PROBE_COARSE_ACT 0
#endif
__device__ __forceinline__ unsigned coarse2(unsigned w) { return PROBE_COARSE_ACT ? ((w + ((w >> 1) & 0x00010001u)) & 0xfffefffeu) : w; }
__device__ __forceinline__ unsigned cvt_pk_bf16(float lo, float hi) { unsigned r; asm volatile("v_cvt_pk_bf16_f32 %0, %1, %2" : "=v"(r) : "v"(lo), "v"(hi)); return coarse2(r); }
typedef float f32x2 __attribute__((ext_vector_type(2)));

typedef unsigned u32x2 __attribute__((ext_vector_type(2)));
__device__ __forceinline__ float silu_f(float v) { return v * __builtin_amdgcn_rcpf(1.f + __builtin_amdgcn_exp2f(v * -1.4426950408889634f)); }
__device__ __forceinline__ u32x4 pack8(f32x4 a, f32x4 b) { u32x4 w; w.x = cvt_pk_bf16(a[0], a[1]); w.y = cvt_pk_bf16(a[2], a[3]); w.z = cvt_pk_bf16(b[0], b[1]); w.w = cvt_pk_bf16(b[2], b[3]); return w; }
__device__ __forceinline__ void rope8(f32x4& a, f32x4& b, const f32x4 c, const f32x4 s) {
    float t1, t2;
    t1 = a[0]; t2 = a[1]; a[0] = t1 * c[0] - t2 * s[0]; a[1] = t2 * c[0] + t1 * s[0];
    t1 = a[2]; t2 = a[3]; a[2] = t1 * c[1] - t2 * s[1]; a[3] = t2 * c[1] + t1 * s[1];
    t1 = b[0]; t2 = b[1]; b[0] = t1 * c[2] - t2 * s[2]; b[1] = t2 * c[2] + t1 * s[2];
    t1 = b[2]; t2 = b[3]; b[2] = t1 * c[3] - t2 * s[3]; b[3] = t2 * c[3] + t1 * s[3];
}
constexpr float NORM_EPS = 1e-6f;

struct EpiIn {
    static constexpr bool PERM = true, AFTER_DRAIN = false;
    bf16_t *Qr, *Kr, *Vr, *Gr, *CQ, *CKV, *Kbuf; const float *cosr, *sinr, *cosm, *sinm; float *ssq_q, *ssq_kv;
    __device__ __forceinline__ void operator()(const f32x4 (&acc)[2][2][4][2], const Unit& u, int wr, int wc, int fr, int fq) const {
        const int pn = u.pn, row0 = u.pm * BM + wr * 64 + fr, cl = wc * 32 + 8 * fq;
        if (pn < 8) {
            bf16_t* O = pn < 4 ? Qr : Kr; const float sc = pn < 4 ? 1.f : 0.08838834764831845f; const int colt = (pn & 3) * 256 + cl;
#pragma unroll
            for (int ai = 0; ai < 2; ++ai)
#pragma unroll
                for (int m = 0; m < 4; ++m) { const int row = row0 + ai * HALF + m * 16;
                    const f32x4 c4 = *(const f32x4*)(cosr + (size_t)row * 64 + (cl >> 1)), s4 = *(const f32x4*)(sinr + (size_t)row * 64 + (cl >> 1));
#pragma unroll
                    for (int bj = 0; bj < 2; ++bj) { f32x4 a = acc[ai][bj][m][0], b = acc[ai][bj][m][1]; rope8(a, b, c4, s4); a = a * sc; b = b * sc;
                        *(u32x4*)(O + (size_t)row * 1024 + colt + bj * HALF) = pack8(a, b); } }
        } else if (pn < 16) {
            const bool isg = pn >= 12; bf16_t* O = isg ? Gr : Vr; const int colt = (pn & 3) * 256 + cl;
#pragma unroll
            for (int ai = 0; ai < 2; ++ai)
#pragma unroll
                for (int m = 0; m < 4; ++m) { const int row = row0 + ai * HALF + m * 16;
#pragma unroll
                    for (int bj = 0; bj < 2; ++bj) { f32x4 a = acc[ai][bj][m][0], b = acc[ai][bj][m][1];
                        if (isg) {
#pragma unroll
                            for (int i = 0; i < 4; ++i) { a[i] = silu_f(a[i]); b[i] = silu_f(b[i]); } }
                        *(u32x4*)(O + (size_t)row * 1024 + colt + bj * HALF) = pack8(a, b); } }
        } else if (pn < 20) {
            bf16_t* O = pn < 18 ? CQ : CKV; float* sq = pn < 18 ? ssq_q : ssq_kv; const int colt = (pn & 1) * 256 + cl;
#pragma unroll
            for (int ai = 0; ai < 2; ++ai)
#pragma unroll
                for (int m = 0; m < 4; ++m) { const int row = row0 + ai * HALF + m * 16; float s = 0.f;
#pragma unroll
                    for (int bj = 0; bj < 2; ++bj) { const f32x4 a = acc[ai][bj][m][0], b = acc[ai][bj][m][1];
                        s += (a[0] * a[0] + a[1] * a[1]) + (a[2] * a[2] + a[3] * a[3]) + (b[0] * b[0] + b[1] * b[1]) + (b[2] * b[2] + b[3] * b[3]);
                        *(u32x4*)(O + (size_t)row * 512 + colt + bj * HALF) = pack8(a, b); }
                    s += __shfl_xor(s, 16); s += __shfl_xor(s, 32);
                    if (fq == 0) atomicAdd(sq + row, s); }
        } else {
            if (wc < 2) {
#pragma unroll
                for (int ai = 0; ai < 2; ++ai)
#pragma unroll
                    for (int m = 0; m < 4; ++m) { const int row = row0 + ai * HALF + m * 16;
                        const f32x4 c4 = *(const f32x4*)(cosm + (size_t)row * 32 + (cl >> 1)), s4 = *(const f32x4*)(sinm + (size_t)row * 32 + (cl >> 1));
                        f32x4 a = acc[ai][0][m][0], b = acc[ai][0][m][1]; rope8(a, b, c4, s4); const u32x4 w = pack8(a, b);
#pragma unroll
                        for (int h = 0; h < 8; ++h) *(u32x4*)(Kbuf + (size_t)row * 1536 + h * 192 + 128 + cl) = w; }
            }
        }
    }
};
struct EpiUpQ {
    static constexpr bool PERM = true, AFTER_DRAIN = false;
    const float* ssq; bf16_t* Qm; const float *cosm, *sinm;
    __device__ __forceinline__ void operator()(const f32x4 (&acc)[2][2][4][2], const Unit& u, int wr, int wc, int fr, int fq) const {
        const int row0 = u.pm * BM + wr * 64 + fr, cl = wc * 32 + 8 * fq;
#pragma unroll
        for (int ai = 0; ai < 2; ++ai)
#pragma unroll
            for (int m = 0; m < 4; ++m) { const int row = row0 + ai * HALF + m * 16; const float rstd = rsqrtf(ssq[row] * (1.f / 512.f) + NORM_EPS);
#pragma unroll
                for (int bj = 0; bj < 2; ++bj) { const int c = u.pn * 256 + bj * HALF + cl, d = c % 192; f32x4 a = acc[ai][bj][m][0] * rstd, b = acc[ai][bj][m][1] * rstd;
                    if (d >= 128) { const int fi = (d - 128) >> 1; const f32x4 c4 = *(const f32x4*)(cosm + (size_t)row * 32 + fi), s4 = *(const f32x4*)(sinm + (size_t)row * 32 + fi); rope8(a, b, c4, s4); }
                    *(u32x4*)(Qm + (size_t)row * 1536 + c) = pack8(a, b); } }
    }
};
struct EpiUpKV {
    static constexpr bool PERM = true, AFTER_DRAIN = false;
    const float* ssq; bf16_t *Kbuf, *Vm;
    __device__ __forceinline__ void operator()(const f32x4 (&acc)[2][2][4][2], const Unit& u, int wr, int wc, int fr, int fq) const {
        const int row0 = u.pm * BM + wr * 64 + fr, cl = wc * 32 + 8 * fq;
#pragma unroll
        for (int ai = 0; ai < 2; ++ai)
#pragma unroll
            for (int m = 0; m < 4; ++m) { const int row = row0 + ai * HALF + m * 16; const float rstd = rsqrtf(ssq[row] * (1.f / 512.f) + NORM_EPS);
                *(u32x4*)(Kbuf + (size_t)row * 1536 + u.pn * 192 + cl) = pack8(acc[ai][0][m][0] * rstd, acc[ai][0][m][1] * rstd);
                *(u32x4*)(Vm + (size_t)row * 1024 + u.pn * 128 + cl) = pack8(acc[ai][1][m][0] * rstd, acc[ai][1][m][1] * rstd); }
    }
};
struct EpiGateRes {
    static constexpr bool PERM = true, AFTER_DRAIN = false;
    const float* x; const float* gate; float* out;
    __device__ __forceinline__ void operator()(const f32x4 (&acc)[2][2][4][2], const Unit& u, int wr, int wc, int fr, int fq) const {
        const int row0 = u.pm * BM + wr * 64 + fr, cl = wc * 32 + 8 * fq, b = u.pm >> 4;
#pragma unroll
        for (int bj = 0; bj < 2; ++bj) { const int c = u.pn * 256 + bj * HALF + cl;
            const f32x4 g0 = *(const f32x4*)(gate + (size_t)b * 12288 + c), g1 = *(const f32x4*)(gate + (size_t)b * 12288 + c + 4);
#pragma unroll
            for (int ai = 0; ai < 2; ++ai)
#pragma unroll
                for (int m = 0; m < 4; ++m) { const size_t off = (size_t)(row0 + ai * HALF + m * 16) * 2048 + c;
                    const f32x4 x0 = *(const f32x4*)(x + off), x1 = *(const f32x4*)(x + off + 4);
                    *(f32x4*)(out + off) = x0 + g0 * acc[ai][bj][m][0]; *(f32x4*)(out + off + 4) = x1 + g1 * acc[ai][bj][m][1]; } }
    }
};
struct EpiGU {
    static constexpr bool PERM = true, AFTER_DRAIN = false;
    bf16_t* Aff;
    __device__ __forceinline__ void operator()(const f32x4 (&acc)[2][2][4][2], const Unit& u, int wr, int wc, int fr, int fq) const {
        const int row0 = u.pm * BM + wr * 64 + fr, cl = wc * 32 + 8 * fq;
#pragma unroll
        for (int ai = 0; ai < 2; ++ai)
#pragma unroll
            for (int m = 0; m < 4; ++m) { const int row = row0 + ai * HALF + m * 16; f32x4 a, b;
#pragma unroll
                for (int i = 0; i < 4; ++i) { a[i] = silu_f(acc[ai][0][m][0][i]) * acc[ai][1][m][0][i]; b[i] = silu_f(acc[ai][0][m][1][i]) * acc[ai][1][m][1][i]; }
                *(u32x4*)(Aff + (size_t)row * 5632 + u.pn * 128 + cl) = pack8(a, b); }
    }
};

template <class Epi, class Sched, bool ALIGN_EPI = false, bool SP2 = false>
__device__ __forceinline__ void gemm_phase(PG8_LAS unsigned char* lds, const Gemm g, const Sched& S, const Epi& E) {
    const int tid = threadIdx.x, wid = __builtin_amdgcn_readfirstlane(tid >> 6), lane = tid & 63, wr = wid >> 2, wc = wid & 3, fr = lane & 15, fq = lane >> 4;
    const int K = g.K, nt = K / BK;
    unsigned voffA[2], voffB[2];
#pragma unroll
    for (int i = 0; i < 2; ++i) { int R, C; stage_rc(tid * 16 + i * 8192, R, C); const int Rb = Epi::PERM ? ((R & ~31) + perm32(R & 31)) : R;
        voffA[i] = (unsigned)(R * K + C) * 2u; voffB[i] = (unsigned)(Rb * K + C) * 2u; }
    const size_t kstep = (size_t)(BK * 2);
    const size_t hstep = (size_t)HALF * K * 2;
    const size_t tstep = 2 * hstep;
    const unsigned ldsw = (unsigned)wid * 1024u;
    const int aoff = lds_byte(wr * 64 + fr, fq * 8), boff = lds_byte(wc * 32 + fr, fq * 8);
#define PG8_SA(b, h) (((b) * 2 + (h)) * HTB)
#define PG8_SB(b, h) ((4 + (b) * 2 + (h)) * HTB)
#define PG8_STAGE(bufoff, gbase, voff) do { _Pragma("unroll") for (int _i = 0; _i < 2; ++_i) \
        __builtin_amdgcn_global_load_lds((const unsigned*)((const char*)(gbase) + (voff)[_i]), (PG8_LAS unsigned*)(lds + (bufoff) + ldsw + _i * 8192), 16, 0, 0); } while (0)
#define PG8_LDA(dst, b, h) do { _Pragma("unroll") for (int m = 0; m < 4; ++m) _Pragma("unroll") for (int k = 0; k < 2; ++k) dst[m][k] = *(const PG8_LAS bf16x8*)(lds + PG8_SA(b, h) + aoff + m * 2048 + k * 1024); } while (0)
#define PG8_LDB(dst, b, h) do { _Pragma("unroll") for (int n = 0; n < 2; ++n) _Pragma("unroll") for (int k = 0; k < 2; ++k) dst[n][k] = *(const PG8_LAS bf16x8*)(lds + PG8_SB(b, h) + boff + n * 2048 + k * 1024); } while (0)
#define PG8_MMA(ai, bj, At, Bt) do { __builtin_amdgcn_s_setprio(1); _Pragma("unroll") for (int m = 0; m < 4; ++m) _Pragma("unroll") for (int n = 0; n < 2; ++n) _Pragma("unroll") for (int k = 0; k < 2; ++k) \
        acc[ai][bj][m][n] = __builtin_amdgcn_mfma_f32_16x16x32_bf16(Bt[n][k], At[m][k], acc[ai][bj][m][n], 0, 0, 0); __builtin_amdgcn_s_setprio(0); } while (0)
#define PG8_WAIT_V(n) asm volatile("s_waitcnt vmcnt(" #n ")" ::: "memory")
#define PG8_WAIT_L(n) asm volatile("s_waitcnt lgkmcnt(" #n ")" ::: "memory")
#define PG8_BAR __builtin_amdgcn_s_barrier()
#define PG8_SCHED __builtin_amdgcn_sched_barrier(0)
    Unit cur, nxt; int ui = 0;
    if (!S.next(0, cur)) return;
    f32x4 acc[2][2][4][2];
#pragma unroll
    for (int a = 0; a < 2; ++a)
#pragma unroll
        for (int b = 0; b < 2; ++b)
#pragma unroll
            for (int m = 0; m < 4; ++m)
#pragma unroll
                for (int n = 0; n < 2; ++n) acc[a][b][m][n] = (f32x4){0.f, 0.f, 0.f, 0.f};
    bf16x8 At[4][2], B0[2][2], B1[2][2];
    const char* cA = (const char*)g.A + (size_t)cur.pm * tstep; const char* cB = (const char*)g.Bt + (size_t)cur.pn * tstep;
    S.a_ready(cur);
    if constexpr (SP2) {
        PG8_STAGE(PG8_SB(0, 0), cB, voffB); PG8_STAGE(PG8_SB(0, 1), cB + hstep, voffB); PG8_STAGE(PG8_SA(0, 0), cA, voffA); PG8_STAGE(PG8_SA(0, 1), cA + hstep, voffA);
        if (wr == 1) PG8_BAR;
        PG8_WAIT_V(2); PG8_BAR;
        PG8_STAGE(PG8_SB(1, 0), cB + kstep, voffB); PG8_STAGE(PG8_SA(1, 0), cA + kstep, voffA); PG8_STAGE(PG8_SB(1, 1), cB + hstep + kstep, voffB);
        PG8_WAIT_V(6); PG8_BAR;
    } else {
        PG8_STAGE(PG8_SB(0, 0), cB, voffB); PG8_STAGE(PG8_SA(0, 0), cA, voffA); PG8_STAGE(PG8_SB(0, 1), cB + hstep, voffB); PG8_STAGE(PG8_SA(0, 1), cA + hstep, voffA);
        if (wr == 1) PG8_BAR;
        PG8_WAIT_V(4); PG8_BAR;
        PG8_STAGE(PG8_SB(1, 0), cB + kstep, voffB); PG8_STAGE(PG8_SA(1, 0), cA + kstep, voffA); PG8_STAGE(PG8_SB(1, 1), cB + hstep + kstep, voffB);
        PG8_WAIT_V(6); PG8_BAR;
    }
    for (;;) {
        const bool has_next = S.next(ui + 1, nxt);
        const char* nA = has_next ? (const char*)g.A + (size_t)nxt.pm * tstep : cA; const char* nB = has_next ? (const char*)g.Bt + (size_t)nxt.pn * tstep : cB;
        for (int t = 0; t < nt; t += 2) {
            const bool last = (t == nt - 2);
            const char* a1 = cA + (size_t)(t + 1) * kstep;
            const char* a2 = last ? nA : cA + (size_t)(t + 2) * kstep; const char* b2 = last ? nB : cB + (size_t)(t + 2) * kstep;
            const char* a3 = a2 + kstep; const char* b3 = b2 + kstep;
            if (last && has_next) S.a_ready(nxt);
            if constexpr (SP2) {
            PG8_LDB(B0, 0, 0); PG8_LDB(B1, 0, 1); PG8_SCHED; PG8_LDA(At, 0, 0); PG8_STAGE(PG8_SA(1, 1), a1 + hstep, voffA);
            PG8_WAIT_V(8); PG8_WAIT_L(0); PG8_BAR; PG8_MMA(0, 0, At, B0); PG8_MMA(0, 1, At, B1); PG8_BAR; PG8_SCHED;
            PG8_LDA(At, 0, 1); PG8_STAGE(PG8_SB(0, 0), b2, voffB); PG8_STAGE(PG8_SB(0, 1), b2 + hstep, voffB); PG8_STAGE(PG8_SA(0, 0), a2, voffA);
            PG8_WAIT_V(8); PG8_WAIT_L(0); PG8_BAR; PG8_MMA(1, 0, At, B0); PG8_MMA(1, 1, At, B1); PG8_BAR; PG8_SCHED;
            PG8_LDB(B0, 1, 0); PG8_LDB(B1, 1, 1); PG8_SCHED; PG8_LDA(At, 1, 0); PG8_STAGE(PG8_SA(0, 1), a2 + hstep, voffA);
            PG8_WAIT_V(8); PG8_WAIT_L(0); PG8_BAR; PG8_MMA(0, 0, At, B0); PG8_MMA(0, 1, At, B1); PG8_BAR; PG8_SCHED;
            PG8_LDA(At, 1, 1); PG8_STAGE(PG8_SB(1, 0), b3, voffB); PG8_STAGE(PG8_SB(1, 1), b3 + hstep, voffB); PG8_STAGE(PG8_SA(1, 0), a3, voffA);
            PG8_WAIT_V(8); PG8_WAIT_L(0); PG8_BAR; PG8_MMA(1, 0, At, B0); PG8_MMA(1, 1, At, B1); PG8_BAR; PG8_SCHED;
            } else {
            PG8_LDB(B0, 0, 0); PG8_SCHED; PG8_LDA(At, 0, 0); PG8_STAGE(PG8_SA(1, 1), a1 + hstep, voffA);
            PG8_WAIT_L(8); PG8_BAR; PG8_WAIT_L(0); PG8_MMA(0, 0, At, B0); PG8_BAR; PG8_SCHED;
            PG8_LDB(B1, 0, 1); PG8_STAGE(PG8_SB(0, 0), b2, voffB);
            PG8_BAR; PG8_WAIT_L(0); PG8_MMA(0, 1, At, B1); PG8_BAR;
            PG8_LDA(At, 0, 1); PG8_STAGE(PG8_SA(0, 0), a2, voffA);
            PG8_BAR; PG8_WAIT_L(0); PG8_MMA(1, 0, At, B0); PG8_BAR; PG8_SCHED;
            PG8_STAGE(PG8_SB(0, 1), b2 + hstep, voffB);
            PG8_WAIT_V(6); PG8_BAR; PG8_MMA(1, 1, At, B1); PG8_BAR;
            PG8_LDB(B0, 1, 0); PG8_SCHED; PG8_LDA(At, 1, 0); PG8_STAGE(PG8_SA(0, 1), a2 + hstep, voffA);
            PG8_WAIT_L(8); PG8_BAR; PG8_WAIT_L(0); PG8_MMA(0, 0, At, B0); PG8_BAR; PG8_SCHED;
            PG8_LDB(B1, 1, 1); PG8_STAGE(PG8_SB(1, 0), b3, voffB);
            PG8_BAR; PG8_WAIT_L(0); PG8_MMA(0, 1, At, B1); PG8_BAR;
            PG8_LDA(At, 1, 1); PG8_STAGE(PG8_SA(1, 0), a3, voffA);
            PG8_BAR; PG8_WAIT_L(0); PG8_MMA(1, 0, At, B0); PG8_BAR; PG8_SCHED;
            PG8_STAGE(PG8_SB(1, 1), b3 + hstep, voffB);
            PG8_WAIT_V(6); PG8_BAR; PG8_MMA(1, 1, At, B1); PG8_BAR;
            }
        }
        if constexpr (ALIGN_EPI) { if (wr == 0) PG8_BAR; }
        if constexpr (!Epi::AFTER_DRAIN) { E(acc, cur, wr, wc, fr, fq); S.done(cur); }
        if (!has_next) break;
#pragma unroll
        for (int a = 0; a < 2; ++a)
#pragma unroll
            for (int b = 0; b < 2; ++b)
#pragma unroll
                for (int m = 0; m < 4; ++m)
#pragma unroll
                    for (int n = 0; n < 2; ++n) acc[a][b][m][n] = (f32x4){0.f, 0.f, 0.f, 0.f};
        cur = nxt; cA = nA; cB = nB; ++ui;
        if constexpr (ALIGN_EPI) { if (wr == 1) PG8_BAR; }
    }
    PG8_WAIT_V(0);
    if constexpr (!ALIGN_EPI) { if (wr == 0) PG8_BAR; }
    PG8_BAR;
    if constexpr (Epi::AFTER_DRAIN) { E.fused(acc, cur, wr, wc, fr, fq, lds, wid, lane); S.done(cur); }
#undef PG8_SA
#undef PG8_SB
#undef PG8_STAGE
#undef PG8_LDA
#undef PG8_LDB
#undef PG8_MMA
#undef PG8_WAIT_V
#undef PG8_WAIT_L
#undef PG8_BAR
#undef PG8_SCHED
}
}

namespace att {
typedef unsigned short bf16_t;
using bf16x8 = __attribute__((ext_vector_type(8))) short;
using s16x4  = __attribute__((ext_vector_type(4))) short;
using f32x16 = __attribute__((ext_vector_type(16))) float;
using f32x4  = __attribute__((ext_vector_type(4))) float;
using u32x4  = __attribute__((ext_vector_type(4))) unsigned;
using u32x2  = __attribute__((ext_vector_type(2))) unsigned;
constexpr int NW = 8, QBLK = 32, KVBLK = 64;
constexpr int LDQ = 1536, LDK = 1536, LDV = 1024, LDO = 1024;
constexpr float SCALE = 0.07216878364870323f;
constexpr float THR = 8.f;
constexpr int NQR = 8;
constexpr int SHM_V = KVBLK * 128 * 2, SHM_K = KVBLK * 192 * 2, SHM_ATTN = 2 * SHM_V + 2 * SHM_K + NW * 64 * 4;
#define AKSWZ(row, colB) ((row) * 384 + ((colB) ^ (((((row) >> 1) & 3) | (((row) >> 2) & 4)) << 4)))
#define KSWZ128(row, colB) ((row) * 256 + ((colB) ^ (((row) & 7) << 4)))
#define SBAR() __builtin_amdgcn_sched_barrier(0)
#define GAS __attribute__((address_space(1)))
__device__ __forceinline__ const GAS char* uniform_ptr(const void* p) { const unsigned long long v = (unsigned long long)p; const unsigned lo = __builtin_amdgcn_readfirstlane((unsigned)v), hi = __builtin_amdgcn_readfirstlane((unsigned)(v >> 32)); return (const GAS char*)(((unsigned long long)hi << 32) | lo); }
__device__ __forceinline__ int crow(int r, int hi) { return (r & 3) + 8 * (r >> 2) + 4 * hi; }
__device__ __forceinline__ unsigned cvtpk(float lo, float hi) { unsigned r; asm volatile("v_cvt_pk_bf16_f32 %0, %1, %2" : "=v"(r) : "v"(lo), "v"(hi)); return pg8::coarse2(r); }
__device__ __forceinline__ float swap_sum(float v) { auto rr = __builtin_amdgcn_permlane32_swap(__float_as_uint(v), __float_as_uint(v), false, false); return __uint_as_float(rr[0]) + __uint_as_float(rr[1]); }

__device__ __forceinline__ void partialSM(f32x16& p0, f32x16& p1, float& m_reg, float& mn, float& alpha) {
  constexpr float C = SCALE * 1.4426950408889634f;
  float pmax = p0[0];
#pragma unroll
  for (int r = 1; r < 16; ++r) pmax = fmaxf(pmax, p0[r]);
#pragma unroll
  for (int r = 0; r < 16; ++r) pmax = fmaxf(pmax, p1[r]);
  { auto rr = __builtin_amdgcn_permlane32_swap(__float_as_uint(pmax), __float_as_uint(pmax), false, false);
    pmax = fmaxf(__uint_as_float(rr[0]), __uint_as_float(rr[1])); }
  if (__builtin_expect(__all(pmax - m_reg <= THR / SCALE), 1)) { mn = m_reg; alpha = 1.f; }
  else { mn = fmaxf(m_reg, pmax); alpha = __builtin_amdgcn_exp2f((m_reg - mn) * C); m_reg = mn; }
  float mnC = -mn * C;
#pragma unroll
  for (int r = 0; r < 16; ++r) p0[r] = fmaf(p0[r], C, mnC);
#pragma unroll
  for (int r = 0; r < 16; ++r) p1[r] = fmaf(p1[r], C, mnC);
#pragma unroll
  for (int r = 0; r < 16; ++r) p0[r] = __builtin_amdgcn_exp2f(p0[r]);
}
#define PK4(P, BASE, OUT) do { unsigned a0 = cvtpk(P[BASE + 0], P[BASE + 1]), a1 = cvtpk(P[BASE + 2], P[BASE + 3]);   \
    unsigned b0 = cvtpk(P[BASE + 4], P[BASE + 5]), b1 = cvtpk(P[BASE + 6], P[BASE + 7]);                              \
    auto r0 = __builtin_amdgcn_permlane32_swap(a0, b0, false, false); auto r1 = __builtin_amdgcn_permlane32_swap(a1, b1, false, false); \
    u32x4 w = {r0[0], r1[0], r0[1], r1[1]}; OUT = *reinterpret_cast<bf16x8*>(&w); } while (0)
__device__ __forceinline__ void finishSM(f32x16& p0, f32x16& p1, float alpha, float& l_reg, bf16x8& pa0, bf16x8& pa1, bf16x8& pa2, bf16x8& pa3) {
#pragma unroll
  for (int r = 0; r < 16; ++r) p1[r] = __builtin_amdgcn_exp2f(p1[r]);
  float ps = 0;
#pragma unroll
  for (int r = 0; r < 16; ++r) ps += p0[r];
#pragma unroll
  for (int r = 0; r < 16; ++r) ps += p1[r];
  ps = swap_sum(ps);
  l_reg = l_reg * alpha + ps;
  PK4(p0, 0, pa0); PK4(p0, 8, pa1); PK4(p1, 0, pa2); PK4(p1, 8, pa3);
}
__device__ __forceinline__ void qkt192(f32x16& p0, f32x16& p1, const char* Ks, const bf16x8 (&qr)[NQR], const char* Qs, int r32, int hi) {
  p0 = f32x16{}; p1 = f32x16{};
#pragma unroll
  for (int d0 = 0; d0 < 12; ++d0) { int cb = (d0 * 16 + hi * 8) * 2;
    bf16x8 b0 = *reinterpret_cast<const bf16x8*>(Ks + AKSWZ(r32, cb));
    bf16x8 b1 = *reinterpret_cast<const bf16x8*>(Ks + AKSWZ(32 + r32, cb));
    bf16x8 qv; if (d0 < NQR) qv = qr[d0 < NQR ? d0 : 0]; else qv = *reinterpret_cast<const bf16x8*>(Qs + (d0 - NQR) * 1024);
    p0 = __builtin_amdgcn_mfma_f32_32x32x16_bf16(b0, qv, p0, 0, 0, 0);
    p1 = __builtin_amdgcn_mfma_f32_32x32x16_bf16(b1, qv, p1, 0, 0, 0); }
}
__device__ __forceinline__ void qkt128(f32x16& p0, f32x16& p1, const char* Ks, const bf16x8 (&qr)[8], int r32, int hi) {
  p0 = f32x16{}; p1 = f32x16{};
#pragma unroll
  for (int d0 = 0; d0 < 8; ++d0) { int cb = (d0 * 16 + hi * 8) * 2;
    bf16x8 b0 = *reinterpret_cast<const bf16x8*>(Ks + KSWZ128(r32, cb));
    bf16x8 b1 = *reinterpret_cast<const bf16x8*>(Ks + KSWZ128(32 + r32, cb));
    p0 = __builtin_amdgcn_mfma_f32_32x32x16_bf16(b0, qr[d0], p0, 0, 0, 0);
    p1 = __builtin_amdgcn_mfma_f32_32x32x16_bf16(b1, qr[d0], p1, 0, 0, 0); }
}
__device__ __forceinline__ int v_st(int k, int c) { const int kk = (k & ~0xC) | ((k & 4) << 1) | ((k & 8) >> 1); return ((kk >> 3) * 4 + (c >> 5)) * 512 + ((kk & 7) * 32 + (c & 31)) * 2; }
__device__ __forceinline__ int v_rd_base(int lane) { return ((lane & 3) << 3) | (((lane >> 2) & 3) << 6) | (((lane >> 4) & 1) << 5) | (((lane >> 5) & 1) << 8); }
constexpr int v_rd_off(int d0, int ks, int half) { return d0 * 512 + ks * 4096 + half * 2048; }
template <int OFF> __device__ __forceinline__ s16x4 tr_read(int vb) {
  s16x4 r; asm volatile("ds_read_b64_tr_b16 %0, %1 offset:%2" : "=&v"(r) : "v"(vb), "i"(OFF) : "memory"); return r;
}
#define PKLH(L, H) (bf16x8){L[0], L[1], L[2], L[3], H[0], H[1], H[2], H[3]}
template <int D0> __device__ __forceinline__ void pv_one(f32x16& od, int vb, bf16x8 pa0, bf16x8 pa1, bf16x8 pa2, bf16x8 pa3) {
  const s16x4 l0 = tr_read<v_rd_off(D0, 0, 0)>(vb), h0 = tr_read<v_rd_off(D0, 0, 1)>(vb), l1 = tr_read<v_rd_off(D0, 1, 0)>(vb), h1 = tr_read<v_rd_off(D0, 1, 1)>(vb);
  const s16x4 l2 = tr_read<v_rd_off(D0, 2, 0)>(vb), h2 = tr_read<v_rd_off(D0, 2, 1)>(vb), l3 = tr_read<v_rd_off(D0, 3, 0)>(vb), h3 = tr_read<v_rd_off(D0, 3, 1)>(vb);
  asm volatile("s_waitcnt lgkmcnt(0)" ::: "memory"); SBAR();
  od = __builtin_amdgcn_mfma_f32_32x32x16_bf16(pa0, PKLH(l0, h0), od, 0, 0, 0);
  od = __builtin_amdgcn_mfma_f32_32x32x16_bf16(pa1, PKLH(l1, h1), od, 0, 0, 0);
  od = __builtin_amdgcn_mfma_f32_32x32x16_bf16(pa2, PKLH(l2, h2), od, 0, 0, 0);
  od = __builtin_amdgcn_mfma_f32_32x32x16_bf16(pa3, PKLH(l3, h3), od, 0, 0, 0);
}
__device__ __forceinline__ void pv_d0(f32x16* o, int vb, bf16x8 pa0, bf16x8 pa1, bf16x8 pa2, bf16x8 pa3) {
  pv_one<0>(o[0], vb, pa0, pa1, pa2, pa3); pv_one<1>(o[1], vb, pa0, pa1, pa2, pa3); pv_one<2>(o[2], vb, pa0, pa1, pa2, pa3); pv_one<3>(o[3], vb, pa0, pa1, pa2, pa3);
}
template <int D0> __device__ __forceinline__ void pvT_one(f32x16& od, int vb, bf16x8 pa0, bf16x8 pa1, bf16x8 pa2, bf16x8 pa3) {
  const s16x4 l0 = tr_read<v_rd_off(D0, 0, 0)>(vb), h0 = tr_read<v_rd_off(D0, 0, 1)>(vb), l1 = tr_read<v_rd_off(D0, 1, 0)>(vb), h1 = tr_read<v_rd_off(D0, 1, 1)>(vb);
  const s16x4 l2 = tr_read<v_rd_off(D0, 2, 0)>(vb), h2 = tr_read<v_rd_off(D0, 2, 1)>(vb), l3 = tr_read<v_rd_off(D0, 3, 0)>(vb), h3 = tr_read<v_rd_off(D0, 3, 1)>(vb);
  asm volatile("s_waitcnt lgkmcnt(0)" ::: "memory"); SBAR();
  od = __builtin_amdgcn_mfma_f32_32x32x16_bf16(PKLH(l0, h0), pa0, od, 0, 0, 0);
  od = __builtin_amdgcn_mfma_f32_32x32x16_bf16(PKLH(l1, h1), pa1, od, 0, 0, 0);
  od = __builtin_amdgcn_mfma_f32_32x32x16_bf16(PKLH(l2, h2), pa2, od, 0, 0, 0);
  od = __builtin_amdgcn_mfma_f32_32x32x16_bf16(PKLH(l3, h3), pa3, od, 0, 0, 0);
}

__device__ __forceinline__ void attn_unit(const bf16_t* __restrict__ Qb, const bf16_t* __restrict__ Kh, const bf16_t* __restrict__ Vh, bf16_t* __restrict__ Ob, int seq, char* lds, int ldsaddr) {
  const int tid = threadIdx.x, wid = tid >> 6, lane = tid & 63, r32 = lane & 31, hi = lane >> 5;
  char* V_lds = lds; char* K_lds = lds + 2 * SHM_V;
  float* ws = (float*)(lds + 2 * SHM_V + 2 * SHM_K) + wid * 64; float* li_l = ws; float* al_l = ws + 32;
  float m_reg = -1e30f, l_reg = 0; f32x16 o[4] = {}; bf16x8 qr[NQR];
  const bf16_t* Qw = Qb + (long)(wid * QBLK + r32) * LDQ + hi * 8;
  char* Qs = lds + SHM_ATTN + wid * ((12 - NQR) * 1024) + lane * 16;
#pragma unroll
  for (int d0 = 0; d0 < NQR; ++d0) qr[d0] = *reinterpret_cast<const bf16x8*>(Qw + d0 * 16);
#pragma unroll
  for (int d0 = NQR; d0 < 12; ++d0) *(bf16x8*)(Qs + (d0 - NQR) * 1024) = *reinterpret_cast<const bf16x8*>(Qw + d0 * 16);
  const int sr = tid >> 4, sc = (tid & 15) * 8, vst0 = v_st(sr, sc), vst1 = v_st(32 + sr, sc);
  unsigned kg0, kg1, kg2; int kl0, kl1, kl2;
  { int p = tid;        int kr = p / 24, kc = (p % 24) * 8; kg0 = (unsigned)(kr * LDK + kc) * 2u; kl0 = AKSWZ(kr, kc * 2);
    p = tid + 512;      kr = p / 24; kc = (p % 24) * 8;     kg1 = (unsigned)(kr * LDK + kc) * 2u; kl1 = AKSWZ(kr, kc * 2);
    p = tid + 1024;     kr = p / 24; kc = (p % 24) * 8;     kg2 = (unsigned)(kr * LDK + kc) * 2u; kl2 = AKSWZ(kr, kc * 2); }
  const unsigned vg0 = (unsigned)(sr * LDV + sc) * 2u, vg1 = (unsigned)((32 + sr) * LDV + sc) * 2u;
  const int vb0 = ldsaddr + v_rd_base(lane);
  bf16x8 vs0, vs1, ks0, ks1, ks2;
#define SLOAD(k0) do { const GAS char* vb_ = uniform_ptr((const char*)Vh + (size_t)(k0) * (LDV * 2)); const GAS char* kb_ = uniform_ptr((const char*)Kh + (size_t)(k0) * (LDK * 2)); \
    vs0 = *(const GAS bf16x8*)(vb_ + vg0); vs1 = *(const GAS bf16x8*)(vb_ + vg1); \
    ks0 = *(const GAS bf16x8*)(kb_ + kg0); ks1 = *(const GAS bf16x8*)(kb_ + kg1); ks2 = *(const GAS bf16x8*)(kb_ + kg2); } while (0)
#define SWRITE(b) do { *(bf16x8*)(V_lds + (b) * SHM_V + vst0) = vs0; *(bf16x8*)(V_lds + (b) * SHM_V + vst1) = vs1; \
    *(bf16x8*)(K_lds + (b) * SHM_K + kl0) = ks0; *(bf16x8*)(K_lds + (b) * SHM_K + kl1) = ks1; *(bf16x8*)(K_lds + (b) * SHM_K + kl2) = ks2; } while (0)
#define SWAIT() asm volatile("s_waitcnt vmcnt(0)" ::: "memory")
#define RESC(a) do { if (__any((a) < 1.f)) { if (hi == 0) al_l[r32] = (a); asm volatile("s_waitcnt lgkmcnt(0)" ::: "memory"); \
    _Pragma("unroll") for (int d = 0; d < 4; ++d) _Pragma("unroll") for (int r = 0; r < 16; ++r) o[d][r] *= al_l[crow(r, hi)]; } } while (0)
  f32x16 pA0, pA1, pB0, pB1; float mnA, mnB, alA, alB; bf16x8 pa0, pa1, pa2, pa3; const int NT = seq / KVBLK;
  __syncthreads();
  SLOAD(0); SWAIT(); SWRITE(0); __syncthreads();
  qkt192(pA0, pA1, K_lds, qr, Qs, r32, hi); partialSM(pA0, pA1, m_reg, mnA, alA);
  SLOAD(KVBLK);
  SWAIT(); SWRITE(1); __syncthreads();
  for (int j = 1; j + 1 < NT; j += 2) {
    SBAR(); qkt192(pB0, pB1, K_lds + SHM_K, qr, Qs, r32, hi);
    finishSM(pA0, pA1, alA, l_reg, pa0, pa1, pa2, pa3); SBAR();
    SLOAD((j + 1) * KVBLK); SBAR();
    pv_d0(o, vb0, pa0, pa1, pa2, pa3); partialSM(pB0, pB1, m_reg, mnB, alB);
    __syncthreads(); SWAIT(); SWRITE(0);
    RESC(alB); __syncthreads();
    SBAR(); qkt192(pA0, pA1, K_lds, qr, Qs, r32, hi);
    finishSM(pB0, pB1, alB, l_reg, pa0, pa1, pa2, pa3); SBAR();
    SLOAD((j + 2) * KVBLK); SBAR();
    pv_d0(o, vb0 + SHM_V, pa0, pa1, pa2, pa3); partialSM(pA0, pA1, m_reg, mnA, alA);
    __syncthreads(); SWAIT(); SWRITE(1);
    RESC(alA); __syncthreads();
  }
  SBAR(); qkt192(pB0, pB1, K_lds + SHM_K, qr, Qs, r32, hi);
  finishSM(pA0, pA1, alA, l_reg, pa0, pa1, pa2, pa3); SBAR();
  pv_d0(o, vb0, pa0, pa1, pa2, pa3); partialSM(pB0, pB1, m_reg, mnB, alB);
  __syncthreads(); RESC(alB);
  finishSM(pB0, pB1, alB, l_reg, pa0, pa1, pa2, pa3); SBAR();
  pv_d0(o, vb0 + SHM_V, pa0, pa1, pa2, pa3);
  if (hi == 0) li_l[r32] = l_reg; asm volatile("s_waitcnt lgkmcnt(0)" ::: "memory");
  float rli[16];
#pragma unroll
  for (int r = 0; r < 16; ++r) rli[r] = __builtin_amdgcn_rcpf(li_l[crow(r, hi)]);
  bf16_t* Ow = Ob + (long)(wid * QBLK) * LDO;
#pragma unroll
  for (int r = 0; r < 16; ++r) { int orow = crow(r, hi);
#pragma unroll
    for (int d0 = 0; d0 < 4; ++d0) Ow[(long)orow * LDO + d0 * 32 + r32] = (bf16_t)(cvtpk(o[d0][r] * rli[r], 0.f) & 0xffffu); }
#undef SLOAD
#undef SWRITE
#undef SWAIT
#undef RESC
}

__device__ __forceinline__ bf16x8 scale8(bf16x8 v, float s) {
  u32x4 w = *reinterpret_cast<u32x4*>(&v), o;
#pragma unroll
  for (int i = 0; i < 4; ++i) o[i] = cvtpk(__uint_as_float(w[i] << 16) * s, __uint_as_float(w[i] & 0xffff0000u) * s);
  return *reinterpret_cast<bf16x8*>(&o);
}
__device__ __forceinline__ s16x4 trr(int addr) { s16x4 r; asm volatile("ds_read_b64_tr_b16 %0, %1" : "=&v"(r) : "v"(addr) : "memory"); return r; }

__device__ __forceinline__ void chunk_kv_unit(const bf16_t* __restrict__ Kc, const bf16_t* __restrict__ Vc, bf16_t* __restrict__ CKf, bf16_t* __restrict__ CKb, float lgf, float lgb, char* lds, int ldsaddr) {
  const int tid = threadIdx.x, wid = tid >> 6, lane = tid & 63, r32 = lane & 31, hi = lane >> 5;
  const int dir = wid >> 2, db = wid & 3, d = 32 * db + r32;
  __syncthreads();
  { const int sr = tid >> 4, sc = (tid & 15) * 8;
#pragma unroll
    for (int i = 0; i < 4; ++i) { const int row = sr + 32 * i;
      *(bf16x8*)(lds + (row >> 6) * 16384 + v_st(row & 63, sc)) = *reinterpret_cast<const bf16x8*>(Vc + (long)row * 1024 + sc); } }
  bf16x8 kb[8];
  int hio = hi; asm volatile("" : "+v"(hio));
  const GAS char* kg = uniform_ptr(Kc); const unsigned kofs = (unsigned)((hio * 8) * 1024 + d) * 2u;
#pragma unroll
  for (int ks = 0; ks < 8; ++ks) { u32x4 w;
#pragma unroll
    for (int i = 0; i < 4; ++i) { const int s0 = ks * 16 + hio * 8 + 2 * i;
      const float k0 = __uint_as_float((unsigned)*(const GAS unsigned short*)(kg + kofs + (ks * 16 + 2 * i) * 2048) << 16), k1 = __uint_as_float((unsigned)*(const GAS unsigned short*)(kg + kofs + (ks * 16 + 2 * i + 1) * 2048) << 16);
      const float z0 = __builtin_amdgcn_exp2f(dir ? lgb * (float)s0 : lgf * (float)(127 - s0)), z1 = __builtin_amdgcn_exp2f(dir ? lgb * (float)(s0 + 1) : lgf * (float)(126 - s0));
      w[i] = cvtpk(k0 * z0, k1 * z1); }
    kb[ks] = *reinterpret_cast<bf16x8*>(&w); }
  __syncthreads();
  f32x16 acc[4] = {};
  const int vb = ldsaddr + v_rd_base(lane);
  pvT_one<0>(acc[0], vb, kb[0], kb[1], kb[2], kb[3]); pvT_one<1>(acc[1], vb, kb[0], kb[1], kb[2], kb[3]); pvT_one<2>(acc[2], vb, kb[0], kb[1], kb[2], kb[3]); pvT_one<3>(acc[3], vb, kb[0], kb[1], kb[2], kb[3]);
  pvT_one<0>(acc[0], vb + 16384, kb[4], kb[5], kb[6], kb[7]); pvT_one<1>(acc[1], vb + 16384, kb[4], kb[5], kb[6], kb[7]); pvT_one<2>(acc[2], vb + 16384, kb[4], kb[5], kb[6], kb[7]); pvT_one<3>(acc[3], vb + 16384, kb[4], kb[5], kb[6], kb[7]);
  bf16_t* CK = dir ? CKb : CKf;
#pragma unroll
  for (int eb = 0; eb < 4; ++eb)
#pragma unroll
    for (int r = 0; r < 16; ++r) CK[(32 * eb + crow(r, hi)) * 128 + d] = (bf16_t)(cvtpk(acc[eb][r], 0.f) & 0xffffu);
}

#ifndef PROBE_COMP
#define PROBE_COMP 0
#endif
__device__ __forceinline__ void ret_out_unit(const bf16_t* __restrict__ Qc, const bf16_t* __restrict__ Kc, const bf16_t* __restrict__ Vc, const bf16_t* __restrict__ Gc,
                                             const bf16_t* __restrict__ STf, const bf16_t* __restrict__ STb, const float* __restrict__ gnw, const float* __restrict__ gnb,
                                             bf16_t* __restrict__ Oc, float lgf, float lgb, char* lds, int ldsaddr, float* dump = nullptr) {
  const int tid = threadIdx.x, ht = tid & 255, wq = (tid >> 6) & 3, lane = tid & 63, r32 = lane & 31, hi = lane >> 5;
  __syncthreads();
  { const int sr = ht >> 4, sc = (ht & 15) * 8;
#pragma unroll
    for (int i = 0; i < 8; ++i) { const int row = sr + 16 * i, tile = row >> 6, key = row & 63;
      *(bf16x8*)(lds + tile * 16384 + KSWZ128(key, sc * 2)) = *reinterpret_cast<const bf16x8*>(Kc + (long)row * 1024 + sc);
      *(bf16x8*)(lds + 32768 + tile * 16384 + v_st(key, sc)) = *reinterpret_cast<const bf16x8*>(Vc + (long)row * 1024 + sc); } }
  const int c = 32 * wq + r32;
  bf16x8 qr[8];
#pragma unroll
  for (int d0 = 0; d0 < 8; ++d0) qr[d0] = *reinterpret_cast<const bf16x8*>(Qc + (long)c * 1024 + d0 * 16 + hi * 8);
  __syncthreads();
  f32x16 pA0, pA1, pB0, pB1;
  qkt128(pA0, pA1, lds, qr, r32, hi); qkt128(pB0, pB1, lds + 16384, qr, r32, hi);
  int cdec = c; asm volatile("" : "+v"(cdec));
#define DEC(P, JB) do { _Pragma("unroll") for (int r = 0; r < 16; ++r) { const int dl = cdec - ((JB) + crow(r, hi)); \
    P[r] *= __builtin_amdgcn_exp2f(dl >= 0 ? lgf * (float)dl : lgb * (float)(-dl)); } } while (0)
  DEC(pA0, 0); DEC(pA1, 32); DEC(pB0, 64); DEC(pB1, 96);
#undef DEC
  bf16x8 xa0, xa1, xa2, xa3, xb0, xb1, xb2, xb3;
  PK4(pA0, 0, xa0); PK4(pA0, 8, xa1); PK4(pA1, 0, xa2); PK4(pA1, 8, xa3);
  PK4(pB0, 0, xb0); PK4(pB0, 8, xb1); PK4(pB1, 0, xb2); PK4(pB1, 8, xb3);
  f32x16 o[4] = {};
  const int vb = ldsaddr + 32768 + v_rd_base(lane);
  if (PROBE_COMP == 0 || (PROBE_COMP & 1)) {
  pvT_one<0>(o[0], vb, xa0, xa1, xa2, xa3); pvT_one<1>(o[1], vb, xa0, xa1, xa2, xa3); pvT_one<2>(o[2], vb, xa0, xa1, xa2, xa3); pvT_one<3>(o[3], vb, xa0, xa1, xa2, xa3);
  pvT_one<0>(o[0], vb + 16384, xb0, xb1, xb2, xb3); pvT_one<1>(o[1], vb + 16384, xb0, xb1, xb2, xb3); pvT_one<2>(o[2], vb + 16384, xb0, xb1, xb2, xb3); pvT_one<3>(o[3], vb + 16384, xb0, xb1, xb2, xb3);
  }
#pragma unroll
  for (int dir = 0; dir < 2; ++dir) {
    if (PROBE_COMP != 0 && !((PROBE_COMP >> (1 + dir)) & 1)) continue;
    const float xi = __builtin_amdgcn_exp2f(dir == 0 ? lgf * (float)(c + 1) : lgb * (float)(128 - c));
    const bf16_t* ST = dir == 0 ? STf : STb;
    bf16x8 qs[8];
#pragma unroll
    for (int d0 = 0; d0 < 8; ++d0) qs[d0] = scale8(qr[d0], xi);
    const GAS char* stb = uniform_ptr(ST); const unsigned so = (unsigned)(r32 * 128 + hi * 8) * 2u;
#pragma unroll
    for (int eb = 0; eb < 4; ++eb) {
      bf16x8 A[8];
      SBAR();
#pragma unroll
      for (int d0 = 0; d0 < 8; ++d0) A[d0] = *(const GAS bf16x8*)(stb + so + (eb * 32 * 128 + d0 * 16) * 2);
#pragma unroll
      for (int d0 = 0; d0 < 8; ++d0) o[eb] = __builtin_amdgcn_mfma_f32_32x32x16_bf16(A[d0], qs[d0], o[eb], 0, 0, 0);
      SBAR();
    }
  }
  if (PROBE_COMP != 0) {
#pragma unroll
    for (int eb = 0; eb < 4; ++eb)
#pragma unroll
      for (int g = 0; g < 4; ++g) *(f32x4*)(dump + (long)c * 1024 + 32 * eb + 8 * g + 4 * hi) = (f32x4){o[eb][4 * g], o[eb][4 * g + 1], o[eb][4 * g + 2], o[eb][4 * g + 3]};
    return; }
  float s = 0.f;
#pragma unroll
  for (int eb = 0; eb < 4; ++eb)
#pragma unroll
    for (int r = 0; r < 16; ++r) s += o[eb][r];
  const float mu = swap_sum(s) * (1.f / 128.f);
  float q = 0.f;
#pragma unroll
  for (int eb = 0; eb < 4; ++eb)
#pragma unroll
    for (int r = 0; r < 16; ++r) { const float d = o[eb][r] - mu; q += d * d; }
  const float rstd = rsqrtf(swap_sum(q) * (1.f / 128.f) + 1e-6f);
#pragma unroll
  for (int eb = 0; eb < 4; ++eb)
#pragma unroll
    for (int g = 0; g < 4; ++g) { const int e0 = 32 * eb + 8 * g + 4 * hi;
      const f32x4 w4 = *(const f32x4*)(gnw + e0), b4 = *(const f32x4*)(gnb + e0);
      const u32x2 gg = *(const u32x2*)(Gc + (long)c * 1024 + e0);
      const float g0 = __uint_as_float(gg.x << 16), g1 = __uint_as_float(gg.x & 0xffff0000u), g2 = __uint_as_float(gg.y << 16), g3 = __uint_as_float(gg.y & 0xffff0000u);
      const float y0 = ((o[eb][4 * g] - mu) * rstd * w4[0] + b4[0]) * g0, y1 = ((o[eb][4 * g + 1] - mu) * rstd * w4[1] + b4[1]) * g1;
      const float y2 = ((o[eb][4 * g + 2] - mu) * rstd * w4[2] + b4[2]) * g2, y3 = ((o[eb][4 * g + 3] - mu) * rstd * w4[3] + b4[3]) * g3;
      u32x2 w; w.x = cvtpk(y0, y1); w.y = cvtpk(y2, y3);
      *(u32x2*)(Oc + (long)c * 2048 + e0) = w; }
}

__device__ __forceinline__ void ret_brute_unit(const bf16_t* __restrict__ Qh, const bf16_t* __restrict__ Kh, const bf16_t* __restrict__ Vh, const bf16_t* __restrict__ Gc,
                                               const float* __restrict__ gnw, const float* __restrict__ gnb, bf16_t* __restrict__ Oc, int t0, float lgf, float lgb, char* lds, const float* dump = nullptr) {
  const int tid = threadIdx.x, qi = tid >> 2, part = tid & 3, t = t0 + qi;
  float q[32], acc[32];
#pragma unroll
  for (int i = 0; i < 32; ++i) { q[i] = __uint_as_float((unsigned)Qh[(long)t * 1024 + part * 32 + i] << 16); acc[i] = 0.f; }
  for (int s0 = 0; s0 < 4096; s0 += 64) {
    { const int rel = s0 < t0 ? 1 : (s0 >= t0 + 128 ? 2 : 0); if (PROBE_COMP != 0 && ((PROBE_COMP >> rel) & 1)) continue; }
    __syncthreads();
    for (int c = tid; c < 64 * 16; c += 512) { const int r = c >> 4, c8 = (c & 15) * 8;
      *(bf16x8*)(lds + (r * 128 + c8) * 2) = *reinterpret_cast<const bf16x8*>(Kh + (long)(s0 + r) * 1024 + c8);
      *(bf16x8*)(lds + 16384 + (r * 128 + c8) * 2) = *reinterpret_cast<const bf16x8*>(Vh + (long)(s0 + r) * 1024 + c8); }
    __syncthreads();
    for (int j = 0; j < 64; ++j) { const int s = s0 + j; float d = 0.f;
      const unsigned short* kr = (const unsigned short*)(lds + (j * 128 + part * 32) * 2); const unsigned short* vr = (const unsigned short*)(lds + 16384 + (j * 128 + part * 32) * 2);
#pragma unroll
      for (int i = 0; i < 32; ++i) d += q[i] * __uint_as_float((unsigned)kr[i] << 16);
      d += __shfl_xor(d, 1); d += __shfl_xor(d, 2);
      const int dl = t - s; const float w = d * __builtin_amdgcn_exp2f(dl >= 0 ? lgf * (float)dl : lgb * (float)(-dl));
#pragma unroll
      for (int i = 0; i < 32; ++i) acc[i] += w * __uint_as_float((unsigned)vr[i] << 16); }
  }
  if (PROBE_COMP != 0) {
#pragma unroll
    for (int i = 0; i < 32; ++i) acc[i] += dump[(long)qi * 1024 + part * 32 + i]; }
  float sm = 0.f;
#pragma unroll
  for (int i = 0; i < 32; ++i) sm += acc[i];
  sm += __shfl_xor(sm, 1); sm += __shfl_xor(sm, 2); const float mu = sm * (1.f / 128.f);
  float qq = 0.f;
#pragma unroll
  for (int i = 0; i < 32; ++i) { const float dd = acc[i] - mu; qq += dd * dd; }
  qq += __shfl_xor(qq, 1); qq += __shfl_xor(qq, 2); const float rstd = rsqrtf(qq * (1.f / 128.f) + 1e-6f);
#pragma unroll
  for (int i = 0; i < 32; ++i) { const int e = part * 32 + i; const float g = __uint_as_float((unsigned)Gc[(long)qi * 1024 + e] << 16);
    Oc[(long)qi * 2048 + e] = (bf16_t)(cvtpk(((acc[i] - mu) * rstd * gnw[e] + gnb[e]) * g, 0.f) & 0xffffu); }
}
#undef SBAR
}


#ifndef PROBE_BRUTE_RET
#define PROBE_BRUTE_RET 0
#endif
#ifndef MK_SPLIT
#define MK_SPLIT 0
#endif
#define LAS __attribute__((address_space(3)))
#define GASX __attribute__((address_space(1)))
typedef unsigned short bf16_t;
typedef unsigned v4u __attribute__((ext_vector_type(4)));
typedef unsigned v2u __attribute__((ext_vector_type(2)));
typedef float f32x4 __attribute__((ext_vector_type(4)));
typedef short bf16x8 __attribute__((ext_vector_type(8)));

constexpr int BATCH = 8, SEQ = 4096, DM = 2048, T = BATCH * SEQ;
constexpr int INC = 5184, INCP = 5376, DFF = 5632, NMODC = 6 * DM;
constexpr int NPH = 11;
constexpr size_t MiB = 1u << 20;
constexpr size_t WS_CTL = 0, CTL_ZERO_BYTES = 2 * MiB;
constexpr size_t OFF_MOD = 0, OFF_SSQQ = 512 * 1024, OFF_SSQKV = 640 * 1024;
constexpr size_t WS_COSR = 2 * MiB, WS_SINR = 10 * MiB, WS_COSM = 18 * MiB, WS_SINM = 22 * MiB;
constexpr size_t WS_WIN = 26 * MiB, WS_WUQ = 47 * MiB, WS_WUKV = 49 * MiB, WS_WO = 51 * MiB, WS_WGU = 59 * MiB, WS_WDN = 103 * MiB;
constexpr size_t WS_H = 128 * MiB;
constexpr size_t WS_QR = 256 * MiB, WS_KR = 320 * MiB, WS_VR = 384 * MiB, WS_GR = 448 * MiB;
constexpr size_t WS_CQ = 512 * MiB, WS_CKV = 544 * MiB;
constexpr size_t WS_QM = 576 * MiB, WS_KB = 672 * MiB, WS_VM = 768 * MiB, WS_OAT = 832 * MiB, WS_END = 896 * MiB;
constexpr size_t WS_CAT = 576 * MiB;
constexpr size_t WS_AFF = 256 * MiB;
static_assert(WS_AFF + (size_t)T * DFF * 2 <= WS_END && WS_CAT + (size_t)T * 2048 * 2 <= WS_VM, "d_ws map");
constexpr int LDS_BAR_OFF = 150528;
constexpr size_t OFF_XBAR = 1536 * 1024;
constexpr int LDS_BYTES = 150528 + 64;

#define LDS_WAIT() asm volatile("s_waitcnt lgkmcnt(0)" ::: "memory")
__device__ __forceinline__ unsigned f2bf(float f) { unsigned u = __builtin_bit_cast(unsigned, f); return (u + 0x7fffu + ((u >> 16) & 1u)) >> 16; }
__device__ __forceinline__ unsigned pk2(float lo, float hi) { return f2bf(lo) | (f2bf(hi) << 16); }
__device__ __forceinline__ unsigned pk2a(float lo, float hi) { return pg8::coarse2(pk2(lo, hi)); }
__device__ __forceinline__ float wave_sum(float v) {
#pragma unroll
    for (int o = 1; o < 64; o <<= 1) v += __shfl_xor(v, o);
    return v;
}
__device__ __forceinline__ int dest_row(int mapid, int n) {
    switch (mapid) {
    case 1: if (n < 2048) { const int j = n & 127; return (n & ~127) + (j < 64 ? 2 * j : 2 * (j - 64) + 1); }
            if (n < 5120) return n;
            { const int j = n - 5120; return 5120 + (j < 32 ? 2 * j : 2 * (j - 32) + 1); }
    case 2: { const int d = n % 192; if (d < 128) return n; const int j = d - 128; return n - d + 128 + (j < 32 ? 2 * j : 2 * (j - 32) + 1); }
    case 3: return (n >> 7) * 256 + (n & 127);
    case 4: return (n >> 7) * 256 + 128 + (n & 127);
    default: return n;
    }
}
__device__ __forceinline__ void transpose_item(const float* __restrict__ W, int K, int N, bf16_t* __restrict__ WT, const float* __restrict__ kscale, int mapid, LAS float* scr, int item, int lane) {
    const int nblk = N / 32, kb = item / nblk, nb = item % nblk, k0 = 64 * kb, n0 = 32 * nb;
#pragma unroll 8
    for (int i = 0; i < 32; ++i) { const int kk = 2 * i + (lane >> 5); float v = W[(size_t)(k0 + kk) * N + n0 + (lane & 31)]; if (kscale) v *= kscale[k0 + kk]; scr[kk * 33 + (lane & 31)] = v; }
    LDS_WAIT(); asm volatile("" ::: "memory");
    const int c = lane & 7;
#pragma unroll
    for (int j = 0; j < 4; ++j) { const int n = (lane >> 3) + 8 * j; const LAS float* s = scr + (8 * c) * 33 + n;
        v4u o; o.x = pk2(s[0 * 33], s[1 * 33]); o.y = pk2(s[2 * 33], s[3 * 33]); o.z = pk2(s[4 * 33], s[5 * 33]); o.w = pk2(s[6 * 33], s[7 * 33]);
        *(v4u*)(WT + (size_t)dest_row(mapid, n0 + n) * K + k0 + 8 * c) = o; }
    LDS_WAIT(); asm volatile("" ::: "memory");
}
__device__ __forceinline__ void norm_row(const float* xrow, const float* __restrict__ w, const float* __restrict__ shift, const float* __restrict__ scale, bf16_t* ob, float* of, int lane) {
    const f32x4* xr = (const f32x4*)xrow + lane;
    f32x4 v[8]; float s = 0.f;
#pragma unroll
    for (int j = 0; j < 8; ++j) { v[j] = xr[64 * j]; s += (v[j].x * v[j].x + v[j].y * v[j].y) + (v[j].z * v[j].z + v[j].w * v[j].w); }
    const float rstd = rsqrtf(wave_sum(s) * (1.f / 2048.f) + 1e-6f);
#pragma unroll
    for (int j = 0; j < 8; ++j) { const int col = 4 * lane + 256 * j; f32x4 y = v[j] * rstd * *(const f32x4*)(w + col);
        if (shift) y = y * (*(const f32x4*)(scale + col) + 1.f) + *(const f32x4*)(shift + col);
        if (ob) { v2u o; o.x = pk2a(y.x, y.y); o.y = pk2a(y.z, y.w); *(v2u*)(ob + col) = o; } else *(f32x4*)(of + col) = y; }
}

#define XB_TMO      128
#define XB_XCNT(j)  (256  + 64 * (j))
#define XB_XSUB(j)  (1280 + 64 * (j))
#define XB_XGEN(j)  (2304 + 64 * (j))
#define XB_TOP      3328
#define XB_TOPGEN   3392
#define XCD_BAR_WORDS 3456
#define XB_SPIN_CAP (1u << 18)

__device__ __forceinline__ unsigned xb_ld(unsigned* p)              { return __hip_atomic_load(p, __ATOMIC_RELAXED, __HIP_MEMORY_SCOPE_AGENT); }
__device__ __forceinline__ unsigned xb_add(unsigned* p, unsigned v) { return __hip_atomic_fetch_add(p, v, __ATOMIC_RELAXED, __HIP_MEMORY_SCOPE_AGENT); }
__device__ __forceinline__ unsigned xb_xcc_id() { return (unsigned)__builtin_amdgcn_s_getreg((3 << 11) | 20) & 0xFu; }
#define XB_SPIN(cond, bar) do { unsigned _sp = 0; while (cond) { __builtin_amdgcn_s_sleep(1); \
    if ((++_sp & 255u) == 0u) { if (xb_ld(&(bar)[XB_TMO])) break; if (_sp > XB_SPIN_CAP) { atomicAdd(&(bar)[XB_TMO], 1u); break; } } } } while (0)

struct XcdBarrier {
    unsigned* bar; unsigned x;
    volatile LAS unsigned* st;
};

__device__ __forceinline__ XcdBarrier xcd_barrier_post(unsigned* bar, volatile LAS unsigned* st) {
    XcdBarrier b; b.bar = bar; b.x = xb_xcc_id(); b.st = st;
    if (threadIdx.x == 0) (void)xb_add(&bar[XB_XCNT(b.x)], 1u);
    return b;
}
__device__ __forceinline__ void xcd_barrier_complete(unsigned* bar, unsigned x, unsigned& nloc, unsigned& nx) {
    const unsigned G = gridDim.x * gridDim.y * gridDim.z;
    unsigned sum, cnt, mine, sp = 0u;
    for (;;) {
        sum = 0u; cnt = 0u; mine = 0u;
#pragma unroll
        for (unsigned j = 0; j < 16; ++j) { const unsigned c = xb_ld(&bar[XB_XCNT(j)]); sum += c; cnt += (c > 0u) ? 1u : 0u; mine = (j == x) ? c : mine; }
        if (sum == G) break;
        __builtin_amdgcn_s_sleep(1);
        if ((++sp & 255u) == 0u) { if (xb_ld(&bar[XB_TMO])) break; if (sp > XB_SPIN_CAP) { atomicAdd(&bar[XB_TMO], 1u); break; } }
    }
    nloc = mine > 0u ? mine : 1u; nx = cnt > 0u ? cnt : 1u;
}

__device__ __forceinline__ void xcd_barrier(const XcdBarrier& b) {
    asm volatile("s_waitcnt vmcnt(0)" ::: "memory");
    __syncthreads();
    if (threadIdx.x == 0) {
        unsigned* bar = b.bar;
        __builtin_amdgcn_s_waitcnt(0);
        unsigned nloc = b.st[0], nx = b.st[1];
        if (nloc == 0u) { xcd_barrier_complete(bar, b.x, nloc, nx); b.st[0] = nloc; b.st[1] = nx; }
        const unsigned old = xb_add(&bar[XB_XSUB(b.x)], 1u);
        const unsigned gen = old / nloc;
        if (old + 1u == (gen + 1u) * nloc) {
            __builtin_amdgcn_fence(__ATOMIC_RELEASE, "agent");
            asm volatile("s_waitcnt vmcnt(0)" ::: "memory");
            const unsigned og = xb_add(&bar[XB_TOP], 1u);
            const unsigned tg = og / nx;
            if (og + 1u == (tg + 1u) * nx) xb_add(&bar[XB_TOPGEN], 1u);
            else XB_SPIN(xb_ld(&bar[XB_TOPGEN]) == tg, bar);
            __builtin_amdgcn_fence(__ATOMIC_ACQUIRE, "agent");
            xb_add(&bar[XB_XGEN(b.x)], 1u);
            asm volatile("s_waitcnt vmcnt(0)" ::: "memory");
        } else {
            XB_SPIN(xb_ld(&bar[XB_XGEN(b.x)]) == gen, bar);
            __builtin_amdgcn_fence(__ATOMIC_ACQUIRE, "agent");
            asm volatile("s_waitcnt vmcnt(0)" ::: "memory");
        }
    }
    __syncthreads();
}

struct Args { const float* in[21]; float* out; unsigned char* ws; float inv_r[64]; float inv_m[32]; int ph_lo, ph_hi; };
static_assert(sizeof(Args) == 21 * 8 + 16 + 96 * 4 + 8, "Args has no padding");

__global__ void __launch_bounds__(512, 2) mk_fwd(Args a) {
    extern __shared__ __attribute__((aligned(16))) unsigned char smem[];
    cg::grid_group grid = cg::this_grid();
    const int tid = threadIdx.x, lane = tid & 63, wave = __builtin_amdgcn_readfirstlane(tid >> 6);
    const int G = gridDim.x, bx = blockIdx.x, vcu = (G % 8 == 0) ? (bx % 8) * (G / 8) + bx / 8 : bx;
    const int gw = vcu * 8 + wave, NGW = G * 8;
    LAS unsigned char* lds3 = (LAS unsigned char*)smem; char* ldsg = (char*)smem; const int ldsaddr = (int)(unsigned)(uintptr_t)lds3;
    float* out = a.out;
#define WSB() size_t wz_ = 0; asm volatile("" : "+s"(wz_)); unsigned char* ws = a.ws + wz_
#define INP(name, k) const float* name = a.in[k] + wz_
#define WSF(name, off) float* name = (float*)(ws + (off))
#define WSH(name, off) bf16_t* name = (bf16_t*)(ws + (off))
    const int lo = a.ph_lo, hi = a.ph_hi;
    if (tid < 16) ((LAS unsigned*)(lds3 + LDS_BAR_OFF))[tid] = 0u;
    __syncthreads();
    XcdBarrier xbar = xcd_barrier_post((unsigned*)(a.ws + WS_CTL + OFF_XBAR), (volatile LAS unsigned*)(lds3 + LDS_BAR_OFF));
#ifndef PH_MASK
#define PH_MASK 0x7ff
#endif
#define IN(k) (((PH_MASK >> (k)) & 1) && lo <= (k) && (k) < hi)
#define SEAM(k) do { if (IN(k) && IN((k) + 1)) { asm volatile("s_waitcnt vmcnt(0) lgkmcnt(0)" ::: "memory"); grid.sync(); \
    __builtin_amdgcn_fence(__ATOMIC_ACQUIRE, "agent"); asm volatile("s_waitcnt vmcnt(0)" ::: "memory"); } } while (0)
#define SEAMX(k) do { if (IN(k) && IN((k) + 1)) xcd_barrier(xbar); } while (0)

    if (IN(0)) {
        WSB(); WSF(mod, WS_CTL + OFF_MOD); WSF(cosr, WS_COSR); WSF(sinr, WS_SINR); WSF(cosm, WS_COSM); WSF(sinm, WS_SINM);
        WSH(Win, WS_WIN); WSH(Wuq, WS_WUQ); WSH(Wukv, WS_WUKV); WSH(Wo, WS_WO); WSH(Wgu, WS_WGU); WSH(Wdn, WS_WDN);
        INP(cin, 1); INP(ada_w, 3); INP(ada_b, 4); INP(w_in, 6); INP(mla_q_norm_w, 10); INP(w_uq, 11); INP(mla_kv_norm_w, 12); INP(w_ukv, 13); INP(w_o, 15); INP(w_gate, 17); INP(w_up, 18); INP(w_down, 19);
        const int* positions = (const int*)a.in[2] + wz_;
        {
            LAS float* cs = (LAS float*)lds3;
            for (int i = tid; i < 8 * 2048; i += 512) { const int b = i >> 11, k = i & 2047; const float v = cin[i]; cs[k * 8 + b] = v / (1.f + __expf(-v)); }
            __syncthreads();
            for (int task = gw; task < 192 * 16; task += NGW) { const int cb = task % 192, ks = task / 192, col = cb * 64 + lane;
                float acc[8]; const float bias = ks == 0 ? ada_b[col] : 0.f;
#pragma unroll
                for (int b = 0; b < 8; ++b) acc[b] = bias;
                const float* wp = ada_w + (size_t)(ks * 128) * NMODC + col;
                for (int k8 = 0; k8 < 128; k8 += 8) { float wv[8];
#pragma unroll
                    for (int i = 0; i < 8; ++i) wv[i] = wp[(size_t)(k8 + i) * NMODC];
#pragma unroll
                    for (int i = 0; i < 8; ++i) { const LAS f32x4* c4 = (const LAS f32x4*)(cs + (ks * 128 + k8 + i) * 8); const f32x4 c0 = c4[0], c1 = c4[1];
                        acc[0] += c0.x * wv[i]; acc[1] += c0.y * wv[i]; acc[2] += c0.z * wv[i]; acc[3] += c0.w * wv[i]; acc[4] += c1.x * wv[i]; acc[5] += c1.y * wv[i]; acc[6] += c1.z * wv[i]; acc[7] += c1.w * wv[i]; } }
#pragma unroll
                for (int b = 0; b < 8; ++b) atomicAdd(mod + (size_t)b * NMODC + col, acc[b]); }
            __syncthreads();
        }
        {
            LAS float* scr = (LAS float*)(lds3 + wave * 16384);
            constexpr int I_IN = 32 * (INC / 32), I_UQ = 8 * 48, I_UKV = 8 * 64, I_O = 32 * 64, I_G = 32 * (DFF / 32), I_D = (DFF / 64) * 64;
            constexpr int NITEMS = I_IN + I_UQ + I_UKV + I_O + 2 * I_G + I_D;
            for (int it = gw; it < NITEMS; it += NGW) { int r = it;
                if (r < I_IN) { transpose_item(w_in, 2048, INC, Win, nullptr, 1, scr, r, lane); continue; } r -= I_IN;
                if (r < I_UQ) { transpose_item(w_uq, 512, 1536, Wuq, mla_q_norm_w, 2, scr, r, lane); continue; } r -= I_UQ;
                if (r < I_UKV) { transpose_item(w_ukv, 512, 2048, Wukv, mla_kv_norm_w, 0, scr, r, lane); continue; } r -= I_UKV;
                if (r < I_O) { transpose_item(w_o, 2048, 2048, Wo, nullptr, 0, scr, r, lane); continue; } r -= I_O;
                if (r < I_G) { transpose_item(w_gate, 2048, DFF, Wgu, nullptr, 3, scr, r, lane); continue; } r -= I_G;
                if (r < I_G) { transpose_item(w_up, 2048, DFF, Wgu, nullptr, 4, scr, r, lane); continue; } r -= I_G;
                transpose_item(w_down, DFF, 2048, Wdn, nullptr, 0, scr, r, lane); }
            for (int i = bx * 512 + tid; i < (INCP - INC) * 2048 / 8; i += G * 512) *(v4u*)(Win + (size_t)INC * 2048 + (size_t)i * 8) = (v4u){0u, 0u, 0u, 0u};
        }
        {
            for (int i = bx * 512 + tid; i < T * 96; i += G * 512) { const int t = i / 96, j = i % 96; const float pos = (float)positions[t];
                const float inv = j < 64 ? a.inv_r[j] : a.inv_m[j - 64]; const float ang = pos * inv;
                double rev = (double)ang * 0.15915494309189535; rev -= __builtin_rint(rev);
                const double qd = __builtin_rint(rev * 4.0); const double y = (rev - qd * 0.25) * 6.283185307179586; const double y2 = y * y;
                const double sy = y * (1.0 + y2 * (-1.0 / 6 + y2 * (1.0 / 120 + y2 * (-1.0 / 5040 + y2 * (1.0 / 362880 + y2 * (-1.0 / 39916800 + y2 * (1.0 / 6227020800.0)))))));
                const double cy = 1.0 + y2 * (-0.5 + y2 * (1.0 / 24 + y2 * (-1.0 / 720 + y2 * (1.0 / 40320 + y2 * (-1.0 / 3628800 + y2 * (1.0 / 479001600.0 + y2 * (-1.0 / 87178291200.0)))))));
                const int qi = (int)qd & 3;
                const float cv = (float)(qi == 0 ? cy : qi == 1 ? -sy : qi == 2 ? -cy : sy), sv = (float)(qi == 0 ? sy : qi == 1 ? cy : qi == 2 ? -sy : -cy);
                if (j < 64) { cosr[(size_t)t * 64 + j] = cv; sinr[(size_t)t * 64 + j] = sv; } else { cosm[(size_t)t * 32 + j - 64] = cv; sinm[(size_t)t * 32 + j - 64] = sv; } }
        }
    }
    SEAMX(0);
    if (a.ph_hi > 1000) { SEAM(0); }
    if (IN(1)) { WSB(); WSF(mod, WS_CTL + OFF_MOD); WSH(H, WS_H); INP(x, 0); INP(norm1_w, 5);
        for (int m = gw; m < T; m += NGW) { const int b = m >> 12; norm_row(x + (size_t)m * DM, norm1_w, mod + (size_t)b * NMODC, mod + (size_t)b * NMODC + DM, H + (size_t)m * DM, nullptr, lane); } }
    SEAMX(1);
    if (IN(2)) {
        WSB(); WSH(H, WS_H); WSH(Win, WS_WIN); WSH(Qr, WS_QR); WSH(Kr, WS_KR); WSH(Vr, WS_VR); WSH(Gr, WS_GR); WSH(CQ, WS_CQ); WSH(CKV, WS_CKV); WSH(Kbuf, WS_KB);
        WSF(cosr, WS_COSR); WSF(sinr, WS_SINR); WSF(cosm, WS_COSM); WSF(sinm, WS_SINM); WSF(ssq_q, WS_CTL + OFF_SSQQ); WSF(ssq_kv, WS_CTL + OFF_SSQKV);
        pg8::Gemm g{H, Win, T, INCP, DM}; pg8::StaticOrder S; S.init(T, INCP, G, bx);
        pg8::EpiIn E{Qr, Kr, Vr, Gr, CQ, CKV, Kbuf, cosr, sinr, cosm, sinm, ssq_q, ssq_kv};
        pg8::gemm_phase<pg8::EpiIn, pg8::StaticOrder, true, true>(lds3, g, S, E);
    }
    SEAMX(2);
    if (IN(3)) {
        WSB(); WSH(CQ, WS_CQ); WSH(CKV, WS_CKV); WSH(Wuq, WS_WUQ); WSH(Wukv, WS_WUKV); WSH(Qm, WS_QM); WSH(Kbuf, WS_KB); WSH(Vm, WS_VM); WSH(Kr, WS_KR); WSH(Vr, WS_VR); WSH(CK, WS_H);
        WSF(cosm, WS_COSM); WSF(sinm, WS_SINM); WSF(ssq_q, WS_CTL + OFF_SSQQ); WSF(ssq_kv, WS_CTL + OFF_SSQKV); INP(ret_decay, 7);
        { pg8::Gemm g{CQ, Wuq, T, 1536, 512}; pg8::StaticOrder S; S.init(T, 1536, G, bx); pg8::EpiUpQ E{ssq_q, Qm, cosm, sinm};
          pg8::gemm_phase<pg8::EpiUpQ, pg8::StaticOrder, true, true>(lds3, g, S, E); }
        { pg8::Gemm g{CKV, Wukv, T, 2048, 512}; pg8::StaticOrder S; S.init(T, 2048, G, bx); pg8::EpiUpKV E{ssq_kv, Kbuf, Vm};
          pg8::gemm_phase<pg8::EpiUpKV, pg8::StaticOrder, true, true>(lds3, g, S, E); }
        for (int u = vcu; u < 2048; u += G) { const int n = u & 31, h = (u >> 5) & 7, b = u >> 8; const size_t t0 = (size_t)b * SEQ + n * 128;
            const float lgf = -__expf(ret_decay[h]) * 1.4426950408889634f, lgb = -__expf(ret_decay[8 + h]) * 1.4426950408889634f;
            att::chunk_kv_unit(Kr + t0 * 1024 + h * 128, Vr + t0 * 1024 + h * 128, CK + ((size_t)(b * 8 + h) * 32 + n) * 16384, CK + ((size_t)(64 + b * 8 + h) * 32 + n) * 16384, lgf, lgb, ldsg, ldsaddr); }
        __syncthreads();
    }
    SEAMX(3);
    if (IN(4)) {
        WSB(); WSH(Qm, WS_QM); WSH(Kbuf, WS_KB); WSH(Vm, WS_VM); WSH(Oat, WS_OAT); WSH(CK, WS_H); INP(ret_decay, 7);
        for (int u = vcu; u < 1024; u += G) { const int qb = u & 15, h = (u >> 4) & 7, b = u >> 7; const size_t r0 = (size_t)b * SEQ;
            att::attn_unit(Qm + (r0 + qb * 256) * 1536 + h * 192, Kbuf + r0 * 1536 + h * 192, Vm + r0 * 1024 + h * 128, Oat + (r0 + qb * 256) * 1024 + h * 128, SEQ, ldsg, ldsaddr); }
#ifndef NO_SCAN
        for (int idx = bx * 512 + tid; idx < 2 * 64 * 2048; idx += G * 512) { const int dir = idx >> 17, bh = (idx >> 11) & 63, e8 = idx & 2047, h = bh & 7;
            const float cd = __builtin_amdgcn_exp2f(-__expf(ret_decay[dir * 8 + h]) * 1.4426950408889634f * 128.f);
            bf16_t* base = CK + ((size_t)(dir * 64 + bh) * 32) * 16384 + e8 * 8; float st[8];
#pragma unroll
            for (int i = 0; i < 8; ++i) st[i] = 0.f;
            for (int s8 = 0; s8 < 32; s8 += 8) { v4u kv[8];
#pragma unroll
                for (int i = 0; i < 8; ++i) { const int m = dir ? 31 - (s8 + i) : s8 + i; kv[i] = *(const v4u*)(base + (size_t)m * 16384); }
#pragma unroll
                for (int i = 0; i < 8; ++i) { const int m = dir ? 31 - (s8 + i) : s8 + i; v4u o;
                    o.x = pk2a(st[0], st[1]); o.y = pk2a(st[2], st[3]); o.z = pk2a(st[4], st[5]); o.w = pk2a(st[6], st[7]);
                    *(v4u*)(base + (size_t)m * 16384) = o;
#pragma unroll
                    for (int q = 0; q < 4; ++q) { const unsigned w = kv[i][q]; st[2 * q] = st[2 * q] * cd + __uint_as_float(w << 16); st[2 * q + 1] = st[2 * q + 1] * cd + __uint_as_float(w & 0xffff0000u); } } }
        }
#endif
    }
    SEAMX(4);
    if (IN(5)) {
        WSB(); WSH(Qr, WS_QR); WSH(Kr, WS_KR); WSH(Vr, WS_VR); WSH(Gr, WS_GR); WSH(CK, WS_H); WSH(Cat, WS_CAT); WSH(Oat, WS_OAT); INP(ret_decay, 7); INP(ret_gn_w, 8); INP(ret_gn_b, 9); INP(mla_out_w, 14);
#if PROBE_BRUTE_RET
        float* dumpb = (float*)(ws + 704 * MiB);
        for (int up = vcu; up < 1024; up += G) {
            if (PROBE_COMP != 0) { const int u = up * 2 + (wave >> 2); const int n = u & 31, h = (u >> 5) & 7, b = u >> 8; const size_t t0 = (size_t)b * SEQ + n * 128;
                const float lgf = -__expf(ret_decay[h]) * 1.4426950408889634f, lgb = -__expf(ret_decay[8 + h]) * 1.4426950408889634f; const int hf = wave >> 2;
                att::ret_out_unit(Qr + t0 * 1024 + h * 128, Kr + t0 * 1024 + h * 128, Vr + t0 * 1024 + h * 128, Gr + t0 * 1024 + h * 128,
                                  CK + ((size_t)(b * 8 + h) * 32 + n) * 16384, CK + ((size_t)(64 + b * 8 + h) * 32 + n) * 16384, ret_gn_w + h * 128, ret_gn_b + h * 128,
                                  Cat + t0 * 2048 + h * 128, lgf, lgb, ldsg + hf * 65536, ldsaddr + hf * 65536, dumpb + t0 * 1024 + h * 128);
                __threadfence(); __syncthreads(); }
            for (int k2 = 0; k2 < 2; ++k2) { const int u = up * 2 + k2; const int n = u & 31, h = (u >> 5) & 7, b = u >> 8; const size_t r0 = (size_t)b * SEQ, t0 = r0 + n * 128;
                const float lgf = -__expf(ret_decay[h]) * 1.4426950408889634f, lgb = -__expf(ret_decay[8 + h]) * 1.4426950408889634f;
                att::ret_brute_unit(Qr + r0 * 1024 + h * 128, Kr + r0 * 1024 + h * 128, Vr + r0 * 1024 + h * 128, Gr + t0 * 1024 + h * 128, ret_gn_w + h * 128, ret_gn_b + h * 128, Cat + t0 * 2048 + h * 128, n * 128, lgf, lgb, ldsg, dumpb + t0 * 1024 + h * 128); } }
        __syncthreads();
        for (int up = vcu; up < 0; up += G) { const int u = up * 2 + (wave >> 2);
#else
        for (int up = vcu; up < 1024; up += G) { const int u = up * 2 + (wave >> 2);
#endif
            const int n = u & 31, h = (u >> 5) & 7, b = u >> 8; const size_t t0 = (size_t)b * SEQ + n * 128;
            const float lgf = -__expf(ret_decay[h]) * 1.4426950408889634f, lgb = -__expf(ret_decay[8 + h]) * 1.4426950408889634f; const int hf = wave >> 2;
            att::ret_out_unit(Qr + t0 * 1024 + h * 128, Kr + t0 * 1024 + h * 128, Vr + t0 * 1024 + h * 128, Gr + t0 * 1024 + h * 128,
                              CK + ((size_t)(b * 8 + h) * 32 + n) * 16384, CK + ((size_t)(64 + b * 8 + h) * 32 + n) * 16384, ret_gn_w + h * 128, ret_gn_b + h * 128,
                              Cat + t0 * 2048 + h * 128, lgf, lgb, ldsg + hf * 65536, ldsaddr + hf * 65536); }
        for (int m = gw; m < T; m += NGW) {
            const bf16_t* orow = Oat + (size_t)m * 1024; float v[16]; float s = 0.f;
#pragma unroll
            for (int j = 0; j < 2; ++j) { const v4u w = *(const v4u*)(orow + lane * 8 + 512 * j);
#pragma unroll
                for (int q = 0; q < 4; ++q) { v[j * 8 + 2 * q] = __uint_as_float(w[q] << 16); v[j * 8 + 2 * q + 1] = __uint_as_float(w[q] & 0xffff0000u); } }
#pragma unroll
            for (int i = 0; i < 16; ++i) s += v[i] * v[i];
            const float rstd = rsqrtf(wave_sum(s) * (1.f / 1024.f) + 1e-6f);
#pragma unroll
            for (int j = 0; j < 2; ++j) { const int col = lane * 8 + 512 * j; const f32x4 w0 = *(const f32x4*)(mla_out_w + col), w1 = *(const f32x4*)(mla_out_w + col + 4); v4u o;
                o.x = pk2a(v[j * 8 + 0] * rstd * w0.x, v[j * 8 + 1] * rstd * w0.y); o.y = pk2a(v[j * 8 + 2] * rstd * w0.z, v[j * 8 + 3] * rstd * w0.w);
                o.z = pk2a(v[j * 8 + 4] * rstd * w1.x, v[j * 8 + 5] * rstd * w1.y); o.w = pk2a(v[j * 8 + 6] * rstd * w1.z, v[j * 8 + 7] * rstd * w1.w);
                *(v4u*)(Cat + (size_t)m * 2048 + 1024 + col) = o; } }
        __syncthreads();
    }
    SEAMX(5);
    if (IN(6)) {
        WSB(); WSH(Cat, WS_CAT); WSH(Wo, WS_WO); WSF(mod, WS_CTL + OFF_MOD); INP(x, 0);
        pg8::Gemm g{Cat, Wo, T, 2048, 2048}; pg8::StaticOrder S; S.init(T, 2048, G, bx); pg8::EpiGateRes E{x, mod + 2 * DM, out};
        pg8::gemm_phase<pg8::EpiGateRes, pg8::StaticOrder, true, true>(lds3, g, S, E);
    }
    SEAMX(6);
    if (IN(7)) { WSB(); WSF(mod, WS_CTL + OFF_MOD); WSH(H, WS_H); INP(norm2_w, 16);
        for (int m = gw; m < T; m += NGW) { const int b = m >> 12; norm_row(out + (size_t)m * DM, norm2_w, mod + (size_t)b * NMODC + 3 * DM, mod + (size_t)b * NMODC + 4 * DM, H + (size_t)m * DM, nullptr, lane); } }
    SEAMX(7);
    if (IN(8)) {
        WSB(); WSH(H, WS_H); WSH(Wgu, WS_WGU); WSH(Aff, WS_AFF);
        pg8::Gemm g{H, Wgu, T, 2 * DFF, DM}; pg8::StaticOrder S; S.init(T, 2 * DFF, G, bx); pg8::EpiGU E{Aff};
        pg8::gemm_phase<pg8::EpiGU, pg8::StaticOrder, true, true>(lds3, g, S, E);
    }
    SEAMX(8);
    if (IN(9)) {
        WSB(); WSH(Aff, WS_AFF); WSH(Wdn, WS_WDN); WSF(mod, WS_CTL + OFF_MOD);
        pg8::Gemm g{Aff, Wdn, T, 2048, DFF}; pg8::StaticOrder S; S.init(T, 2048, G, bx); pg8::EpiGateRes E{out, mod + 5 * DM, out};
        pg8::gemm_phase<pg8::EpiGateRes, pg8::StaticOrder, true, true>(lds3, g, S, E);
    }
    SEAMX(9);
    if (IN(10)) { WSB(); (void)ws; INP(final_norm_w, 20);
        for (int m = gw; m < T; m += NGW) norm_row(out + (size_t)m * DM, final_norm_w, nullptr, nullptr, nullptr, out + (size_t)m * DM, lane); }
#undef IN
#undef SEAM
}

extern "C" void kernel_launch(void* const* d_in, const int* in_sizes, int n_in, void* d_out, int out_size, void* d_ws, size_t ws_size, hipStream_t stream) {
    static int grid = 0;
    if (grid == 0) {
        if (n_in != 21 || in_sizes[0] != T * DM || out_size != T * DM || ws_size < WS_END) { fprintf(stderr, "kernel_launch: shape/workspace mismatch (n_in %d, ws %zu < %zu)\n", n_in, ws_size, (size_t)WS_END); grid = -1; return; }
        int dev = 0, cus = 0, per_cu = 0;
        (void)hipGetDevice(&dev); (void)hipDeviceGetAttribute(&cus, hipDeviceAttributeMultiprocessorCount, dev);
        if (hipFuncSetAttribute((const void*)mk_fwd, hipFuncAttributeMaxDynamicSharedMemorySize, LDS_BYTES) != hipSuccess) { fprintf(stderr, "kernel_launch: hipFuncSetAttribute failed\n"); grid = -1; return; }
        if (hipOccupancyMaxActiveBlocksPerMultiprocessor(&per_cu, (const void*)mk_fwd, 512, LDS_BYTES) != hipSuccess || per_cu < 1) { fprintf(stderr, "kernel_launch: occupancy query gave %d\n", per_cu); per_cu = 1; }
        (void)hipGetLastError();
        grid = cus * per_cu;
    }
    if (grid < 0) return;
    (void)hipMemsetAsync((char*)d_ws + WS_CTL, 0, CTL_ZERO_BYTES, stream);
    Args a{};
    for (int i = 0; i < 21; ++i) a.in[i] = (const float*)d_in[i];
    a.out = (float*)d_out; a.ws = (unsigned char*)d_ws;
    for (int i = 0; i < 64; ++i) a.inv_r[i] = powf(10000.0f, -((float)(2 * i)) / 128.0f);
    for (int i = 0; i < 32; ++i) a.inv_m[i] = powf(10000.0f, -((float)(2 * i)) / 64.0f);
#if MK_SPLIT
    for (int p = 0; p < NPH; ++p) { a.ph_lo = p; a.ph_hi = p + 1; hipLaunchKernelGGL(mk_fwd, dim3(grid), dim3(512), LDS_BYTES, stream, a); }
#else
    a.ph_lo = 0; a.ph_hi = NPH;
    void* args[] = {&a};
    hipError_t e = hipLaunchCooperativeKernel((const void*)mk_fwd, dim3(grid), dim3(512), args, LDS_BYTES, stream);
    if (e != hipSuccess) fprintf(stderr, "kernel_launch: cooperative launch failed: %s (grid %d)\n", hipGetErrorString(e), grid);
#endif
}
```

```cpp
#include <hip/hip_runtime.h>
#include <hip/hip_cooperative_groups.h>
#include <cstdio>
#include <cstdint>
#include <cmath>
namespace cg = cooperative_groups;
namespace pg8 {
#define PG8_LAS __attribute__((address_space(3)))
typedef unsigned short bf16_t;
typedef short bf16x8 __attribute__((ext_vector_type(8)));
typedef float f32x4 __attribute__((ext_vector_type(4)));
typedef unsigned u32x4 __attribute__((ext_vector_type(4)));
constexpr int BM = 256, BK = 64, HALF = 128, HTB = HALF * BK * 2  , STAGE_BYTES = 8 * HTB, NXCD = 8, WGM = 8;

__host__ __device__ __forceinline__ int lds_byte(int r, int c) { const int st = (r >> 4) * 2 + (c >> 5), rr = r & 15, cc = c & 31, ob = rr * 64 + cc * 2; return st * 1024 + (ob ^ (((ob >> 9) & 1) << 5)); }
__host__ __device__ __forceinline__ void stage_rc(int b, int& R, int& C) { const int st = b / 1024, sb = b % 1024, swz = sb ^ (((sb >> 9) & 1) << 5); R = (st >> 1) * 16 + swz / 64; C = (st & 1) * 32 + (swz % 64) / 2; }
__host__ __device__ __forceinline__ int perm32(int rho) { const int n = rho >> 4, i = rho & 15; return 8 * (i >> 2) + 4 * n + (i & 3); }

struct Unit { int pm, pn; };
struct Gemm { const bf16_t* A; const bf16_t* Bt; int M, N, K; };

struct StaticOrder {
    int nM, nN, nwg, G, c;
    __host__ __device__ void init(int M, int N, int G_, int c_) { nM = M / BM; nN = N / BM; nwg = nM * nN; G = G_; c = c_; }
    __host__ __device__ bool next(int i, Unit& u) const {
        const long L = (long)i * G + c; if (L >= nwg) return false;
        int wgid = (int)L; { const int q = nwg / NXCD, r = nwg % NXCD, xcd = wgid % NXCD, off = wgid / NXCD; wgid = (xcd < r ? xcd * (q + 1) : r * (q + 1) + (xcd - r) * q) + off; }
        const int nig = WGM * nN, gid = wgid / nig, fm = gid * WGM, gsz = (nM - fm) < WGM ? (nM - fm) : WGM;
        u.pm = fm + ((wgid % nig) % gsz); u.pn = (wgid % nig) / gsz; return true;
    }
    __device__ __forceinline__ void a_ready(const Unit&) const {}
    __device__ __forceinline__ void done(const Unit&) const {}
};

#ifndef PROBE_COARSE_ACT
#define PROBE_COARSE_ACT 0
#endif
__device__ __forceinline__ unsigned coarse2(unsigned w) { return PROBE_COARSE_ACT ? ((w + ((w >> 1) & 0x00010001u)) & 0xfffefffeu) : w; }
__device__ __forceinline__ unsigned cvt_pk_bf16(float lo, float hi) { unsigned r; asm volatile("v_cvt_pk_bf16_f32 %0, %1, %2" : "=v"(r) : "v"(lo), "v"(hi)); return coarse2(r); }
typedef float f32x2 __attribute__((ext_vector_type(2)));

typedef unsigned u32x2 __attribute__((ext_vector_type(2)));
__device__ __forceinline__ float silu_f(float v) { return v * __builtin_amdgcn_rcpf(1.f + __builtin_amdgcn_exp2f(v * -1.4426950408889634f)); }
__device__ __forceinline__ u32x4 pack8(f32x4 a, f32x4 b) { u32x4 w; w.x = cvt_pk_bf16(a[0], a[1]); w.y = cvt_pk_bf16(a[2], a[3]); w.z = cvt_pk_bf16(b[0], b[1]); w.w = cvt_pk_bf16(b[2], b[3]); return w; }
__device__ __forceinline__ void rope8(f32x4& a, f32x4& b, const f32x4 c, const f32x4 s) {
    float t1, t2;
    t1 = a[0]; t2 = a[1]; a[0] = t1 * c[0] - t2 * s[0]; a[1] = t2 * c[0] + t1 * s[0];
    t1 = a[2]; t2 = a[3]; a[2] = t1 * c[1] - t2 * s[1]; a[3] = t2 * c[1] + t1 * s[1];
    t1 = b[0]; t2 = b[1]; b[0] = t1 * c[2] - t2 * s[2]; b[1] = t2 * c[2] + t1 * s[2];
    t1 = b[2]; t2 = b[3]; b[2] = t1 * c[3] - t2 * s[3]; b[3] = t2 * c[3] + t1 * s[3];
}
constexpr float NORM_EPS = 1e-6f;

struct EpiIn {
    static constexpr bool PERM = true, AFTER_DRAIN = false;
    bf16_t *Qr, *Kr, *Vr, *Gr, *CQ, *CKV, *Kbuf; const float *cosr, *sinr, *cosm, *sinm; float *ssq_q, *ssq_kv;
    __device__ __forceinline__ void operator()(const f32x4 (&acc)[2][2][4][2], const Unit& u, int wr, int wc, int fr, int fq) const {
        const int pn = u.pn, row0 = u.pm * BM + wr * 64 + fr, cl = wc * 32 + 8 * fq;
        if (pn < 8) {
            bf16_t* O = pn < 4 ? Qr : Kr; const float sc = pn < 4 ? 1.f : 0.08838834764831845f; const int colt = (pn & 3) * 256 + cl;
#pragma unroll
            for (int ai = 0; ai < 2; ++ai)
#pragma unroll
                for (int m = 0; m < 4; ++m) { const int row = row0 + ai * HALF + m * 16;
                    const f32x4 c4 = *(const f32x4*)(cosr + (size_t)row * 64 + (cl >> 1)), s4 = *(const f32x4*)(sinr + (size_t)row * 64 + (cl >> 1));
#pragma unroll
                    for (int bj = 0; bj < 2; ++bj) { f32x4 a = acc[ai][bj][m][0], b = acc[ai][bj][m][1]; rope8(a, b, c4, s4); a = a * sc; b = b * sc;
                        *(u32x4*)(O + (size_t)row * 1024 + colt + bj * HALF) = pack8(a, b); } }
        } else if (pn < 16) {
            const bool isg = pn >= 12; bf16_t* O = isg ? Gr : Vr; const int colt = (pn & 3) * 256 + cl;
#pragma unroll
            for (int ai = 0; ai < 2; ++ai)
#pragma unroll
                for (int m = 0; m < 4; ++m) { const int row = row0 + ai * HALF + m * 16;
#pragma unroll
                    for (int bj = 0; bj < 2; ++bj) { f32x4 a = acc[ai][bj][m][0], b = acc[ai][bj][m][1];
                        if (isg) {
#pragma unroll
                            for (int i = 0; i < 4; ++i) { a[i] = silu_f(a[i]); b[i] = silu_f(b[i]); } }
                        *(u32x4*)(O + (size_t)row * 1024 + colt + bj * HALF) = pack8(a, b); } }
        } else if (pn < 20) {
            bf16_t* O = pn < 18 ? CQ : CKV; float* sq = pn < 18 ? ssq_q : ssq_kv; const int colt = (pn & 1) * 256 + cl;
#pragma unroll
            for (int ai = 0; ai < 2; ++ai)
#pragma unroll
                for (int m = 0; m < 4; ++m) { const int row = row0 + ai * HALF + m * 16; float s = 0.f;
#pragma unroll
                    for (int bj = 0; bj < 2; ++bj) { const f32x4 a = acc[ai][bj][m][0], b = acc[ai][bj][m][1];
                        s += (a[0] * a[0] + a[1] * a[1]) + (a[2] * a[2] + a[3] * a[3]) + (b[0] * b[0] + b[1] * b[1]) + (b[2] * b[2] + b[3] * b[3]);
                        *(u32x4*)(O + (size_t)row * 512 + colt + bj * HALF) = pack8(a, b); }
                    s += __shfl_xor(s, 16); s += __shfl_xor(s, 32);
                    if (fq == 0) atomicAdd(sq + row, s); }
        } else {
            if (wc < 2) {
#pragma unroll
                for (int ai = 0; ai < 2; ++ai)
#pragma unroll
                    for (int m = 0; m < 4; ++m) { const int row = row0 + ai * HALF + m * 16;
                        const f32x4 c4 = *(const f32x4*)(cosm + (size_t)row * 32 + (cl >> 1)), s4 = *(const f32x4*)(sinm + (size_t)row * 32 + (cl >> 1));
                        f32x4 a = acc[ai][0][m][0], b = acc[ai][0][m][1]; rope8(a, b, c4, s4); const u32x4 w = pack8(a, b);
#pragma unroll
                        for (int h = 0; h < 8; ++h) *(u32x4*)(Kbuf + (size_t)row * 1536 + h * 192 + 128 + cl) = w; }
            }
        }
    }
};
struct EpiUpQ {
    static constexpr bool PERM = true, AFTER_DRAIN = false;
    const float* ssq; bf16_t* Qm; const float *cosm, *sinm;
    __device__ __forceinline__ void operator()(const f32x4 (&acc)[2][2][4][2], const Unit& u, int wr, int wc, int fr, int fq) const {
        const int row0 = u.pm * BM + wr * 64 + fr, cl = wc * 32 + 8 * fq;
#pragma unroll
        for (int ai = 0; ai < 2; ++ai)
#pragma unroll
            for (int m = 0; m < 4; ++m) { const int row = row0 + ai * HALF + m * 16; const float rstd = rsqrtf(ssq[row] * (1.f / 512.f) + NORM_EPS);
#pragma unroll
                for (int bj = 0; bj < 2; ++bj) { const int c = u.pn * 256 + bj * HALF + cl, d = c % 192; f32x4 a = acc[ai][bj][m][0] * rstd, b = acc[ai][bj][m][1] * rstd;
                    if (d >= 128) { const int fi = (d - 128) >> 1; const f32x4 c4 = *(const f32x4*)(cosm + (size_t)row * 32 + fi), s4 = *(const f32x4*)(sinm + (size_t)row * 32 + fi); rope8(a, b, c4, s4); }
                    *(u32x4*)(Qm + (size_t)row * 1536 + c) = pack8(a, b); } }
    }
};
struct EpiUpKV {
    static constexpr bool PERM = true, AFTER_DRAIN = false;
    const float* ssq; bf16_t *Kbuf, *Vm;
    __device__ __forceinline__ void operator()(const f32x4 (&acc)[2][2][4][2], const Unit& u, int wr, int wc, int fr, int fq) const {
        const int row0 = u.pm * BM + wr * 64 + fr, cl = wc * 32 + 8 * fq;
#pragma unroll
        for (int ai = 0; ai < 2; ++ai)
#pragma unroll
            for (int m = 0; m < 4; ++m) { const int row = row0 + ai * HALF + m * 16; const float rstd = rsqrtf(ssq[row] * (1.f / 512.f) + NORM_EPS);
                *(u32x4*)(Kbuf + (size_t)row * 1536 + u.pn * 192 + cl) = pack8(acc[ai][0][m][0] * rstd, acc[ai][0][m][1] * rstd);
                *(u32x4*)(Vm + (size_t)row * 1024 + u.pn * 128 + cl) = pack8(acc[ai][1][m][0] * rstd, acc[ai][1][m][1] * rstd); }
    }
};
struct EpiGateRes {
    static constexpr bool PERM = true, AFTER_DRAIN = false;
    const float* x; const float* gate; float* out;
    __device__ __forceinline__ void operator()(const f32x4 (&acc)[2][2][4][2], const Unit& u, int wr, int wc, int fr, int fq) const {
        const int row0 = u.pm * BM + wr * 64 + fr, cl = wc * 32 + 8 * fq, b = u.pm >> 4;
#pragma unroll
        for (int bj = 0; bj < 2; ++bj) { const int c = u.pn * 256 + bj * HALF + cl;
            const f32x4 g0 = *(const f32x4*)(gate + (size_t)b * 12288 + c), g1 = *(const f32x4*)(gate + (size_t)b * 12288 + c + 4);
#pragma unroll
            for (int ai = 0; ai < 2; ++ai)
#pragma unroll
                for (int m = 0; m < 4; ++m) { const size_t off = (size_t)(row0 + ai * HALF + m * 16) * 2048 + c;
                    const f32x4 x0 = *(const f32x4*)(x + off), x1 = *(const f32x4*)(x + off + 4);
                    *(f32x4*)(out + off) = x0 + g0 * acc[ai][bj][m][0]; *(f32x4*)(out + off + 4) = x1 + g1 * acc[ai][bj][m][1]; } }
    }
};
struct EpiGU {
    static constexpr bool PERM = true, AFTER_DRAIN = false;
    bf16_t* Aff;
    __device__ __forceinline__ void operator()(const f32x4 (&acc)[2][2][4][2], const Unit& u, int wr, int wc, int fr, int fq) const {
        const int row0 = u.pm * BM + wr * 64 + fr, cl = wc * 32 + 8 * fq;
#pragma unroll
        for (int ai = 0; ai < 2; ++ai)
#pragma unroll
            for (int m = 0; m < 4; ++m) { const int row = row0 + ai * HALF + m * 16; f32x4 a, b;
#pragma unroll
                for (int i = 0; i < 4; ++i) { a[i] = silu_f(acc[ai][0][m][0][i]) * acc[ai][1][m][0][i]; b[i] = silu_f(acc[ai][0][m][1][i]) * acc[ai][1][m][1][i]; }
                *(u32x4*)(Aff + (size_t)row * 5632 + u.pn * 128 + cl) = pack8(a, b); }
    }
};

template <class Epi, class Sched, bool ALIGN_EPI = false, bool SP2 = false>
__device__ __forceinline__ void gemm_phase(PG8_LAS unsigned char* lds, const Gemm g, const Sched& S, const Epi& E) {
    const int tid = threadIdx.x, wid = __builtin_amdgcn_readfirstlane(tid >> 6), lane = tid & 63, wr = wid >> 2, wc = wid & 3, fr = lane & 15, fq = lane >> 4;
    const int K = g.K, nt = K / BK;
    unsigned voffA[2], voffB[2];
#pragma unroll
    for (int i = 0; i < 2; ++i) { int R, C; stage_rc(tid * 16 + i * 8192, R, C); const int Rb = Epi::PERM ? ((R & ~31) + perm32(R & 31)) : R;
        voffA[i] = (unsigned)(R * K + C) * 2u; voffB[i] = (unsigned)(Rb * K + C) * 2u; }
    const size_t kstep = (size_t)(BK * 2);
    const size_t hstep = (size_t)HALF * K * 2;
    const size_t tstep = 2 * hstep;
    const unsigned ldsw = (unsigned)wid * 1024u;
    const int aoff = lds_byte(wr * 64 + fr, fq * 8), boff = lds_byte(wc * 32 + fr, fq * 8);
#define PG8_SA(b, h) (((b) * 2 + (h)) * HTB)
#define PG8_SB(b, h) ((4 + (b) * 2 + (h)) * HTB)
#define PG8_STAGE(bufoff, gbase, voff) do { _Pragma("unroll") for (int _i = 0; _i < 2; ++_i) \
        __builtin_amdgcn_global_load_lds((const unsigned*)((const char*)(gbase) + (voff)[_i]), (PG8_LAS unsigned*)(lds + (bufoff) + ldsw + _i * 8192), 16, 0, 0); } while (0)
#define PG8_LDA(dst, b, h) do { _Pragma("unroll") for (int m = 0; m < 4; ++m) _Pragma("unroll") for (int k = 0; k < 2; ++k) dst[m][k] = *(const PG8_LAS bf16x8*)(lds + PG8_SA(b, h) + aoff + m * 2048 + k * 1024); } while (0)
#define PG8_LDB(dst, b, h) do { _Pragma("unroll") for (int n = 0; n < 2; ++n) _Pragma("unroll") for (int k = 0; k < 2; ++k) dst[n][k] = *(const PG8_LAS bf16x8*)(lds + PG8_SB(b, h) + boff + n * 2048 + k * 1024); } while (0)
#define PG8_MMA(ai, bj, At, Bt) do { __builtin_amdgcn_s_setprio(1); _Pragma("unroll") for (int m = 0; m < 4; ++m) _Pragma("unroll") for (int n = 0; n < 2; ++n) _Pragma("unroll") for (int k = 0; k < 2; ++k) \
        acc[ai][bj][m][n] = __builtin_amdgcn_mfma_f32_16x16x32_bf16(Bt[n][k], At[m][k], acc[ai][bj][m][n], 0, 0, 0); __builtin_amdgcn_s_setprio(0); } while (0)
#define PG8_WAIT_V(n) asm volatile("s_waitcnt vmcnt(" #n ")" ::: "memory")
#define PG8_WAIT_L(n) asm volatile("s_waitcnt lgkmcnt(" #n ")" ::: "memory")
#define PG8_BAR __builtin_amdgcn_s_barrier()
#define PG8_SCHED __builtin_amdgcn_sched_barrier(0)
    Unit cur, nxt; int ui = 0;
    if (!S.next(0, cur)) return;
    f32x4 acc[2][2][4][2];
#pragma unroll
    for (int a = 0; a < 2; ++a)
#pragma unroll
        for (int b = 0; b < 2; ++b)
#pragma unroll
            for (int m = 0; m < 4; ++m)
#pragma unroll
                for (int n = 0; n < 2; ++n) acc[a][b][m][n] = (f32x4){0.f, 0.f, 0.f, 0.f};
    bf16x8 At[4][2], B0[2][2], B1[2][2];
    const char* cA = (const char*)g.A + (size_t)cur.pm * tstep; const char* cB = (const char*)g.Bt + (size_t)cur.pn * tstep;
    S.a_ready(cur);
    if constexpr (SP2) {
        PG8_STAGE(PG8_SB(0, 0), cB, voffB); PG8_STAGE(PG8_SB(0, 1), cB + hstep, voffB); PG8_STAGE(PG8_SA(0, 0), cA, voffA); PG8_STAGE(PG8_SA(0, 1), cA + hstep, voffA);
        if (wr == 1) PG8_BAR;
        PG8_WAIT_V(2); PG8_BAR;
        PG8_STAGE(PG8_SB(1, 0), cB + kstep, voffB); PG8_STAGE(PG8_SA(1, 0), cA + kstep, voffA); PG8_STAGE(PG8_SB(1, 1), cB + hstep + kstep, voffB);
        PG8_WAIT_V(6); PG8_BAR;
    } else {
        PG8_STAGE(PG8_SB(0, 0), cB, voffB); PG8_STAGE(PG8_SA(0, 0), cA, voffA); PG8_STAGE(PG8_SB(0, 1), cB + hstep, voffB); PG8_STAGE(PG8_SA(0, 1), cA + hstep, voffA);
        if (wr == 1) PG8_BAR;
        PG8_WAIT_V(4); PG8_BAR;
        PG8_STAGE(PG8_SB(1, 0), cB + kstep, voffB); PG8_STAGE(PG8_SA(1, 0), cA + kstep, voffA); PG8_STAGE(PG8_SB(1, 1), cB + hstep + kstep, voffB);
        PG8_WAIT_V(6); PG8_BAR;
    }
    for (;;) {
        const bool has_next = S.next(ui + 1, nxt);
        const char* nA = has_next ? (const char*)g.A + (size_t)nxt.pm * tstep : cA; const char* nB = has_next ? (const char*)g.Bt + (size_t)nxt.pn * tstep : cB;
        for (int t = 0; t < nt; t += 2) {
            const bool last = (t == nt - 2);
            const char* a1 = cA + (size_t)(t + 1) * kstep;
            const char* a2 = last ? nA : cA + (size_t)(t + 2) * kstep; const char* b2 = last ? nB : cB + (size_t)(t + 2) * kstep;
            const char* a3 = a2 + kstep; const char* b3 = b2 + kstep;
            if (last && has_next) S.a_ready(nxt);
            if constexpr (SP2) {
            PG8_LDB(B0, 0, 0); PG8_LDB(B1, 0, 1); PG8_SCHED; PG8_LDA(At, 0, 0); PG8_STAGE(PG8_SA(1, 1), a1 + hstep, voffA);
            PG8_WAIT_V(8); PG8_WAIT_L(0); PG8_BAR; PG8_MMA(0, 0, At, B0); PG8_MMA(0, 1, At, B1); PG8_BAR; PG8_SCHED;
            PG8_LDA(At, 0, 1); PG8_STAGE(PG8_SB(0, 0), b2, voffB); PG8_STAGE(PG8_SB(0, 1), b2 + hstep, voffB); PG8_STAGE(PG8_SA(0, 0), a2, voffA);
            PG8_WAIT_V(8); PG8_WAIT_L(0); PG8_BAR; PG8_MMA(1, 0, At, B0); PG8_MMA(1, 1, At, B1); PG8_BAR; PG8_SCHED;
            PG8_LDB(B0, 1, 0); PG8_LDB(B1, 1, 1); PG8_SCHED; PG8_LDA(At, 1, 0); PG8_STAGE(PG8_SA(0, 1), a2 + hstep, voffA);
            PG8_WAIT_V(8); PG8_WAIT_L(0); PG8_BAR; PG8_MMA(0, 0, At, B0); PG8_MMA(0, 1, At, B1); PG8_BAR; PG8_SCHED;
            PG8_LDA(At, 1, 1); PG8_STAGE(PG8_SB(1, 0), b3, voffB); PG8_STAGE(PG8_SB(1, 1), b3 + hstep, voffB); PG8_STAGE(PG8_SA(1, 0), a3, voffA);
            PG8_WAIT_V(8); PG8_WAIT_L(0); PG8_BAR; PG8_MMA(1, 0, At, B0); PG8_MMA(1, 1, At, B1); PG8_BAR; PG8_SCHED;
            } else {
            PG8_LDB(B0, 0, 0); PG8_SCHED; PG8_LDA(At, 0, 0); PG8_STAGE(PG8_SA(1, 1), a1 + hstep, voffA);
            PG8_WAIT_L(8); PG8_BAR; PG8_WAIT_L(0); PG8_MMA(0, 0, At, B0); PG8_BAR; PG8_SCHED;
            PG8_LDB(B1, 0, 1); PG8_STAGE(PG8_SB(0, 0), b2, voffB);
            PG8_BAR; PG8_WAIT_L(0); PG8_MMA(0, 1, At, B1); PG8_BAR;
            PG8_LDA(At, 0, 1); PG8_STAGE(PG8_SA(0, 0), a2, voffA);
            PG8_BAR; PG8_WAIT_L(0); PG8_MMA(1, 0, At, B0); PG8_BAR; PG8_SCHED;
            PG8_STAGE(PG8_SB(0, 1), b2 + hstep, voffB);
            PG8_WAIT_V(6); PG8_BAR; PG8_MMA(1, 1, At, B1); PG8_BAR;
            PG8_LDB(B0, 1, 0); PG8_SCHED; PG8_LDA(At, 1, 0); PG8_STAGE(PG8_SA(0, 1), a2 + hstep, voffA);
            PG8_WAIT_L(8); PG8_BAR; PG8_WAIT_L(0); PG8_MMA(0, 0, At, B0); PG8_BAR; PG8_SCHED;
            PG8_LDB(B1, 1, 1); PG8_STAGE(PG8_SB(1, 0), b3, voffB);
            PG8_BAR; PG8_WAIT_L(0); PG8_MMA(0, 1, At, B1); PG8_BAR;
            PG8_LDA(At, 1, 1); PG8_STAGE(PG8_SA(1, 0), a3, voffA);
            PG8_BAR; PG8_WAIT_L(0); PG8_MMA(1, 0, At, B0); PG8_BAR; PG8_SCHED;
            PG8_STAGE(PG8_SB(1, 1), b3 + hstep, voffB);
            PG8_WAIT_V(6); PG8_BAR; PG8_MMA(1, 1, At, B1); PG8_BAR;
            }
        }
        if constexpr (ALIGN_EPI) { if (wr == 0) PG8_BAR; }
        if constexpr (!Epi::AFTER_DRAIN) { E(acc, cur, wr, wc, fr, fq); S.done(cur); }
        if (!has_next) break;
#pragma unroll
        for (int a = 0; a < 2; ++a)
#pragma unroll
            for (int b = 0; b < 2; ++b)
#pragma unroll
                for (int m = 0; m < 4; ++m)
#pragma unroll
                    for (int n = 0; n < 2; ++n) acc[a][b][m][n] = (f32x4){0.f, 0.f, 0.f, 0.f};
        cur = nxt; cA = nA; cB = nB; ++ui;
        if constexpr (ALIGN_EPI) { if (wr == 1) PG8_BAR; }
    }
    PG8_WAIT_V(0);
    if constexpr (!ALIGN_EPI) { if (wr == 0) PG8_BAR; }
    PG8_BAR;
    if constexpr (Epi::AFTER_DRAIN) { E.fused(acc, cur, wr, wc, fr, fq, lds, wid, lane); S.done(cur); }
#undef PG8_SA
#undef PG8_SB
#undef PG8_STAGE
#undef PG8_LDA
#undef PG8_LDB
#undef PG8_MMA
#undef PG8_WAIT_V
#undef PG8_WAIT_L
#undef PG8_BAR
#undef PG8_SCHED
}
}

namespace att {
typedef unsigned short bf16_t;
using bf16x8 = __attribute__((ext_vector_type(8))) short;
using s16x4  = __attribute__((ext_vector_type(4))) short;
using f32x16 = __attribute__((ext_vector_type(16))) float;
using f32x4  = __attribute__((ext_vector_type(4))) float;
using u32x4  = __attribute__((ext_vector_type(4))) unsigned;
using u32x2  = __attribute__((ext_vector_type(2))) unsigned;
constexpr int NW = 8, QBLK = 32, KVBLK = 64;
constexpr int LDQ = 1536, LDK = 1536, LDV = 1024, LDO = 1024;
constexpr float SCALE = 0.07216878364870323f;
constexpr float THR = 8.f;
constexpr int NQR = 8;
constexpr int SHM_V = KVBLK * 128 * 2, SHM_K = KVBLK * 192 * 2, SHM_ATTN = 2 * SHM_V + 2 * SHM_K + NW * 64 * 4;
#define AKSWZ(row, colB) ((row) * 384 + ((colB) ^ (((((row) >> 1) & 3) | (((row) >> 2) & 4)) << 4)))
#define KSWZ128(row, colB) ((row) * 256 + ((colB) ^ (((row) & 7) << 4)))
#define SBAR() __builtin_amdgcn_sched_barrier(0)
#define GAS __attribute__((address_space(1)))
__device__ __forceinline__ const GAS char* uniform_ptr(const void* p) { const unsigned long long v = (unsigned long long)p; const unsigned lo = __builtin_amdgcn_readfirstlane((unsigned)v), hi = __builtin_amdgcn_readfirstlane((unsigned)(v >> 32)); return (const GAS char*)(((unsigned long long)hi << 32) | lo); }
__device__ __forceinline__ int crow(int r, int hi) { return (r & 3) + 8 * (r >> 2) + 4 * hi; }
__device__ __forceinline__ unsigned cvtpk(float lo, float hi) { unsigned r; asm volatile("v_cvt_pk_bf16_f32 %0, %1, %2" : "=v"(r) : "v"(lo), "v"(hi)); return pg8::coarse2(r); }
__device__ __forceinline__ float swap_sum(float v) { auto rr = __builtin_amdgcn_permlane32_swap(__float_as_uint(v), __float_as_uint(v), false, false); return __uint_as_float(rr[0]) + __uint_as_float(rr[1]); }

__device__ __forceinline__ void partialSM(f32x16& p0, f32x16& p1, float& m_reg, float& mn, float& alpha) {
  constexpr float C = SCALE * 1.4426950408889634f;
  float pmax = p0[0];
#pragma unroll
  for (int r = 1; r < 16; ++r) pmax = fmaxf(pmax, p0[r]);
#pragma unroll
  for (int r = 0; r < 16; ++r) pmax = fmaxf(pmax, p1[r]);
  { auto rr = __builtin_amdgcn_permlane32_swap(__float_as_uint(pmax), __float_as_uint(pmax), false, false);
    pmax = fmaxf(__uint_as_float(rr[0]), __uint_as_float(rr[1])); }
  if (__builtin_expect(__all(pmax - m_reg <= THR / SCALE), 1)) { mn = m_reg; alpha = 1.f; }
  else { mn = fmaxf(m_reg, pmax); alpha = __builtin_amdgcn_exp2f((m_reg - mn) * C); m_reg = mn; }
  float mnC = -mn * C;
#pragma unroll
  for (int r = 0; r < 16; ++r) p0[r] = fmaf(p0[r], C, mnC);
#pragma unroll
  for (int r = 0; r < 16; ++r) p1[r] = fmaf(p1[r], C, mnC);
#pragma unroll
  for (int r = 0; r < 16; ++r) p0[r] = __builtin_amdgcn_exp2f(p0[r]);
}
#define PK4(P, BASE, OUT) do { unsigned a0 = cvtpk(P[BASE + 0], P[BASE + 1]), a1 = cvtpk(P[BASE + 2], P[BASE + 3]);   \
    unsigned b0 = cvtpk(P[BASE + 4], P[BASE + 5]), b1 = cvtpk(P[BASE + 6], P[BASE + 7]);                              \
    auto r0 = __builtin_amdgcn_permlane32_swap(a0, b0, false, false); auto r1 = __builtin_amdgcn_permlane32_swap(a1, b1, false, false); \
    u32x4 w = {r0[0], r1[0], r0[1], r1[1]}; OUT = *reinterpret_cast<bf16x8*>(&w); } while (0)
__device__ __forceinline__ void finishSM(f32x16& p0, f32x16& p1, float alpha, float& l_reg, bf16x8& pa0, bf16x8& pa1, bf16x8& pa2, bf16x8& pa3) {
#pragma unroll
  for (int r = 0; r < 16; ++r) p1[r] = __builtin_amdgcn_exp2f(p1[r]);
  float ps = 0;
#pragma unroll
  for (int r = 0; r < 16; ++r) ps += p0[r];
#pragma unroll
  for (int r = 0; r < 16; ++r) ps += p1[r];
  ps = swap_sum(ps);
  l_reg = l_reg * alpha + ps;
  PK4(p0, 0, pa0); PK4(p0, 8, pa1); PK4(p1, 0, pa2); PK4(p1, 8, pa3);
}
__device__ __forceinline__ void qkt192(f32x16& p0, f32x16& p1, const char* Ks, const bf16x8 (&qr)[NQR], const char* Qs, int r32, int hi) {
  p0 = f32x16{}; p1 = f32x16{};
#pragma unroll
  for (int d0 = 0; d0 < 12; ++d0) { int cb = (d0 * 16 + hi * 8) * 2;
    bf16x8 b0 = *reinterpret_cast<const bf16x8*>(Ks + AKSWZ(r32, cb));
    bf16x8 b1 = *reinterpret_cast<const bf16x8*>(Ks + AKSWZ(32 + r32, cb));
    bf16x8 qv; if (d0 < NQR) qv = qr[d0 < NQR ? d0 : 0]; else qv = *reinterpret_cast<const bf16x8*>(Qs + (d0 - NQR) * 1024);
    p0 = __builtin_amdgcn_mfma_f32_32x32x16_bf16(b0, qv, p0, 0, 0, 0);
    p1 = __builtin_amdgcn_mfma_f32_32x32x16_bf16(b1, qv, p1, 0, 0, 0); }
}
__device__ __forceinline__ void qkt128(f32x16& p0, f32x16& p1, const char* Ks, const bf16x8 (&qr)[8], int r32, int hi) {
  p0 = f32x16{}; p1 = f32x16{};
#pragma unroll
  for (int d0 = 0; d0 < 8; ++d0) { int cb = (d0 * 16 + hi * 8) * 2;
    bf16x8 b0 = *reinterpret_cast<const bf16x8*>(Ks + KSWZ128(r32, cb));
    bf16x8 b1 = *reinterpret_cast<const bf16x8*>(Ks + KSWZ128(32 + r32, cb));
    p0 = __builtin_amdgcn_mfma_f32_32x32x16_bf16(b0, qr[d0], p0, 0, 0, 0);
    p1 = __builtin_amdgcn_mfma_f32_32x32x16_bf16(b1, qr[d0], p1, 0, 0, 0); }
}
__device__ __forceinline__ int v_st(int k, int c) { const int kk = (k & ~0xC) | ((k & 4) << 1) | ((k & 8) >> 1); return ((kk >> 3) * 4 + (c >> 5)) * 512 + ((kk & 7) * 32 + (c & 31)) * 2; }
__device__ __forceinline__ int v_rd_base(int lane) { return ((lane & 3) << 3) | (((lane >> 2) & 3) << 6) | (((lane >> 4) & 1) << 5) | (((lane >> 5) & 1) << 8); }
constexpr int v_rd_off(int d0, int ks, int half) { return d0 * 512 + ks * 4096 + half * 2048; }
template <int OFF> __device__ __forceinline__ s16x4 tr_read(int vb) {
  s16x4 r; asm volatile("ds_read_b64_tr_b16 %0, %1 offset:%2" : "=&v"(r) : "v"(vb), "i"(OFF) : "memory"); return r;
}
#define PKLH(L, H) (bf16x8){L[0], L[1], L[2], L[3], H[0], H[1], H[2], H[3]}
template <int D0> __device__ __forceinline__ void pv_one(f32x16& od, int vb, bf16x8 pa0, bf16x8 pa1, bf16x8 pa2, bf16x8 pa3) {
  const s16x4 l0 = tr_read<v_rd_off(D0, 0, 0)>(vb), h0 = tr_read<v_rd_off(D0, 0, 1)>(vb), l1 = tr_read<v_rd_off(D0, 1, 0)>(vb), h1 = tr_read<v_rd_off(D0, 1, 1)>(vb);
  const s16x4 l2 = tr_read<v_rd_off(D0, 2, 0)>(vb), h2 = tr_read<v_rd_off(D0, 2, 1)>(vb), l3 = tr_read<v_rd_off(D0, 3, 0)>(vb), h3 = tr_read<v_rd_off(D0, 3, 1)>(vb);
  asm volatile("s_waitcnt lgkmcnt(0)" ::: "memory"); SBAR();
  od = __builtin_amdgcn_mfma_f32_32x32x16_bf16(pa0, PKLH(l0, h0), od, 0, 0, 0);
  od = __builtin_amdgcn_mfma_f32_32x32x16_bf16(pa1, PKLH(l1, h1), od, 0, 0, 0);
  od = __builtin_amdgcn_mfma_f32_32x32x16_bf16(pa2, PKLH(l2, h2), od, 0, 0, 0);
  od = __builtin_amdgcn_mfma_f32_32x32x16_bf16(pa3, PKLH(l3, h3), od, 0, 0, 0);
}
__device__ __forceinline__ void pv_d0(f32x16* o, int vb, bf16x8 pa0, bf16x8 pa1, bf16x8 pa2, bf16x8 pa3) {
  pv_one<0>(o[0], vb, pa0, pa1, pa2, pa3); pv_one<1>(o[1], vb, pa0, pa1, pa2, pa3); pv_one<2>(o[2], vb, pa0, pa1, pa2, pa3); pv_one<3>(o[3], vb, pa0, pa1, pa2, pa3);
}
template <int D0> __device__ __forceinline__ void pvT_one(f32x16& od, int vb, bf16x8 pa0, bf16x8 pa1, bf16x8 pa2, bf16x8 pa3) {
  const s16x4 l0 = tr_read<v_rd_off(D0, 0, 0)>(vb), h0 = tr_read<v_rd_off(D0, 0, 1)>(vb), l1 = tr_read<v_rd_off(D0, 1, 0)>(vb), h1 = tr_read<v_rd_off(D0, 1, 1)>(vb);
  const s16x4 l2 = tr_read<v_rd_off(D0, 2, 0)>(vb), h2 = tr_read<v_rd_off(D0, 2, 1)>(vb), l3 = tr_read<v_rd_off(D0, 3, 0)>(vb), h3 = tr_read<v_rd_off(D0, 3, 1)>(vb);
  asm volatile("s_waitcnt lgkmcnt(0)" ::: "memory"); SBAR();
  od = __builtin_amdgcn_mfma_f32_32x32x16_bf16(PKLH(l0, h0), pa0, od, 0, 0, 0);
  od = __builtin_amdgcn_mfma_f32_32x32x16_bf16(PKLH(l1, h1), pa1, od, 0, 0, 0);
  od = __builtin_amdgcn_mfma_f32_32x32x16_bf16(PKLH(l2, h2), pa2, od, 0, 0, 0);
  od = __builtin_amdgcn_mfma_f32_32x32x16_bf16(PKLH(l3, h3), pa3, od, 0, 0, 0);
}

__device__ __forceinline__ void attn_unit(const bf16_t* __restrict__ Qb, const bf16_t* __restrict__ Kh, const bf16_t* __restrict__ Vh, bf16_t* __restrict__ Ob, int seq, char* lds, int ldsaddr) {
  const int tid = threadIdx.x, wid = tid >> 6, lane = tid & 63, r32 = lane & 31, hi = lane >> 5;
  char* V_lds = lds; char* K_lds = lds + 2 * SHM_V;
  float* ws = (float*)(lds + 2 * SHM_V + 2 * SHM_K) + wid * 64; float* li_l = ws; float* al_l = ws + 32;
  float m_reg = -1e30f, l_reg = 0; f32x16 o[4] = {}; bf16x8 qr[NQR];
  const bf16_t* Qw = Qb + (long)(wid * QBLK + r32) * LDQ + hi * 8;
  char* Qs = lds + SHM_ATTN + wid * ((12 - NQR) * 1024) + lane * 16;
#pragma unroll
  for (int d0 = 0; d0 < NQR; ++d0) qr[d0] = *reinterpret_cast<const bf16x8*>(Qw + d0 * 16);
#pragma unroll
  for (int d0 = NQR; d0 < 12; ++d0) *(bf16x8*)(Qs + (d0 - NQR) * 1024) = *reinterpret_cast<const bf16x8*>(Qw + d0 * 16);
  const int sr = tid >> 4, sc = (tid & 15) * 8, vst0 = v_st(sr, sc), vst1 = v_st(32 + sr, sc);
  unsigned kg0, kg1, kg2; int kl0, kl1, kl2;
  { int p = tid;        int kr = p / 24, kc = (p % 24) * 8; kg0 = (unsigned)(kr * LDK + kc) * 2u; kl0 = AKSWZ(kr, kc * 2);
    p = tid + 512;      kr = p / 24; kc = (p % 24) * 8;     kg1 = (unsigned)(kr * LDK + kc) * 2u; kl1 = AKSWZ(kr, kc * 2);
    p = tid + 1024;     kr = p / 24; kc = (p % 24) * 8;     kg2 = (unsigned)(kr * LDK + kc) * 2u; kl2 = AKSWZ(kr, kc * 2); }
  const unsigned vg0 = (unsigned)(sr * LDV + sc) * 2u, vg1 = (unsigned)((32 + sr) * LDV + sc) * 2u;
  const int vb0 = ldsaddr + v_rd_base(lane);
  bf16x8 vs0, vs1, ks0, ks1, ks2;
#define SLOAD(k0) do { const GAS char* vb_ = uniform_ptr((const char*)Vh + (size_t)(k0) * (LDV * 2)); const GAS char* kb_ = uniform_ptr((const char*)Kh + (size_t)(k0) * (LDK * 2)); \
    vs0 = *(const GAS bf16x8*)(vb_ + vg0); vs1 = *(const GAS bf16x8*)(vb_ + vg1); \
    ks0 = *(const GAS bf16x8*)(kb_ + kg0); ks1 = *(const GAS bf16x8*)(kb_ + kg1); ks2 = *(const GAS bf16x8*)(kb_ + kg2); } while (0)
#define SWRITE(b) do { *(bf16x8*)(V_lds + (b) * SHM_V + vst0) = vs0; *(bf16x8*)(V_lds + (b) * SHM_V + vst1) = vs1; \
    *(bf16x8*)(K_lds + (b) * SHM_K + kl0) = ks0; *(bf16x8*)(K_lds + (b) * SHM_K + kl1) = ks1; *(bf16x8*)(K_lds + (b) * SHM_K + kl2) = ks2; } while (0)
#define SWAIT() asm volatile("s_waitcnt vmcnt(0)" ::: "memory")
#define RESC(a) do { if (__any((a) < 1.f)) { if (hi == 0) al_l[r32] = (a); asm volatile("s_waitcnt lgkmcnt(0)" ::: "memory"); \
    _Pragma("unroll") for (int d = 0; d < 4; ++d) _Pragma("unroll") for (int r = 0; r < 16; ++r) o[d][r] *= al_l[crow(r, hi)]; } } while (0)
  f32x16 pA0, pA1, pB0, pB1; float mnA, mnB, alA, alB; bf16x8 pa0, pa1, pa2, pa3; const int NT = seq / KVBLK;
  __syncthreads();
  SLOAD(0); SWAIT(); SWRITE(0); __syncthreads();
  qkt192(pA0, pA1, K_lds, qr, Qs, r32, hi); partialSM(pA0, pA1, m_reg, mnA, alA);
  SLOAD(KVBLK);
  SWAIT(); SWRITE(1); __syncthreads();
  for (int j = 1; j + 1 < NT; j += 2) {
    SBAR(); qkt192(pB0, pB1, K_lds + SHM_K, qr, Qs, r32, hi);
    finishSM(pA0, pA1, alA, l_reg, pa0, pa1, pa2, pa3); SBAR();
    SLOAD((j + 1) * KVBLK); SBAR();
    pv_d0(o, vb0, pa0, pa1, pa2, pa3); partialSM(pB0, pB1, m_reg, mnB, alB);
    __syncthreads(); SWAIT(); SWRITE(0);
    RESC(alB); __syncthreads();
    SBAR(); qkt192(pA0, pA1, K_lds, qr, Qs, r32, hi);
    finishSM(pB0, pB1, alB, l_reg, pa0, pa1, pa2, pa3); SBAR();
    SLOAD((j + 2) * KVBLK); SBAR();
    pv_d0(o, vb0 + SHM_V, pa0, pa1, pa2, pa3); partialSM(pA0, pA1, m_reg, mnA, alA);
    __syncthreads(); SWAIT(); SWRITE(1);
    RESC(alA); __syncthreads();
  }
  SBAR(); qkt192(pB0, pB1, K_lds + SHM_K, qr, Qs, r32, hi);
  finishSM(pA0, pA1, alA, l_reg, pa0, pa1, pa2, pa3); SBAR();
  pv_d0(o, vb0, pa0, pa1, pa2, pa3); partialSM(pB0, pB1, m_reg, mnB, alB);
  __syncthreads(); RESC(alB);
  finishSM(pB0, pB1, alB, l_reg, pa0, pa1, pa2, pa3); SBAR();
  pv_d0(o, vb0 + SHM_V, pa0, pa1, pa2, pa3);
  if (hi == 0) li_l[r32] = l_reg; asm volatile("s_waitcnt lgkmcnt(0)" ::: "memory");
  float rli[16];
#pragma unroll
  for (int r = 0; r < 16; ++r) rli[r] = __builtin_amdgcn_rcpf(li_l[crow(r, hi)]);
  bf16_t* Ow = Ob + (long)(wid * QBLK) * LDO;
#pragma unroll
  for (int r = 0; r < 16; ++r) { int orow = crow(r, hi);
#pragma unroll
    for (int d0 = 0; d0 < 4; ++d0) Ow[(long)orow * LDO + d0 * 32 + r32] = (bf16_t)(cvtpk(o[d0][r] * rli[r], 0.f) & 0xffffu); }
#undef SLOAD
#undef SWRITE
#undef SWAIT
#undef RESC
}

__device__ __forceinline__ bf16x8 scale8(bf16x8 v, float s) {
  u32x4 w = *reinterpret_cast<u32x4*>(&v), o;
#pragma unroll
  for (int i = 0; i < 4; ++i) o[i] = cvtpk(__uint_as_float(w[i] << 16) * s, __uint_as_float(w[i] & 0xffff0000u) * s);
  return *reinterpret_cast<bf16x8*>(&o);
}
__device__ __forceinline__ s16x4 trr(int addr) { s16x4 r; asm volatile("ds_read_b64_tr_b16 %0, %1" : "=&v"(r) : "v"(addr) : "memory"); return r; }

__device__ __forceinline__ void chunk_kv_unit(const bf16_t* __restrict__ Kc, const bf16_t* __restrict__ Vc, bf16_t* __restrict__ CKf, bf16_t* __restrict__ CKb, float lgf, float lgb, char* lds, int ldsaddr) {
  const int tid = threadIdx.x, wid = tid >> 6, lane = tid & 63, r32 = lane & 31, hi = lane >> 5;
  const int dir = wid >> 2, db = wid & 3, d = 32 * db + r32;
  __syncthreads();
  { const int sr = tid >> 4, sc = (tid & 15) * 8;
#pragma unroll
    for (int i = 0; i < 4; ++i) { const int row = sr + 32 * i;
      *(bf16x8*)(lds + (row >> 6) * 16384 + v_st(row & 63, sc)) = *reinterpret_cast<const bf16x8*>(Vc + (long)row * 1024 + sc);
      *(bf16x8*)(lds + 32768 + row * 272 + sc * 2) = *reinterpret_cast<const bf16x8*>(Kc + (long)row * 1024 + sc); } }
  __syncthreads();
  bf16x8 kb[8];
  int hio = hi; asm volatile("" : "+v"(hio));
  const char* kl = lds + 32768 + (hio * 8) * 272 + d * 2;
#pragma unroll
  for (int ks = 0; ks < 8; ++ks) { u32x4 w;
#pragma unroll
    for (int i = 0; i < 4; ++i) { const int s0 = ks * 16 + hio * 8 + 2 * i;
      const float k0 = __uint_as_float((unsigned)*(const unsigned short*)(kl + (ks * 16 + 2 * i) * 272) << 16), k1 = __uint_as_float((unsigned)*(const unsigned short*)(kl + (ks * 16 + 2 * i + 1) * 272) << 16);
      const float z0 = __builtin_amdgcn_exp2f(dir ? lgb * (float)s0 : lgf * (float)(127 - s0)), z1 = __builtin_amdgcn_exp2f(dir ? lgb * (float)(s0 + 1) : lgf * (float)(126 - s0));
      w[i] = cvtpk(k0 * z0, k1 * z1); }
    kb[ks] = *reinterpret_cast<bf16x8*>(&w); }
  f32x16 acc[4] = {};
  const int vb = ldsaddr + v_rd_base(lane);
  pvT_one<0>(acc[0], vb, kb[0], kb[1], kb[2], kb[3]); pvT_one<1>(acc[1], vb, kb[0], kb[1], kb[2], kb[3]); pvT_one<2>(acc[2], vb, kb[0], kb[1], kb[2], kb[3]); pvT_one<3>(acc[3], vb, kb[0], kb[1], kb[2], kb[3]);
  pvT_one<0>(acc[0], vb + 16384, kb[4], kb[5], kb[6], kb[7]); pvT_one<1>(acc[1], vb + 16384, kb[4], kb[5], kb[6], kb[7]); pvT_one<2>(acc[2], vb + 16384, kb[4], kb[5], kb[6], kb[7]); pvT_one<3>(acc[3], vb + 16384, kb[4], kb[5], kb[6], kb[7]);
  bf16_t* CK = dir ? CKb : CKf;
#pragma unroll
  for (int eb = 0; eb < 4; ++eb)
#pragma unroll
    for (int r = 0; r < 16; ++r) CK[(32 * eb + crow(r, hi)) * 128 + d] = (bf16_t)(cvtpk(acc[eb][r], 0.f) & 0xffffu);
}

#ifndef PROBE_COMP
#define PROBE_COMP 0
#endif
__device__ __forceinline__ void ret_out_unit(const bf16_t* __restrict__ Qc, const bf16_t* __restrict__ Kc, const bf16_t* __restrict__ Vc, const bf16_t* __restrict__ Gc,
                                             const bf16_t* __restrict__ STf, const bf16_t* __restrict__ STb, const float* __restrict__ gnw, const float* __restrict__ gnb,
                                             bf16_t* __restrict__ Oc, float lgf, float lgb, char* lds, int ldsaddr, float* dump = nullptr) {
  const int tid = threadIdx.x, ht = tid & 255, wq = (tid >> 6) & 3, lane = tid & 63, r32 = lane & 31, hi = lane >> 5;
  __syncthreads();
  { const int sr = ht >> 4, sc = (ht & 15) * 8;
#pragma unroll
    for (int i = 0; i < 8; ++i) { const int row = sr + 16 * i, tile = row >> 6, key = row & 63;
      *(bf16x8*)(lds + tile * 16384 + KSWZ128(key, sc * 2)) = *reinterpret_cast<const bf16x8*>(Kc + (long)row * 1024 + sc);
      *(bf16x8*)(lds + 32768 + tile * 16384 + v_st(key, sc)) = *reinterpret_cast<const bf16x8*>(Vc + (long)row * 1024 + sc); } }
  const int c = 32 * wq + r32;
  bf16x8 qr[8];
#pragma unroll
  for (int d0 = 0; d0 < 8; ++d0) qr[d0] = *reinterpret_cast<const bf16x8*>(Qc + (long)c * 1024 + d0 * 16 + hi * 8);
  __syncthreads();
  f32x16 pA0, pA1, pB0, pB1;
  qkt128(pA0, pA1, lds, qr, r32, hi); qkt128(pB0, pB1, lds + 16384, qr, r32, hi);
  int cdec = c; asm volatile("" : "+v"(cdec));
#define DEC(P, JB) do { _Pragma("unroll") for (int r = 0; r < 16; ++r) { const int dl = cdec - ((JB) + crow(r, hi)); \
    P[r] *= __builtin_amdgcn_exp2f(dl >= 0 ? lgf * (float)dl : lgb * (float)(-dl)); } } while (0)
  DEC(pA0, 0); DEC(pA1, 32); DEC(pB0, 64); DEC(pB1, 96);
#undef DEC
  bf16x8 xa0, xa1, xa2, xa3, xb0, xb1, xb2, xb3;
  PK4(pA0, 0, xa0); PK4(pA0, 8, xa1); PK4(pA1, 0, xa2); PK4(pA1, 8, xa3);
  PK4(pB0, 0, xb0); PK4(pB0, 8, xb1); PK4(pB1, 0, xb2); PK4(pB1, 8, xb3);
  f32x16 o[4] = {};
  const int vb = ldsaddr + 32768 + v_rd_base(lane);
  if (PROBE_COMP == 0 || (PROBE_COMP & 1)) {
  pvT_one<0>(o[0], vb, xa0, xa1, xa2, xa3); pvT_one<1>(o[1], vb, xa0, xa1, xa2, xa3); pvT_one<2>(o[2], vb, xa0, xa1, xa2, xa3); pvT_one<3>(o[3], vb, xa0, xa1, xa2, xa3);
  pvT_one<0>(o[0], vb + 16384, xb0, xb1, xb2, xb3); pvT_one<1>(o[1], vb + 16384, xb0, xb1, xb2, xb3); pvT_one<2>(o[2], vb + 16384, xb0, xb1, xb2, xb3); pvT_one<3>(o[3], vb + 16384, xb0, xb1, xb2, xb3);
  }
#pragma unroll
  for (int dir = 0; dir < 2; ++dir) {
    if (PROBE_COMP != 0 && !((PROBE_COMP >> (1 + dir)) & 1)) continue;
    const float xi = __builtin_amdgcn_exp2f(dir == 0 ? lgf * (float)(c + 1) : lgb * (float)(128 - c));
    const bf16_t* ST = dir == 0 ? STf : STb;
    bf16x8 qs[8];
#pragma unroll
    for (int d0 = 0; d0 < 8; ++d0) qs[d0] = scale8(qr[d0], xi);
    const GAS char* stb = uniform_ptr(ST); const unsigned so = (unsigned)(r32 * 128 + hi * 8) * 2u;
#pragma unroll
    for (int eb = 0; eb < 4; ++eb) {
      bf16x8 A[8];
      SBAR();
#pragma unroll
      for (int d0 = 0; d0 < 8; ++d0) A[d0] = *(const GAS bf16x8*)(stb + so + (eb * 32 * 128 + d0 * 16) * 2);
#pragma unroll
      for (int d0 = 0; d0 < 8; ++d0) o[eb] = __builtin_amdgcn_mfma_f32_32x32x16_bf16(A[d0], qs[d0], o[eb], 0, 0, 0);
      SBAR();
    }
  }
  if (PROBE_COMP != 0) {
#pragma unroll
    for (int eb = 0; eb < 4; ++eb)
#pragma unroll
      for (int g = 0; g < 4; ++g) *(f32x4*)(dump + (long)c * 1024 + 32 * eb + 8 * g + 4 * hi) = (f32x4){o[eb][4 * g], o[eb][4 * g + 1], o[eb][4 * g + 2], o[eb][4 * g + 3]};
    return; }
  float s = 0.f;
#pragma unroll
  for (int eb = 0; eb < 4; ++eb)
#pragma unroll
    for (int r = 0; r < 16; ++r) s += o[eb][r];
  const float mu = swap_sum(s) * (1.f / 128.f);
  float q = 0.f;
#pragma unroll
  for (int eb = 0; eb < 4; ++eb)
#pragma unroll
    for (int r = 0; r < 16; ++r) { const float d = o[eb][r] - mu; q += d * d; }
  const float rstd = rsqrtf(swap_sum(q) * (1.f / 128.f) + 1e-6f);
#pragma unroll
  for (int eb = 0; eb < 4; ++eb)
#pragma unroll
    for (int g = 0; g < 4; ++g) { const int e0 = 32 * eb + 8 * g + 4 * hi;
      const f32x4 w4 = *(const f32x4*)(gnw + e0), b4 = *(const f32x4*)(gnb + e0);
      const u32x2 gg = *(const u32x2*)(Gc + (long)c * 1024 + e0);
      const float g0 = __uint_as_float(gg.x << 16), g1 = __uint_as_float(gg.x & 0xffff0000u), g2 = __uint_as_float(gg.y << 16), g3 = __uint_as_float(gg.y & 0xffff0000u);
      const float y0 = ((o[eb][4 * g] - mu) * rstd * w4[0] + b4[0]) * g0, y1 = ((o[eb][4 * g + 1] - mu) * rstd * w4[1] + b4[1]) * g1;
      const float y2 = ((o[eb][4 * g + 2] - mu) * rstd * w4[2] + b4[2]) * g2, y3 = ((o[eb][4 * g + 3] - mu) * rstd * w4[3] + b4[3]) * g3;
      u32x2 w; w.x = cvtpk(y0, y1); w.y = cvtpk(y2, y3);
      *(u32x2*)(Oc + (long)c * 2048 + e0) = w; }
}

__device__ __forceinline__ void ret_brute_unit(const bf16_t* __restrict__ Qh, const bf16_t* __restrict__ Kh, const bf16_t* __restrict__ Vh, const bf16_t* __restrict__ Gc,
                                               const float* __restrict__ gnw, const float* __restrict__ gnb, bf16_t* __restrict__ Oc, int t0, float lgf, float lgb, char* lds, const float* dump = nullptr) {
  const int tid = threadIdx.x, qi = tid >> 2, part = tid & 3, t = t0 + qi;
  float q[32], acc[32];
#pragma unroll
  for (int i = 0; i < 32; ++i) { q[i] = __uint_as_float((unsigned)Qh[(long)t * 1024 + part * 32 + i] << 16); acc[i] = 0.f; }
  for (int s0 = 0; s0 < 4096; s0 += 64) {
    { const int rel = s0 < t0 ? 1 : (s0 >= t0 + 128 ? 2 : 0); if (PROBE_COMP != 0 && ((PROBE_COMP >> rel) & 1)) continue; }
    __syncthreads();
    for (int c = tid; c < 64 * 16; c += 512) { const int r = c >> 4, c8 = (c & 15) * 8;
      *(bf16x8*)(lds + (r * 128 + c8) * 2) = *reinterpret_cast<const bf16x8*>(Kh + (long)(s0 + r) * 1024 + c8);
      *(bf16x8*)(lds + 16384 + (r * 128 + c8) * 2) = *reinterpret_cast<const bf16x8*>(Vh + (long)(s0 + r) * 1024 + c8); }
    __syncthreads();
    for (int j = 0; j < 64; ++j) { const int s = s0 + j; float d = 0.f;
      const unsigned short* kr = (const unsigned short*)(lds + (j * 128 + part * 32) * 2); const unsigned short* vr = (const unsigned short*)(lds + 16384 + (j * 128 + part * 32) * 2);
#pragma unroll
      for (int i = 0; i < 32; ++i) d += q[i] * __uint_as_float((unsigned)kr[i] << 16);
      d += __shfl_xor(d, 1); d += __shfl_xor(d, 2);
      const int dl = t - s; const float w = d * __builtin_amdgcn_exp2f(dl >= 0 ? lgf * (float)dl : lgb * (float)(-dl));
#pragma unroll
      for (int i = 0; i < 32; ++i) acc[i] += w * __uint_as_float((unsigned)vr[i] << 16); }
  }
  if (PROBE_COMP != 0) {
#pragma unroll
    for (int i = 0; i < 32; ++i) acc[i] += dump[(long)qi * 1024 + part * 32 + i]; }
  float sm = 0.f;
#pragma unroll
  for (int i = 0; i < 32; ++i) sm += acc[i];
  sm += __shfl_xor(sm, 1); sm += __shfl_xor(sm, 2); const float mu = sm * (1.f / 128.f);
  float qq = 0.f;
#pragma unroll
  for (int i = 0; i < 32; ++i) { const float dd = acc[i] - mu; qq += dd * dd; }
  qq += __shfl_xor(qq, 1); qq += __shfl_xor(qq, 2); const float rstd = rsqrtf(qq * (1.f / 128.f) + 1e-6f);
#pragma unroll
  for (int i = 0; i < 32; ++i) { const int e = part * 32 + i; const float g = __uint_as_float((unsigned)Gc[(long)qi * 1024 + e] << 16);
    Oc[(long)qi * 2048 + e] = (bf16_t)(cvtpk(((acc[i] - mu) * rstd * gnw[e] + gnb[e]) * g, 0.f) & 0xffffu); }
}
#undef SBAR
}


#ifndef PROBE_BRUTE_RET
#define PROBE_BRUTE_RET 0
#endif
#ifndef MK_SPLIT
#define MK_SPLIT 0
#endif
#define LAS __attribute__((address_space(3)))
#define GASX __attribute__((address_space(1)))
typedef unsigned short bf16_t;
typedef unsigned v4u __attribute__((ext_vector_type(4)));
typedef unsigned v2u __attribute__((ext_vector_type(2)));
typedef float f32x4 __attribute__((ext_vector_type(4)));
typedef short bf16x8 __attribute__((ext_vector_type(8)));

constexpr int BATCH = 8, SEQ = 4096, DM = 2048, T = BATCH * SEQ;
constexpr int INC = 5184, INCP = 5376, DFF = 5632, NMODC = 6 * DM;
constexpr int NPH = 11;
constexpr size_t MiB = 1u << 20;
constexpr size_t WS_CTL = 0, CTL_ZERO_BYTES = 2 * MiB;
constexpr size_t OFF_MOD = 0, OFF_SSQQ = 512 * 1024, OFF_SSQKV = 640 * 1024;
constexpr size_t WS_COSR = 2 * MiB, WS_SINR = 10 * MiB, WS_COSM = 18 * MiB, WS_SINM = 22 * MiB;
constexpr size_t WS_WIN = 26 * MiB, WS_WUQ = 47 * MiB, WS_WUKV = 49 * MiB, WS_WO = 51 * MiB, WS_WGU = 59 * MiB, WS_WDN = 103 * MiB;
constexpr size_t WS_H = 128 * MiB;
constexpr size_t WS_QR = 256 * MiB, WS_KR = 320 * MiB, WS_VR = 384 * MiB, WS_GR = 448 * MiB;
constexpr size_t WS_CQ = 512 * MiB, WS_CKV = 544 * MiB;
constexpr size_t WS_QM = 576 * MiB, WS_KB = 672 * MiB, WS_VM = 768 * MiB, WS_OAT = 832 * MiB, WS_END = 896 * MiB;
constexpr size_t WS_CAT = 576 * MiB;
constexpr size_t WS_AFF = 256 * MiB;
static_assert(WS_AFF + (size_t)T * DFF * 2 <= WS_END && WS_CAT + (size_t)T * 2048 * 2 <= WS_VM, "d_ws map");
constexpr int LDS_BAR_OFF = 150528;
constexpr size_t OFF_XBAR = 1536 * 1024;
constexpr int LDS_BYTES = 150528 + 64;

#define LDS_WAIT() asm volatile("s_waitcnt lgkmcnt(0)" ::: "memory")
__device__ __forceinline__ unsigned f2bf(float f) { unsigned u = __builtin_bit_cast(unsigned, f); return (u + 0x7fffu + ((u >> 16) & 1u)) >> 16; }
__device__ __forceinline__ unsigned pk2(float lo, float hi) { return f2bf(lo) | (f2bf(hi) << 16); }
__device__ __forceinline__ unsigned pk2a(float lo, float hi) { return pg8::coarse2(pk2(lo, hi)); }
__device__ __forceinline__ float wave_sum(float v) {
#pragma unroll
    for (int o = 1; o < 64; o <<= 1) v += __shfl_xor(v, o);
    return v;
}
__device__ __forceinline__ int dest_row(int mapid, int n) {
    switch (mapid) {
    case 1: if (n < 2048) { const int j = n & 127; return (n & ~127) + (j < 64 ? 2 * j : 2 * (j - 64) + 1); }
            if (n < 5120) return n;
            { const int j = n - 5120; return 5120 + (j < 32 ? 2 * j : 2 * (j - 32) + 1); }
    case 2: { const int d = n % 192; if (d < 128) return n; const int j = d - 128; return n - d + 128 + (j < 32 ? 2 * j : 2 * (j - 32) + 1); }
    case 3: return (n >> 7) * 256 + (n & 127);
    case 4: return (n >> 7) * 256 + 128 + (n & 127);
    default: return n;
    }
}
__device__ __forceinline__ void transpose_item(const float* __restrict__ W, int K, int N, bf16_t* __restrict__ WT, const float* __restrict__ kscale, int mapid, LAS float* scr, int item, int lane) {
    const int nblk = N / 32, kb = item / nblk, nb = item % nblk, k0 = 64 * kb, n0 = 32 * nb;
#pragma unroll 8
    for (int i = 0; i < 32; ++i) { const int kk = 2 * i + (lane >> 5); float v = W[(size_t)(k0 + kk) * N + n0 + (lane & 31)]; if (kscale) v *= kscale[k0 + kk]; scr[kk * 33 + (lane & 31)] = v; }
    LDS_WAIT(); asm volatile("" ::: "memory");
    const int c = lane & 7;
#pragma unroll
    for (int j = 0; j < 4; ++j) { const int n = (lane >> 3) + 8 * j; const LAS float* s = scr + (8 * c) * 33 + n;
        v4u o; o.x = pk2(s[0 * 33], s[1 * 33]); o.y = pk2(s[2 * 33], s[3 * 33]); o.z = pk2(s[4 * 33], s[5 * 33]); o.w = pk2(s[6 * 33], s[7 * 33]);
        *(v4u*)(WT + (size_t)dest_row(mapid, n0 + n) * K + k0 + 8 * c) = o; }
    LDS_WAIT(); asm volatile("" ::: "memory");
}
__device__ __forceinline__ void norm_row(const float* xrow, const float* __restrict__ w, const float* __restrict__ shift, const float* __restrict__ scale, bf16_t* ob, float* of, int lane) {
    const f32x4* xr = (const f32x4*)xrow + lane;
    f32x4 v[8]; float s = 0.f;
#pragma unroll
    for (int j = 0; j < 8; ++j) { v[j] = xr[64 * j]; s += (v[j].x * v[j].x + v[j].y * v[j].y) + (v[j].z * v[j].z + v[j].w * v[j].w); }
    const float rstd = rsqrtf(wave_sum(s) * (1.f / 2048.f) + 1e-6f);
#pragma unroll
    for (int j = 0; j < 8; ++j) { const int col = 4 * lane + 256 * j; f32x4 y = v[j] * rstd * *(const f32x4*)(w + col);
        if (shift) y = y * (*(const f32x4*)(scale + col) + 1.f) + *(const f32x4*)(shift + col);
        if (ob) { v2u o; o.x = pk2a(y.x, y.y); o.y = pk2a(y.z, y.w); *(v2u*)(ob + col) = o; } else *(f32x4*)(of + col) = y; }
}

#define XB_TMO      128
#define XB_XCNT(j)  (256  + 64 * (j))
#define XB_XSUB(j)  (1280 + 64 * (j))
#define XB_XGEN(j)  (2304 + 64 * (j))
#define XB_TOP      3328
#define XB_TOPGEN   3392
#define XCD_BAR_WORDS 3456
#define XB_SPIN_CAP (1u << 18)

__device__ __forceinline__ unsigned xb_ld(unsigned* p)              { return __hip_atomic_load(p, __ATOMIC_RELAXED, __HIP_MEMORY_SCOPE_AGENT); }
__device__ __forceinline__ unsigned xb_add(unsigned* p, unsigned v) { return __hip_atomic_fetch_add(p, v, __ATOMIC_RELAXED, __HIP_MEMORY_SCOPE_AGENT); }
__device__ __forceinline__ unsigned xb_xcc_id() { return (unsigned)__builtin_amdgcn_s_getreg((3 << 11) | 20) & 0xFu; }
#define XB_SPIN(cond, bar) do { unsigned _sp = 0; while (cond) { __builtin_amdgcn_s_sleep(1); \
    if ((++_sp & 255u) == 0u) { if (xb_ld(&(bar)[XB_TMO])) break; if (_sp > XB_SPIN_CAP) { atomicAdd(&(bar)[XB_TMO], 1u); break; } } } } while (0)

struct XcdBarrier {
    unsigned* bar; unsigned x;
    volatile LAS unsigned* st;
};

__device__ __forceinline__ XcdBarrier xcd_barrier_post(unsigned* bar, volatile LAS unsigned* st) {
    XcdBarrier b; b.bar = bar; b.x = xb_xcc_id(); b.st = st;
    if (threadIdx.x == 0) (void)xb_add(&bar[XB_XCNT(b.x)], 1u);
    return b;
}
__device__ __forceinline__ void xcd_barrier_complete(unsigned* bar, unsigned x, unsigned& nloc, unsigned& nx) {
    const unsigned G = gridDim.x * gridDim.y * gridDim.z;
    unsigned sum, cnt, mine, sp = 0u;
    for (;;) {
        sum = 0u; cnt = 0u; mine = 0u;
#pragma unroll
        for (unsigned j = 0; j < 16; ++j) { const unsigned c = xb_ld(&bar[XB_XCNT(j)]); sum += c; cnt += (c > 0u) ? 1u : 0u; mine = (j == x) ? c : mine; }
        if (sum == G) break;
        __builtin_amdgcn_s_sleep(1);
        if ((++sp & 255u) == 0u) { if (xb_ld(&bar[XB_TMO])) break; if (sp > XB_SPIN_CAP) { atomicAdd(&bar[XB_TMO], 1u); break; } }
    }
    nloc = mine > 0u ? mine : 1u; nx = cnt > 0u ? cnt : 1u;
}

__device__ __forceinline__ void xcd_barrier(const XcdBarrier& b) {
    asm volatile("s_waitcnt vmcnt(0)" ::: "memory");
    __syncthreads();
    if (threadIdx.x == 0) {
        unsigned* bar = b.bar;
        __builtin_amdgcn_s_waitcnt(0);
        unsigned nloc = b.st[0], nx = b.st[1];
        if (nloc == 0u) { xcd_barrier_complete(bar, b.x, nloc, nx); b.st[0] = nloc; b.st[1] = nx; }
        const unsigned old = xb_add(&bar[XB_XSUB(b.x)], 1u);
        const unsigned gen = old / nloc;
        if (old + 1u == (gen + 1u) * nloc) {
            __builtin_amdgcn_fence(__ATOMIC_RELEASE, "agent");
            asm volatile("s_waitcnt vmcnt(0)" ::: "memory");
            const unsigned og = xb_add(&bar[XB_TOP], 1u);
            const unsigned tg = og / nx;
            if (og + 1u == (tg + 1u) * nx) xb_add(&bar[XB_TOPGEN], 1u);
            else XB_SPIN(xb_ld(&bar[XB_TOPGEN]) == tg, bar);
            __builtin_amdgcn_fence(__ATOMIC_ACQUIRE, "agent");
            xb_add(&bar[XB_XGEN(b.x)], 1u);
            asm volatile("s_waitcnt vmcnt(0)" ::: "memory");
        } else {
            XB_SPIN(xb_ld(&bar[XB_XGEN(b.x)]) == gen, bar);
            __builtin_amdgcn_fence(__ATOMIC_ACQUIRE, "agent");
            asm volatile("s_waitcnt vmcnt(0)" ::: "memory");
        }
    }
    __syncthreads();
}

struct Args { const float* in[21]; float* out; unsigned char* ws; float inv_r[64]; float inv_m[32]; int ph_lo, ph_hi; };
static_assert(sizeof(Args) == 21 * 8 + 16 + 96 * 4 + 8, "Args has no padding");

__global__ void __launch_bounds__(512, 2) mk_fwd(Args a) {
    extern __shared__ __attribute__((aligned(16))) unsigned char smem[];
    cg::grid_group grid = cg::this_grid();
    const int tid = threadIdx.x, lane = tid & 63, wave = __builtin_amdgcn_readfirstlane(tid >> 6);
    const int G = gridDim.x, bx = blockIdx.x, vcu = (G % 8 == 0) ? (bx % 8) * (G / 8) + bx / 8 : bx;
    const int gw = vcu * 8 + wave, NGW = G * 8;
    LAS unsigned char* lds3 = (LAS unsigned char*)smem; char* ldsg = (char*)smem; const int ldsaddr = (int)(unsigned)(uintptr_t)lds3;
    float* out = a.out;
#define WSB() size_t wz_ = 0; asm volatile("" : "+s"(wz_)); unsigned char* ws = a.ws + wz_
#define INP(name, k) const float* name = a.in[k] + wz_
#define WSF(name, off) float* name = (float*)(ws + (off))
#define WSH(name, off) bf16_t* name = (bf16_t*)(ws + (off))
    const int lo = a.ph_lo, hi = a.ph_hi;
    if (tid < 16) ((LAS unsigned*)(lds3 + LDS_BAR_OFF))[tid] = 0u;
    __syncthreads();
    XcdBarrier xbar = xcd_barrier_post((unsigned*)(a.ws + WS_CTL + OFF_XBAR), (volatile LAS unsigned*)(lds3 + LDS_BAR_OFF));
#ifndef PH_MASK
#define PH_MASK 0x7ff
#endif
#define IN(k) (((PH_MASK >> (k)) & 1) && lo <= (k) && (k) < hi)
#define SEAM(k) do { if (IN(k) && IN((k) + 1)) { asm volatile("s_waitcnt vmcnt(0) lgkmcnt(0)" ::: "memory"); grid.sync(); \
    __builtin_amdgcn_fence(__ATOMIC_ACQUIRE, "agent"); asm volatile("s_waitcnt vmcnt(0)" ::: "memory"); } } while (0)
#define SEAMX(k) do { if (IN(k) && IN((k) + 1)) xcd_barrier(xbar); } while (0)

    if (IN(0)) {
        WSB(); WSF(mod, WS_CTL + OFF_MOD); WSF(cosr, WS_COSR); WSF(sinr, WS_SINR); WSF(cosm, WS_COSM); WSF(sinm, WS_SINM);
        WSH(Win, WS_WIN); WSH(Wuq, WS_WUQ); WSH(Wukv, WS_WUKV); WSH(Wo, WS_WO); WSH(Wgu, WS_WGU); WSH(Wdn, WS_WDN);
        INP(cin, 1); INP(ada_w, 3); INP(ada_b, 4); INP(w_in, 6); INP(mla_q_norm_w, 10); INP(w_uq, 11); INP(mla_kv_norm_w, 12); INP(w_ukv, 13); INP(w_o, 15); INP(w_gate, 17); INP(w_up, 18); INP(w_down, 19);
        const int* positions = (const int*)a.in[2] + wz_;
        {
            LAS float* cs = (LAS float*)lds3;
            for (int i = tid; i < 8 * 2048; i += 512) { const int b = i >> 11, k = i & 2047; const float v = cin[i]; cs[k * 8 + b] = v / (1.f + __expf(-v)); }
            __syncthreads();
            for (int task = gw; task < 192 * 16; task += NGW) { const int cb = task % 192, ks = task / 192, col = cb * 64 + lane;
                float acc[8]; const float bias = ks == 0 ? ada_b[col] : 0.f;
#pragma unroll
                for (int b = 0; b < 8; ++b) acc[b] = bias;
                const float* wp = ada_w + (size_t)(ks * 128) * NMODC + col;
                for (int k8 = 0; k8 < 128; k8 += 8) { float wv[8];
#pragma unroll
                    for (int i = 0; i < 8; ++i) wv[i] = wp[(size_t)(k8 + i) * NMODC];
#pragma unroll
                    for (int i = 0; i < 8; ++i) { const LAS f32x4* c4 = (const LAS f32x4*)(cs + (ks * 128 + k8 + i) * 8); const f32x4 c0 = c4[0], c1 = c4[1];
                        acc[0] += c0.x * wv[i]; acc[1] += c0.y * wv[i]; acc[2] += c0.z * wv[i]; acc[3] += c0.w * wv[i]; acc[4] += c1.x * wv[i]; acc[5] += c1.y * wv[i]; acc[6] += c1.z * wv[i]; acc[7] += c1.w * wv[i]; } }
#pragma unroll
                for (int b = 0; b < 8; ++b) atomicAdd(mod + (size_t)b * NMODC + col, acc[b]); }
            __syncthreads();
        }
        {
            LAS float* scr = (LAS float*)(lds3 + wave * 16384);
            constexpr int I_IN = 32 * (INC / 32), I_UQ = 8 * 48, I_UKV = 8 * 64, I_O = 32 * 64, I_G = 32 * (DFF / 32), I_D = (DFF / 64) * 64;
            constexpr int NITEMS = I_IN + I_UQ + I_UKV + I_O + 2 * I_G + I_D;
            for (int it = gw; it < NITEMS; it += NGW) { int r = it;
                if (r < I_IN) { transpose_item(w_in, 2048, INC, Win, nullptr, 1, scr, r, lane); continue; } r -= I_IN;
                if (r < I_UQ) { transpose_item(w_uq, 512, 1536, Wuq, mla_q_norm_w, 2, scr, r, lane); continue; } r -= I_UQ;
                if (r < I_UKV) { transpose_item(w_ukv, 512, 2048, Wukv, mla_kv_norm_w, 0, scr, r, lane); continue; } r -= I_UKV;
                if (r < I_O) { transpose_item(w_o, 2048, 2048, Wo, nullptr, 0, scr, r, lane); continue; } r -= I_O;
                if (r < I_G) { transpose_item(w_gate, 2048, DFF, Wgu, nullptr, 3, scr, r, lane); continue; } r -= I_G;
                if (r < I_G) { transpose_item(w_up, 2048, DFF, Wgu, nullptr, 4, scr, r, lane); continue; } r -= I_G;
                transpose_item(w_down, DFF, 2048, Wdn, nullptr, 0, scr, r, lane); }
            for (int i = bx * 512 + tid; i < (INCP - INC) * 2048 / 8; i += G * 512) *(v4u*)(Win + (size_t)INC * 2048 + (size_t)i * 8) = (v4u){0u, 0u, 0u, 0u};
        }
        {
            for (int i = bx * 512 + tid; i < T * 96; i += G * 512) { const int t = i / 96, j = i % 96; const float pos = (float)positions[t];
                const float inv = j < 64 ? a.inv_r[j] : a.inv_m[j - 64]; const float ang = pos * inv;
                double rev = (double)ang * 0.15915494309189535; rev -= __builtin_rint(rev);
                const double qd = __builtin_rint(rev * 4.0); const double y = (rev - qd * 0.25) * 6.283185307179586; const double y2 = y * y;
                const double sy = y * (1.0 + y2 * (-1.0 / 6 + y2 * (1.0 / 120 + y2 * (-1.0 / 5040 + y2 * (1.0 / 362880 + y2 * (-1.0 / 39916800 + y2 * (1.0 / 6227020800.0)))))));
                const double cy = 1.0 + y2 * (-0.5 + y2 * (1.0 / 24 + y2 * (-1.0 / 720 + y2 * (1.0 / 40320 + y2 * (-1.0 / 3628800 + y2 * (1.0 / 479001600.0 + y2 * (-1.0 / 87178291200.0)))))));
                const int qi = (int)qd & 3;
                const float cv = (float)(qi == 0 ? cy : qi == 1 ? -sy : qi == 2 ? -cy : sy), sv = (float)(qi == 0 ? sy : qi == 1 ? cy : qi == 2 ? -sy : -cy);
                if (j < 64) { cosr[(size_t)t * 64 + j] = cv; sinr[(size_t)t * 64 + j] = sv; } else { cosm[(size_t)t * 32 + j - 64] = cv; sinm[(size_t)t * 32 + j - 64] = sv; } }
        }
    }
    SEAMX(0);
    if (a.ph_hi > 1000) { SEAM(0); }
    if (IN(1)) { WSB(); WSF(mod, WS_CTL + OFF_MOD); WSH(H, WS_H); INP(x, 0); INP(norm1_w, 5);
        for (int m = gw; m < T; m += NGW) { const int b = m >> 12; norm_row(x + (size_t)m * DM, norm1_w, mod + (size_t)b * NMODC, mod + (size_t)b * NMODC + DM, H + (size_t)m * DM, nullptr, lane); } }
    SEAMX(1);
    if (IN(2)) {
        WSB(); WSH(H, WS_H); WSH(Win, WS_WIN); WSH(Qr, WS_QR); WSH(Kr, WS_KR); WSH(Vr, WS_VR); WSH(Gr, WS_GR); WSH(CQ, WS_CQ); WSH(CKV, WS_CKV); WSH(Kbuf, WS_KB);
        WSF(cosr, WS_COSR); WSF(sinr, WS_SINR); WSF(cosm, WS_COSM); WSF(sinm, WS_SINM); WSF(ssq_q, WS_CTL + OFF_SSQQ); WSF(ssq_kv, WS_CTL + OFF_SSQKV);
        pg8::Gemm g{H, Win, T, INCP, DM}; pg8::StaticOrder S; S.init(T, INCP, G, bx);
        pg8::EpiIn E{Qr, Kr, Vr, Gr, CQ, CKV, Kbuf, cosr, sinr, cosm, sinm, ssq_q, ssq_kv};
        pg8::gemm_phase<pg8::EpiIn, pg8::StaticOrder, true, true>(lds3, g, S, E);
    }
    SEAMX(2);
    if (IN(3)) {
        WSB(); WSH(CQ, WS_CQ); WSH(CKV, WS_CKV); WSH(Wuq, WS_WUQ); WSH(Wukv, WS_WUKV); WSH(Qm, WS_QM); WSH(Kbuf, WS_KB); WSH(Vm, WS_VM); WSH(Kr, WS_KR); WSH(Vr, WS_VR); WSH(CK, WS_H);
        WSF(cosm, WS_COSM); WSF(sinm, WS_SINM); WSF(ssq_q, WS_CTL + OFF_SSQQ); WSF(ssq_kv, WS_CTL + OFF_SSQKV); INP(ret_decay, 7);
        { pg8::Gemm g{CQ, Wuq, T, 1536, 512}; pg8::StaticOrder S; S.init(T, 1536, G, bx); pg8::EpiUpQ E{ssq_q, Qm, cosm, sinm};
          pg8::gemm_phase<pg8::EpiUpQ, pg8::StaticOrder, true, true>(lds3, g, S, E); }
        { pg8::Gemm g{CKV, Wukv, T, 2048, 512}; pg8::StaticOrder S; S.init(T, 2048, G, bx); pg8::EpiUpKV E{ssq_kv, Kbuf, Vm};
          pg8::gemm_phase<pg8::EpiUpKV, pg8::StaticOrder, true, true>(lds3, g, S, E); }
        for (int u = vcu; u < 2048; u += G) { const int n = u & 31, h = (u >> 5) & 7, b = u >> 8; const size_t t0 = (size_t)b * SEQ + n * 128;
            const float lgf = -__expf(ret_decay[h]) * 1.4426950408889634f, lgb = -__expf(ret_decay[8 + h]) * 1.4426950408889634f;
            att::chunk_kv_unit(Kr + t0 * 1024 + h * 128, Vr + t0 * 1024 + h * 128, CK + ((size_t)(b * 8 + h) * 32 + n) * 16384, CK + ((size_t)(64 + b * 8 + h) * 32 + n) * 16384, lgf, lgb, ldsg, ldsaddr); }
        __syncthreads();
    }
    SEAMX(3);
    if (IN(4)) {
        WSB(); WSH(Qm, WS_QM); WSH(Kbuf, WS_KB); WSH(Vm, WS_VM); WSH(Oat, WS_OAT); WSH(CK, WS_H); INP(ret_decay, 7);
        for (int u = vcu; u < 1024; u += G) { const int qb = u & 15, h = (u >> 4) & 7, b = u >> 7; const size_t r0 = (size_t)b * SEQ;
            att::attn_unit(Qm + (r0 + qb * 256) * 1536 + h * 192, Kbuf + r0 * 1536 + h * 192, Vm + r0 * 1024 + h * 128, Oat + (r0 + qb * 256) * 1024 + h * 128, SEQ, ldsg, ldsaddr); }
#ifndef NO_SCAN
        for (int idx = bx * 512 + tid; idx < 2 * 64 * 2048; idx += G * 512) { const int dir = idx >> 17, bh = (idx >> 11) & 63, e8 = idx & 2047, h = bh & 7;
            const float cd = __builtin_amdgcn_exp2f(-__expf(ret_decay[dir * 8 + h]) * 1.4426950408889634f * 128.f);
            bf16_t* base = CK + ((size_t)(dir * 64 + bh) * 32) * 16384 + e8 * 8; float st[8];
#pragma unroll
            for (int i = 0; i < 8; ++i) st[i] = 0.f;
            for (int s8 = 0; s8 < 32; s8 += 8) { v4u kv[8];
#pragma unroll
                for (int i = 0; i < 8; ++i) { const int m = dir ? 31 - (s8 + i) : s8 + i; kv[i] = *(const v4u*)(base + (size_t)m * 16384); }
#pragma unroll
                for (int i = 0; i < 8; ++i) { const int m = dir ? 31 - (s8 + i) : s8 + i; v4u o;
                    o.x = pk2a(st[0], st[1]); o.y = pk2a(st[2], st[3]); o.z = pk2a(st[4], st[5]); o.w = pk2a(st[6], st[7]);
                    *(v4u*)(base + (size_t)m * 16384) = o;
#pragma unroll
                    for (int q = 0; q < 4; ++q) { const unsigned w = kv[i][q]; st[2 * q] = st[2 * q] * cd + __uint_as_float(w << 16); st[2 * q + 1] = st[2 * q + 1] * cd + __uint_as_float(w & 0xffff0000u); } } }
        }
#endif
    }
    SEAMX(4);
    if (IN(5)) {
        WSB(); WSH(Qr, WS_QR); WSH(Kr, WS_KR); WSH(Vr, WS_VR); WSH(Gr, WS_GR); WSH(CK, WS_H); WSH(Cat, WS_CAT); WSH(Oat, WS_OAT); INP(ret_decay, 7); INP(ret_gn_w, 8); INP(ret_gn_b, 9); INP(mla_out_w, 14);
#if PROBE_BRUTE_RET
        float* dumpb = (float*)(ws + 704 * MiB);
        for (int up = vcu; up < 1024; up += G) {
            if (PROBE_COMP != 0) { const int u = up * 2 + (wave >> 2); const int n = u & 31, h = (u >> 5) & 7, b = u >> 8; const size_t t0 = (size_t)b * SEQ + n * 128;
                const float lgf = -__expf(ret_decay[h]) * 1.4426950408889634f, lgb = -__expf(ret_decay[8 + h]) * 1.4426950408889634f; const int hf = wave >> 2;
                att::ret_out_unit(Qr + t0 * 1024 + h * 128, Kr + t0 * 1024 + h * 128, Vr + t0 * 1024 + h * 128, Gr + t0 * 1024 + h * 128,
                                  CK + ((size_t)(b * 8 + h) * 32 + n) * 16384, CK + ((size_t)(64 + b * 8 + h) * 32 + n) * 16384, ret_gn_w + h * 128, ret_gn_b + h * 128,
                                  Cat + t0 * 2048 + h * 128, lgf, lgb, ldsg + hf * 65536, ldsaddr + hf * 65536, dumpb + t0 * 1024 + h * 128);
                __threadfence(); __syncthreads(); }
            for (int k2 = 0; k2 < 2; ++k2) { const int u = up * 2 + k2; const int n = u & 31, h = (u >> 5) & 7, b = u >> 8; const size_t r0 = (size_t)b * SEQ, t0 = r0 + n * 128;
                const float lgf = -__expf(ret_decay[h]) * 1.4426950408889634f, lgb = -__expf(ret_decay[8 + h]) * 1.4426950408889634f;
                att::ret_brute_unit(Qr + r0 * 1024 + h * 128, Kr + r0 * 1024 + h * 128, Vr + r0 * 1024 + h * 128, Gr + t0 * 1024 + h * 128, ret_gn_w + h * 128, ret_gn_b + h * 128, Cat + t0 * 2048 + h * 128, n * 128, lgf, lgb, ldsg, dumpb + t0 * 1024 + h * 128); } }
        __syncthreads();
        for (int up = vcu; up < 0; up += G) { const int u = up * 2 + (wave >> 2);
#else
        for (int up = vcu; up < 1024; up += G) { const int u = up * 2 + (wave >> 2);
#endif
            const int n = u & 31, h = (u >> 5) & 7, b = u >> 8; const size_t t0 = (size_t)b * SEQ + n * 128;
            const float lgf = -__expf(ret_decay[h]) * 1.4426950408889634f, lgb = -__expf(ret_decay[8 + h]) * 1.4426950408889634f; const int hf = wave >> 2;
            att::ret_out_unit(Qr + t0 * 1024 + h * 128, Kr + t0 * 1024 + h * 128, Vr + t0 * 1024 + h * 128, Gr + t0 * 1024 + h * 128,
                              CK + ((size_t)(b * 8 + h) * 32 + n) * 16384, CK + ((size_t)(64 + b * 8 + h) * 32 + n) * 16384, ret_gn_w + h * 128, ret_gn_b + h * 128,
                              Cat + t0 * 2048 + h * 128, lgf, lgb, ldsg + hf * 65536, ldsaddr + hf * 65536); }
        for (int m = gw; m < T; m += NGW) {
            const bf16_t* orow = Oat + (size_t)m * 1024; float v[16]; float s = 0.f;
#pragma unroll
            for (int j = 0; j < 2; ++j) { const v4u w = *(const v4u*)(orow + lane * 8 + 512 * j);
#pragma unroll
                for (int q = 0; q < 4; ++q) { v[j * 8 + 2 * q] = __uint_as_float(w[q] << 16); v[j * 8 + 2 * q + 1] = __uint_as_float(w[q] & 0xffff0000u); } }
#pragma unroll
            for (int i = 0; i < 16; ++i) s += v[i] * v[i];
            const float rstd = rsqrtf(wave_sum(s) * (1.f / 1024.f) + 1e-6f);
#pragma unroll
            for (int j = 0; j < 2; ++j) { const int col = lane * 8 + 512 * j; const f32x4 w0 = *(const f32x4*)(mla_out_w + col), w1 = *(const f32x4*)(mla_out_w + col + 4); v4u o;
                o.x = pk2a(v[j * 8 + 0] * rstd * w0.x, v[j * 8 + 1] * rstd * w0.y); o.y = pk2a(v[j * 8 + 2] * rstd * w0.z, v[j * 8 + 3] * rstd * w0.w);
                o.z = pk2a(v[j * 8 + 4] * rstd * w1.x, v[j * 8 + 5] * rstd * w1.y); o.w = pk2a(v[j * 8 + 6] * rstd * w1.z, v[j * 8 + 7] * rstd * w1.w);
                *(v4u*)(Cat + (size_t)m * 2048 + 1024 + col) = o; } }
        __syncthreads();
    }
    SEAMX(5);
    if (IN(6)) {
        WSB(); WSH(Cat, WS_CAT); WSH(Wo, WS_WO); WSF(mod, WS_CTL + OFF_MOD); INP(x, 0);
        pg8::Gemm g{Cat, Wo, T, 2048, 2048}; pg8::StaticOrder S; S.init(T, 2048, G, bx); pg8::EpiGateRes E{x, mod + 2 * DM, out};
        pg8::gemm_phase<pg8::EpiGateRes, pg8::StaticOrder, true, true>(lds3, g, S, E);
    }
    SEAMX(6);
    if (IN(7)) { WSB(); WSF(mod, WS_CTL + OFF_MOD); WSH(H, WS_H); INP(norm2_w, 16);
        for (int m = gw; m < T; m += NGW) { const int b = m >> 12; norm_row(out + (size_t)m * DM, norm2_w, mod + (size_t)b * NMODC + 3 * DM, mod + (size_t)b * NMODC + 4 * DM, H + (size_t)m * DM, nullptr, lane); } }
    SEAMX(7);
    if (IN(8)) {
        WSB(); WSH(H, WS_H); WSH(Wgu, WS_WGU); WSH(Aff, WS_AFF);
        pg8::Gemm g{H, Wgu, T, 2 * DFF, DM}; pg8::StaticOrder S; S.init(T, 2 * DFF, G, bx); pg8::EpiGU E{Aff};
        pg8::gemm_phase<pg8::EpiGU, pg8::StaticOrder, true, true>(lds3, g, S, E);
    }
    SEAMX(8);
    if (IN(9)) {
        WSB(); WSH(Aff, WS_AFF); WSH(Wdn, WS_WDN); WSF(mod, WS_CTL + OFF_MOD);
        pg8::Gemm g{Aff, Wdn, T, 2048, DFF}; pg8::StaticOrder S; S.init(T, 2048, G, bx); pg8::EpiGateRes E{out, mod + 5 * DM, out};
        pg8::gemm_phase<pg8::EpiGateRes, pg8::StaticOrder, true, true>(lds3, g, S, E);
    }
    SEAMX(9);
    if (IN(10)) { WSB(); (void)ws; INP(final_norm_w, 20);
        for (int m = gw; m < T; m += NGW) norm_row(out + (size_t)m * DM, final_norm_w, nullptr, nullptr, nullptr, out + (size_t)m * DM, lane); }
#undef IN
#undef SEAM
}

extern "C" void kernel_launch(void* const* d_in, const int* in_sizes, int n_in, void* d_out, int out_size, void* d_ws, size_t ws_size, hipStream_t stream) {
    static int grid = 0;
    if (grid == 0) {
        if (n_in != 21 || in_sizes[0] != T * DM || out_size != T * DM || ws_size < WS_END) { fprintf(stderr, "kernel_launch: shape/workspace mismatch (n_in %d, ws %zu < %zu)\n", n_in, ws_size, (size_t)WS_END); grid = -1; return; }
        int dev = 0, cus = 0, per_cu = 0;
        (void)hipGetDevice(&dev); (void)hipDeviceGetAttribute(&cus, hipDeviceAttributeMultiprocessorCount, dev);
        if (hipFuncSetAttribute((const void*)mk_fwd, hipFuncAttributeMaxDynamicSharedMemorySize, LDS_BYTES) != hipSuccess) { fprintf(stderr, "kernel_launch: hipFuncSetAttribute failed\n"); grid = -1; return; }
        if (hipOccupancyMaxActiveBlocksPerMultiprocessor(&per_cu, (const void*)mk_fwd, 512, LDS_BYTES) != hipSuccess || per_cu < 1) { fprintf(stderr, "kernel_launch: occupancy query gave %d\n", per_cu); per_cu = 1; }
        (void)hipGetLastError();
        grid = cus * per_cu;
    }
    if (grid < 0) return;
    (void)hipMemsetAsync((char*)d_ws + WS_CTL, 0, CTL_ZERO_BYTES, stream);
    Args a{};
    for (int i = 0; i < 21; ++i) a.in[i] = (const float*)d_in[i];
    a.out = (float*)d_out; a.ws = (unsigned char*)d_ws;
    for (int i = 0; i < 64; ++i) a.inv_r[i] = powf(10000.0f, -((float)(2 * i)) / 128.0f);
    for (int i = 0; i < 32; ++i) a.inv_m[i] = powf(10000.0f, -((float)(2 * i)) / 64.0f);
#if MK_SPLIT
    for (int p = 0; p < NPH; ++p) { a.ph_lo = p; a.ph_hi = p + 1; hipLaunchKernelGGL(mk_fwd, dim3(grid), dim3(512), LDS_BYTES, stream, a); }
#else
    a.ph_lo = 0; a.ph_hi = NPH;
    void* args[] = {&a};
    hipError_t e = hipLaunchCooperativeKernel((const void*)mk_fwd, dim3(grid), dim3(512), args, LDS_BYTES, stream);
    if (e != hipSuccess) fprintf(stderr, "kernel_launch: cooperative launch failed: %s (grid %d)\n", hipGetErrorString(e), grid);
#endif
}
```

```cpp
#include <hip/hip_runtime.h>
#include <hip/hip_cooperative_groups.h>
#include <cstdio>
#include <cstdint>
#include <cmath>
namespace cg = cooperative_groups;
namespace pg8 {
#define PG8_LAS __attribute__((address_space(3)))
typedef unsigned short bf16_t;
typedef short bf16x8 __attribute__((ext_vector_type(8)));
typedef float f32x4 __attribute__((ext_vector_type(4)));
typedef unsigned u32x4 __attribute__((ext_vector_type(4)));
constexpr int BM = 256, BK = 64, HALF = 128, HTB = HALF * BK * 2  , STAGE_BYTES = 8 * HTB, NXCD = 8, WGM = 8;

__host__ __device__ __forceinline__ int lds_byte(int r, int c) { const int st = (r >> 4) * 2 + (c >> 5), rr = r & 15, cc = c & 31, ob = rr * 64 + cc * 2; return st * 1024 + (ob ^ (((ob >> 9) & 1) << 5)); }
__host__ __device__ __forceinline__ void stage_rc(int b, int& R, int& C) { const int st = b / 1024, sb = b % 1024, swz = sb ^ (((sb >> 9) & 1) << 5); R = (st >> 1) * 16 + swz / 64; C = (st & 1) * 32 + (swz % 64) / 2; }
__host__ __device__ __forceinline__ int perm32(int rho) { const int n = rho >> 4, i = rho & 15; return 8 * (i >> 2) + 4 * n + (i & 3); }

struct Unit { int pm, pn; };
struct Gemm { const bf16_t* A; const bf16_t* Bt; int M, N, K; };

struct StaticOrder {
    int nM, nN, nwg, G, c;
    __host__ __device__ void init(int M, int N, int G_, int c_) { nM = M / BM; nN = N / BM; nwg = nM * nN; G = G_; c = c_; }
    __host__ __device__ bool next(int i, Unit& u) const {
        const long L = (long)i * G + c; if (L >= nwg) return false;
        int wgid = (int)L; { const int q = nwg / NXCD, r = nwg % NXCD, xcd = wgid % NXCD, off = wgid / NXCD; wgid = (xcd < r ? xcd * (q + 1) : r * (q + 1) + (xcd - r) * q) + off; }
        const int nig = WGM * nN, gid = wgid / nig, fm = gid * WGM, gsz = (nM - fm) < WGM ? (nM - fm) : WGM;
        u.pm = fm + ((wgid % nig) % gsz); u.pn = (wgid % nig) / gsz; return true;
    }
    __device__ __forceinline__ void a_ready(const Unit&) const {}
    __device__ __forceinline__ void done(const Unit&) const {}
};

#ifndef PROBE_COARSE_ACT
#define PROBE_COARSE_ACT 0
#endif
__device__ __forceinline__ unsigned coarse2(unsigned w) { return PROBE_COARSE_ACT ? ((w + ((w >> 1) & 0x00010001u)) & 0xfffefffeu) : w; }
__device__ __forceinline__ unsigned cvt_pk_bf16(float lo, float hi) { unsigned r; asm volatile("v_cvt_pk_bf16_f32 %0, %1, %2" : "=v"(r) : "v"(lo), "v"(hi)); return coarse2(r); }
typedef float f32x2 __attribute__((ext_vector_type(2)));

typedef unsigned u32x2 __attribute__((ext_vector_type(2)));
__device__ __forceinline__ float silu_f(float v) { return v * __builtin_amdgcn_rcpf(1.f + __builtin_amdgcn_exp2f(v * -1.4426950408889634f)); }
__device__ __forceinline__ u32x4 pack8(f32x4 a, f32x4 b) { u32x4 w; w.x = cvt_pk_bf16(a[0], a[1]); w.y = cvt_pk_bf16(a[2], a[3]); w.z = cvt_pk_bf16(b[0], b[1]); w.w = cvt_pk_bf16(b[2], b[3]); return w; }
__device__ __forceinline__ void rope8(f32x4& a, f32x4& b, const f32x4 c, const f32x4 s) {
    float t1, t2;
    t1 = a[0]; t2 = a[1]; a[0] = t1 * c[0] - t2 * s[0]; a[1] = t2 * c[0] + t1 * s[0];
    t1 = a[2]; t2 = a[3]; a[2] = t1 * c[1] - t2 * s[1]; a[3] = t2 * c[1] + t1 * s[1];
    t1 = b[0]; t2 = b[1]; b[0] = t1 * c[2] - t2 * s[2]; b[1] = t2 * c[2] + t1 * s[2];
    t1 = b[2]; t2 = b[3]; b[2] = t1 * c[3] - t2 * s[3]; b[3] = t2 * c[3] + t1 * s[3];
}
constexpr float NORM_EPS = 1e-6f;

struct EpiIn {
    static constexpr bool PERM = true, AFTER_DRAIN = false;
    bf16_t *Qr, *Kr, *Vr, *Gr, *CQ, *CKV, *Kbuf; const float *cosr, *sinr, *cosm, *sinm; float *ssq_q, *ssq_kv;
    __device__ __forceinline__ void operator()(const f32x4 (&acc)[2][2][4][2], const Unit& u, int wr, int wc, int fr, int fq) const {
        const int pn = u.pn, row0 = u.pm * BM + wr * 64 + fr, cl = wc * 32 + 8 * fq;
        if (pn < 8) {
            bf16_t* O = pn < 4 ? Qr : Kr; const float sc = pn < 4 ? 1.f : 0.08838834764831845f; const int colt = (pn & 3) * 256 + cl;
#pragma unroll
            for (int ai = 0; ai < 2; ++ai)
#pragma unroll
                for (int m = 0; m < 4; ++m) { const int row = row0 + ai * HALF + m * 16;
                    const f32x4 c4 = *(const f32x4*)(cosr + (size_t)row * 64 + (cl >> 1)), s4 = *(const f32x4*)(sinr + (size_t)row * 64 + (cl >> 1));
#pragma unroll
                    for (int bj = 0; bj < 2; ++bj) { f32x4 a = acc[ai][bj][m][0], b = acc[ai][bj][m][1]; rope8(a, b, c4, s4); a = a * sc; b = b * sc;
                        *(u32x4*)(O + (size_t)row * 1024 + colt + bj * HALF) = pack8(a, b); } }
        } else if (pn < 16) {
            const bool isg = pn >= 12; bf16_t* O = isg ? Gr : Vr; const int colt = (pn & 3) * 256 + cl;
#pragma unroll
            for (int ai = 0; ai < 2; ++ai)
#pragma unroll
                for (int m = 0; m < 4; ++m) { const int row = row0 + ai * HALF + m * 16;
#pragma unroll
                    for (int bj = 0; bj < 2; ++bj) { f32x4 a = acc[ai][bj][m][0], b = acc[ai][bj][m][1];
                        if (isg) {
#pragma unroll
                            for (int i = 0; i < 4; ++i) { a[i] = silu_f(a[i]); b[i] = silu_f(b[i]); } }
                        *(u32x4*)(O + (size_t)row * 1024 + colt + bj * HALF) = pack8(a, b); } }
        } else if (pn < 20) {
            bf16_t* O = pn < 18 ? CQ : CKV; float* sq = pn < 18 ? ssq_q : ssq_kv; const int colt = (pn & 1) * 256 + cl;
#pragma unroll
            for (int ai = 0; ai < 2; ++ai)
#pragma unroll
                for (int m = 0; m < 4; ++m) { const int row = row0 + ai * HALF + m * 16; float s = 0.f;
#pragma unroll
                    for (int bj = 0; bj < 2; ++bj) { const f32x4 a = acc[ai][bj][m][0], b = acc[ai][bj][m][1];
                        s += (a[0] * a[0] + a[1] * a[1]) + (a[2] * a[2] + a[3] * a[3]) + (b[0] * b[0] + b[1] * b[1]) + (b[2] * b[2] + b[3] * b[3]);
                        *(u32x4*)(O + (size_t)row * 512 + colt + bj * HALF) = pack8(a, b); }
                    s += __shfl_xor(s, 16); s += __shfl_xor(s, 32);
                    if (fq == 0) atomicAdd(sq + row, s); }
        } else {
            if (wc < 2) {
#pragma unroll
                for (int ai = 0; ai < 2; ++ai)
#pragma unroll
                    for (int m = 0; m < 4; ++m) { const int row = row0 + ai * HALF + m * 16;
                        const f32x4 c4 = *(const f32x4*)(cosm + (size_t)row * 32 + (cl >> 1)), s4 = *(const f32x4*)(sinm + (size_t)row * 32 + (cl >> 1));
                        f32x4 a = acc[ai][0][m][0], b = acc[ai][0][m][1]; rope8(a, b, c4, s4); const u32x4 w = pack8(a, b);
#pragma unroll
                        for (int h = 0; h < 8; ++h) *(u32x4*)(Kbuf + (size_t)row * 1536 + h * 192 + 128 + cl) = w; }
            }
        }
    }
};
struct EpiUpQ {
    static constexpr bool PERM = true, AFTER_DRAIN = false;
    const float* ssq; bf16_t* Qm; const float *cosm, *sinm;
    __device__ __forceinline__ void operator()(const f32x4 (&acc)[2][2][4][2], const Unit& u, int wr, int wc, int fr, int fq) const {
        const int row0 = u.pm * BM + wr * 64 + fr, cl = wc * 32 + 8 * fq;
#pragma unroll
        for (int ai = 0; ai < 2; ++ai)
#pragma unroll
            for (int m = 0; m < 4; ++m) { const int row = row0 + ai * HALF + m * 16; const float rstd = rsqrtf(ssq[row] * (1.f / 512.f) + NORM_EPS);
#pragma unroll
                for (int bj = 0; bj < 2; ++bj) { const int c = u.pn * 256 + bj * HALF + cl, d = c % 192; f32x4 a = acc[ai][bj][m][0] * rstd, b = acc[ai][bj][m][1] * rstd;
                    if (d >= 128) { const int fi = (d - 128) >> 1; const f32x4 c4 = *(const f32x4*)(cosm + (size_t)row * 32 + fi), s4 = *(const f32x4*)(sinm + (size_t)row * 32 + fi); rope8(a, b, c4, s4); }
                    *(u32x4*)(Qm + (size_t)row * 1536 + c) = pack8(a, b); } }
    }
};
struct EpiUpKV {
    static constexpr bool PERM = true, AFTER_DRAIN = false;
    const float* ssq; bf16_t *Kbuf, *Vm;
    __device__ __forceinline__ void operator()(const f32x4 (&acc)[2][2][4][2], const Unit& u, int wr, int wc, int fr, int fq) const {
        const int row0 = u.pm * BM + wr * 64 + fr, cl = wc * 32 + 8 * fq;
#pragma unroll
        for (int ai = 0; ai < 2; ++ai)
#pragma unroll
            for (int m = 0; m < 4; ++m) { const int row = row0 + ai * HALF + m * 16; const float rstd = rsqrtf(ssq[row] * (1.f / 512.f) + NORM_EPS);
                *(u32x4*)(Kbuf + (size_t)row * 1536 + u.pn * 192 + cl) = pack8(acc[ai][0][m][0] * rstd, acc[ai][0][m][1] * rstd);
                *(u32x4*)(Vm + (size_t)row * 1024 + u.pn * 128 + cl) = pack8(acc[ai][1][m][0] * rstd, acc[ai][1][m][1] * rstd); }
    }
};
struct EpiGateRes {
    static constexpr bool PERM = true, AFTER_DRAIN = false;
    const float* x; const float* gate; float* out;
    __device__ __forceinline__ void operator()(const f32x4 (&acc)[2][2][4][2], const Unit& u, int wr, int wc, int fr, int fq) const {
        const int row0 = u.pm * BM + wr * 64 + fr, cl = wc * 32 + 8 * fq, b = u.pm >> 4;
#pragma unroll
        for (int bj = 0; bj < 2; ++bj) { const int c = u.pn * 256 + bj * HALF + cl;
            const f32x4 g0 = *(const f32x4*)(gate + (size_t)b * 12288 + c), g1 = *(const f32x4*)(gate + (size_t)b * 12288 + c + 4);
#pragma unroll
            for (int ai = 0; ai < 2; ++ai)
#pragma unroll
                for (int m = 0; m < 4; ++m) { const size_t off = (size_t)(row0 + ai * HALF + m * 16) * 2048 + c;
                    const f32x4 x0 = *(const f32x4*)(x + off), x1 = *(const f32x4*)(x + off + 4);
                    *(f32x4*)(out + off) = x0 + g0 * acc[ai][bj][m][0]; *(f32x4*)(out + off + 4) = x1 + g1 * acc[ai][bj][m][1]; } }
    }
};
struct EpiGU {
    static constexpr bool PERM = true, AFTER_DRAIN = false;
    bf16_t* Aff;
    __device__ __forceinline__ void operator()(const f32x4 (&acc)[2][2][4][2], const Unit& u, int wr, int wc, int fr, int fq) const {
        const int row0 = u.pm * BM + wr * 64 + fr, cl = wc * 32 + 8 * fq;
#pragma unroll
        for (int ai = 0; ai < 2; ++ai)
#pragma unroll
            for (int m = 0; m < 4; ++m) { const int row = row0 + ai * HALF + m * 16; f32x4 a, b;
#pragma unroll
                for (int i = 0; i < 4; ++i) { a[i] = silu_f(acc[ai][0][m][0][i]) * acc[ai][1][m][0][i]; b[i] = silu_f(acc[ai][0][m][1][i]) * acc[ai][1][m][1][i]; }
                *(u32x4*)(Aff + (size_t)row * 5632 + u.pn * 128 + cl) = pack8(a, b); }
    }
};

template <class Epi, class Sched, bool ALIGN_EPI = false, bool SP2 = false>
__device__ __forceinline__ void gemm_phase(PG8_LAS unsigned char* lds, const Gemm g, const Sched& S, const Epi& E) {
    const int tid = threadIdx.x, wid = __builtin_amdgcn_readfirstlane(tid >> 6), lane = tid & 63, wr = wid >> 2, wc = wid & 3, fr = lane & 15, fq = lane >> 4;
    const int K = g.K, nt = K / BK;
    unsigned voffA[2], voffB[2];
#pragma unroll
    for (int i = 0; i < 2; ++i) { int R, C; stage_rc(tid * 16 + i * 8192, R, C); const int Rb = Epi::PERM ? ((R & ~31) + perm32(R & 31)) : R;
        voffA[i] = (unsigned)(R * K + C) * 2u; voffB[i] = (unsigned)(Rb * K + C) * 2u; }
    const size_t kstep = (size_t)(BK * 2);
    const size_t hstep = (size_t)HALF * K * 2;
    const size_t tstep = 2 * hstep;
    const unsigned ldsw = (unsigned)wid * 1024u;
    const int aoff = lds_byte(wr * 64 + fr, fq * 8), boff = lds_byte(wc * 32 + fr, fq * 8);
#define PG8_SA(b, h) (((b) * 2 + (h)) * HTB)
#define PG8_SB(b, h) ((4 + (b) * 2 + (h)) * HTB)
#define PG8_STAGE(bufoff, gbase, voff) do { _Pragma("unroll") for (int _i = 0; _i < 2; ++_i) \
        __builtin_amdgcn_global_load_lds((const unsigned*)((const char*)(gbase) + (voff)[_i]), (PG8_LAS unsigned*)(lds + (bufoff) + ldsw + _i * 8192), 16, 0, 0); } while (0)
#define PG8_LDA(dst, b, h) do { _Pragma("unroll") for (int m = 0; m < 4; ++m) _Pragma("unroll") for (int k = 0; k < 2; ++k) dst[m][k] = *(const PG8_LAS bf16x8*)(lds + PG8_SA(b, h) + aoff + m * 2048 + k * 1024); } while (0)
#define PG8_LDB(dst, b, h) do { _Pragma("unroll") for (int n = 0; n < 2; ++n) _Pragma("unroll") for (int k = 0; k < 2; ++k) dst[n][k] = *(const PG8_LAS bf16x8*)(lds + PG8_SB(b, h) + boff + n * 2048 + k * 1024); } while (0)
#define PG8_MMA(ai, bj, At, Bt) do { __builtin_amdgcn_s_setprio(1); _Pragma("unroll") for (int m = 0; m < 4; ++m) _Pragma("unroll") for (int n = 0; n < 2; ++n) _Pragma("unroll") for (int k = 0; k < 2; ++k) \
        acc[ai][bj][m][n] = __builtin_amdgcn_mfma_f32_16x16x32_bf16(Bt[n][k], At[m][k], acc[ai][bj][m][n], 0, 0, 0); __builtin_amdgcn_s_setprio(0); } while (0)
#define PG8_WAIT_V(n) asm volatile("s_waitcnt vmcnt(" #n ")" ::: "memory")
#define PG8_WAIT_L(n) asm volatile("s_waitcnt lgkmcnt(" #n ")" ::: "memory")
#define PG8_BAR __builtin_amdgcn_s_barrier()
#define PG8_SCHED __builtin_amdgcn_sched_barrier(0)
    Unit cur, nxt; int ui = 0;
    if (!S.next(0, cur)) return;
    f32x4 acc[2][2][4][2];
#pragma unroll
    for (int a = 0; a < 2; ++a)
#pragma unroll
        for (int b = 0; b < 2; ++b)
#pragma unroll
            for (int m = 0; m < 4; ++m)
#pragma unroll
                for (int n = 0; n < 2; ++n) acc[a][b][m][n] = (f32x4){0.f, 0.f, 0.f, 0.f};
    bf16x8 At[4][2], B0[2][2], B1[2][2];
    const char* cA = (const char*)g.A + (size_t)cur.pm * tstep; const char* cB = (const char*)g.Bt + (size_t)cur.pn * tstep;
    S.a_ready(cur);
    if constexpr (SP2) {
        PG8_STAGE(PG8_SB(0, 0), cB, voffB); PG8_STAGE(PG8_SB(0, 1), cB + hstep, voffB); PG8_STAGE(PG8_SA(0, 0), cA, voffA); PG8_STAGE(PG8_SA(0, 1), cA + hstep, voffA);
        if (wr == 1) PG8_BAR;
        PG8_WAIT_V(2); PG8_BAR;
        PG8_STAGE(PG8_SB(1, 0), cB + kstep, voffB); PG8_STAGE(PG8_SA(1, 0), cA + kstep, voffA); PG8_STAGE(PG8_SB(1, 1), cB + hstep + kstep, voffB);
        PG8_WAIT_V(6); PG8_BAR;
    } else {
        PG8_STAGE(PG8_SB(0, 0), cB, voffB); PG8_STAGE(PG8_SA(0, 0), cA, voffA); PG8_STAGE(PG8_SB(0, 1), cB + hstep, voffB); PG8_STAGE(PG8_SA(0, 1), cA + hstep, voffA);
        if (wr == 1) PG8_BAR;
        PG8_WAIT_V(4); PG8_BAR;
        PG8_STAGE(PG8_SB(1, 0), cB + kstep, voffB); PG8_STAGE(PG8_SA(1, 0), cA + kstep, voffA); PG8_STAGE(PG8_SB(1, 1), cB + hstep + kstep, voffB);
        PG8_WAIT_V(6); PG8_BAR;
    }
    for (;;) {
        const bool has_next = S.next(ui + 1, nxt);
        const char* nA = has_next ? (const char*)g.A + (size_t)nxt.pm * tstep : cA; const char* nB = has_next ? (const char*)g.Bt + (size_t)nxt.pn * tstep : cB;
        for (int t = 0; t < nt; t += 2) {
            const bool last = (t == nt - 2);
            const char* a1 = cA + (size_t)(t + 1) * kstep;
            const char* a2 = last ? nA : cA + (size_t)(t + 2) * kstep; const char* b2 = last ? nB : cB + (size_t)(t + 2) * kstep;
            const char* a3 = a2 + kstep; const char* b3 = b2 + kstep;
            if (last && has_next) S.a_ready(nxt);
            if constexpr (SP2) {
            PG8_LDB(B0, 0, 0); PG8_LDB(B1, 0, 1); PG8_SCHED; PG8_LDA(At, 0, 0); PG8_STAGE(PG8_SA(1, 1), a1 + hstep, voffA);
            PG8_WAIT_V(8); PG8_WAIT_L(0); PG8_BAR; PG8_MMA(0, 0, At, B0); PG8_MMA(0, 1, At, B1); PG8_BAR; PG8_SCHED;
            PG8_LDA(At, 0, 1); PG8_STAGE(PG8_SB(0, 0), b2, voffB); PG8_STAGE(PG8_SB(0, 1), b2 + hstep, voffB); PG8_STAGE(PG8_SA(0, 0), a2, voffA);
            PG8_WAIT_V(8); PG8_WAIT_L(0); PG8_BAR; PG8_MMA(1, 0, At, B0); PG8_MMA(1, 1, At, B1); PG8_BAR; PG8_SCHED;
            PG8_LDB(B0, 1, 0); PG8_LDB(B1, 1, 1); PG8_SCHED; PG8_LDA(At, 1, 0); PG8_STAGE(PG8_SA(0, 1), a2 + hstep, voffA);
            PG8_WAIT_V(8); PG8_WAIT_L(0); PG8_BAR; PG8_MMA(0, 0, At, B0); PG8_MMA(0, 1, At, B1); PG8_BAR; PG8_SCHED;
            PG8_LDA(At, 1, 1); PG8_STAGE(PG8_SB(1, 0), b3, voffB); PG8_STAGE(PG8_SB(1, 1), b3 + hstep, voffB); PG8_STAGE(PG8_SA(1, 0), a3, voffA);
            PG8_WAIT_V(8); PG8_WAIT_L(0); PG8_BAR; PG8_MMA(1, 0, At, B0); PG8_MMA(1, 1, At, B1); PG8_BAR; PG8_SCHED;
            } else {
            PG8_LDB(B0, 0, 0); PG8_SCHED; PG8_LDA(At, 0, 0); PG8_STAGE(PG8_SA(1, 1), a1 + hstep, voffA);
            PG8_WAIT_L(8); PG8_BAR; PG8_WAIT_L(0); PG8_MMA(0, 0, At, B0); PG8_BAR; PG8_SCHED;
            PG8_LDB(B1, 0, 1); PG8_STAGE(PG8_SB(0, 0), b2, voffB);
            PG8_BAR; PG8_WAIT_L(0); PG8_MMA(0, 1, At, B1); PG8_BAR;
            PG8_LDA(At, 0, 1); PG8_STAGE(PG8_SA(0, 0), a2, voffA);
            PG8_BAR; PG8_WAIT_L(0); PG8_MMA(1, 0, At, B0); PG8_BAR; PG8_SCHED;
            PG8_STAGE(PG8_SB(0, 1), b2 + hstep, voffB);
            PG8_WAIT_V(6); PG8_BAR; PG8_MMA(1, 1, At, B1); PG8_BAR;
            PG8_LDB(B0, 1, 0); PG8_SCHED; PG8_LDA(At, 1, 0); PG8_STAGE(PG8_SA(0, 1), a2 + hstep, voffA);
            PG8_WAIT_L(8); PG8_BAR; PG8_WAIT_L(0); PG8_MMA(0, 0, At, B0); PG8_BAR; PG8_SCHED;
            PG8_LDB(B1, 1, 1); PG8_STAGE(PG8_SB(1, 0), b3, voffB);
            PG8_BAR; PG8_WAIT_L(0); PG8_MMA(0, 1, At, B1); PG8_BAR;
            PG8_LDA(At, 1, 1); PG8_STAGE(PG8_SA(1, 0), a3, voffA);
            PG8_BAR; PG8_WAIT_L(0); PG8_MMA(1, 0, At, B0); PG8_BAR; PG8_SCHED;
            PG8_STAGE(PG8_SB(1, 1), b3 + hstep, voffB);
            PG8_WAIT_V(6); PG8_BAR; PG8_MMA(1, 1, At, B1); PG8_BAR;
            }
        }
        if constexpr (ALIGN_EPI) { if (wr == 0) PG8_BAR; }
        if constexpr (!Epi::AFTER_DRAIN) { E(acc, cur, wr, wc, fr, fq); S.done(cur); }
        if (!has_next) break;
#pragma unroll
        for (int a = 0; a < 2; ++a)
#pragma unroll
            for (int b = 0; b < 2; ++b)
#pragma unroll
                for (int m = 0; m < 4; ++m)
#pragma unroll
                    for (int n = 0; n < 2; ++n) acc[a][b][m][n] = (f32x4){0.f, 0.f, 0.f, 0.f};
        cur = nxt; cA = nA; cB = nB; ++ui;
        if constexpr (ALIGN_EPI) { if (wr == 1) PG8_BAR; }
    }
    PG8_WAIT_V(0);
    if constexpr (!ALIGN_EPI) { if (wr == 0) PG8_BAR; }
    PG8_BAR;
    if constexpr (Epi::AFTER_DRAIN) { E.fused(acc, cur, wr, wc, fr, fq, lds, wid, lane); S.done(cur); }
#undef PG8_SA
#undef PG8_SB
#undef PG8_STAGE
#undef PG8_LDA
#undef PG8_LDB
#undef PG8_MMA
#undef PG8_WAIT_V
#undef PG8_WAIT_L
#undef PG8_BAR
#undef PG8_SCHED
}
}

namespace att {
typedef unsigned short bf16_t;
using bf16x8 = __attribute__((ext_vector_type(8))) short;
using s16x4  = __attribute__((ext_vector_type(4))) short;
using f32x16 = __attribute__((ext_vector_type(16))) float;
using f32x4  = __attribute__((ext_vector_type(4))) float;
using u32x4  = __attribute__((ext_vector_type(4))) unsigned;
using u32x2  = __attribute__((ext_vector_type(2))) unsigned;
constexpr int NW = 8, QBLK = 32, KVBLK = 64;
constexpr int LDQ = 1536, LDK = 1536, LDV = 1024, LDO = 1024;
constexpr float SCALE = 0.07216878364870323f;
constexpr float THR = 8.f;
constexpr int NQR = 8;
constexpr int SHM_V = KVBLK * 128 * 2, SHM_K = KVBLK * 192 * 2, SHM_ATTN = 2 * SHM_V + 2 * SHM_K + NW * 64 * 4;
#define AKSWZ(row, colB) ((row) * 384 + ((colB) ^ (((((row) >> 1) & 3) | (((row) >> 2) & 4)) << 4)))
#define KSWZ128(row, colB) ((row) * 256 + ((colB) ^ (((row) & 7) << 4)))
#define SBAR() __builtin_amdgcn_sched_barrier(0)
#define GAS __attribute__((address_space(1)))
__device__ __forceinline__ const GAS char* uniform_ptr(const void* p) { const unsigned long long v = (unsigned long long)p; const unsigned lo = __builtin_amdgcn_readfirstlane((unsigned)v), hi = __builtin_amdgcn_readfirstlane((unsigned)(v >> 32)); return (const GAS char*)(((unsigned long long)hi << 32) | lo); }
__device__ __forceinline__ int crow(int r, int hi) { return (r & 3) + 8 * (r >> 2) + 4 * hi; }
__device__ __forceinline__ unsigned cvtpk(float lo, float hi) { unsigned r; asm volatile("v_cvt_pk_bf16_f32 %0, %1, %2" : "=v"(r) : "v"(lo), "v"(hi)); return pg8::coarse2(r); }
__device__ __forceinline__ float swap_sum(float v) { auto rr = __builtin_amdgcn_permlane32_swap(__float_as_uint(v), __float_as_uint(v), false, false); return __uint_as_float(rr[0]) + __uint_as_float(rr[1]); }

__device__ __forceinline__ void partialSM(f32x16& p0, f32x16& p1, float& m_reg, float& mn, float& alpha) {
  constexpr float C = SCALE * 1.4426950408889634f;
  float pmax = p0[0];
#pragma unroll
  for (int r = 1; r < 16; ++r) pmax = fmaxf(pmax, p0[r]);
#pragma unroll
  for (int r = 0; r < 16; ++r) pmax = fmaxf(pmax, p1[r]);
  { auto rr = __builtin_amdgcn_permlane32_swap(__float_as_uint(pmax), __float_as_uint(pmax), false, false);
    pmax = fmaxf(__uint_as_float(rr[0]), __uint_as_float(rr[1])); }
  if (__builtin_expect(__all(pmax - m_reg <= THR / SCALE), 1)) { mn = m_reg; alpha = 1.f; }
  else { mn = fmaxf(m_reg, pmax); alpha = __builtin_amdgcn_exp2f((m_reg - mn) * C); m_reg = mn; }
  float mnC = -mn * C;
#pragma unroll
  for (int r = 0; r < 16; ++r) p0[r] = fmaf(p0[r], C, mnC);
#pragma unroll
  for (int r = 0; r < 16; ++r) p1[r] = fmaf(p1[r], C, mnC);
#pragma unroll
  for (int r = 0; r < 16; ++r) p0[r] = __builtin_amdgcn_exp2f(p0[r]);
}
#define PK4(P, BASE, OUT) do { unsigned a0 = cvtpk(P[BASE + 0], P[BASE + 1]), a1 = cvtpk(P[BASE + 2], P[BASE + 3]);   \
    unsigned b0 = cvtpk(P[BASE + 4], P[BASE + 5]), b1 = cvtpk(P[BASE + 6], P[BASE + 7]);                              \
    auto r0 = __builtin_amdgcn_permlane32_swap(a0, b0, false, false); auto r1 = __builtin_amdgcn_permlane32_swap(a1, b1, false, false); \
    u32x4 w = {r0[0], r1[0], r0[1], r1[1]}; OUT = *reinterpret_cast<bf16x8*>(&w); } while (0)
__device__ __forceinline__ void finishSM(f32x16& p0, f32x16& p1, float alpha, float& l_reg, bf16x8& pa0, bf16x8& pa1, bf16x8& pa2, bf16x8& pa3) {
#pragma unroll
  for (int r = 0; r < 16; ++r) p1[r] = __builtin_amdgcn_exp2f(p1[r]);
  float ps = 0;
#pragma unroll
  for (int r = 0; r < 16; ++r) ps += p0[r];
#pragma unroll
  for (int r = 0; r < 16; ++r) ps += p1[r];
  ps = swap_sum(ps);
  l_reg = l_reg * alpha + ps;
  PK4(p0, 0, pa0); PK4(p0, 8, pa1); PK4(p1, 0, pa2); PK4(p1, 8, pa3);
}
__device__ __forceinline__ void qkt192(f32x16& p0, f32x16& p1, const char* Ks, const bf16x8 (&qr)[NQR], const char* Qs, int r32, int hi) {
  p0 = f32x16{}; p1 = f32x16{};
  __builtin_amdgcn_s_setprio(1);
#pragma unroll
  for (int d0 = 0; d0 < 12; ++d0) { int cb = (d0 * 16 + hi * 8) * 2;
    bf16x8 b0 = *reinterpret_cast<const bf16x8*>(Ks + AKSWZ(r32, cb));
    bf16x8 b1 = *reinterpret_cast<const bf16x8*>(Ks + AKSWZ(32 + r32, cb));
    bf16x8 qv; if (d0 < NQR) qv = qr[d0 < NQR ? d0 : 0]; else qv = *reinterpret_cast<const bf16x8*>(Qs + (d0 - NQR) * 1024);
    p0 = __builtin_amdgcn_mfma_f32_32x32x16_bf16(b0, qv, p0, 0, 0, 0);
    p1 = __builtin_amdgcn_mfma_f32_32x32x16_bf16(b1, qv, p1, 0, 0, 0); }
  __builtin_amdgcn_s_setprio(0);
}
__device__ __forceinline__ void qkt128(f32x16& p0, f32x16& p1, const char* Ks, const bf16x8 (&qr)[8], int r32, int hi) {
  p0 = f32x16{}; p1 = f32x16{};
#pragma unroll
  for (int d0 = 0; d0 < 8; ++d0) { int cb = (d0 * 16 + hi * 8) * 2;
    bf16x8 b0 = *reinterpret_cast<const bf16x8*>(Ks + KSWZ128(r32, cb));
    bf16x8 b1 = *reinterpret_cast<const bf16x8*>(Ks + KSWZ128(32 + r32, cb));
    p0 = __builtin_amdgcn_mfma_f32_32x32x16_bf16(b0, qr[d0], p0, 0, 0, 0);
    p1 = __builtin_amdgcn_mfma_f32_32x32x16_bf16(b1, qr[d0], p1, 0, 0, 0); }
}
__device__ __forceinline__ int v_st(int k, int c) { const int kk = (k & ~0xC) | ((k & 4) << 1) | ((k & 8) >> 1); return ((kk >> 3) * 4 + (c >> 5)) * 512 + ((kk & 7) * 32 + (c & 31)) * 2; }
__device__ __forceinline__ int v_rd_base(int lane) { return ((lane & 3) << 3) | (((lane >> 2) & 3) << 6) | (((lane >> 4) & 1) << 5) | (((lane >> 5) & 1) << 8); }
constexpr int v_rd_off(int d0, int ks, int half) { return d0 * 512 + ks * 4096 + half * 2048; }
template <int OFF> __device__ __forceinline__ s16x4 tr_read(int vb) {
  s16x4 r; asm volatile("ds_read_b64_tr_b16 %0, %1 offset:%2" : "=&v"(r) : "v"(vb), "i"(OFF) : "memory"); return r;
}
#define PKLH(L, H) (bf16x8){L[0], L[1], L[2], L[3], H[0], H[1], H[2], H[3]}
template <int D0> __device__ __forceinline__ void pv_one(f32x16& od, int vb, bf16x8 pa0, bf16x8 pa1, bf16x8 pa2, bf16x8 pa3) {
  const s16x4 l0 = tr_read<v_rd_off(D0, 0, 0)>(vb), h0 = tr_read<v_rd_off(D0, 0, 1)>(vb), l1 = tr_read<v_rd_off(D0, 1, 0)>(vb), h1 = tr_read<v_rd_off(D0, 1, 1)>(vb);
  const s16x4 l2 = tr_read<v_rd_off(D0, 2, 0)>(vb), h2 = tr_read<v_rd_off(D0, 2, 1)>(vb), l3 = tr_read<v_rd_off(D0, 3, 0)>(vb), h3 = tr_read<v_rd_off(D0, 3, 1)>(vb);
  asm volatile("s_waitcnt lgkmcnt(0)" ::: "memory"); SBAR();
  __builtin_amdgcn_s_setprio(1);
  od = __builtin_amdgcn_mfma_f32_32x32x16_bf16(pa0, PKLH(l0, h0), od, 0, 0, 0);
  od = __builtin_amdgcn_mfma_f32_32x32x16_bf16(pa1, PKLH(l1, h1), od, 0, 0, 0);
  od = __builtin_amdgcn_mfma_f32_32x32x16_bf16(pa2, PKLH(l2, h2), od, 0, 0, 0);
  od = __builtin_amdgcn_mfma_f32_32x32x16_bf16(pa3, PKLH(l3, h3), od, 0, 0, 0);
  __builtin_amdgcn_s_setprio(0);
}
__device__ __forceinline__ void pv_d0(f32x16* o, int vb, bf16x8 pa0, bf16x8 pa1, bf16x8 pa2, bf16x8 pa3) {
  pv_one<0>(o[0], vb, pa0, pa1, pa2, pa3); pv_one<1>(o[1], vb, pa0, pa1, pa2, pa3); pv_one<2>(o[2], vb, pa0, pa1, pa2, pa3); pv_one<3>(o[3], vb, pa0, pa1, pa2, pa3);
}
template <int D0> __device__ __forceinline__ void pvT_one(f32x16& od, int vb, bf16x8 pa0, bf16x8 pa1, bf16x8 pa2, bf16x8 pa3) {
  const s16x4 l0 = tr_read<v_rd_off(D0, 0, 0)>(vb), h0 = tr_read<v_rd_off(D0, 0, 1)>(vb), l1 = tr_read<v_rd_off(D0, 1, 0)>(vb), h1 = tr_read<v_rd_off(D0, 1, 1)>(vb);
  const s16x4 l2 = tr_read<v_rd_off(D0, 2, 0)>(vb), h2 = tr_read<v_rd_off(D0, 2, 1)>(vb), l3 = tr_read<v_rd_off(D0, 3, 0)>(vb), h3 = tr_read<v_rd_off(D0, 3, 1)>(vb);
  asm volatile("s_waitcnt lgkmcnt(0)" ::: "memory"); SBAR();
  od = __builtin_amdgcn_mfma_f32_32x32x16_bf16(PKLH(l0, h0), pa0, od, 0, 0, 0);
  od = __builtin_amdgcn_mfma_f32_32x32x16_bf16(PKLH(l1, h1), pa1, od, 0, 0, 0);
  od = __builtin_amdgcn_mfma_f32_32x32x16_bf16(PKLH(l2, h2), pa2, od, 0, 0, 0);
  od = __builtin_amdgcn_mfma_f32_32x32x16_bf16(PKLH(l3, h3), pa3, od, 0, 0, 0);
}

__device__ __forceinline__ void attn_unit(const bf16_t* __restrict__ Qb, const bf16_t* __restrict__ Kh, const bf16_t* __restrict__ Vh, bf16_t* __restrict__ Ob, int seq, char* lds, int ldsaddr) {
  const int tid = threadIdx.x, wid = tid >> 6, lane = tid & 63, r32 = lane & 31, hi = lane >> 5;
  char* V_lds = lds; char* K_lds = lds + 2 * SHM_V;
  float* ws = (float*)(lds + 2 * SHM_V + 2 * SHM_K) + wid * 64; float* li_l = ws; float* al_l = ws + 32;
  float m_reg = -1e30f, l_reg = 0; f32x16 o[4] = {}; bf16x8 qr[NQR];
  const bf16_t* Qw = Qb + (long)(wid * QBLK + r32) * LDQ + hi * 8;
  char* Qs = lds + SHM_ATTN + wid * ((12 - NQR) * 1024) + lane * 16;
#pragma unroll
  for (int d0 = 0; d0 < NQR; ++d0) qr[d0] = *reinterpret_cast<const bf16x8*>(Qw + d0 * 16);
#pragma unroll
  for (int d0 = NQR; d0 < 12; ++d0) *(bf16x8*)(Qs + (d0 - NQR) * 1024) = *reinterpret_cast<const bf16x8*>(Qw + d0 * 16);
  const int sr = tid >> 4, sc = (tid & 15) * 8, vst0 = v_st(sr, sc), vst1 = v_st(32 + sr, sc);
  unsigned kg0, kg1, kg2; int kl0, kl1, kl2;
  { int p = tid;        int kr = p / 24, kc = (p % 24) * 8; kg0 = (unsigned)(kr * LDK + kc) * 2u; kl0 = AKSWZ(kr, kc * 2);
    p = tid + 512;      kr = p / 24; kc = (p % 24) * 8;     kg1 = (unsigned)(kr * LDK + kc) * 2u; kl1 = AKSWZ(kr, kc * 2);
    p = tid + 1024;     kr = p / 24; kc = (p % 24) * 8;     kg2 = (unsigned)(kr * LDK + kc) * 2u; kl2 = AKSWZ(kr, kc * 2); }
  const unsigned vg0 = (unsigned)(sr * LDV + sc) * 2u, vg1 = (unsigned)((32 + sr) * LDV + sc) * 2u;
  const int vb0 = ldsaddr + v_rd_base(lane);
  bf16x8 vs0, vs1, ks0, ks1, ks2;
#define SLOAD(k0) do { const GAS char* vb_ = uniform_ptr((const char*)Vh + (size_t)(k0) * (LDV * 2)); const GAS char* kb_ = uniform_ptr((const char*)Kh + (size_t)(k0) * (LDK * 2)); \
    vs0 = *(const GAS bf16x8*)(vb_ + vg0); vs1 = *(const GAS bf16x8*)(vb_ + vg1); \
    ks0 = *(const GAS bf16x8*)(kb_ + kg0); ks1 = *(const GAS bf16x8*)(kb_ + kg1); ks2 = *(const GAS bf16x8*)(kb_ + kg2); } while (0)
#define SWRITE(b) do { *(bf16x8*)(V_lds + (b) * SHM_V + vst0) = vs0; *(bf16x8*)(V_lds + (b) * SHM_V + vst1) = vs1; \
    *(bf16x8*)(K_lds + (b) * SHM_K + kl0) = ks0; *(bf16x8*)(K_lds + (b) * SHM_K + kl1) = ks1; *(bf16x8*)(K_lds + (b) * SHM_K + kl2) = ks2; } while (0)
#define SWAIT() asm volatile("s_waitcnt vmcnt(0)" ::: "memory")
#define RESC(a) do { if (__any((a) < 1.f)) { if (hi == 0) al_l[r32] = (a); asm volatile("s_waitcnt lgkmcnt(0)" ::: "memory"); \
    _Pragma("unroll") for (int d = 0; d < 4; ++d) _Pragma("unroll") for (int r = 0; r < 16; ++r) o[d][r] *= al_l[crow(r, hi)]; } } while (0)
  f32x16 pA0, pA1, pB0, pB1; float mnA, mnB, alA, alB; bf16x8 pa0, pa1, pa2, pa3; const int NT = seq / KVBLK;
  __syncthreads();
  SLOAD(0); SWAIT(); SWRITE(0); __syncthreads();
  qkt192(pA0, pA1, K_lds, qr, Qs, r32, hi); partialSM(pA0, pA1, m_reg, mnA, alA);
  SLOAD(KVBLK);
  SWAIT(); SWRITE(1); __syncthreads();
  for (int j = 1; j + 1 < NT; j += 2) {
    SBAR(); qkt192(pB0, pB1, K_lds + SHM_K, qr, Qs, r32, hi);
    finishSM(pA0, pA1, alA, l_reg, pa0, pa1, pa2, pa3); SBAR();
    SLOAD((j + 1) * KVBLK); SBAR();
    pv_d0(o, vb0, pa0, pa1, pa2, pa3); partialSM(pB0, pB1, m_reg, mnB, alB);
    __syncthreads(); SWAIT(); SWRITE(0);
    RESC(alB); __syncthreads();
    SBAR(); qkt192(pA0, pA1, K_lds, qr, Qs, r32, hi);
    finishSM(pB0, pB1, alB, l_reg, pa0, pa1, pa2, pa3); SBAR();
    SLOAD((j + 2) * KVBLK); SBAR();
    pv_d0(o, vb0 + SHM_V, pa0, pa1, pa2, pa3); partialSM(pA0, pA1, m_reg, mnA, alA);
    __syncthreads(); SWAIT(); SWRITE(1);
    RESC(alA); __syncthreads();
  }
  SBAR(); qkt192(pB0, pB1, K_lds + SHM_K, qr, Qs, r32, hi);
  finishSM(pA0, pA1, alA, l_reg, pa0, pa1, pa2, pa3); SBAR();
  pv_d0(o, vb0, pa0, pa1, pa2, pa3); partialSM(pB0, pB1, m_reg, mnB, alB);
  __syncthreads(); RESC(alB);
  finishSM(pB0, pB1, alB, l_reg, pa0, pa1, pa2, pa3); SBAR();
  pv_d0(o, vb0 + SHM_V, pa0, pa1, pa2, pa3);
  if (hi == 0) li_l[r32] = l_reg; asm volatile("s_waitcnt lgkmcnt(0)" ::: "memory");
  float rli[16];
#pragma unroll
  for (int r = 0; r < 16; ++r) rli[r] = __builtin_amdgcn_rcpf(li_l[crow(r, hi)]);
  bf16_t* Ow = Ob + (long)(wid * QBLK) * LDO;
#pragma unroll
  for (int r = 0; r < 16; ++r) { int orow = crow(r, hi);
#pragma unroll
    for (int d0 = 0; d0 < 4; ++d0) Ow[(long)orow * LDO + d0 * 32 + r32] = (bf16_t)(cvtpk(o[d0][r] * rli[r], 0.f) & 0xffffu); }
#undef SLOAD
#undef SWRITE
#undef SWAIT
#undef RESC
}

__device__ __forceinline__ bf16x8 scale8(bf16x8 v, float s) {
  u32x4 w = *reinterpret_cast<u32x4*>(&v), o;
#pragma unroll
  for (int i = 0; i < 4; ++i) o[i] = cvtpk(__uint_as_float(w[i] << 16) * s, __uint_as_float(w[i] & 0xffff0000u) * s);
  return *reinterpret_cast<bf16x8*>(&o);
}
__device__ __forceinline__ s16x4 trr(int addr) { s16x4 r; asm volatile("ds_read_b64_tr_b16 %0, %1" : "=&v"(r) : "v"(addr) : "memory"); return r; }

__device__ __forceinline__ void chunk_kv_unit(const bf16_t* __restrict__ Kc, const bf16_t* __restrict__ Vc, bf16_t* __restrict__ CKf, bf16_t* __restrict__ CKb, float lgf, float lgb, char* lds, int ldsaddr) {
  const int tid = threadIdx.x, wid = tid >> 6, lane = tid & 63, r32 = lane & 31, hi = lane >> 5;
  const int dir = wid >> 2, db = wid & 3, d = 32 * db + r32;
  __syncthreads();
  { const int sr = tid >> 4, sc = (tid & 15) * 8;
#pragma unroll
    for (int i = 0; i < 4; ++i) { const int row = sr + 32 * i;
      *(bf16x8*)(lds + (row >> 6) * 16384 + v_st(row & 63, sc)) = *reinterpret_cast<const bf16x8*>(Vc + (long)row * 1024 + sc);
      *(bf16x8*)(lds + 32768 + row * 272 + sc * 2) = *reinterpret_cast<const bf16x8*>(Kc + (long)row * 1024 + sc); } }
  __syncthreads();
  bf16x8 kb[8];
  int hio = hi; asm volatile("" : "+v"(hio));
  const char* kl = lds + 32768 + (hio * 8) * 272 + d * 2;
#pragma unroll
  for (int ks = 0; ks < 8; ++ks) { u32x4 w;
#pragma unroll
    for (int i = 0; i < 4; ++i) { const int s0 = ks * 16 + hio * 8 + 2 * i;
      const float k0 = __uint_as_float((unsigned)*(const unsigned short*)(kl + (ks * 16 + 2 * i) * 272) << 16), k1 = __uint_as_float((unsigned)*(const unsigned short*)(kl + (ks * 16 + 2 * i + 1) * 272) << 16);
      const float z0 = __builtin_amdgcn_exp2f(dir ? lgb * (float)s0 : lgf * (float)(127 - s0)), z1 = __builtin_amdgcn_exp2f(dir ? lgb * (float)(s0 + 1) : lgf * (float)(126 - s0));
      w[i] = cvtpk(k0 * z0, k1 * z1); }
    kb[ks] = *reinterpret_cast<bf16x8*>(&w); }
  f32x16 acc[4] = {};
  const int vb = ldsaddr + v_rd_base(lane);
  pvT_one<0>(acc[0], vb, kb[0], kb[1], kb[2], kb[3]); pvT_one<1>(acc[1], vb, kb[0], kb[1], kb[2], kb[3]); pvT_one<2>(acc[2], vb, kb[0], kb[1], kb[2], kb[3]); pvT_one<3>(acc[3], vb, kb[0], kb[1], kb[2], kb[3]);
  pvT_one<0>(acc[0], vb + 16384, kb[4], kb[5], kb[6], kb[7]); pvT_one<1>(acc[1], vb + 16384, kb[4], kb[5], kb[6], kb[7]); pvT_one<2>(acc[2], vb + 16384, kb[4], kb[5], kb[6], kb[7]); pvT_one<3>(acc[3], vb + 16384, kb[4], kb[5], kb[6], kb[7]);
  bf16_t* CK = dir ? CKb : CKf;
#pragma unroll
  for (int eb = 0; eb < 4; ++eb)
#pragma unroll
    for (int r = 0; r < 16; ++r) CK[(32 * eb + crow(r, hi)) * 128 + d] = (bf16_t)(cvtpk(acc[eb][r], 0.f) & 0xffffu);
}

#ifndef PROBE_COMP
#define PROBE_COMP 0
#endif
__device__ __forceinline__ void ret_out_unit(const bf16_t* __restrict__ Qc, const bf16_t* __restrict__ Kc, const bf16_t* __restrict__ Vc, const bf16_t* __restrict__ Gc,
                                             const bf16_t* __restrict__ STf, const bf16_t* __restrict__ STb, const float* __restrict__ gnw, const float* __restrict__ gnb,
                                             bf16_t* __restrict__ Oc, float lgf, float lgb, char* lds, int ldsaddr, float* dump = nullptr) {
  const int tid = threadIdx.x, ht = tid & 255, wq = (tid >> 6) & 3, lane = tid & 63, r32 = lane & 31, hi = lane >> 5;
  __syncthreads();
  { const int sr = ht >> 4, sc = (ht & 15) * 8;
#pragma unroll
    for (int i = 0; i < 8; ++i) { const int row = sr + 16 * i, tile = row >> 6, key = row & 63;
      *(bf16x8*)(lds + tile * 16384 + KSWZ128(key, sc * 2)) = *reinterpret_cast<const bf16x8*>(Kc + (long)row * 1024 + sc);
      *(bf16x8*)(lds + 32768 + tile * 16384 + v_st(key, sc)) = *reinterpret_cast<const bf16x8*>(Vc + (long)row * 1024 + sc); } }
  const int c = 32 * wq + r32;
  bf16x8 qr[8];
#pragma unroll
  for (int d0 = 0; d0 < 8; ++d0) qr[d0] = *reinterpret_cast<const bf16x8*>(Qc + (long)c * 1024 + d0 * 16 + hi * 8);
  __syncthreads();
  f32x16 pA0, pA1, pB0, pB1;
  qkt128(pA0, pA1, lds, qr, r32, hi); qkt128(pB0, pB1, lds + 16384, qr, r32, hi);
  int cdec = c; asm volatile("" : "+v"(cdec));
#define DEC(P, JB) do { _Pragma("unroll") for (int r = 0; r < 16; ++r) { const int dl = cdec - ((JB) + crow(r, hi)); \
    P[r] *= __builtin_amdgcn_exp2f(dl >= 0 ? lgf * (float)dl : lgb * (float)(-dl)); } } while (0)
  DEC(pA0, 0); DEC(pA1, 32); DEC(pB0, 64); DEC(pB1, 96);
#undef DEC
  bf16x8 xa0, xa1, xa2, xa3, xb0, xb1, xb2, xb3;
  PK4(pA0, 0, xa0); PK4(pA0, 8, xa1); PK4(pA1, 0, xa2); PK4(pA1, 8, xa3);
  PK4(pB0, 0, xb0); PK4(pB0, 8, xb1); PK4(pB1, 0, xb2); PK4(pB1, 8, xb3);
  f32x16 o[4] = {};
  const int vb = ldsaddr + 32768 + v_rd_base(lane);
  if (PROBE_COMP == 0 || (PROBE_COMP & 1)) {
  pvT_one<0>(o[0], vb, xa0, xa1, xa2, xa3); pvT_one<1>(o[1], vb, xa0, xa1, xa2, xa3); pvT_one<2>(o[2], vb, xa0, xa1, xa2, xa3); pvT_one<3>(o[3], vb, xa0, xa1, xa2, xa3);
  pvT_one<0>(o[0], vb + 16384, xb0, xb1, xb2, xb3); pvT_one<1>(o[1], vb + 16384, xb0, xb1, xb2, xb3); pvT_one<2>(o[2], vb + 16384, xb0, xb1, xb2, xb3); pvT_one<3>(o[3], vb + 16384, xb0, xb1, xb2, xb3);
  }
#pragma unroll
  for (int dir = 0; dir < 2; ++dir) {
    if (PROBE_COMP != 0 && !((PROBE_COMP >> (1 + dir)) & 1)) continue;
    const float xi = __builtin_amdgcn_exp2f(dir == 0 ? lgf * (float)(c + 1) : lgb * (float)(128 - c));
    const bf16_t* ST = dir == 0 ? STf : STb;
    bf16x8 qs[8];
#pragma unroll
    for (int d0 = 0; d0 < 8; ++d0) qs[d0] = scale8(qr[d0], xi);
    const GAS char* stb = uniform_ptr(ST); const unsigned so = (unsigned)(r32 * 128 + hi * 8) * 2u;
#pragma unroll
    for (int eb = 0; eb < 4; ++eb) {
      bf16x8 A[8];
      SBAR();
#pragma unroll
      for (int d0 = 0; d0 < 8; ++d0) A[d0] = *(const GAS bf16x8*)(stb + so + (eb * 32 * 128 + d0 * 16) * 2);
#pragma unroll
      for (int d0 = 0; d0 < 8; ++d0) o[eb] = __builtin_amdgcn_mfma_f32_32x32x16_bf16(A[d0], qs[d0], o[eb], 0, 0, 0);
      SBAR();
    }
  }
  if (PROBE_COMP != 0) {
#pragma unroll
    for (int eb = 0; eb < 4; ++eb)
#pragma unroll
      for (int g = 0; g < 4; ++g) *(f32x4*)(dump + (long)c * 1024 + 32 * eb + 8 * g + 4 * hi) = (f32x4){o[eb][4 * g], o[eb][4 * g + 1], o[eb][4 * g + 2], o[eb][4 * g + 3]};
    return; }
  float s = 0.f;
#pragma unroll
  for (int eb = 0; eb < 4; ++eb)
#pragma unroll
    for (int r = 0; r < 16; ++r) s += o[eb][r];
  const float mu = swap_sum(s) * (1.f / 128.f);
  float q = 0.f;
#pragma unroll
  for (int eb = 0; eb < 4; ++eb)
#pragma unroll
    for (int r = 0; r < 16; ++r) { const float d = o[eb][r] - mu; q += d * d; }
  const float rstd = rsqrtf(swap_sum(q) * (1.f / 128.f) + 1e-6f);
#pragma unroll
  for (int eb = 0; eb < 4; ++eb)
#pragma unroll
    for (int g = 0; g < 4; ++g) { const int e0 = 32 * eb + 8 * g + 4 * hi;
      const f32x4 w4 = *(const f32x4*)(gnw + e0), b4 = *(const f32x4*)(gnb + e0);
      const u32x2 gg = *(const u32x2*)(Gc + (long)c * 1024 + e0);
      const float g0 = __uint_as_float(gg.x << 16), g1 = __uint_as_float(gg.x & 0xffff0000u), g2 = __uint_as_float(gg.y << 16), g3 = __uint_as_float(gg.y & 0xffff0000u);
      const float y0 = ((o[eb][4 * g] - mu) * rstd * w4[0] + b4[0]) * g0, y1 = ((o[eb][4 * g + 1] - mu) * rstd * w4[1] + b4[1]) * g1;
      const float y2 = ((o[eb][4 * g + 2] - mu) * rstd * w4[2] + b4[2]) * g2, y3 = ((o[eb][4 * g + 3] - mu) * rstd * w4[3] + b4[3]) * g3;
      u32x2 w; w.x = cvtpk(y0, y1); w.y = cvtpk(y2, y3);
      *(u32x2*)(Oc + (long)c * 2048 + e0) = w; }
}

__device__ __forceinline__ void ret_brute_unit(const bf16_t* __restrict__ Qh, const bf16_t* __restrict__ Kh, const bf16_t* __restrict__ Vh, const bf16_t* __restrict__ Gc,
                                               const float* __restrict__ gnw, const float* __restrict__ gnb, bf16_t* __restrict__ Oc, int t0, float lgf, float lgb, char* lds, const float* dump = nullptr) {
  const int tid = threadIdx.x, qi = tid >> 2, part = tid & 3, t = t0 + qi;
  float q[32], acc[32];
#pragma unroll
  for (int i = 0; i < 32; ++i) { q[i] = __uint_as_float((unsigned)Qh[(long)t * 1024 + part * 32 + i] << 16); acc[i] = 0.f; }
  for (int s0 = 0; s0 < 4096; s0 += 64) {
    { const int rel = s0 < t0 ? 1 : (s0 >= t0 + 128 ? 2 : 0); if (PROBE_COMP != 0 && ((PROBE_COMP >> rel) & 1)) continue; }
    __syncthreads();
    for (int c = tid; c < 64 * 16; c += 512) { const int r = c >> 4, c8 = (c & 15) * 8;
      *(bf16x8*)(lds + (r * 128 + c8) * 2) = *reinterpret_cast<const bf16x8*>(Kh + (long)(s0 + r) * 1024 + c8);
      *(bf16x8*)(lds + 16384 + (r * 128 + c8) * 2) = *reinterpret_cast<const bf16x8*>(Vh + (long)(s0 + r) * 1024 + c8); }
    __syncthreads();
    for (int j = 0; j < 64; ++j) { const int s = s0 + j; float d = 0.f;
      const unsigned short* kr = (const unsigned short*)(lds + (j * 128 + part * 32) * 2); const unsigned short* vr = (const unsigned short*)(lds + 16384 + (j * 128 + part * 32) * 2);
#pragma unroll
      for (int i = 0; i < 32; ++i) d += q[i] * __uint_as_float((unsigned)kr[i] << 16);
      d += __shfl_xor(d, 1); d += __shfl_xor(d, 2);
      const int dl = t - s; const float w = d * __builtin_amdgcn_exp2f(dl >= 0 ? lgf * (float)dl : lgb * (float)(-dl));
#pragma unroll
      for (int i = 0; i < 32; ++i) acc[i] += w * __uint_as_float((unsigned)vr[i] << 16); }
  }
  if (PROBE_COMP != 0) {
#pragma unroll
    for (int i = 0; i < 32; ++i) acc[i] += dump[(long)qi * 1024 + part * 32 + i]; }
  float sm = 0.f;
#pragma unroll
  for (int i = 0; i < 32; ++i) sm += acc[i];
  sm += __shfl_xor(sm, 1); sm += __shfl_xor(sm, 2); const float mu = sm * (1.f / 128.f);
  float qq = 0.f;
#pragma unroll
  for (int i = 0; i < 32; ++i) { const float dd = acc[i] - mu; qq += dd * dd; }
  qq += __shfl_xor(qq, 1); qq += __shfl_xor(qq, 2); const float rstd = rsqrtf(qq * (1.f / 128.f) + 1e-6f);
#pragma unroll
  for (int i = 0; i < 32; ++i) { const int e = part * 32 + i; const float g = __uint_as_float((unsigned)Gc[(long)qi * 1024 + e] << 16);
    Oc[(long)qi * 2048 + e] = (bf16_t)(cvtpk(((acc[i] - mu) * rstd * gnw[e] + gnb[e]) * g, 0.f) & 0xffffu); }
}
#undef SBAR
}


#ifndef PROBE_BRUTE_RET
#define PROBE_BRUTE_RET 0
#endif
#ifndef MK_SPLIT
#define MK_SPLIT 0
#endif
#define LAS __attribute__((address_space(3)))
#define GASX __attribute__((address_space(1)))
typedef unsigned short bf16_t;
typedef unsigned v4u __attribute__((ext_vector_type(4)));
typedef unsigned v2u __attribute__((ext_vector_type(2)));
typedef float f32x4 __attribute__((ext_vector_type(4)));
typedef short bf16x8 __attribute__((ext_vector_type(8)));

constexpr int BATCH = 8, SEQ = 4096, DM = 2048, T = BATCH * SEQ;
constexpr int INC = 5184, INCP = 5376, DFF = 5632, NMODC = 6 * DM;
constexpr int NPH = 11;
constexpr size_t MiB = 1u << 20;
constexpr size_t WS_CTL = 0, CTL_ZERO_BYTES = 2 * MiB;
constexpr size_t OFF_MOD = 0, OFF_SSQQ = 512 * 1024, OFF_SSQKV = 640 * 1024;
constexpr size_t WS_COSR = 2 * MiB, WS_SINR = 10 * MiB, WS_COSM = 18 * MiB, WS_SINM = 22 * MiB;
constexpr size_t WS_WIN = 26 * MiB, WS_WUQ = 47 * MiB, WS_WUKV = 49 * MiB, WS_WO = 51 * MiB, WS_WGU = 59 * MiB, WS_WDN = 103 * MiB;
constexpr size_t WS_H = 128 * MiB;
constexpr size_t WS_QR = 256 * MiB, WS_KR = 320 * MiB, WS_VR = 384 * MiB, WS_GR = 448 * MiB;
constexpr size_t WS_CQ = 512 * MiB, WS_CKV = 544 * MiB;
constexpr size_t WS_QM = 576 * MiB, WS_KB = 672 * MiB, WS_VM = 768 * MiB, WS_OAT = 832 * MiB, WS_END = 896 * MiB;
constexpr size_t WS_CAT = 576 * MiB;
constexpr size_t WS_AFF = 256 * MiB;
static_assert(WS_AFF + (size_t)T * DFF * 2 <= WS_END && WS_CAT + (size_t)T * 2048 * 2 <= WS_VM, "d_ws map");
constexpr int LDS_BAR_OFF = 150528;
constexpr size_t OFF_XBAR = 1536 * 1024;
constexpr int LDS_BYTES = 150528 + 64;

#define LDS_WAIT() asm volatile("s_waitcnt lgkmcnt(0)" ::: "memory")
__device__ __forceinline__ unsigned f2bf(float f) { unsigned u = __builtin_bit_cast(unsigned, f); return (u + 0x7fffu + ((u >> 16) & 1u)) >> 16; }
__device__ __forceinline__ unsigned pk2(float lo, float hi) { return f2bf(lo) | (f2bf(hi) << 16); }
__device__ __forceinline__ unsigned pk2a(float lo, float hi) { return pg8::coarse2(pk2(lo, hi)); }
__device__ __forceinline__ float wave_sum(float v) {
#pragma unroll
    for (int o = 1; o < 64; o <<= 1) v += __shfl_xor(v, o);
    return v;
}
__device__ __forceinline__ int dest_row(int mapid, int n) {
    switch (mapid) {
    case 1: if (n < 2048) { const int j = n & 127; return (n & ~127) + (j < 64 ? 2 * j : 2 * (j - 64) + 1); }
            if (n < 5120) return n;
            { const int j = n - 5120; return 5120 + (j < 32 ? 2 * j : 2 * (j - 32) + 1); }
    case 2: { const int d = n % 192; if (d < 128) return n; const int j = d - 128; return n - d + 128 + (j < 32 ? 2 * j : 2 * (j - 32) + 1); }
    case 3: return (n >> 7) * 256 + (n & 127);
    case 4: return (n >> 7) * 256 + 128 + (n & 127);
    default: return n;
    }
}
__device__ __forceinline__ void transpose_item(const float* __restrict__ W, int K, int N, bf16_t* __restrict__ WT, const float* __restrict__ kscale, int mapid, LAS float* scr, int item, int lane) {
    const int nblk = N / 32, kb = item / nblk, nb = item % nblk, k0 = 64 * kb, n0 = 32 * nb;
#pragma unroll 8
    for (int i = 0; i < 32; ++i) { const int kk = 2 * i + (lane >> 5); float v = W[(size_t)(k0 + kk) * N + n0 + (lane & 31)]; if (kscale) v *= kscale[k0 + kk]; scr[kk * 33 + (lane & 31)] = v; }
    LDS_WAIT(); asm volatile("" ::: "memory");
    const int c = lane & 7;
#pragma unroll
    for (int j = 0; j < 4; ++j) { const int n = (lane >> 3) + 8 * j; const LAS float* s = scr + (8 * c) * 33 + n;
        v4u o; o.x = pk2(s[0 * 33], s[1 * 33]); o.y = pk2(s[2 * 33], s[3 * 33]); o.z = pk2(s[4 * 33], s[5 * 33]); o.w = pk2(s[6 * 33], s[7 * 33]);
        *(v4u*)(WT + (size_t)dest_row(mapid, n0 + n) * K + k0 + 8 * c) = o; }
    LDS_WAIT(); asm volatile("" ::: "memory");
}
__device__ __forceinline__ void norm_row(const float* xrow, const float* __restrict__ w, const float* __restrict__ shift, const float* __restrict__ scale, bf16_t* ob, float* of, int lane) {
    const f32x4* xr = (const f32x4*)xrow + lane;
    f32x4 v[8]; float s = 0.f;
#pragma unroll
    for (int j = 0; j < 8; ++j) { v[j] = xr[64 * j]; s += (v[j].x * v[j].x + v[j].y * v[j].y) + (v[j].z * v[j].z + v[j].w * v[j].w); }
    const float rstd = rsqrtf(wave_sum(s) * (1.f / 2048.f) + 1e-6f);
#pragma unroll
    for (int j = 0; j < 8; ++j) { const int col = 4 * lane + 256 * j; f32x4 y = v[j] * rstd * *(const f32x4*)(w + col);
        if (shift) y = y * (*(const f32x4*)(scale + col) + 1.f) + *(const f32x4*)(shift + col);
        if (ob) { v2u o; o.x = pk2a(y.x, y.y); o.y = pk2a(y.z, y.w); *(v2u*)(ob + col) = o; } else *(f32x4*)(of + col) = y; }
}

#define XB_TMO      128
#define XB_XCNT(j)  (256  + 64 * (j))
#define XB_XSUB(j)  (1280 + 64 * (j))
#define XB_XGEN(j)  (2304 + 64 * (j))
#define XB_TOP      3328
#define XB_TOPGEN   3392
#define XCD_BAR_WORDS 3456
#define XB_SPIN_CAP (1u << 18)

__device__ __forceinline__ unsigned xb_ld(unsigned* p)              { return __hip_atomic_load(p, __ATOMIC_RELAXED, __HIP_MEMORY_SCOPE_AGENT); }
__device__ __forceinline__ unsigned xb_add(unsigned* p, unsigned v) { return __hip_atomic_fetch_add(p, v, __ATOMIC_RELAXED, __HIP_MEMORY_SCOPE_AGENT); }
__device__ __forceinline__ unsigned xb_xcc_id() { return (unsigned)__builtin_amdgcn_s_getreg((3 << 11) | 20) & 0xFu; }
#define XB_SPIN(cond, bar) do { unsigned _sp = 0; while (cond) { __builtin_amdgcn_s_sleep(1); \
    if ((++_sp & 255u) == 0u) { if (xb_ld(&(bar)[XB_TMO])) break; if (_sp > XB_SPIN_CAP) { atomicAdd(&(bar)[XB_TMO], 1u); break; } } } } while (0)

struct XcdBarrier {
    unsigned* bar; unsigned x;
    volatile LAS unsigned* st;
};

__device__ __forceinline__ XcdBarrier xcd_barrier_post(unsigned* bar, volatile LAS unsigned* st) {
    XcdBarrier b; b.bar = bar; b.x = xb_xcc_id(); b.st = st;
    if (threadIdx.x == 0) (void)xb_add(&bar[XB_XCNT(b.x)], 1u);
    return b;
}
__device__ __forceinline__ void xcd_barrier_complete(unsigned* bar, unsigned x, unsigned& nloc, unsigned& nx) {
    const unsigned G = gridDim.x * gridDim.y * gridDim.z;
    unsigned sum, cnt, mine, sp = 0u;
    for (;;) {
        sum = 0u; cnt = 0u; mine = 0u;
#pragma unroll
        for (unsigned j = 0; j < 16; ++j) { const unsigned c = xb_ld(&bar[XB_XCNT(j)]); sum += c; cnt += (c > 0u) ? 1u : 0u; mine = (j == x) ? c : mine; }
        if (sum == G) break;
        __builtin_amdgcn_s_sleep(1);
        if ((++sp & 255u) == 0u) { if (xb_ld(&bar[XB_TMO])) break; if (sp > XB_SPIN_CAP) { atomicAdd(&bar[XB_TMO], 1u); break; } }
    }
    nloc = mine > 0u ? mine : 1u; nx = cnt > 0u ? cnt : 1u;
}

__device__ __forceinline__ void xcd_barrier(const XcdBarrier& b) {
    asm volatile("s_waitcnt vmcnt(0)" ::: "memory");
    __syncthreads();
    if (threadIdx.x == 0) {
        unsigned* bar = b.bar;
        __builtin_amdgcn_s_waitcnt(0);
        unsigned nloc = b.st[0], nx = b.st[1];
        if (nloc == 0u) { xcd_barrier_complete(bar, b.x, nloc, nx); b.st[0] = nloc; b.st[1] = nx; }
        const unsigned old = xb_add(&bar[XB_XSUB(b.x)], 1u);
        const unsigned gen = old / nloc;
        if (old + 1u == (gen + 1u) * nloc) {
            __builtin_amdgcn_fence(__ATOMIC_RELEASE, "agent");
            asm volatile("s_waitcnt vmcnt(0)" ::: "memory");
            const unsigned og = xb_add(&bar[XB_TOP], 1u);
            const unsigned tg = og / nx;
            if (og + 1u == (tg + 1u) * nx) xb_add(&bar[XB_TOPGEN], 1u);
            else XB_SPIN(xb_ld(&bar[XB_TOPGEN]) == tg, bar);
            __builtin_amdgcn_fence(__ATOMIC_ACQUIRE, "agent");
            xb_add(&bar[XB_XGEN(b.x)], 1u);
            asm volatile("s_waitcnt vmcnt(0)" ::: "memory");
        } else {
            XB_SPIN(xb_ld(&bar[XB_XGEN(b.x)]) == gen, bar);
            __builtin_amdgcn_fence(__ATOMIC_ACQUIRE, "agent");
            asm volatile("s_waitcnt vmcnt(0)" ::: "memory");
        }
    }
    __syncthreads();
}

struct Args { const float* in[21]; float* out; unsigned char* ws; float inv_r[64]; float inv_m[32]; int ph_lo, ph_hi; };
static_assert(sizeof(Args) == 21 * 8 + 16 + 96 * 4 + 8, "Args has no padding");

__global__ void __launch_bounds__(512, 2) mk_fwd(Args a) {
    extern __shared__ __attribute__((aligned(16))) unsigned char smem[];
    cg::grid_group grid = cg::this_grid();
    const int tid = threadIdx.x, lane = tid & 63, wave = __builtin_amdgcn_readfirstlane(tid >> 6);
    const int G = gridDim.x, bx = blockIdx.x, vcu = (G % 8 == 0) ? (bx % 8) * (G / 8) + bx / 8 : bx;
    const int gw = vcu * 8 + wave, NGW = G * 8;
    LAS unsigned char* lds3 = (LAS unsigned char*)smem; char* ldsg = (char*)smem; const int ldsaddr = (int)(unsigned)(uintptr_t)lds3;
    float* out = a.out;
#define WSB() size_t wz_ = 0; asm volatile("" : "+s"(wz_)); unsigned char* ws = a.ws + wz_
#define INP(name, k) const float* name = a.in[k] + wz_
#define WSF(name, off) float* name = (float*)(ws + (off))
#define WSH(name, off) bf16_t* name = (bf16_t*)(ws + (off))
    const int lo = a.ph_lo, hi = a.ph_hi;
    if (tid < 16) ((LAS unsigned*)(lds3 + LDS_BAR_OFF))[tid] = 0u;
    __syncthreads();
    XcdBarrier xbar = xcd_barrier_post((unsigned*)(a.ws + WS_CTL + OFF_XBAR), (volatile LAS unsigned*)(lds3 + LDS_BAR_OFF));
#ifndef PH_MASK
#define PH_MASK 0x7ff
#endif
#define IN(k) (((PH_MASK >> (k)) & 1) && lo <= (k) && (k) < hi)
#define SEAM(k) do { if (IN(k) && IN((k) + 1)) { asm volatile("s_waitcnt vmcnt(0) lgkmcnt(0)" ::: "memory"); grid.sync(); \
    __builtin_amdgcn_fence(__ATOMIC_ACQUIRE, "agent"); asm volatile("s_waitcnt vmcnt(0)" ::: "memory"); } } while (0)
#define SEAMX(k) do { if (IN(k) && IN((k) + 1)) xcd_barrier(xbar); } while (0)

    if (IN(0)) {
        WSB(); WSF(mod, WS_CTL + OFF_MOD); WSF(cosr, WS_COSR); WSF(sinr, WS_SINR); WSF(cosm, WS_COSM); WSF(sinm, WS_SINM);
        WSH(Win, WS_WIN); WSH(Wuq, WS_WUQ); WSH(Wukv, WS_WUKV); WSH(Wo, WS_WO); WSH(Wgu, WS_WGU); WSH(Wdn, WS_WDN);
        INP(cin, 1); INP(ada_w, 3); INP(ada_b, 4); INP(w_in, 6); INP(mla_q_norm_w, 10); INP(w_uq, 11); INP(mla_kv_norm_w, 12); INP(w_ukv, 13); INP(w_o, 15); INP(w_gate, 17); INP(w_up, 18); INP(w_down, 19);
        const int* positions = (const int*)a.in[2] + wz_;
        {
            LAS float* cs = (LAS float*)lds3;
            for (int i = tid; i < 8 * 2048; i += 512) { const int b = i >> 11, k = i & 2047; const float v = cin[i]; cs[k * 8 + b] = v / (1.f + __expf(-v)); }
            __syncthreads();
            for (int task = gw; task < 192 * 16; task += NGW) { const int cb = task % 192, ks = task / 192, col = cb * 64 + lane;
                float acc[8]; const float bias = ks == 0 ? ada_b[col] : 0.f;
#pragma unroll
                for (int b = 0; b < 8; ++b) acc[b] = bias;
                const float* wp = ada_w + (size_t)(ks * 128) * NMODC + col;
                for (int k8 = 0; k8 < 128; k8 += 8) { float wv[8];
#pragma unroll
                    for (int i = 0; i < 8; ++i) wv[i] = wp[(size_t)(k8 + i) * NMODC];
#pragma unroll
                    for (int i = 0; i < 8; ++i) { const LAS f32x4* c4 = (const LAS f32x4*)(cs + (ks * 128 + k8 + i) * 8); const f32x4 c0 = c4[0], c1 = c4[1];
                        acc[0] += c0.x * wv[i]; acc[1] += c0.y * wv[i]; acc[2] += c0.z * wv[i]; acc[3] += c0.w * wv[i]; acc[4] += c1.x * wv[i]; acc[5] += c1.y * wv[i]; acc[6] += c1.z * wv[i]; acc[7] += c1.w * wv[i]; } }
#pragma unroll
                for (int b = 0; b < 8; ++b) atomicAdd(mod + (size_t)b * NMODC + col, acc[b]); }
            __syncthreads();
        }
        {
            LAS float* scr = (LAS float*)(lds3 + wave * 16384);
            constexpr int I_IN = 32 * (INC / 32), I_UQ = 8 * 48, I_UKV = 8 * 64, I_O = 32 * 64, I_G = 32 * (DFF / 32), I_D = (DFF / 64) * 64;
            constexpr int NITEMS = I_IN + I_UQ + I_UKV + I_O + 2 * I_G + I_D;
            for (int it = gw; it < NITEMS; it += NGW) { int r = it;
                if (r < I_IN) { transpose_item(w_in, 2048, INC, Win, nullptr, 1, scr, r, lane); continue; } r -= I_IN;
                if (r < I_UQ) { transpose_item(w_uq, 512, 1536, Wuq, mla_q_norm_w, 2, scr, r, lane); continue; } r -= I_UQ;
                if (r < I_UKV) { transpose_item(w_ukv, 512, 2048, Wukv, mla_kv_norm_w, 0, scr, r, lane); continue; } r -= I_UKV;
                if (r < I_O) { transpose_item(w_o, 2048, 2048, Wo, nullptr, 0, scr, r, lane); continue; } r -= I_O;
                if (r < I_G) { transpose_item(w_gate, 2048, DFF, Wgu, nullptr, 3, scr, r, lane); continue; } r -= I_G;
                if (r < I_G) { transpose_item(w_up, 2048, DFF, Wgu, nullptr, 4, scr, r, lane); continue; } r -= I_G;
                transpose_item(w_down, DFF, 2048, Wdn, nullptr, 0, scr, r, lane); }
            for (int i = bx * 512 + tid; i < (INCP - INC) * 2048 / 8; i += G * 512) *(v4u*)(Win + (size_t)INC * 2048 + (size_t)i * 8) = (v4u){0u, 0u, 0u, 0u};
        }
        {
            for (int i = bx * 512 + tid; i < T * 96; i += G * 512) { const int t = i / 96, j = i % 96; const float pos = (float)positions[t];
                const float inv = j < 64 ? a.inv_r[j] : a.inv_m[j - 64]; const float ang = pos * inv;
                double rev = (double)ang * 0.15915494309189535; rev -= __builtin_rint(rev);
                const double qd = __builtin_rint(rev * 4.0); const double y = (rev - qd * 0.25) * 6.283185307179586; const double y2 = y * y;
                const double sy = y * (1.0 + y2 * (-1.0 / 6 + y2 * (1.0 / 120 + y2 * (-1.0 / 5040 + y2 * (1.0 / 362880 + y2 * (-1.0 / 39916800 + y2 * (1.0 / 6227020800.0)))))));
                const double cy = 1.0 + y2 * (-0.5 + y2 * (1.0 / 24 + y2 * (-1.0 / 720 + y2 * (1.0 / 40320 + y2 * (-1.0 / 3628800 + y2 * (1.0 / 479001600.0 + y2 * (-1.0 / 87178291200.0)))))));
                const int qi = (int)qd & 3;
                const float cv = (float)(qi == 0 ? cy : qi == 1 ? -sy : qi == 2 ? -cy : sy), sv = (float)(qi == 0 ? sy : qi == 1 ? cy : qi == 2 ? -sy : -cy);
                if (j < 64) { cosr[(size_t)t * 64 + j] = cv; sinr[(size_t)t * 64 + j] = sv; } else { cosm[(size_t)t * 32 + j - 64] = cv; sinm[(size_t)t * 32 + j - 64] = sv; } }
        }
    }
    SEAMX(0);
    if (a.ph_hi > 1000) { SEAM(0); }
    if (IN(1)) { WSB(); WSF(mod, WS_CTL + OFF_MOD); WSH(H, WS_H); INP(x, 0); INP(norm1_w, 5);
        for (int m = gw; m < T; m += NGW) { const int b = m >> 12; norm_row(x + (size_t)m * DM, norm1_w, mod + (size_t)b * NMODC, mod + (size_t)b * NMODC + DM, H + (size_t)m * DM, nullptr, lane); } }
    SEAMX(1);
    if (IN(2)) {
        WSB(); WSH(H, WS_H); WSH(Win, WS_WIN); WSH(Qr, WS_QR); WSH(Kr, WS_KR); WSH(Vr, WS_VR); WSH(Gr, WS_GR); WSH(CQ, WS_CQ); WSH(CKV, WS_CKV); WSH(Kbuf, WS_KB);
        WSF(cosr, WS_COSR); WSF(sinr, WS_SINR); WSF(cosm, WS_COSM); WSF(sinm, WS_SINM); WSF(ssq_q, WS_CTL + OFF_SSQQ); WSF(ssq_kv, WS_CTL + OFF_SSQKV);
        pg8::Gemm g{H, Win, T, INCP, DM}; pg8::StaticOrder S; S.init(T, INCP, G, bx);
        pg8::EpiIn E{Qr, Kr, Vr, Gr, CQ, CKV, Kbuf, cosr, sinr, cosm, sinm, ssq_q, ssq_kv};
        pg8::gemm_phase<pg8::EpiIn, pg8::StaticOrder, true, true>(lds3, g, S, E);
    }
    SEAMX(2);
    if (IN(3)) {
        WSB(); WSH(CQ, WS_CQ); WSH(CKV, WS_CKV); WSH(Wuq, WS_WUQ); WSH(Wukv, WS_WUKV); WSH(Qm, WS_QM); WSH(Kbuf, WS_KB); WSH(Vm, WS_VM); WSH(Kr, WS_KR); WSH(Vr, WS_VR); WSH(CK, WS_H);
        WSF(cosm, WS_COSM); WSF(sinm, WS_SINM); WSF(ssq_q, WS_CTL + OFF_SSQQ); WSF(ssq_kv, WS_CTL + OFF_SSQKV); INP(ret_decay, 7);
        { pg8::Gemm g{CQ, Wuq, T, 1536, 512}; pg8::StaticOrder S; S.init(T, 1536, G, bx); pg8::EpiUpQ E{ssq_q, Qm, cosm, sinm};
          pg8::gemm_phase<pg8::EpiUpQ, pg8::StaticOrder, true, true>(lds3, g, S, E); }
        { pg8::Gemm g{CKV, Wukv, T, 2048, 512}; pg8::StaticOrder S; S.init(T, 2048, G, bx); pg8::EpiUpKV E{ssq_kv, Kbuf, Vm};
          pg8::gemm_phase<pg8::EpiUpKV, pg8::StaticOrder, true, true>(lds3, g, S, E); }
        for (int u = vcu; u < 2048; u += G) { const int n = u & 31, h = (u >> 5) & 7, b = u >> 8; const size_t t0 = (size_t)b * SEQ + n * 128;
            const float lgf = -__expf(ret_decay[h]) * 1.4426950408889634f, lgb = -__expf(ret_decay[8 + h]) * 1.4426950408889634f;
            att::chunk_kv_unit(Kr + t0 * 1024 + h * 128, Vr + t0 * 1024 + h * 128, CK + ((size_t)(b * 8 + h) * 32 + n) * 16384, CK + ((size_t)(64 + b * 8 + h) * 32 + n) * 16384, lgf, lgb, ldsg, ldsaddr); }
        __syncthreads();
    }
    SEAMX(3);
    if (IN(4)) {
        WSB(); WSH(Qm, WS_QM); WSH(Kbuf, WS_KB); WSH(Vm, WS_VM); WSH(Oat, WS_OAT); WSH(CK, WS_H); INP(ret_decay, 7);
        for (int u = vcu; u < 1024; u += G) { const int qb = u & 15, h = (u >> 4) & 7, b = u >> 7; const size_t r0 = (size_t)b * SEQ;
            att::attn_unit(Qm + (r0 + qb * 256) * 1536 + h * 192, Kbuf + r0 * 1536 + h * 192, Vm + r0 * 1024 + h * 128, Oat + (r0 + qb * 256) * 1024 + h * 128, SEQ, ldsg, ldsaddr); }
#ifndef NO_SCAN
        for (int idx = bx * 512 + tid; idx < 2 * 64 * 2048; idx += G * 512) { const int dir = idx >> 17, bh = (idx >> 11) & 63, e8 = idx & 2047, h = bh & 7;
            const float cd = __builtin_amdgcn_exp2f(-__expf(ret_decay[dir * 8 + h]) * 1.4426950408889634f * 128.f);
            bf16_t* base = CK + ((size_t)(dir * 64 + bh) * 32) * 16384 + e8 * 8; float st[8];
#pragma unroll
            for (int i = 0; i < 8; ++i) st[i] = 0.f;
            for (int s8 = 0; s8 < 32; s8 += 8) { v4u kv[8];
#pragma unroll
                for (int i = 0; i < 8; ++i) { const int m = dir ? 31 - (s8 + i) : s8 + i; kv[i] = *(const v4u*)(base + (size_t)m * 16384); }
#pragma unroll
                for (int i = 0; i < 8; ++i) { const int m = dir ? 31 - (s8 + i) : s8 + i; v4u o;
                    o.x = pk2a(st[0], st[1]); o.y = pk2a(st[2], st[3]); o.z = pk2a(st[4], st[5]); o.w = pk2a(st[6], st[7]);
                    *(v4u*)(base + (size_t)m * 16384) = o;
#pragma unroll
                    for (int q = 0; q < 4; ++q) { const unsigned w = kv[i][q]; st[2 * q] = st[2 * q] * cd + __uint_as_float(w << 16); st[2 * q + 1] = st[2 * q + 1] * cd + __uint_as_float(w & 0xffff0000u); } } }
        }
#endif
    }
    SEAMX(4);
    if (IN(5)) {
        WSB(); WSH(Qr, WS_QR); WSH(Kr, WS_KR); WSH(Vr, WS_VR); WSH(Gr, WS_GR); WSH(CK, WS_H); WSH(Cat, WS_CAT); WSH(Oat, WS_OAT); INP(ret_decay, 7); INP(ret_gn_w, 8); INP(ret_gn_b, 9); INP(mla_out_w, 14);
#if PROBE_BRUTE_RET
        float* dumpb = (float*)(ws + 704 * MiB);
        for (int up = vcu; up < 1024; up += G) {
            if (PROBE_COMP != 0) { const int u = up * 2 + (wave >> 2); const int n = u & 31, h = (u >> 5) & 7, b = u >> 8; const size_t t0 = (size_t)b * SEQ + n * 128;
                const float lgf = -__expf(ret_decay[h]) * 1.4426950408889634f, lgb = -__expf(ret_decay[8 + h]) * 1.4426950408889634f; const int hf = wave >> 2;
                att::ret_out_unit(Qr + t0 * 1024 + h * 128, Kr + t0 * 1024 + h * 128, Vr + t0 * 1024 + h * 128, Gr + t0 * 1024 + h * 128,
                                  CK + ((size_t)(b * 8 + h) * 32 + n) * 16384, CK + ((size_t)(64 + b * 8 + h) * 32 + n) * 16384, ret_gn_w + h * 128, ret_gn_b + h * 128,
                                  Cat + t0 * 2048 + h * 128, lgf, lgb, ldsg + hf * 65536, ldsaddr + hf * 65536, dumpb + t0 * 1024 + h * 128);
                __threadfence(); __syncthreads(); }
            for (int k2 = 0; k2 < 2; ++k2) { const int u = up * 2 + k2; const int n = u & 31, h = (u >> 5) & 7, b = u >> 8; const size_t r0 = (size_t)b * SEQ, t0 = r0 + n * 128;
                const float lgf = -__expf(ret_decay[h]) * 1.4426950408889634f, lgb = -__expf(ret_decay[8 + h]) * 1.4426950408889634f;
                att::ret_brute_unit(Qr + r0 * 1024 + h * 128, Kr + r0 * 1024 + h * 128, Vr + r0 * 1024 + h * 128, Gr + t0 * 1024 + h * 128, ret_gn_w + h * 128, ret_gn_b + h * 128, Cat + t0 * 2048 + h * 128, n * 128, lgf, lgb, ldsg, dumpb + t0 * 1024 + h * 128); } }
        __syncthreads();
        for (int up = vcu; up < 0; up += G) { const int u = up * 2 + (wave >> 2);
#else
        for (int up = vcu; up < 1024; up += G) { const int u = up * 2 + (wave >> 2);
#endif
            const int n = u & 31, h = (u >> 5) & 7, b = u >> 8; const size_t t0 = (size_t)b * SEQ + n * 128;
            const float lgf = -__expf(ret_decay[h]) * 1.4426950408889634f, lgb = -__expf(ret_decay[8 + h]) * 1.4426950408889634f; const int hf = wave >> 2;
            att::ret_out_unit(Qr + t0 * 1024 + h * 128, Kr + t0 * 1024 + h * 128, Vr + t0 * 1024 + h * 128, Gr + t0 * 1024 + h * 128,
                              CK + ((size_t)(b * 8 + h) * 32 + n) * 16384, CK + ((size_t)(64 + b * 8 + h) * 32 + n) * 16384, ret_gn_w + h * 128, ret_gn_b + h * 128,
                              Cat + t0 * 2048 + h * 128, lgf, lgb, ldsg + hf * 65536, ldsaddr + hf * 65536); }
        for (int m = gw; m < T; m += NGW) {
            const bf16_t* orow = Oat + (size_t)m * 1024; float v[16]; float s = 0.f;
#pragma unroll
            for (int j = 0; j < 2; ++j) { const v4u w = *(const v4u*)(orow + lane * 8 + 512 * j);
#pragma unroll
                for (int q = 0; q < 4; ++q) { v[j * 8 + 2 * q] = __uint_as_float(w[q] << 16); v[j * 8 + 2 * q + 1] = __uint_as_float(w[q] & 0xffff0000u); } }
#pragma unroll
            for (int i = 0; i < 16; ++i) s += v[i] * v[i];
            const float rstd = rsqrtf(wave_sum(s) * (1.f / 1024.f) + 1e-6f);
#pragma unroll
            for (int j = 0; j < 2; ++j) { const int col = lane * 8 + 512 * j; const f32x4 w0 = *(const f32x4*)(mla_out_w + col), w1 = *(const f32x4*)(mla_out_w + col + 4); v4u o;
                o.x = pk2a(v[j * 8 + 0] * rstd * w0.x, v[j * 8 + 1] * rstd * w0.y); o.y = pk2a(v[j * 8 + 2] * rstd * w0.z, v[j * 8 + 3] * rstd * w0.w);
                o.z = pk2a(v[j * 8 + 4] * rstd * w1.x, v[j * 8 + 5] * rstd * w1.y); o.w = pk2a(v[j * 8 + 6] * rstd * w1.z, v[j * 8 + 7] * rstd * w1.w);
                *(v4u*)(Cat + (size_t)m * 2048 + 1024 + col) = o; } }
        __syncthreads();
    }
    SEAMX(5);
    if (IN(6)) {
        WSB(); WSH(Cat, WS_CAT); WSH(Wo, WS_WO); WSF(mod, WS_CTL + OFF_MOD); INP(x, 0);
        pg8::Gemm g{Cat, Wo, T, 2048, 2048}; pg8::StaticOrder S; S.init(T, 2048, G, bx); pg8::EpiGateRes E{x, mod + 2 * DM, out};
        pg8::gemm_phase<pg8::EpiGateRes, pg8::StaticOrder, true, true>(lds3, g, S, E);
    }
    SEAMX(6);
    if (IN(7)) { WSB(); WSF(mod, WS_CTL + OFF_MOD); WSH(H, WS_H); INP(norm2_w, 16);
        for (int m = gw; m < T; m += NGW) { const int b = m >> 12; norm_row(out + (size_t)m * DM, norm2_w, mod + (size_t)b * NMODC + 3 * DM, mod + (size_t)b * NMODC + 4 * DM, H + (size_t)m * DM, nullptr, lane); } }
    SEAMX(7);
    if (IN(8)) {
        WSB(); WSH(H, WS_H); WSH(Wgu, WS_WGU); WSH(Aff, WS_AFF);
        pg8::Gemm g{H, Wgu, T, 2 * DFF, DM}; pg8::StaticOrder S; S.init(T, 2 * DFF, G, bx); pg8::EpiGU E{Aff};
        pg8::gemm_phase<pg8::EpiGU, pg8::StaticOrder, true, true>(lds3, g, S, E);
    }
    SEAMX(8);
    if (IN(9)) {
        WSB(); WSH(Aff, WS_AFF); WSH(Wdn, WS_WDN); WSF(mod, WS_CTL + OFF_MOD);
        pg8::Gemm g{Aff, Wdn, T, 2048, DFF}; pg8::StaticOrder S; S.init(T, 2048, G, bx); pg8::EpiGateRes E{out, mod + 5 * DM, out};
        pg8::gemm_phase<pg8::EpiGateRes, pg8::StaticOrder, true, true>(lds3, g, S, E);
    }
    SEAMX(9);
    if (IN(10)) { WSB(); (void)ws; INP(final_norm_w, 20);
        for (int m = gw; m < T; m += NGW) norm_row(out + (size_t)m * DM, final_norm_w, nullptr, nullptr, nullptr, out + (size_t)m * DM, lane); }
#undef IN
#undef SEAM
}

extern "C" void kernel_launch(void* const* d_in, const int* in_sizes, int n_in, void* d_out, int out_size, void* d_ws, size_t ws_size, hipStream_t stream) {
    static int grid = 0;
    if (grid == 0) {
        if (n_in != 21 || in_sizes[0] != T * DM || out_size != T * DM || ws_size < WS_END) { fprintf(stderr, "kernel_launch: shape/workspace mismatch (n_in %d, ws %zu < %zu)\n", n_in, ws_size, (size_t)WS_END); grid = -1; return; }
        int dev = 0, cus = 0, per_cu = 0;
        (void)hipGetDevice(&dev); (void)hipDeviceGetAttribute(&cus, hipDeviceAttributeMultiprocessorCount, dev);
        if (hipFuncSetAttribute((const void*)mk_fwd, hipFuncAttributeMaxDynamicSharedMemorySize, LDS_BYTES) != hipSuccess) { fprintf(stderr, "kernel_launch: hipFuncSetAttribute failed\n"); grid = -1; return; }
        if (hipOccupancyMaxActiveBlocksPerMultiprocessor(&per_cu, (const void*)mk_fwd, 512, LDS_BYTES) != hipSuccess || per_cu < 1) { fprintf(stderr, "kernel_launch: occupancy query gave %d\n", per_cu); per_cu = 1; }
        (void)hipGetLastError();
        grid = cus * per_cu;
    }
    if (grid < 0) return;
    (void)hipMemsetAsync((char*)d_ws + WS_CTL, 0, CTL_ZERO_BYTES, stream);
    Args a{};
    for (int i = 0; i < 21; ++i) a.in[i] = (const float*)d_in[i];
    a.out = (float*)d_out; a.ws = (unsigned char*)d_ws;
    for (int i = 0; i < 64; ++i) a.inv_r[i] = powf(10000.0f, -((float)(2 * i)) / 128.0f);
    for (int i = 0; i < 32; ++i) a.inv_m[i] = powf(10000.0f, -((float)(2 * i)) / 64.0f);
#if MK_SPLIT
    for (int p = 0; p < NPH; ++p) { a.ph_lo = p; a.ph_hi = p + 1; hipLaunchKernelGGL(mk_fwd, dim3(grid), dim3(512), LDS_BYTES, stream, a); }
#else
    a.ph_lo = 0; a.ph_hi = NPH;
    void* args[] = {&a};
    hipError_t e = hipLaunchCooperativeKernel((const void*)mk_fwd, dim3(grid), dim3(512), args, LDS_BYTES, stream);
    if (e != hipSuccess) fprintf(stderr, "kernel_launch: cooperative launch failed: %s (grid %d)\n", hipGetErrorString(e), grid);
#endif
}
```

```cpp
#include <hip/hip_runtime.h>
#include <hip/hip_cooperative_groups.h>
#include <cstdio>
#include <cstdint>
#include <cmath>
namespace cg = cooperative_groups;
namespace pg8 {
#define PG8_LAS __attribute__((address_space(3)))
typedef unsigned short bf16_t;
typedef short bf16x8 __attribute__((ext_vector_type(8)));
typedef float f32x4 __attribute__((ext_vector_type(4)));
typedef unsigned u32x4 __attribute__((ext_vector_type(4)));
constexpr int BM = 256, BK = 64, HALF = 128, HTB = HALF * BK * 2  , STAGE_BYTES = 8 * HTB, NXCD = 8, WGM = 8;

__host__ __device__ __forceinline__ int lds_byte(int r, int c) { const int st = (r >> 4) * 2 + (c >> 5), rr = r & 15, cc = c & 31, ob = rr * 64 + cc * 2; return st * 1024 + (ob ^ (((ob >> 9) & 1) << 5)); }
__host__ __device__ __forceinline__ void stage_rc(int b, int& R, int& C) { const int st = b / 1024, sb = b % 1024, swz = sb ^ (((sb >> 9) & 1) << 5); R = (st >> 1) * 16 + swz / 64; C = (st & 1) * 32 + (swz % 64) / 2; }
__host__ __device__ __forceinline__ int perm32(int rho) { const int n = rho >> 4, i = rho & 15; return 8 * (i >> 2) + 4 * n + (i & 3); }

struct Unit { int pm, pn; };
struct Gemm { const bf16_t* A; const bf16_t* Bt; int M, N, K; };

struct StaticOrder {
    int nM, nN, nwg, G, c;
    __host__ __device__ void init(int M, int N, int G_, int c_) { nM = M / BM; nN = N / BM; nwg = nM * nN; G = G_; c = c_; }
    __host__ __device__ bool next(int i, Unit& u) const {
        const long L = (long)i * G + c; if (L >= nwg) return false;
        int wgid = (int)L; { const int q = nwg / NXCD, r = nwg % NXCD, xcd = wgid % NXCD, off = wgid / NXCD; wgid = (xcd < r ? xcd * (q + 1) : r * (q + 1) + (xcd - r) * q) + off; }
        const int nig = WGM * nN, gid = wgid / nig, fm = gid * WGM, gsz = (nM - fm) < WGM ? (nM - fm) : WGM;
        u.pm = fm + ((wgid % nig) % gsz); u.pn = (wgid % nig) / gsz; return true;
    }
    __device__ __forceinline__ void a_ready(const Unit&) const {}
    __device__ __forceinline__ void done(const Unit&) const {}
};

#ifndef PROBE_COARSE_ACT
#define PROBE_COARSE_ACT 0
#endif
__device__ __forceinline__ unsigned coarse2(unsigned w) { return PROBE_COARSE_ACT ? ((w + ((w >> 1) & 0x00010001u)) & 0xfffefffeu) : w; }
__device__ __forceinline__ unsigned cvt_pk_bf16(float lo, float hi) { unsigned r; asm volatile("v_cvt_pk_bf16_f32 %0, %1, %2" : "=v"(r) : "v"(lo), "v"(hi)); return coarse2(r); }
typedef float f32x2 __attribute__((ext_vector_type(2)));

typedef unsigned u32x2 __attribute__((ext_vector_type(2)));
__device__ __forceinline__ float silu_f(float v) { return v * __builtin_amdgcn_rcpf(1.f + __builtin_amdgcn_exp2f(v * -1.4426950408889634f)); }
__device__ __forceinline__ u32x4 pack8(f32x4 a, f32x4 b) { u32x4 w; w.x = cvt_pk_bf16(a[0], a[1]); w.y = cvt_pk_bf16(a[2], a[3]); w.z = cvt_pk_bf16(b[0], b[1]); w.w = cvt_pk_bf16(b[2], b[3]); return w; }
__device__ __forceinline__ void rope8(f32x4& a, f32x4& b, const f32x4 c, const f32x4 s) {
    float t1, t2;
    t1 = a[0]; t2 = a[1]; a[0] = t1 * c[0] - t2 * s[0]; a[1] = t2 * c[0] + t1 * s[0];
    t1 = a[2]; t2 = a[3]; a[2] = t1 * c[1] - t2 * s[1]; a[3] = t2 * c[1] + t1 * s[1];
    t1 = b[0]; t2 = b[1]; b[0] = t1 * c[2] - t2 * s[2]; b[1] = t2 * c[2] + t1 * s[2];
    t1 = b[2]; t2 = b[3]; b[2] = t1 * c[3] - t2 * s[3]; b[3] = t2 * c[3] + t1 * s[3];
}
constexpr float NORM_EPS = 1e-6f;

struct EpiIn {
    static constexpr bool PERM = true, AFTER_DRAIN = false;
    bf16_t *Qr, *Kr, *Vr, *Gr, *CQ, *CKV, *Kbuf; const float *cosr, *sinr, *cosm, *sinm; float *ssq_q, *ssq_kv;
    __device__ __forceinline__ void operator()(const f32x4 (&acc)[2][2][4][2], const Unit& u, int wr, int wc, int fr, int fq) const {
        const int pn = u.pn, row0 = u.pm * BM + wr * 64 + fr, cl = wc * 32 + 8 * fq;
        if (pn < 8) {
            bf16_t* O = pn < 4 ? Qr : Kr; const float sc = pn < 4 ? 1.f : 0.08838834764831845f; const int colt = (pn & 3) * 256 + cl;
#pragma unroll
            for (int ai = 0; ai < 2; ++ai)
#pragma unroll
                for (int m = 0; m < 4; ++m) { const int row = row0 + ai * HALF + m * 16;
                    const f32x4 c4 = *(const f32x4*)(cosr + (size_t)row * 64 + (cl >> 1)), s4 = *(const f32x4*)(sinr + (size_t)row * 64 + (cl >> 1));
#pragma unroll
                    for (int bj = 0; bj < 2; ++bj) { f32x4 a = acc[ai][bj][m][0], b = acc[ai][bj][m][1]; rope8(a, b, c4, s4); a = a * sc; b = b * sc;
                        *(u32x4*)(O + (size_t)row * 1024 + colt + bj * HALF) = pack8(a, b); } }
        } else if (pn < 16) {
            const bool isg = pn >= 12; bf16_t* O = isg ? Gr : Vr; const int colt = (pn & 3) * 256 + cl;
#pragma unroll
            for (int ai = 0; ai < 2; ++ai)
#pragma unroll
                for (int m = 0; m < 4; ++m) { const int row = row0 + ai * HALF + m * 16;
#pragma unroll
                    for (int bj = 0; bj < 2; ++bj) { f32x4 a = acc[ai][bj][m][0], b = acc[ai][bj][m][1];
                        if (isg) {
#pragma unroll
                            for (int i = 0; i < 4; ++i) { a[i] = silu_f(a[i]); b[i] = silu_f(b[i]); } }
                        *(u32x4*)(O + (size_t)row * 1024 + colt + bj * HALF) = pack8(a, b); } }
        } else if (pn < 20) {
            bf16_t* O = pn < 18 ? CQ : CKV; float* sq = pn < 18 ? ssq_q : ssq_kv; const int colt = (pn & 1) * 256 + cl;
#pragma unroll
            for (int ai = 0; ai < 2; ++ai)
#pragma unroll
                for (int m = 0; m < 4; ++m) { const int row = row0 + ai * HALF + m * 16; float s = 0.f;
#pragma unroll
                    for (int bj = 0; bj < 2; ++bj) { const f32x4 a = acc[ai][bj][m][0], b = acc[ai][bj][m][1];
                        s += (a[0] * a[0] + a[1] * a[1]) + (a[2] * a[2] + a[3] * a[3]) + (b[0] * b[0] + b[1] * b[1]) + (b[2] * b[2] + b[3] * b[3]);
                        *(u32x4*)(O + (size_t)row * 512 + colt + bj * HALF) = pack8(a, b); }
                    s += __shfl_xor(s, 16); s += __shfl_xor(s, 32);
                    if (fq == 0) atomicAdd(sq + row, s); }
        } else {
            if (wc < 2) {
#pragma unroll
                for (int ai = 0; ai < 2; ++ai)
#pragma unroll
                    for (int m = 0; m < 4; ++m) { const int row = row0 + ai * HALF + m * 16;
                        const f32x4 c4 = *(const f32x4*)(cosm + (size_t)row * 32 + (cl >> 1)), s4 = *(const f32x4*)(sinm + (size_t)row * 32 + (cl >> 1));
                        f32x4 a = acc[ai][0][m][0], b = acc[ai][0][m][1]; rope8(a, b, c4, s4); const u32x4 w = pack8(a, b);
#pragma unroll
                        for (int h = 0; h < 8; ++h) *(u32x4*)(Kbuf + (size_t)row * 1536 + h * 192 + 128 + cl) = w; }
            }
        }
    }
};
struct EpiUpQ {
    static constexpr bool PERM = true, AFTER_DRAIN = false;
    const float* ssq; bf16_t* Qm; const float *cosm, *sinm;
    __device__ __forceinline__ void operator()(const f32x4 (&acc)[2][2][4][2], const Unit& u, int wr, int wc, int fr, int fq) const {
        const int row0 = u.pm * BM + wr * 64 + fr, cl = wc * 32 + 8 * fq;
#pragma unroll
        for (int ai = 0; ai < 2; ++ai)
#pragma unroll
            for (int m = 0; m < 4; ++m) { const int row = row0 + ai * HALF + m * 16; const float rstd = rsqrtf(ssq[row] * (1.f / 512.f) + NORM_EPS);
#pragma unroll
                for (int bj = 0; bj < 2; ++bj) { const int c = u.pn * 256 + bj * HALF + cl, d = c % 192; f32x4 a = acc[ai][bj][m][0] * rstd, b = acc[ai][bj][m][1] * rstd;
                    if (d >= 128) { const int fi = (d - 128) >> 1; const f32x4 c4 = *(const f32x4*)(cosm + (size_t)row * 32 + fi), s4 = *(const f32x4*)(sinm + (size_t)row * 32 + fi); rope8(a, b, c4, s4); }
                    *(u32x4*)(Qm + (size_t)row * 1536 + c) = pack8(a, b); } }
    }
};
struct EpiUpKV {
    static constexpr bool PERM = true, AFTER_DRAIN = false;
    const float* ssq; bf16_t *Kbuf, *Vm;
    __device__ __forceinline__ void operator()(const f32x4 (&acc)[2][2][4][2], const Unit& u, int wr, int wc, int fr, int fq) const {
        const int row0 = u.pm * BM + wr * 64 + fr, cl = wc * 32 + 8 * fq;
#pragma unroll
        for (int ai = 0; ai < 2; ++ai)
#pragma unroll
            for (int m = 0; m < 4; ++m) { const int row = row0 + ai * HALF + m * 16; const float rstd = rsqrtf(ssq[row] * (1.f / 512.f) + NORM_EPS);
                *(u32x4*)(Kbuf + (size_t)row * 1536 + u.pn * 192 + cl) = pack8(acc[ai][0][m][0] * rstd, acc[ai][0][m][1] * rstd);
                *(u32x4*)(Vm + (size_t)row * 1024 + u.pn * 128 + cl) = pack8(acc[ai][1][m][0] * rstd, acc[ai][1][m][1] * rstd); }
    }
};
struct EpiGateRes {
    static constexpr bool PERM = true, AFTER_DRAIN = false;
    const float* x; const float* gate; float* out;
    __device__ __forceinline__ void operator()(const f32x4 (&acc)[2][2][4][2], const Unit& u, int wr, int wc, int fr, int fq) const {
        const int row0 = u.pm * BM + wr * 64 + fr, cl = wc * 32 + 8 * fq, b = u.pm >> 4;
#pragma unroll
        for (int bj = 0; bj < 2; ++bj) { const int c = u.pn * 256 + bj * HALF + cl;
            const f32x4 g0 = *(const f32x4*)(gate + (size_t)b * 12288 + c), g1 = *(const f32x4*)(gate + (size_t)b * 12288 + c + 4);
#pragma unroll
            for (int ai = 0; ai < 2; ++ai)
#pragma unroll
                for (int m = 0; m < 4; ++m) { const size_t off = (size_t)(row0 + ai * HALF + m * 16) * 2048 + c;
                    const f32x4 x0 = *(const f32x4*)(x + off), x1 = *(const f32x4*)(x + off + 4);
                    *(f32x4*)(out + off) = x0 + g0 * acc[ai][bj][m][0]; *(f32x4*)(out + off + 4) = x1 + g1 * acc[ai][bj][m][1]; } }
    }
};
struct EpiGU {
    static constexpr bool PERM = true, AFTER_DRAIN = false;
    bf16_t* Aff;
    __device__ __forceinline__ void operator()(const f32x4 (&acc)[2][2][4][2], const Unit& u, int wr, int wc, int fr, int fq) const {
        const int row0 = u.pm * BM + wr * 64 + fr, cl = wc * 32 + 8 * fq;
#pragma unroll
        for (int ai = 0; ai < 2; ++ai)
#pragma unroll
            for (int m = 0; m < 4; ++m) { const int row = row0 + ai * HALF + m * 16; f32x4 a, b;
#pragma unroll
                for (int i = 0; i < 4; ++i) { a[i] = silu_f(acc[ai][0][m][0][i]) * acc[ai][1][m][0][i]; b[i] = silu_f(acc[ai][0][m][1][i]) * acc[ai][1][m][1][i]; }
                *(u32x4*)(Aff + (size_t)row * 5632 + u.pn * 128 + cl) = pack8(a, b); }
    }
};

template <class Epi, class Sched, bool ALIGN_EPI = false, bool SP2 = false>
__device__ __forceinline__ void gemm_phase(PG8_LAS unsigned char* lds, const Gemm g, const Sched& S, const Epi& E) {
    const int tid = threadIdx.x, wid = __builtin_amdgcn_readfirstlane(tid >> 6), lane = tid & 63, wr = wid >> 2, wc = wid & 3, fr = lane & 15, fq = lane >> 4;
    const int K = g.K, nt = K / BK;
    unsigned voffA[2], voffB[2];
#pragma unroll
    for (int i = 0; i < 2; ++i) { int R, C; stage_rc(tid * 16 + i * 8192, R, C); const int Rb = Epi::PERM ? ((R & ~31) + perm32(R & 31)) : R;
        voffA[i] = (unsigned)(R * K + C) * 2u; voffB[i] = (unsigned)(Rb * K + C) * 2u; }
    const size_t kstep = (size_t)(BK * 2);
    const size_t hstep = (size_t)HALF * K * 2;
    const size_t tstep = 2 * hstep;
    const unsigned ldsw = (unsigned)wid * 1024u;
    const int aoff = lds_byte(wr * 64 + fr, fq * 8), boff = lds_byte(wc * 32 + fr, fq * 8);
#define PG8_SA(b, h) (((b) * 2 + (h)) * HTB)
#define PG8_SB(b, h) ((4 + (b) * 2 + (h)) * HTB)
#define PG8_STAGE(bufoff, gbase, voff) do { _Pragma("unroll") for (int _i = 0; _i < 2; ++_i) \
        __builtin_amdgcn_global_load_lds((const unsigned*)((const char*)(gbase) + (voff)[_i]), (PG8_LAS unsigned*)(lds + (bufoff) + ldsw + _i * 8192), 16, 0, 0); } while (0)
#define PG8_LDA(dst, b, h) do { _Pragma("unroll") for (int m = 0; m < 4; ++m) _Pragma("unroll") for (int k = 0; k < 2; ++k) dst[m][k] = *(const PG8_LAS bf16x8*)(lds + PG8_SA(b, h) + aoff + m * 2048 + k * 1024); } while (0)
#define PG8_LDB(dst, b, h) do { _Pragma("unroll") for (int n = 0; n < 2; ++n) _Pragma("unroll") for (int k = 0; k < 2; ++k) dst[n][k] = *(const PG8_LAS bf16x8*)(lds + PG8_SB(b, h) + boff + n * 2048 + k * 1024); } while (0)
#define PG8_MMA(ai, bj, At, Bt) do { __builtin_amdgcn_s_setprio(1); _Pragma("unroll") for (int m = 0; m < 4; ++m) _Pragma("unroll") for (int n = 0; n < 2; ++n) _Pragma("unroll") for (int k = 0; k < 2; ++k) \
        acc[ai][bj][m][n] = __builtin_amdgcn_mfma_f32_16x16x32_bf16(Bt[n][k], At[m][k], acc[ai][bj][m][n], 0, 0, 0); __builtin_amdgcn_s_setprio(0); } while (0)
#define PG8_WAIT_V(n) asm volatile("s_waitcnt vmcnt(" #n ")" ::: "memory")
#define PG8_WAIT_L(n) asm volatile("s_waitcnt lgkmcnt(" #n ")" ::: "memory")
#define PG8_BAR __builtin_amdgcn_s_barrier()
#define PG8_SCHED __builtin_amdgcn_sched_barrier(0)
    Unit cur, nxt; int ui = 0;
    if (!S.next(0, cur)) return;
    f32x4 acc[2][2][4][2];
#pragma unroll
    for (int a = 0; a < 2; ++a)
#pragma unroll
        for (int b = 0; b < 2; ++b)
#pragma unroll
            for (int m = 0; m < 4; ++m)
#pragma unroll
                for (int n = 0; n < 2; ++n) acc[a][b][m][n] = (f32x4){0.f, 0.f, 0.f, 0.f};
    bf16x8 At[4][2], B0[2][2], B1[2][2];
    const char* cA = (const char*)g.A + (size_t)cur.pm * tstep; const char* cB = (const char*)g.Bt + (size_t)cur.pn * tstep;
    S.a_ready(cur);
    if constexpr (SP2) {
        PG8_STAGE(PG8_SB(0, 0), cB, voffB); PG8_STAGE(PG8_SB(0, 1), cB + hstep, voffB); PG8_STAGE(PG8_SA(0, 0), cA, voffA); PG8_STAGE(PG8_SA(0, 1), cA + hstep, voffA);
        if (wr == 1) PG8_BAR;
        PG8_WAIT_V(2); PG8_BAR;
        PG8_STAGE(PG8_SB(1, 0), cB + kstep, voffB); PG8_STAGE(PG8_SA(1, 0), cA + kstep, voffA); PG8_STAGE(PG8_SB(1, 1), cB + hstep + kstep, voffB);
        PG8_WAIT_V(6); PG8_BAR;
    } else {
        PG8_STAGE(PG8_SB(0, 0), cB, voffB); PG8_STAGE(PG8_SA(0, 0), cA, voffA); PG8_STAGE(PG8_SB(0, 1), cB + hstep, voffB); PG8_STAGE(PG8_SA(0, 1), cA + hstep, voffA);
        if (wr == 1) PG8_BAR;
        PG8_WAIT_V(4); PG8_BAR;
        PG8_STAGE(PG8_SB(1, 0), cB + kstep, voffB); PG8_STAGE(PG8_SA(1, 0), cA + kstep, voffA); PG8_STAGE(PG8_SB(1, 1), cB + hstep + kstep, voffB);
        PG8_WAIT_V(6); PG8_BAR;
    }
    for (;;) {
        const bool has_next = S.next(ui + 1, nxt);
        const char* nA = has_next ? (const char*)g.A + (size_t)nxt.pm * tstep : cA; const char* nB = has_next ? (const char*)g.Bt + (size_t)nxt.pn * tstep : cB;
        for (int t = 0; t < nt; t += 2) {
            const bool last = (t == nt - 2);
            const char* a1 = cA + (size_t)(t + 1) * kstep;
            const char* a2 = last ? nA : cA + (size_t)(t + 2) * kstep; const char* b2 = last ? nB : cB + (size_t)(t + 2) * kstep;
            const char* a3 = a2 + kstep; const char* b3 = b2 + kstep;
            if (last && has_next) S.a_ready(nxt);
            if constexpr (SP2) {
            PG8_LDB(B0, 0, 0); PG8_LDB(B1, 0, 1); PG8_SCHED; PG8_LDA(At, 0, 0); PG8_STAGE(PG8_SA(1, 1), a1 + hstep, voffA);
            PG8_WAIT_V(8); PG8_WAIT_L(0); PG8_BAR; PG8_MMA(0, 0, At, B0); PG8_MMA(0, 1, At, B1); PG8_BAR; PG8_SCHED;
            PG8_LDA(At, 0, 1); PG8_STAGE(PG8_SB(0, 0), b2, voffB); PG8_STAGE(PG8_SB(0, 1), b2 + hstep, voffB); PG8_STAGE(PG8_SA(0, 0), a2, voffA);
            PG8_WAIT_V(8); PG8_WAIT_L(0); PG8_BAR; PG8_MMA(1, 0, At, B0); PG8_MMA(1, 1, At, B1); PG8_BAR; PG8_SCHED;
            PG8_LDB(B0, 1, 0); PG8_LDB(B1, 1, 1); PG8_SCHED; PG8_LDA(At, 1, 0); PG8_STAGE(PG8_SA(0, 1), a2 + hstep, voffA);
            PG8_WAIT_V(8); PG8_WAIT_L(0); PG8_BAR; PG8_MMA(0, 0, At, B0); PG8_MMA(0, 1, At, B1); PG8_BAR; PG8_SCHED;
            PG8_LDA(At, 1, 1); PG8_STAGE(PG8_SB(1, 0), b3, voffB); PG8_STAGE(PG8_SB(1, 1), b3 + hstep, voffB); PG8_STAGE(PG8_SA(1, 0), a3, voffA);
            PG8_WAIT_V(8); PG8_WAIT_L(0); PG8_BAR; PG8_MMA(1, 0, At, B0); PG8_MMA(1, 1, At, B1); PG8_BAR; PG8_SCHED;
            } else {
            PG8_LDB(B0, 0, 0); PG8_SCHED; PG8_LDA(At, 0, 0); PG8_STAGE(PG8_SA(1, 1), a1 + hstep, voffA);
            PG8_WAIT_L(8); PG8_BAR; PG8_WAIT_L(0); PG8_MMA(0, 0, At, B0); PG8_BAR; PG8_SCHED;
            PG8_LDB(B1, 0, 1); PG8_STAGE(PG8_SB(0, 0), b2, voffB);
            PG8_BAR; PG8_WAIT_L(0); PG8_MMA(0, 1, At, B1); PG8_BAR;
            PG8_LDA(At, 0, 1); PG8_STAGE(PG8_SA(0, 0), a2, voffA);
            PG8_BAR; PG8_WAIT_L(0); PG8_MMA(1, 0, At, B0); PG8_BAR; PG8_SCHED;
            PG8_STAGE(PG8_SB(0, 1), b2 + hstep, voffB);
            PG8_WAIT_V(6); PG8_BAR; PG8_MMA(1, 1, At, B1); PG8_BAR;
            PG8_LDB(B0, 1, 0); PG8_SCHED; PG8_LDA(At, 1, 0); PG8_STAGE(PG8_SA(0, 1), a2 + hstep, voffA);
            PG8_WAIT_L(8); PG8_BAR; PG8_WAIT_L(0); PG8_MMA(0, 0, At, B0); PG8_BAR; PG8_SCHED;
            PG8_LDB(B1, 1, 1); PG8_STAGE(PG8_SB(1, 0), b3, voffB);
            PG8_BAR; PG8_WAIT_L(0); PG8_MMA(0, 1, At, B1); PG8_BAR;
            PG8_LDA(At, 1, 1); PG8_STAGE(PG8_SA(1, 0), a3, voffA);
            PG8_BAR; PG8_WAIT_L(0); PG8_MMA(1, 0, At, B0); PG8_BAR; PG8_SCHED;
            PG8_STAGE(PG8_SB(1, 1), b3 + hstep, voffB);
            PG8_WAIT_V(6); PG8_BAR; PG8_MMA(1, 1, At, B1); PG8_BAR;
            }
        }
        if constexpr (ALIGN_EPI) { if (wr == 0) PG8_BAR; }
        if constexpr (!Epi::AFTER_DRAIN) { E(acc, cur, wr, wc, fr, fq); S.done(cur); }
        if (!has_next) break;
#pragma unroll
        for (int a = 0; a < 2; ++a)
#pragma unroll
            for (int b = 0; b < 2; ++b)
#pragma unroll
                for (int m = 0; m < 4; ++m)
#pragma unroll
                    for (int n = 0; n < 2; ++n) acc[a][b][m][n] = (f32x4){0.f, 0.f, 0.f, 0.f};
        cur = nxt; cA = nA; cB = nB; ++ui;
        if constexpr (ALIGN_EPI) { if (wr == 1) PG8_BAR; }
    }
    PG8_WAIT_V(0);
    if constexpr (!ALIGN_EPI) { if (wr == 0) PG8_BAR; }
    PG8_BAR;
    if constexpr (Epi::AFTER_DRAIN) { E.fused(acc, cur, wr, wc, fr, fq, lds, wid, lane); S.done(cur); }
#undef PG8_SA
#undef PG8_SB
#undef PG8_STAGE
#undef PG8_LDA
#undef PG8_LDB
#undef PG8_MMA
#undef PG8_WAIT_V
#undef PG8_WAIT_L
#undef PG8_BAR
#undef PG8_SCHED
}
}

namespace att {
typedef unsigned short bf16_t;
using bf16x8 = __attribute__((ext_vector_type(8))) short;
using s16x4  = __attribute__((ext_vector_type(4))) short;
using f32x16 = __attribute__((ext_vector_type(16))) float;
using f32x4  = __attribute__((ext_vector_type(4))) float;
using u32x4  = __attribute__((ext_vector_type(4))) unsigned;
using u32x2  = __attribute__((ext_vector_type(2))) unsigned;
constexpr int NW = 8, QBLK = 32, KVBLK = 64;
constexpr int LDQ = 1536, LDK = 1536, LDV = 1024, LDO = 1024;
constexpr float SCALE = 0.07216878364870323f;
constexpr float THR = 8.f;
constexpr int NQR = 8;
constexpr int SHM_V = KVBLK * 128 * 2, SHM_K = KVBLK * 192 * 2, SHM_ATTN = 2 * SHM_V + 2 * SHM_K + NW * 64 * 4;
#define AKSWZ(row, colB) ((row) * 384 + ((colB) ^ (((((row) >> 1) & 3) | (((row) >> 2) & 4)) << 4)))
#define KSWZ128(row, colB) ((row) * 256 + ((colB) ^ (((row) & 15) << 4)))
#define SBAR() __builtin_amdgcn_sched_barrier(0)
#define GAS __attribute__((address_space(1)))
__device__ __forceinline__ const GAS char* uniform_ptr(const void* p) { const unsigned long long v = (unsigned long long)p; const unsigned lo = __builtin_amdgcn_readfirstlane((unsigned)v), hi = __builtin_amdgcn_readfirstlane((unsigned)(v >> 32)); return (const GAS char*)(((unsigned long long)hi << 32) | lo); }
__device__ __forceinline__ int crow(int r, int hi) { return (r & 3) + 8 * (r >> 2) + 4 * hi; }
__device__ __forceinline__ unsigned cvtpk(float lo, float hi) { unsigned r; asm volatile("v_cvt_pk_bf16_f32 %0, %1, %2" : "=v"(r) : "v"(lo), "v"(hi)); return pg8::coarse2(r); }
__device__ __forceinline__ float swap_sum(float v) { auto rr = __builtin_amdgcn_permlane32_swap(__float_as_uint(v), __float_as_uint(v), false, false); return __uint_as_float(rr[0]) + __uint_as_float(rr[1]); }

__device__ __forceinline__ void partialSM(f32x16& p0, f32x16& p1, float& m_reg, float& mn, float& alpha) {
  constexpr float C = SCALE * 1.4426950408889634f;
  float pmax = p0[0];
#pragma unroll
  for (int r = 1; r < 16; ++r) pmax = fmaxf(pmax, p0[r]);
#pragma unroll
  for (int r = 0; r < 16; ++r) pmax = fmaxf(pmax, p1[r]);
  { auto rr = __builtin_amdgcn_permlane32_swap(__float_as_uint(pmax), __float_as_uint(pmax), false, false);
    pmax = fmaxf(__uint_as_float(rr[0]), __uint_as_float(rr[1])); }
  if (__builtin_expect(__all(pmax - m_reg <= THR / SCALE), 1)) { mn = m_reg; alpha = 1.f; }
  else { mn = fmaxf(m_reg, pmax); alpha = __builtin_amdgcn_exp2f((m_reg - mn) * C); m_reg = mn; }
  float mnC = -mn * C;
#pragma unroll
  for (int r = 0; r < 16; ++r) p0[r] = fmaf(p0[r], C, mnC);
#pragma unroll
  for (int r = 0; r < 16; ++r) p1[r] = fmaf(p1[r], C, mnC);
#pragma unroll
  for (int r = 0; r < 16; ++r) p0[r] = __builtin_amdgcn_exp2f(p0[r]);
}
#define PK4(P, BASE, OUT) do { unsigned a0 = cvtpk(P[BASE + 0], P[BASE + 1]), a1 = cvtpk(P[BASE + 2], P[BASE + 3]);   \
    unsigned b0 = cvtpk(P[BASE + 4], P[BASE + 5]), b1 = cvtpk(P[BASE + 6], P[BASE + 7]);                              \
    auto r0 = __builtin_amdgcn_permlane32_swap(a0, b0, false, false); auto r1 = __builtin_amdgcn_permlane32_swap(a1, b1, false, false); \
    u32x4 w = {r0[0], r1[0], r0[1], r1[1]}; OUT = *reinterpret_cast<bf16x8*>(&w); } while (0)
__device__ __forceinline__ void finishSM(f32x16& p0, f32x16& p1, float alpha, float& l_reg, bf16x8& pa0, bf16x8& pa1, bf16x8& pa2, bf16x8& pa3) {
#pragma unroll
  for (int r = 0; r < 16; ++r) p1[r] = __builtin_amdgcn_exp2f(p1[r]);
  float ps = 0;
#pragma unroll
  for (int r = 0; r < 16; ++r) ps += p0[r];
#pragma unroll
  for (int r = 0; r < 16; ++r) ps += p1[r];
  ps = swap_sum(ps);
  l_reg = l_reg * alpha + ps;
  PK4(p0, 0, pa0); PK4(p0, 8, pa1); PK4(p1, 0, pa2); PK4(p1, 8, pa3);
}
__device__ __forceinline__ void qkt192(f32x16& p0, f32x16& p1, const char* Ks, const bf16x8 (&qr)[NQR], const char* Qs, int r32, int hi) {
  p0 = f32x16{}; p1 = f32x16{};
  __builtin_amdgcn_s_setprio(1);
#pragma unroll
  for (int d0 = 0; d0 < 12; ++d0) { int cb = (d0 * 16 + hi * 8) * 2;
    bf16x8 b0 = *reinterpret_cast<const bf16x8*>(Ks + AKSWZ(r32, cb));
    bf16x8 b1 = *reinterpret_cast<const bf16x8*>(Ks + AKSWZ(32 + r32, cb));
    bf16x8 qv; if (d0 < NQR) qv = qr[d0 < NQR ? d0 : 0]; else qv = *reinterpret_cast<const bf16x8*>(Qs + (d0 - NQR) * 1024);
    p0 = __builtin_amdgcn_mfma_f32_32x32x16_bf16(b0, qv, p0, 0, 0, 0);
    p1 = __builtin_amdgcn_mfma_f32_32x32x16_bf16(b1, qv, p1, 0, 0, 0); }
  __builtin_amdgcn_s_setprio(0);
}
__device__ __forceinline__ void qkt128(f32x16& p0, f32x16& p1, const char* Ks, const bf16x8 (&qr)[8], int r32, int hi) {
  p0 = f32x16{}; p1 = f32x16{};
#pragma unroll
  for (int d0 = 0; d0 < 8; ++d0) { int cb = (d0 * 16 + hi * 8) * 2;
    bf16x8 b0 = *reinterpret_cast<const bf16x8*>(Ks + KSWZ128(r32, cb));
    bf16x8 b1 = *reinterpret_cast<const bf16x8*>(Ks + KSWZ128(32 + r32, cb));
    p0 = __builtin_amdgcn_mfma_f32_32x32x16_bf16(b0, qr[d0], p0, 0, 0, 0);
    p1 = __builtin_amdgcn_mfma_f32_32x32x16_bf16(b1, qr[d0], p1, 0, 0, 0); }
}
__device__ __forceinline__ int v_st(int k, int c) { const int kk = (k & ~0xC) | ((k & 4) << 1) | ((k & 8) >> 1); return ((kk >> 3) * 4 + (c >> 5)) * 512 + ((kk & 7) * 32 + (c & 31)) * 2; }
__device__ __forceinline__ int v_rd_base(int lane) { return ((lane & 3) << 3) | (((lane >> 2) & 3) << 6) | (((lane >> 4) & 1) << 5) | (((lane >> 5) & 1) << 8); }
constexpr int v_rd_off(int d0, int ks, int half) { return d0 * 512 + ks * 4096 + half * 2048; }
template <int OFF> __device__ __forceinline__ s16x4 tr_read(int vb) {
  s16x4 r; asm volatile("ds_read_b64_tr_b16 %0, %1 offset:%2" : "=&v"(r) : "v"(vb), "i"(OFF) : "memory"); return r;
}
#define PKLH(L, H) (bf16x8){L[0], L[1], L[2], L[3], H[0], H[1], H[2], H[3]}
template <int D0> __device__ __forceinline__ void pv_one(f32x16& od, int vb, bf16x8 pa0, bf16x8 pa1, bf16x8 pa2, bf16x8 pa3) {
  const s16x4 l0 = tr_read<v_rd_off(D0, 0, 0)>(vb), h0 = tr_read<v_rd_off(D0, 0, 1)>(vb), l1 = tr_read<v_rd_off(D0, 1, 0)>(vb), h1 = tr_read<v_rd_off(D0, 1, 1)>(vb);
  const s16x4 l2 = tr_read<v_rd_off(D0, 2, 0)>(vb), h2 = tr_read<v_rd_off(D0, 2, 1)>(vb), l3 = tr_read<v_rd_off(D0, 3, 0)>(vb), h3 = tr_read<v_rd_off(D0, 3, 1)>(vb);
  asm volatile("s_waitcnt lgkmcnt(0)" ::: "memory"); SBAR();
  __builtin_amdgcn_s_setprio(1);
  od = __builtin_amdgcn_mfma_f32_32x32x16_bf16(pa0, PKLH(l0, h0), od, 0, 0, 0);
  od = __builtin_amdgcn_mfma_f32_32x32x16_bf16(pa1, PKLH(l1, h1), od, 0, 0, 0);
  od = __builtin_amdgcn_mfma_f32_32x32x16_bf16(pa2, PKLH(l2, h2), od, 0, 0, 0);
  od = __builtin_amdgcn_mfma_f32_32x32x16_bf16(pa3, PKLH(l3, h3), od, 0, 0, 0);
  __builtin_amdgcn_s_setprio(0);
}
__device__ __forceinline__ void pv_d0(f32x16* o, int vb, bf16x8 pa0, bf16x8 pa1, bf16x8 pa2, bf16x8 pa3) {
  pv_one<0>(o[0], vb, pa0, pa1, pa2, pa3); pv_one<1>(o[1], vb, pa0, pa1, pa2, pa3); pv_one<2>(o[2], vb, pa0, pa1, pa2, pa3); pv_one<3>(o[3], vb, pa0, pa1, pa2, pa3);
}
template <int D0> __device__ __forceinline__ void pvT_one(f32x16& od, int vb, bf16x8 pa0, bf16x8 pa1, bf16x8 pa2, bf16x8 pa3) {
  const s16x4 l0 = tr_read<v_rd_off(D0, 0, 0)>(vb), h0 = tr_read<v_rd_off(D0, 0, 1)>(vb), l1 = tr_read<v_rd_off(D0, 1, 0)>(vb), h1 = tr_read<v_rd_off(D0, 1, 1)>(vb);
  const s16x4 l2 = tr_read<v_rd_off(D0, 2, 0)>(vb), h2 = tr_read<v_rd_off(D0, 2, 1)>(vb), l3 = tr_read<v_rd_off(D0, 3, 0)>(vb), h3 = tr_read<v_rd_off(D0, 3, 1)>(vb);
  asm volatile("s_waitcnt lgkmcnt(0)" ::: "memory"); SBAR();
  od = __builtin_amdgcn_mfma_f32_32x32x16_bf16(PKLH(l0, h0), pa0, od, 0, 0, 0);
  od = __builtin_amdgcn_mfma_f32_32x32x16_bf16(PKLH(l1, h1), pa1, od, 0, 0, 0);
  od = __builtin_amdgcn_mfma_f32_32x32x16_bf16(PKLH(l2, h2), pa2, od, 0, 0, 0);
  od = __builtin_amdgcn_mfma_f32_32x32x16_bf16(PKLH(l3, h3), pa3, od, 0, 0, 0);
}

__device__ __forceinline__ void attn_unit(const bf16_t* __restrict__ Qb, const bf16_t* __restrict__ Kh, const bf16_t* __restrict__ Vh, bf16_t* __restrict__ Ob, int seq, char* lds, int ldsaddr) {
  const int tid = threadIdx.x, wid = tid >> 6, lane = tid & 63, r32 = lane & 31, hi = lane >> 5;
  char* V_lds = lds; char* K_lds = lds + 2 * SHM_V;
  float* ws = (float*)(lds + 2 * SHM_V + 2 * SHM_K) + wid * 64; float* li_l = ws; float* al_l = ws + 32;
  float m_reg = -1e30f, l_reg = 0; f32x16 o[4] = {}; bf16x8 qr[NQR];
  const bf16_t* Qw = Qb + (long)(wid * QBLK + r32) * LDQ + hi * 8;
  char* Qs = lds + SHM_ATTN + wid * ((12 - NQR) * 1024) + lane * 16;
#pragma unroll
  for (int d0 = 0; d0 < NQR; ++d0) qr[d0] = *reinterpret_cast<const bf16x8*>(Qw + d0 * 16);
#pragma unroll
  for (int d0 = NQR; d0 < 12; ++d0) *(bf16x8*)(Qs + (d0 - NQR) * 1024) = *reinterpret_cast<const bf16x8*>(Qw + d0 * 16);
  const int sr = tid >> 4, sc = (tid & 15) * 8, vst0 = v_st(sr, sc), vst1 = v_st(32 + sr, sc);
  unsigned kg0, kg1, kg2; int kl0, kl1, kl2;
  { int p = tid;        int kr = p / 24, kc = (p % 24) * 8; kg0 = (unsigned)(kr * LDK + kc) * 2u; kl0 = AKSWZ(kr, kc * 2);
    p = tid + 512;      kr = p / 24; kc = (p % 24) * 8;     kg1 = (unsigned)(kr * LDK + kc) * 2u; kl1 = AKSWZ(kr, kc * 2);
    p = tid + 1024;     kr = p / 24; kc = (p % 24) * 8;     kg2 = (unsigned)(kr * LDK + kc) * 2u; kl2 = AKSWZ(kr, kc * 2); }
  const unsigned vg0 = (unsigned)(sr * LDV + sc) * 2u, vg1 = (unsigned)((32 + sr) * LDV + sc) * 2u;
  const int vb0 = ldsaddr + v_rd_base(lane);
  bf16x8 vs0, vs1, ks0, ks1, ks2;
#define SLOAD(k0) do { const GAS char* vb_ = uniform_ptr((const char*)Vh + (size_t)(k0) * (LDV * 2)); const GAS char* kb_ = uniform_ptr((const char*)Kh + (size_t)(k0) * (LDK * 2)); \
    vs0 = *(const GAS bf16x8*)(vb_ + vg0); vs1 = *(const GAS bf16x8*)(vb_ + vg1); \
    ks0 = *(const GAS bf16x8*)(kb_ + kg0); ks1 = *(const GAS bf16x8*)(kb_ + kg1); ks2 = *(const GAS bf16x8*)(kb_ + kg2); } while (0)
#define SWRITE(b) do { *(bf16x8*)(V_lds + (b) * SHM_V + vst0) = vs0; *(bf16x8*)(V_lds + (b) * SHM_V + vst1) = vs1; \
    *(bf16x8*)(K_lds + (b) * SHM_K + kl0) = ks0; *(bf16x8*)(K_lds + (b) * SHM_K + kl1) = ks1; *(bf16x8*)(K_lds + (b) * SHM_K + kl2) = ks2; } while (0)
#define SWAIT() asm volatile("s_waitcnt vmcnt(0)" ::: "memory")
#define RESC(a) do { if (__any((a) < 1.f)) { if (hi == 0) al_l[r32] = (a); asm volatile("s_waitcnt lgkmcnt(0)" ::: "memory"); \
    _Pragma("unroll") for (int d = 0; d < 4; ++d) _Pragma("unroll") for (int r = 0; r < 16; ++r) o[d][r] *= al_l[crow(r, hi)]; } } while (0)
  f32x16 pA0, pA1, pB0, pB1; float mnA, mnB, alA, alB; bf16x8 pa0, pa1, pa2, pa3; const int NT = seq / KVBLK;
  __syncthreads();
  SLOAD(0); SWAIT(); SWRITE(0); __syncthreads();
  qkt192(pA0, pA1, K_lds, qr, Qs, r32, hi); partialSM(pA0, pA1, m_reg, mnA, alA);
  SLOAD(KVBLK);
  SWAIT(); SWRITE(1); __syncthreads();
  for (int j = 1; j + 1 < NT; j += 2) {
    SBAR(); qkt192(pB0, pB1, K_lds + SHM_K, qr, Qs, r32, hi);
    finishSM(pA0, pA1, alA, l_reg, pa0, pa1, pa2, pa3); SBAR();
    SLOAD((j + 1) * KVBLK); SBAR();
    pv_d0(o, vb0, pa0, pa1, pa2, pa3); partialSM(pB0, pB1, m_reg, mnB, alB);
    __syncthreads(); SWAIT(); SWRITE(0);
    RESC(alB); __syncthreads();
    SBAR(); qkt192(pA0, pA1, K_lds, qr, Qs, r32, hi);
    finishSM(pB0, pB1, alB, l_reg, pa0, pa1, pa2, pa3); SBAR();
    SLOAD((j + 2) * KVBLK); SBAR();
    pv_d0(o, vb0 + SHM_V, pa0, pa1, pa2, pa3); partialSM(pA0, pA1, m_reg, mnA, alA);
    __syncthreads(); SWAIT(); SWRITE(1);
    RESC(alA); __syncthreads();
  }
  SBAR(); qkt192(pB0, pB1, K_lds + SHM_K, qr, Qs, r32, hi);
  finishSM(pA0, pA1, alA, l_reg, pa0, pa1, pa2, pa3); SBAR();
  pv_d0(o, vb0, pa0, pa1, pa2, pa3); partialSM(pB0, pB1, m_reg, mnB, alB);
  __syncthreads(); RESC(alB);
  finishSM(pB0, pB1, alB, l_reg, pa0, pa1, pa2, pa3); SBAR();
  pv_d0(o, vb0 + SHM_V, pa0, pa1, pa2, pa3);
  if (hi == 0) li_l[r32] = l_reg; asm volatile("s_waitcnt lgkmcnt(0)" ::: "memory");
  float rli[16];
#pragma unroll
  for (int r = 0; r < 16; ++r) rli[r] = __builtin_amdgcn_rcpf(li_l[crow(r, hi)]);
  bf16_t* Ow = Ob + (long)(wid * QBLK) * LDO;
#pragma unroll
  for (int r = 0; r < 16; ++r) { int orow = crow(r, hi);
#pragma unroll
    for (int d0 = 0; d0 < 4; ++d0) Ow[(long)orow * LDO + d0 * 32 + r32] = (bf16_t)(cvtpk(o[d0][r] * rli[r], 0.f) & 0xffffu); }
#undef SLOAD
#undef SWRITE
#undef SWAIT
#undef RESC
}

__device__ __forceinline__ bf16x8 scale8(bf16x8 v, float s) {
  u32x4 w = *reinterpret_cast<u32x4*>(&v), o;
#pragma unroll
  for (int i = 0; i < 4; ++i) o[i] = cvtpk(__uint_as_float(w[i] << 16) * s, __uint_as_float(w[i] & 0xffff0000u) * s);
  return *reinterpret_cast<bf16x8*>(&o);
}
__device__ __forceinline__ s16x4 trr(int addr) { s16x4 r; asm volatile("ds_read_b64_tr_b16 %0, %1" : "=&v"(r) : "v"(addr) : "memory"); return r; }

__device__ __forceinline__ void chunk_kv_unit(const bf16_t* __restrict__ Kc, const bf16_t* __restrict__ Vc, bf16_t* __restrict__ CKf, bf16_t* __restrict__ CKb, float lgf, float lgb, char* lds, int ldsaddr) {
  const int tid = threadIdx.x, wid = tid >> 6, lane = tid & 63, r32 = lane & 31, hi = lane >> 5;
  const int dir = wid >> 2, db = wid & 3, d = 32 * db + r32;
  __syncthreads();
  { const int sr = tid >> 4, sc = (tid & 15) * 8;
#pragma unroll
    for (int i = 0; i < 4; ++i) { const int row = sr + 32 * i;
      *(bf16x8*)(lds + (row >> 6) * 16384 + v_st(row & 63, sc)) = *reinterpret_cast<const bf16x8*>(Vc + (long)row * 1024 + sc);
      *(bf16x8*)(lds + 32768 + row * 272 + sc * 2) = *reinterpret_cast<const bf16x8*>(Kc + (long)row * 1024 + sc); } }
  __syncthreads();
  bf16x8 kb[8];
  int hio = hi; asm volatile("" : "+v"(hio));
  const char* kl = lds + 32768 + (hio * 8) * 272 + d * 2;
#pragma unroll
  for (int ks = 0; ks < 8; ++ks) { u32x4 w;
#pragma unroll
    for (int i = 0; i < 4; ++i) { const int s0 = ks * 16 + hio * 8 + 2 * i;
      const float k0 = __uint_as_float((unsigned)*(const unsigned short*)(kl + (ks * 16 + 2 * i) * 272) << 16), k1 = __uint_as_float((unsigned)*(const unsigned short*)(kl + (ks * 16 + 2 * i + 1) * 272) << 16);
      const float z0 = __builtin_amdgcn_exp2f(dir ? lgb * (float)s0 : lgf * (float)(127 - s0)), z1 = __builtin_amdgcn_exp2f(dir ? lgb * (float)(s0 + 1) : lgf * (float)(126 - s0));
      w[i] = cvtpk(k0 * z0, k1 * z1); }
    kb[ks] = *reinterpret_cast<bf16x8*>(&w); }
  f32x16 acc[4] = {};
  const int vb = ldsaddr + v_rd_base(lane);
  pvT_one<0>(acc[0], vb, kb[0], kb[1], kb[2], kb[3]); pvT_one<1>(acc[1], vb, kb[0], kb[1], kb[2], kb[3]); pvT_one<2>(acc[2], vb, kb[0], kb[1], kb[2], kb[3]); pvT_one<3>(acc[3], vb, kb[0], kb[1], kb[2], kb[3]);
  pvT_one<0>(acc[0], vb + 16384, kb[4], kb[5], kb[6], kb[7]); pvT_one<1>(acc[1], vb + 16384, kb[4], kb[5], kb[6], kb[7]); pvT_one<2>(acc[2], vb + 16384, kb[4], kb[5], kb[6], kb[7]); pvT_one<3>(acc[3], vb + 16384, kb[4], kb[5], kb[6], kb[7]);
  bf16_t* CK = dir ? CKb : CKf;
#pragma unroll
  for (int eb = 0; eb < 4; ++eb)
#pragma unroll
    for (int r = 0; r < 16; ++r) CK[(32 * eb + crow(r, hi)) * 128 + d] = (bf16_t)(cvtpk(acc[eb][r], 0.f) & 0xffffu);
}

#ifndef PROBE_COMP
#define PROBE_COMP 0
#endif
__device__ __forceinline__ void ret_out_unit(const bf16_t* __restrict__ Qc, const bf16_t* __restrict__ Kc, const bf16_t* __restrict__ Vc, const bf16_t* __restrict__ Gc,
                                             const bf16_t* __restrict__ STf, const bf16_t* __restrict__ STb, const float* __restrict__ gnw, const float* __restrict__ gnb,
                                             bf16_t* __restrict__ Oc, float lgf, float lgb, char* lds, int ldsaddr, float* dump = nullptr) {
  const int tid = threadIdx.x, ht = tid & 255, wq = (tid >> 6) & 3, lane = tid & 63, r32 = lane & 31, hi = lane >> 5;
  __syncthreads();
  { const int sr = ht >> 4, sc = (ht & 15) * 8;
#pragma unroll
    for (int i = 0; i < 8; ++i) { const int row = sr + 16 * i, tile = row >> 6, key = row & 63;
      *(bf16x8*)(lds + tile * 16384 + KSWZ128(key, sc * 2)) = *reinterpret_cast<const bf16x8*>(Kc + (long)row * 1024 + sc);
      *(bf16x8*)(lds + 32768 + tile * 16384 + v_st(key, sc)) = *reinterpret_cast<const bf16x8*>(Vc + (long)row * 1024 + sc); } }
  const int c = 32 * wq + r32;
  bf16x8 qr[8];
#pragma unroll
  for (int d0 = 0; d0 < 8; ++d0) qr[d0] = *reinterpret_cast<const bf16x8*>(Qc + (long)c * 1024 + d0 * 16 + hi * 8);
  __syncthreads();
  f32x16 pA0, pA1, pB0, pB1;
  qkt128(pA0, pA1, lds, qr, r32, hi); qkt128(pB0, pB1, lds + 16384, qr, r32, hi);
  int cdec = c; asm volatile("" : "+v"(cdec));
#define DEC(P, JB) do { _Pragma("unroll") for (int r = 0; r < 16; ++r) { const int dl = cdec - ((JB) + crow(r, hi)); \
    P[r] *= __builtin_amdgcn_exp2f(dl >= 0 ? lgf * (float)dl : lgb * (float)(-dl)); } } while (0)
  DEC(pA0, 0); DEC(pA1, 32); DEC(pB0, 64); DEC(pB1, 96);
#undef DEC
  bf16x8 xa0, xa1, xa2, xa3, xb0, xb1, xb2, xb3;
  PK4(pA0, 0, xa0); PK4(pA0, 8, xa1); PK4(pA1, 0, xa2); PK4(pA1, 8, xa3);
  PK4(pB0, 0, xb0); PK4(pB0, 8, xb1); PK4(pB1, 0, xb2); PK4(pB1, 8, xb3);
  f32x16 o[4] = {};
  const int vb = ldsaddr + 32768 + v_rd_base(lane);
  if (PROBE_COMP == 0 || (PROBE_COMP & 1)) {
  pvT_one<0>(o[0], vb, xa0, xa1, xa2, xa3); pvT_one<1>(o[1], vb, xa0, xa1, xa2, xa3); pvT_one<2>(o[2], vb, xa0, xa1, xa2, xa3); pvT_one<3>(o[3], vb, xa0, xa1, xa2, xa3);
  pvT_one<0>(o[0], vb + 16384, xb0, xb1, xb2, xb3); pvT_one<1>(o[1], vb + 16384, xb0, xb1, xb2, xb3); pvT_one<2>(o[2], vb + 16384, xb0, xb1, xb2, xb3); pvT_one<3>(o[3], vb + 16384, xb0, xb1, xb2, xb3);
  }
#pragma unroll
  for (int dir = 0; dir < 2; ++dir) {
    if (PROBE_COMP != 0 && !((PROBE_COMP >> (1 + dir)) & 1)) continue;
    const float xi = __builtin_amdgcn_exp2f(dir == 0 ? lgf * (float)(c + 1) : lgb * (float)(128 - c));
    const bf16_t* ST = dir == 0 ? STf : STb;
    bf16x8 qs[8];
#pragma unroll
    for (int d0 = 0; d0 < 8; ++d0) qs[d0] = scale8(qr[d0], xi);
    const GAS char* stb = uniform_ptr(ST); const unsigned so = (unsigned)(r32 * 128 + hi * 8) * 2u;
#pragma unroll
    for (int eb = 0; eb < 4; ++eb) {
      bf16x8 A[8];
      SBAR();
#pragma unroll
      for (int d0 = 0; d0 < 8; ++d0) A[d0] = *(const GAS bf16x8*)(stb + so + (eb * 32 * 128 + d0 * 16) * 2);
#pragma unroll
      for (int d0 = 0; d0 < 8; ++d0) o[eb] = __builtin_amdgcn_mfma_f32_32x32x16_bf16(A[d0], qs[d0], o[eb], 0, 0, 0);
      SBAR();
    }
  }
  if (PROBE_COMP != 0) {
#pragma unroll
    for (int eb = 0; eb < 4; ++eb)
#pragma unroll
      for (int g = 0; g < 4; ++g) *(f32x4*)(dump + (long)c * 1024 + 32 * eb + 8 * g + 4 * hi) = (f32x4){o[eb][4 * g], o[eb][4 * g + 1], o[eb][4 * g + 2], o[eb][4 * g + 3]};
    return; }
  float s = 0.f;
#pragma unroll
  for (int eb = 0; eb < 4; ++eb)
#pragma unroll
    for (int r = 0; r < 16; ++r) s += o[eb][r];
  const float mu = swap_sum(s) * (1.f / 128.f);
  float q = 0.f;
#pragma unroll
  for (int eb = 0; eb < 4; ++eb)
#pragma unroll
    for (int r = 0; r < 16; ++r) { const float d = o[eb][r] - mu; q += d * d; }
  const float rstd = rsqrtf(swap_sum(q) * (1.f / 128.f) + 1e-6f);
#pragma unroll
  for (int eb = 0; eb < 4; ++eb)
#pragma unroll
    for (int g = 0; g < 4; ++g) { const int e0 = 32 * eb + 8 * g + 4 * hi;
      const f32x4 w4 = *(const f32x4*)(gnw + e0), b4 = *(const f32x4*)(gnb + e0);
      const u32x2 gg = *(const u32x2*)(Gc + (long)c * 1024 + e0);
      const float g0 = __uint_as_float(gg.x << 16), g1 = __uint_as_float(gg.x & 0xffff0000u), g2 = __uint_as_float(gg.y << 16), g3 = __uint_as_float(gg.y & 0xffff0000u);
      const float y0 = ((o[eb][4 * g] - mu) * rstd * w4[0] + b4[0]) * g0, y1 = ((o[eb][4 * g + 1] - mu) * rstd * w4[1] + b4[1]) * g1;
      const float y2 = ((o[eb][4 * g + 2] - mu) * rstd * w4[2] + b4[2]) * g2, y3 = ((o[eb][4 * g + 3] - mu) * rstd * w4[3] + b4[3]) * g3;
      u32x2 w; w.x = cvtpk(y0, y1); w.y = cvtpk(y2, y3);
      *(u32x2*)(Oc + (long)c * 2048 + e0) = w; }
}

__device__ __forceinline__ void ret_brute_unit(const bf16_t* __restrict__ Qh, const bf16_t* __restrict__ Kh, const bf16_t* __restrict__ Vh, const bf16_t* __restrict__ Gc,
                                               const float* __restrict__ gnw, const float* __restrict__ gnb, bf16_t* __restrict__ Oc, int t0, float lgf, float lgb, char* lds, const float* dump = nullptr) {
  const int tid = threadIdx.x, qi = tid >> 2, part = tid & 3, t = t0 + qi;
  float q[32], acc[32];
#pragma unroll
  for (int i = 0; i < 32; ++i) { q[i] = __uint_as_float((unsigned)Qh[(long)t * 1024 + part * 32 + i] << 16); acc[i] = 0.f; }
  for (int s0 = 0; s0 < 4096; s0 += 64) {
    { const int rel = s0 < t0 ? 1 : (s0 >= t0 + 128 ? 2 : 0); if (PROBE_COMP != 0 && ((PROBE_COMP >> rel) & 1)) continue; }
    __syncthreads();
    for (int c = tid; c < 64 * 16; c += 512) { const int r = c >> 4, c8 = (c & 15) * 8;
      *(bf16x8*)(lds + (r * 128 + c8) * 2) = *reinterpret_cast<const bf16x8*>(Kh + (long)(s0 + r) * 1024 + c8);
      *(bf16x8*)(lds + 16384 + (r * 128 + c8) * 2) = *reinterpret_cast<const bf16x8*>(Vh + (long)(s0 + r) * 1024 + c8); }
    __syncthreads();
    for (int j = 0; j < 64; ++j) { const int s = s0 + j; float d = 0.f;
      const unsigned short* kr = (const unsigned short*)(lds + (j * 128 + part * 32) * 2); const unsigned short* vr = (const unsigned short*)(lds + 16384 + (j * 128 + part * 32) * 2);
#pragma unroll
      for (int i = 0; i < 32; ++i) d += q[i] * __uint_as_float((unsigned)kr[i] << 16);
      d += __shfl_xor(d, 1); d += __shfl_xor(d, 2);
      const int dl = t - s; const float w = d * __builtin_amdgcn_exp2f(dl >= 0 ? lgf * (float)dl : lgb * (float)(-dl));
#pragma unroll
      for (int i = 0; i < 32; ++i) acc[i] += w * __uint_as_float((unsigned)vr[i] << 16); }
  }
  if (PROBE_COMP != 0) {
#pragma unroll
    for (int i = 0; i < 32; ++i) acc[i] += dump[(long)qi * 1024 + part * 32 + i]; }
  float sm = 0.f;
#pragma unroll
  for (int i = 0; i < 32; ++i) sm += acc[i];
  sm += __shfl_xor(sm, 1); sm += __shfl_xor(sm, 2); const float mu = sm * (1.f / 128.f);
  float qq = 0.f;
#pragma unroll
  for (int i = 0; i < 32; ++i) { const float dd = acc[i] - mu; qq += dd * dd; }
  qq += __shfl_xor(qq, 1); qq += __shfl_xor(qq, 2); const float rstd = rsqrtf(qq * (1.f / 128.f) + 1e-6f);
#pragma unroll
  for (int i = 0; i < 32; ++i) { const int e = part * 32 + i; const float g = __uint_as_float((unsigned)Gc[(long)qi * 1024 + e] << 16);
    Oc[(long)qi * 2048 + e] = (bf16_t)(cvtpk(((acc[i] - mu) * rstd * gnw[e] + gnb[e]) * g, 0.f) & 0xffffu); }
}
#undef SBAR
}


#ifndef PROBE_BRUTE_RET
#define PROBE_BRUTE_RET 0
#endif
#ifndef MK_SPLIT
#define MK_SPLIT 0
#endif
#define LAS __attribute__((address_space(3)))
#define GASX __attribute__((address_space(1)))
typedef unsigned short bf16_t;
typedef unsigned v4u __attribute__((ext_vector_type(4)));
typedef unsigned v2u __attribute__((ext_vector_type(2)));
typedef float f32x4 __attribute__((ext_vector_type(4)));
typedef short bf16x8 __attribute__((ext_vector_type(8)));

constexpr int BATCH = 8, SEQ = 4096, DM = 2048, T = BATCH * SEQ;
constexpr int INC = 5184, INCP = 5376, DFF = 5632, NMODC = 6 * DM;
constexpr int NPH = 11;
constexpr size_t MiB = 1u << 20;
constexpr size_t WS_CTL = 0, CTL_ZERO_BYTES = 2 * MiB;
constexpr size_t OFF_MOD = 0, OFF_SSQQ = 512 * 1024, OFF_SSQKV = 640 * 1024;
constexpr size_t WS_COSR = 2 * MiB, WS_SINR = 10 * MiB, WS_COSM = 18 * MiB, WS_SINM = 22 * MiB;
constexpr size_t WS_WIN = 26 * MiB, WS_WUQ = 47 * MiB, WS_WUKV = 49 * MiB, WS_WO = 51 * MiB, WS_WGU = 59 * MiB, WS_WDN = 103 * MiB;
constexpr size_t WS_H = 128 * MiB;
constexpr size_t WS_QR = 256 * MiB, WS_KR = 320 * MiB, WS_VR = 384 * MiB, WS_GR = 448 * MiB;
constexpr size_t WS_CQ = 512 * MiB, WS_CKV = 544 * MiB;
constexpr size_t WS_QM = 576 * MiB, WS_KB = 672 * MiB, WS_VM = 768 * MiB, WS_OAT = 832 * MiB, WS_END = 896 * MiB;
constexpr size_t WS_CAT = 576 * MiB;
constexpr size_t WS_AFF = 256 * MiB;
static_assert(WS_AFF + (size_t)T * DFF * 2 <= WS_END && WS_CAT + (size_t)T * 2048 * 2 <= WS_VM, "d_ws map");
constexpr int LDS_BAR_OFF = 150528;
constexpr size_t OFF_XBAR = 1536 * 1024;
constexpr int LDS_BYTES = 150528 + 64;

#define LDS_WAIT() asm volatile("s_waitcnt lgkmcnt(0)" ::: "memory")
__device__ __forceinline__ unsigned f2bf(float f) { unsigned u = __builtin_bit_cast(unsigned, f); return (u + 0x7fffu + ((u >> 16) & 1u)) >> 16; }
__device__ __forceinline__ unsigned pk2(float lo, float hi) { return f2bf(lo) | (f2bf(hi) << 16); }
__device__ __forceinline__ unsigned pk2a(float lo, float hi) { return pg8::coarse2(pk2(lo, hi)); }
__device__ __forceinline__ float wave_sum(float v) {
#pragma unroll
    for (int o = 1; o < 64; o <<= 1) v += __shfl_xor(v, o);
    return v;
}
__device__ __forceinline__ int dest_row(int mapid, int n) {
    switch (mapid) {
    case 1: if (n < 2048) { const int j = n & 127; return (n & ~127) + (j < 64 ? 2 * j : 2 * (j - 64) + 1); }
            if (n < 5120) return n;
            { const int j = n - 5120; return 5120 + (j < 32 ? 2 * j : 2 * (j - 32) + 1); }
    case 2: { const int d = n % 192; if (d < 128) return n; const int j = d - 128; return n - d + 128 + (j < 32 ? 2 * j : 2 * (j - 32) + 1); }
    case 3: return (n >> 7) * 256 + (n & 127);
    case 4: return (n >> 7) * 256 + 128 + (n & 127);
    default: return n;
    }
}
__device__ __forceinline__ void transpose_item(const float* __restrict__ W, int K, int N, bf16_t* __restrict__ WT, const float* __restrict__ kscale, int mapid, LAS float* scr, int item, int lane) {
    const int nblk = N / 32, kb = item / nblk, nb = item % nblk, k0 = 64 * kb, n0 = 32 * nb;
#pragma unroll 8
    for (int i = 0; i < 32; ++i) { const int kk = 2 * i + (lane >> 5); float v = W[(size_t)(k0 + kk) * N + n0 + (lane & 31)]; if (kscale) v *= kscale[k0 + kk]; scr[kk * 33 + (lane & 31)] = v; }
    LDS_WAIT(); asm volatile("" ::: "memory");
    const int c = lane & 7;
#pragma unroll
    for (int j = 0; j < 4; ++j) { const int n = (lane >> 3) + 8 * j; const LAS float* s = scr + (8 * c) * 33 + n;
        v4u o; o.x = pk2(s[0 * 33], s[1 * 33]); o.y = pk2(s[2 * 33], s[3 * 33]); o.z = pk2(s[4 * 33], s[5 * 33]); o.w = pk2(s[6 * 33], s[7 * 33]);
        *(v4u*)(WT + (size_t)dest_row(mapid, n0 + n) * K + k0 + 8 * c) = o; }
    LDS_WAIT(); asm volatile("" ::: "memory");
}
__device__ __forceinline__ void norm_row(const float* xrow, const float* __restrict__ w, const float* __restrict__ shift, const float* __restrict__ scale, bf16_t* ob, float* of, int lane) {
    const f32x4* xr = (const f32x4*)xrow + lane;
    f32x4 v[8]; float s = 0.f;
#pragma unroll
    for (int j = 0; j < 8; ++j) { v[j] = xr[64 * j]; s += (v[j].x * v[j].x + v[j].y * v[j].y) + (v[j].z * v[j].z + v[j].w * v[j].w); }
    const float rstd = rsqrtf(wave_sum(s) * (1.f / 2048.f) + 1e-6f);
#pragma unroll
    for (int j = 0; j < 8; ++j) { const int col = 4 * lane + 256 * j; f32x4 y = v[j] * rstd * *(const f32x4*)(w + col);
        if (shift) y = y * (*(const f32x4*)(scale + col) + 1.f) + *(const f32x4*)(shift + col);
        if (ob) { v2u o; o.x = pk2a(y.x, y.y); o.y = pk2a(y.z, y.w); *(v2u*)(ob + col) = o; } else *(f32x4*)(of + col) = y; }
}

#define XB_TMO      128
#define XB_XCNT(j)  (256  + 64 * (j))
#define XB_XSUB(j)  (1280 + 64 * (j))
#define XB_XGEN(j)  (2304 + 64 * (j))
#define XB_TOP      3328
#define XB_TOPGEN   3392
#define XCD_BAR_WORDS 3456
#define XB_SPIN_CAP (1u << 18)

__device__ __forceinline__ unsigned xb_ld(unsigned* p)              { return __hip_atomic_load(p, __ATOMIC_RELAXED, __HIP_MEMORY_SCOPE_AGENT); }
__device__ __forceinline__ unsigned xb_add(unsigned* p, unsigned v) { return __hip_atomic_fetch_add(p, v, __ATOMIC_RELAXED, __HIP_MEMORY_SCOPE_AGENT); }
__device__ __forceinline__ unsigned xb_xcc_id() { return (unsigned)__builtin_amdgcn_s_getreg((3 << 11) | 20) & 0xFu; }
#define XB_SPIN(cond, bar) do { unsigned _sp = 0; while (cond) { __builtin_amdgcn_s_sleep(1); \
    if ((++_sp & 255u) == 0u) { if (xb_ld(&(bar)[XB_TMO])) break; if (_sp > XB_SPIN_CAP) { atomicAdd(&(bar)[XB_TMO], 1u); break; } } } } while (0)

struct XcdBarrier {
    unsigned* bar; unsigned x;
    volatile LAS unsigned* st;
};

__device__ __forceinline__ XcdBarrier xcd_barrier_post(unsigned* bar, volatile LAS unsigned* st) {
    XcdBarrier b; b.bar = bar; b.x = xb_xcc_id(); b.st = st;
    if (threadIdx.x == 0) (void)xb_add(&bar[XB_XCNT(b.x)], 1u);
    return b;
}
__device__ __forceinline__ void xcd_barrier_complete(unsigned* bar, unsigned x, unsigned& nloc, unsigned& nx) {
    const unsigned G = gridDim.x * gridDim.y * gridDim.z;
    unsigned sum, cnt, mine, sp = 0u;
    for (;;) {
        sum = 0u; cnt = 0u; mine = 0u;
#pragma unroll
        for (unsigned j = 0; j < 16; ++j) { const unsigned c = xb_ld(&bar[XB_XCNT(j)]); sum += c; cnt += (c > 0u) ? 1u : 0u; mine = (j == x) ? c : mine; }
        if (sum == G) break;
        __builtin_amdgcn_s_sleep(1);
        if ((++sp & 255u) == 0u) { if (xb_ld(&bar[XB_TMO])) break; if (sp > XB_SPIN_CAP) { atomicAdd(&bar[XB_TMO], 1u); break; } }
    }
    nloc = mine > 0u ? mine : 1u; nx = cnt > 0u ? cnt : 1u;
}

__device__ __forceinline__ void xcd_barrier(const XcdBarrier& b) {
    asm volatile("s_waitcnt vmcnt(0)" ::: "memory");
    __syncthreads();
    if (threadIdx.x == 0) {
        unsigned* bar = b.bar;
        __builtin_amdgcn_s_waitcnt(0);
        unsigned nloc = b.st[0], nx = b.st[1];
        if (nloc == 0u) { xcd_barrier_complete(bar, b.x, nloc, nx); b.st[0] = nloc; b.st[1] = nx; }
        const unsigned old = xb_add(&bar[XB_XSUB(b.x)], 1u);
        const unsigned gen = old / nloc;
        if (old + 1u == (gen + 1u) * nloc) {
            __builtin_amdgcn_fence(__ATOMIC_RELEASE, "agent");
            asm volatile("s_waitcnt vmcnt(0)" ::: "memory");
            const unsigned og = xb_add(&bar[XB_TOP], 1u);
            const unsigned tg = og / nx;
            if (og + 1u == (tg + 1u) * nx) xb_add(&bar[XB_TOPGEN], 1u);
            else XB_SPIN(xb_ld(&bar[XB_TOPGEN]) == tg, bar);
            __builtin_amdgcn_fence(__ATOMIC_ACQUIRE, "agent");
            xb_add(&bar[XB_XGEN(b.x)], 1u);
            asm volatile("s_waitcnt vmcnt(0)" ::: "memory");
        } else {
            XB_SPIN(xb_ld(&bar[XB_XGEN(b.x)]) == gen, bar);
            __builtin_amdgcn_fence(__ATOMIC_ACQUIRE, "agent");
            asm volatile("s_waitcnt vmcnt(0)" ::: "memory");
        }
    }
    __syncthreads();
}

struct Args { const float* in[21]; float* out; unsigned char* ws; float inv_r[64]; float inv_m[32]; int ph_lo, ph_hi; };
static_assert(sizeof(Args) == 21 * 8 + 16 + 96 * 4 + 8, "Args has no padding");

__global__ void __launch_bounds__(512, 2) mk_fwd(Args a) {
    extern __shared__ __attribute__((aligned(16))) unsigned char smem[];
    cg::grid_group grid = cg::this_grid();
    const int tid = threadIdx.x, lane = tid & 63, wave = __builtin_amdgcn_readfirstlane(tid >> 6);
    const int G = gridDim.x, bx = blockIdx.x, vcu = (G % 8 == 0) ? (bx % 8) * (G / 8) + bx / 8 : bx;
    const int gw = vcu * 8 + wave, NGW = G * 8;
    LAS unsigned char* lds3 = (LAS unsigned char*)smem; char* ldsg = (char*)smem; const int ldsaddr = (int)(unsigned)(uintptr_t)lds3;
    float* out = a.out;
#define WSB() size_t wz_ = 0; asm volatile("" : "+s"(wz_)); unsigned char* ws = a.ws + wz_
#define INP(name, k) const float* name = a.in[k] + wz_
#define WSF(name, off) float* name = (float*)(ws + (off))
#define WSH(name, off) bf16_t* name = (bf16_t*)(ws + (off))
    const int lo = a.ph_lo, hi = a.ph_hi;
    if (tid < 16) ((LAS unsigned*)(lds3 + LDS_BAR_OFF))[tid] = 0u;
    __syncthreads();
    XcdBarrier xbar = xcd_barrier_post((unsigned*)(a.ws + WS_CTL + OFF_XBAR), (volatile LAS unsigned*)(lds3 + LDS_BAR_OFF));
#ifndef PH_MASK
#define PH_MASK 0x7ff
#endif
#define IN(k) (((PH_MASK >> (k)) & 1) && lo <= (k) && (k) < hi)
#define SEAM(k) do { if (IN(k) && IN((k) + 1)) { asm volatile("s_waitcnt vmcnt(0) lgkmcnt(0)" ::: "memory"); grid.sync(); \
    __builtin_amdgcn_fence(__ATOMIC_ACQUIRE, "agent"); asm volatile("s_waitcnt vmcnt(0)" ::: "memory"); } } while (0)
#define SEAMX(k) do { if (IN(k) && IN((k) + 1)) xcd_barrier(xbar); } while (0)

    if (IN(0)) {
        WSB(); WSF(mod, WS_CTL + OFF_MOD); WSF(cosr, WS_COSR); WSF(sinr, WS_SINR); WSF(cosm, WS_COSM); WSF(sinm, WS_SINM);
        WSH(Win, WS_WIN); WSH(Wuq, WS_WUQ); WSH(Wukv, WS_WUKV); WSH(Wo, WS_WO); WSH(Wgu, WS_WGU); WSH(Wdn, WS_WDN);
        INP(cin, 1); INP(ada_w, 3); INP(ada_b, 4); INP(w_in, 6); INP(mla_q_norm_w, 10); INP(w_uq, 11); INP(mla_kv_norm_w, 12); INP(w_ukv, 13); INP(w_o, 15); INP(w_gate, 17); INP(w_up, 18); INP(w_down, 19);
        const int* positions = (const int*)a.in[2] + wz_;
        {
            LAS float* cs = (LAS float*)lds3;
            for (int i = tid; i < 8 * 2048; i += 512) { const int b = i >> 11, k = i & 2047; const float v = cin[i]; cs[k * 8 + b] = v / (1.f + __expf(-v)); }
            __syncthreads();
            for (int task = gw; task < 192 * 16; task += NGW) { const int cb = task % 192, ks = task / 192, col = cb * 64 + lane;
                float acc[8]; const float bias = ks == 0 ? ada_b[col] : 0.f;
#pragma unroll
                for (int b = 0; b < 8; ++b) acc[b] = bias;
                const float* wp = ada_w + (size_t)(ks * 128) * NMODC + col;
                for (int k8 = 0; k8 < 128; k8 += 8) { float wv[8];
#pragma unroll
                    for (int i = 0; i < 8; ++i) wv[i] = wp[(size_t)(k8 + i) * NMODC];
#pragma unroll
                    for (int i = 0; i < 8; ++i) { const LAS f32x4* c4 = (const LAS f32x4*)(cs + (ks * 128 + k8 + i) * 8); const f32x4 c0 = c4[0], c1 = c4[1];
                        acc[0] += c0.x * wv[i]; acc[1] += c0.y * wv[i]; acc[2] += c0.z * wv[i]; acc[3] += c0.w * wv[i]; acc[4] += c1.x * wv[i]; acc[5] += c1.y * wv[i]; acc[6] += c1.z * wv[i]; acc[7] += c1.w * wv[i]; } }
#pragma unroll
                for (int b = 0; b < 8; ++b) atomicAdd(mod + (size_t)b * NMODC + col, acc[b]); }
            __syncthreads();
        }
        {
            LAS float* scr = (LAS float*)(lds3 + wave * 16384);
            constexpr int I_IN = 32 * (INC / 32), I_UQ = 8 * 48, I_UKV = 8 * 64, I_O = 32 * 64, I_G = 32 * (DFF / 32), I_D = (DFF / 64) * 64;
            constexpr int NITEMS = I_IN + I_UQ + I_UKV + I_O + 2 * I_G + I_D;
            for (int it = gw; it < NITEMS; it += NGW) { int r = it;
                if (r < I_IN) { transpose_item(w_in, 2048, INC, Win, nullptr, 1, scr, r, lane); continue; } r -= I_IN;
                if (r < I_UQ) { transpose_item(w_uq, 512, 1536, Wuq, mla_q_norm_w, 2, scr, r, lane); continue; } r -= I_UQ;
                if (r < I_UKV) { transpose_item(w_ukv, 512, 2048, Wukv, mla_kv_norm_w, 0, scr, r, lane); continue; } r -= I_UKV;
                if (r < I_O) { transpose_item(w_o, 2048, 2048, Wo, nullptr, 0, scr, r, lane); continue; } r -= I_O;
                if (r < I_G) { transpose_item(w_gate, 2048, DFF, Wgu, nullptr, 3, scr, r, lane); continue; } r -= I_G;
                if (r < I_G) { transpose_item(w_up, 2048, DFF, Wgu, nullptr, 4, scr, r, lane); continue; } r -= I_G;
                transpose_item(w_down, DFF, 2048, Wdn, nullptr, 0, scr, r, lane); }
            for (int i = bx * 512 + tid; i < (INCP - INC) * 2048 / 8; i += G * 512) *(v4u*)(Win + (size_t)INC * 2048 + (size_t)i * 8) = (v4u){0u, 0u, 0u, 0u};
        }
        {
            for (int i = bx * 512 + tid; i < T * 96; i += G * 512) { const int t = i / 96, j = i % 96; const float pos = (float)positions[t];
                const float inv = j < 64 ? a.inv_r[j] : a.inv_m[j - 64]; const float ang = pos * inv;
                double rev = (double)ang * 0.15915494309189535; rev -= __builtin_rint(rev);
                const double qd = __builtin_rint(rev * 4.0); const double y = (rev - qd * 0.25) * 6.283185307179586; const double y2 = y * y;
                const double sy = y * (1.0 + y2 * (-1.0 / 6 + y2 * (1.0 / 120 + y2 * (-1.0 / 5040 + y2 * (1.0 / 362880 + y2 * (-1.0 / 39916800 + y2 * (1.0 / 6227020800.0)))))));
                const double cy = 1.0 + y2 * (-0.5 + y2 * (1.0 / 24 + y2 * (-1.0 / 720 + y2 * (1.0 / 40320 + y2 * (-1.0 / 3628800 + y2 * (1.0 / 479001600.0 + y2 * (-1.0 / 87178291200.0)))))));
                const int qi = (int)qd & 3;
                const float cv = (float)(qi == 0 ? cy : qi == 1 ? -sy : qi == 2 ? -cy : sy), sv = (float)(qi == 0 ? sy : qi == 1 ? cy : qi == 2 ? -sy : -cy);
                if (j < 64) { cosr[(size_t)t * 64 + j] = cv; sinr[(size_t)t * 64 + j] = sv; } else { cosm[(size_t)t * 32 + j - 64] = cv; sinm[(size_t)t * 32 + j - 64] = sv; } }
        }
    }
    SEAMX(0);
    if (a.ph_hi > 1000) { SEAM(0); }
    if (IN(1)) { WSB(); WSF(mod, WS_CTL + OFF_MOD); WSH(H, WS_H); INP(x, 0); INP(norm1_w, 5);
        for (int m = gw; m < T; m += NGW) { const int b = m >> 12; norm_row(x + (size_t)m * DM, norm1_w, mod + (size_t)b * NMODC, mod + (size_t)b * NMODC + DM, H + (size_t)m * DM, nullptr, lane); } }
    SEAMX(1);
    if (IN(2)) {
        WSB(); WSH(H, WS_H); WSH(Win, WS_WIN); WSH(Qr, WS_QR); WSH(Kr, WS_KR); WSH(Vr, WS_VR); WSH(Gr, WS_GR); WSH(CQ, WS_CQ); WSH(CKV, WS_CKV); WSH(Kbuf, WS_KB);
        WSF(cosr, WS_COSR); WSF(sinr, WS_SINR); WSF(cosm, WS_COSM); WSF(sinm, WS_SINM); WSF(ssq_q, WS_CTL + OFF_SSQQ); WSF(ssq_kv, WS_CTL + OFF_SSQKV);
        pg8::Gemm g{H, Win, T, INCP, DM}; pg8::StaticOrder S; S.init(T, INCP, G, bx);
        pg8::EpiIn E{Qr, Kr, Vr, Gr, CQ, CKV, Kbuf, cosr, sinr, cosm, sinm, ssq_q, ssq_kv};
        pg8::gemm_phase<pg8::EpiIn, pg8::StaticOrder, true, true>(lds3, g, S, E);
    }
    SEAMX(2);
    if (IN(3)) {
        WSB(); WSH(CQ, WS_CQ); WSH(CKV, WS_CKV); WSH(Wuq, WS_WUQ); WSH(Wukv, WS_WUKV); WSH(Qm, WS_QM); WSH(Kbuf, WS_KB); WSH(Vm, WS_VM); WSH(Kr, WS_KR); WSH(Vr, WS_VR); WSH(CK, WS_H);
        WSF(cosm, WS_COSM); WSF(sinm, WS_SINM); WSF(ssq_q, WS_CTL + OFF_SSQQ); WSF(ssq_kv, WS_CTL + OFF_SSQKV); INP(ret_decay, 7);
        { pg8::Gemm g{CQ, Wuq, T, 1536, 512}; pg8::StaticOrder S; S.init(T, 1536, G, bx); pg8::EpiUpQ E{ssq_q, Qm, cosm, sinm};
          pg8::gemm_phase<pg8::EpiUpQ, pg8::StaticOrder, true, true>(lds3, g, S, E); }
        { pg8::Gemm g{CKV, Wukv, T, 2048, 512}; pg8::StaticOrder S; S.init(T, 2048, G, bx); pg8::EpiUpKV E{ssq_kv, Kbuf, Vm};
          pg8::gemm_phase<pg8::EpiUpKV, pg8::StaticOrder, true, true>(lds3, g, S, E); }
        for (int u = vcu; u < 2048; u += G) { const int n = u & 31, h = (u >> 5) & 7, b = u >> 8; const size_t t0 = (size_t)b * SEQ + n * 128;
            const float lgf = -__expf(ret_decay[h]) * 1.4426950408889634f, lgb = -__expf(ret_decay[8 + h]) * 1.4426950408889634f;
            att::chunk_kv_unit(Kr + t0 * 1024 + h * 128, Vr + t0 * 1024 + h * 128, CK + ((size_t)(b * 8 + h) * 32 + n) * 16384, CK + ((size_t)(64 + b * 8 + h) * 32 + n) * 16384, lgf, lgb, ldsg, ldsaddr); }
        __syncthreads();
    }
    SEAMX(3);
    if (IN(4)) {
        WSB(); WSH(Qm, WS_QM); WSH(Kbuf, WS_KB); WSH(Vm, WS_VM); WSH(Oat, WS_OAT); WSH(CK, WS_H); INP(ret_decay, 7);
        for (int u = vcu; u < 1024; u += G) { const int qb = u & 15, h = (u >> 4) & 7, b = u >> 7; const size_t r0 = (size_t)b * SEQ;
            att::attn_unit(Qm + (r0 + qb * 256) * 1536 + h * 192, Kbuf + r0 * 1536 + h * 192, Vm + r0 * 1024 + h * 128, Oat + (r0 + qb * 256) * 1024 + h * 128, SEQ, ldsg, ldsaddr); }
#ifndef NO_SCAN
        for (int idx = bx * 512 + tid; idx < 2 * 64 * 2048; idx += G * 512) { const int dir = idx >> 17, bh = (idx >> 11) & 63, e8 = idx & 2047, h = bh & 7;
            const float cd = __builtin_amdgcn_exp2f(-__expf(ret_decay[dir * 8 + h]) * 1.4426950408889634f * 128.f);
            bf16_t* base = CK + ((size_t)(dir * 64 + bh) * 32) * 16384 + e8 * 8; float st[8];
#pragma unroll
            for (int i = 0; i < 8; ++i) st[i] = 0.f;
            for (int s8 = 0; s8 < 32; s8 += 8) { v4u kv[8];
#pragma unroll
                for (int i = 0; i < 8; ++i) { const int m = dir ? 31 - (s8 + i) : s8 + i; kv[i] = *(const v4u*)(base + (size_t)m * 16384); }
#pragma unroll
                for (int i = 0; i < 8; ++i) { const int m = dir ? 31 - (s8 + i) : s8 + i; v4u o;
                    o.x = pk2a(st[0], st[1]); o.y = pk2a(st[2], st[3]); o.z = pk2a(st[4], st[5]); o.w = pk2a(st[6], st[7]);
                    *(v4u*)(base + (size_t)m * 16384) = o;
#pragma unroll
                    for (int q = 0; q < 4; ++q) { const unsigned w = kv[i][q]; st[2 * q] = st[2 * q] * cd + __uint_as_float(w << 16); st[2 * q + 1] = st[2 * q + 1] * cd + __uint_as_float(w & 0xffff0000u); } } }
        }
#endif
    }
    SEAMX(4);
    if (IN(5)) {
        WSB(); WSH(Qr, WS_QR); WSH(Kr, WS_KR); WSH(Vr, WS_VR); WSH(Gr, WS_GR); WSH(CK, WS_H); WSH(Cat, WS_CAT); WSH(Oat, WS_OAT); INP(ret_decay, 7); INP(ret_gn_w, 8); INP(ret_gn_b, 9); INP(mla_out_w, 14);
#if PROBE_BRUTE_RET
        float* dumpb = (float*)(ws + 704 * MiB);
        for (int up = vcu; up < 1024; up += G) {
            if (PROBE_COMP != 0) { const int u = up * 2 + (wave >> 2); const int n = u & 31, h = (u >> 5) & 7, b = u >> 8; const size_t t0 = (size_t)b * SEQ + n * 128;
                const float lgf = -__expf(ret_decay[h]) * 1.4426950408889634f, lgb = -__expf(ret_decay[8 + h]) * 1.4426950408889634f; const int hf = wave >> 2;
                att::ret_out_unit(Qr + t0 * 1024 + h * 128, Kr + t0 * 1024 + h * 128, Vr + t0 * 1024 + h * 128, Gr + t0 * 1024 + h * 128,
                                  CK + ((size_t)(b * 8 + h) * 32 + n) * 16384, CK + ((size_t)(64 + b * 8 + h) * 32 + n) * 16384, ret_gn_w + h * 128, ret_gn_b + h * 128,
                                  Cat + t0 * 2048 + h * 128, lgf, lgb, ldsg + hf * 65536, ldsaddr + hf * 65536, dumpb + t0 * 1024 + h * 128);
                __threadfence(); __syncthreads(); }
            for (int k2 = 0; k2 < 2; ++k2) { const int u = up * 2 + k2; const int n = u & 31, h = (u >> 5) & 7, b = u >> 8; const size_t r0 = (size_t)b * SEQ, t0 = r0 + n * 128;
                const float lgf = -__expf(ret_decay[h]) * 1.4426950408889634f, lgb = -__expf(ret_decay[8 + h]) * 1.4426950408889634f;
                att::ret_brute_unit(Qr + r0 * 1024 + h * 128, Kr + r0 * 1024 + h * 128, Vr + r0 * 1024 + h * 128, Gr + t0 * 1024 + h * 128, ret_gn_w + h * 128, ret_gn_b + h * 128, Cat + t0 * 2048 + h * 128, n * 128, lgf, lgb, ldsg, dumpb + t0 * 1024 + h * 128); } }
        __syncthreads();
        for (int up = vcu; up < 0; up += G) { const int u = up * 2 + (wave >> 2);
#else
        for (int up = vcu; up < 1024; up += G) { const int u = up * 2 + (wave >> 2);
#endif
            const int n = u & 31, h = (u >> 5) & 7, b = u >> 8; const size_t t0 = (size_t)b * SEQ + n * 128;
            const float lgf = -__expf(ret_decay[h]) * 1.4426950408889634f, lgb = -__expf(ret_decay[8 + h]) * 1.4426950408889634f; const int hf = wave >> 2;
            att::ret_out_unit(Qr + t0 * 1024 + h * 128, Kr + t0 * 1024 + h * 128, Vr + t0 * 1024 + h * 128, Gr + t0 * 1024 + h * 128,
                              CK + ((size_t)(b * 8 + h) * 32 + n) * 16384, CK + ((size_t)(64 + b * 8 + h) * 32 + n) * 16384, ret_gn_w + h * 128, ret_gn_b + h * 128,
                              Cat + t0 * 2048 + h * 128, lgf, lgb, ldsg + hf * 65536, ldsaddr + hf * 65536); }
        for (int m = gw; m < T; m += NGW) {
            const bf16_t* orow = Oat + (size_t)m * 1024; float v[16]; float s = 0.f;
#pragma unroll
            for (int j = 0; j < 2; ++j) { const v4u w = *(const v4u*)(orow + lane * 8 + 512 * j);
#pragma unroll
                for (int q = 0; q < 4; ++q) { v[j * 8 + 2 * q] = __uint_as_float(w[q] << 16); v[j * 8 + 2 * q + 1] = __uint_as_float(w[q] & 0xffff0000u); } }
#pragma unroll
            for (int i = 0; i < 16; ++i) s += v[i] * v[i];
            const float rstd = rsqrtf(wave_sum(s) * (1.f / 1024.f) + 1e-6f);
#pragma unroll
            for (int j = 0; j < 2; ++j) { const int col = lane * 8 + 512 * j; const f32x4 w0 = *(const f32x4*)(mla_out_w + col), w1 = *(const f32x4*)(mla_out_w + col + 4); v4u o;
                o.x = pk2a(v[j * 8 + 0] * rstd * w0.x, v[j * 8 + 1] * rstd * w0.y); o.y = pk2a(v[j * 8 + 2] * rstd * w0.z, v[j * 8 + 3] * rstd * w0.w);
                o.z = pk2a(v[j * 8 + 4] * rstd * w1.x, v[j * 8 + 5] * rstd * w1.y); o.w = pk2a(v[j * 8 + 6] * rstd * w1.z, v[j * 8 + 7] * rstd * w1.w);
                *(v4u*)(Cat + (size_t)m * 2048 + 1024 + col) = o; } }
        __syncthreads();
    }
    SEAMX(5);
    if (IN(6)) {
        WSB(); WSH(Cat, WS_CAT); WSH(Wo, WS_WO); WSF(mod, WS_CTL + OFF_MOD); INP(x, 0);
        pg8::Gemm g{Cat, Wo, T, 2048, 2048}; pg8::StaticOrder S; S.init(T, 2048, G, bx); pg8::EpiGateRes E{x, mod + 2 * DM, out};
        pg8::gemm_phase<pg8::EpiGateRes, pg8::StaticOrder, true, true>(lds3, g, S, E);
    }
    SEAMX(6);
    if (IN(7)) { WSB(); WSF(mod, WS_CTL + OFF_MOD); WSH(H, WS_H); INP(norm2_w, 16);
        for (int m = gw; m < T; m += NGW) { const int b = m >> 12; norm_row(out + (size_t)m * DM, norm2_w, mod + (size_t)b * NMODC + 3 * DM, mod + (size_t)b * NMODC + 4 * DM, H + (size_t)m * DM, nullptr, lane); } }
    SEAMX(7);
    if (IN(8)) {
        WSB(); WSH(H, WS_H); WSH(Wgu, WS_WGU); WSH(Aff, WS_AFF);
        pg8::Gemm g{H, Wgu, T, 2 * DFF, DM}; pg8::StaticOrder S; S.init(T, 2 * DFF, G, bx); pg8::EpiGU E{Aff};
        pg8::gemm_phase<pg8::EpiGU, pg8::StaticOrder, true, true>(lds3, g, S, E);
    }
    SEAMX(8);
    if (IN(9)) {
        WSB(); WSH(Aff, WS_AFF); WSH(Wdn, WS_WDN); WSF(mod, WS_CTL + OFF_MOD);
        pg8::Gemm g{Aff, Wdn, T, 2048, DFF}; pg8::StaticOrder S; S.init(T, 2048, G, bx); pg8::EpiGateRes E{out, mod + 5 * DM, out};
        pg8::gemm_phase<pg8::EpiGateRes, pg8::StaticOrder, true, true>(lds3, g, S, E);
    }
    SEAMX(9);
    if (IN(10)) { WSB(); (void)ws; INP(final_norm_w, 20);
        for (int m = gw; m < T; m += NGW) norm_row(out + (size_t)m * DM, final_norm_w, nullptr, nullptr, nullptr, out + (size_t)m * DM, lane); }
#undef IN
#undef SEAM
}

extern "C" void kernel_launch(void* const* d_in, const int* in_sizes, int n_in, void* d_out, int out_size, void* d_ws, size_t ws_size, hipStream_t stream) {
    static int grid = 0;
    if (grid == 0) {
        if (n_in != 21 || in_sizes[0] != T * DM || out_size != T * DM || ws_size < WS_END) { fprintf(stderr, "kernel_launch: shape/workspace mismatch (n_in %d, ws %zu < %zu)\n", n_in, ws_size, (size_t)WS_END); grid = -1; return; }
        int dev = 0, cus = 0, per_cu = 0;
        (void)hipGetDevice(&dev); (void)hipDeviceGetAttribute(&cus, hipDeviceAttributeMultiprocessorCount, dev);
        if (hipFuncSetAttribute((const void*)mk_fwd, hipFuncAttributeMaxDynamicSharedMemorySize, LDS_BYTES) != hipSuccess) { fprintf(stderr, "kernel_launch: hipFuncSetAttribute failed\n"); grid = -1; return; }
        if (hipOccupancyMaxActiveBlocksPerMultiprocessor(&per_cu, (const void*)mk_fwd, 512, LDS_BYTES) != hipSuccess || per_cu < 1) { fprintf(stderr, "kernel_launch: occupancy query gave %d\n", per_cu); per_cu = 1; }
        (void)hipGetLastError();
        grid = cus * per_cu;
    }
    if (grid < 0) return;
    (void)hipMemsetAsync((char*)d_ws + WS_CTL, 0, CTL_ZERO_BYTES, stream);
    Args a{};
    for (int i = 0; i < 21; ++i) a.in[i] = (const float*)d_in[i];
    a.out = (float*)d_out; a.ws = (unsigned char*)d_ws;
    for (int i = 0; i < 64; ++i) a.inv_r[i] = powf(10000.0f, -((float)(2 * i)) / 128.0f);
    for (int i = 0; i < 32; ++i) a.inv_m[i] = powf(10000.0f, -((float)(2 * i)) / 64.0f);
#if MK_SPLIT
    for (int p = 0; p < NPH; ++p) { a.ph_lo = p; a.ph_hi = p + 1; hipLaunchKernelGGL(mk_fwd, dim3(grid), dim3(512), LDS_BYTES, stream, a); }
#else
    a.ph_lo = 0; a.ph_hi = NPH;
    void* args[] = {&a};
    hipError_t e = hipLaunchCooperativeKernel((const void*)mk_fwd, dim3(grid), dim3(512), args, LDS_BYTES, stream);
    if (e != hipSuccess) fprintf(stderr, "kernel_launch: cooperative launch failed: %s (grid %d)\n", hipGetErrorString(e), grid);
#endif
}
```

```cpp
#include <hip/hip_runtime.h>
#include <hip/hip_cooperative_groups.h>
#include <cstdio>
#include <cstdint>
#include <cmath>
namespace cg = cooperative_groups;
namespace pg8 {
#define PG8_LAS __attribute__((address_space(3)))
typedef unsigned short bf16_t;
typedef short bf16x8 __attribute__((ext_vector_type(8)));
typedef float f32x4 __attribute__((ext_vector_type(4)));
typedef unsigned u32x4 __attribute__((ext_vector_type(4)));
constexpr int BM = 256, BK = 64, HALF = 128, HTB = HALF * BK * 2  , STAGE_BYTES = 8 * HTB, NXCD = 8, WGM = 8;

__host__ __device__ __forceinline__ int lds_byte(int r, int c) { const int st = (r >> 4) * 2 + (c >> 5), rr = r & 15, cc = c & 31, ob = rr * 64 + cc * 2; return st * 1024 + (ob ^ (((ob >> 9) & 1) << 5)); }
__host__ __device__ __forceinline__ void stage_rc(int b, int& R, int& C) { const int st = b / 1024, sb = b % 1024, swz = sb ^ (((sb >> 9) & 1) << 5); R = (st >> 1) * 16 + swz / 64; C = (st & 1) * 32 + (swz % 64) / 2; }
__host__ __device__ __forceinline__ int perm32(int rho) { const int n = rho >> 4, i = rho & 15; return 8 * (i >> 2) + 4 * n + (i & 3); }

struct Unit { int pm, pn; };
struct Gemm { const bf16_t* A; const bf16_t* Bt; int M, N, K; };

struct StaticOrder {
    int nM, nN, nwg, G, c;
    __host__ __device__ void init(int M, int N, int G_, int c_) { nM = M / BM; nN = N / BM; nwg = nM * nN; G = G_; c = c_; }
    __host__ __device__ bool next(int i, Unit& u) const {
        const long L = (long)i * G + c; if (L >= nwg) return false;
        int wgid = (int)L; { const int q = nwg / NXCD, r = nwg % NXCD, xcd = wgid % NXCD, off = wgid / NXCD; wgid = (xcd < r ? xcd * (q + 1) : r * (q + 1) + (xcd - r) * q) + off; }
        const int nig = WGM * nN, gid = wgid / nig, fm = gid * WGM, gsz = (nM - fm) < WGM ? (nM - fm) : WGM;
        u.pm = fm + ((wgid % nig) % gsz); u.pn = (wgid % nig) / gsz; return true;
    }
    __device__ __forceinline__ void a_ready(const Unit&) const {}
    __device__ __forceinline__ void done(const Unit&) const {}
};

#ifndef PROBE_COARSE_ACT
#define PROBE_COARSE_ACT 0
#endif
__device__ __forceinline__ unsigned coarse2(unsigned w) { return PROBE_COARSE_ACT ? ((w + ((w >> 1) & 0x00010001u)) & 0xfffefffeu) : w; }
__device__ __forceinline__ unsigned cvt_pk_bf16(float lo, float hi) { unsigned r; asm volatile("v_cvt_pk_bf16_f32 %0, %1, %2" : "=v"(r) : "v"(lo), "v"(hi)); return coarse2(r); }
typedef float f32x2 __attribute__((ext_vector_type(2)));

typedef unsigned u32x2 __attribute__((ext_vector_type(2)));
__device__ __forceinline__ float silu_f(float v) { return v * __builtin_amdgcn_rcpf(1.f + __builtin_amdgcn_exp2f(v * -1.4426950408889634f)); }
__device__ __forceinline__ u32x4 pack8(f32x4 a, f32x4 b) { u32x4 w; w.x = cvt_pk_bf16(a[0], a[1]); w.y = cvt_pk_bf16(a[2], a[3]); w.z = cvt_pk_bf16(b[0], b[1]); w.w = cvt_pk_bf16(b[2], b[3]); return w; }
__device__ __forceinline__ void rope8(f32x4& a, f32x4& b, const f32x4 c, const f32x4 s) {
    float t1, t2;
    t1 = a[0]; t2 = a[1]; a[0] = t1 * c[0] - t2 * s[0]; a[1] = t2 * c[0] + t1 * s[0];
    t1 = a[2]; t2 = a[3]; a[2] = t1 * c[1] - t2 * s[1]; a[3] = t2 * c[1] + t1 * s[1];
    t1 = b[0]; t2 = b[1]; b[0] = t1 * c[2] - t2 * s[2]; b[1] = t2 * c[2] + t1 * s[2];
    t1 = b[2]; t2 = b[3]; b[2] = t1 * c[3] - t2 * s[3]; b[3] = t2 * c[3] + t1 * s[3];
}
constexpr float NORM_EPS = 1e-6f;

struct EpiIn {
    static constexpr bool PERM = true, AFTER_DRAIN = false;
    bf16_t *Qr, *Kr, *Vr, *Gr, *CQ, *CKV, *Kbuf; const float *cosr, *sinr, *cosm, *sinm; float *ssq_q, *ssq_kv;
    __device__ __forceinline__ void operator()(const f32x4 (&acc)[2][2][4][2], const Unit& u, int wr, int wc, int fr, int fq) const {
        const int pn = u.pn, row0 = u.pm * BM + wr * 64 + fr, cl = wc * 32 + 8 * fq;
        if (pn < 8) {
            bf16_t* O = pn < 4 ? Qr : Kr; const float sc = pn < 4 ? 1.f : 0.08838834764831845f; const int colt = (pn & 3) * 256 + cl;
#pragma unroll
            for (int ai = 0; ai < 2; ++ai)
#pragma unroll
                for (int m = 0; m < 4; ++m) { const int row = row0 + ai * HALF + m * 16;
                    const f32x4 c4 = *(const f32x4*)(cosr + (size_t)row * 64 + (cl >> 1)), s4 = *(const f32x4*)(sinr + (size_t)row * 64 + (cl >> 1));
#pragma unroll
                    for (int bj = 0; bj < 2; ++bj) { f32x4 a = acc[ai][bj][m][0], b = acc[ai][bj][m][1]; rope8(a, b, c4, s4); a = a * sc; b = b * sc;
                        *(u32x4*)(O + (size_t)row * 1024 + colt + bj * HALF) = pack8(a, b); } }
        } else if (pn < 16) {
            const bool isg = pn >= 12; bf16_t* O = isg ? Gr : Vr; const int colt = (pn & 3) * 256 + cl;
#pragma unroll
            for (int ai = 0; ai < 2; ++ai)
#pragma unroll
                for (int m = 0; m < 4; ++m) { const int row = row0 + ai * HALF + m * 16;
#pragma unroll
                    for (int bj = 0; bj < 2; ++bj) { f32x4 a = acc[ai][bj][m][0], b = acc[ai][bj][m][1];
                        if (isg) {
#pragma unroll
                            for (int i = 0; i < 4; ++i) { a[i] = silu_f(a[i]); b[i] = silu_f(b[i]); } }
                        *(u32x4*)(O + (size_t)row * 1024 + colt + bj * HALF) = pack8(a, b); } }
        } else if (pn < 20) {
            bf16_t* O = pn < 18 ? CQ : CKV; float* sq = pn < 18 ? ssq_q : ssq_kv; const int colt = (pn & 1) * 256 + cl;
#pragma unroll
            for (int ai = 0; ai < 2; ++ai)
#pragma unroll
                for (int m = 0; m < 4; ++m) { const int row = row0 + ai * HALF + m * 16; float s = 0.f;
#pragma unroll
                    for (int bj = 0; bj < 2; ++bj) { const f32x4 a = acc[ai][bj][m][0], b = acc[ai][bj][m][1];
                        s += (a[0] * a[0] + a[1] * a[1]) + (a[2] * a[2] + a[3] * a[3]) + (b[0] * b[0] + b[1] * b[1]) + (b[2] * b[2] + b[3] * b[3]);
                        *(u32x4*)(O + (size_t)row * 512 + colt + bj * HALF) = pack8(a, b); }
                    s += __shfl_xor(s, 16); s += __shfl_xor(s, 32);
                    if (fq == 0) atomicAdd(sq + row, s); }
        } else {
            if (wc < 2) {
#pragma unroll
                for (int ai = 0; ai < 2; ++ai)
#pragma unroll
                    for (int m = 0; m < 4; ++m) { const int row = row0 + ai * HALF + m * 16;
                        const f32x4 c4 = *(const f32x4*)(cosm + (size_t)row * 32 + (cl >> 1)), s4 = *(const f32x4*)(sinm + (size_t)row * 32 + (cl >> 1));
                        f32x4 a = acc[ai][0][m][0], b = acc[ai][0][m][1]; rope8(a, b, c4, s4); const u32x4 w = pack8(a, b);
#pragma unroll
                        for (int h = 0; h < 8; ++h) *(u32x4*)(Kbuf + (size_t)row * 1536 + h * 192 + 128 + cl) = w; }
            }
        }
    }
};
struct EpiUpQ {
    static constexpr bool PERM = true, AFTER_DRAIN = false;
    const float* ssq; bf16_t* Qm; const float *cosm, *sinm;
    __device__ __forceinline__ void operator()(const f32x4 (&acc)[2][2][4][2], const Unit& u, int wr, int wc, int fr, int fq) const {
        const int row0 = u.pm * BM + wr * 64 + fr, cl = wc * 32 + 8 * fq;
#pragma unroll
        for (int ai = 0; ai < 2; ++ai)
#pragma unroll
            for (int m = 0; m < 4; ++m) { const int row = row0 + ai * HALF + m * 16; const float rstd = rsqrtf(ssq[row] * (1.f / 512.f) + NORM_EPS);
#pragma unroll
                for (int bj = 0; bj < 2; ++bj) { const int c = u.pn * 256 + bj * HALF + cl, d = c % 192; f32x4 a = acc[ai][bj][m][0] * rstd, b = acc[ai][bj][m][1] * rstd;
                    if (d >= 128) { const int fi = (d - 128) >> 1; const f32x4 c4 = *(const f32x4*)(cosm + (size_t)row * 32 + fi), s4 = *(const f32x4*)(sinm + (size_t)row * 32 + fi); rope8(a, b, c4, s4); }
                    *(u32x4*)(Qm + (size_t)row * 1536 + c) = pack8(a, b); } }
    }
};
struct EpiUpKV {
    static constexpr bool PERM = true, AFTER_DRAIN = false;
    const float* ssq; bf16_t *Kbuf, *Vm;
    __device__ __forceinline__ void operator()(const f32x4 (&acc)[2][2][4][2], const Unit& u, int wr, int wc, int fr, int fq) const {
        const int row0 = u.pm * BM + wr * 64 + fr, cl = wc * 32 + 8 * fq;
#pragma unroll
        for (int ai = 0; ai < 2; ++ai)
#pragma unroll
            for (int m = 0; m < 4; ++m) { const int row = row0 + ai * HALF + m * 16; const float rstd = rsqrtf(ssq[row] * (1.f / 512.f) + NORM_EPS);
                *(u32x4*)(Kbuf + (size_t)row * 1536 + u.pn * 192 + cl) = pack8(acc[ai][0][m][0] * rstd, acc[ai][0][m][1] * rstd);
                *(u32x4*)(Vm + (size_t)row * 1024 + u.pn * 128 + cl) = pack8(acc[ai][1][m][0] * rstd, acc[ai][1][m][1] * rstd); }
    }
};
struct EpiGateRes {
    static constexpr bool PERM = true, AFTER_DRAIN = false;
    const float* x; const float* gate; float* out;
    __device__ __forceinline__ void operator()(const f32x4 (&acc)[2][2][4][2], const Unit& u, int wr, int wc, int fr, int fq) const {
        const int row0 = u.pm * BM + wr * 64 + fr, cl = wc * 32 + 8 * fq, b = u.pm >> 4;
#pragma unroll
        for (int bj = 0; bj < 2; ++bj) { const int c = u.pn * 256 + bj * HALF + cl;
            const f32x4 g0 = *(const f32x4*)(gate + (size_t)b * 12288 + c), g1 = *(const f32x4*)(gate + (size_t)b * 12288 + c + 4);
#pragma unroll
            for (int ai = 0; ai < 2; ++ai)
#pragma unroll
                for (int m = 0; m < 4; ++m) { const size_t off = (size_t)(row0 + ai * HALF + m * 16) * 2048 + c;
                    const f32x4 x0 = *(const f32x4*)(x + off), x1 = *(const f32x4*)(x + off + 4);
                    *(f32x4*)(out + off) = x0 + g0 * acc[ai][bj][m][0]; *(f32x4*)(out + off + 4) = x1 + g1 * acc[ai][bj][m][1]; } }
    }
};
struct EpiGU {
    static constexpr bool PERM = true, AFTER_DRAIN = false;
    bf16_t* Aff;
    __device__ __forceinline__ void operator()(const f32x4 (&acc)[2][2][4][2], const Unit& u, int wr, int wc, int fr, int fq) const {
        const int row0 = u.pm * BM + wr * 64 + fr, cl = wc * 32 + 8 * fq;
#pragma unroll
        for (int ai = 0; ai < 2; ++ai)
#pragma unroll
            for (int m = 0; m < 4; ++m) { const int row = row0 + ai * HALF + m * 16; f32x4 a, b;
#pragma unroll
                for (int i = 0; i < 4; ++i) { a[i] = silu_f(acc[ai][0][m][0][i]) * acc[ai][1][m][0][i]; b[i] = silu_f(acc[ai][0][m][1][i]) * acc[ai][1][m][1][i]; }
                *(u32x4*)(Aff + (size_t)row * 5632 + u.pn * 128 + cl) = pack8(a, b); }
    }
};

template <class Epi, class Sched, bool ALIGN_EPI = false, bool SP2 = false>
__device__ __forceinline__ void gemm_phase(PG8_LAS unsigned char* lds, const Gemm g, const Sched& S, const Epi& E) {
    const int tid = threadIdx.x, wid = __builtin_amdgcn_readfirstlane(tid >> 6), lane = tid & 63, wr = wid >> 2, wc = wid & 3, fr = lane & 15, fq = lane >> 4;
    const int K = g.K, nt = K / BK;
    unsigned voffA[2], voffB[2];
#pragma unroll
    for (int i = 0; i < 2; ++i) { int R, C; stage_rc(tid * 16 + i * 8192, R, C); const int Rb = Epi::PERM ? ((R & ~31) + perm32(R & 31)) : R;
        voffA[i] = (unsigned)(R * K + C) * 2u; voffB[i] = (unsigned)(Rb * K + C) * 2u; }
    const size_t kstep = (size_t)(BK * 2);
    const size_t hstep = (size_t)HALF * K * 2;
    const size_t tstep = 2 * hstep;
    const unsigned ldsw = (unsigned)wid * 1024u;
    const int aoff = lds_byte(wr * 64 + fr, fq * 8), boff = lds_byte(wc * 32 + fr, fq * 8);
#define PG8_SA(b, h) (((b) * 2 + (h)) * HTB)
#define PG8_SB(b, h) ((4 + (b) * 2 + (h)) * HTB)
#define PG8_STAGE(bufoff, gbase, voff) do { _Pragma("unroll") for (int _i = 0; _i < 2; ++_i) \
        __builtin_amdgcn_global_load_lds((const unsigned*)((const char*)(gbase) + (voff)[_i]), (PG8_LAS unsigned*)(lds + (bufoff) + ldsw + _i * 8192), 16, 0, 0); } while (0)
#define PG8_LDA(dst, b, h) do { _Pragma("unroll") for (int m = 0; m < 4; ++m) _Pragma("unroll") for (int k = 0; k < 2; ++k) dst[m][k] = *(const PG8_LAS bf16x8*)(lds + PG8_SA(b, h) + aoff + m * 2048 + k * 1024); } while (0)
#define PG8_LDB(dst, b, h) do { _Pragma("unroll") for (int n = 0; n < 2; ++n) _Pragma("unroll") for (int k = 0; k < 2; ++k) dst[n][k] = *(const PG8_LAS bf16x8*)(lds + PG8_SB(b, h) + boff + n * 2048 + k * 1024); } while (0)
#define PG8_MMA(ai, bj, At, Bt) do { __builtin_amdgcn_s_setprio(1); _Pragma("unroll") for (int m = 0; m < 4; ++m) _Pragma("unroll") for (int n = 0; n < 2; ++n) _Pragma("unroll") for (int k = 0; k < 2; ++k) \
        acc[ai][bj][m][n] = __builtin_amdgcn_mfma_f32_16x16x32_bf16(Bt[n][k], At[m][k], acc[ai][bj][m][n], 0, 0, 0); __builtin_amdgcn_s_setprio(0); } while (0)
#define PG8_WAIT_V(n) asm volatile("s_waitcnt vmcnt(" #n ")" ::: "memory")
#define PG8_WAIT_L(n) asm volatile("s_waitcnt lgkmcnt(" #n ")" ::: "memory")
#define PG8_BAR __builtin_amdgcn_s_barrier()
#define PG8_SCHED __builtin_amdgcn_sched_barrier(0)
    Unit cur, nxt; int ui = 0;
    if (!S.next(0, cur)) return;
    f32x4 acc[2][2][4][2];
#pragma unroll
    for (int a = 0; a < 2; ++a)
#pragma unroll
        for (int b = 0; b < 2; ++b)
#pragma unroll
            for (int m = 0; m < 4; ++m)
#pragma unroll
                for (int n = 0; n < 2; ++n) acc[a][b][m][n] = (f32x4){0.f, 0.f, 0.f, 0.f};
    bf16x8 At[4][2], B0[2][2], B1[2][2];
    const char* cA = (const char*)g.A + (size_t)cur.pm * tstep; const char* cB = (const char*)g.Bt + (size_t)cur.pn * tstep;
    S.a_ready(cur);
    if constexpr (SP2) {
        PG8_STAGE(PG8_SB(0, 0), cB, voffB); PG8_STAGE(PG8_SB(0, 1), cB + hstep, voffB); PG8_STAGE(PG8_SA(0, 0), cA, voffA); PG8_STAGE(PG8_SA(0, 1), cA + hstep, voffA);
        if (wr == 1) PG8_BAR;
        PG8_WAIT_V(2); PG8_BAR;
        PG8_STAGE(PG8_SB(1, 0), cB + kstep, voffB); PG8_STAGE(PG8_SA(1, 0), cA + kstep, voffA); PG8_STAGE(PG8_SB(1, 1), cB + hstep + kstep, voffB);
        PG8_WAIT_V(6); PG8_BAR;
    } else {
        PG8_STAGE(PG8_SB(0, 0), cB, voffB); PG8_STAGE(PG8_SA(0, 0), cA, voffA); PG8_STAGE(PG8_SB(0, 1), cB + hstep, voffB); PG8_STAGE(PG8_SA(0, 1), cA + hstep, voffA);
        if (wr == 1) PG8_BAR;
        PG8_WAIT_V(4); PG8_BAR;
        PG8_STAGE(PG8_SB(1, 0), cB + kstep, voffB); PG8_STAGE(PG8_SA(1, 0), cA + kstep, voffA); PG8_STAGE(PG8_SB(1, 1), cB + hstep + kstep, voffB);
        PG8_WAIT_V(6); PG8_BAR;
    }
    for (;;) {
        const bool has_next = S.next(ui + 1, nxt);
        const char* nA = has_next ? (const char*)g.A + (size_t)nxt.pm * tstep : cA; const char* nB = has_next ? (const char*)g.Bt + (size_t)nxt.pn * tstep : cB;
        for (int t = 0; t < nt; t += 2) {
            const bool last = (t == nt - 2);
            const char* a1 = cA + (size_t)(t + 1) * kstep;
            const char* a2 = last ? nA : cA + (size_t)(t + 2) * kstep; const char* b2 = last ? nB : cB + (size_t)(t + 2) * kstep;
            const char* a3 = a2 + kstep; const char* b3 = b2 + kstep;
            if (last && has_next) S.a_ready(nxt);
            if constexpr (SP2) {
            PG8_LDB(B0, 0, 0); PG8_LDB(B1, 0, 1); PG8_SCHED; PG8_LDA(At, 0, 0); PG8_STAGE(PG8_SA(1, 1), a1 + hstep, voffA);
            PG8_WAIT_V(8); PG8_WAIT_L(0); PG8_BAR; PG8_MMA(0, 0, At, B0); PG8_MMA(0, 1, At, B1); PG8_BAR; PG8_SCHED;
            PG8_LDA(At, 0, 1); PG8_STAGE(PG8_SB(0, 0), b2, voffB); PG8_STAGE(PG8_SB(0, 1), b2 + hstep, voffB); PG8_STAGE(PG8_SA(0, 0), a2, voffA);
            PG8_WAIT_V(8); PG8_WAIT_L(0); PG8_BAR; PG8_MMA(1, 0, At, B0); PG8_MMA(1, 1, At, B1); PG8_BAR; PG8_SCHED;
            PG8_LDB(B0, 1, 0); PG8_LDB(B1, 1, 1); PG8_SCHED; PG8_LDA(At, 1, 0); PG8_STAGE(PG8_SA(0, 1), a2 + hstep, voffA);
            PG8_WAIT_V(8); PG8_WAIT_L(0); PG8_BAR; PG8_MMA(0, 0, At, B0); PG8_MMA(0, 1, At, B1); PG8_BAR; PG8_SCHED;
            PG8_LDA(At, 1, 1); PG8_STAGE(PG8_SB(1, 0), b3, voffB); PG8_STAGE(PG8_SB(1, 1), b3 + hstep, voffB); PG8_STAGE(PG8_SA(1, 0), a3, voffA);
            PG8_WAIT_V(8); PG8_WAIT_L(0); PG8_BAR; PG8_MMA(1, 0, At, B0); PG8_MMA(1, 1, At, B1); PG8_BAR; PG8_SCHED;
            } else {
            PG8_LDB(B0, 0, 0); PG8_SCHED; PG8_LDA(At, 0, 0); PG8_STAGE(PG8_SA(1, 1), a1 + hstep, voffA);
            PG8_WAIT_L(8); PG8_BAR; PG8_WAIT_L(0); PG8_MMA(0, 0, At, B0); PG8_BAR; PG8_SCHED;
            PG8_LDB(B1, 0, 1); PG8_STAGE(PG8_SB(0, 0), b2, voffB);
            PG8_BAR; PG8_WAIT_L(0); PG8_MMA(0, 1, At, B1); PG8_BAR;
            PG8_LDA(At, 0, 1); PG8_STAGE(PG8_SA(0, 0), a2, voffA);
            PG8_BAR; PG8_WAIT_L(0); PG8_MMA(1, 0, At, B0); PG8_BAR; PG8_SCHED;
            PG8_STAGE(PG8_SB(0, 1), b2 + hstep, voffB);
            PG8_WAIT_V(6); PG8_BAR; PG8_MMA(1, 1, At, B1); PG8_BAR;
            PG8_LDB(B0, 1, 0); PG8_SCHED; PG8_LDA(At, 1, 0); PG8_STAGE(PG8_SA(0, 1), a2 + hstep, voffA);
            PG8_WAIT_L(8); PG8_BAR; PG8_WAIT_L(0); PG8_MMA(0, 0, At, B0); PG8_BAR; PG8_SCHED;
            PG8_LDB(B1, 1, 1); PG8_STAGE(PG8_SB(1, 0), b3, voffB);
            PG8_BAR; PG8_WAIT_L(0); PG8_MMA(0, 1, At, B1); PG8_BAR;
            PG8_LDA(At, 1, 1); PG8_STAGE(PG8_SA(1, 0), a3, voffA);
            PG8_BAR; PG8_WAIT_L(0); PG8_MMA(1, 0, At, B0); PG8_BAR; PG8_SCHED;
            PG8_STAGE(PG8_SB(1, 1), b3 + hstep, voffB);
            PG8_WAIT_V(6); PG8_BAR; PG8_MMA(1, 1, At, B1); PG8_BAR;
            }
        }
        if constexpr (ALIGN_EPI) { if (wr == 0) PG8_BAR; }
        if constexpr (!Epi::AFTER_DRAIN) { E(acc, cur, wr, wc, fr, fq); S.done(cur); }
        if (!has_next) break;
#pragma unroll
        for (int a = 0; a < 2; ++a)
#pragma unroll
            for (int b = 0; b < 2; ++b)
#pragma unroll
                for (int m = 0; m < 4; ++m)
#pragma unroll
                    for (int n = 0; n < 2; ++n) acc[a][b][m][n] = (f32x4){0.f, 0.f, 0.f, 0.f};
        cur = nxt; cA = nA; cB = nB; ++ui;
        if constexpr (ALIGN_EPI) { if (wr == 1) PG8_BAR; }
    }
    PG8_WAIT_V(0);
    if constexpr (!ALIGN_EPI) { if (wr == 0) PG8_BAR; }
    PG8_BAR;
    if constexpr (Epi::AFTER_DRAIN) { E.fused(acc, cur, wr, wc, fr, fq, lds, wid, lane); S.done(cur); }
#undef PG8_SA
#undef PG8_SB
#undef PG8_STAGE
#undef PG8_LDA
#undef PG8_LDB
#undef PG8_MMA
#undef PG8_WAIT_V
#undef PG8_WAIT_L
#undef PG8_BAR
#undef PG8_SCHED
}
}

namespace att {
typedef unsigned short bf16_t;
using bf16x8 = __attribute__((ext_vector_type(8))) short;
using s16x4  = __attribute__((ext_vector_type(4))) short;
using f32x16 = __attribute__((ext_vector_type(16))) float;
using f32x4  = __attribute__((ext_vector_type(4))) float;
using u32x4  = __attribute__((ext_vector_type(4))) unsigned;
using u32x2  = __attribute__((ext_vector_type(2))) unsigned;
constexpr int NW = 8, QBLK = 32, KVBLK = 64;
constexpr int LDQ = 1536, LDK = 1536, LDV = 1024, LDO = 1024;
constexpr float SCALE = 0.07216878364870323f;
constexpr float THR = 8.f;
constexpr int NQR = 8;
constexpr int SHM_V = KVBLK * 128 * 2, SHM_K = KVBLK * 192 * 2, SHM_ATTN = 2 * SHM_V + 2 * SHM_K + NW * 64 * 4;
#define AKSWZ(row, colB) ((row) * 384 + ((colB) ^ (((((row) >> 1) & 3) | (((row) >> 2) & 4)) << 4)))
#define KSWZ128(row, colB) ((row) * 256 + ((colB) ^ (((row) & 15) << 4)))
#define SBAR() __builtin_amdgcn_sched_barrier(0)
#define GAS __attribute__((address_space(1)))
__device__ __forceinline__ const GAS char* uniform_ptr(const void* p) { const unsigned long long v = (unsigned long long)p; const unsigned lo = __builtin_amdgcn_readfirstlane((unsigned)v), hi = __builtin_amdgcn_readfirstlane((unsigned)(v >> 32)); return (const GAS char*)(((unsigned long long)hi << 32) | lo); }
__device__ __forceinline__ int crow(int r, int hi) { return (r & 3) + 8 * (r >> 2) + 4 * hi; }
__device__ __forceinline__ unsigned cvtpk(float lo, float hi) { unsigned r; asm volatile("v_cvt_pk_bf16_f32 %0, %1, %2" : "=v"(r) : "v"(lo), "v"(hi)); return pg8::coarse2(r); }
__device__ __forceinline__ float swap_sum(float v) { auto rr = __builtin_amdgcn_permlane32_swap(__float_as_uint(v), __float_as_uint(v), false, false); return __uint_as_float(rr[0]) + __uint_as_float(rr[1]); }

__device__ __forceinline__ void partialSM(f32x16& p0, f32x16& p1, float& m_reg, float& mn, float& alpha) {
  constexpr float C = SCALE * 1.4426950408889634f;
  float pmax = p0[0];
#pragma unroll
  for (int r = 1; r < 16; ++r) pmax = fmaxf(pmax, p0[r]);
#pragma unroll
  for (int r = 0; r < 16; ++r) pmax = fmaxf(pmax, p1[r]);
  { auto rr = __builtin_amdgcn_permlane32_swap(__float_as_uint(pmax), __float_as_uint(pmax), false, false);
    pmax = fmaxf(__uint_as_float(rr[0]), __uint_as_float(rr[1])); }
  if (__builtin_expect(__all(pmax - m_reg <= THR / SCALE), 1)) { mn = m_reg; alpha = 1.f; }
  else { mn = fmaxf(m_reg, pmax); alpha = __builtin_amdgcn_exp2f((m_reg - mn) * C); m_reg = mn; }
  float mnC = -mn * C;
#pragma unroll
  for (int r = 0; r < 16; ++r) p0[r] = fmaf(p0[r], C, mnC);
#pragma unroll
  for (int r = 0; r < 16; ++r) p1[r] = fmaf(p1[r], C, mnC);
#pragma unroll
  for (int r = 0; r < 16; ++r) p0[r] = __builtin_amdgcn_exp2f(p0[r]);
}
#define PK4(P, BASE, OUT) do { unsigned a0 = cvtpk(P[BASE + 0], P[BASE + 1]), a1 = cvtpk(P[BASE + 2], P[BASE + 3]);   \
    unsigned b0 = cvtpk(P[BASE + 4], P[BASE + 5]), b1 = cvtpk(P[BASE + 6], P[BASE + 7]);                              \
    auto r0 = __builtin_amdgcn_permlane32_swap(a0, b0, false, false); auto r1 = __builtin_amdgcn_permlane32_swap(a1, b1, false, false); \
    u32x4 w = {r0[0], r1[0], r0[1], r1[1]}; OUT = *reinterpret_cast<bf16x8*>(&w); } while (0)
__device__ __forceinline__ void finishSM(f32x16& p0, f32x16& p1, float alpha, float& l_reg, bf16x8& pa0, bf16x8& pa1, bf16x8& pa2, bf16x8& pa3) {
#pragma unroll
  for (int r = 0; r < 16; ++r) p1[r] = __builtin_amdgcn_exp2f(p1[r]);
  float ps = 0;
#pragma unroll
  for (int r = 0; r < 16; ++r) ps += p0[r];
#pragma unroll
  for (int r = 0; r < 16; ++r) ps += p1[r];
  ps = swap_sum(ps);
  l_reg = l_reg * alpha + ps;
  PK4(p0, 0, pa0); PK4(p0, 8, pa1); PK4(p1, 0, pa2); PK4(p1, 8, pa3);
}
__device__ __forceinline__ void qkt192(f32x16& p0, f32x16& p1, const char* Ks, const bf16x8 (&qr)[NQR], const char* Qs, int r32, int hi) {
  p0 = f32x16{}; p1 = f32x16{};
  __builtin_amdgcn_s_setprio(1);
#pragma unroll
  for (int d0 = 0; d0 < 12; ++d0) { int cb = (d0 * 16 + hi * 8) * 2;
    bf16x8 b0 = *reinterpret_cast<const bf16x8*>(Ks + AKSWZ(r32, cb));
    bf16x8 b1 = *reinterpret_cast<const bf16x8*>(Ks + AKSWZ(32 + r32, cb));
    bf16x8 qv; if (d0 < NQR) qv = qr[d0 < NQR ? d0 : 0]; else qv = *reinterpret_cast<const bf16x8*>(Qs + (d0 - NQR) * 1024);
    p0 = __builtin_amdgcn_mfma_f32_32x32x16_bf16(b0, qv, p0, 0, 0, 0);
    p1 = __builtin_amdgcn_mfma_f32_32x32x16_bf16(b1, qv, p1, 0, 0, 0); }
  __builtin_amdgcn_s_setprio(0);
}
__device__ __forceinline__ void qkt128(f32x16& p0, f32x16& p1, const char* Ks, const bf16x8 (&qr)[8], int r32, int hi) {
  p0 = f32x16{}; p1 = f32x16{};
#pragma unroll
  for (int d0 = 0; d0 < 8; ++d0) { int cb = (d0 * 16 + hi * 8) * 2;
    bf16x8 b0 = *reinterpret_cast<const bf16x8*>(Ks + KSWZ128(r32, cb));
    bf16x8 b1 = *reinterpret_cast<const bf16x8*>(Ks + KSWZ128(32 + r32, cb));
    p0 = __builtin_amdgcn_mfma_f32_32x32x16_bf16(b0, qr[d0], p0, 0, 0, 0);
    p1 = __builtin_amdgcn_mfma_f32_32x32x16_bf16(b1, qr[d0], p1, 0, 0, 0); }
}
__device__ __forceinline__ int v_st(int k, int c) { const int kk = (k & ~0xC) | ((k & 4) << 1) | ((k & 8) >> 1); return ((kk >> 3) * 4 + (c >> 5)) * 512 + ((kk & 7) * 32 + (c & 31)) * 2; }
__device__ __forceinline__ int v_rd_base(int lane) { return ((lane & 3) << 3) | (((lane >> 2) & 3) << 6) | (((lane >> 4) & 1) << 5) | (((lane >> 5) & 1) << 8); }
constexpr int v_rd_off(int d0, int ks, int half) { return d0 * 512 + ks * 4096 + half * 2048; }
template <int OFF> __device__ __forceinline__ s16x4 tr_read(int vb) {
  s16x4 r; asm volatile("ds_read_b64_tr_b16 %0, %1 offset:%2" : "=&v"(r) : "v"(vb), "i"(OFF) : "memory"); return r;
}
#define PKLH(L, H) (bf16x8){L[0], L[1], L[2], L[3], H[0], H[1], H[2], H[3]}
template <int D0> __device__ __forceinline__ void pv_one(f32x16& od, int vb, bf16x8 pa0, bf16x8 pa1, bf16x8 pa2, bf16x8 pa3) {
  const s16x4 l0 = tr_read<v_rd_off(D0, 0, 0)>(vb), h0 = tr_read<v_rd_off(D0, 0, 1)>(vb), l1 = tr_read<v_rd_off(D0, 1, 0)>(vb), h1 = tr_read<v_rd_off(D0, 1, 1)>(vb);
  const s16x4 l2 = tr_read<v_rd_off(D0, 2, 0)>(vb), h2 = tr_read<v_rd_off(D0, 2, 1)>(vb), l3 = tr_read<v_rd_off(D0, 3, 0)>(vb), h3 = tr_read<v_rd_off(D0, 3, 1)>(vb);
  asm volatile("s_waitcnt lgkmcnt(0)" ::: "memory"); SBAR();
  __builtin_amdgcn_s_setprio(1);
  od = __builtin_amdgcn_mfma_f32_32x32x16_bf16(pa0, PKLH(l0, h0), od, 0, 0, 0);
  od = __builtin_amdgcn_mfma_f32_32x32x16_bf16(pa1, PKLH(l1, h1), od, 0, 0, 0);
  od = __builtin_amdgcn_mfma_f32_32x32x16_bf16(pa2, PKLH(l2, h2), od, 0, 0, 0);
  od = __builtin_amdgcn_mfma_f32_32x32x16_bf16(pa3, PKLH(l3, h3), od, 0, 0, 0);
  __builtin_amdgcn_s_setprio(0);
}
__device__ __forceinline__ void pv_d0(f32x16* o, int vb, bf16x8 pa0, bf16x8 pa1, bf16x8 pa2, bf16x8 pa3) {
  pv_one<0>(o[0], vb, pa0, pa1, pa2, pa3); pv_one<1>(o[1], vb, pa0, pa1, pa2, pa3); pv_one<2>(o[2], vb, pa0, pa1, pa2, pa3); pv_one<3>(o[3], vb, pa0, pa1, pa2, pa3);
}
template <int D0> __device__ __forceinline__ void pvT_one(f32x16& od, int vb, bf16x8 pa0, bf16x8 pa1, bf16x8 pa2, bf16x8 pa3) {
  const s16x4 l0 = tr_read<v_rd_off(D0, 0, 0)>(vb), h0 = tr_read<v_rd_off(D0, 0, 1)>(vb), l1 = tr_read<v_rd_off(D0, 1, 0)>(vb), h1 = tr_read<v_rd_off(D0, 1, 1)>(vb);
  const s16x4 l2 = tr_read<v_rd_off(D0, 2, 0)>(vb), h2 = tr_read<v_rd_off(D0, 2, 1)>(vb), l3 = tr_read<v_rd_off(D0, 3, 0)>(vb), h3 = tr_read<v_rd_off(D0, 3, 1)>(vb);
  asm volatile("s_waitcnt lgkmcnt(0)" ::: "memory"); SBAR();
  od = __builtin_amdgcn_mfma_f32_32x32x16_bf16(PKLH(l0, h0), pa0, od, 0, 0, 0);
  od = __builtin_amdgcn_mfma_f32_32x32x16_bf16(PKLH(l1, h1), pa1, od, 0, 0, 0);
  od = __builtin_amdgcn_mfma_f32_32x32x16_bf16(PKLH(l2, h2), pa2, od, 0, 0, 0);
  od = __builtin_amdgcn_mfma_f32_32x32x16_bf16(PKLH(l3, h3), pa3, od, 0, 0, 0);
}

__device__ __forceinline__ void attn_unit(const bf16_t* __restrict__ Qb, const bf16_t* __restrict__ Kh, const bf16_t* __restrict__ Vh, bf16_t* __restrict__ Ob, int seq, char* lds, int ldsaddr) {
  const int tid = threadIdx.x, wid = tid >> 6, lane = tid & 63, r32 = lane & 31, hi = lane >> 5;
  char* V_lds = lds; char* K_lds = lds + 2 * SHM_V;
  float* ws = (float*)(lds + 2 * SHM_V + 2 * SHM_K) + wid * 64; float* li_l = ws; float* al_l = ws + 32;
  float m_reg = -1e30f, l_reg = 0; f32x16 o[4] = {}; bf16x8 qr[NQR];
  const bf16_t* Qw = Qb + (long)(wid * QBLK + r32) * LDQ + hi * 8;
  char* Qs = lds + SHM_ATTN + wid * ((12 - NQR) * 1024) + lane * 16;
#pragma unroll
  for (int d0 = 0; d0 < NQR; ++d0) qr[d0] = *reinterpret_cast<const bf16x8*>(Qw + d0 * 16);
#pragma unroll
  for (int d0 = NQR; d0 < 12; ++d0) *(bf16x8*)(Qs + (d0 - NQR) * 1024) = *reinterpret_cast<const bf16x8*>(Qw + d0 * 16);
  const int sr = tid >> 4, sc = (tid & 15) * 8, vst0 = v_st(sr, sc), vst1 = v_st(32 + sr, sc);
  unsigned kg0, kg1, kg2; int kl0, kl1, kl2;
  { int p = tid;        int kr = p / 24, kc = (p % 24) * 8; kg0 = (unsigned)(kr * LDK + kc) * 2u; kl0 = AKSWZ(kr, kc * 2);
    p = tid + 512;      kr = p / 24; kc = (p % 24) * 8;     kg1 = (unsigned)(kr * LDK + kc) * 2u; kl1 = AKSWZ(kr, kc * 2);
    p = tid + 1024;     kr = p / 24; kc = (p % 24) * 8;     kg2 = (unsigned)(kr * LDK + kc) * 2u; kl2 = AKSWZ(kr, kc * 2); }
  const unsigned vg0 = (unsigned)(sr * LDV + sc) * 2u, vg1 = (unsigned)((32 + sr) * LDV + sc) * 2u;
  const int vb0 = ldsaddr + v_rd_base(lane);
  bf16x8 vs0, vs1, ks0, ks1, ks2;
#define SLOAD(k0) do { const GAS char* vb_ = uniform_ptr((const char*)Vh + (size_t)(k0) * (LDV * 2)); const GAS char* kb_ = uniform_ptr((const char*)Kh + (size_t)(k0) * (LDK * 2)); \
    vs0 = *(const GAS bf16x8*)(vb_ + vg0); vs1 = *(const GAS bf16x8*)(vb_ + vg1); \
    ks0 = *(const GAS bf16x8*)(kb_ + kg0); ks1 = *(const GAS bf16x8*)(kb_ + kg1); ks2 = *(const GAS bf16x8*)(kb_ + kg2); } while (0)
#define SWRITE(b) do { *(bf16x8*)(V_lds + (b) * SHM_V + vst0) = vs0; *(bf16x8*)(V_lds + (b) * SHM_V + vst1) = vs1; \
    *(bf16x8*)(K_lds + (b) * SHM_K + kl0) = ks0; *(bf16x8*)(K_lds + (b) * SHM_K + kl1) = ks1; *(bf16x8*)(K_lds + (b) * SHM_K + kl2) = ks2; } while (0)
#define SWAIT() asm volatile("s_waitcnt vmcnt(0)" ::: "memory")
#define RESC(a) do { if (__any((a) < 1.f)) { if (hi == 0) al_l[r32] = (a); asm volatile("s_waitcnt lgkmcnt(0)" ::: "memory"); \
    _Pragma("unroll") for (int d = 0; d < 4; ++d) _Pragma("unroll") for (int r = 0; r < 16; ++r) o[d][r] *= al_l[crow(r, hi)]; } } while (0)
  f32x16 pA0, pA1, pB0, pB1; float mnA, mnB, alA, alB; bf16x8 pa0, pa1, pa2, pa3; const int NT = seq / KVBLK;
  __syncthreads();
  SLOAD(0); SWAIT(); SWRITE(0); __syncthreads();
  qkt192(pA0, pA1, K_lds, qr, Qs, r32, hi); partialSM(pA0, pA1, m_reg, mnA, alA);
  SLOAD(KVBLK);
  SWAIT(); SWRITE(1); __syncthreads();
  for (int j = 1; j + 1 < NT; j += 2) {
    SBAR(); qkt192(pB0, pB1, K_lds + SHM_K, qr, Qs, r32, hi);
    finishSM(pA0, pA1, alA, l_reg, pa0, pa1, pa2, pa3); SBAR();
    SLOAD((j + 1) * KVBLK); SBAR();
    pv_d0(o, vb0, pa0, pa1, pa2, pa3); partialSM(pB0, pB1, m_reg, mnB, alB);
    __syncthreads(); SWAIT(); SWRITE(0);
    RESC(alB); __syncthreads();
    SBAR(); qkt192(pA0, pA1, K_lds, qr, Qs, r32, hi);
    finishSM(pB0, pB1, alB, l_reg, pa0, pa1, pa2, pa3); SBAR();
    SLOAD((j + 2) * KVBLK); SBAR();
    pv_d0(o, vb0 + SHM_V, pa0, pa1, pa2, pa3); partialSM(pA0, pA1, m_reg, mnA, alA);
    __syncthreads(); SWAIT(); SWRITE(1);
    RESC(alA); __syncthreads();
  }
  SBAR(); qkt192(pB0, pB1, K_lds + SHM_K, qr, Qs, r32, hi);
  finishSM(pA0, pA1, alA, l_reg, pa0, pa1, pa2, pa3); SBAR();
  pv_d0(o, vb0, pa0, pa1, pa2, pa3); partialSM(pB0, pB1, m_reg, mnB, alB);
  __syncthreads(); RESC(alB);
  finishSM(pB0, pB1, alB, l_reg, pa0, pa1, pa2, pa3); SBAR();
  pv_d0(o, vb0 + SHM_V, pa0, pa1, pa2, pa3);
  if (hi == 0) li_l[r32] = l_reg; asm volatile("s_waitcnt lgkmcnt(0)" ::: "memory");
  float rli[16];
#pragma unroll
  for (int r = 0; r < 16; ++r) rli[r] = __builtin_amdgcn_rcpf(li_l[crow(r, hi)]);
  bf16_t* Ow = Ob + (long)(wid * QBLK) * LDO;
#pragma unroll
  for (int r = 0; r < 16; ++r) { int orow = crow(r, hi);
#pragma unroll
    for (int d0 = 0; d0 < 4; ++d0) Ow[(long)orow * LDO + d0 * 32 + r32] = (bf16_t)(cvtpk(o[d0][r] * rli[r], 0.f) & 0xffffu); }
#undef SLOAD
#undef SWRITE
#undef SWAIT
#undef RESC
}

__device__ __forceinline__ bf16x8 scale8(bf16x8 v, float s) {
  u32x4 w = *reinterpret_cast<u32x4*>(&v), o;
#pragma unroll
  for (int i = 0; i < 4; ++i) o[i] = cvtpk(__uint_as_float(w[i] << 16) * s, __uint_as_float(w[i] & 0xffff0000u) * s);
  return *reinterpret_cast<bf16x8*>(&o);
}
__device__ __forceinline__ s16x4 trr(int addr) { s16x4 r; asm volatile("ds_read_b64_tr_b16 %0, %1" : "=&v"(r) : "v"(addr) : "memory"); return r; }

__device__ __forceinline__ void chunk_kv_unit(const bf16_t* __restrict__ Kc, const bf16_t* __restrict__ Vc, bf16_t* __restrict__ CKf, bf16_t* __restrict__ CKb, float lgf, float lgb, char* lds, int ldsaddr) {
  const int tid = threadIdx.x, wid = tid >> 6, lane = tid & 63, r32 = lane & 31, hi = lane >> 5;
  const int dir = wid >> 2, db = wid & 3, d = 32 * db + r32;
  __syncthreads();
  { const int sr = tid >> 4, sc = (tid & 15) * 8;
#pragma unroll
    for (int i = 0; i < 4; ++i) { const int row = sr + 32 * i;
      *(bf16x8*)(lds + (row >> 6) * 16384 + v_st(row & 63, sc)) = *reinterpret_cast<const bf16x8*>(Vc + (long)row * 1024 + sc);
      *(bf16x8*)(lds + 32768 + row * 272 + sc * 2) = *reinterpret_cast<const bf16x8*>(Kc + (long)row * 1024 + sc); } }
  __syncthreads();
  bf16x8 kb[8];
  int hio = hi; asm volatile("" : "+v"(hio));
  const char* kl = lds + 32768 + (hio * 8) * 272 + d * 2;
#pragma unroll
  for (int ks = 0; ks < 8; ++ks) { u32x4 w;
#pragma unroll
    for (int i = 0; i < 4; ++i) { const int s0 = ks * 16 + hio * 8 + 2 * i;
      const float k0 = __uint_as_float((unsigned)*(const unsigned short*)(kl + (ks * 16 + 2 * i) * 272) << 16), k1 = __uint_as_float((unsigned)*(const unsigned short*)(kl + (ks * 16 + 2 * i + 1) * 272) << 16);
      const float z0 = __builtin_amdgcn_exp2f(dir ? lgb * (float)s0 : lgf * (float)(127 - s0)), z1 = __builtin_amdgcn_exp2f(dir ? lgb * (float)(s0 + 1) : lgf * (float)(126 - s0));
      w[i] = cvtpk(k0 * z0, k1 * z1); }
    kb[ks] = *reinterpret_cast<bf16x8*>(&w); }
  f32x16 acc[4] = {};
  const int vb = ldsaddr + v_rd_base(lane);
  pvT_one<0>(acc[0], vb, kb[0], kb[1], kb[2], kb[3]); pvT_one<1>(acc[1], vb, kb[0], kb[1], kb[2], kb[3]); pvT_one<2>(acc[2], vb, kb[0], kb[1], kb[2], kb[3]); pvT_one<3>(acc[3], vb, kb[0], kb[1], kb[2], kb[3]);
  pvT_one<0>(acc[0], vb + 16384, kb[4], kb[5], kb[6], kb[7]); pvT_one<1>(acc[1], vb + 16384, kb[4], kb[5], kb[6], kb[7]); pvT_one<2>(acc[2], vb + 16384, kb[4], kb[5], kb[6], kb[7]); pvT_one<3>(acc[3], vb + 16384, kb[4], kb[5], kb[6], kb[7]);
  bf16_t* CK = dir ? CKb : CKf;
#pragma unroll
  for (int eb = 0; eb < 4; ++eb)
#pragma unroll
    for (int r = 0; r < 16; ++r) CK[(32 * eb + crow(r, hi)) * 128 + d] = (bf16_t)(cvtpk(acc[eb][r], 0.f) & 0xffffu);
}

#ifndef PROBE_COMP
#define PROBE_COMP 0
#endif
__device__ __forceinline__ void ret_out_unit(const bf16_t* __restrict__ Qc, const bf16_t* __restrict__ Kc, const bf16_t* __restrict__ Vc, const bf16_t* __restrict__ Gc,
                                             const bf16_t* __restrict__ STf, const bf16_t* __restrict__ STb, const float* __restrict__ gnw, const float* __restrict__ gnb,
                                             bf16_t* __restrict__ Oc, float lgf, float lgb, char* lds, int ldsaddr, float* dump = nullptr) {
  const int tid = threadIdx.x, ht = tid & 255, wq = (tid >> 6) & 3, lane = tid & 63, r32 = lane & 31, hi = lane >> 5;
  __syncthreads();
  { const int sr = ht >> 4, sc = (ht & 15) * 8;
#pragma unroll
    for (int i = 0; i < 8; ++i) { const int row = sr + 16 * i, tile = row >> 6, key = row & 63;
      *(bf16x8*)(lds + tile * 16384 + KSWZ128(key, sc * 2)) = *reinterpret_cast<const bf16x8*>(Kc + (long)row * 1024 + sc);
      *(bf16x8*)(lds + 32768 + tile * 16384 + v_st(key, sc)) = *reinterpret_cast<const bf16x8*>(Vc + (long)row * 1024 + sc); } }
  const int c = 32 * wq + r32;
  bf16x8 qr[8];
#pragma unroll
  for (int d0 = 0; d0 < 8; ++d0) qr[d0] = *reinterpret_cast<const bf16x8*>(Qc + (long)c * 1024 + d0 * 16 + hi * 8);
  __syncthreads();
  f32x16 pA0, pA1, pB0, pB1;
  qkt128(pA0, pA1, lds, qr, r32, hi); qkt128(pB0, pB1, lds + 16384, qr, r32, hi);
  int cdec = c; asm volatile("" : "+v"(cdec));
#define DEC(P, JB) do { _Pragma("unroll") for (int r = 0; r < 16; ++r) { const int dl = cdec - ((JB) + crow(r, hi)); \
    P[r] *= __builtin_amdgcn_exp2f(dl >= 0 ? lgf * (float)dl : lgb * (float)(-dl)); } } while (0)
  DEC(pA0, 0); DEC(pA1, 32); DEC(pB0, 64); DEC(pB1, 96);
#undef DEC
  bf16x8 xa0, xa1, xa2, xa3, xb0, xb1, xb2, xb3;
  PK4(pA0, 0, xa0); PK4(pA0, 8, xa1); PK4(pA1, 0, xa2); PK4(pA1, 8, xa3);
  PK4(pB0, 0, xb0); PK4(pB0, 8, xb1); PK4(pB1, 0, xb2); PK4(pB1, 8, xb3);
  f32x16 o[4] = {};
  const int vb = ldsaddr + 32768 + v_rd_base(lane);
  if (PROBE_COMP == 0 || (PROBE_COMP & 1)) {
  pvT_one<0>(o[0], vb, xa0, xa1, xa2, xa3); pvT_one<1>(o[1], vb, xa0, xa1, xa2, xa3); pvT_one<2>(o[2], vb, xa0, xa1, xa2, xa3); pvT_one<3>(o[3], vb, xa0, xa1, xa2, xa3);
  pvT_one<0>(o[0], vb + 16384, xb0, xb1, xb2, xb3); pvT_one<1>(o[1], vb + 16384, xb0, xb1, xb2, xb3); pvT_one<2>(o[2], vb + 16384, xb0, xb1, xb2, xb3); pvT_one<3>(o[3], vb + 16384, xb0, xb1, xb2, xb3);
  }
#pragma unroll
  for (int dir = 0; dir < 2; ++dir) {
    if (PROBE_COMP != 0 && !((PROBE_COMP >> (1 + dir)) & 1)) continue;
    const float xi = __builtin_amdgcn_exp2f(dir == 0 ? lgf * (float)(c + 1) : lgb * (float)(128 - c));
    const bf16_t* ST = dir == 0 ? STf : STb;
    bf16x8 qs[8];
#pragma unroll
    for (int d0 = 0; d0 < 8; ++d0) qs[d0] = scale8(qr[d0], xi);
    const GAS char* stb = uniform_ptr(ST); const unsigned so = (unsigned)(r32 * 128 + hi * 8) * 2u;
#pragma unroll
    for (int eb = 0; eb < 4; ++eb) {
      bf16x8 A[8];
      SBAR();
#pragma unroll
      for (int d0 = 0; d0 < 8; ++d0) A[d0] = *(const GAS bf16x8*)(stb + so + (eb * 32 * 128 + d0 * 16) * 2);
#pragma unroll
      for (int d0 = 0; d0 < 8; ++d0) o[eb] = __builtin_amdgcn_mfma_f32_32x32x16_bf16(A[d0], qs[d0], o[eb], 0, 0, 0);
      SBAR();
    }
  }
  if (PROBE_COMP != 0) {
#pragma unroll
    for (int eb = 0; eb < 4; ++eb)
#pragma unroll
      for (int g = 0; g < 4; ++g) *(f32x4*)(dump + (long)c * 1024 + 32 * eb + 8 * g + 4 * hi) = (f32x4){o[eb][4 * g], o[eb][4 * g + 1], o[eb][4 * g + 2], o[eb][4 * g + 3]};
    return; }
  float s = 0.f;
#pragma unroll
  for (int eb = 0; eb < 4; ++eb)
#pragma unroll
    for (int r = 0; r < 16; ++r) s += o[eb][r];
  const float mu = swap_sum(s) * (1.f / 128.f);
  float q = 0.f;
#pragma unroll
  for (int eb = 0; eb < 4; ++eb)
#pragma unroll
    for (int r = 0; r < 16; ++r) { const float d = o[eb][r] - mu; q += d * d; }
  const float rstd = rsqrtf(swap_sum(q) * (1.f / 128.f) + 1e-6f);
#pragma unroll
  for (int eb = 0; eb < 4; ++eb)
#pragma unroll
    for (int g = 0; g < 4; ++g) { const int e0 = 32 * eb + 8 * g + 4 * hi;
      const f32x4 w4 = *(const f32x4*)(gnw + e0), b4 = *(const f32x4*)(gnb + e0);
      const u32x2 gg = *(const u32x2*)(Gc + (long)c * 1024 + e0);
      const float g0 = __uint_as_float(gg.x << 16), g1 = __uint_as_float(gg.x & 0xffff0000u), g2 = __uint_as_float(gg.y << 16), g3 = __uint_as_float(gg.y & 0xffff0000u);
      const float y0 = ((o[eb][4 * g] - mu) * rstd * w4[0] + b4[0]) * g0, y1 = ((o[eb][4 * g + 1] - mu) * rstd * w4[1] + b4[1]) * g1;
      const float y2 = ((o[eb][4 * g + 2] - mu) * rstd * w4[2] + b4[2]) * g2, y3 = ((o[eb][4 * g + 3] - mu) * rstd * w4[3] + b4[3]) * g3;
      u32x2 w; w.x = cvtpk(y0, y1); w.y = cvtpk(y2, y3);
      *(u32x2*)(Oc + (long)c * 2048 + e0) = w; }
}

__device__ __forceinline__ void ret_brute_unit(const bf16_t* __restrict__ Qh, const bf16_t* __restrict__ Kh, const bf16_t* __restrict__ Vh, const bf16_t* __restrict__ Gc,
                                               const float* __restrict__ gnw, const float* __restrict__ gnb, bf16_t* __restrict__ Oc, int t0, float lgf, float lgb, char* lds, const float* dump = nullptr) {
  const int tid = threadIdx.x, qi = tid >> 2, part = tid & 3, t = t0 + qi;
  float q[32], acc[32];
#pragma unroll
  for (int i = 0; i < 32; ++i) { q[i] = __uint_as_float((unsigned)Qh[(long)t * 1024 + part * 32 + i] << 16); acc[i] = 0.f; }
  for (int s0 = 0; s0 < 4096; s0 += 64) {
    { const int rel = s0 < t0 ? 1 : (s0 >= t0 + 128 ? 2 : 0); if (PROBE_COMP != 0 && ((PROBE_COMP >> rel) & 1)) continue; }
    __syncthreads();
    for (int c = tid; c < 64 * 16; c += 512) { const int r = c >> 4, c8 = (c & 15) * 8;
      *(bf16x8*)(lds + (r * 128 + c8) * 2) = *reinterpret_cast<const bf16x8*>(Kh + (long)(s0 + r) * 1024 + c8);
      *(bf16x8*)(lds + 16384 + (r * 128 + c8) * 2) = *reinterpret_cast<const bf16x8*>(Vh + (long)(s0 + r) * 1024 + c8); }
    __syncthreads();
    for (int j = 0; j < 64; ++j) { const int s = s0 + j; float d = 0.f;
      const unsigned short* kr = (const unsigned short*)(lds + (j * 128 + part * 32) * 2); const unsigned short* vr = (const unsigned short*)(lds + 16384 + (j * 128 + part * 32) * 2);
#pragma unroll
      for (int i = 0; i < 32; ++i) d += q[i] * __uint_as_float((unsigned)kr[i] << 16);
      d += __shfl_xor(d, 1); d += __shfl_xor(d, 2);
      const int dl = t - s; const float w = d * __builtin_amdgcn_exp2f(dl >= 0 ? lgf * (float)dl : lgb * (float)(-dl));
#pragma unroll
      for (int i = 0; i < 32; ++i) acc[i] += w * __uint_as_float((unsigned)vr[i] << 16); }
  }
  if (PROBE_COMP != 0) {
#pragma unroll
    for (int i = 0; i < 32; ++i) acc[i] += dump[(long)qi * 1024 + part * 32 + i]; }
  float sm = 0.f;
#pragma unroll
  for (int i = 0; i < 32; ++i) sm += acc[i];
  sm += __shfl_xor(sm, 1); sm += __shfl_xor(sm, 2); const float mu = sm * (1.f / 128.f);
  float qq = 0.f;
#pragma unroll
  for (int i = 0; i < 32; ++i) { const float dd = acc[i] - mu; qq += dd * dd; }
  qq += __shfl_xor(qq, 1); qq += __shfl_xor(qq, 2); const float rstd = rsqrtf(qq * (1.f / 128.f) + 1e-6f);
#pragma unroll
  for (int i = 0; i < 32; ++i) { const int e = part * 32 + i; const float g = __uint_as_float((unsigned)Gc[(long)qi * 1024 + e] << 16);
    Oc[(long)qi * 2048 + e] = (bf16_t)(cvtpk(((acc[i] - mu) * rstd * gnw[e] + gnb[e]) * g, 0.f) & 0xffffu); }
}
#undef SBAR
}


#ifndef PROBE_BRUTE_RET
#define PROBE_BRUTE_RET 0
#endif
#ifndef MK_SPLIT
#define MK_SPLIT 0
#endif
#define LAS __attribute__((address_space(3)))
#define GASX __attribute__((address_space(1)))
typedef unsigned short bf16_t;
typedef unsigned v4u __attribute__((ext_vector_type(4)));
typedef unsigned v2u __attribute__((ext_vector_type(2)));
typedef float f32x4 __attribute__((ext_vector_type(4)));
typedef short bf16x8 __attribute__((ext_vector_type(8)));

constexpr int BATCH = 8, SEQ = 4096, DM = 2048, T = BATCH * SEQ;
constexpr int INC = 5184, INCP = 5376, DFF = 5632, NMODC = 6 * DM;
constexpr int NPH = 11;
constexpr size_t MiB = 1u << 20;
constexpr size_t WS_CTL = 0, CTL_ZERO_BYTES = 2 * MiB;
constexpr size_t OFF_MOD = 0, OFF_SSQQ = 512 * 1024, OFF_SSQKV = 640 * 1024;
constexpr size_t WS_COSR = 2 * MiB, WS_SINR = 10 * MiB, WS_COSM = 18 * MiB, WS_SINM = 22 * MiB;
constexpr size_t WS_WIN = 26 * MiB, WS_WUQ = 47 * MiB, WS_WUKV = 49 * MiB, WS_WO = 51 * MiB, WS_WGU = 59 * MiB, WS_WDN = 103 * MiB;
constexpr size_t WS_H = 128 * MiB;
constexpr size_t WS_QR = 256 * MiB, WS_KR = 320 * MiB, WS_VR = 384 * MiB, WS_GR = 448 * MiB;
constexpr size_t WS_CQ = 512 * MiB, WS_CKV = 544 * MiB;
constexpr size_t WS_QM = 576 * MiB, WS_KB = 672 * MiB, WS_VM = 768 * MiB, WS_OAT = 832 * MiB, WS_END = 896 * MiB;
constexpr size_t WS_CAT = 576 * MiB;
constexpr size_t WS_AFF = 256 * MiB;
static_assert(WS_AFF + (size_t)T * DFF * 2 <= WS_END && WS_CAT + (size_t)T * 2048 * 2 <= WS_VM, "d_ws map");
constexpr int LDS_BAR_OFF = 150528;
constexpr size_t OFF_XBAR = 1536 * 1024;
constexpr int LDS_BYTES = 150528 + 64;

#define LDS_WAIT() asm volatile("s_waitcnt lgkmcnt(0)" ::: "memory")
__device__ __forceinline__ unsigned f2bf(float f) { unsigned u = __builtin_bit_cast(unsigned, f); return (u + 0x7fffu + ((u >> 16) & 1u)) >> 16; }
__device__ __forceinline__ unsigned pk2(float lo, float hi) { return f2bf(lo) | (f2bf(hi) << 16); }
__device__ __forceinline__ unsigned pk2a(float lo, float hi) { return pg8::coarse2(pk2(lo, hi)); }
__device__ __forceinline__ float wave_sum(float v) {
#pragma unroll
    for (int o = 1; o < 64; o <<= 1) v += __shfl_xor(v, o);
    return v;
}
__device__ __forceinline__ int dest_row(int mapid, int n) {
    switch (mapid) {
    case 1: if (n < 2048) { const int j = n & 127; return (n & ~127) + (j < 64 ? 2 * j : 2 * (j - 64) + 1); }
            if (n < 5120) return n;
            { const int j = n - 5120; return 5120 + (j < 32 ? 2 * j : 2 * (j - 32) + 1); }
    case 2: { const int d = n % 192; if (d < 128) return n; const int j = d - 128; return n - d + 128 + (j < 32 ? 2 * j : 2 * (j - 32) + 1); }
    case 3: return (n >> 7) * 256 + (n & 127);
    case 4: return (n >> 7) * 256 + 128 + (n & 127);
    default: return n;
    }
}
__device__ __forceinline__ void transpose_item(const float* __restrict__ W, int K, int N, bf16_t* __restrict__ WT, const float* __restrict__ kscale, int mapid, LAS float* scr, int item, int lane) {
    const int nblk = N / 32, kb = item / nblk, nb = item % nblk, k0 = 64 * kb, n0 = 32 * nb;
#pragma unroll 8
    for (int i = 0; i < 32; ++i) { const int kk = 2 * i + (lane >> 5); float v = W[(size_t)(k0 + kk) * N + n0 + (lane & 31)]; if (kscale) v *= kscale[k0 + kk]; scr[kk * 33 + (lane & 31)] = v; }
    LDS_WAIT(); asm volatile("" ::: "memory");
    const int c = lane & 7;
#pragma unroll
    for (int j = 0; j < 4; ++j) { const int n = (lane >> 3) + 8 * j; const LAS float* s = scr + (8 * c) * 33 + n;
        v4u o; o.x = pk2(s[0 * 33], s[1 * 33]); o.y = pk2(s[2 * 33], s[3 * 33]); o.z = pk2(s[4 * 33], s[5 * 33]); o.w = pk2(s[6 * 33], s[7 * 33]);
        *(v4u*)(WT + (size_t)dest_row(mapid, n0 + n) * K + k0 + 8 * c) = o; }
    LDS_WAIT(); asm volatile("" ::: "memory");
}
__device__ __forceinline__ void norm_row(const float* xrow, const float* __restrict__ w, const float* __restrict__ shift, const float* __restrict__ scale, bf16_t* ob, float* of, int lane) {
    const f32x4* xr = (const f32x4*)xrow + lane;
    f32x4 v[8]; float s = 0.f;
#pragma unroll
    for (int j = 0; j < 8; ++j) { v[j] = xr[64 * j]; s += (v[j].x * v[j].x + v[j].y * v[j].y) + (v[j].z * v[j].z + v[j].w * v[j].w); }
    const float rstd = rsqrtf(wave_sum(s) * (1.f / 2048.f) + 1e-6f);
#pragma unroll
    for (int j = 0; j < 8; ++j) { const int col = 4 * lane + 256 * j; f32x4 y = v[j] * rstd * *(const f32x4*)(w + col);
        if (shift) y = y * (*(const f32x4*)(scale + col) + 1.f) + *(const f32x4*)(shift + col);
        if (ob) { v2u o; o.x = pk2a(y.x, y.y); o.y = pk2a(y.z, y.w); *(v2u*)(ob + col) = o; } else *(f32x4*)(of + col) = y; }
}

#define XB_TMO      128
#define XB_XCNT(j)  (256  + 64 * (j))
#define XB_XSUB(j)  (1280 + 64 * (j))
#define XB_XGEN(j)  (2304 + 64 * (j))
#define XB_TOP      3328
#define XB_TOPGEN   3392
#define XCD_BAR_WORDS 3456
#define XB_SPIN_CAP (1u << 18)

__device__ __forceinline__ unsigned xb_ld(unsigned* p)              { return __hip_atomic_load(p, __ATOMIC_RELAXED, __HIP_MEMORY_SCOPE_AGENT); }
__device__ __forceinline__ unsigned xb_add(unsigned* p, unsigned v) { return __hip_atomic_fetch_add(p, v, __ATOMIC_RELAXED, __HIP_MEMORY_SCOPE_AGENT); }
__device__ __forceinline__ unsigned xb_xcc_id() { return (unsigned)__builtin_amdgcn_s_getreg((3 << 11) | 20) & 0xFu; }
#define XB_SPIN(cond, bar) do { unsigned _sp = 0; while (cond) { __builtin_amdgcn_s_sleep(1); \
    if ((++_sp & 255u) == 0u) { if (xb_ld(&(bar)[XB_TMO])) break; if (_sp > XB_SPIN_CAP) { atomicAdd(&(bar)[XB_TMO], 1u); break; } } } } while (0)

struct XcdBarrier {
    unsigned* bar; unsigned x;
    volatile LAS unsigned* st;
};

__device__ __forceinline__ XcdBarrier xcd_barrier_post(unsigned* bar, volatile LAS unsigned* st) {
    XcdBarrier b; b.bar = bar; b.x = xb_xcc_id(); b.st = st;
    if (threadIdx.x == 0) (void)xb_add(&bar[XB_XCNT(b.x)], 1u);
    return b;
}
__device__ __forceinline__ void xcd_barrier_complete(unsigned* bar, unsigned x, unsigned& nloc, unsigned& nx) {
    const unsigned G = gridDim.x * gridDim.y * gridDim.z;
    unsigned sum, cnt, mine, sp = 0u;
    for (;;) {
        sum = 0u; cnt = 0u; mine = 0u;
#pragma unroll
        for (unsigned j = 0; j < 16; ++j) { const unsigned c = xb_ld(&bar[XB_XCNT(j)]); sum += c; cnt += (c > 0u) ? 1u : 0u; mine = (j == x) ? c : mine; }
        if (sum == G) break;
        __builtin_amdgcn_s_sleep(1);
        if ((++sp & 255u) == 0u) { if (xb_ld(&bar[XB_TMO])) break; if (sp > XB_SPIN_CAP) { atomicAdd(&bar[XB_TMO], 1u); break; } }
    }
    nloc = mine > 0u ? mine : 1u; nx = cnt > 0u ? cnt : 1u;
}

__device__ __forceinline__ void xcd_barrier(const XcdBarrier& b) {
    asm volatile("s_waitcnt vmcnt(0)" ::: "memory");
    __syncthreads();
    if (threadIdx.x == 0) {
        unsigned* bar = b.bar;
        __builtin_amdgcn_s_waitcnt(0);
        unsigned nloc = b.st[0], nx = b.st[1];
        if (nloc == 0u) { xcd_barrier_complete(bar, b.x, nloc, nx); b.st[0] = nloc; b.st[1] = nx; }
        const unsigned old = xb_add(&bar[XB_XSUB(b.x)], 1u);
        const unsigned gen = old / nloc;
        if (old + 1u == (gen + 1u) * nloc) {
            __builtin_amdgcn_fence(__ATOMIC_RELEASE, "agent");
            asm volatile("s_waitcnt vmcnt(0)" ::: "memory");
            const unsigned og = xb_add(&bar[XB_TOP], 1u);
            const unsigned tg = og / nx;
            if (og + 1u == (tg + 1u) * nx) xb_add(&bar[XB_TOPGEN], 1u);
            else XB_SPIN(xb_ld(&bar[XB_TOPGEN]) == tg, bar);
            __builtin_amdgcn_fence(__ATOMIC_ACQUIRE, "agent");
            xb_add(&bar[XB_XGEN(b.x)], 1u);
            asm volatile("s_waitcnt vmcnt(0)" ::: "memory");
        } else {
            XB_SPIN(xb_ld(&bar[XB_XGEN(b.x)]) == gen, bar);
            __builtin_amdgcn_fence(__ATOMIC_ACQUIRE, "agent");
            asm volatile("s_waitcnt vmcnt(0)" ::: "memory");
        }
    }
    __syncthreads();
}

struct Args { const float* in[21]; float* out; unsigned char* ws; float inv_r[64]; float inv_m[32]; int ph_lo, ph_hi; };
static_assert(sizeof(Args) == 21 * 8 + 16 + 96 * 4 + 8, "Args has no padding");

__global__ void __launch_bounds__(512, 2) mk_fwd(Args a) {
    extern __shared__ __attribute__((aligned(16))) unsigned char smem[];
    cg::grid_group grid = cg::this_grid();
    const int tid = threadIdx.x, lane = tid & 63, wave = __builtin_amdgcn_readfirstlane(tid >> 6);
    const int G = gridDim.x, bx = blockIdx.x, vcu = (G % 8 == 0) ? (bx % 8) * (G / 8) + bx / 8 : bx;
    const int gw = vcu * 8 + wave, NGW = G * 8;
    LAS unsigned char* lds3 = (LAS unsigned char*)smem; char* ldsg = (char*)smem; const int ldsaddr = (int)(unsigned)(uintptr_t)lds3;
    float* out = a.out;
#define WSB() size_t wz_ = 0; asm volatile("" : "+s"(wz_)); unsigned char* ws = a.ws + wz_
#define INP(name, k) const float* name = a.in[k] + wz_
#define WSF(name, off) float* name = (float*)(ws + (off))
#define WSH(name, off) bf16_t* name = (bf16_t*)(ws + (off))
    const int lo = a.ph_lo, hi = a.ph_hi;
    if (tid < 16) ((LAS unsigned*)(lds3 + LDS_BAR_OFF))[tid] = 0u;
    __syncthreads();
    XcdBarrier xbar = xcd_barrier_post((unsigned*)(a.ws + WS_CTL + OFF_XBAR), (volatile LAS unsigned*)(lds3 + LDS_BAR_OFF));
#ifndef PH_MASK
#define PH_MASK 0x7ff
#endif
#define IN(k) (((PH_MASK >> (k)) & 1) && lo <= (k) && (k) < hi)
#define SEAM(k) do { if (IN(k) && IN((k) + 1)) { asm volatile("s_waitcnt vmcnt(0) lgkmcnt(0)" ::: "memory"); grid.sync(); \
    __builtin_amdgcn_fence(__ATOMIC_ACQUIRE, "agent"); asm volatile("s_waitcnt vmcnt(0)" ::: "memory"); } } while (0)
#define SEAMX(k) do { if (IN(k) && IN((k) + 1)) xcd_barrier(xbar); } while (0)

    if (IN(0)) {
        WSB(); WSF(mod, WS_CTL + OFF_MOD); WSF(cosr, WS_COSR); WSF(sinr, WS_SINR); WSF(cosm, WS_COSM); WSF(sinm, WS_SINM);
        WSH(Win, WS_WIN); WSH(Wuq, WS_WUQ); WSH(Wukv, WS_WUKV); WSH(Wo, WS_WO); WSH(Wgu, WS_WGU); WSH(Wdn, WS_WDN);
        INP(cin, 1); INP(ada_w, 3); INP(ada_b, 4); INP(w_in, 6); INP(mla_q_norm_w, 10); INP(w_uq, 11); INP(mla_kv_norm_w, 12); INP(w_ukv, 13); INP(w_o, 15); INP(w_gate, 17); INP(w_up, 18); INP(w_down, 19);
        const int* positions = (const int*)a.in[2] + wz_;
        {
            LAS float* cs = (LAS float*)lds3;
            for (int i = tid; i < 8 * 2048; i += 512) { const int b = i >> 11, k = i & 2047; const float v = cin[i]; cs[k * 8 + b] = v / (1.f + __expf(-v)); }
            __syncthreads();
            for (int task = gw; task < 192 * 16; task += NGW) { const int cb = task % 192, ks = task / 192, col = cb * 64 + lane;
                float acc[8]; const float bias = ks == 0 ? ada_b[col] : 0.f;
#pragma unroll
                for (int b = 0; b < 8; ++b) acc[b] = bias;
                const float* wp = ada_w + (size_t)(ks * 128) * NMODC + col;
                for (int k8 = 0; k8 < 128; k8 += 8) { float wv[8];
#pragma unroll
                    for (int i = 0; i < 8; ++i) wv[i] = wp[(size_t)(k8 + i) * NMODC];
#pragma unroll
                    for (int i = 0; i < 8; ++i) { const LAS f32x4* c4 = (const LAS f32x4*)(cs + (ks * 128 + k8 + i) * 8); const f32x4 c0 = c4[0], c1 = c4[1];
                        acc[0] += c0.x * wv[i]; acc[1] += c0.y * wv[i]; acc[2] += c0.z * wv[i]; acc[3] += c0.w * wv[i]; acc[4] += c1.x * wv[i]; acc[5] += c1.y * wv[i]; acc[6] += c1.z * wv[i]; acc[7] += c1.w * wv[i]; } }
#pragma unroll
                for (int b = 0; b < 8; ++b) atomicAdd(mod + (size_t)b * NMODC + col, acc[b]); }
            __syncthreads();
        }
        {
            LAS float* scr = (LAS float*)(lds3 + wave * 16384);
            constexpr int I_IN = 32 * (INC / 32), I_UQ = 8 * 48, I_UKV = 8 * 64, I_O = 32 * 64, I_G = 32 * (DFF / 32), I_D = (DFF / 64) * 64;
            constexpr int NITEMS = I_IN + I_UQ + I_UKV + I_O + I_D;
            for (int it = gw; it < NITEMS; it += NGW) { int r = it;
                if (r < I_IN) { transpose_item(w_in, 2048, INC, Win, nullptr, 1, scr, r, lane); continue; } r -= I_IN;
                if (r < I_UQ) { transpose_item(w_uq, 512, 1536, Wuq, mla_q_norm_w, 2, scr, r, lane); continue; } r -= I_UQ;
                if (r < I_UKV) { transpose_item(w_ukv, 512, 2048, Wukv, mla_kv_norm_w, 0, scr, r, lane); continue; } r -= I_UKV;
                if (r < I_O) { transpose_item(w_o, 2048, 2048, Wo, nullptr, 0, scr, r, lane); continue; } r -= I_O;
                transpose_item(w_down, DFF, 2048, Wdn, nullptr, 0, scr, r, lane); }
            for (int i = bx * 512 + tid; i < (INCP - INC) * 2048 / 8; i += G * 512) *(v4u*)(Win + (size_t)INC * 2048 + (size_t)i * 8) = (v4u){0u, 0u, 0u, 0u};
        }
        {
            for (int i = bx * 512 + tid; i < T * 96; i += G * 512) { const int t = i / 96, j = i % 96; const float pos = (float)positions[t];
                const float inv = j < 64 ? a.inv_r[j] : a.inv_m[j - 64]; const float ang = pos * inv;
                double rev = (double)ang * 0.15915494309189535; rev -= __builtin_rint(rev);
                const double qd = __builtin_rint(rev * 4.0); const double y = (rev - qd * 0.25) * 6.283185307179586; const double y2 = y * y;
                const double sy = y * (1.0 + y2 * (-1.0 / 6 + y2 * (1.0 / 120 + y2 * (-1.0 / 5040 + y2 * (1.0 / 362880 + y2 * (-1.0 / 39916800 + y2 * (1.0 / 6227020800.0)))))));
                const double cy = 1.0 + y2 * (-0.5 + y2 * (1.0 / 24 + y2 * (-1.0 / 720 + y2 * (1.0 / 40320 + y2 * (-1.0 / 3628800 + y2 * (1.0 / 479001600.0 + y2 * (-1.0 / 87178291200.0)))))));
                const int qi = (int)qd & 3;
                const float cv = (float)(qi == 0 ? cy : qi == 1 ? -sy : qi == 2 ? -cy : sy), sv = (float)(qi == 0 ? sy : qi == 1 ? cy : qi == 2 ? -sy : -cy);
                if (j < 64) { cosr[(size_t)t * 64 + j] = cv; sinr[(size_t)t * 64 + j] = sv; } else { cosm[(size_t)t * 32 + j - 64] = cv; sinm[(size_t)t * 32 + j - 64] = sv; } }
        }
    }
    SEAMX(0);
    if (a.ph_hi > 1000) { SEAM(0); }
    if (IN(1)) { WSB(); WSF(mod, WS_CTL + OFF_MOD); WSH(H, WS_H); INP(x, 0); INP(norm1_w, 5);
        for (int m = gw; m < T; m += NGW) { const int b = m >> 12; norm_row(x + (size_t)m * DM, norm1_w, mod + (size_t)b * NMODC, mod + (size_t)b * NMODC + DM, H + (size_t)m * DM, nullptr, lane); } }
    SEAMX(1);
    if (IN(2)) {
        WSB(); WSH(H, WS_H); WSH(Win, WS_WIN); WSH(Qr, WS_QR); WSH(Kr, WS_KR); WSH(Vr, WS_VR); WSH(Gr, WS_GR); WSH(CQ, WS_CQ); WSH(CKV, WS_CKV); WSH(Kbuf, WS_KB);
        WSF(cosr, WS_COSR); WSF(sinr, WS_SINR); WSF(cosm, WS_COSM); WSF(sinm, WS_SINM); WSF(ssq_q, WS_CTL + OFF_SSQQ); WSF(ssq_kv, WS_CTL + OFF_SSQKV);
        pg8::Gemm g{H, Win, T, INCP, DM}; pg8::StaticOrder S; S.init(T, INCP, G, bx);
        pg8::EpiIn E{Qr, Kr, Vr, Gr, CQ, CKV, Kbuf, cosr, sinr, cosm, sinm, ssq_q, ssq_kv};
        pg8::gemm_phase<pg8::EpiIn, pg8::StaticOrder, true, true>(lds3, g, S, E);
        {
            constexpr int I_G = 32 * (DFF / 32); const int first = ((T / 256) * (INCP / 256)) % G, nsw = (G - first) * 8;
            if (bx >= first) { WSH(Wgu, WS_WGU); INP(w_gate, 17); INP(w_up, 18); LAS float* scr = (LAS float*)(lds3 + wave * 16384); const int wi = (bx - first) * 8 + wave;
                for (int it = wi; it < 2 * I_G; it += nsw) { if (it < I_G) transpose_item(w_gate, 2048, DFF, Wgu, nullptr, 3, scr, it, lane); else transpose_item(w_up, 2048, DFF, Wgu, nullptr, 4, scr, it - I_G, lane); } }
        }
    }
    SEAMX(2);
    if (IN(3)) {
        WSB(); WSH(CQ, WS_CQ); WSH(CKV, WS_CKV); WSH(Wuq, WS_WUQ); WSH(Wukv, WS_WUKV); WSH(Qm, WS_QM); WSH(Kbuf, WS_KB); WSH(Vm, WS_VM); WSH(Kr, WS_KR); WSH(Vr, WS_VR); WSH(CK, WS_H);
        WSF(cosm, WS_COSM); WSF(sinm, WS_SINM); WSF(ssq_q, WS_CTL + OFF_SSQQ); WSF(ssq_kv, WS_CTL + OFF_SSQKV); INP(ret_decay, 7);
        { pg8::Gemm g{CQ, Wuq, T, 1536, 512}; pg8::StaticOrder S; S.init(T, 1536, G, bx); pg8::EpiUpQ E{ssq_q, Qm, cosm, sinm};
          pg8::gemm_phase<pg8::EpiUpQ, pg8::StaticOrder, true, true>(lds3, g, S, E); }
        { pg8::Gemm g{CKV, Wukv, T, 2048, 512}; pg8::StaticOrder S; S.init(T, 2048, G, bx); pg8::EpiUpKV E{ssq_kv, Kbuf, Vm};
          pg8::gemm_phase<pg8::EpiUpKV, pg8::StaticOrder, true, true>(lds3, g, S, E); }
        for (int u = vcu; u < 2048; u += G) { const int n = u & 31, h = (u >> 5) & 7, b = u >> 8; const size_t t0 = (size_t)b * SEQ + n * 128;
            const float lgf = -__expf(ret_decay[h]) * 1.4426950408889634f, lgb = -__expf(ret_decay[8 + h]) * 1.4426950408889634f;
            att::chunk_kv_unit(Kr + t0 * 1024 + h * 128, Vr + t0 * 1024 + h * 128, CK + ((size_t)(b * 8 + h) * 32 + n) * 16384, CK + ((size_t)(64 + b * 8 + h) * 32 + n) * 16384, lgf, lgb, ldsg, ldsaddr); }
        __syncthreads();
    }
    SEAMX(3);
    if (IN(4)) {
        WSB(); WSH(Qm, WS_QM); WSH(Kbuf, WS_KB); WSH(Vm, WS_VM); WSH(Oat, WS_OAT); WSH(CK, WS_H); INP(ret_decay, 7);
        for (int u = vcu; u < 1024; u += G) { const int qb = u & 15, h = (u >> 4) & 7, b = u >> 7; const size_t r0 = (size_t)b * SEQ;
            att::attn_unit(Qm + (r0 + qb * 256) * 1536 + h * 192, Kbuf + r0 * 1536 + h * 192, Vm + r0 * 1024 + h * 128, Oat + (r0 + qb * 256) * 1024 + h * 128, SEQ, ldsg, ldsaddr); }
#ifndef NO_SCAN
        for (int idx = bx * 512 + tid; idx < 2 * 64 * 2048; idx += G * 512) { const int dir = idx >> 17, bh = (idx >> 11) & 63, e8 = idx & 2047, h = bh & 7;
            const float cd = __builtin_amdgcn_exp2f(-__expf(ret_decay[dir * 8 + h]) * 1.4426950408889634f * 128.f);
            bf16_t* base = CK + ((size_t)(dir * 64 + bh) * 32) * 16384 + e8 * 8; float st[8];
#pragma unroll
            for (int i = 0; i < 8; ++i) st[i] = 0.f;
            for (int s8 = 0; s8 < 32; s8 += 8) { v4u kv[8];
#pragma unroll
                for (int i = 0; i < 8; ++i) { const int m = dir ? 31 - (s8 + i) : s8 + i; kv[i] = *(const v4u*)(base + (size_t)m * 16384); }
#pragma unroll
                for (int i = 0; i < 8; ++i) { const int m = dir ? 31 - (s8 + i) : s8 + i; v4u o;
                    o.x = pk2a(st[0], st[1]); o.y = pk2a(st[2], st[3]); o.z = pk2a(st[4], st[5]); o.w = pk2a(st[6], st[7]);
                    *(v4u*)(base + (size_t)m * 16384) = o;
#pragma unroll
                    for (int q = 0; q < 4; ++q) { const unsigned w = kv[i][q]; st[2 * q] = st[2 * q] * cd + __uint_as_float(w << 16); st[2 * q + 1] = st[2 * q + 1] * cd + __uint_as_float(w & 0xffff0000u); } } }
        }
#endif
    }
    SEAMX(4);
    if (IN(5)) {
        WSB(); WSH(Qr, WS_QR); WSH(Kr, WS_KR); WSH(Vr, WS_VR); WSH(Gr, WS_GR); WSH(CK, WS_H); WSH(Cat, WS_CAT); WSH(Oat, WS_OAT); INP(ret_decay, 7); INP(ret_gn_w, 8); INP(ret_gn_b, 9); INP(mla_out_w, 14);
#if PROBE_BRUTE_RET
        float* dumpb = (float*)(ws + 704 * MiB);
        for (int up = vcu; up < 1024; up += G) {
            if (PROBE_COMP != 0) { const int u = up * 2 + (wave >> 2); const int n = u & 31, h = (u >> 5) & 7, b = u >> 8; const size_t t0 = (size_t)b * SEQ + n * 128;
                const float lgf = -__expf(ret_decay[h]) * 1.4426950408889634f, lgb = -__expf(ret_decay[8 + h]) * 1.4426950408889634f; const int hf = wave >> 2;
                att::ret_out_unit(Qr + t0 * 1024 + h * 128, Kr + t0 * 1024 + h * 128, Vr + t0 * 1024 + h * 128, Gr + t0 * 1024 + h * 128,
                                  CK + ((size_t)(b * 8 + h) * 32 + n) * 16384, CK + ((size_t)(64 + b * 8 + h) * 32 + n) * 16384, ret_gn_w + h * 128, ret_gn_b + h * 128,
                                  Cat + t0 * 2048 + h * 128, lgf, lgb, ldsg + hf * 65536, ldsaddr + hf * 65536, dumpb + t0 * 1024 + h * 128);
                __threadfence(); __syncthreads(); }
            for (int k2 = 0; k2 < 2; ++k2) { const int u = up * 2 + k2; const int n = u & 31, h = (u >> 5) & 7, b = u >> 8; const size_t r0 = (size_t)b * SEQ, t0 = r0 + n * 128;
                const float lgf = -__expf(ret_decay[h]) * 1.4426950408889634f, lgb = -__expf(ret_decay[8 + h]) * 1.4426950408889634f;
                att::ret_brute_unit(Qr + r0 * 1024 + h * 128, Kr + r0 * 1024 + h * 128, Vr + r0 * 1024 + h * 128, Gr + t0 * 1024 + h * 128, ret_gn_w + h * 128, ret_gn_b + h * 128, Cat + t0 * 2048 + h * 128, n * 128, lgf, lgb, ldsg, dumpb + t0 * 1024 + h * 128); } }
        __syncthreads();
        for (int up = vcu; up < 0; up += G) { const int u = up * 2 + (wave >> 2);
#else
        for (int up = vcu; up < 1024; up += G) { const int u = up * 2 + (wave >> 2);
#endif
            const int n = u & 31, h = (u >> 5) & 7, b = u >> 8; const size_t t0 = (size_t)b * SEQ + n * 128;
            const float lgf = -__expf(ret_decay[h]) * 1.4426950408889634f, lgb = -__expf(ret_decay[8 + h]) * 1.4426950408889634f; const int hf = wave >> 2;
            att::ret_out_unit(Qr + t0 * 1024 + h * 128, Kr + t0 * 1024 + h * 128, Vr + t0 * 1024 + h * 128, Gr + t0 * 1024 + h * 128,
                              CK + ((size_t)(b * 8 + h) * 32 + n) * 16384, CK + ((size_t)(64 + b * 8 + h) * 32 + n) * 16384, ret_gn_w + h * 128, ret_gn_b + h * 128,
                              Cat + t0 * 2048 + h * 128, lgf, lgb, ldsg + hf * 65536, ldsaddr + hf * 65536); }
        for (int m = gw; m < T; m += NGW) {
            const bf16_t* orow = Oat + (size_t)m * 1024; float v[16]; float s = 0.f;
#pragma unroll
            for (int j = 0; j < 2; ++j) { const v4u w = *(const v4u*)(orow + lane * 8 + 512 * j);
#pragma unroll
                for (int q = 0; q < 4; ++q) { v[j * 8 + 2 * q] = __uint_as_float(w[q] << 16); v[j * 8 + 2 * q + 1] = __uint_as_float(w[q] & 0xffff0000u); } }
#pragma unroll
            for (int i = 0; i < 16; ++i) s += v[i] * v[i];
            const float rstd = rsqrtf(wave_sum(s) * (1.f / 1024.f) + 1e-6f);
#pragma unroll
            for (int j = 0; j < 2; ++j) { const int col = lane * 8 + 512 * j; const f32x4 w0 = *(const f32x4*)(mla_out_w + col), w1 = *(const f32x4*)(mla_out_w + col + 4); v4u o;
                o.x = pk2a(v[j * 8 + 0] * rstd * w0.x, v[j * 8 + 1] * rstd * w0.y); o.y = pk2a(v[j * 8 + 2] * rstd * w0.z, v[j * 8 + 3] * rstd * w0.w);
                o.z = pk2a(v[j * 8 + 4] * rstd * w1.x, v[j * 8 + 5] * rstd * w1.y); o.w = pk2a(v[j * 8 + 6] * rstd * w1.z, v[j * 8 + 7] * rstd * w1.w);
                *(v4u*)(Cat + (size_t)m * 2048 + 1024 + col) = o; } }
        __syncthreads();
    }
    SEAMX(5);
    if (IN(6)) {
        WSB(); WSH(Cat, WS_CAT); WSH(Wo, WS_WO); WSF(mod, WS_CTL + OFF_MOD); INP(x, 0);
        pg8::Gemm g{Cat, Wo, T, 2048, 2048}; pg8::StaticOrder S; S.init(T, 2048, G, bx); pg8::EpiGateRes E{x, mod + 2 * DM, out};
        pg8::gemm_phase<pg8::EpiGateRes, pg8::StaticOrder, true, true>(lds3, g, S, E);
    }
    SEAMX(6);
    if (IN(7)) { WSB(); WSF(mod, WS_CTL + OFF_MOD); WSH(H, WS_H); INP(norm2_w, 16);
        for (int m = gw; m < T; m += NGW) { const int b = m >> 12; norm_row(out + (size_t)m * DM, norm2_w, mod + (size_t)b * NMODC + 3 * DM, mod + (size_t)b * NMODC + 4 * DM, H + (size_t)m * DM, nullptr, lane); } }
    SEAMX(7);
    if (IN(8)) {
        WSB(); WSH(H, WS_H); WSH(Wgu, WS_WGU); WSH(Aff, WS_AFF);
        pg8::Gemm g{H, Wgu, T, 2 * DFF, DM}; pg8::StaticOrder S; S.init(T, 2 * DFF, G, bx); pg8::EpiGU E{Aff};
        pg8::gemm_phase<pg8::EpiGU, pg8::StaticOrder, true, true>(lds3, g, S, E);
    }
    SEAMX(8);
    if (IN(9)) {
        WSB(); WSH(Aff, WS_AFF); WSH(Wdn, WS_WDN); WSF(mod, WS_CTL + OFF_MOD);
        pg8::Gemm g{Aff, Wdn, T, 2048, DFF}; pg8::StaticOrder S; S.init(T, 2048, G, bx); pg8::EpiGateRes E{out, mod + 5 * DM, out};
        pg8::gemm_phase<pg8::EpiGateRes, pg8::StaticOrder, true, true>(lds3, g, S, E);
    }
    SEAMX(9);
    if (IN(10)) { WSB(); (void)ws; INP(final_norm_w, 20);
        for (int m = gw; m < T; m += NGW) norm_row(out + (size_t)m * DM, final_norm_w, nullptr, nullptr, nullptr, out + (size_t)m * DM, lane); }
#undef IN
#undef SEAM
}

extern "C" void kernel_launch(void* const* d_in, const int* in_sizes, int n_in, void* d_out, int out_size, void* d_ws, size_t ws_size, hipStream_t stream) {
    static int grid = 0;
    if (grid == 0) {
        if (n_in != 21 || in_sizes[0] != T * DM || out_size != T * DM || ws_size < WS_END) { fprintf(stderr, "kernel_launch: shape/workspace mismatch (n_in %d, ws %zu < %zu)\n", n_in, ws_size, (size_t)WS_END); grid = -1; return; }
        int dev = 0, cus = 0, per_cu = 0;
        (void)hipGetDevice(&dev); (void)hipDeviceGetAttribute(&cus, hipDeviceAttributeMultiprocessorCount, dev);
        if (hipFuncSetAttribute((const void*)mk_fwd, hipFuncAttributeMaxDynamicSharedMemorySize, LDS_BYTES) != hipSuccess) { fprintf(stderr, "kernel_launch: hipFuncSetAttribute failed\n"); grid = -1; return; }
        if (hipOccupancyMaxActiveBlocksPerMultiprocessor(&per_cu, (const void*)mk_fwd, 512, LDS_BYTES) != hipSuccess || per_cu < 1) { fprintf(stderr, "kernel_launch: occupancy query gave %d\n", per_cu); per_cu = 1; }
        (void)hipGetLastError();
        grid = cus * per_cu;
    }
    if (grid < 0) return;
    (void)hipMemsetAsync((char*)d_ws + WS_CTL, 0, CTL_ZERO_BYTES, stream);
    Args a{};
    for (int i = 0; i < 21; ++i) a.in[i] = (const float*)d_in[i];
    a.out = (float*)d_out; a.ws = (unsigned char*)d_ws;
    for (int i = 0; i < 64; ++i) a.inv_r[i] = powf(10000.0f, -((float)(2 * i)) / 128.0f);
    for (int i = 0; i < 32; ++i) a.inv_m[i] = powf(10000.0f, -((float)(2 * i)) / 64.0f);
#if MK_SPLIT
    for (int p = 0; p < NPH; ++p) { a.ph_lo = p; a.ph_hi = p + 1; hipLaunchKernelGGL(mk_fwd, dim3(grid), dim3(512), LDS_BYTES, stream, a); }
#else
    a.ph_lo = 0; a.ph_hi = NPH;
    void* args[] = {&a};
    hipError_t e = hipLaunchCooperativeKernel((const void*)mk_fwd, dim3(grid), dim3(512), args, LDS_BYTES, stream);
    if (e != hipSuccess) fprintf(stderr, "kernel_launch: cooperative launch failed: %s (grid %d)\n", hipGetErrorString(e), grid);
#endif
}
```

```cpp
#include <hip/hip_runtime.h>
#include <hip/hip_cooperative_groups.h>
#include <cstdio>
#include <cstdint>
#include <cmath>
namespace cg = cooperative_groups;
namespace pg8 {
#define PG8_LAS __attribute__((address_space(3)))
typedef unsigned short bf16_t;
typedef short bf16x8 __attribute__((ext_vector_type(8)));
typedef float f32x4 __attribute__((ext_vector_type(4)));
typedef unsigned u32x4 __attribute__((ext_vector_type(4)));
constexpr int BM = 256, BK = 64, HALF = 128, HTB = HALF * BK * 2  , STAGE_BYTES = 8 * HTB, NXCD = 8, WGM = 8;

__host__ __device__ __forceinline__ int lds_byte(int r, int c) { const int st = (r >> 4) * 2 + (c >> 5), rr = r & 15, cc = c & 31, ob = rr * 64 + cc * 2; return st * 1024 + (ob ^ (((ob >> 9) & 1) << 5)); }
__host__ __device__ __forceinline__ void stage_rc(int b, int& R, int& C) { const int st = b / 1024, sb = b % 1024, swz = sb ^ (((sb >> 9) & 1) << 5); R = (st >> 1) * 16 + swz / 64; C = (st & 1) * 32 + (swz % 64) / 2; }
__host__ __device__ __forceinline__ int perm32(int rho) { const int n = rho >> 4, i = rho & 15; return 8 * (i >> 2) + 4 * n + (i & 3); }

struct Unit { int pm, pn; };
struct Gemm { const bf16_t* A; const bf16_t* Bt; int M, N, K; };

struct StaticOrder {
    int nM, nN, nwg, G, c;
    __host__ __device__ void init(int M, int N, int G_, int c_) { nM = M / BM; nN = N / BM; nwg = nM * nN; G = G_; c = c_; }
    __host__ __device__ bool next(int i, Unit& u) const {
        const long L = (long)i * G + c; if (L >= nwg) return false;
        int wgid = (int)L; { const int q = nwg / NXCD, r = nwg % NXCD, xcd = wgid % NXCD, off = wgid / NXCD; wgid = (xcd < r ? xcd * (q + 1) : r * (q + 1) + (xcd - r) * q) + off; }
        const int nig = WGM * nN, gid = wgid / nig, fm = gid * WGM, gsz = (nM - fm) < WGM ? (nM - fm) : WGM;
        u.pm = fm + ((wgid % nig) % gsz); u.pn = (wgid % nig) / gsz; return true;
    }
    __device__ __forceinline__ void a_ready(const Unit&) const {}
    __device__ __forceinline__ void done(const Unit&) const {}
};

#ifndef PROBE_COARSE_ACT
#define PROBE_COARSE_ACT 0
#endif
__device__ __forceinline__ unsigned coarse2(unsigned w) { return PROBE_COARSE_ACT ? ((w + ((w >> 1) & 0x00010001u)) & 0xfffefffeu) : w; }
__device__ __forceinline__ unsigned cvt_pk_bf16(float lo, float hi) { unsigned r; asm volatile("v_cvt_pk_bf16_f32 %0, %1, %2" : "=v"(r) : "v"(lo), "v"(hi)); return coarse2(r); }
typedef float f32x2 __attribute__((ext_vector_type(2)));

typedef unsigned u32x2 __attribute__((ext_vector_type(2)));
__device__ __forceinline__ float silu_f(float v) { return v * __builtin_amdgcn_rcpf(1.f + __builtin_amdgcn_exp2f(v * -1.4426950408889634f)); }
__device__ __forceinline__ u32x4 pack8(f32x4 a, f32x4 b) { u32x4 w; w.x = cvt_pk_bf16(a[0], a[1]); w.y = cvt_pk_bf16(a[2], a[3]); w.z = cvt_pk_bf16(b[0], b[1]); w.w = cvt_pk_bf16(b[2], b[3]); return w; }
__device__ __forceinline__ void rope8(f32x4& a, f32x4& b, const f32x4 c, const f32x4 s) {
    float t1, t2;
    t1 = a[0]; t2 = a[1]; a[0] = t1 * c[0] - t2 * s[0]; a[1] = t2 * c[0] + t1 * s[0];
    t1 = a[2]; t2 = a[3]; a[2] = t1 * c[1] - t2 * s[1]; a[3] = t2 * c[1] + t1 * s[1];
    t1 = b[0]; t2 = b[1]; b[0] = t1 * c[2] - t2 * s[2]; b[1] = t2 * c[2] + t1 * s[2];
    t1 = b[2]; t2 = b[3]; b[2] = t1 * c[3] - t2 * s[3]; b[3] = t2 * c[3] + t1 * s[3];
}
constexpr float NORM_EPS = 1e-6f;

struct EpiIn {
    static constexpr bool PERM = true, AFTER_DRAIN = false;
    bf16_t *Qr, *Kr, *Vr, *Gr, *CQ, *CKV, *Kbuf; const float *cosr, *sinr, *cosm, *sinm; float *ssq_q, *ssq_kv;
    __device__ __forceinline__ void operator()(const f32x4 (&acc)[2][2][4][2], const Unit& u, int wr, int wc, int fr, int fq) const {
        const int pn = u.pn, row0 = u.pm * BM + wr * 64 + fr, cl = wc * 32 + 8 * fq;
        if (pn < 8) {
            bf16_t* O = pn < 4 ? Qr : Kr; const float sc = pn < 4 ? 1.f : 0.08838834764831845f; const int colt = (pn & 3) * 256 + cl;
#pragma unroll
            for (int ai = 0; ai < 2; ++ai)
#pragma unroll
                for (int m = 0; m < 4; ++m) { const int row = row0 + ai * HALF + m * 16;
                    const f32x4 c4 = *(const f32x4*)(cosr + (size_t)row * 64 + (cl >> 1)), s4 = *(const f32x4*)(sinr + (size_t)row * 64 + (cl >> 1));
#pragma unroll
                    for (int bj = 0; bj < 2; ++bj) { f32x4 a = acc[ai][bj][m][0], b = acc[ai][bj][m][1]; rope8(a, b, c4, s4); a = a * sc; b = b * sc;
                        *(u32x4*)(O + (size_t)row * 1024 + colt + bj * HALF) = pack8(a, b); } }
        } else if (pn < 16) {
            const bool isg = pn >= 12; bf16_t* O = isg ? Gr : Vr; const int colt = (pn & 3) * 256 + cl;
#pragma unroll
            for (int ai = 0; ai < 2; ++ai)
#pragma unroll
                for (int m = 0; m < 4; ++m) { const int row = row0 + ai * HALF + m * 16;
#pragma unroll
                    for (int bj = 0; bj < 2; ++bj) { f32x4 a = acc[ai][bj][m][0], b = acc[ai][bj][m][1];
                        if (isg) {
#pragma unroll
                            for (int i = 0; i < 4; ++i) { a[i] = silu_f(a[i]); b[i] = silu_f(b[i]); } }
                        *(u32x4*)(O + (size_t)row * 1024 + colt + bj * HALF) = pack8(a, b); } }
        } else if (pn < 20) {
            bf16_t* O = pn < 18 ? CQ : CKV; float* sq = pn < 18 ? ssq_q : ssq_kv; const int colt = (pn & 1) * 256 + cl;
#pragma unroll
            for (int ai = 0; ai < 2; ++ai)
#pragma unroll
                for (int m = 0; m < 4; ++m) { const int row = row0 + ai * HALF + m * 16; float s = 0.f;
#pragma unroll
                    for (int bj = 0; bj < 2; ++bj) { const f32x4 a = acc[ai][bj][m][0], b = acc[ai][bj][m][1];
                        s += (a[0] * a[0] + a[1] * a[1]) + (a[2] * a[2] + a[3] * a[3]) + (b[0] * b[0] + b[1] * b[1]) + (b[2] * b[2] + b[3] * b[3]);
                        *(u32x4*)(O + (size_t)row * 512 + colt + bj * HALF) = pack8(a, b); }
                    s += __shfl_xor(s, 16); s += __shfl_xor(s, 32);
                    if (fq == 0) atomicAdd(sq + row, s); }
        } else {
            if (wc < 2) {
#pragma unroll
                for (int ai = 0; ai < 2; ++ai)
#pragma unroll
                    for (int m = 0; m < 4; ++m) { const int row = row0 + ai * HALF + m * 16;
                        const f32x4 c4 = *(const f32x4*)(cosm + (size_t)row * 32 + (cl >> 1)), s4 = *(const f32x4*)(sinm + (size_t)row * 32 + (cl >> 1));
                        f32x4 a = acc[ai][0][m][0], b = acc[ai][0][m][1]; rope8(a, b, c4, s4); const u32x4 w = pack8(a, b);
#pragma unroll
                        for (int h = 0; h < 8; ++h) *(u32x4*)(Kbuf + (size_t)row * 1536 + h * 192 + 128 + cl) = w; }
            }
        }
    }
};
struct EpiUpQ {
    static constexpr bool PERM = true, AFTER_DRAIN = false;
    const float* ssq; bf16_t* Qm; const float *cosm, *sinm;
    __device__ __forceinline__ void operator()(const f32x4 (&acc)[2][2][4][2], const Unit& u, int wr, int wc, int fr, int fq) const {
        const int row0 = u.pm * BM + wr * 64 + fr, cl = wc * 32 + 8 * fq;
#pragma unroll
        for (int ai = 0; ai < 2; ++ai)
#pragma unroll
            for (int m = 0; m < 4; ++m) { const int row = row0 + ai * HALF + m * 16; const float rstd = rsqrtf(ssq[row] * (1.f / 512.f) + NORM_EPS);
#pragma unroll
                for (int bj = 0; bj < 2; ++bj) { const int c = u.pn * 256 + bj * HALF + cl, d = c % 192; f32x4 a = acc[ai][bj][m][0] * rstd, b = acc[ai][bj][m][1] * rstd;
                    if (d >= 128) { const int fi = (d - 128) >> 1; const f32x4 c4 = *(const f32x4*)(cosm + (size_t)row * 32 + fi), s4 = *(const f32x4*)(sinm + (size_t)row * 32 + fi); rope8(a, b, c4, s4); }
                    *(u32x4*)(Qm + (size_t)row * 1536 + c) = pack8(a, b); } }
    }
};
struct EpiUpKV {
    static constexpr bool PERM = true, AFTER_DRAIN = false;
    const float* ssq; bf16_t *Kbuf, *Vm;
    __device__ __forceinline__ void operator()(const f32x4 (&acc)[2][2][4][2], const Unit& u, int wr, int wc, int fr, int fq) const {
        const int row0 = u.pm * BM + wr * 64 + fr, cl = wc * 32 + 8 * fq;
#pragma unroll
        for (int ai = 0; ai < 2; ++ai)
#pragma unroll
            for (int m = 0; m < 4; ++m) { const int row = row0 + ai * HALF + m * 16; const float rstd = rsqrtf(ssq[row] * (1.f / 512.f) + NORM_EPS);
                *(u32x4*)(Kbuf + (size_t)row * 1536 + u.pn * 192 + cl) = pack8(acc[ai][0][m][0] * rstd, acc[ai][0][m][1] * rstd);
                *(u32x4*)(Vm + (size_t)row * 1024 + u.pn * 128 + cl) = pack8(acc[ai][1][m][0] * rstd, acc[ai][1][m][1] * rstd); }
    }
};
struct EpiGateRes {
    static constexpr bool PERM = true, AFTER_DRAIN = false;
    const float* x; const float* gate; float* out;
    __device__ __forceinline__ void operator()(const f32x4 (&acc)[2][2][4][2], const Unit& u, int wr, int wc, int fr, int fq) const {
        const int row0 = u.pm * BM + wr * 64 + fr, cl = wc * 32 + 8 * fq, b = u.pm >> 4;
#pragma unroll
        for (int bj = 0; bj < 2; ++bj) { const int c = u.pn * 256 + bj * HALF + cl;
            const f32x4 g0 = *(const f32x4*)(gate + (size_t)b * 12288 + c), g1 = *(const f32x4*)(gate + (size_t)b * 12288 + c + 4);
#pragma unroll
            for (int ai = 0; ai < 2; ++ai)
#pragma unroll
                for (int m = 0; m < 4; ++m) { const size_t off = (size_t)(row0 + ai * HALF + m * 16) * 2048 + c;
                    const f32x4 x0 = *(const f32x4*)(x + off), x1 = *(const f32x4*)(x + off + 4);
                    *(f32x4*)(out + off) = x0 + g0 * acc[ai][bj][m][0]; *(f32x4*)(out + off + 4) = x1 + g1 * acc[ai][bj][m][1]; } }
    }
};
struct EpiGU {
    static constexpr bool PERM = true, AFTER_DRAIN = false;
    bf16_t* Aff;
    __device__ __forceinline__ void operator()(const f32x4 (&acc)[2][2][4][2], const Unit& u, int wr, int wc, int fr, int fq) const {
        const int row0 = u.pm * BM + wr * 64 + fr, cl = wc * 32 + 8 * fq;
#pragma unroll
        for (int ai = 0; ai < 2; ++ai)
#pragma unroll
            for (int m = 0; m < 4; ++m) { const int row = row0 + ai * HALF + m * 16; f32x4 a, b;
#pragma unroll
                for (int i = 0; i < 4; ++i) { a[i] = silu_f(acc[ai][0][m][0][i]) * acc[ai][1][m][0][i]; b[i] = silu_f(acc[ai][0][m][1][i]) * acc[ai][1][m][1][i]; }
                *(u32x4*)(Aff + (size_t)row * 5632 + u.pn * 128 + cl) = pack8(a, b); }
    }
};

template <class Epi, class Sched, bool ALIGN_EPI = false, bool SP2 = false>
__device__ __forceinline__ void gemm_phase(PG8_LAS unsigned char* lds, const Gemm g, const Sched& S, const Epi& E) {
    const int tid = threadIdx.x, wid = __builtin_amdgcn_readfirstlane(tid >> 6), lane = tid & 63, wr = wid >> 2, wc = wid & 3, fr = lane & 15, fq = lane >> 4;
    const int K = g.K, nt = K / BK;
    unsigned voffA[2], voffB[2];
#pragma unroll
    for (int i = 0; i < 2; ++i) { int R, C; stage_rc(tid * 16 + i * 8192, R, C); const int Rb = Epi::PERM ? ((R & ~31) + perm32(R & 31)) : R;
        voffA[i] = (unsigned)(R * K + C) * 2u; voffB[i] = (unsigned)(Rb * K + C) * 2u; }
    const size_t kstep = (size_t)(BK * 2);
    const size_t hstep = (size_t)HALF * K * 2;
    const size_t tstep = 2 * hstep;
    const unsigned ldsw = (unsigned)wid * 1024u;
    const int aoff = lds_byte(wr * 64 + fr, fq * 8), boff = lds_byte(wc * 32 + fr, fq * 8);
#define PG8_SA(b, h) (((b) * 2 + (h)) * HTB)
#define PG8_SB(b, h) ((4 + (b) * 2 + (h)) * HTB)
#define PG8_STAGE(bufoff, gbase, voff) do { _Pragma("unroll") for (int _i = 0; _i < 2; ++_i) \
        __builtin_amdgcn_global_load_lds((const unsigned*)((const char*)(gbase) + (voff)[_i]), (PG8_LAS unsigned*)(lds + (bufoff) + ldsw + _i * 8192), 16, 0, 0); } while (0)
#define PG8_LDA(dst, b, h) do { _Pragma("unroll") for (int m = 0; m < 4; ++m) _Pragma("unroll") for (int k = 0; k < 2; ++k) dst[m][k] = *(const PG8_LAS bf16x8*)(lds + PG8_SA(b, h) + aoff + m * 2048 + k * 1024); } while (0)
#define PG8_LDB(dst, b, h) do { _Pragma("unroll") for (int n = 0; n < 2; ++n) _Pragma("unroll") for (int k = 0; k < 2; ++k) dst[n][k] = *(const PG8_LAS bf16x8*)(lds + PG8_SB(b, h) + boff + n * 2048 + k * 1024); } while (0)
#define PG8_MMA(ai, bj, At, Bt) do { __builtin_amdgcn_s_setprio(1); _Pragma("unroll") for (int m = 0; m < 4; ++m) _Pragma("unroll") for (int n = 0; n < 2; ++n) _Pragma("unroll") for (int k = 0; k < 2; ++k) \
        acc[ai][bj][m][n] = __builtin_amdgcn_mfma_f32_16x16x32_bf16(Bt[n][k], At[m][k], acc[ai][bj][m][n], 0, 0, 0); __builtin_amdgcn_s_setprio(0); } while (0)
#define PG8_WAIT_V(n) asm volatile("s_waitcnt vmcnt(" #n ")" ::: "memory")
#define PG8_WAIT_L(n) asm volatile("s_waitcnt lgkmcnt(" #n ")" ::: "memory")
#define PG8_BAR __builtin_amdgcn_s_barrier()
#define PG8_SCHED __builtin_amdgcn_sched_barrier(0)
    Unit cur, nxt; int ui = 0;
    if (!S.next(0, cur)) return;
    f32x4 acc[2][2][4][2];
#pragma unroll
    for (int a = 0; a < 2; ++a)
#pragma unroll
        for (int b = 0; b < 2; ++b)
#pragma unroll
            for (int m = 0; m < 4; ++m)
#pragma unroll
                for (int n = 0; n < 2; ++n) acc[a][b][m][n] = (f32x4){0.f, 0.f, 0.f, 0.f};
    bf16x8 At[4][2], B0[2][2], B1[2][2];
    const char* cA = (const char*)g.A + (size_t)cur.pm * tstep; const char* cB = (const char*)g.Bt + (size_t)cur.pn * tstep;
    S.a_ready(cur);
    if constexpr (SP2) {
        PG8_STAGE(PG8_SB(0, 0), cB, voffB); PG8_STAGE(PG8_SB(0, 1), cB + hstep, voffB); PG8_STAGE(PG8_SA(0, 0), cA, voffA); PG8_STAGE(PG8_SA(0, 1), cA + hstep, voffA);
        if (wr == 1) PG8_BAR;
        PG8_WAIT_V(2); PG8_BAR;
        PG8_STAGE(PG8_SB(1, 0), cB + kstep, voffB); PG8_STAGE(PG8_SA(1, 0), cA + kstep, voffA); PG8_STAGE(PG8_SB(1, 1), cB + hstep + kstep, voffB);
        PG8_WAIT_V(6); PG8_BAR;
    } else {
        PG8_STAGE(PG8_SB(0, 0), cB, voffB); PG8_STAGE(PG8_SA(0, 0), cA, voffA); PG8_STAGE(PG8_SB(0, 1), cB + hstep, voffB); PG8_STAGE(PG8_SA(0, 1), cA + hstep, voffA);
        if (wr == 1) PG8_BAR;
        PG8_WAIT_V(4); PG8_BAR;
        PG8_STAGE(PG8_SB(1, 0), cB + kstep, voffB); PG8_STAGE(PG8_SA(1, 0), cA + kstep, voffA); PG8_STAGE(PG8_SB(1, 1), cB + hstep + kstep, voffB);
        PG8_WAIT_V(6); PG8_BAR;
    }
    for (;;) {
        const bool has_next = S.next(ui + 1, nxt);
        const char* nA = has_next ? (const char*)g.A + (size_t)nxt.pm * tstep : cA; const char* nB = has_next ? (const char*)g.Bt + (size_t)nxt.pn * tstep : cB;
        for (int t = 0; t < nt; t += 2) {
            const bool last = (t == nt - 2);
            const char* a1 = cA + (size_t)(t + 1) * kstep;
            const char* a2 = last ? nA : cA + (size_t)(t + 2) * kstep; const char* b2 = last ? nB : cB + (size_t)(t + 2) * kstep;
            const char* a3 = a2 + kstep; const char* b3 = b2 + kstep;
            if (last && has_next) S.a_ready(nxt);
            if constexpr (SP2) {
            PG8_LDB(B0, 0, 0); PG8_LDB(B1, 0, 1); PG8_SCHED; PG8_LDA(At, 0, 0); PG8_STAGE(PG8_SA(1, 1), a1 + hstep, voffA);
            PG8_WAIT_V(8); PG8_WAIT_L(0); PG8_BAR; PG8_MMA(0, 0, At, B0); PG8_MMA(0, 1, At, B1); PG8_BAR; PG8_SCHED;
            PG8_LDA(At, 0, 1); PG8_STAGE(PG8_SB(0, 0), b2, voffB); PG8_STAGE(PG8_SB(0, 1), b2 + hstep, voffB); PG8_STAGE(PG8_SA(0, 0), a2, voffA);
            PG8_WAIT_V(8); PG8_WAIT_L(0); PG8_BAR; PG8_MMA(1, 0, At, B0); PG8_MMA(1, 1, At, B1); PG8_BAR; PG8_SCHED;
            PG8_LDB(B0, 1, 0); PG8_LDB(B1, 1, 1); PG8_SCHED; PG8_LDA(At, 1, 0); PG8_STAGE(PG8_SA(0, 1), a2 + hstep, voffA);
            PG8_WAIT_V(8); PG8_WAIT_L(0); PG8_BAR; PG8_MMA(0, 0, At, B0); PG8_MMA(0, 1, At, B1); PG8_BAR; PG8_SCHED;
            PG8_LDA(At, 1, 1); PG8_STAGE(PG8_SB(1, 0), b3, voffB); PG8_STAGE(PG8_SB(1, 1), b3 + hstep, voffB); PG8_STAGE(PG8_SA(1, 0), a3, voffA);
            PG8_WAIT_V(8); PG8_WAIT_L(0); PG8_BAR; PG8_MMA(1, 0, At, B0); PG8_MMA(1, 1, At, B1); PG8_BAR; PG8_SCHED;
            } else {
            PG8_LDB(B0, 0, 0); PG8_SCHED; PG8_LDA(At, 0, 0); PG8_STAGE(PG8_SA(1, 1), a1 + hstep, voffA);
            PG8_WAIT_L(8); PG8_BAR; PG8_WAIT_L(0); PG8_MMA(0, 0, At, B0); PG8_BAR; PG8_SCHED;
            PG8_LDB(B1, 0, 1); PG8_STAGE(PG8_SB(0, 0), b2, voffB);
            PG8_BAR; PG8_WAIT_L(0); PG8_MMA(0, 1, At, B1); PG8_BAR;
            PG8_LDA(At, 0, 1); PG8_STAGE(PG8_SA(0, 0), a2, voffA);
            PG8_BAR; PG8_WAIT_L(0); PG8_MMA(1, 0, At, B0); PG8_BAR; PG8_SCHED;
            PG8_STAGE(PG8_SB(0, 1), b2 + hstep, voffB);
            PG8_WAIT_V(6); PG8_BAR; PG8_MMA(1, 1, At, B1); PG8_BAR;
            PG8_LDB(B0, 1, 0); PG8_SCHED; PG8_LDA(At, 1, 0); PG8_STAGE(PG8_SA(0, 1), a2 + hstep, voffA);
            PG8_WAIT_L(8); PG8_BAR; PG8_WAIT_L(0); PG8_MMA(0, 0, At, B0); PG8_BAR; PG8_SCHED;
            PG8_LDB(B1, 1, 1); PG8_STAGE(PG8_SB(1, 0), b3, voffB);
            PG8_BAR; PG8_WAIT_L(0); PG8_MMA(0, 1, At, B1); PG8_BAR;
            PG8_LDA(At, 1, 1); PG8_STAGE(PG8_SA(1, 0), a3, voffA);
            PG8_BAR; PG8_WAIT_L(0); PG8_MMA(1, 0, At, B0); PG8_BAR; PG8_SCHED;
            PG8_STAGE(PG8_SB(1, 1), b3 + hstep, voffB);
            PG8_WAIT_V(6); PG8_BAR; PG8_MMA(1, 1, At, B1); PG8_BAR;
            }
        }
        if constexpr (ALIGN_EPI) { if (wr == 0) PG8_BAR; }
        if constexpr (!Epi::AFTER_DRAIN) { E(acc, cur, wr, wc, fr, fq); S.done(cur); }
        if (!has_next) break;
#pragma unroll
        for (int a = 0; a < 2; ++a)
#pragma unroll
            for (int b = 0; b < 2; ++b)
#pragma unroll
                for (int m = 0; m < 4; ++m)
#pragma unroll
                    for (int n = 0; n < 2; ++n) acc[a][b][m][n] = (f32x4){0.f, 0.f, 0.f, 0.f};
        cur = nxt; cA = nA; cB = nB; ++ui;
        if constexpr (ALIGN_EPI) { if (wr == 1) PG8_BAR; }
    }
    PG8_WAIT_V(0);
    if constexpr (!ALIGN_EPI) { if (wr == 0) PG8_BAR; }
    PG8_BAR;
    if constexpr (Epi::AFTER_DRAIN) { E.fused(acc, cur, wr, wc, fr, fq, lds, wid, lane); S.done(cur); }
#undef PG8_SA
#undef PG8_SB
#undef PG8_STAGE
#undef PG8_LDA
#undef PG8_LDB
#undef PG8_MMA
#undef PG8_WAIT_V
#undef PG8_WAIT_L
#undef PG8_BAR
#undef PG8_SCHED
}
}

namespace att {
typedef unsigned short bf16_t;
using bf16x8 = __attribute__((ext_vector_type(8))) short;
using s16x4  = __attribute__((ext_vector_type(4))) short;
using f32x16 = __attribute__((ext_vector_type(16))) float;
using f32x4  = __attribute__((ext_vector_type(4))) float;
using u32x4  = __attribute__((ext_vector_type(4))) unsigned;
using u32x2  = __attribute__((ext_vector_type(2))) unsigned;
constexpr int NW = 8, QBLK = 32, KVBLK = 64;
constexpr int LDQ = 1536, LDK = 1536, LDV = 1024, LDO = 1024;
constexpr float SCALE = 0.07216878364870323f;
constexpr float THR = 8.f;
constexpr int NQR = 8;
constexpr int SHM_V = KVBLK * 128 * 2, SHM_K = KVBLK * 192 * 2, SHM_ATTN = 2 * SHM_V + 2 * SHM_K + NW * 64 * 4;
#define AKSWZ(row, colB) ((row) * 384 + ((colB) ^ (((((row) >> 1) & 3) | (((row) >> 2) & 4)) << 4)))
#define KSWZ128(row, colB) ((row) * 256 + ((colB) ^ (((row) & 15) << 4)))
#define SBAR() __builtin_amdgcn_sched_barrier(0)
#define GAS __attribute__((address_space(1)))
__device__ __forceinline__ const GAS char* uniform_ptr(const void* p) { const unsigned long long v = (unsigned long long)p; const unsigned lo = __builtin_amdgcn_readfirstlane((unsigned)v), hi = __builtin_amdgcn_readfirstlane((unsigned)(v >> 32)); return (const GAS char*)(((unsigned long long)hi << 32) | lo); }
__device__ __forceinline__ int crow(int r, int hi) { return (r & 3) + 8 * (r >> 2) + 4 * hi; }
__device__ __forceinline__ unsigned cvtpk(float lo, float hi) { unsigned r; asm volatile("v_cvt_pk_bf16_f32 %0, %1, %2" : "=v"(r) : "v"(lo), "v"(hi)); return pg8::coarse2(r); }
__device__ __forceinline__ float swap_sum(float v) { auto rr = __builtin_amdgcn_permlane32_swap(__float_as_uint(v), __float_as_uint(v), false, false); return __uint_as_float(rr[0]) + __uint_as_float(rr[1]); }

__device__ __forceinline__ void partialSM(f32x16& p0, f32x16& p1, float& m_reg, float& mn, float& alpha) {
  constexpr float C = SCALE * 1.4426950408889634f;
  float pmax = p0[0];
#pragma unroll
  for (int r = 1; r < 16; ++r) pmax = fmaxf(pmax, p0[r]);
#pragma unroll
  for (int r = 0; r < 16; ++r) pmax = fmaxf(pmax, p1[r]);
  { auto rr = __builtin_amdgcn_permlane32_swap(__float_as_uint(pmax), __float_as_uint(pmax), false, false);
    pmax = fmaxf(__uint_as_float(rr[0]), __uint_as_float(rr[1])); }
  if (__builtin_expect(__all(pmax - m_reg <= THR / SCALE), 1)) { mn = m_reg; alpha = 1.f; }
  else { mn = fmaxf(m_reg, pmax); alpha = __builtin_amdgcn_exp2f((m_reg - mn) * C); m_reg = mn; }
  float mnC = -mn * C;
#pragma unroll
  for (int r = 0; r < 16; ++r) p0[r] = fmaf(p0[r], C, mnC);
#pragma unroll
  for (int r = 0; r < 16; ++r) p1[r] = fmaf(p1[r], C, mnC);
#pragma unroll
  for (int r = 0; r < 16; ++r) p0[r] = __builtin_amdgcn_exp2f(p0[r]);
}
#define PK4(P, BASE, OUT) do { unsigned a0 = cvtpk(P[BASE + 0], P[BASE + 1]), a1 = cvtpk(P[BASE + 2], P[BASE + 3]);   \
    unsigned b0 = cvtpk(P[BASE + 4], P[BASE + 5]), b1 = cvtpk(P[BASE + 6], P[BASE + 7]);                              \
    auto r0 = __builtin_amdgcn_permlane32_swap(a0, b0, false, false); auto r1 = __builtin_amdgcn_permlane32_swap(a1, b1, false, false); \
    u32x4 w = {r0[0], r1[0], r0[1], r1[1]}; OUT = *reinterpret_cast<bf16x8*>(&w); } while (0)
__device__ __forceinline__ void finishSM(f32x16& p0, f32x16& p1, float alpha, float& l_reg, bf16x8& pa0, bf16x8& pa1, bf16x8& pa2, bf16x8& pa3) {
#pragma unroll
  for (int r = 0; r < 16; ++r) p1[r] = __builtin_amdgcn_exp2f(p1[r]);
  float ps = 0;
#pragma unroll
  for (int r = 0; r < 16; ++r) ps += p0[r];
#pragma unroll
  for (int r = 0; r < 16; ++r) ps += p1[r];
  ps = swap_sum(ps);
  l_reg = l_reg * alpha + ps;
  PK4(p0, 0, pa0); PK4(p0, 8, pa1); PK4(p1, 0, pa2); PK4(p1, 8, pa3);
}
__device__ __forceinline__ void qkt192(f32x16& p0, f32x16& p1, const char* Ks, const bf16x8 (&qr)[NQR], const char* Qs, int r32, int hi) {
  p0 = f32x16{}; p1 = f32x16{};
  __builtin_amdgcn_s_setprio(1);
#pragma unroll
  for (int d0 = 0; d0 < 12; ++d0) { int cb = (d0 * 16 + hi * 8) * 2;
    bf16x8 b0 = *reinterpret_cast<const bf16x8*>(Ks + AKSWZ(r32, cb));
    bf16x8 b1 = *reinterpret_cast<const bf16x8*>(Ks + AKSWZ(32 + r32, cb));
    bf16x8 qv; if (d0 < NQR) qv = qr[d0 < NQR ? d0 : 0]; else qv = *reinterpret_cast<const bf16x8*>(Qs + (d0 - NQR) * 1024);
    p0 = __builtin_amdgcn_mfma_f32_32x32x16_bf16(b0, qv, p0, 0, 0, 0);
    p1 = __builtin_amdgcn_mfma_f32_32x32x16_bf16(b1, qv, p1, 0, 0, 0); }
  __builtin_amdgcn_s_setprio(0);
}
__device__ __forceinline__ void qkt128(f32x16& p0, f32x16& p1, const char* Ks, const bf16x8 (&qr)[8], int r32, int hi) {
  p0 = f32x16{}; p1 = f32x16{};
#pragma unroll
  for (int d0 = 0; d0 < 8; ++d0) { int cb = (d0 * 16 + hi * 8) * 2;
    bf16x8 b0 = *reinterpret_cast<const bf16x8*>(Ks + KSWZ128(r32, cb));
    bf16x8 b1 = *reinterpret_cast<const bf16x8*>(Ks + KSWZ128(32 + r32, cb));
    p0 = __builtin_amdgcn_mfma_f32_32x32x16_bf16(b0, qr[d0], p0, 0, 0, 0);
    p1 = __builtin_amdgcn_mfma_f32_32x32x16_bf16(b1, qr[d0], p1, 0, 0, 0); }
}
__device__ __forceinline__ int v_st(int k, int c) { const int kk = (k & ~0xC) | ((k & 4) << 1) | ((k & 8) >> 1); return ((kk >> 3) * 4 + (c >> 5)) * 512 + ((kk & 7) * 32 + (c & 31)) * 2; }
__device__ __forceinline__ int v_rd_base(int lane) { return ((lane & 3) << 3) | (((lane >> 2) & 3) << 6) | (((lane >> 4) & 1) << 5) | (((lane >> 5) & 1) << 8); }
constexpr int v_rd_off(int d0, int ks, int half) { return d0 * 512 + ks * 4096 + half * 2048; }
template <int OFF> __device__ __forceinline__ s16x4 tr_read(int vb) {
  s16x4 r; asm volatile("ds_read_b64_tr_b16 %0, %1 offset:%2" : "=&v"(r) : "v"(vb), "i"(OFF) : "memory"); return r;
}
#define PKLH(L, H) (bf16x8){L[0], L[1], L[2], L[3], H[0], H[1], H[2], H[3]}
template <int D0> __device__ __forceinline__ void pv_one(f32x16& od, int vb, bf16x8 pa0, bf16x8 pa1, bf16x8 pa2, bf16x8 pa3) {
  const s16x4 l0 = tr_read<v_rd_off(D0, 0, 0)>(vb), h0 = tr_read<v_rd_off(D0, 0, 1)>(vb), l1 = tr_read<v_rd_off(D0, 1, 0)>(vb), h1 = tr_read<v_rd_off(D0, 1, 1)>(vb);
  const s16x4 l2 = tr_read<v_rd_off(D0, 2, 0)>(vb), h2 = tr_read<v_rd_off(D0, 2, 1)>(vb), l3 = tr_read<v_rd_off(D0, 3, 0)>(vb), h3 = tr_read<v_rd_off(D0, 3, 1)>(vb);
  asm volatile("s_waitcnt lgkmcnt(0)" ::: "memory"); SBAR();
  __builtin_amdgcn_s_setprio(1);
  od = __builtin_amdgcn_mfma_f32_32x32x16_bf16(pa0, PKLH(l0, h0), od, 0, 0, 0);
  od = __builtin_amdgcn_mfma_f32_32x32x16_bf16(pa1, PKLH(l1, h1), od, 0, 0, 0);
  od = __builtin_amdgcn_mfma_f32_32x32x16_bf16(pa2, PKLH(l2, h2), od, 0, 0, 0);
  od = __builtin_amdgcn_mfma_f32_32x32x16_bf16(pa3, PKLH(l3, h3), od, 0, 0, 0);
  __builtin_amdgcn_s_setprio(0);
}
__device__ __forceinline__ void pv_d0(f32x16* o, int vb, bf16x8 pa0, bf16x8 pa1, bf16x8 pa2, bf16x8 pa3) {
  pv_one<0>(o[0], vb, pa0, pa1, pa2, pa3); pv_one<1>(o[1], vb, pa0, pa1, pa2, pa3); pv_one<2>(o[2], vb, pa0, pa1, pa2, pa3); pv_one<3>(o[3], vb, pa0, pa1, pa2, pa3);
}
template <int D0> __device__ __forceinline__ void pvT_one(f32x16& od, int vb, bf16x8 pa0, bf16x8 pa1, bf16x8 pa2, bf16x8 pa3) {
  const s16x4 l0 = tr_read<v_rd_off(D0, 0, 0)>(vb), h0 = tr_read<v_rd_off(D0, 0, 1)>(vb), l1 = tr_read<v_rd_off(D0, 1, 0)>(vb), h1 = tr_read<v_rd_off(D0, 1, 1)>(vb);
  const s16x4 l2 = tr_read<v_rd_off(D0, 2, 0)>(vb), h2 = tr_read<v_rd_off(D0, 2, 1)>(vb), l3 = tr_read<v_rd_off(D0, 3, 0)>(vb), h3 = tr_read<v_rd_off(D0, 3, 1)>(vb);
  asm volatile("s_waitcnt lgkmcnt(0)" ::: "memory"); SBAR();
  od = __builtin_amdgcn_mfma_f32_32x32x16_bf16(PKLH(l0, h0), pa0, od, 0, 0, 0);
  od = __builtin_amdgcn_mfma_f32_32x32x16_bf16(PKLH(l1, h1), pa1, od, 0, 0, 0);
  od = __builtin_amdgcn_mfma_f32_32x32x16_bf16(PKLH(l2, h2), pa2, od, 0, 0, 0);
  od = __builtin_amdgcn_mfma_f32_32x32x16_bf16(PKLH(l3, h3), pa3, od, 0, 0, 0);
}

__device__ __forceinline__ void attn_unit(const bf16_t* __restrict__ Qb, const bf16_t* __restrict__ Kh, const bf16_t* __restrict__ Vh, bf16_t* __restrict__ Ob, int seq, char* lds, int ldsaddr) {
  const int tid = threadIdx.x, wid = tid >> 6, lane = tid & 63, r32 = lane & 31, hi = lane >> 5;
  char* V_lds = lds; char* K_lds = lds + 2 * SHM_V;
  float* ws = (float*)(lds + 2 * SHM_V + 2 * SHM_K) + wid * 64; float* li_l = ws; float* al_l = ws + 32;
  float m_reg = -1e30f, l_reg = 0; f32x16 o[4] = {}; bf16x8 qr[NQR];
  const bf16_t* Qw = Qb + (long)(wid * QBLK + r32) * LDQ + hi * 8;
  char* Qs = lds + SHM_ATTN + wid * ((12 - NQR) * 1024) + lane * 16;
#pragma unroll
  for (int d0 = 0; d0 < NQR; ++d0) qr[d0] = *reinterpret_cast<const bf16x8*>(Qw + d0 * 16);
#pragma unroll
  for (int d0 = NQR; d0 < 12; ++d0) *(bf16x8*)(Qs + (d0 - NQR) * 1024) = *reinterpret_cast<const bf16x8*>(Qw + d0 * 16);
  const int sr = tid >> 4, sc = (tid & 15) * 8, vst0 = v_st(sr, sc), vst1 = v_st(32 + sr, sc);
  unsigned kg0, kg1, kg2; int kl0, kl1, kl2;
  { int p = tid;        int kr = p / 24, kc = (p % 24) * 8; kg0 = (unsigned)(kr * LDK + kc) * 2u; kl0 = AKSWZ(kr, kc * 2);
    p = tid + 512;      kr = p / 24; kc = (p % 24) * 8;     kg1 = (unsigned)(kr * LDK + kc) * 2u; kl1 = AKSWZ(kr, kc * 2);
    p = tid + 1024;     kr = p / 24; kc = (p % 24) * 8;     kg2 = (unsigned)(kr * LDK + kc) * 2u; kl2 = AKSWZ(kr, kc * 2); }
  const unsigned vg0 = (unsigned)(sr * LDV + sc) * 2u, vg1 = (unsigned)((32 + sr) * LDV + sc) * 2u;
  const int vb0 = ldsaddr + v_rd_base(lane);
  bf16x8 vs0, vs1, ks0, ks1, ks2;
#define SLOAD(k0) do { const GAS char* vb_ = uniform_ptr((const char*)Vh + (size_t)(k0) * (LDV * 2)); const GAS char* kb_ = uniform_ptr((const char*)Kh + (size_t)(k0) * (LDK * 2)); \
    vs0 = *(const GAS bf16x8*)(vb_ + vg0); vs1 = *(const GAS bf16x8*)(vb_ + vg1); \
    ks0 = *(const GAS bf16x8*)(kb_ + kg0); ks1 = *(const GAS bf16x8*)(kb_ + kg1); ks2 = *(const GAS bf16x8*)(kb_ + kg2); } while (0)
#define SWRITE(b) do { *(bf16x8*)(V_lds + (b) * SHM_V + vst0) = vs0; *(bf16x8*)(V_lds + (b) * SHM_V + vst1) = vs1; \
    *(bf16x8*)(K_lds + (b) * SHM_K + kl0) = ks0; *(bf16x8*)(K_lds + (b) * SHM_K + kl1) = ks1; *(bf16x8*)(K_lds + (b) * SHM_K + kl2) = ks2; } while (0)
#define SWAIT() asm volatile("s_waitcnt vmcnt(0)" ::: "memory")
#define RESC(a) do { if (__any((a) < 1.f)) { if (hi == 0) al_l[r32] = (a); asm volatile("s_waitcnt lgkmcnt(0)" ::: "memory"); \
    _Pragma("unroll") for (int d = 0; d < 4; ++d) _Pragma("unroll") for (int r = 0; r < 16; ++r) o[d][r] *= al_l[crow(r, hi)]; } } while (0)
  f32x16 pA0, pA1, pB0, pB1; float mnA, mnB, alA, alB; bf16x8 pa0, pa1, pa2, pa3; const int NT = seq / KVBLK;
  __syncthreads();
  SLOAD(0); SWAIT(); SWRITE(0); __syncthreads();
  qkt192(pA0, pA1, K_lds, qr, Qs, r32, hi); partialSM(pA0, pA1, m_reg, mnA, alA);
  SLOAD(KVBLK);
  SWAIT(); SWRITE(1); __syncthreads();
  for (int j = 1; j + 1 < NT; j += 2) {
    SBAR(); qkt192(pB0, pB1, K_lds + SHM_K, qr, Qs, r32, hi);
    finishSM(pA0, pA1, alA, l_reg, pa0, pa1, pa2, pa3); SBAR();
    SLOAD((j + 1) * KVBLK); SBAR();
    pv_d0(o, vb0, pa0, pa1, pa2, pa3); partialSM(pB0, pB1, m_reg, mnB, alB);
    __syncthreads(); SWAIT(); SWRITE(0);
    RESC(alB); __syncthreads();
    SBAR(); qkt192(pA0, pA1, K_lds, qr, Qs, r32, hi);
    finishSM(pB0, pB1, alB, l_reg, pa0, pa1, pa2, pa3); SBAR();
    SLOAD((j + 2) * KVBLK); SBAR();
    pv_d0(o, vb0 + SHM_V, pa0, pa1, pa2, pa3); partialSM(pA0, pA1, m_reg, mnA, alA);
    __syncthreads(); SWAIT(); SWRITE(1);
    RESC(alA); __syncthreads();
  }
  SBAR(); qkt192(pB0, pB1, K_lds + SHM_K, qr, Qs, r32, hi);
  finishSM(pA0, pA1, alA, l_reg, pa0, pa1, pa2, pa3); SBAR();
  pv_d0(o, vb0, pa0, pa1, pa2, pa3); partialSM(pB0, pB1, m_reg, mnB, alB);
  __syncthreads(); RESC(alB);
  finishSM(pB0, pB1, alB, l_reg, pa0, pa1, pa2, pa3); SBAR();
  pv_d0(o, vb0 + SHM_V, pa0, pa1, pa2, pa3);
  if (hi == 0) li_l[r32] = l_reg; asm volatile("s_waitcnt lgkmcnt(0)" ::: "memory");
  float rli[16];
#pragma unroll
  for (int r = 0; r < 16; ++r) rli[r] = __builtin_amdgcn_rcpf(li_l[crow(r, hi)]);
  bf16_t* Ow = Ob + (long)(wid * QBLK) * LDO;
#pragma unroll
  for (int r = 0; r < 16; ++r) { int orow = crow(r, hi);
#pragma unroll
    for (int d0 = 0; d0 < 4; ++d0) Ow[(long)orow * LDO + d0 * 32 + r32] = (bf16_t)(cvtpk(o[d0][r] * rli[r], 0.f) & 0xffffu); }
#undef SLOAD
#undef SWRITE
#undef SWAIT
#undef RESC
}

__device__ __forceinline__ bf16x8 scale8(bf16x8 v, float s) {
  u32x4 w = *reinterpret_cast<u32x4*>(&v), o;
#pragma unroll
  for (int i = 0; i < 4; ++i) o[i] = cvtpk(__uint_as_float(w[i] << 16) * s, __uint_as_float(w[i] & 0xffff0000u) * s);
  return *reinterpret_cast<bf16x8*>(&o);
}
__device__ __forceinline__ s16x4 trr(int addr) { s16x4 r; asm volatile("ds_read_b64_tr_b16 %0, %1" : "=&v"(r) : "v"(addr) : "memory"); return r; }

__device__ __forceinline__ void chunk_kv_unit(const bf16_t* __restrict__ Kc, const bf16_t* __restrict__ Vc, bf16_t* __restrict__ CKf, bf16_t* __restrict__ CKb, float lgf, float lgb, char* lds, int ldsaddr) {
  const int tid = threadIdx.x, wid = tid >> 6, lane = tid & 63, r32 = lane & 31, hi = lane >> 5;
  const int dir = wid >> 2, db = wid & 3, d = 32 * db + r32;
  __syncthreads();
  { const int sr = tid >> 4, sc = (tid & 15) * 8;
#pragma unroll
    for (int i = 0; i < 4; ++i) { const int row = sr + 32 * i;
      *(bf16x8*)(lds + (row >> 6) * 16384 + v_st(row & 63, sc)) = *reinterpret_cast<const bf16x8*>(Vc + (long)row * 1024 + sc);
      *(bf16x8*)(lds + 32768 + row * 272 + sc * 2) = *reinterpret_cast<const bf16x8*>(Kc + (long)row * 1024 + sc); } }
  __syncthreads();
  bf16x8 kb[8];
  int hio = hi; asm volatile("" : "+v"(hio));
  const char* kl = lds + 32768 + (hio * 8) * 272 + d * 2;
#pragma unroll
  for (int ks = 0; ks < 8; ++ks) { u32x4 w;
#pragma unroll
    for (int i = 0; i < 4; ++i) { const int s0 = ks * 16 + hio * 8 + 2 * i;
      const float k0 = __uint_as_float((unsigned)*(const unsigned short*)(kl + (ks * 16 + 2 * i) * 272) << 16), k1 = __uint_as_float((unsigned)*(const unsigned short*)(kl + (ks * 16 + 2 * i + 1) * 272) << 16);
      const float z0 = __builtin_amdgcn_exp2f(dir ? lgb * (float)s0 : lgf * (float)(127 - s0)), z1 = __builtin_amdgcn_exp2f(dir ? lgb * (float)(s0 + 1) : lgf * (float)(126 - s0));
      w[i] = cvtpk(k0 * z0, k1 * z1); }
    kb[ks] = *reinterpret_cast<bf16x8*>(&w); }
  f32x16 acc[4] = {};
  const int vb = ldsaddr + v_rd_base(lane);
  pvT_one<0>(acc[0], vb, kb[0], kb[1], kb[2], kb[3]); pvT_one<1>(acc[1], vb, kb[0], kb[1], kb[2], kb[3]); pvT_one<2>(acc[2], vb, kb[0], kb[1], kb[2], kb[3]); pvT_one<3>(acc[3], vb, kb[0], kb[1], kb[2], kb[3]);
  pvT_one<0>(acc[0], vb + 16384, kb[4], kb[5], kb[6], kb[7]); pvT_one<1>(acc[1], vb + 16384, kb[4], kb[5], kb[6], kb[7]); pvT_one<2>(acc[2], vb + 16384, kb[4], kb[5], kb[6], kb[7]); pvT_one<3>(acc[3], vb + 16384, kb[4], kb[5], kb[6], kb[7]);
  bf16_t* CK = dir ? CKb : CKf;
#pragma unroll
  for (int eb = 0; eb < 4; ++eb)
#pragma unroll
    for (int r = 0; r < 16; ++r) CK[(32 * eb + crow(r, hi)) * 128 + d] = (bf16_t)(cvtpk(acc[eb][r], 0.f) & 0xffffu);
}

#ifndef PROBE_COMP
#define PROBE_COMP 0
#endif
__device__ __forceinline__ void ret_out_unit(const bf16_t* __restrict__ Qc, const bf16_t* __restrict__ Kc, const bf16_t* __restrict__ Vc, const bf16_t* __restrict__ Gc,
                                             const bf16_t* __restrict__ STf, const bf16_t* __restrict__ STb, const float* __restrict__ gnw, const float* __restrict__ gnb,
                                             bf16_t* __restrict__ Oc, float lgf, float lgb, char* lds, int ldsaddr, float* dump = nullptr) {
  const int tid = threadIdx.x, ht = tid & 255, wq = (tid >> 6) & 3, lane = tid & 63, r32 = lane & 31, hi = lane >> 5;
  __syncthreads();
  { const int sr = ht >> 4, sc = (ht & 15) * 8;
#pragma unroll
    for (int i = 0; i < 8; ++i) { const int row = sr + 16 * i, tile = row >> 6, key = row & 63;
      *(bf16x8*)(lds + tile * 16384 + KSWZ128(key, sc * 2)) = *reinterpret_cast<const bf16x8*>(Kc + (long)row * 1024 + sc);
      *(bf16x8*)(lds + 32768 + tile * 16384 + v_st(key, sc)) = *reinterpret_cast<const bf16x8*>(Vc + (long)row * 1024 + sc); } }
  const int c = 32 * wq + r32;
  bf16x8 qr[8];
#pragma unroll
  for (int d0 = 0; d0 < 8; ++d0) qr[d0] = *reinterpret_cast<const bf16x8*>(Qc + (long)c * 1024 + d0 * 16 + hi * 8);
  __syncthreads();
  f32x16 pA0, pA1, pB0, pB1;
  qkt128(pA0, pA1, lds, qr, r32, hi); qkt128(pB0, pB1, lds + 16384, qr, r32, hi);
  int cdec = c; asm volatile("" : "+v"(cdec));
#define DEC(P, JB) do { _Pragma("unroll") for (int r = 0; r < 16; ++r) { const int dl = cdec - ((JB) + crow(r, hi)); \
    P[r] *= __builtin_amdgcn_exp2f(dl >= 0 ? lgf * (float)dl : lgb * (float)(-dl)); } } while (0)
  DEC(pA0, 0); DEC(pA1, 32); DEC(pB0, 64); DEC(pB1, 96);
#undef DEC
  bf16x8 xa0, xa1, xa2, xa3, xb0, xb1, xb2, xb3;
  PK4(pA0, 0, xa0); PK4(pA0, 8, xa1); PK4(pA1, 0, xa2); PK4(pA1, 8, xa3);
  PK4(pB0, 0, xb0); PK4(pB0, 8, xb1); PK4(pB1, 0, xb2); PK4(pB1, 8, xb3);
  f32x16 o[4] = {};
  const int vb = ldsaddr + 32768 + v_rd_base(lane);
  if (PROBE_COMP == 0 || (PROBE_COMP & 1)) {
  pvT_one<0>(o[0], vb, xa0, xa1, xa2, xa3); pvT_one<1>(o[1], vb, xa0, xa1, xa2, xa3); pvT_one<2>(o[2], vb, xa0, xa1, xa2, xa3); pvT_one<3>(o[3], vb, xa0, xa1, xa2, xa3);
  pvT_one<0>(o[0], vb + 16384, xb0, xb1, xb2, xb3); pvT_one<1>(o[1], vb + 16384, xb0, xb1, xb2, xb3); pvT_one<2>(o[2], vb + 16384, xb0, xb1, xb2, xb3); pvT_one<3>(o[3], vb + 16384, xb0, xb1, xb2, xb3);
  }
#pragma unroll
  for (int dir = 0; dir < 2; ++dir) {
    if (PROBE_COMP != 0 && !((PROBE_COMP >> (1 + dir)) & 1)) continue;
    const float xi = __builtin_amdgcn_exp2f(dir == 0 ? lgf * (float)(c + 1) : lgb * (float)(128 - c));
    const bf16_t* ST = dir == 0 ? STf : STb;
    bf16x8 qs[8];
#pragma unroll
    for (int d0 = 0; d0 < 8; ++d0) qs[d0] = scale8(qr[d0], xi);
    const GAS char* stb = uniform_ptr(ST); const unsigned so = (unsigned)(r32 * 128 + hi * 8) * 2u;
#pragma unroll
    for (int eb = 0; eb < 4; ++eb) {
      bf16x8 A[8];
      SBAR();
#pragma unroll
      for (int d0 = 0; d0 < 8; ++d0) A[d0] = *(const GAS bf16x8*)(stb + so + (eb * 32 * 128 + d0 * 16) * 2);
#pragma unroll
      for (int d0 = 0; d0 < 8; ++d0) o[eb] = __builtin_amdgcn_mfma_f32_32x32x16_bf16(A[d0], qs[d0], o[eb], 0, 0, 0);
      SBAR();
    }
  }
  if (PROBE_COMP != 0) {
#pragma unroll
    for (int eb = 0; eb < 4; ++eb)
#pragma unroll
      for (int g = 0; g < 4; ++g) *(f32x4*)(dump + (long)c * 1024 + 32 * eb + 8 * g + 4 * hi) = (f32x4){o[eb][4 * g], o[eb][4 * g + 1], o[eb][4 * g + 2], o[eb][4 * g + 3]};
    return; }
  float s = 0.f;
#pragma unroll
  for (int eb = 0; eb < 4; ++eb)
#pragma unroll
    for (int r = 0; r < 16; ++r) s += o[eb][r];
  const float mu = swap_sum(s) * (1.f / 128.f);
  float q = 0.f;
#pragma unroll
  for (int eb = 0; eb < 4; ++eb)
#pragma unroll
    for (int r = 0; r < 16; ++r) { const float d = o[eb][r] - mu; q += d * d; }
  const float rstd = rsqrtf(swap_sum(q) * (1.f / 128.f) + 1e-6f);
#pragma unroll
  for (int eb = 0; eb < 4; ++eb)
#pragma unroll
    for (int g = 0; g < 4; ++g) { const int e0 = 32 * eb + 8 * g + 4 * hi;
      const f32x4 w4 = *(const f32x4*)(gnw + e0), b4 = *(const f32x4*)(gnb + e0);
      const u32x2 gg = *(const u32x2*)(Gc + (long)c * 1024 + e0);
      const float g0 = __uint_as_float(gg.x << 16), g1 = __uint_as_float(gg.x & 0xffff0000u), g2 = __uint_as_float(gg.y << 16), g3 = __uint_as_float(gg.y & 0xffff0000u);
      const float y0 = ((o[eb][4 * g] - mu) * rstd * w4[0] + b4[0]) * g0, y1 = ((o[eb][4 * g + 1] - mu) * rstd * w4[1] + b4[1]) * g1;
      const float y2 = ((o[eb][4 * g + 2] - mu) * rstd * w4[2] + b4[2]) * g2, y3 = ((o[eb][4 * g + 3] - mu) * rstd * w4[3] + b4[3]) * g3;
      u32x2 w; w.x = cvtpk(y0, y1); w.y = cvtpk(y2, y3);
      *(u32x2*)(Oc + (long)c * 2048 + e0) = w; }
}

__device__ __forceinline__ void ret_brute_unit(const bf16_t* __restrict__ Qh, const bf16_t* __restrict__ Kh, const bf16_t* __restrict__ Vh, const bf16_t* __restrict__ Gc,
                                               const float* __restrict__ gnw, const float* __restrict__ gnb, bf16_t* __restrict__ Oc, int t0, float lgf, float lgb, char* lds, const float* dump = nullptr) {
  const int tid = threadIdx.x, qi = tid >> 2, part = tid & 3, t = t0 + qi;
  float q[32], acc[32];
#pragma unroll
  for (int i = 0; i < 32; ++i) { q[i] = __uint_as_float((unsigned)Qh[(long)t * 1024 + part * 32 + i] << 16); acc[i] = 0.f; }
  for (int s0 = 0; s0 < 4096; s0 += 64) {
    { const int rel = s0 < t0 ? 1 : (s0 >= t0 + 128 ? 2 : 0); if (PROBE_COMP != 0 && ((PROBE_COMP >> rel) & 1)) continue; }
    __syncthreads();
    for (int c = tid; c < 64 * 16; c += 512) { const int r = c >> 4, c8 = (c & 15) * 8;
      *(bf16x8*)(lds + (r * 128 + c8) * 2) = *reinterpret_cast<const bf16x8*>(Kh + (long)(s0 + r) * 1024 + c8);
      *(bf16x8*)(lds + 16384 + (r * 128 + c8) * 2) = *reinterpret_cast<const bf16x8*>(Vh + (long)(s0 + r) * 1024 + c8); }
    __syncthreads();
    for (int j = 0; j < 64; ++j) { const int s = s0 + j; float d = 0.f;
      const unsigned short* kr = (const unsigned short*)(lds + (j * 128 + part * 32) * 2); const unsigned short* vr = (const unsigned short*)(lds + 16384 + (j * 128 + part * 32) * 2);
#pragma unroll
      for (int i = 0; i < 32; ++i) d += q[i] * __uint_as_float((unsigned)kr[i] << 16);
      d += __shfl_xor(d, 1); d += __shfl_xor(d, 2);
      const int dl = t - s; const float w = d * __builtin_amdgcn_exp2f(dl >= 0 ? lgf * (float)dl : lgb * (float)(-dl));
#pragma unroll
      for (int i = 0; i < 32; ++i) acc[i] += w * __uint_as_float((unsigned)vr[i] << 16); }
  }
  if (PROBE_COMP != 0) {
#pragma unroll
    for (int i = 0; i < 32; ++i) acc[i] += dump[(long)qi * 1024 + part * 32 + i]; }
  float sm = 0.f;
#pragma unroll
  for (int i = 0; i < 32; ++i) sm += acc[i];
  sm += __shfl_xor(sm, 1); sm += __shfl_xor(sm, 2); const float mu = sm * (1.f / 128.f);
  float qq = 0.f;
#pragma unroll
  for (int i = 0; i < 32; ++i) { const float dd = acc[i] - mu; qq += dd * dd; }
  qq += __shfl_xor(qq, 1); qq += __shfl_xor(qq, 2); const float rstd = rsqrtf(qq * (1.f / 128.f) + 1e-6f);
#pragma unroll
  for (int i = 0; i < 32; ++i) { const int e = part * 32 + i; const float g = __uint_as_float((unsigned)Gc[(long)qi * 1024 + e] << 16);
    Oc[(long)qi * 2048 + e] = (bf16_t)(cvtpk(((acc[i] - mu) * rstd * gnw[e] + gnb[e]) * g, 0.f) & 0xffffu); }
}
#undef SBAR
}


#ifndef PROBE_BRUTE_RET
#define PROBE_BRUTE_RET 0
#endif
#ifndef MK_SPLIT
#define MK_SPLIT 0
#endif
#define LAS __attribute__((address_space(3)))
#define GASX __attribute__((address_space(1)))
typedef unsigned short bf16_t;
typedef unsigned v4u __attribute__((ext_vector_type(4)));
typedef unsigned v2u __attribute__((ext_vector_type(2)));
typedef float f32x4 __attribute__((ext_vector_type(4)));
typedef short bf16x8 __attribute__((ext_vector_type(8)));

constexpr int BATCH = 8, SEQ = 4096, DM = 2048, T = BATCH * SEQ;
constexpr int INC = 5184, INCP = 5376, DFF = 5632, NMODC = 6 * DM;
constexpr int NPH = 11;
constexpr size_t MiB = 1u << 20;
constexpr size_t WS_CTL = 0, CTL_ZERO_BYTES = 2 * MiB;
constexpr size_t OFF_MOD = 0, OFF_SSQQ = 512 * 1024, OFF_SSQKV = 640 * 1024;
constexpr size_t WS_COSR = 2 * MiB, WS_SINR = 10 * MiB, WS_COSM = 18 * MiB, WS_SINM = 22 * MiB;
constexpr size_t WS_WIN = 26 * MiB, WS_WUQ = 47 * MiB, WS_WUKV = 49 * MiB, WS_WO = 51 * MiB, WS_WGU = 59 * MiB, WS_WDN = 103 * MiB;
constexpr size_t WS_H = 128 * MiB;
constexpr size_t WS_QR = 256 * MiB, WS_KR = 320 * MiB, WS_VR = 384 * MiB, WS_GR = 448 * MiB;
constexpr size_t WS_CQ = 512 * MiB, WS_CKV = 544 * MiB;
constexpr size_t WS_QM = 576 * MiB, WS_KB = 672 * MiB, WS_VM = 768 * MiB, WS_OAT = 832 * MiB, WS_END = 896 * MiB;
constexpr size_t WS_CAT = 576 * MiB;
constexpr size_t WS_AFF = 256 * MiB;
static_assert(WS_AFF + (size_t)T * DFF * 2 <= WS_END && WS_CAT + (size_t)T * 2048 * 2 <= WS_VM, "d_ws map");
constexpr int LDS_BAR_OFF = 150528;
constexpr size_t OFF_XBAR = 1536 * 1024;
constexpr int LDS_BYTES = 150528 + 64;

#define LDS_WAIT() asm volatile("s_waitcnt lgkmcnt(0)" ::: "memory")
__device__ __forceinline__ unsigned f2bf(float f) { unsigned u = __builtin_bit_cast(unsigned, f); return (u + 0x7fffu + ((u >> 16) & 1u)) >> 16; }
__device__ __forceinline__ unsigned pk2(float lo, float hi) { return f2bf(lo) | (f2bf(hi) << 16); }
__device__ __forceinline__ unsigned pk2a(float lo, float hi) { return pg8::coarse2(pk2(lo, hi)); }
__device__ __forceinline__ float wave_sum(float v) {
#pragma unroll
    for (int o = 1; o < 64; o <<= 1) v += __shfl_xor(v, o);
    return v;
}
__device__ __forceinline__ int dest_row(int mapid, int n) {
    switch (mapid) {
    case 1: if (n < 2048) { const int j = n & 127; return (n & ~127) + (j < 64 ? 2 * j : 2 * (j - 64) + 1); }
            if (n < 5120) return n;
            { const int j = n - 5120; return 5120 + (j < 32 ? 2 * j : 2 * (j - 32) + 1); }
    case 2: { const int d = n % 192; if (d < 128) return n; const int j = d - 128; return n - d + 128 + (j < 32 ? 2 * j : 2 * (j - 32) + 1); }
    case 3: return (n >> 7) * 256 + (n & 127);
    case 4: return (n >> 7) * 256 + 128 + (n & 127);
    default: return n;
    }
}
__device__ __forceinline__ void transpose_item(const float* __restrict__ W, int K, int N, bf16_t* __restrict__ WT, const float* __restrict__ kscale, int mapid, LAS float* scr, int item, int lane) {
    const int nblk = N / 32, kb = item / nblk, nb = item % nblk, k0 = 64 * kb, n0 = 32 * nb;
#pragma unroll 8
    for (int i = 0; i < 32; ++i) { const int kk = 2 * i + (lane >> 5); float v = W[(size_t)(k0 + kk) * N + n0 + (lane & 31)]; if (kscale) v *= kscale[k0 + kk]; scr[kk * 33 + (lane & 31)] = v; }
    LDS_WAIT(); asm volatile("" ::: "memory");
    const int c = lane & 7;
#pragma unroll
    for (int j = 0; j < 4; ++j) { const int n = (lane >> 3) + 8 * j; const LAS float* s = scr + (8 * c) * 33 + n;
        v4u o; o.x = pk2(s[0 * 33], s[1 * 33]); o.y = pk2(s[2 * 33], s[3 * 33]); o.z = pk2(s[4 * 33], s[5 * 33]); o.w = pk2(s[6 * 33], s[7 * 33]);
        *(v4u*)(WT + (size_t)dest_row(mapid, n0 + n) * K + k0 + 8 * c) = o; }
    LDS_WAIT(); asm volatile("" ::: "memory");
}
__device__ __forceinline__ void norm_row(const float* xrow, const float* __restrict__ w, const float* __restrict__ shift, const float* __restrict__ scale, bf16_t* ob, float* of, int lane) {
    const f32x4* xr = (const f32x4*)xrow + lane;
    f32x4 v[8]; float s = 0.f;
#pragma unroll
    for (int j = 0; j < 8; ++j) { v[j] = xr[64 * j]; s += (v[j].x * v[j].x + v[j].y * v[j].y) + (v[j].z * v[j].z + v[j].w * v[j].w); }
    const float rstd = rsqrtf(wave_sum(s) * (1.f / 2048.f) + 1e-6f);
#pragma unroll
    for (int j = 0; j < 8; ++j) { const int col = 4 * lane + 256 * j; f32x4 y = v[j] * rstd * *(const f32x4*)(w + col);
        if (shift) y = y * (*(const f32x4*)(scale + col) + 1.f) + *(const f32x4*)(shift + col);
        if (ob) { v2u o; o.x = pk2a(y.x, y.y); o.y = pk2a(y.z, y.w); *(v2u*)(ob + col) = o; } else *(f32x4*)(of + col) = y; }
}

#define XB_TMO      128
#define XB_XCNT(j)  (256  + 64 * (j))
#define XB_XSUB(j)  (1280 + 64 * (j))
#define XB_XGEN(j)  (2304 + 64 * (j))
#define XB_TOP      3328
#define XB_TOPGEN   3392
#define XCD_BAR_WORDS 3456
#define XB_SPIN_CAP (1u << 18)

__device__ __forceinline__ unsigned xb_ld(unsigned* p)              { return __hip_atomic_load(p, __ATOMIC_RELAXED, __HIP_MEMORY_SCOPE_AGENT); }
__device__ __forceinline__ unsigned xb_add(unsigned* p, unsigned v) { return __hip_atomic_fetch_add(p, v, __ATOMIC_RELAXED, __HIP_MEMORY_SCOPE_AGENT); }
__device__ __forceinline__ unsigned xb_xcc_id() { return (unsigned)__builtin_amdgcn_s_getreg((3 << 11) | 20) & 0xFu; }
#define XB_SPIN(cond, bar) do { unsigned _sp = 0; while (cond) { __builtin_amdgcn_s_sleep(1); \
    if ((++_sp & 255u) == 0u) { if (xb_ld(&(bar)[XB_TMO])) break; if (_sp > XB_SPIN_CAP) { atomicAdd(&(bar)[XB_TMO], 1u); break; } } } } while (0)

struct XcdBarrier {
    unsigned* bar; unsigned x;
    volatile LAS unsigned* st;
};

__device__ __forceinline__ XcdBarrier xcd_barrier_post(unsigned* bar, volatile LAS unsigned* st) {
    XcdBarrier b; b.bar = bar; b.x = xb_xcc_id(); b.st = st;
    if (threadIdx.x == 0) (void)xb_add(&bar[XB_XCNT(b.x)], 1u);
    return b;
}
__device__ __forceinline__ void xcd_barrier_complete(unsigned* bar, unsigned x, unsigned& nloc, unsigned& nx) {
    const unsigned G = gridDim.x * gridDim.y * gridDim.z;
    unsigned sum, cnt, mine, sp = 0u;
    for (;;) {
        sum = 0u; cnt = 0u; mine = 0u;
#pragma unroll
        for (unsigned j = 0; j < 16; ++j) { const unsigned c = xb_ld(&bar[XB_XCNT(j)]); sum += c; cnt += (c > 0u) ? 1u : 0u; mine = (j == x) ? c : mine; }
        if (sum == G) break;
        __builtin_amdgcn_s_sleep(1);
        if ((++sp & 255u) == 0u) { if (xb_ld(&bar[XB_TMO])) break; if (sp > XB_SPIN_CAP) { atomicAdd(&bar[XB_TMO], 1u); break; } }
    }
    nloc = mine > 0u ? mine : 1u; nx = cnt > 0u ? cnt : 1u;
}

__device__ __forceinline__ void xcd_barrier(const XcdBarrier& b) {
    asm volatile("s_waitcnt vmcnt(0)" ::: "memory");
    __syncthreads();
    if (threadIdx.x == 0) {
        unsigned* bar = b.bar;
        __builtin_amdgcn_s_waitcnt(0);
        unsigned nloc = b.st[0], nx = b.st[1];
        if (nloc == 0u) { xcd_barrier_complete(bar, b.x, nloc, nx); b.st[0] = nloc; b.st[1] = nx; }
        const unsigned old = xb_add(&bar[XB_XSUB(b.x)], 1u);
        const unsigned gen = old / nloc;
        if (old + 1u == (gen + 1u) * nloc) {
            __builtin_amdgcn_fence(__ATOMIC_RELEASE, "agent");
            asm volatile("s_waitcnt vmcnt(0)" ::: "memory");
            const unsigned og = xb_add(&bar[XB_TOP], 1u);
            const unsigned tg = og / nx;
            if (og + 1u == (tg + 1u) * nx) xb_add(&bar[XB_TOPGEN], 1u);
            else XB_SPIN(xb_ld(&bar[XB_TOPGEN]) == tg, bar);
            __builtin_amdgcn_fence(__ATOMIC_ACQUIRE, "agent");
            xb_add(&bar[XB_XGEN(b.x)], 1u);
            asm volatile("s_waitcnt vmcnt(0)" ::: "memory");
        } else {
            XB_SPIN(xb_ld(&bar[XB_XGEN(b.x)]) == gen, bar);
            __builtin_amdgcn_fence(__ATOMIC_ACQUIRE, "agent");
            asm volatile("s_waitcnt vmcnt(0)" ::: "memory");
        }
    }
    __syncthreads();
}

struct Args { const float* in[21]; float* out; unsigned char* ws; float inv_r[64]; float inv_m[32]; int ph_lo, ph_hi; };
static_assert(sizeof(Args) == 21 * 8 + 16 + 96 * 4 + 8, "Args has no padding");

__global__ void __launch_bounds__(512, 2) mk_fwd(Args a) {
    extern __shared__ __attribute__((aligned(16))) unsigned char smem[];
    cg::grid_group grid = cg::this_grid();
    const int tid = threadIdx.x, lane = tid & 63, wave = __builtin_amdgcn_readfirstlane(tid >> 6);
    const int G = gridDim.x, bx = blockIdx.x, vcu = (G % 8 == 0) ? (bx % 8) * (G / 8) + bx / 8 : bx;
    const int gw = vcu * 8 + wave, NGW = G * 8;
    LAS unsigned char* lds3 = (LAS unsigned char*)smem; char* ldsg = (char*)smem; const int ldsaddr = (int)(unsigned)(uintptr_t)lds3;
    float* out = a.out;
#define WSB() size_t wz_ = 0; asm volatile("" : "+s"(wz_)); unsigned char* ws = a.ws + wz_
#define INP(name, k) const float* name = a.in[k] + wz_
#define WSF(name, off) float* name = (float*)(ws + (off))
#define WSH(name, off) bf16_t* name = (bf16_t*)(ws + (off))
    const int lo = a.ph_lo, hi = a.ph_hi;
    if (tid < 16) ((LAS unsigned*)(lds3 + LDS_BAR_OFF))[tid] = 0u;
    __syncthreads();
    XcdBarrier xbar = xcd_barrier_post((unsigned*)(a.ws + WS_CTL + OFF_XBAR), (volatile LAS unsigned*)(lds3 + LDS_BAR_OFF));
#ifndef PH_MASK
#define PH_MASK 0x7ff
#endif
#define IN(k) (((PH_MASK >> (k)) & 1) && lo <= (k) && (k) < hi)
#define SEAM(k) do { if (IN(k) && IN((k) + 1)) { asm volatile("s_waitcnt vmcnt(0) lgkmcnt(0)" ::: "memory"); grid.sync(); \
    __builtin_amdgcn_fence(__ATOMIC_ACQUIRE, "agent"); asm volatile("s_waitcnt vmcnt(0)" ::: "memory"); } } while (0)
#define SEAMX(k) do { if (IN(k) && IN((k) + 1)) xcd_barrier(xbar); } while (0)

    if (IN(0)) {
        WSB(); WSF(mod, WS_CTL + OFF_MOD); WSF(cosr, WS_COSR); WSF(sinr, WS_SINR); WSF(cosm, WS_COSM); WSF(sinm, WS_SINM);
        WSH(Win, WS_WIN); WSH(Wuq, WS_WUQ); WSH(Wukv, WS_WUKV); WSH(Wo, WS_WO); WSH(Wgu, WS_WGU); WSH(Wdn, WS_WDN);
        INP(cin, 1); INP(ada_w, 3); INP(ada_b, 4); INP(w_in, 6); INP(mla_q_norm_w, 10); INP(w_uq, 11); INP(mla_kv_norm_w, 12); INP(w_ukv, 13); INP(w_o, 15); INP(w_gate, 17); INP(w_up, 18); INP(w_down, 19);
        const int* positions = (const int*)a.in[2] + wz_;
        {
            LAS float* cs = (LAS float*)lds3;
            for (int i = tid; i < 8 * 2048; i += 512) { const int b = i >> 11, k = i & 2047; const float v = cin[i]; cs[k * 8 + b] = v / (1.f + __expf(-v)); }
            __syncthreads();
            for (int task = gw; task < 192 * 16; task += NGW) { const int cb = task % 192, ks = task / 192, col = cb * 64 + lane;
                float acc[8]; const float bias = ks == 0 ? ada_b[col] : 0.f;
#pragma unroll
                for (int b = 0; b < 8; ++b) acc[b] = bias;
                const float* wp = ada_w + (size_t)(ks * 128) * NMODC + col;
                for (int k8 = 0; k8 < 128; k8 += 8) { float wv[8];
#pragma unroll
                    for (int i = 0; i < 8; ++i) wv[i] = wp[(size_t)(k8 + i) * NMODC];
#pragma unroll
                    for (int i = 0; i < 8; ++i) { const LAS f32x4* c4 = (const LAS f32x4*)(cs + (ks * 128 + k8 + i) * 8); const f32x4 c0 = c4[0], c1 = c4[1];
                        acc[0] += c0.x * wv[i]; acc[1] += c0.y * wv[i]; acc[2] += c0.z * wv[i]; acc[3] += c0.w * wv[i]; acc[4] += c1.x * wv[i]; acc[5] += c1.y * wv[i]; acc[6] += c1.z * wv[i]; acc[7] += c1.w * wv[i]; } }
#pragma unroll
                for (int b = 0; b < 8; ++b) atomicAdd(mod + (size_t)b * NMODC + col, acc[b]); }
            __syncthreads();
        }
        {
            LAS float* scr = (LAS float*)(lds3 + wave * 16384);
            constexpr int I_IN = 32 * (INC / 32), I_UQ = 8 * 48, I_UKV = 8 * 64, I_O = 32 * 64, I_G = 32 * (DFF / 32), I_D = (DFF / 64) * 64;
            constexpr int NITEMS = I_IN + I_UQ + I_UKV + I_O;
            for (int it = gw; it < NITEMS; it += NGW) { int r = it;
                if (r < I_IN) { transpose_item(w_in, 2048, INC, Win, nullptr, 1, scr, r, lane); continue; } r -= I_IN;
                if (r < I_UQ) { transpose_item(w_uq, 512, 1536, Wuq, mla_q_norm_w, 2, scr, r, lane); continue; } r -= I_UQ;
                if (r < I_UKV) { transpose_item(w_ukv, 512, 2048, Wukv, mla_kv_norm_w, 0, scr, r, lane); continue; } r -= I_UKV;
                if (r < I_O) { transpose_item(w_o, 2048, 2048, Wo, nullptr, 0, scr, r, lane); continue; } r -= I_O;
                (void)I_D; }
            for (int i = bx * 512 + tid; i < (INCP - INC) * 2048 / 8; i += G * 512) *(v4u*)(Win + (size_t)INC * 2048 + (size_t)i * 8) = (v4u){0u, 0u, 0u, 0u};
        }
        {
            for (int i = bx * 512 + tid; i < T * 96; i += G * 512) { const int t = i / 96, j = i % 96; const float pos = (float)positions[t];
                const float inv = j < 64 ? a.inv_r[j] : a.inv_m[j - 64]; const float ang = pos * inv;
                double rev = (double)ang * 0.15915494309189535; rev -= __builtin_rint(rev);
                const double qd = __builtin_rint(rev * 4.0); const double y = (rev - qd * 0.25) * 6.283185307179586; const double y2 = y * y;
                const double sy = y * (1.0 + y2 * (-1.0 / 6 + y2 * (1.0 / 120 + y2 * (-1.0 / 5040 + y2 * (1.0 / 362880 + y2 * (-1.0 / 39916800 + y2 * (1.0 / 6227020800.0)))))));
                const double cy = 1.0 + y2 * (-0.5 + y2 * (1.0 / 24 + y2 * (-1.0 / 720 + y2 * (1.0 / 40320 + y2 * (-1.0 / 3628800 + y2 * (1.0 / 479001600.0 + y2 * (-1.0 / 87178291200.0)))))));
                const int qi = (int)qd & 3;
                const float cv = (float)(qi == 0 ? cy : qi == 1 ? -sy : qi == 2 ? -cy : sy), sv = (float)(qi == 0 ? sy : qi == 1 ? cy : qi == 2 ? -sy : -cy);
                if (j < 64) { cosr[(size_t)t * 64 + j] = cv; sinr[(size_t)t * 64 + j] = sv; } else { cosm[(size_t)t * 32 + j - 64] = cv; sinm[(size_t)t * 32 + j - 64] = sv; } }
        }
    }
    SEAMX(0);
    if (a.ph_hi > 1000) { SEAM(0); }
    if (IN(1)) { WSB(); WSF(mod, WS_CTL + OFF_MOD); WSH(H, WS_H); INP(x, 0); INP(norm1_w, 5);
        for (int m = gw; m < T; m += NGW) { const int b = m >> 12; norm_row(x + (size_t)m * DM, norm1_w, mod + (size_t)b * NMODC, mod + (size_t)b * NMODC + DM, H + (size_t)m * DM, nullptr, lane); } }
    SEAMX(1);
    if (IN(2)) {
        WSB(); WSH(H, WS_H); WSH(Win, WS_WIN); WSH(Qr, WS_QR); WSH(Kr, WS_KR); WSH(Vr, WS_VR); WSH(Gr, WS_GR); WSH(CQ, WS_CQ); WSH(CKV, WS_CKV); WSH(Kbuf, WS_KB);
        WSF(cosr, WS_COSR); WSF(sinr, WS_SINR); WSF(cosm, WS_COSM); WSF(sinm, WS_SINM); WSF(ssq_q, WS_CTL + OFF_SSQQ); WSF(ssq_kv, WS_CTL + OFF_SSQKV);
        pg8::Gemm g{H, Win, T, INCP, DM}; pg8::StaticOrder S; S.init(T, INCP, G, bx);
        pg8::EpiIn E{Qr, Kr, Vr, Gr, CQ, CKV, Kbuf, cosr, sinr, cosm, sinm, ssq_q, ssq_kv};
        pg8::gemm_phase<pg8::EpiIn, pg8::StaticOrder, true, true>(lds3, g, S, E);
        {
            constexpr int I_G = 32 * (DFF / 32); const int first = ((T / 256) * (INCP / 256)) % G, nsw = (G - first) * 8;
            if (bx >= first) { WSH(Wgu, WS_WGU); INP(w_gate, 17); INP(w_up, 18); LAS float* scr = (LAS float*)(lds3 + wave * 16384); const int wi = (bx - first) * 8 + wave;
                constexpr int I_D = (DFF / 64) * 64; WSH(Wdn, WS_WDN); INP(w_down, 19);
                for (int it = wi; it < 2 * I_G + I_D; it += nsw) { if (it < I_G) transpose_item(w_gate, 2048, DFF, Wgu, nullptr, 3, scr, it, lane); else if (it < 2 * I_G) transpose_item(w_up, 2048, DFF, Wgu, nullptr, 4, scr, it - I_G, lane); else transpose_item(w_down, DFF, 2048, Wdn, nullptr, 0, scr, it - 2 * I_G, lane); } }
        }
    }
    SEAMX(2);
    if (IN(3)) {
        WSB(); WSH(CQ, WS_CQ); WSH(CKV, WS_CKV); WSH(Wuq, WS_WUQ); WSH(Wukv, WS_WUKV); WSH(Qm, WS_QM); WSH(Kbuf, WS_KB); WSH(Vm, WS_VM); WSH(Kr, WS_KR); WSH(Vr, WS_VR); WSH(CK, WS_H);
        WSF(cosm, WS_COSM); WSF(sinm, WS_SINM); WSF(ssq_q, WS_CTL + OFF_SSQQ); WSF(ssq_kv, WS_CTL + OFF_SSQKV); INP(ret_decay, 7);
        { pg8::Gemm g{CQ, Wuq, T, 1536, 512}; pg8::StaticOrder S; S.init(T, 1536, G, bx); pg8::EpiUpQ E{ssq_q, Qm, cosm, sinm};
          pg8::gemm_phase<pg8::EpiUpQ, pg8::StaticOrder, true, true>(lds3, g, S, E); }
        { pg8::Gemm g{CKV, Wukv, T, 2048, 512}; pg8::StaticOrder S; S.init(T, 2048, G, bx); pg8::EpiUpKV E{ssq_kv, Kbuf, Vm};
          pg8::gemm_phase<pg8::EpiUpKV, pg8::StaticOrder, true, true>(lds3, g, S, E); }
        for (int u = vcu; u < 2048; u += G) { const int n = u & 31, h = (u >> 5) & 7, b = u >> 8; const size_t t0 = (size_t)b * SEQ + n * 128;
            const float lgf = -__expf(ret_decay[h]) * 1.4426950408889634f, lgb = -__expf(ret_decay[8 + h]) * 1.4426950408889634f;
            att::chunk_kv_unit(Kr + t0 * 1024 + h * 128, Vr + t0 * 1024 + h * 128, CK + ((size_t)(b * 8 + h) * 32 + n) * 16384, CK + ((size_t)(64 + b * 8 + h) * 32 + n) * 16384, lgf, lgb, ldsg, ldsaddr); }
        __syncthreads();
    }
    SEAMX(3);
    if (IN(4)) {
        WSB(); WSH(Qm, WS_QM); WSH(Kbuf, WS_KB); WSH(Vm, WS_VM); WSH(Oat, WS_OAT); WSH(CK, WS_H); INP(ret_decay, 7);
        for (int u = vcu; u < 1024; u += G) { const int qb = u & 15, h = (u >> 4) & 7, b = u >> 7; const size_t r0 = (size_t)b * SEQ;
            att::attn_unit(Qm + (r0 + qb * 256) * 1536 + h * 192, Kbuf + r0 * 1536 + h * 192, Vm + r0 * 1024 + h * 128, Oat + (r0 + qb * 256) * 1024 + h * 128, SEQ, ldsg, ldsaddr); }
#ifndef NO_SCAN
        for (int idx = bx * 512 + tid; idx < 2 * 64 * 2048; idx += G * 512) { const int dir = idx >> 17, bh = (idx >> 11) & 63, e8 = idx & 2047, h = bh & 7;
            const float cd = __builtin_amdgcn_exp2f(-__expf(ret_decay[dir * 8 + h]) * 1.4426950408889634f * 128.f);
            bf16_t* base = CK + ((size_t)(dir * 64 + bh) * 32) * 16384 + e8 * 8; float st[8];
#pragma unroll
            for (int i = 0; i < 8; ++i) st[i] = 0.f;
            for (int s8 = 0; s8 < 32; s8 += 8) { v4u kv[8];
#pragma unroll
                for (int i = 0; i < 8; ++i) { const int m = dir ? 31 - (s8 + i) : s8 + i; kv[i] = *(const v4u*)(base + (size_t)m * 16384); }
#pragma unroll
                for (int i = 0; i < 8; ++i) { const int m = dir ? 31 - (s8 + i) : s8 + i; v4u o;
                    o.x = pk2a(st[0], st[1]); o.y = pk2a(st[2], st[3]); o.z = pk2a(st[4], st[5]); o.w = pk2a(st[6], st[7]);
                    *(v4u*)(base + (size_t)m * 16384) = o;
#pragma unroll
                    for (int q = 0; q < 4; ++q) { const unsigned w = kv[i][q]; st[2 * q] = st[2 * q] * cd + __uint_as_float(w << 16); st[2 * q + 1] = st[2 * q + 1] * cd + __uint_as_float(w & 0xffff0000u); } } }
        }
#endif
    }
    SEAMX(4);
    if (IN(5)) {
        WSB(); WSH(Qr, WS_QR); WSH(Kr, WS_KR); WSH(Vr, WS_VR); WSH(Gr, WS_GR); WSH(CK, WS_H); WSH(Cat, WS_CAT); WSH(Oat, WS_OAT); INP(ret_decay, 7); INP(ret_gn_w, 8); INP(ret_gn_b, 9); INP(mla_out_w, 14);
#if PROBE_BRUTE_RET
        float* dumpb = (float*)(ws + 704 * MiB);
        for (int up = vcu; up < 1024; up += G) {
            if (PROBE_COMP != 0) { const int u = up * 2 + (wave >> 2); const int n = u & 31, h = (u >> 5) & 7, b = u >> 8; const size_t t0 = (size_t)b * SEQ + n * 128;
                const float lgf = -__expf(ret_decay[h]) * 1.4426950408889634f, lgb = -__expf(ret_decay[8 + h]) * 1.4426950408889634f; const int hf = wave >> 2;
                att::ret_out_unit(Qr + t0 * 1024 + h * 128, Kr + t0 * 1024 + h * 128, Vr + t0 * 1024 + h * 128, Gr + t0 * 1024 + h * 128,
                                  CK + ((size_t)(b * 8 + h) * 32 + n) * 16384, CK + ((size_t)(64 + b * 8 + h) * 32 + n) * 16384, ret_gn_w + h * 128, ret_gn_b + h * 128,
                                  Cat + t0 * 2048 + h * 128, lgf, lgb, ldsg + hf * 65536, ldsaddr + hf * 65536, dumpb + t0 * 1024 + h * 128);
                __threadfence(); __syncthreads(); }
            for (int k2 = 0; k2 < 2; ++k2) { const int u = up * 2 + k2; const int n = u & 31, h = (u >> 5) & 7, b = u >> 8; const size_t r0 = (size_t)b * SEQ, t0 = r0 + n * 128;
                const float lgf = -__expf(ret_decay[h]) * 1.4426950408889634f, lgb = -__expf(ret_decay[8 + h]) * 1.4426950408889634f;
                att::ret_brute_unit(Qr + r0 * 1024 + h * 128, Kr + r0 * 1024 + h * 128, Vr + r0 * 1024 + h * 128, Gr + t0 * 1024 + h * 128, ret_gn_w + h * 128, ret_gn_b + h * 128, Cat + t0 * 2048 + h * 128, n * 128, lgf, lgb, ldsg, dumpb + t0 * 1024 + h * 128); } }
        __syncthreads();
        for (int up = vcu; up < 0; up += G) { const int u = up * 2 + (wave >> 2);
#else
        for (int up = vcu; up < 1024; up += G) { const int u = up * 2 + (wave >> 2);
#endif
            const int n = u & 31, h = (u >> 5) & 7, b = u >> 8; const size_t t0 = (size_t)b * SEQ + n * 128;
            const float lgf = -__expf(ret_decay[h]) * 1.4426950408889634f, lgb = -__expf(ret_decay[8 + h]) * 1.4426950408889634f; const int hf = wave >> 2;
            att::ret_out_unit(Qr + t0 * 1024 + h * 128, Kr + t0 * 1024 + h * 128, Vr + t0 * 1024 + h * 128, Gr + t0 * 1024 + h * 128,
                              CK + ((size_t)(b * 8 + h) * 32 + n) * 16384, CK + ((size_t)(64 + b * 8 + h) * 32 + n) * 16384, ret_gn_w + h * 128, ret_gn_b + h * 128,
                              Cat + t0 * 2048 + h * 128, lgf, lgb, ldsg + hf * 65536, ldsaddr + hf * 65536); }
        for (int m = gw; m < T; m += NGW) {
            const bf16_t* orow = Oat + (size_t)m * 1024; float v[16]; float s = 0.f;
#pragma unroll
            for (int j = 0; j < 2; ++j) { const v4u w = *(const v4u*)(orow + lane * 8 + 512 * j);
#pragma unroll
                for (int q = 0; q < 4; ++q) { v[j * 8 + 2 * q] = __uint_as_float(w[q] << 16); v[j * 8 + 2 * q + 1] = __uint_as_float(w[q] & 0xffff0000u); } }
#pragma unroll
            for (int i = 0; i < 16; ++i) s += v[i] * v[i];
            const float rstd = rsqrtf(wave_sum(s) * (1.f / 1024.f) + 1e-6f);
#pragma unroll
            for (int j = 0; j < 2; ++j) { const int col = lane * 8 + 512 * j; const f32x4 w0 = *(const f32x4*)(mla_out_w + col), w1 = *(const f32x4*)(mla_out_w + col + 4); v4u o;
                o.x = pk2a(v[j * 8 + 0] * rstd * w0.x, v[j * 8 + 1] * rstd * w0.y); o.y = pk2a(v[j * 8 + 2] * rstd * w0.z, v[j * 8 + 3] * rstd * w0.w);
                o.z = pk2a(v[j * 8 + 4] * rstd * w1.x, v[j * 8 + 5] * rstd * w1.y); o.w = pk2a(v[j * 8 + 6] * rstd * w1.z, v[j * 8 + 7] * rstd * w1.w);
                *(v4u*)(Cat + (size_t)m * 2048 + 1024 + col) = o; } }
        __syncthreads();
    }
    SEAMX(5);
    if (IN(6)) {
        WSB(); WSH(Cat, WS_CAT); WSH(Wo, WS_WO); WSF(mod, WS_CTL + OFF_MOD); INP(x, 0);
        pg8::Gemm g{Cat, Wo, T, 2048, 2048}; pg8::StaticOrder S; S.init(T, 2048, G, bx); pg8::EpiGateRes E{x, mod + 2 * DM, out};
        pg8::gemm_phase<pg8::EpiGateRes, pg8::StaticOrder, true, true>(lds3, g, S, E);
    }
    SEAMX(6);
    if (IN(7)) { WSB(); WSF(mod, WS_CTL + OFF_MOD); WSH(H, WS_H); INP(norm2_w, 16);
        for (int m = gw; m < T; m += NGW) { const int b = m >> 12; norm_row(out + (size_t)m * DM, norm2_w, mod + (size_t)b * NMODC + 3 * DM, mod + (size_t)b * NMODC + 4 * DM, H + (size_t)m * DM, nullptr, lane); } }
    SEAMX(7);
    if (IN(8)) {
        WSB(); WSH(H, WS_H); WSH(Wgu, WS_WGU); WSH(Aff, WS_AFF);
        pg8::Gemm g{H, Wgu, T, 2 * DFF, DM}; pg8::StaticOrder S; S.init(T, 2 * DFF, G, bx); pg8::EpiGU E{Aff};
        pg8::gemm_phase<pg8::EpiGU, pg8::StaticOrder, true, true>(lds3, g, S, E);
    }
    SEAMX(8);
    if (IN(9)) {
        WSB(); WSH(Aff, WS_AFF); WSH(Wdn, WS_WDN); WSF(mod, WS_CTL + OFF_MOD);
        pg8::Gemm g{Aff, Wdn, T, 2048, DFF}; pg8::StaticOrder S; S.init(T, 2048, G, bx); pg8::EpiGateRes E{out, mod + 5 * DM, out};
        pg8::gemm_phase<pg8::EpiGateRes, pg8::StaticOrder, true, true>(lds3, g, S, E);
    }
    SEAMX(9);
    if (IN(10)) { WSB(); (void)ws; INP(final_norm_w, 20);
        for (int m = gw; m < T; m += NGW) norm_row(out + (size_t)m * DM, final_norm_w, nullptr, nullptr, nullptr, out + (size_t)m * DM, lane); }
#undef IN
#undef SEAM
}

extern "C" void kernel_launch(void* const* d_in, const int* in_sizes, int n_in, void* d_out, int out_size, void* d_ws, size_t ws_size, hipStream_t stream) {
    static int grid = 0;
    if (grid == 0) {
        if (n_in != 21 || in_sizes[0] != T * DM || out_size != T * DM || ws_size < WS_END) { fprintf(stderr, "kernel_launch: shape/workspace mismatch (n_in %d, ws %zu < %zu)\n", n_in, ws_size, (size_t)WS_END); grid = -1; return; }
        int dev = 0, cus = 0, per_cu = 0;
        (void)hipGetDevice(&dev); (void)hipDeviceGetAttribute(&cus, hipDeviceAttributeMultiprocessorCount, dev);
        if (hipFuncSetAttribute((const void*)mk_fwd, hipFuncAttributeMaxDynamicSharedMemorySize, LDS_BYTES) != hipSuccess) { fprintf(stderr, "kernel_launch: hipFuncSetAttribute failed\n"); grid = -1; return; }
        if (hipOccupancyMaxActiveBlocksPerMultiprocessor(&per_cu, (const void*)mk_fwd, 512, LDS_BYTES) != hipSuccess || per_cu < 1) { fprintf(stderr, "kernel_launch: occupancy query gave %d\n", per_cu); per_cu = 1; }
        (void)hipGetLastError();
        grid = cus * per_cu;
    }
    if (grid < 0) return;
    (void)hipMemsetAsync((char*)d_ws + WS_CTL, 0, CTL_ZERO_BYTES, stream);
    Args a{};
    for (int i = 0; i < 21; ++i) a.in[i] = (const float*)d_in[i];
    a.out = (float*)d_out; a.ws = (unsigned char*)d_ws;
    for (int i = 0; i < 64; ++i) a.inv_r[i] = powf(10000.0f, -((float)(2 * i)) / 128.0f);
    for (int i = 0; i < 32; ++i) a.inv_m[i] = powf(10000.0f, -((float)(2 * i)) / 64.0f);
#if MK_SPLIT
    for (int p = 0; p < NPH; ++p) { a.ph_lo = p; a.ph_hi = p + 1; hipLaunchKernelGGL(mk_fwd, dim3(grid), dim3(512), LDS_BYTES, stream, a); }
#else
    a.ph_lo = 0; a.ph_hi = NPH;
    void* args[] = {&a};
    hipError_t e = hipLaunchCooperativeKernel((const void*)mk_fwd, dim3(grid), dim3(512), args, LDS_BYTES, stream);
    if (e != hipSuccess) fprintf(stderr, "kernel_launch: cooperative launch failed: %s (grid %d)\n", hipGetErrorString(e), grid);
#endif
}
```

```cpp
#include <hip/hip_runtime.h>
#include <hip/hip_cooperative_groups.h>
#include <cstdio>
#include <cstdint>
#include <cmath>
namespace cg = cooperative_groups;
namespace pg8 {
#define PG8_LAS __attribute__((address_space(3)))
typedef unsigned short bf16_t;
typedef short bf16x8 __attribute__((ext_vector_type(8)));
typedef float f32x4 __attribute__((ext_vector_type(4)));
typedef unsigned u32x4 __attribute__((ext_vector_type(4)));
constexpr int BM = 256, BK = 64, HALF = 128, HTB = HALF * BK * 2  , STAGE_BYTES = 8 * HTB, NXCD = 8, WGM = 8;

__host__ __device__ __forceinline__ int lds_byte(int r, int c) { const int st = (r >> 4) * 2 + (c >> 5), rr = r & 15, cc = c & 31, ob = rr * 64 + cc * 2; return st * 1024 + (ob ^ (((ob >> 9) & 1) << 5)); }
__host__ __device__ __forceinline__ void stage_rc(int b, int& R, int& C) { const int st = b / 1024, sb = b % 1024, swz = sb ^ (((sb >> 9) & 1) << 5); R = (st >> 1) * 16 + swz / 64; C = (st & 1) * 32 + (swz % 64) / 2; }
__host__ __device__ __forceinline__ int perm32(int rho) { const int n = rho >> 4, i = rho & 15; return 8 * (i >> 2) + 4 * n + (i & 3); }

struct Unit { int pm, pn; };
struct Gemm { const bf16_t* A; const bf16_t* Bt; int M, N, K; };

struct StaticOrder {
    int nM, nN, nwg, G, c;
    __host__ __device__ void init(int M, int N, int G_, int c_) { nM = M / BM; nN = N / BM; nwg = nM * nN; G = G_; c = c_; }
    __host__ __device__ bool next(int i, Unit& u) const {
        const long L = (long)i * G + c; if (L >= nwg) return false;
        int wgid = (int)L; { const int q = nwg / NXCD, r = nwg % NXCD, xcd = wgid % NXCD, off = wgid / NXCD; wgid = (xcd < r ? xcd * (q + 1) : r * (q + 1) + (xcd - r) * q) + off; }
        const int nig = WGM * nN, gid = wgid / nig, fm = gid * WGM, gsz = (nM - fm) < WGM ? (nM - fm) : WGM;
        u.pm = fm + ((wgid % nig) % gsz); u.pn = (wgid % nig) / gsz; return true;
    }
    __device__ __forceinline__ void a_ready(const Unit&) const {}
    __device__ __forceinline__ void done(const Unit&) const {}
};

#ifndef PROBE_COARSE_ACT
#define PROBE_COARSE_ACT 0
#endif
__device__ __forceinline__ unsigned coarse2(unsigned w) { return PROBE_COARSE_ACT ? ((w + ((w >> 1) & 0x00010001u)) & 0xfffefffeu) : w; }
__device__ __forceinline__ unsigned cvt_pk_bf16(float lo, float hi) { unsigned r; asm volatile("v_cvt_pk_bf16_f32 %0, %1, %2" : "=v"(r) : "v"(lo), "v"(hi)); return coarse2(r); }
typedef float f32x2 __attribute__((ext_vector_type(2)));

typedef unsigned u32x2 __attribute__((ext_vector_type(2)));
__device__ __forceinline__ float silu_f(float v) { return v * __builtin_amdgcn_rcpf(1.f + __builtin_amdgcn_exp2f(v * -1.4426950408889634f)); }
__device__ __forceinline__ u32x4 pack8(f32x4 a, f32x4 b) { u32x4 w; w.x = cvt_pk_bf16(a[0], a[1]); w.y = cvt_pk_bf16(a[2], a[3]); w.z = cvt_pk_bf16(b[0], b[1]); w.w = cvt_pk_bf16(b[2], b[3]); return w; }
__device__ __forceinline__ void rope8(f32x4& a, f32x4& b, const f32x4 c, const f32x4 s) {
    float t1, t2;
    t1 = a[0]; t2 = a[1]; a[0] = t1 * c[0] - t2 * s[0]; a[1] = t2 * c[0] + t1 * s[0];
    t1 = a[2]; t2 = a[3]; a[2] = t1 * c[1] - t2 * s[1]; a[3] = t2 * c[1] + t1 * s[1];
    t1 = b[0]; t2 = b[1]; b[0] = t1 * c[2] - t2 * s[2]; b[1] = t2 * c[2] + t1 * s[2];
    t1 = b[2]; t2 = b[3]; b[2] = t1 * c[3] - t2 * s[3]; b[3] = t2 * c[3] + t1 * s[3];
}
constexpr float NORM_EPS = 1e-6f;

struct EpiIn {
    static constexpr bool PERM = true, AFTER_DRAIN = false;
    bf16_t *Qr, *Kr, *Vr, *Gr, *CQ, *CKV, *Kbuf; const float *cosr, *sinr, *cosm, *sinm; float *ssq_q, *ssq_kv;
    __device__ __forceinline__ void operator()(const f32x4 (&acc)[2][2][4][2], const Unit& u, int wr, int wc, int fr, int fq) const {
        const int pn = u.pn, row0 = u.pm * BM + wr * 64 + fr, cl = wc * 32 + 8 * fq;
        if (pn < 8) {
            bf16_t* O = pn < 4 ? Qr : Kr; const float sc = pn < 4 ? 1.f : 0.08838834764831845f; const int colt = (pn & 3) * 256 + cl;
#pragma unroll
            for (int ai = 0; ai < 2; ++ai)
#pragma unroll
                for (int m = 0; m < 4; ++m) { const int row = row0 + ai * HALF + m * 16;
                    const f32x4 c4 = *(const f32x4*)(cosr + (size_t)row * 64 + (cl >> 1)), s4 = *(const f32x4*)(sinr + (size_t)row * 64 + (cl >> 1));
#pragma unroll
                    for (int bj = 0; bj < 2; ++bj) { f32x4 a = acc[ai][bj][m][0], b = acc[ai][bj][m][1]; rope8(a, b, c4, s4); a = a * sc; b = b * sc;
                        *(u32x4*)(O + (size_t)row * 1024 + colt + bj * HALF) = pack8(a, b); } }
        } else if (pn < 16) {
            const bool isg = pn >= 12; bf16_t* O = isg ? Gr : Vr; const int colt = (pn & 3) * 256 + cl;
#pragma unroll
            for (int ai = 0; ai < 2; ++ai)
#pragma unroll
                for (int m = 0; m < 4; ++m) { const int row = row0 + ai * HALF + m * 16;
#pragma unroll
                    for (int bj = 0; bj < 2; ++bj) { f32x4 a = acc[ai][bj][m][0], b = acc[ai][bj][m][1];
                        if (isg) {
#pragma unroll
                            for (int i = 0; i < 4; ++i) { a[i] = silu_f(a[i]); b[i] = silu_f(b[i]); } }
                        *(u32x4*)(O + (size_t)row * 1024 + colt + bj * HALF) = pack8(a, b); } }
        } else if (pn < 20) {
            bf16_t* O = pn < 18 ? CQ : CKV; float* sq = pn < 18 ? ssq_q : ssq_kv; const int colt = (pn & 1) * 256 + cl;
#pragma unroll
            for (int ai = 0; ai < 2; ++ai)
#pragma unroll
                for (int m = 0; m < 4; ++m) { const int row = row0 + ai * HALF + m * 16; float s = 0.f;
#pragma unroll
                    for (int bj = 0; bj < 2; ++bj) { const f32x4 a = acc[ai][bj][m][0], b = acc[ai][bj][m][1];
                        s += (a[0] * a[0] + a[1] * a[1]) + (a[2] * a[2] + a[3] * a[3]) + (b[0] * b[0] + b[1] * b[1]) + (b[2] * b[2] + b[3] * b[3]);
                        *(u32x4*)(O + (size_t)row * 512 + colt + bj * HALF) = pack8(a, b); }
                    s += __shfl_xor(s, 16); s += __shfl_xor(s, 32);
                    if (fq == 0) atomicAdd(sq + row, s); }
        } else {
            if (wc < 2) {
#pragma unroll
                for (int ai = 0; ai < 2; ++ai)
#pragma unroll
                    for (int m = 0; m < 4; ++m) { const int row = row0 + ai * HALF + m * 16;
                        const f32x4 c4 = *(const f32x4*)(cosm + (size_t)row * 32 + (cl >> 1)), s4 = *(const f32x4*)(sinm + (size_t)row * 32 + (cl >> 1));
                        f32x4 a = acc[ai][0][m][0], b = acc[ai][0][m][1]; rope8(a, b, c4, s4); const u32x4 w = pack8(a, b);
#pragma unroll
                        for (int h = 0; h < 8; ++h) *(u32x4*)(Kbuf + (size_t)row * 1536 + h * 192 + 128 + cl) = w; }
            }
        }
    }
};
struct EpiUpQ {
    static constexpr bool PERM = true, AFTER_DRAIN = false;
    const float* ssq; bf16_t* Qm; const float *cosm, *sinm;
    __device__ __forceinline__ void operator()(const f32x4 (&acc)[2][2][4][2], const Unit& u, int wr, int wc, int fr, int fq) const {
        const int row0 = u.pm * BM + wr * 64 + fr, cl = wc * 32 + 8 * fq;
#pragma unroll
        for (int ai = 0; ai < 2; ++ai)
#pragma unroll
            for (int m = 0; m < 4; ++m) { const int row = row0 + ai * HALF + m * 16; const float rstd = rsqrtf(ssq[row] * (1.f / 512.f) + NORM_EPS);
#pragma unroll
                for (int bj = 0; bj < 2; ++bj) { const int c = u.pn * 256 + bj * HALF + cl, d = c % 192; f32x4 a = acc[ai][bj][m][0] * rstd, b = acc[ai][bj][m][1] * rstd;
                    if (d >= 128) { const int fi = (d - 128) >> 1; const f32x4 c4 = *(const f32x4*)(cosm + (size_t)row * 32 + fi), s4 = *(const f32x4*)(sinm + (size_t)row * 32 + fi); rope8(a, b, c4, s4); }
                    *(u32x4*)(Qm + (size_t)row * 1536 + c) = pack8(a, b); } }
    }
};
struct EpiUpKV {
    static constexpr bool PERM = true, AFTER_DRAIN = false;
    const float* ssq; bf16_t *Kbuf, *Vm;
    __device__ __forceinline__ void operator()(const f32x4 (&acc)[2][2][4][2], const Unit& u, int wr, int wc, int fr, int fq) const {
        const int row0 = u.pm * BM + wr * 64 + fr, cl = wc * 32 + 8 * fq;
#pragma unroll
        for (int ai = 0; ai < 2; ++ai)
#pragma unroll
            for (int m = 0; m < 4; ++m) { const int row = row0 + ai * HALF + m * 16; const float rstd = rsqrtf(ssq[row] * (1.f / 512.f) + NORM_EPS);
                *(u32x4*)(Kbuf + (size_t)row * 1536 + u.pn * 192 + cl) = pack8(acc[ai][0][m][0] * rstd, acc[ai][0][m][1] * rstd);
                *(u32x4*)(Vm + (size_t)row * 1024 + u.pn * 128 + cl) = pack8(acc[ai][1][m][0] * rstd, acc[ai][1][m][1] * rstd); }
    }
};
struct EpiGateRes {
    static constexpr bool PERM = true, AFTER_DRAIN = false;
    const float* x; const float* gate; float* out;
    __device__ __forceinline__ void operator()(const f32x4 (&acc)[2][2][4][2], const Unit& u, int wr, int wc, int fr, int fq) const {
        const int row0 = u.pm * BM + wr * 64 + fr, cl = wc * 32 + 8 * fq, b = u.pm >> 4;
#pragma unroll
        for (int bj = 0; bj < 2; ++bj) { const int c = u.pn * 256 + bj * HALF + cl;
            const f32x4 g0 = *(const f32x4*)(gate + (size_t)b * 12288 + c), g1 = *(const f32x4*)(gate + (size_t)b * 12288 + c + 4);
#pragma unroll
            for (int ai = 0; ai < 2; ++ai)
#pragma unroll
                for (int m = 0; m < 4; ++m) { const size_t off = (size_t)(row0 + ai * HALF + m * 16) * 2048 + c;
                    const f32x4 x0 = *(const f32x4*)(x + off), x1 = *(const f32x4*)(x + off + 4);
                    *(f32x4*)(out + off) = x0 + g0 * acc[ai][bj][m][0]; *(f32x4*)(out + off + 4) = x1 + g1 * acc[ai][bj][m][1]; } }
    }
};
struct EpiGU {
    static constexpr bool PERM = true, AFTER_DRAIN = false;
    bf16_t* Aff;
    __device__ __forceinline__ void operator()(const f32x4 (&acc)[2][2][4][2], const Unit& u, int wr, int wc, int fr, int fq) const {
        const int row0 = u.pm * BM + wr * 64 + fr, cl = wc * 32 + 8 * fq;
#pragma unroll
        for (int ai = 0; ai < 2; ++ai)
#pragma unroll
            for (int m = 0; m < 4; ++m) { const int row = row0 + ai * HALF + m * 16; f32x4 a, b;
#pragma unroll
                for (int i = 0; i < 4; ++i) { a[i] = silu_f(acc[ai][0][m][0][i]) * acc[ai][1][m][0][i]; b[i] = silu_f(acc[ai][0][m][1][i]) * acc[ai][1][m][1][i]; }
                *(u32x4*)(Aff + (size_t)row * 5632 + u.pn * 128 + cl) = pack8(a, b); }
    }
};

template <class Epi, class Sched, bool ALIGN_EPI = false, bool SP2 = false>
__device__ __forceinline__ void gemm_phase(PG8_LAS unsigned char* lds, const Gemm g, const Sched& S, const Epi& E) {
    const int tid = threadIdx.x, wid = __builtin_amdgcn_readfirstlane(tid >> 6), lane = tid & 63, wr = wid >> 2, wc = wid & 3, fr = lane & 15, fq = lane >> 4;
    const int K = g.K, nt = K / BK;
    unsigned voffA[2], voffB[2];
#pragma unroll
    for (int i = 0; i < 2; ++i) { int R, C; stage_rc(tid * 16 + i * 8192, R, C); const int Rb = Epi::PERM ? ((R & ~31) + perm32(R & 31)) : R;
        voffA[i] = (unsigned)(R * K + C) * 2u; voffB[i] = (unsigned)(Rb * K + C) * 2u; }
    const size_t kstep = (size_t)(BK * 2);
    const size_t hstep = (size_t)HALF * K * 2;
    const size_t tstep = 2 * hstep;
    const unsigned ldsw = (unsigned)wid * 1024u;
    const int aoff = lds_byte(wr * 64 + fr, fq * 8), boff = lds_byte(wc * 32 + fr, fq * 8);
#define PG8_SA(b, h) (((b) * 2 + (h)) * HTB)
#define PG8_SB(b, h) ((4 + (b) * 2 + (h)) * HTB)
#define PG8_STAGE(bufoff, gbase, voff) do { _Pragma("unroll") for (int _i = 0; _i < 2; ++_i) \
        __builtin_amdgcn_global_load_lds((const unsigned*)((const char*)(gbase) + (voff)[_i]), (PG8_LAS unsigned*)(lds + (bufoff) + ldsw + _i * 8192), 16, 0, 0); } while (0)
#define PG8_LDA(dst, b, h) do { _Pragma("unroll") for (int m = 0; m < 4; ++m) _Pragma("unroll") for (int k = 0; k < 2; ++k) dst[m][k] = *(const PG8_LAS bf16x8*)(lds + PG8_SA(b, h) + aoff + m * 2048 + k * 1024); } while (0)
#define PG8_LDB(dst, b, h) do { _Pragma("unroll") for (int n = 0; n < 2; ++n) _Pragma("unroll") for (int k = 0; k < 2; ++k) dst[n][k] = *(const PG8_LAS bf16x8*)(lds + PG8_SB(b, h) + boff + n * 2048 + k * 1024); } while (0)
#define PG8_MMA(ai, bj, At, Bt) do { __builtin_amdgcn_s_setprio(1); _Pragma("unroll") for (int m = 0; m < 4; ++m) _Pragma("unroll") for (int n = 0; n < 2; ++n) _Pragma("unroll") for (int k = 0; k < 2; ++k) \
        acc[ai][bj][m][n] = __builtin_amdgcn_mfma_f32_16x16x32_bf16(Bt[n][k], At[m][k], acc[ai][bj][m][n], 0, 0, 0); __builtin_amdgcn_s_setprio(0); } while (0)
#define PG8_WAIT_V(n) asm volatile("s_waitcnt vmcnt(" #n ")" ::: "memory")
#define PG8_WAIT_L(n) asm volatile("s_waitcnt lgkmcnt(" #n ")" ::: "memory")
#define PG8_BAR __builtin_amdgcn_s_barrier()
#define PG8_SCHED __builtin_amdgcn_sched_barrier(0)
    Unit cur, nxt; int ui = 0;
    if (!S.next(0, cur)) return;
    f32x4 acc[2][2][4][2];
#pragma unroll
    for (int a = 0; a < 2; ++a)
#pragma unroll
        for (int b = 0; b < 2; ++b)
#pragma unroll
            for (int m = 0; m < 4; ++m)
#pragma unroll
                for (int n = 0; n < 2; ++n) acc[a][b][m][n] = (f32x4){0.f, 0.f, 0.f, 0.f};
    bf16x8 At[4][2], B0[2][2], B1[2][2];
    const char* cA = (const char*)g.A + (size_t)cur.pm * tstep; const char* cB = (const char*)g.Bt + (size_t)cur.pn * tstep;
    S.a_ready(cur);
    if constexpr (SP2) {
        PG8_STAGE(PG8_SB(0, 0), cB, voffB); PG8_STAGE(PG8_SB(0, 1), cB + hstep, voffB); PG8_STAGE(PG8_SA(0, 0), cA, voffA); PG8_STAGE(PG8_SA(0, 1), cA + hstep, voffA);
        if (wr == 1) PG8_BAR;
        PG8_WAIT_V(2); PG8_BAR;
        PG8_STAGE(PG8_SB(1, 0), cB + kstep, voffB); PG8_STAGE(PG8_SA(1, 0), cA + kstep, voffA); PG8_STAGE(PG8_SB(1, 1), cB + hstep + kstep, voffB);
        PG8_WAIT_V(6); PG8_BAR;
    } else {
        PG8_STAGE(PG8_SB(0, 0), cB, voffB); PG8_STAGE(PG8_SA(0, 0), cA, voffA); PG8_STAGE(PG8_SB(0, 1), cB + hstep, voffB); PG8_STAGE(PG8_SA(0, 1), cA + hstep, voffA);
        if (wr == 1) PG8_BAR;
        PG8_WAIT_V(4); PG8_BAR;
        PG8_STAGE(PG8_SB(1, 0), cB + kstep, voffB); PG8_STAGE(PG8_SA(1, 0), cA + kstep, voffA); PG8_STAGE(PG8_SB(1, 1), cB + hstep + kstep, voffB);
        PG8_WAIT_V(6); PG8_BAR;
    }
    for (;;) {
        const bool has_next = S.next(ui + 1, nxt);
        const char* nA = has_next ? (const char*)g.A + (size_t)nxt.pm * tstep : cA; const char* nB = has_next ? (const char*)g.Bt + (size_t)nxt.pn * tstep : cB;
        for (int t = 0; t < nt; t += 2) {
            const bool last = (t == nt - 2);
            const char* a1 = cA + (size_t)(t + 1) * kstep;
            const char* a2 = last ? nA : cA + (size_t)(t + 2) * kstep; const char* b2 = last ? nB : cB + (size_t)(t + 2) * kstep;
            const char* a3 = a2 + kstep; const char* b3 = b2 + kstep;
            if (last && has_next) S.a_ready(nxt);
            if constexpr (SP2) {
            PG8_LDB(B0, 0, 0); PG8_LDB(B1, 0, 1); PG8_SCHED; PG8_LDA(At, 0, 0); PG8_STAGE(PG8_SA(1, 1), a1 + hstep, voffA);
            PG8_WAIT_V(8); PG8_WAIT_L(0); PG8_BAR; PG8_MMA(0, 0, At, B0); PG8_MMA(0, 1, At, B1); PG8_BAR; PG8_SCHED;
            PG8_LDA(At, 0, 1); PG8_STAGE(PG8_SB(0, 0), b2, voffB); PG8_STAGE(PG8_SB(0, 1), b2 + hstep, voffB); PG8_STAGE(PG8_SA(0, 0), a2, voffA);
            PG8_WAIT_V(8); PG8_WAIT_L(0); PG8_BAR; PG8_MMA(1, 0, At, B0); PG8_MMA(1, 1, At, B1); PG8_BAR; PG8_SCHED;
            PG8_LDB(B0, 1, 0); PG8_LDB(B1, 1, 1); PG8_SCHED; PG8_LDA(At, 1, 0); PG8_STAGE(PG8_SA(0, 1), a2 + hstep, voffA);
            PG8_WAIT_V(8); PG8_WAIT_L(0); PG8_BAR; PG8_MMA(0, 0, At, B0); PG8_MMA(0, 1, At, B1); PG8_BAR; PG8_SCHED;
            PG8_LDA(At, 1, 1); PG8_STAGE(PG8_SB(1, 0), b3, voffB); PG8_STAGE(PG8_SB(1, 1), b3 + hstep, voffB); PG8_STAGE(PG8_SA(1, 0), a3, voffA);
            PG8_WAIT_V(8); PG8_WAIT_L(0); PG8_BAR; PG8_MMA(1, 0, At, B0); PG8_MMA(1, 1, At, B1); PG8_BAR; PG8_SCHED;
            } else {
            PG8_LDB(B0, 0, 0); PG8_SCHED; PG8_LDA(At, 0, 0); PG8_STAGE(PG8_SA(1, 1), a1 + hstep, voffA);
            PG8_WAIT_L(8); PG8_BAR; PG8_WAIT_L(0); PG8_MMA(0, 0, At, B0); PG8_BAR; PG8_SCHED;
            PG8_LDB(B1, 0, 1); PG8_STAGE(PG8_SB(0, 0), b2, voffB);
            PG8_BAR; PG8_WAIT_L(0); PG8_MMA(0, 1, At, B1); PG8_BAR;
            PG8_LDA(At, 0, 1); PG8_STAGE(PG8_SA(0, 0), a2, voffA);
            PG8_BAR; PG8_WAIT_L(0); PG8_MMA(1, 0, At, B0); PG8_BAR; PG8_SCHED;
            PG8_STAGE(PG8_SB(0, 1), b2 + hstep, voffB);
            PG8_WAIT_V(6); PG8_BAR; PG8_MMA(1, 1, At, B1); PG8_BAR;
            PG8_LDB(B0, 1, 0); PG8_SCHED; PG8_LDA(At, 1, 0); PG8_STAGE(PG8_SA(0, 1), a2 + hstep, voffA);
            PG8_WAIT_L(8); PG8_BAR; PG8_WAIT_L(0); PG8_MMA(0, 0, At, B0); PG8_BAR; PG8_SCHED;
            PG8_LDB(B1, 1, 1); PG8_STAGE(PG8_SB(1, 0), b3, voffB);
            PG8_BAR; PG8_WAIT_L(0); PG8_MMA(0, 1, At, B1); PG8_BAR;
            PG8_LDA(At, 1, 1); PG8_STAGE(PG8_SA(1, 0), a3, voffA);
            PG8_BAR; PG8_WAIT_L(0); PG8_MMA(1, 0, At, B0); PG8_BAR; PG8_SCHED;
            PG8_STAGE(PG8_SB(1, 1), b3 + hstep, voffB);
            PG8_WAIT_V(6); PG8_BAR; PG8_MMA(1, 1, At, B1); PG8_BAR;
            }
        }
        if constexpr (ALIGN_EPI) { if (wr == 0) PG8_BAR; }
        if constexpr (!Epi::AFTER_DRAIN) { E(acc, cur, wr, wc, fr, fq); S.done(cur); }
        if (!has_next) break;
#pragma unroll
        for (int a = 0; a < 2; ++a)
#pragma unroll
            for (int b = 0; b < 2; ++b)
#pragma unroll
                for (int m = 0; m < 4; ++m)
#pragma unroll
                    for (int n = 0; n < 2; ++n) acc[a][b][m][n] = (f32x4){0.f, 0.f, 0.f, 0.f};
        cur = nxt; cA = nA; cB = nB; ++ui;
        if constexpr (ALIGN_EPI) { if (wr == 1) PG8_BAR; }
    }
    PG8_WAIT_V(0);
    if constexpr (!ALIGN_EPI) { if (wr == 0) PG8_BAR; }
    PG8_BAR;
    if constexpr (Epi::AFTER_DRAIN) { E.fused(acc, cur, wr, wc, fr, fq, lds, wid, lane); S.done(cur); }
#undef PG8_SA
#undef PG8_SB
#undef PG8_STAGE
#undef PG8_LDA
#undef PG8_LDB
#undef PG8_MMA
#undef PG8_WAIT_V
#undef PG8_WAIT_L
#undef PG8_BAR
#undef PG8_SCHED
}
}

namespace att {
typedef unsigned short bf16_t;
using bf16x8 = __attribute__((ext_vector_type(8))) short;
using s16x4  = __attribute__((ext_vector_type(4))) short;
using f32x16 = __attribute__((ext_vector_type(16))) float;
using f32x4  = __attribute__((ext_vector_type(4))) float;
using u32x4  = __attribute__((ext_vector_type(4))) unsigned;
using u32x2  = __attribute__((ext_vector_type(2))) unsigned;
constexpr int NW = 8, QBLK = 32, KVBLK = 64;
constexpr int LDQ = 1536, LDK = 1536, LDV = 1024, LDO = 1024;
constexpr float SCALE = 0.07216878364870323f;
constexpr float THR = 8.f;
constexpr int NQR = 8;
constexpr int SHM_V = KVBLK * 128 * 2, SHM_K = KVBLK * 192 * 2, SHM_ATTN = 2 * SHM_V + 2 * SHM_K + NW * 64 * 4;
#define AKSWZ(row, colB) ((row) * 384 + ((colB) ^ (((((row) >> 1) & 3) | (((row) >> 2) & 4)) << 4)))
#define KSWZ128(row, colB) ((row) * 256 + ((colB) ^ (((row) & 15) << 4)))
#define SBAR() __builtin_amdgcn_sched_barrier(0)
#define GAS __attribute__((address_space(1)))
__device__ __forceinline__ const GAS char* uniform_ptr(const void* p) { const unsigned long long v = (unsigned long long)p; const unsigned lo = __builtin_amdgcn_readfirstlane((unsigned)v), hi = __builtin_amdgcn_readfirstlane((unsigned)(v >> 32)); return (const GAS char*)(((unsigned long long)hi << 32) | lo); }
__device__ __forceinline__ int crow(int r, int hi) { return (r & 3) + 8 * (r >> 2) + 4 * hi; }
__device__ __forceinline__ unsigned cvtpk(float lo, float hi) { unsigned r; asm volatile("v_cvt_pk_bf16_f32 %0, %1, %2" : "=v"(r) : "v"(lo), "v"(hi)); return pg8::coarse2(r); }
__device__ __forceinline__ float swap_sum(float v) { auto rr = __builtin_amdgcn_permlane32_swap(__float_as_uint(v), __float_as_uint(v), false, false); return __uint_as_float(rr[0]) + __uint_as_float(rr[1]); }

__device__ __forceinline__ void partialSM(f32x16& p0, f32x16& p1, float& m_reg, float& mn, float& alpha) {
  constexpr float C = SCALE * 1.4426950408889634f;
  float pmax = p0[0];
#pragma unroll
  for (int r = 1; r < 16; ++r) pmax = fmaxf(pmax, p0[r]);
#pragma unroll
  for (int r = 0; r < 16; ++r) pmax = fmaxf(pmax, p1[r]);
  { auto rr = __builtin_amdgcn_permlane32_swap(__float_as_uint(pmax), __float_as_uint(pmax), false, false);
    pmax = fmaxf(__uint_as_float(rr[0]), __uint_as_float(rr[1])); }
  if (__builtin_expect(__all(pmax - m_reg <= THR / SCALE), 1)) { mn = m_reg; alpha = 1.f; }
  else { mn = fmaxf(m_reg, pmax); alpha = __builtin_amdgcn_exp2f((m_reg - mn) * C); m_reg = mn; }
  float mnC = -mn * C;
#pragma unroll
  for (int r = 0; r < 16; ++r) p0[r] = fmaf(p0[r], C, mnC);
#pragma unroll
  for (int r = 0; r < 16; ++r) p1[r] = fmaf(p1[r], C, mnC);
#pragma unroll
  for (int r = 0; r < 16; ++r) p0[r] = __builtin_amdgcn_exp2f(p0[r]);
}
#define PK4(P, BASE, OUT) do { unsigned a0 = cvtpk(P[BASE + 0], P[BASE + 1]), a1 = cvtpk(P[BASE + 2], P[BASE + 3]);   \
    unsigned b0 = cvtpk(P[BASE + 4], P[BASE + 5]), b1 = cvtpk(P[BASE + 6], P[BASE + 7]);                              \
    auto r0 = __builtin_amdgcn_permlane32_swap(a0, b0, false, false); auto r1 = __builtin_amdgcn_permlane32_swap(a1, b1, false, false); \
    u32x4 w = {r0[0], r1[0], r0[1], r1[1]}; OUT = *reinterpret_cast<bf16x8*>(&w); } while (0)
__device__ __forceinline__ void finishSM(f32x16& p0, f32x16& p1, float alpha, float& l_reg, bf16x8& pa0, bf16x8& pa1, bf16x8& pa2, bf16x8& pa3) {
#pragma unroll
  for (int r = 0; r < 16; ++r) p1[r] = __builtin_amdgcn_exp2f(p1[r]);
  float ps = 0;
#pragma unroll
  for (int r = 0; r < 16; ++r) ps += p0[r];
#pragma unroll
  for (int r = 0; r < 16; ++r) ps += p1[r];
  ps = swap_sum(ps);
  l_reg = l_reg * alpha + ps;
  PK4(p0, 0, pa0); PK4(p0, 8, pa1); PK4(p1, 0, pa2); PK4(p1, 8, pa3);
}
__device__ __forceinline__ void qkt192(f32x16& p0, f32x16& p1, const char* Ks, const bf16x8 (&qr)[NQR], const char* Qs, int r32, int hi) {
  p0 = f32x16{}; p1 = f32x16{};
  __builtin_amdgcn_s_setprio(1);
#pragma unroll
  for (int d0 = 0; d0 < 12; ++d0) { int cb = (d0 * 16 + hi * 8) * 2;
    bf16x8 b0 = *reinterpret_cast<const bf16x8*>(Ks + AKSWZ(r32, cb));
    bf16x8 b1 = *reinterpret_cast<const bf16x8*>(Ks + AKSWZ(32 + r32, cb));
    bf16x8 qv; if (d0 < NQR) qv = qr[d0 < NQR ? d0 : 0]; else qv = *reinterpret_cast<const bf16x8*>(Qs + (d0 - NQR) * 1024);
    p0 = __builtin_amdgcn_mfma_f32_32x32x16_bf16(b0, qv, p0, 0, 0, 0);
    p1 = __builtin_amdgcn_mfma_f32_32x32x16_bf16(b1, qv, p1, 0, 0, 0); }
  __builtin_amdgcn_s_setprio(0);
}
__device__ __forceinline__ void qkt128(f32x16& p0, f32x16& p1, const char* Ks, const bf16x8 (&qr)[8], int r32, int hi) {
  p0 = f32x16{}; p1 = f32x16{};
#pragma unroll
  for (int d0 = 0; d0 < 8; ++d0) { int cb = (d0 * 16 + hi * 8) * 2;
    bf16x8 b0 = *reinterpret_cast<const bf16x8*>(Ks + KSWZ128(r32, cb));
    bf16x8 b1 = *reinterpret_cast<const bf16x8*>(Ks + KSWZ128(32 + r32, cb));
    p0 = __builtin_amdgcn_mfma_f32_32x32x16_bf16(b0, qr[d0], p0, 0, 0, 0);
    p1 = __builtin_amdgcn_mfma_f32_32x32x16_bf16(b1, qr[d0], p1, 0, 0, 0); }
}
__device__ __forceinline__ int v_st(int k, int c) { const int kk = (k & ~0xC) | ((k & 4) << 1) | ((k & 8) >> 1); return ((kk >> 3) * 4 + (c >> 5)) * 512 + ((kk & 7) * 32 + (c & 31)) * 2; }
__device__ __forceinline__ int v_rd_base(int lane) { return ((lane & 3) << 3) | (((lane >> 2) & 3) << 6) | (((lane >> 4) & 1) << 5) | (((lane >> 5) & 1) << 8); }
constexpr int v_rd_off(int d0, int ks, int half) { return d0 * 512 + ks * 4096 + half * 2048; }
template <int OFF> __device__ __forceinline__ s16x4 tr_read(int vb) {
  s16x4 r; asm volatile("ds_read_b64_tr_b16 %0, %1 offset:%2" : "=&v"(r) : "v"(vb), "i"(OFF) : "memory"); return r;
}
#define PKLH(L, H) (bf16x8){L[0], L[1], L[2], L[3], H[0], H[1], H[2], H[3]}
template <int D0> __device__ __forceinline__ void pv_one(f32x16& od, int vb, bf16x8 pa0, bf16x8 pa1, bf16x8 pa2, bf16x8 pa3) {
  const s16x4 l0 = tr_read<v_rd_off(D0, 0, 0)>(vb), h0 = tr_read<v_rd_off(D0, 0, 1)>(vb), l1 = tr_read<v_rd_off(D0, 1, 0)>(vb), h1 = tr_read<v_rd_off(D0, 1, 1)>(vb);
  const s16x4 l2 = tr_read<v_rd_off(D0, 2, 0)>(vb), h2 = tr_read<v_rd_off(D0, 2, 1)>(vb), l3 = tr_read<v_rd_off(D0, 3, 0)>(vb), h3 = tr_read<v_rd_off(D0, 3, 1)>(vb);
  asm volatile("s_waitcnt lgkmcnt(0)" ::: "memory"); SBAR();
  __builtin_amdgcn_s_setprio(1);
  od = __builtin_amdgcn_mfma_f32_32x32x16_bf16(pa0, PKLH(l0, h0), od, 0, 0, 0);
  od = __builtin_amdgcn_mfma_f32_32x32x16_bf16(pa1, PKLH(l1, h1), od, 0, 0, 0);
  od = __builtin_amdgcn_mfma_f32_32x32x16_bf16(pa2, PKLH(l2, h2), od, 0, 0, 0);
  od = __builtin_amdgcn_mfma_f32_32x32x16_bf16(pa3, PKLH(l3, h3), od, 0, 0, 0);
  __builtin_amdgcn_s_setprio(0);
}
__device__ __forceinline__ void pv_d0(f32x16* o, int vb, bf16x8 pa0, bf16x8 pa1, bf16x8 pa2, bf16x8 pa3) {
  pv_one<0>(o[0], vb, pa0, pa1, pa2, pa3); pv_one<1>(o[1], vb, pa0, pa1, pa2, pa3); pv_one<2>(o[2], vb, pa0, pa1, pa2, pa3); pv_one<3>(o[3], vb, pa0, pa1, pa2, pa3);
}
template <int D0> __device__ __forceinline__ void pvT_one(f32x16& od, int vb, bf16x8 pa0, bf16x8 pa1, bf16x8 pa2, bf16x8 pa3) {
  const s16x4 l0 = tr_read<v_rd_off(D0, 0, 0)>(vb), h0 = tr_read<v_rd_off(D0, 0, 1)>(vb), l1 = tr_read<v_rd_off(D0, 1, 0)>(vb), h1 = tr_read<v_rd_off(D0, 1, 1)>(vb);
  const s16x4 l2 = tr_read<v_rd_off(D0, 2, 0)>(vb), h2 = tr_read<v_rd_off(D0, 2, 1)>(vb), l3 = tr_read<v_rd_off(D0, 3, 0)>(vb), h3 = tr_read<v_rd_off(D0, 3, 1)>(vb);
  asm volatile("s_waitcnt lgkmcnt(0)" ::: "memory"); SBAR();
  od = __builtin_amdgcn_mfma_f32_32x32x16_bf16(PKLH(l0, h0), pa0, od, 0, 0, 0);
  od = __builtin_amdgcn_mfma_f32_32x32x16_bf16(PKLH(l1, h1), pa1, od, 0, 0, 0);
  od = __builtin_amdgcn_mfma_f32_32x32x16_bf16(PKLH(l2, h2), pa2, od, 0, 0, 0);
  od = __builtin_amdgcn_mfma_f32_32x32x16_bf16(PKLH(l3, h3), pa3, od, 0, 0, 0);
}

__device__ __forceinline__ void attn_unit(const bf16_t* __restrict__ Qb, const bf16_t* __restrict__ Kh, const bf16_t* __restrict__ Vh, bf16_t* __restrict__ Ob, int seq, char* lds, int ldsaddr) {
  const int tid = threadIdx.x, wid = tid >> 6, lane = tid & 63, r32 = lane & 31, hi = lane >> 5;
  char* V_lds = lds; char* K_lds = lds + 2 * SHM_V;
  float* ws = (float*)(lds + 2 * SHM_V + 2 * SHM_K) + wid * 64; float* li_l = ws; float* al_l = ws + 32;
  float m_reg = -1e30f, l_reg = 0; f32x16 o[4] = {}; bf16x8 qr[NQR];
  const bf16_t* Qw = Qb + (long)(wid * QBLK + r32) * LDQ + hi * 8;
  char* Qs = lds + SHM_ATTN + wid * ((12 - NQR) * 1024) + lane * 16;
#pragma unroll
  for (int d0 = 0; d0 < NQR; ++d0) qr[d0] = *reinterpret_cast<const bf16x8*>(Qw + d0 * 16);
#pragma unroll
  for (int d0 = NQR; d0 < 12; ++d0) *(bf16x8*)(Qs + (d0 - NQR) * 1024) = *reinterpret_cast<const bf16x8*>(Qw + d0 * 16);
  const int sr = tid >> 4, sc = (tid & 15) * 8, vst0 = v_st(sr, sc), vst1 = v_st(32 + sr, sc);
  unsigned kg0, kg1, kg2; int kl0, kl1, kl2;
  { int p = tid;        int kr = p / 24, kc = (p % 24) * 8; kg0 = (unsigned)(kr * LDK + kc) * 2u; kl0 = AKSWZ(kr, kc * 2);
    p = tid + 512;      kr = p / 24; kc = (p % 24) * 8;     kg1 = (unsigned)(kr * LDK + kc) * 2u; kl1 = AKSWZ(kr, kc * 2);
    p = tid + 1024;     kr = p / 24; kc = (p % 24) * 8;     kg2 = (unsigned)(kr * LDK + kc) * 2u; kl2 = AKSWZ(kr, kc * 2); }
  const unsigned vg0 = (unsigned)(sr * LDV + sc) * 2u, vg1 = (unsigned)((32 + sr) * LDV + sc) * 2u;
  const int vb0 = ldsaddr + v_rd_base(lane);
  bf16x8 vs0, vs1, ks0, ks1, ks2;
#define SLOAD(k0) do { const GAS char* vb_ = uniform_ptr((const char*)Vh + (size_t)(k0) * (LDV * 2)); const GAS char* kb_ = uniform_ptr((const char*)Kh + (size_t)(k0) * (LDK * 2)); \
    vs0 = *(const GAS bf16x8*)(vb_ + vg0); vs1 = *(const GAS bf16x8*)(vb_ + vg1); \
    ks0 = *(const GAS bf16x8*)(kb_ + kg0); ks1 = *(const GAS bf16x8*)(kb_ + kg1); ks2 = *(const GAS bf16x8*)(kb_ + kg2); } while (0)
#define SWRITE(b) do { *(bf16x8*)(V_lds + (b) * SHM_V + vst0) = vs0; *(bf16x8*)(V_lds + (b) * SHM_V + vst1) = vs1; \
    *(bf16x8*)(K_lds + (b) * SHM_K + kl0) = ks0; *(bf16x8*)(K_lds + (b) * SHM_K + kl1) = ks1; *(bf16x8*)(K_lds + (b) * SHM_K + kl2) = ks2; } while (0)
#define SWAIT() asm volatile("s_waitcnt vmcnt(0)" ::: "memory")
#define RESC(a) do { if (__any((a) < 1.f)) { if (hi == 0) al_l[r32] = (a); asm volatile("s_waitcnt lgkmcnt(0)" ::: "memory"); \
    _Pragma("unroll") for (int d = 0; d < 4; ++d) _Pragma("unroll") for (int r = 0; r < 16; ++r) o[d][r] *= al_l[crow(r, hi)]; } } while (0)
  f32x16 pA0, pA1, pB0, pB1; float mnA, mnB, alA, alB; bf16x8 pa0, pa1, pa2, pa3; const int NT = seq / KVBLK;
  __syncthreads();
  SLOAD(0); SWAIT(); SWRITE(0); __syncthreads();
  qkt192(pA0, pA1, K_lds, qr, Qs, r32, hi); partialSM(pA0, pA1, m_reg, mnA, alA);
  SLOAD(KVBLK);
  SWAIT(); SWRITE(1); __syncthreads();
  for (int j = 1; j + 1 < NT; j += 2) {
    SBAR(); qkt192(pB0, pB1, K_lds + SHM_K, qr, Qs, r32, hi);
    finishSM(pA0, pA1, alA, l_reg, pa0, pa1, pa2, pa3); SBAR();
    SLOAD((j + 1) * KVBLK); SBAR();
    pv_d0(o, vb0, pa0, pa1, pa2, pa3); partialSM(pB0, pB1, m_reg, mnB, alB);
    __syncthreads(); SWAIT(); SWRITE(0);
    RESC(alB); __syncthreads();
    SBAR(); qkt192(pA0, pA1, K_lds, qr, Qs, r32, hi);
    finishSM(pB0, pB1, alB, l_reg, pa0, pa1, pa2, pa3); SBAR();
    SLOAD((j + 2) * KVBLK); SBAR();
    pv_d0(o, vb0 + SHM_V, pa0, pa1, pa2, pa3); partialSM(pA0, pA1, m_reg, mnA, alA);
    __syncthreads(); SWAIT(); SWRITE(1);
    RESC(alA); __syncthreads();
  }
  SBAR(); qkt192(pB0, pB1, K_lds + SHM_K, qr, Qs, r32, hi);
  finishSM(pA0, pA1, alA, l_reg, pa0, pa1, pa2, pa3); SBAR();
  pv_d0(o, vb0, pa0, pa1, pa2, pa3); partialSM(pB0, pB1, m_reg, mnB, alB);
  __syncthreads(); RESC(alB);
  finishSM(pB0, pB1, alB, l_reg, pa0, pa1, pa2, pa3); SBAR();
  pv_d0(o, vb0 + SHM_V, pa0, pa1, pa2, pa3);
  if (hi == 0) li_l[r32] = l_reg; asm volatile("s_waitcnt lgkmcnt(0)" ::: "memory");
  float rli[16];
#pragma unroll
  for (int r = 0; r < 16; ++r) rli[r] = __builtin_amdgcn_rcpf(li_l[crow(r, hi)]);
  bf16_t* Ow = Ob + (long)(wid * QBLK) * LDO;
#pragma unroll
  for (int r = 0; r < 16; ++r) { int orow = crow(r, hi);
#pragma unroll
    for (int d0 = 0; d0 < 4; ++d0) Ow[(long)orow * LDO + d0 * 32 + r32] = (bf16_t)(cvtpk(o[d0][r] * rli[r], 0.f) & 0xffffu); }
#undef SLOAD
#undef SWRITE
#undef SWAIT
#undef RESC
}

__device__ __forceinline__ bf16x8 scale8(bf16x8 v, float s) {
  u32x4 w = *reinterpret_cast<u32x4*>(&v), o;
#pragma unroll
  for (int i = 0; i < 4; ++i) o[i] = cvtpk(__uint_as_float(w[i] << 16) * s, __uint_as_float(w[i] & 0xffff0000u) * s);
  return *reinterpret_cast<bf16x8*>(&o);
}
__device__ __forceinline__ s16x4 trr(int addr) { s16x4 r; asm volatile("ds_read_b64_tr_b16 %0, %1" : "=&v"(r) : "v"(addr) : "memory"); return r; }

__device__ __forceinline__ void chunk_kv_unit(const bf16_t* __restrict__ Kc, const bf16_t* __restrict__ Vc, bf16_t* __restrict__ CKf, bf16_t* __restrict__ CKb, float lgf, float lgb, char* lds, int ldsaddr) {
  const int tid = threadIdx.x, wid = tid >> 6, lane = tid & 63, r32 = lane & 31, hi = lane >> 5;
  const int dir = wid >> 2, db = wid & 3, d = 32 * db + r32;
  __syncthreads();
  { const int sr = tid >> 4, sc = (tid & 15) * 8;
#pragma unroll
    for (int i = 0; i < 4; ++i) { const int row = sr + 32 * i;
      *(bf16x8*)(lds + (row >> 6) * 16384 + v_st(row & 63, sc)) = *reinterpret_cast<const bf16x8*>(Vc + (long)row * 1024 + sc);
      *(bf16x8*)(lds + 32768 + row * 272 + sc * 2) = *reinterpret_cast<const bf16x8*>(Kc + (long)row * 1024 + sc); } }
  __syncthreads();
  bf16x8 kb[8];
  int hio = hi; asm volatile("" : "+v"(hio));
  const char* kl = lds + 32768 + (hio * 8) * 272 + d * 2;
#pragma unroll
  for (int ks = 0; ks < 8; ++ks) { u32x4 w;
#pragma unroll
    for (int i = 0; i < 4; ++i) { const int s0 = ks * 16 + hio * 8 + 2 * i;
      const float k0 = __uint_as_float((unsigned)*(const unsigned short*)(kl + (ks * 16 + 2 * i) * 272) << 16), k1 = __uint_as_float((unsigned)*(const unsigned short*)(kl + (ks * 16 + 2 * i + 1) * 272) << 16);
      const float z0 = __builtin_amdgcn_exp2f(dir ? lgb * (float)s0 : lgf * (float)(127 - s0)), z1 = __builtin_amdgcn_exp2f(dir ? lgb * (float)(s0 + 1) : lgf * (float)(126 - s0));
      w[i] = cvtpk(k0 * z0, k1 * z1); }
    kb[ks] = *reinterpret_cast<bf16x8*>(&w); }
  f32x16 acc[4] = {};
  const int vb = ldsaddr + v_rd_base(lane);
  pvT_one<0>(acc[0], vb, kb[0], kb[1], kb[2], kb[3]); pvT_one<1>(acc[1], vb, kb[0], kb[1], kb[2], kb[3]); pvT_one<2>(acc[2], vb, kb[0], kb[1], kb[2], kb[3]); pvT_one<3>(acc[3], vb, kb[0], kb[1], kb[2], kb[3]);
  pvT_one<0>(acc[0], vb + 16384, kb[4], kb[5], kb[6], kb[7]); pvT_one<1>(acc[1], vb + 16384, kb[4], kb[5], kb[6], kb[7]); pvT_one<2>(acc[2], vb + 16384, kb[4], kb[5], kb[6], kb[7]); pvT_one<3>(acc[3], vb + 16384, kb[4], kb[5], kb[6], kb[7]);
  bf16_t* CK = dir ? CKb : CKf;
#pragma unroll
  for (int eb = 0; eb < 4; ++eb)
#pragma unroll
    for (int r = 0; r < 16; ++r) CK[(32 * eb + crow(r, hi)) * 128 + d] = (bf16_t)(cvtpk(acc[eb][r], 0.f) & 0xffffu);
}

#ifndef PROBE_COMP
#define PROBE_COMP 0
#endif
__device__ __forceinline__ void ret_out_unit(const bf16_t* __restrict__ Qc, const bf16_t* __restrict__ Kc, const bf16_t* __restrict__ Vc, const bf16_t* __restrict__ Gc,
                                             const bf16_t* __restrict__ STf, const bf16_t* __restrict__ STb, const float* __restrict__ gnw, const float* __restrict__ gnb,
                                             bf16_t* __restrict__ Oc, float lgf, float lgb, char* lds, int ldsaddr, float* dump = nullptr) {
  const int tid = threadIdx.x, ht = tid & 255, wq = (tid >> 6) & 3, lane = tid & 63, r32 = lane & 31, hi = lane >> 5;
  __syncthreads();
  { const int sr = ht >> 4, sc = (ht & 15) * 8;
#pragma unroll
    for (int i = 0; i < 8; ++i) { const int row = sr + 16 * i, tile = row >> 6, key = row & 63;
      *(bf16x8*)(lds + tile * 16384 + KSWZ128(key, sc * 2)) = *reinterpret_cast<const bf16x8*>(Kc + (long)row * 1024 + sc);
      *(bf16x8*)(lds + 32768 + tile * 16384 + v_st(key, sc)) = *reinterpret_cast<const bf16x8*>(Vc + (long)row * 1024 + sc); } }
  const int c = 32 * wq + r32;
  bf16x8 qr[8];
#pragma unroll
  for (int d0 = 0; d0 < 8; ++d0) qr[d0] = *reinterpret_cast<const bf16x8*>(Qc + (long)c * 1024 + d0 * 16 + hi * 8);
  __syncthreads();
  f32x16 pA0, pA1, pB0, pB1;
  qkt128(pA0, pA1, lds, qr, r32, hi); qkt128(pB0, pB1, lds + 16384, qr, r32, hi);
  int cdec = c; asm volatile("" : "+v"(cdec));
#define DEC(P, JB) do { _Pragma("unroll") for (int r = 0; r < 16; ++r) { const int dl = cdec - ((JB) + crow(r, hi)); \
    P[r] *= __builtin_amdgcn_exp2f(dl >= 0 ? lgf * (float)dl : lgb * (float)(-dl)); } } while (0)
  DEC(pA0, 0); DEC(pA1, 32); DEC(pB0, 64); DEC(pB1, 96);
#undef DEC
  bf16x8 xa0, xa1, xa2, xa3, xb0, xb1, xb2, xb3;
  PK4(pA0, 0, xa0); PK4(pA0, 8, xa1); PK4(pA1, 0, xa2); PK4(pA1, 8, xa3);
  PK4(pB0, 0, xb0); PK4(pB0, 8, xb1); PK4(pB1, 0, xb2); PK4(pB1, 8, xb3);
  f32x16 o[4] = {};
  const int vb = ldsaddr + 32768 + v_rd_base(lane);
  if (PROBE_COMP == 0 || (PROBE_COMP & 1)) {
  pvT_one<0>(o[0], vb, xa0, xa1, xa2, xa3); pvT_one<1>(o[1], vb, xa0, xa1, xa2, xa3); pvT_one<2>(o[2], vb, xa0, xa1, xa2, xa3); pvT_one<3>(o[3], vb, xa0, xa1, xa2, xa3);
  pvT_one<0>(o[0], vb + 16384, xb0, xb1, xb2, xb3); pvT_one<1>(o[1], vb + 16384, xb0, xb1, xb2, xb3); pvT_one<2>(o[2], vb + 16384, xb0, xb1, xb2, xb3); pvT_one<3>(o[3], vb + 16384, xb0, xb1, xb2, xb3);
  }
#pragma unroll
  for (int dir = 0; dir < 2; ++dir) {
    if (PROBE_COMP != 0 && !((PROBE_COMP >> (1 + dir)) & 1)) continue;
    const float xi = __builtin_amdgcn_exp2f(dir == 0 ? lgf * (float)(c + 1) : lgb * (float)(128 - c));
    const bf16_t* ST = dir == 0 ? STf : STb;
    bf16x8 qs[8];
#pragma unroll
    for (int d0 = 0; d0 < 8; ++d0) qs[d0] = scale8(qr[d0], xi);
    const GAS char* stb = uniform_ptr(ST); const unsigned so = (unsigned)(r32 * 128 + hi * 8) * 2u;
#pragma unroll
    for (int eb = 0; eb < 4; ++eb) {
      bf16x8 A[8];
      SBAR();
#pragma unroll
      for (int d0 = 0; d0 < 8; ++d0) A[d0] = *(const GAS bf16x8*)(stb + so + (eb * 32 * 128 + d0 * 16) * 2);
#pragma unroll
      for (int d0 = 0; d0 < 8; ++d0) o[eb] = __builtin_amdgcn_mfma_f32_32x32x16_bf16(A[d0], qs[d0], o[eb], 0, 0, 0);
      SBAR();
    }
  }
  if (PROBE_COMP != 0) {
#pragma unroll
    for (int eb = 0; eb < 4; ++eb)
#pragma unroll
      for (int g = 0; g < 4; ++g) *(f32x4*)(dump + (long)c * 1024 + 32 * eb + 8 * g + 4 * hi) = (f32x4){o[eb][4 * g], o[eb][4 * g + 1], o[eb][4 * g + 2], o[eb][4 * g + 3]};
    return; }
  float s = 0.f;
#pragma unroll
  for (int eb = 0; eb < 4; ++eb)
#pragma unroll
    for (int r = 0; r < 16; ++r) s += o[eb][r];
  const float mu = swap_sum(s) * (1.f / 128.f);
  float q = 0.f;
#pragma unroll
  for (int eb = 0; eb < 4; ++eb)
#pragma unroll
    for (int r = 0; r < 16; ++r) { const float d = o[eb][r] - mu; q += d * d; }
  const float rstd = rsqrtf(swap_sum(q) * (1.f / 128.f) + 1e-6f);
#pragma unroll
  for (int eb = 0; eb < 4; ++eb)
#pragma unroll
    for (int g = 0; g < 4; ++g) { const int e0 = 32 * eb + 8 * g + 4 * hi;
      const f32x4 w4 = *(const f32x4*)(gnw + e0), b4 = *(const f32x4*)(gnb + e0);
      const u32x2 gg = *(const u32x2*)(Gc + (long)c * 1024 + e0);
      const float g0 = __uint_as_float(gg.x << 16), g1 = __uint_as_float(gg.x & 0xffff0000u), g2 = __uint_as_float(gg.y << 16), g3 = __uint_as_float(gg.y & 0xffff0000u);
      const float y0 = ((o[eb][4 * g] - mu) * rstd * w4[0] + b4[0]) * g0, y1 = ((o[eb][4 * g + 1] - mu) * rstd * w4[1] + b4[1]) * g1;
      const float y2 = ((o[eb][4 * g + 2] - mu) * rstd * w4[2] + b4[2]) * g2, y3 = ((o[eb][4 * g + 3] - mu) * rstd * w4[3] + b4[3]) * g3;
      u32x2 w; w.x = cvtpk(y0, y1); w.y = cvtpk(y2, y3);
      *(u32x2*)(Oc + (long)c * 2048 + e0) = w; }
}

__device__ __forceinline__ void ret_brute_unit(const bf16_t* __restrict__ Qh, const bf16_t* __restrict__ Kh, const bf16_t* __restrict__ Vh, const bf16_t* __restrict__ Gc,
                                               const float* __restrict__ gnw, const float* __restrict__ gnb, bf16_t* __restrict__ Oc, int t0, float lgf, float lgb, char* lds, const float* dump = nullptr) {
  const int tid = threadIdx.x, qi = tid >> 2, part = tid & 3, t = t0 + qi;
  float q[32], acc[32];
#pragma unroll
  for (int i = 0; i < 32; ++i) { q[i] = __uint_as_float((unsigned)Qh[(long)t * 1024 + part * 32 + i] << 16); acc[i] = 0.f; }
  for (int s0 = 0; s0 < 4096; s0 += 64) {
    { const int rel = s0 < t0 ? 1 : (s0 >= t0 + 128 ? 2 : 0); if (PROBE_COMP != 0 && ((PROBE_COMP >> rel) & 1)) continue; }
    __syncthreads();
    for (int c = tid; c < 64 * 16; c += 512) { const int r = c >> 4, c8 = (c & 15) * 8;
      *(bf16x8*)(lds + (r * 128 + c8) * 2) = *reinterpret_cast<const bf16x8*>(Kh + (long)(s0 + r) * 1024 + c8);
      *(bf16x8*)(lds + 16384 + (r * 128 + c8) * 2) = *reinterpret_cast<const bf16x8*>(Vh + (long)(s0 + r) * 1024 + c8); }
    __syncthreads();
    for (int j = 0; j < 64; ++j) { const int s = s0 + j; float d = 0.f;
      const unsigned short* kr = (const unsigned short*)(lds + (j * 128 + part * 32) * 2); const unsigned short* vr = (const unsigned short*)(lds + 16384 + (j * 128 + part * 32) * 2);
#pragma unroll
      for (int i = 0; i < 32; ++i) d += q[i] * __uint_as_float((unsigned)kr[i] << 16);
      d += __shfl_xor(d, 1); d += __shfl_xor(d, 2);
      const int dl = t - s; const float w = d * __builtin_amdgcn_exp2f(dl >= 0 ? lgf * (float)dl : lgb * (float)(-dl));
#pragma unroll
      for (int i = 0; i < 32; ++i) acc[i] += w * __uint_as_float((unsigned)vr[i] << 16); }
  }
  if (PROBE_COMP != 0) {
#pragma unroll
    for (int i = 0; i < 32; ++i) acc[i] += dump[(long)qi * 1024 + part * 32 + i]; }
  float sm = 0.f;
#pragma unroll
  for (int i = 0; i < 32; ++i) sm += acc[i];
  sm += __shfl_xor(sm, 1); sm += __shfl_xor(sm, 2); const float mu = sm * (1.f / 128.f);
  float qq = 0.f;
#pragma unroll
  for (int i = 0; i < 32; ++i) { const float dd = acc[i] - mu; qq += dd * dd; }
  qq += __shfl_xor(qq, 1); qq += __shfl_xor(qq, 2); const float rstd = rsqrtf(qq * (1.f / 128.f) + 1e-6f);
#pragma unroll
  for (int i = 0; i < 32; ++i) { const int e = part * 32 + i; const float g = __uint_as_float((unsigned)Gc[(long)qi * 1024 + e] << 16);
    Oc[(long)qi * 2048 + e] = (bf16_t)(cvtpk(((acc[i] - mu) * rstd * gnw[e] + gnb[e]) * g, 0.f) & 0xffffu); }
}
#undef SBAR
}


#ifndef PROBE_BRUTE_RET
#define PROBE_BRUTE_RET 0
#endif
#ifndef MK_SPLIT
#define MK_SPLIT 0
#endif
#define LAS __attribute__((address_space(3)))
#define GASX __attribute__((address_space(1)))
typedef unsigned short bf16_t;
typedef unsigned v4u __attribute__((ext_vector_type(4)));
typedef unsigned v2u __attribute__((ext_vector_type(2)));
typedef float f32x4 __attribute__((ext_vector_type(4)));
typedef short bf16x8 __attribute__((ext_vector_type(8)));

constexpr int BATCH = 8, SEQ = 4096, DM = 2048, T = BATCH * SEQ;
constexpr int INC = 5184, INCP = 5376, DFF = 5632, NMODC = 6 * DM;
constexpr int NPH = 11;
constexpr size_t MiB = 1u << 20;
constexpr size_t WS_CTL = 0, CTL_ZERO_BYTES = 2 * MiB;
constexpr size_t OFF_MOD = 0, OFF_SSQQ = 512 * 1024, OFF_SSQKV = 640 * 1024;
constexpr size_t WS_COSR = 2 * MiB, WS_SINR = 10 * MiB, WS_COSM = 18 * MiB, WS_SINM = 22 * MiB;
constexpr size_t WS_WIN = 26 * MiB, WS_WUQ = 47 * MiB, WS_WUKV = 49 * MiB, WS_WO = 51 * MiB, WS_WGU = 59 * MiB, WS_WDN = 103 * MiB;
constexpr size_t WS_H = 128 * MiB;
constexpr size_t WS_QR = 256 * MiB, WS_KR = 320 * MiB, WS_VR = 384 * MiB, WS_GR = 448 * MiB;
constexpr size_t WS_CQ = 512 * MiB, WS_CKV = 544 * MiB;
constexpr size_t WS_QM = 576 * MiB, WS_KB = 672 * MiB, WS_VM = 768 * MiB, WS_OAT = 832 * MiB, WS_END = 896 * MiB;
constexpr size_t WS_CAT = 576 * MiB;
constexpr size_t WS_AFF = 256 * MiB;
static_assert(WS_AFF + (size_t)T * DFF * 2 <= WS_END && WS_CAT + (size_t)T * 2048 * 2 <= WS_VM, "d_ws map");
constexpr int LDS_BAR_OFF = 150528;
constexpr size_t OFF_XBAR = 1536 * 1024;
constexpr int LDS_BYTES = 150528 + 64;

#define LDS_WAIT() asm volatile("s_waitcnt lgkmcnt(0)" ::: "memory")
__device__ __forceinline__ unsigned f2bf(float f) { unsigned u = __builtin_bit_cast(unsigned, f); return (u + 0x7fffu + ((u >> 16) & 1u)) >> 16; }
__device__ __forceinline__ unsigned pk2(float lo, float hi) { return f2bf(lo) | (f2bf(hi) << 16); }
__device__ __forceinline__ unsigned pk2a(float lo, float hi) { return pg8::coarse2(pk2(lo, hi)); }
__device__ __forceinline__ float wave_sum(float v) {
#pragma unroll
    for (int o = 1; o < 64; o <<= 1) v += __shfl_xor(v, o);
    return v;
}
__device__ __forceinline__ int dest_row(int mapid, int n) {
    switch (mapid) {
    case 1: if (n < 2048) { const int j = n & 127; return (n & ~127) + (j < 64 ? 2 * j : 2 * (j - 64) + 1); }
            if (n < 5120) return n;
            { const int j = n - 5120; return 5120 + (j < 32 ? 2 * j : 2 * (j - 32) + 1); }
    case 2: { const int d = n % 192; if (d < 128) return n; const int j = d - 128; return n - d + 128 + (j < 32 ? 2 * j : 2 * (j - 32) + 1); }
    case 3: return (n >> 7) * 256 + (n & 127);
    case 4: return (n >> 7) * 256 + 128 + (n & 127);
    default: return n;
    }
}
__device__ __forceinline__ void transpose_item(const float* __restrict__ W, int K, int N, bf16_t* __restrict__ WT, const float* __restrict__ kscale, int mapid, LAS float* scr, int item, int lane) {
    const int nblk = N / 32, kb = item / nblk, nb = item % nblk, k0 = 64 * kb, n0 = 32 * nb;
#pragma unroll 8
    for (int i = 0; i < 32; ++i) { const int kk = 2 * i + (lane >> 5); float v = W[(size_t)(k0 + kk) * N + n0 + (lane & 31)]; if (kscale) v *= kscale[k0 + kk]; scr[kk * 33 + (lane & 31)] = v; }
    LDS_WAIT(); asm volatile("" ::: "memory");
    const int c = lane & 7;
#pragma unroll
    for (int j = 0; j < 4; ++j) { const int n = (lane >> 3) + 8 * j; const LAS float* s = scr + (8 * c) * 33 + n;
        v4u o; o.x = pk2(s[0 * 33], s[1 * 33]); o.y = pk2(s[2 * 33], s[3 * 33]); o.z = pk2(s[4 * 33], s[5 * 33]); o.w = pk2(s[6 * 33], s[7 * 33]);
        *(v4u*)(WT + (size_t)dest_row(mapid, n0 + n) * K + k0 + 8 * c) = o; }
    LDS_WAIT(); asm volatile("" ::: "memory");
}
__device__ __forceinline__ void norm_row(const float* xrow, const float* __restrict__ w, const float* __restrict__ shift, const float* __restrict__ scale, bf16_t* ob, float* of, int lane) {
    const f32x4* xr = (const f32x4*)xrow + lane;
    f32x4 v[8]; float s = 0.f;
#pragma unroll
    for (int j = 0; j < 8; ++j) { v[j] = xr[64 * j]; s += (v[j].x * v[j].x + v[j].y * v[j].y) + (v[j].z * v[j].z + v[j].w * v[j].w); }
    const float rstd = rsqrtf(wave_sum(s) * (1.f / 2048.f) + 1e-6f);
#pragma unroll
    for (int j = 0; j < 8; ++j) { const int col = 4 * lane + 256 * j; f32x4 y = v[j] * rstd * *(const f32x4*)(w + col);
        if (shift) y = y * (*(const f32x4*)(scale + col) + 1.f) + *(const f32x4*)(shift + col);
        if (ob) { v2u o; o.x = pk2a(y.x, y.y); o.y = pk2a(y.z, y.w); *(v2u*)(ob + col) = o; } else *(f32x4*)(of + col) = y; }
}
__device__ __forceinline__ void norm_row2(const float* xa, const float* __restrict__ w, const float* __restrict__ shifta, const float* __restrict__ scalea, bf16_t* oba, float* ofa, int lane) {
    const float* shiftb = shifta; const float* scaleb = scalea; bf16_t* obb = oba + 2048; float* ofb = ofa + 2048;
    const f32x4* ra = (const f32x4*)xa + lane; const f32x4* rb = ra + 512;
    f32x4 va[8], vb[8]; float sa = 0.f, sb = 0.f;
#pragma unroll
    for (int j = 0; j < 8; ++j) va[j] = ra[64 * j];
#pragma unroll
    for (int j = 0; j < 8; ++j) vb[j] = rb[64 * j];
#pragma unroll
    for (int j = 0; j < 8; ++j) { sa += (va[j].x * va[j].x + va[j].y * va[j].y) + (va[j].z * va[j].z + va[j].w * va[j].w); sb += (vb[j].x * vb[j].x + vb[j].y * vb[j].y) + (vb[j].z * vb[j].z + vb[j].w * vb[j].w); }
    const float rsa = rsqrtf(wave_sum(sa) * (1.f / 2048.f) + 1e-6f), rsb = rsqrtf(wave_sum(sb) * (1.f / 2048.f) + 1e-6f);
#pragma unroll
    for (int j = 0; j < 8; ++j) { const int col = 4 * lane + 256 * j; const f32x4 wv = *(const f32x4*)(w + col); f32x4 ya = va[j] * rsa * wv, yb = vb[j] * rsb * wv;
        if (shifta) { ya = ya * (*(const f32x4*)(scalea + col) + 1.f) + *(const f32x4*)(shifta + col); yb = yb * (*(const f32x4*)(scaleb + col) + 1.f) + *(const f32x4*)(shiftb + col); }
        if (oba) { v2u o; o.x = pk2a(ya.x, ya.y); o.y = pk2a(ya.z, ya.w); *(v2u*)(oba + col) = o; o.x = pk2a(yb.x, yb.y); o.y = pk2a(yb.z, yb.w); *(v2u*)(obb + col) = o; }
        else { *(f32x4*)(ofa + col) = ya; *(f32x4*)(ofb + col) = yb; } }
}

#define XB_TMO      128
#define XB_XCNT(j)  (256  + 64 * (j))
#define XB_XSUB(j)  (1280 + 64 * (j))
#define XB_XGEN(j)  (2304 + 64 * (j))
#define XB_TOP      3328
#define XB_TOPGEN   3392
#define XCD_BAR_WORDS 3456
#define XB_SPIN_CAP (1u << 18)

__device__ __forceinline__ unsigned xb_ld(unsigned* p)              { return __hip_atomic_load(p, __ATOMIC_RELAXED, __HIP_MEMORY_SCOPE_AGENT); }
__device__ __forceinline__ unsigned xb_add(unsigned* p, unsigned v) { return __hip_atomic_fetch_add(p, v, __ATOMIC_RELAXED, __HIP_MEMORY_SCOPE_AGENT); }
__device__ __forceinline__ unsigned xb_xcc_id() { return (unsigned)__builtin_amdgcn_s_getreg((3 << 11) | 20) & 0xFu; }
#define XB_SPIN(cond, bar) do { unsigned _sp = 0; while (cond) { __builtin_amdgcn_s_sleep(1); \
    if ((++_sp & 255u) == 0u) { if (xb_ld(&(bar)[XB_TMO])) break; if (_sp > XB_SPIN_CAP) { atomicAdd(&(bar)[XB_TMO], 1u); break; } } } } while (0)

struct XcdBarrier {
    unsigned* bar; unsigned x;
    volatile LAS unsigned* st;
};

__device__ __forceinline__ XcdBarrier xcd_barrier_post(unsigned* bar, volatile LAS unsigned* st) {
    XcdBarrier b; b.bar = bar; b.x = xb_xcc_id(); b.st = st;
    if (threadIdx.x == 0) (void)xb_add(&bar[XB_XCNT(b.x)], 1u);
    return b;
}
__device__ __forceinline__ void xcd_barrier_complete(unsigned* bar, unsigned x, unsigned& nloc, unsigned& nx) {
    const unsigned G = gridDim.x * gridDim.y * gridDim.z;
    unsigned sum, cnt, mine, sp = 0u;
    for (;;) {
        sum = 0u; cnt = 0u; mine = 0u;
#pragma unroll
        for (unsigned j = 0; j < 16; ++j) { const unsigned c = xb_ld(&bar[XB_XCNT(j)]); sum += c; cnt += (c > 0u) ? 1u : 0u; mine = (j == x) ? c : mine; }
        if (sum == G) break;
        __builtin_amdgcn_s_sleep(1);
        if ((++sp & 255u) == 0u) { if (xb_ld(&bar[XB_TMO])) break; if (sp > XB_SPIN_CAP) { atomicAdd(&bar[XB_TMO], 1u); break; } }
    }
    nloc = mine > 0u ? mine : 1u; nx = cnt > 0u ? cnt : 1u;
}

__device__ __forceinline__ void xcd_barrier(const XcdBarrier& b) {
    asm volatile("s_waitcnt vmcnt(0)" ::: "memory");
    __syncthreads();
    if (threadIdx.x == 0) {
        unsigned* bar = b.bar;
        __builtin_amdgcn_s_waitcnt(0);
        unsigned nloc = b.st[0], nx = b.st[1];
        if (nloc == 0u) { xcd_barrier_complete(bar, b.x, nloc, nx); b.st[0] = nloc; b.st[1] = nx; }
        const unsigned old = xb_add(&bar[XB_XSUB(b.x)], 1u);
        const unsigned gen = old / nloc;
        if (old + 1u == (gen + 1u) * nloc) {
            __builtin_amdgcn_fence(__ATOMIC_RELEASE, "agent");
            asm volatile("s_waitcnt vmcnt(0)" ::: "memory");
            const unsigned og = xb_add(&bar[XB_TOP], 1u);
            const unsigned tg = og / nx;
            if (og + 1u == (tg + 1u) * nx) xb_add(&bar[XB_TOPGEN], 1u);
            else XB_SPIN(xb_ld(&bar[XB_TOPGEN]) == tg, bar);
            __builtin_amdgcn_fence(__ATOMIC_ACQUIRE, "agent");
            xb_add(&bar[XB_XGEN(b.x)], 1u);
            asm volatile("s_waitcnt vmcnt(0)" ::: "memory");
        } else {
            XB_SPIN(xb_ld(&bar[XB_XGEN(b.x)]) == gen, bar);
            __builtin_amdgcn_fence(__ATOMIC_ACQUIRE, "agent");
            asm volatile("s_waitcnt vmcnt(0)" ::: "memory");
        }
    }
    __syncthreads();
}

struct Args { const float* in[21]; float* out; unsigned char* ws; float inv_r[64]; float inv_m[32]; int ph_lo, ph_hi; };
static_assert(sizeof(Args) == 21 * 8 + 16 + 96 * 4 + 8, "Args has no padding");

__global__ void __launch_bounds__(512, 2) mk_fwd(Args a) {
    extern __shared__ __attribute__((aligned(16))) unsigned char smem[];
    cg::grid_group grid = cg::this_grid();
    const int tid = threadIdx.x, lane = tid & 63, wave = __builtin_amdgcn_readfirstlane(tid >> 6);
    const int G = gridDim.x, bx = blockIdx.x, vcu = (G % 8 == 0) ? (bx % 8) * (G / 8) + bx / 8 : bx;
    const int gw = vcu * 8 + wave, NGW = G * 8;
    LAS unsigned char* lds3 = (LAS unsigned char*)smem; char* ldsg = (char*)smem; const int ldsaddr = (int)(unsigned)(uintptr_t)lds3;
    float* out = a.out;
#define WSB() size_t wz_ = 0; asm volatile("" : "+s"(wz_)); unsigned char* ws = a.ws + wz_
#define INP(name, k) const float* name = a.in[k] + wz_
#define WSF(name, off) float* name = (float*)(ws + (off))
#define WSH(name, off) bf16_t* name = (bf16_t*)(ws + (off))
    const int lo = a.ph_lo, hi = a.ph_hi;
    if (tid < 16) ((LAS unsigned*)(lds3 + LDS_BAR_OFF))[tid] = 0u;
    __syncthreads();
    XcdBarrier xbar = xcd_barrier_post((unsigned*)(a.ws + WS_CTL + OFF_XBAR), (volatile LAS unsigned*)(lds3 + LDS_BAR_OFF));
#ifndef PH_MASK
#define PH_MASK 0x7ff
#endif
#define IN(k) (((PH_MASK >> (k)) & 1) && lo <= (k) && (k) < hi)
#define SEAM(k) do { if (IN(k) && IN((k) + 1)) { asm volatile("s_waitcnt vmcnt(0) lgkmcnt(0)" ::: "memory"); grid.sync(); \
    __builtin_amdgcn_fence(__ATOMIC_ACQUIRE, "agent"); asm volatile("s_waitcnt vmcnt(0)" ::: "memory"); } } while (0)
#define SEAMX(k) do { if (IN(k) && IN((k) + 1)) xcd_barrier(xbar); } while (0)

    if (IN(0)) {
        WSB(); WSF(mod, WS_CTL + OFF_MOD); WSF(cosr, WS_COSR); WSF(sinr, WS_SINR); WSF(cosm, WS_COSM); WSF(sinm, WS_SINM);
        WSH(Win, WS_WIN); WSH(Wuq, WS_WUQ); WSH(Wukv, WS_WUKV); WSH(Wo, WS_WO); WSH(Wgu, WS_WGU); WSH(Wdn, WS_WDN);
        INP(cin, 1); INP(ada_w, 3); INP(ada_b, 4); INP(w_in, 6); INP(mla_q_norm_w, 10); INP(w_uq, 11); INP(mla_kv_norm_w, 12); INP(w_ukv, 13); INP(w_o, 15); INP(w_gate, 17); INP(w_up, 18); INP(w_down, 19);
        const int* positions = (const int*)a.in[2] + wz_;
        {
            LAS float* cs = (LAS float*)lds3;
            for (int i = tid; i < 8 * 2048; i += 512) { const int b = i >> 11, k = i & 2047; const float v = cin[i]; cs[k * 8 + b] = v / (1.f + __expf(-v)); }
            __syncthreads();
            for (int task = gw; task < 192 * 16; task += NGW) { const int cb = task % 192, ks = task / 192, col = cb * 64 + lane;
                float acc[8]; const float bias = ks == 0 ? ada_b[col] : 0.f;
#pragma unroll
                for (int b = 0; b < 8; ++b) acc[b] = bias;
                const float* wp = ada_w + (size_t)(ks * 128) * NMODC + col;
                for (int k8 = 0; k8 < 128; k8 += 8) { float wv[8];
#pragma unroll
                    for (int i = 0; i < 8; ++i) wv[i] = wp[(size_t)(k8 + i) * NMODC];
#pragma unroll
                    for (int i = 0; i < 8; ++i) { const LAS f32x4* c4 = (const LAS f32x4*)(cs + (ks * 128 + k8 + i) * 8); const f32x4 c0 = c4[0], c1 = c4[1];
                        acc[0] += c0.x * wv[i]; acc[1] += c0.y * wv[i]; acc[2] += c0.z * wv[i]; acc[3] += c0.w * wv[i]; acc[4] += c1.x * wv[i]; acc[5] += c1.y * wv[i]; acc[6] += c1.z * wv[i]; acc[7] += c1.w * wv[i]; } }
#pragma unroll
                for (int b = 0; b < 8; ++b) atomicAdd(mod + (size_t)b * NMODC + col, acc[b]); }
            __syncthreads();
        }
        {
            LAS float* scr = (LAS float*)(lds3 + wave * 16384);
            constexpr int I_IN = 32 * (INC / 32), I_UQ = 8 * 48, I_UKV = 8 * 64, I_O = 32 * 64, I_G = 32 * (DFF / 32), I_D = (DFF / 64) * 64;
            constexpr int NITEMS = I_IN + I_UQ + I_UKV + I_O;
            for (int it = gw; it < NITEMS; it += NGW) { int r = it;
                if (r < I_IN) { transpose_item(w_in, 2048, INC, Win, nullptr, 1, scr, r, lane); continue; } r -= I_IN;
                if (r < I_UQ) { transpose_item(w_uq, 512, 1536, Wuq, mla_q_norm_w, 2, scr, r, lane); continue; } r -= I_UQ;
                if (r < I_UKV) { transpose_item(w_ukv, 512, 2048, Wukv, mla_kv_norm_w, 0, scr, r, lane); continue; } r -= I_UKV;
                if (r < I_O) { transpose_item(w_o, 2048, 2048, Wo, nullptr, 0, scr, r, lane); continue; } r -= I_O;
                (void)I_D; }
            for (int i = bx * 512 + tid; i < (INCP - INC) * 2048 / 8; i += G * 512) *(v4u*)(Win + (size_t)INC * 2048 + (size_t)i * 8) = (v4u){0u, 0u, 0u, 0u};
        }
        {
            for (int i = bx * 512 + tid; i < T * 96; i += G * 512) { const int t = i / 96, j = i % 96; const float pos = (float)positions[t];
                const float inv = j < 64 ? a.inv_r[j] : a.inv_m[j - 64]; const float ang = pos * inv;
                double rev = (double)ang * 0.15915494309189535; rev -= __builtin_rint(rev);
                const double qd = __builtin_rint(rev * 4.0); const double y = (rev - qd * 0.25) * 6.283185307179586; const double y2 = y * y;
                const double sy = y * (1.0 + y2 * (-1.0 / 6 + y2 * (1.0 / 120 + y2 * (-1.0 / 5040 + y2 * (1.0 / 362880 + y2 * (-1.0 / 39916800 + y2 * (1.0 / 6227020800.0)))))));
                const double cy = 1.0 + y2 * (-0.5 + y2 * (1.0 / 24 + y2 * (-1.0 / 720 + y2 * (1.0 / 40320 + y2 * (-1.0 / 3628800 + y2 * (1.0 / 479001600.0 + y2 * (-1.0 / 87178291200.0)))))));
                const int qi = (int)qd & 3;
                const float cv = (float)(qi == 0 ? cy : qi == 1 ? -sy : qi == 2 ? -cy : sy), sv = (float)(qi == 0 ? sy : qi == 1 ? cy : qi == 2 ? -sy : -cy);
                if (j < 64) { cosr[(size_t)t * 64 + j] = cv; sinr[(size_t)t * 64 + j] = sv; } else { cosm[(size_t)t * 32 + j - 64] = cv; sinm[(size_t)t * 32 + j - 64] = sv; } }
        }
    }
    SEAMX(0);
    if (a.ph_hi > 1000) { SEAM(0); }
    if (IN(1)) { WSB(); WSF(mod, WS_CTL + OFF_MOD); WSH(H, WS_H); INP(x, 0); INP(norm1_w, 5);
        for (int m = 2 * gw; m < T; m += 2 * NGW) { const int b = m >> 12;
            norm_row2(x + (size_t)m * DM, norm1_w, mod + (size_t)b * NMODC, mod + (size_t)b * NMODC + DM, H + (size_t)m * DM, nullptr, lane); } }
    SEAMX(1);
    if (IN(2)) {
        WSB(); WSH(H, WS_H); WSH(Win, WS_WIN); WSH(Qr, WS_QR); WSH(Kr, WS_KR); WSH(Vr, WS_VR); WSH(Gr, WS_GR); WSH(CQ, WS_CQ); WSH(CKV, WS_CKV); WSH(Kbuf, WS_KB);
        WSF(cosr, WS_COSR); WSF(sinr, WS_SINR); WSF(cosm, WS_COSM); WSF(sinm, WS_SINM); WSF(ssq_q, WS_CTL + OFF_SSQQ); WSF(ssq_kv, WS_CTL + OFF_SSQKV);
        pg8::Gemm g{H, Win, T, INCP, DM}; pg8::StaticOrder S; S.init(T, INCP, G, bx);
        pg8::EpiIn E{Qr, Kr, Vr, Gr, CQ, CKV, Kbuf, cosr, sinr, cosm, sinm, ssq_q, ssq_kv};
        pg8::gemm_phase<pg8::EpiIn, pg8::StaticOrder, true, true>(lds3, g, S, E);
        {
            constexpr int I_G = 32 * (DFF / 32); const int first = ((T / 256) * (INCP / 256)) % G, nsw = (G - first) * 8;
            if (bx >= first) { WSH(Wgu, WS_WGU); INP(w_gate, 17); INP(w_up, 18); LAS float* scr = (LAS float*)(lds3 + wave * 16384); const int wi = (bx - first) * 8 + wave;
                constexpr int I_D = (DFF / 64) * 64; WSH(Wdn, WS_WDN); INP(w_down, 19);
                for (int it = wi; it < 2 * I_G + I_D; it += nsw) { if (it < I_G) transpose_item(w_gate, 2048, DFF, Wgu, nullptr, 3, scr, it, lane); else if (it < 2 * I_G) transpose_item(w_up, 2048, DFF, Wgu, nullptr, 4, scr, it - I_G, lane); else transpose_item(w_down, DFF, 2048, Wdn, nullptr, 0, scr, it - 2 * I_G, lane); } }
        }
    }
    SEAMX(2);
    if (IN(3)) {
        WSB(); WSH(CQ, WS_CQ); WSH(CKV, WS_CKV); WSH(Wuq, WS_WUQ); WSH(Wukv, WS_WUKV); WSH(Qm, WS_QM); WSH(Kbuf, WS_KB); WSH(Vm, WS_VM); WSH(Kr, WS_KR); WSH(Vr, WS_VR); WSH(CK, WS_H);
        WSF(cosm, WS_COSM); WSF(sinm, WS_SINM); WSF(ssq_q, WS_CTL + OFF_SSQQ); WSF(ssq_kv, WS_CTL + OFF_SSQKV); INP(ret_decay, 7);
        { pg8::Gemm g{CQ, Wuq, T, 1536, 512}; pg8::StaticOrder S; S.init(T, 1536, G, bx); pg8::EpiUpQ E{ssq_q, Qm, cosm, sinm};
          pg8::gemm_phase<pg8::EpiUpQ, pg8::StaticOrder, true, true>(lds3, g, S, E); }
        { pg8::Gemm g{CKV, Wukv, T, 2048, 512}; pg8::StaticOrder S; S.init(T, 2048, G, bx); pg8::EpiUpKV E{ssq_kv, Kbuf, Vm};
          pg8::gemm_phase<pg8::EpiUpKV, pg8::StaticOrder, true, true>(lds3, g, S, E); }
        for (int u = vcu; u < 2048; u += G) { const int n = u & 31, h = (u >> 5) & 7, b = u >> 8; const size_t t0 = (size_t)b * SEQ + n * 128;
            const float lgf = -__expf(ret_decay[h]) * 1.4426950408889634f, lgb = -__expf(ret_decay[8 + h]) * 1.4426950408889634f;
            att::chunk_kv_unit(Kr + t0 * 1024 + h * 128, Vr + t0 * 1024 + h * 128, CK + ((size_t)(b * 8 + h) * 32 + n) * 16384, CK + ((size_t)(64 + b * 8 + h) * 32 + n) * 16384, lgf, lgb, ldsg, ldsaddr); }
        __syncthreads();
    }
    SEAMX(3);
    if (IN(4)) {
        WSB(); WSH(Qm, WS_QM); WSH(Kbuf, WS_KB); WSH(Vm, WS_VM); WSH(Oat, WS_OAT); WSH(CK, WS_H); INP(ret_decay, 7);
        for (int u = vcu; u < 1024; u += G) { const int qb = u & 15, h = (u >> 4) & 7, b = u >> 7; const size_t r0 = (size_t)b * SEQ;
            att::attn_unit(Qm + (r0 + qb * 256) * 1536 + h * 192, Kbuf + r0 * 1536 + h * 192, Vm + r0 * 1024 + h * 128, Oat + (r0 + qb * 256) * 1024 + h * 128, SEQ, ldsg, ldsaddr); }
#ifndef NO_SCAN
        for (int idx = bx * 512 + tid; idx < 2 * 64 * 2048; idx += G * 512) { const int dir = idx >> 17, bh = (idx >> 11) & 63, e8 = idx & 2047, h = bh & 7;
            const float cd = __builtin_amdgcn_exp2f(-__expf(ret_decay[dir * 8 + h]) * 1.4426950408889634f * 128.f);
            bf16_t* base = CK + ((size_t)(dir * 64 + bh) * 32) * 16384 + e8 * 8; float st[8];
#pragma unroll
            for (int i = 0; i < 8; ++i) st[i] = 0.f;
            for (int s8 = 0; s8 < 32; s8 += 8) { v4u kv[8];
#pragma unroll
                for (int i = 0; i < 8; ++i) { const int m = dir ? 31 - (s8 + i) : s8 + i; kv[i] = *(const v4u*)(base + (size_t)m * 16384); }
#pragma unroll
                for (int i = 0; i < 8; ++i) { const int m = dir ? 31 - (s8 + i) : s8 + i; v4u o;
                    o.x = pk2a(st[0], st[1]); o.y = pk2a(st[2], st[3]); o.z = pk2a(st[4], st[5]); o.w = pk2a(st[6], st[7]);
                    *(v4u*)(base + (size_t)m * 16384) = o;
#pragma unroll
                    for (int q = 0; q < 4; ++q) { const unsigned w = kv[i][q]; st[2 * q] = st[2 * q] * cd + __uint_as_float(w << 16); st[2 * q + 1] = st[2 * q + 1] * cd + __uint_as_float(w & 0xffff0000u); } } }
        }
#endif
    }
    SEAMX(4);
    if (IN(5)) {
        WSB(); WSH(Qr, WS_QR); WSH(Kr, WS_KR); WSH(Vr, WS_VR); WSH(Gr, WS_GR); WSH(CK, WS_H); WSH(Cat, WS_CAT); WSH(Oat, WS_OAT); INP(ret_decay, 7); INP(ret_gn_w, 8); INP(ret_gn_b, 9); INP(mla_out_w, 14);
#if PROBE_BRUTE_RET
        float* dumpb = (float*)(ws + 704 * MiB);
        for (int up = vcu; up < 1024; up += G) {
            if (PROBE_COMP != 0) { const int u = up * 2 + (wave >> 2); const int n = u & 31, h = (u >> 5) & 7, b = u >> 8; const size_t t0 = (size_t)b * SEQ + n * 128;
                const float lgf = -__expf(ret_decay[h]) * 1.4426950408889634f, lgb = -__expf(ret_decay[8 + h]) * 1.4426950408889634f; const int hf = wave >> 2;
                att::ret_out_unit(Qr + t0 * 1024 + h * 128, Kr + t0 * 1024 + h * 128, Vr + t0 * 1024 + h * 128, Gr + t0 * 1024 + h * 128,
                                  CK + ((size_t)(b * 8 + h) * 32 + n) * 16384, CK + ((size_t)(64 + b * 8 + h) * 32 + n) * 16384, ret_gn_w + h * 128, ret_gn_b + h * 128,
                                  Cat + t0 * 2048 + h * 128, lgf, lgb, ldsg + hf * 65536, ldsaddr + hf * 65536, dumpb + t0 * 1024 + h * 128);
                __threadfence(); __syncthreads(); }
            for (int k2 = 0; k2 < 2; ++k2) { const int u = up * 2 + k2; const int n = u & 31, h = (u >> 5) & 7, b = u >> 8; const size_t r0 = (size_t)b * SEQ, t0 = r0 + n * 128;
                const float lgf = -__expf(ret_decay[h]) * 1.4426950408889634f, lgb = -__expf(ret_decay[8 + h]) * 1.4426950408889634f;
                att::ret_brute_unit(Qr + r0 * 1024 + h * 128, Kr + r0 * 1024 + h * 128, Vr + r0 * 1024 + h * 128, Gr + t0 * 1024 + h * 128, ret_gn_w + h * 128, ret_gn_b + h * 128, Cat + t0 * 2048 + h * 128, n * 128, lgf, lgb, ldsg, dumpb + t0 * 1024 + h * 128); } }
        __syncthreads();
        for (int up = vcu; up < 0; up += G) { const int u = up * 2 + (wave >> 2);
#else
        for (int up = vcu; up < 1024; up += G) { const int u = up * 2 + (wave >> 2);
#endif
            const int n = u & 31, h = (u >> 5) & 7, b = u >> 8; const size_t t0 = (size_t)b * SEQ + n * 128;
            const float lgf = -__expf(ret_decay[h]) * 1.4426950408889634f, lgb = -__expf(ret_decay[8 + h]) * 1.4426950408889634f; const int hf = wave >> 2;
            att::ret_out_unit(Qr + t0 * 1024 + h * 128, Kr + t0 * 1024 + h * 128, Vr + t0 * 1024 + h * 128, Gr + t0 * 1024 + h * 128,
                              CK + ((size_t)(b * 8 + h) * 32 + n) * 16384, CK + ((size_t)(64 + b * 8 + h) * 32 + n) * 16384, ret_gn_w + h * 128, ret_gn_b + h * 128,
                              Cat + t0 * 2048 + h * 128, lgf, lgb, ldsg + hf * 65536, ldsaddr + hf * 65536); }
        for (int m = gw; m < T; m += NGW) {
            const bf16_t* orow = Oat + (size_t)m * 1024; float v[16]; float s = 0.f;
#pragma unroll
            for (int j = 0; j < 2; ++j) { const v4u w = *(const v4u*)(orow + lane * 8 + 512 * j);
#pragma unroll
                for (int q = 0; q < 4; ++q) { v[j * 8 + 2 * q] = __uint_as_float(w[q] << 16); v[j * 8 + 2 * q + 1] = __uint_as_float(w[q] & 0xffff0000u); } }
#pragma unroll
            for (int i = 0; i < 16; ++i) s += v[i] * v[i];
            const float rstd = rsqrtf(wave_sum(s) * (1.f / 1024.f) + 1e-6f);
#pragma unroll
            for (int j = 0; j < 2; ++j) { const int col = lane * 8 + 512 * j; const f32x4 w0 = *(const f32x4*)(mla_out_w + col), w1 = *(const f32x4*)(mla_out_w + col + 4); v4u o;
                o.x = pk2a(v[j * 8 + 0] * rstd * w0.x, v[j * 8 + 1] * rstd * w0.y); o.y = pk2a(v[j * 8 + 2] * rstd * w0.z, v[j * 8 + 3] * rstd * w0.w);
                o.z = pk2a(v[j * 8 + 4] * rstd * w1.x, v[j * 8 + 5] * rstd * w1.y); o.w = pk2a(v[j * 8 + 6] * rstd * w1.z, v[j * 8 + 7] * rstd * w1.w);
                *(v4u*)(Cat + (size_t)m * 2048 + 1024 + col) = o; } }
        __syncthreads();
    }
    SEAMX(5);
    if (IN(6)) {
        WSB(); WSH(Cat, WS_CAT); WSH(Wo, WS_WO); WSF(mod, WS_CTL + OFF_MOD); INP(x, 0);
        pg8::Gemm g{Cat, Wo, T, 2048, 2048}; pg8::StaticOrder S; S.init(T, 2048, G, bx); pg8::EpiGateRes E{x, mod + 2 * DM, out};
        pg8::gemm_phase<pg8::EpiGateRes, pg8::StaticOrder, true, true>(lds3, g, S, E);
    }
    SEAMX(6);
    if (IN(7)) { WSB(); WSF(mod, WS_CTL + OFF_MOD); WSH(H, WS_H); INP(norm2_w, 16);
        for (int m = 2 * gw; m < T; m += 2 * NGW) { const int b = m >> 12;
            norm_row2(out + (size_t)m * DM, norm2_w, mod + (size_t)b * NMODC + 3 * DM, mod + (size_t)b * NMODC + 4 * DM, H + (size_t)m * DM, nullptr, lane); } }
    SEAMX(7);
    if (IN(8)) {
        WSB(); WSH(H, WS_H); WSH(Wgu, WS_WGU); WSH(Aff, WS_AFF);
        pg8::Gemm g{H, Wgu, T, 2 * DFF, DM}; pg8::StaticOrder S; S.init(T, 2 * DFF, G, bx); pg8::EpiGU E{Aff};
        pg8::gemm_phase<pg8::EpiGU, pg8::StaticOrder, true, true>(lds3, g, S, E);
    }
    SEAMX(8);
    if (IN(9)) {
        WSB(); WSH(Aff, WS_AFF); WSH(Wdn, WS_WDN); WSF(mod, WS_CTL + OFF_MOD);
        pg8::Gemm g{Aff, Wdn, T, 2048, DFF}; pg8::StaticOrder S; S.init(T, 2048, G, bx); pg8::EpiGateRes E{out, mod + 5 * DM, out};
        pg8::gemm_phase<pg8::EpiGateRes, pg8::StaticOrder, true, true>(lds3, g, S, E);
    }
    SEAMX(9);
    if (IN(10)) { WSB(); (void)ws; INP(final_norm_w, 20);
        for (int m = 2 * gw; m < T; m += 2 * NGW) norm_row2(out + (size_t)m * DM, final_norm_w, nullptr, nullptr, nullptr, out + (size_t)m * DM, lane); }
#undef IN
#undef SEAM
}

extern "C" void kernel_launch(void* const* d_in, const int* in_sizes, int n_in, void* d_out, int out_size, void* d_ws, size_t ws_size, hipStream_t stream) {
    static int grid = 0;
    if (grid == 0) {
        if (n_in != 21 || in_sizes[0] != T * DM || out_size != T * DM || ws_size < WS_END) { fprintf(stderr, "kernel_launch: shape/workspace mismatch (n_in %d, ws %zu < %zu)\n", n_in, ws_size, (size_t)WS_END); grid = -1; return; }
        int dev = 0, cus = 0, per_cu = 0;
        (void)hipGetDevice(&dev); (void)hipDeviceGetAttribute(&cus, hipDeviceAttributeMultiprocessorCount, dev);
        if (hipFuncSetAttribute((const void*)mk_fwd, hipFuncAttributeMaxDynamicSharedMemorySize, LDS_BYTES) != hipSuccess) { fprintf(stderr, "kernel_launch: hipFuncSetAttribute failed\n"); grid = -1; return; }
        if (hipOccupancyMaxActiveBlocksPerMultiprocessor(&per_cu, (const void*)mk_fwd, 512, LDS_BYTES) != hipSuccess || per_cu < 1) { fprintf(stderr, "kernel_launch: occupancy query gave %d\n", per_cu); per_cu = 1; }
        (void)hipGetLastError();
        grid = cus * per_cu;
    }
    if (grid < 0) return;
    (void)hipMemsetAsync((char*)d_ws + WS_CTL, 0, CTL_ZERO_BYTES, stream);
    Args a{};
    for (int i = 0; i < 21; ++i) a.in[i] = (const float*)d_in[i];
    a.out = (float*)d_out; a.ws = (unsigned char*)d_ws;
    for (int i = 0; i < 64; ++i) a.inv_r[i] = powf(10000.0f, -((float)(2 * i)) / 128.0f);
    for (int i = 0; i < 32; ++i) a.inv_m[i] = powf(10000.0f, -((float)(2 * i)) / 64.0f);
#if MK_SPLIT
    for (int p = 0; p < NPH; ++p) { a.ph_lo = p; a.ph_hi = p + 1; hipLaunchKernelGGL(mk_fwd, dim3(grid), dim3(512), LDS_BYTES, stream, a); }
#else
    a.ph_lo = 0; a.ph_hi = NPH;
    void* args[] = {&a};
    hipError_t e = hipLaunchCooperativeKernel((const void*)mk_fwd, dim3(grid), dim3(512), args, LDS_BYTES, stream);
    if (e != hipSuccess) fprintf(stderr, "kernel_launch: cooperative launch failed: %s (grid %d)\n", hipGetErrorString(e), grid);
#endif
}
```

```cpp
#include <hip/hip_runtime.h>
#include <hip/hip_cooperative_groups.h>
#include <cstdio>
#include <cstdint>
#include <cmath>
namespace cg = cooperative_groups;
namespace pg8 {
#define PG8_LAS __attribute__((address_space(3)))
typedef unsigned short bf16_t;
typedef short bf16x8 __attribute__((ext_vector_type(8)));
typedef float f32x4 __attribute__((ext_vector_type(4)));
typedef unsigned u32x4 __attribute__((ext_vector_type(4)));
constexpr int BM = 256, BK = 64, HALF = 128, HTB = HALF * BK * 2  , STAGE_BYTES = 8 * HTB, NXCD = 8, WGM = 8;

__host__ __device__ __forceinline__ int lds_byte(int r, int c) { const int st = (r >> 4) * 2 + (c >> 5), rr = r & 15, cc = c & 31, ob = rr * 64 + cc * 2; return st * 1024 + (ob ^ (((ob >> 9) & 1) << 5)); }
__host__ __device__ __forceinline__ void stage_rc(int b, int& R, int& C) { const int st = b / 1024, sb = b % 1024, swz = sb ^ (((sb >> 9) & 1) << 5); R = (st >> 1) * 16 + swz / 64; C = (st & 1) * 32 + (swz % 64) / 2; }
__host__ __device__ __forceinline__ int perm32(int rho) { const int n = rho >> 4, i = rho & 15; return 8 * (i >> 2) + 4 * n + (i & 3); }

struct Unit { int pm, pn; };
struct Gemm { const bf16_t* A; const bf16_t* Bt; int M, N, K; };

struct StaticOrder {
    int nM, nN, nwg, G, c;
    __host__ __device__ void init(int M, int N, int G_, int c_) { nM = M / BM; nN = N / BM; nwg = nM * nN; G = G_; c = c_; }
    __host__ __device__ bool next(int i, Unit& u) const {
        const long L = (long)i * G + c; if (L >= nwg) return false;
        int wgid = (int)L; { const int q = nwg / NXCD, r = nwg % NXCD, xcd = wgid % NXCD, off = wgid / NXCD; wgid = (xcd < r ? xcd * (q + 1) : r * (q + 1) + (xcd - r) * q) + off; }
        const int nig = WGM * nN, gid = wgid / nig, fm = gid * WGM, gsz = (nM - fm) < WGM ? (nM - fm) : WGM;
        u.pm = fm + ((wgid % nig) % gsz); u.pn = (wgid % nig) / gsz; return true;
    }
    __device__ __forceinline__ void a_ready(const Unit&) const {}
    __device__ __forceinline__ void done(const Unit&) const {}
};

#ifndef PROBE_COARSE_ACT
#define PROBE_COARSE_ACT 0
#endif
__device__ __forceinline__ unsigned coarse2(unsigned w) { return PROBE_COARSE_ACT ? ((w + ((w >> 1) & 0x00010001u)) & 0xfffefffeu) : w; }
__device__ __forceinline__ unsigned cvt_pk_bf16(float lo, float hi) { unsigned r; asm volatile("v_cvt_pk_bf16_f32 %0, %1, %2" : "=v"(r) : "v"(lo), "v"(hi)); return coarse2(r); }
typedef float f32x2 __attribute__((ext_vector_type(2)));

typedef unsigned u32x2 __attribute__((ext_vector_type(2)));
__device__ __forceinline__ float silu_f(float v) { return v * __builtin_amdgcn_rcpf(1.f + __builtin_amdgcn_exp2f(v * -1.4426950408889634f)); }
__device__ __forceinline__ u32x4 pack8(f32x4 a, f32x4 b) { u32x4 w; w.x = cvt_pk_bf16(a[0], a[1]); w.y = cvt_pk_bf16(a[2], a[3]); w.z = cvt_pk_bf16(b[0], b[1]); w.w = cvt_pk_bf16(b[2], b[3]); return w; }
__device__ __forceinline__ void rope8(f32x4& a, f32x4& b, const f32x4 c, const f32x4 s) {
    float t1, t2;
    t1 = a[0]; t2 = a[1]; a[0] = t1 * c[0] - t2 * s[0]; a[1] = t2 * c[0] + t1 * s[0];
    t1 = a[2]; t2 = a[3]; a[2] = t1 * c[1] - t2 * s[1]; a[3] = t2 * c[1] + t1 * s[1];
    t1 = b[0]; t2 = b[1]; b[0] = t1 * c[2] - t2 * s[2]; b[1] = t2 * c[2] + t1 * s[2];
    t1 = b[2]; t2 = b[3]; b[2] = t1 * c[3] - t2 * s[3]; b[3] = t2 * c[3] + t1 * s[3];
}
constexpr float NORM_EPS = 1e-6f;

struct EpiIn {
    static constexpr bool PERM = true, AFTER_DRAIN = false;
    bf16_t *Qr, *Kr, *Vr, *Gr, *CQ, *CKV, *Kbuf; const float *cosr, *sinr, *cosm, *sinm; float *ssq_q, *ssq_kv;
    __device__ __forceinline__ void operator()(const f32x4 (&acc)[2][2][4][2], const Unit& u, int wr, int wc, int fr, int fq) const {
        const int pn = u.pn, row0 = u.pm * BM + wr * 64 + fr, cl = wc * 32 + 8 * fq;
        if (pn < 8) {
            bf16_t* O = pn < 4 ? Qr : Kr; const float sc = pn < 4 ? 1.f : 0.08838834764831845f; const int colt = (pn & 3) * 256 + cl;
#pragma unroll
            for (int ai = 0; ai < 2; ++ai)
#pragma unroll
                for (int m = 0; m < 4; ++m) { const int row = row0 + ai * HALF + m * 16;
                    const f32x4 c4 = *(const f32x4*)(cosr + (size_t)row * 64 + (cl >> 1)), s4 = *(const f32x4*)(sinr + (size_t)row * 64 + (cl >> 1));
#pragma unroll
                    for (int bj = 0; bj < 2; ++bj) { f32x4 a = acc[ai][bj][m][0], b = acc[ai][bj][m][1]; rope8(a, b, c4, s4); a = a * sc; b = b * sc;
                        *(u32x4*)(O + (size_t)row * 1024 + colt + bj * HALF) = pack8(a, b); } }
        } else if (pn < 16) {
            const bool isg = pn >= 12; bf16_t* O = isg ? Gr : Vr; const int colt = (pn & 3) * 256 + cl;
#pragma unroll
            for (int ai = 0; ai < 2; ++ai)
#pragma unroll
                for (int m = 0; m < 4; ++m) { const int row = row0 + ai * HALF + m * 16;
#pragma unroll
                    for (int bj = 0; bj < 2; ++bj) { f32x4 a = acc[ai][bj][m][0], b = acc[ai][bj][m][1];
                        if (isg) {
#pragma unroll
                            for (int i = 0; i < 4; ++i) { a[i] = silu_f(a[i]); b[i] = silu_f(b[i]); } }
                        *(u32x4*)(O + (size_t)row * 1024 + colt + bj * HALF) = pack8(a, b); } }
        } else if (pn < 20) {
            bf16_t* O = pn < 18 ? CQ : CKV; float* sq = pn < 18 ? ssq_q : ssq_kv; const int colt = (pn & 1) * 256 + cl;
#pragma unroll
            for (int ai = 0; ai < 2; ++ai)
#pragma unroll
                for (int m = 0; m < 4; ++m) { const int row = row0 + ai * HALF + m * 16; float s = 0.f;
#pragma unroll
                    for (int bj = 0; bj < 2; ++bj) { const f32x4 a = acc[ai][bj][m][0], b = acc[ai][bj][m][1];
                        s += (a[0] * a[0] + a[1] * a[1]) + (a[2] * a[2] + a[3] * a[3]) + (b[0] * b[0] + b[1] * b[1]) + (b[2] * b[2] + b[3] * b[3]);
                        *(u32x4*)(O + (size_t)row * 512 + colt + bj * HALF) = pack8(a, b); }
                    s += __shfl_xor(s, 16); s += __shfl_xor(s, 32);
                    if (fq == 0) atomicAdd(sq + row, s); }
        } else {
            if (wc < 2) {
#pragma unroll
                for (int ai = 0; ai < 2; ++ai)
#pragma unroll
                    for (int m = 0; m < 4; ++m) { const int row = row0 + ai * HALF + m * 16;
                        const f32x4 c4 = *(const f32x4*)(cosm + (size_t)row * 32 + (cl >> 1)), s4 = *(const f32x4*)(sinm + (size_t)row * 32 + (cl >> 1));
                        f32x4 a = acc[ai][0][m][0], b = acc[ai][0][m][1]; rope8(a, b, c4, s4); const u32x4 w = pack8(a, b);
#pragma unroll
                        for (int h = 0; h < 8; ++h) *(u32x4*)(Kbuf + (size_t)row * 1536 + h * 192 + 128 + cl) = w; }
            }
        }
    }
};
struct EpiUpQ {
    static constexpr bool PERM = true, AFTER_DRAIN = false;
    const float* ssq; bf16_t* Qm; const float *cosm, *sinm;
    __device__ __forceinline__ void operator()(const f32x4 (&acc)[2][2][4][2], const Unit& u, int wr, int wc, int fr, int fq) const {
        const int row0 = u.pm * BM + wr * 64 + fr, cl = wc * 32 + 8 * fq;
#pragma unroll
        for (int ai = 0; ai < 2; ++ai)
#pragma unroll
            for (int m = 0; m < 4; ++m) { const int row = row0 + ai * HALF + m * 16; const float rstd = rsqrtf(ssq[row] * (1.f / 512.f) + NORM_EPS);
#pragma unroll
                for (int bj = 0; bj < 2; ++bj) { const int c = u.pn * 256 + bj * HALF + cl, d = c % 192; f32x4 a = acc[ai][bj][m][0] * rstd, b = acc[ai][bj][m][1] * rstd;
                    if (d >= 128) { const int fi = (d - 128) >> 1; const f32x4 c4 = *(const f32x4*)(cosm + (size_t)row * 32 + fi), s4 = *(const f32x4*)(sinm + (size_t)row * 32 + fi); rope8(a, b, c4, s4); }
                    *(u32x4*)(Qm + (size_t)row * 1536 + c) = pack8(a, b); } }
    }
};
struct EpiUpKV {
    static constexpr bool PERM = true, AFTER_DRAIN = false;
    const float* ssq; bf16_t *Kbuf, *Vm;
    __device__ __forceinline__ void operator()(const f32x4 (&acc)[2][2][4][2], const Unit& u, int wr, int wc, int fr, int fq) const {
        const int row0 = u.pm * BM + wr * 64 + fr, cl = wc * 32 + 8 * fq;
#pragma unroll
        for (int ai = 0; ai < 2; ++ai)
#pragma unroll
            for (int m = 0; m < 4; ++m) { const int row = row0 + ai * HALF + m * 16; const float rstd = rsqrtf(ssq[row] * (1.f / 512.f) + NORM_EPS);
                *(u32x4*)(Kbuf + (size_t)row * 1536 + u.pn * 192 + cl) = pack8(acc[ai][0][m][0] * rstd, acc[ai][0][m][1] * rstd);
                *(u32x4*)(Vm + (size_t)row * 1024 + u.pn * 128 + cl) = pack8(acc[ai][1][m][0] * rstd, acc[ai][1][m][1] * rstd); }
    }
};
struct EpiGateRes {
    static constexpr bool PERM = true, AFTER_DRAIN = false;
    const float* x; const float* gate; float* out;
    __device__ __forceinline__ void operator()(const f32x4 (&acc)[2][2][4][2], const Unit& u, int wr, int wc, int fr, int fq) const {
        const int row0 = u.pm * BM + wr * 64 + fr, cl = wc * 32 + 8 * fq, b = u.pm >> 4;
#pragma unroll
        for (int bj = 0; bj < 2; ++bj) { const int c = u.pn * 256 + bj * HALF + cl;
            const f32x4 g0 = *(const f32x4*)(gate + (size_t)b * 12288 + c), g1 = *(const f32x4*)(gate + (size_t)b * 12288 + c + 4);
#pragma unroll
            for (int ai = 0; ai < 2; ++ai)
#pragma unroll
                for (int m = 0; m < 4; ++m) { const size_t off = (size_t)(row0 + ai * HALF + m * 16) * 2048 + c;
                    const f32x4 x0 = *(const f32x4*)(x + off), x1 = *(const f32x4*)(x + off + 4);
                    *(f32x4*)(out + off) = x0 + g0 * acc[ai][bj][m][0]; *(f32x4*)(out + off + 4) = x1 + g1 * acc[ai][bj][m][1]; } }
    }
};
struct EpiGU {
    static constexpr bool PERM = true, AFTER_DRAIN = false;
    bf16_t* Aff;
    __device__ __forceinline__ void operator()(const f32x4 (&acc)[2][2][4][2], const Unit& u, int wr, int wc, int fr, int fq) const {
        const int row0 = u.pm * BM + wr * 64 + fr, cl = wc * 32 + 8 * fq;
#pragma unroll
        for (int ai = 0; ai < 2; ++ai)
#pragma unroll
            for (int m = 0; m < 4; ++m) { const int row = row0 + ai * HALF + m * 16; f32x4 a, b;
#pragma unroll
                for (int i = 0; i < 4; ++i) { a[i] = silu_f(acc[ai][0][m][0][i]) * acc[ai][1][m][0][i]; b[i] = silu_f(acc[ai][0][m][1][i]) * acc[ai][1][m][1][i]; }
                *(u32x4*)(Aff + (size_t)row * 5632 + u.pn * 128 + cl) = pack8(a, b); }
    }
};

template <class Epi, class Sched, bool ALIGN_EPI = false, bool SP2 = false>
__device__ __forceinline__ void gemm_phase(PG8_LAS unsigned char* lds, const Gemm g, const Sched& S, const Epi& E) {
    const int tid = threadIdx.x, wid = __builtin_amdgcn_readfirstlane(tid >> 6), lane = tid & 63, wr = wid >> 2, wc = wid & 3, fr = lane & 15, fq = lane >> 4;
    const int K = g.K, nt = K / BK;
    unsigned voffA[2], voffB[2];
#pragma unroll
    for (int i = 0; i < 2; ++i) { int R, C; stage_rc(tid * 16 + i * 8192, R, C); const int Rb = Epi::PERM ? ((R & ~31) + perm32(R & 31)) : R;
        voffA[i] = (unsigned)(R * K + C) * 2u; voffB[i] = (unsigned)(Rb * K + C) * 2u; }
    const size_t kstep = (size_t)(BK * 2);
    const size_t hstep = (size_t)HALF * K * 2;
    const size_t tstep = 2 * hstep;
    const unsigned ldsw = (unsigned)wid * 1024u;
    const int aoff = lds_byte(wr * 64 + fr, fq * 8), boff = lds_byte(wc * 32 + fr, fq * 8);
#define PG8_SA(b, h) (((b) * 2 + (h)) * HTB)
#define PG8_SB(b, h) ((4 + (b) * 2 + (h)) * HTB)
#define PG8_STAGE(bufoff, gbase, voff) do { _Pragma("unroll") for (int _i = 0; _i < 2; ++_i) \
        __builtin_amdgcn_global_load_lds((const unsigned*)((const char*)(gbase) + (voff)[_i]), (PG8_LAS unsigned*)(lds + (bufoff) + ldsw + _i * 8192), 16, 0, 0); } while (0)
#define PG8_LDA(dst, b, h) do { _Pragma("unroll") for (int m = 0; m < 4; ++m) _Pragma("unroll") for (int k = 0; k < 2; ++k) dst[m][k] = *(const PG8_LAS bf16x8*)(lds + PG8_SA(b, h) + aoff + m * 2048 + k * 1024); } while (0)
#define PG8_LDB(dst, b, h) do { _Pragma("unroll") for (int n = 0; n < 2; ++n) _Pragma("unroll") for (int k = 0; k < 2; ++k) dst[n][k] = *(const PG8_LAS bf16x8*)(lds + PG8_SB(b, h) + boff + n * 2048 + k * 1024); } while (0)
#define PG8_MMA(ai, bj, At, Bt) do { __builtin_amdgcn_s_setprio(1); _Pragma("unroll") for (int m = 0; m < 4; ++m) _Pragma("unroll") for (int n = 0; n < 2; ++n) _Pragma("unroll") for (int k = 0; k < 2; ++k) \
        acc[ai][bj][m][n] = __builtin_amdgcn_mfma_f32_16x16x32_bf16(Bt[n][k], At[m][k], acc[ai][bj][m][n], 0, 0, 0); __builtin_amdgcn_s_setprio(0); } while (0)
#define PG8_WAIT_V(n) asm volatile("s_waitcnt vmcnt(" #n ")" ::: "memory")
#define PG8_WAIT_L(n) asm volatile("s_waitcnt lgkmcnt(" #n ")" ::: "memory")
#define PG8_BAR __builtin_amdgcn_s_barrier()
#define PG8_SCHED __builtin_amdgcn_sched_barrier(0)
    Unit cur, nxt; int ui = 0;
    if (!S.next(0, cur)) return;
    f32x4 acc[2][2][4][2];
#pragma unroll
    for (int a = 0; a < 2; ++a)
#pragma unroll
        for (int b = 0; b < 2; ++b)
#pragma unroll
            for (int m = 0; m < 4; ++m)
#pragma unroll
                for (int n = 0; n < 2; ++n) acc[a][b][m][n] = (f32x4){0.f, 0.f, 0.f, 0.f};
    bf16x8 At[4][2], B0[2][2], B1[2][2];
    const char* cA = (const char*)g.A + (size_t)cur.pm * tstep; const char* cB = (const char*)g.Bt + (size_t)cur.pn * tstep;
    S.a_ready(cur);
    if constexpr (SP2) {
        PG8_STAGE(PG8_SB(0, 0), cB, voffB); PG8_STAGE(PG8_SB(0, 1), cB + hstep, voffB); PG8_STAGE(PG8_SA(0, 0), cA, voffA); PG8_STAGE(PG8_SA(0, 1), cA + hstep, voffA);
        if (wr == 1) PG8_BAR;
        PG8_WAIT_V(2); PG8_BAR;
        PG8_STAGE(PG8_SB(1, 0), cB + kstep, voffB); PG8_STAGE(PG8_SA(1, 0), cA + kstep, voffA); PG8_STAGE(PG8_SB(1, 1), cB + hstep + kstep, voffB);
        PG8_WAIT_V(6); PG8_BAR;
    } else {
        PG8_STAGE(PG8_SB(0, 0), cB, voffB); PG8_STAGE(PG8_SA(0, 0), cA, voffA); PG8_STAGE(PG8_SB(0, 1), cB + hstep, voffB); PG8_STAGE(PG8_SA(0, 1), cA + hstep, voffA);
        if (wr == 1) PG8_BAR;
        PG8_WAIT_V(4); PG8_BAR;
        PG8_STAGE(PG8_SB(1, 0), cB + kstep, voffB); PG8_STAGE(PG8_SA(1, 0), cA + kstep, voffA); PG8_STAGE(PG8_SB(1, 1), cB + hstep + kstep, voffB);
        PG8_WAIT_V(6); PG8_BAR;
    }
    for (;;) {
        const bool has_next = S.next(ui + 1, nxt);
        const char* nA = has_next ? (const char*)g.A + (size_t)nxt.pm * tstep : cA; const char* nB = has_next ? (const char*)g.Bt + (size_t)nxt.pn * tstep : cB;
        for (int t = 0; t < nt; t += 2) {
            const bool last = (t == nt - 2);
            const char* a1 = cA + (size_t)(t + 1) * kstep;
            const char* a2 = last ? nA : cA + (size_t)(t + 2) * kstep; const char* b2 = last ? nB : cB + (size_t)(t + 2) * kstep;
            const char* a3 = a2 + kstep; const char* b3 = b2 + kstep;
            if (last && has_next) S.a_ready(nxt);
            if constexpr (SP2) {
            PG8_LDB(B0, 0, 0); PG8_LDB(B1, 0, 1); PG8_SCHED; PG8_LDA(At, 0, 0); PG8_STAGE(PG8_SA(1, 1), a1 + hstep, voffA);
            PG8_WAIT_V(8); PG8_WAIT_L(0); PG8_BAR; PG8_MMA(0, 0, At, B0); PG8_MMA(0, 1, At, B1); PG8_BAR; PG8_SCHED;
            PG8_LDA(At, 0, 1); PG8_STAGE(PG8_SB(0, 0), b2, voffB); PG8_STAGE(PG8_SB(0, 1), b2 + hstep, voffB); PG8_STAGE(PG8_SA(0, 0), a2, voffA);
            PG8_WAIT_V(8); PG8_WAIT_L(0); PG8_BAR; PG8_MMA(1, 0, At, B0); PG8_MMA(1, 1, At, B1); PG8_BAR; PG8_SCHED;
            PG8_LDB(B0, 1, 0); PG8_LDB(B1, 1, 1); PG8_SCHED; PG8_LDA(At, 1, 0); PG8_STAGE(PG8_SA(0, 1), a2 + hstep, voffA);
            PG8_WAIT_V(8); PG8_WAIT_L(0); PG8_BAR; PG8_MMA(0, 0, At, B0); PG8_MMA(0, 1, At, B1); PG8_BAR; PG8_SCHED;
            PG8_LDA(At, 1, 1); PG8_STAGE(PG8_SB(1, 0), b3, voffB); PG8_STAGE(PG8_SB(1, 1), b3 + hstep, voffB); PG8_STAGE(PG8_SA(1, 0), a3, voffA);
            PG8_WAIT_V(8); PG8_WAIT_L(0); PG8_BAR; PG8_MMA(1, 0, At, B0); PG8_MMA(1, 1, At, B1); PG8_BAR; PG8_SCHED;
            } else {
            PG8_LDB(B0, 0, 0); PG8_SCHED; PG8_LDA(At, 0, 0); PG8_STAGE(PG8_SA(1, 1), a1 + hstep, voffA);
            PG8_WAIT_L(8); PG8_BAR; PG8_WAIT_L(0); PG8_MMA(0, 0, At, B0); PG8_BAR; PG8_SCHED;
            PG8_LDB(B1, 0, 1); PG8_STAGE(PG8_SB(0, 0), b2, voffB);
            PG8_BAR; PG8_WAIT_L(0); PG8_MMA(0, 1, At, B1); PG8_BAR;
            PG8_LDA(At, 0, 1); PG8_STAGE(PG8_SA(0, 0), a2, voffA);
            PG8_BAR; PG8_WAIT_L(0); PG8_MMA(1, 0, At, B0); PG8_BAR; PG8_SCHED;
            PG8_STAGE(PG8_SB(0, 1), b2 + hstep, voffB);
            PG8_WAIT_V(6); PG8_BAR; PG8_MMA(1, 1, At, B1); PG8_BAR;
            PG8_LDB(B0, 1, 0); PG8_SCHED; PG8_LDA(At, 1, 0); PG8_STAGE(PG8_SA(0, 1), a2 + hstep, voffA);
            PG8_WAIT_L(8); PG8_BAR; PG8_WAIT_L(0); PG8_MMA(0, 0, At, B0); PG8_BAR; PG8_SCHED;
            PG8_LDB(B1, 1, 1); PG8_STAGE(PG8_SB(1, 0), b3, voffB);
            PG8_BAR; PG8_WAIT_L(0); PG8_MMA(0, 1, At, B1); PG8_BAR;
            PG8_LDA(At, 1, 1); PG8_STAGE(PG8_SA(1, 0), a3, voffA);
            PG8_BAR; PG8_WAIT_L(0); PG8_MMA(1, 0, At, B0); PG8_BAR; PG8_SCHED;
            PG8_STAGE(PG8_SB(1, 1), b3 + hstep, voffB);
            PG8_WAIT_V(6); PG8_BAR; PG8_MMA(1, 1, At, B1); PG8_BAR;
            }
        }
        if constexpr (ALIGN_EPI) { if (wr == 0) PG8_BAR; }
        if constexpr (!Epi::AFTER_DRAIN) { E(acc, cur, wr, wc, fr, fq); S.done(cur); }
        if (!has_next) break;
#pragma unroll
        for (int a = 0; a < 2; ++a)
#pragma unroll
            for (int b = 0; b < 2; ++b)
#pragma unroll
                for (int m = 0; m < 4; ++m)
#pragma unroll
                    for (int n = 0; n < 2; ++n) acc[a][b][m][n] = (f32x4){0.f, 0.f, 0.f, 0.f};
        cur = nxt; cA = nA; cB = nB; ++ui;
        if constexpr (ALIGN_EPI) { if (wr == 1) PG8_BAR; }
    }
    PG8_WAIT_V(0);
    if constexpr (!ALIGN_EPI) { if (wr == 0) PG8_BAR; }
    PG8_BAR;
    if constexpr (Epi::AFTER_DRAIN) { E.fused(acc, cur, wr, wc, fr, fq, lds, wid, lane); S.done(cur); }
#undef PG8_SA
#undef PG8_SB
#undef PG8_STAGE
#undef PG8_LDA
#undef PG8_LDB
#undef PG8_MMA
#undef PG8_WAIT_V
#undef PG8_WAIT_L
#undef PG8_BAR
#undef PG8_SCHED
}
}

namespace att {
typedef unsigned short bf16_t;
using bf16x8 = __attribute__((ext_vector_type(8))) short;
using s16x4  = __attribute__((ext_vector_type(4))) short;
using f32x16 = __attribute__((ext_vector_type(16))) float;
using f32x4  = __attribute__((ext_vector_type(4))) float;
using u32x4  = __attribute__((ext_vector_type(4))) unsigned;
using u32x2  = __attribute__((ext_vector_type(2))) unsigned;
constexpr int NW = 8, QBLK = 32, KVBLK = 64;
constexpr int LDQ = 1536, LDK = 1536, LDV = 1024, LDO = 1024;
constexpr float SCALE = 0.07216878364870323f;
constexpr float THR = 8.f;
constexpr int NQR = 8;
constexpr int SHM_V = KVBLK * 128 * 2, SHM_K = KVBLK * 192 * 2, SHM_ATTN = 2 * SHM_V + 2 * SHM_K + NW * 64 * 4;
#define AKSWZ(row, colB) ((row) * 384 + ((colB) ^ (((((row) >> 1) & 3) | (((row) >> 2) & 4)) << 4)))
#define KSWZ128(row, colB) ((row) * 256 + ((colB) ^ (((row) & 15) << 4)))
#define SBAR() __builtin_amdgcn_sched_barrier(0)
#define GAS __attribute__((address_space(1)))
__device__ __forceinline__ const GAS char* uniform_ptr(const void* p) { const unsigned long long v = (unsigned long long)p; const unsigned lo = __builtin_amdgcn_readfirstlane((unsigned)v), hi = __builtin_amdgcn_readfirstlane((unsigned)(v >> 32)); return (const GAS char*)(((unsigned long long)hi << 32) | lo); }
__device__ __forceinline__ int crow(int r, int hi) { return (r & 3) + 8 * (r >> 2) + 4 * hi; }
__device__ __forceinline__ unsigned cvtpk(float lo, float hi) { unsigned r; asm volatile("v_cvt_pk_bf16_f32 %0, %1, %2" : "=v"(r) : "v"(lo), "v"(hi)); return pg8::coarse2(r); }
__device__ __forceinline__ float swap_sum(float v) { auto rr = __builtin_amdgcn_permlane32_swap(__float_as_uint(v), __float_as_uint(v), false, false); return __uint_as_float(rr[0]) + __uint_as_float(rr[1]); }

__device__ __forceinline__ void partialSM(f32x16& p0, f32x16& p1, float& m_reg, float& mn, float& alpha) {
  constexpr float C = SCALE * 1.4426950408889634f;
  float pmax = p0[0];
#pragma unroll
  for (int r = 1; r < 16; ++r) pmax = fmaxf(pmax, p0[r]);
#pragma unroll
  for (int r = 0; r < 16; ++r) pmax = fmaxf(pmax, p1[r]);
  { auto rr = __builtin_amdgcn_permlane32_swap(__float_as_uint(pmax), __float_as_uint(pmax), false, false);
    pmax = fmaxf(__uint_as_float(rr[0]), __uint_as_float(rr[1])); }
  if (__builtin_expect(__all(pmax - m_reg <= THR / SCALE), 1)) { mn = m_reg; alpha = 1.f; }
  else { mn = fmaxf(m_reg, pmax); alpha = __builtin_amdgcn_exp2f((m_reg - mn) * C); m_reg = mn; }
  float mnC = -mn * C;
#pragma unroll
  for (int r = 0; r < 16; ++r) p0[r] = fmaf(p0[r], C, mnC);
#pragma unroll
  for (int r = 0; r < 16; ++r) p1[r] = fmaf(p1[r], C, mnC);
#pragma unroll
  for (int r = 0; r < 16; ++r) p0[r] = __builtin_amdgcn_exp2f(p0[r]);
}
#define PK4(P, BASE, OUT) do { unsigned a0 = cvtpk(P[BASE + 0], P[BASE + 1]), a1 = cvtpk(P[BASE + 2], P[BASE + 3]);   \
    unsigned b0 = cvtpk(P[BASE + 4], P[BASE + 5]), b1 = cvtpk(P[BASE + 6], P[BASE + 7]);                              \
    auto r0 = __builtin_amdgcn_permlane32_swap(a0, b0, false, false); auto r1 = __builtin_amdgcn_permlane32_swap(a1, b1, false, false); \
    u32x4 w = {r0[0], r1[0], r0[1], r1[1]}; OUT = *reinterpret_cast<bf16x8*>(&w); } while (0)
__device__ __forceinline__ void finishSM(f32x16& p0, f32x16& p1, float alpha, float& l_reg, bf16x8& pa0, bf16x8& pa1, bf16x8& pa2, bf16x8& pa3) {
#pragma unroll
  for (int r = 0; r < 16; ++r) p1[r] = __builtin_amdgcn_exp2f(p1[r]);
  float ps = 0;
#pragma unroll
  for (int r = 0; r < 16; ++r) ps += p0[r];
#pragma unroll
  for (int r = 0; r < 16; ++r) ps += p1[r];
  ps = swap_sum(ps);
  l_reg = l_reg * alpha + ps;
  PK4(p0, 0, pa0); PK4(p0, 8, pa1); PK4(p1, 0, pa2); PK4(p1, 8, pa3);
}
__device__ __forceinline__ void qkt192(f32x16& p0, f32x16& p1, const char* Ks, const bf16x8 (&qr)[NQR], const char* Qs, int r32, int hi) {
  p0 = f32x16{}; p1 = f32x16{};
  __builtin_amdgcn_s_setprio(1);
#pragma unroll
  for (int d0 = 0; d0 < 12; ++d0) { int cb = (d0 * 16 + hi * 8) * 2;
    bf16x8 b0 = *reinterpret_cast<const bf16x8*>(Ks + AKSWZ(r32, cb));
    bf16x8 b1 = *reinterpret_cast<const bf16x8*>(Ks + AKSWZ(32 + r32, cb));
    bf16x8 qv; if (d0 < NQR) qv = qr[d0 < NQR ? d0 : 0]; else qv = *reinterpret_cast<const bf16x8*>(Qs + (d0 - NQR) * 1024);
    p0 = __builtin_amdgcn_mfma_f32_32x32x16_bf16(b0, qv, p0, 0, 0, 0);
    p1 = __builtin_amdgcn_mfma_f32_32x32x16_bf16(b1, qv, p1, 0, 0, 0); }
  __builtin_amdgcn_s_setprio(0);
}
__device__ __forceinline__ void qkt128(f32x16& p0, f32x16& p1, const char* Ks, const bf16x8 (&qr)[8], int r32, int hi) {
  p0 = f32x16{}; p1 = f32x16{};
#pragma unroll
  for (int d0 = 0; d0 < 8; ++d0) { int cb = (d0 * 16 + hi * 8) * 2;
    bf16x8 b0 = *reinterpret_cast<const bf16x8*>(Ks + KSWZ128(r32, cb));
    bf16x8 b1 = *reinterpret_cast<const bf16x8*>(Ks + KSWZ128(32 + r32, cb));
    p0 = __builtin_amdgcn_mfma_f32_32x32x16_bf16(b0, qr[d0], p0, 0, 0, 0);
    p1 = __builtin_amdgcn_mfma_f32_32x32x16_bf16(b1, qr[d0], p1, 0, 0, 0); }
}
__device__ __forceinline__ int v_st(int k, int c) { const int kk = (k & ~0xC) | ((k & 4) << 1) | ((k & 8) >> 1); return ((kk >> 3) * 4 + (c >> 5)) * 512 + ((kk & 7) * 32 + (c & 31)) * 2; }
__device__ __forceinline__ int v_rd_base(int lane) { return ((lane & 3) << 3) | (((lane >> 2) & 3) << 6) | (((lane >> 4) & 1) << 5) | (((lane >> 5) & 1) << 8); }
constexpr int v_rd_off(int d0, int ks, int half) { return d0 * 512 + ks * 4096 + half * 2048; }
template <int OFF> __device__ __forceinline__ s16x4 tr_read(int vb) {
  s16x4 r; asm volatile("ds_read_b64_tr_b16 %0, %1 offset:%2" : "=&v"(r) : "v"(vb), "i"(OFF) : "memory"); return r;
}
#define PKLH(L, H) (bf16x8){L[0], L[1], L[2], L[3], H[0], H[1], H[2], H[3]}
template <int D0> __device__ __forceinline__ void pv_one(f32x16& od, int vb, bf16x8 pa0, bf16x8 pa1, bf16x8 pa2, bf16x8 pa3) {
  const s16x4 l0 = tr_read<v_rd_off(D0, 0, 0)>(vb), h0 = tr_read<v_rd_off(D0, 0, 1)>(vb), l1 = tr_read<v_rd_off(D0, 1, 0)>(vb), h1 = tr_read<v_rd_off(D0, 1, 1)>(vb);
  const s16x4 l2 = tr_read<v_rd_off(D0, 2, 0)>(vb), h2 = tr_read<v_rd_off(D0, 2, 1)>(vb), l3 = tr_read<v_rd_off(D0, 3, 0)>(vb), h3 = tr_read<v_rd_off(D0, 3, 1)>(vb);
  asm volatile("s_waitcnt lgkmcnt(0)" ::: "memory"); SBAR();
  __builtin_amdgcn_s_setprio(1);
  od = __builtin_amdgcn_mfma_f32_32x32x16_bf16(pa0, PKLH(l0, h0), od, 0, 0, 0);
  od = __builtin_amdgcn_mfma_f32_32x32x16_bf16(pa1, PKLH(l1, h1), od, 0, 0, 0);
  od = __builtin_amdgcn_mfma_f32_32x32x16_bf16(pa2, PKLH(l2, h2), od, 0, 0, 0);
  od = __builtin_amdgcn_mfma_f32_32x32x16_bf16(pa3, PKLH(l3, h3), od, 0, 0, 0);
  __builtin_amdgcn_s_setprio(0);
}
__device__ __forceinline__ void pv_d0(f32x16* o, int vb, bf16x8 pa0, bf16x8 pa1, bf16x8 pa2, bf16x8 pa3) {
  pv_one<0>(o[0], vb, pa0, pa1, pa2, pa3); pv_one<1>(o[1], vb, pa0, pa1, pa2, pa3); pv_one<2>(o[2], vb, pa0, pa1, pa2, pa3); pv_one<3>(o[3], vb, pa0, pa1, pa2, pa3);
}
template <int D0> __device__ __forceinline__ void pvT_one(f32x16& od, int vb, bf16x8 pa0, bf16x8 pa1, bf16x8 pa2, bf16x8 pa3) {
  const s16x4 l0 = tr_read<v_rd_off(D0, 0, 0)>(vb), h0 = tr_read<v_rd_off(D0, 0, 1)>(vb), l1 = tr_read<v_rd_off(D0, 1, 0)>(vb), h1 = tr_read<v_rd_off(D0, 1, 1)>(vb);
  const s16x4 l2 = tr_read<v_rd_off(D0, 2, 0)>(vb), h2 = tr_read<v_rd_off(D0, 2, 1)>(vb), l3 = tr_read<v_rd_off(D0, 3, 0)>(vb), h3 = tr_read<v_rd_off(D0, 3, 1)>(vb);
  asm volatile("s_waitcnt lgkmcnt(0)" ::: "memory"); SBAR();
  od = __builtin_amdgcn_mfma_f32_32x32x16_bf16(PKLH(l0, h0), pa0, od, 0, 0, 0);
  od = __builtin_amdgcn_mfma_f32_32x32x16_bf16(PKLH(l1, h1), pa1, od, 0, 0, 0);
  od = __builtin_amdgcn_mfma_f32_32x32x16_bf16(PKLH(l2, h2), pa2, od, 0, 0, 0);
  od = __builtin_amdgcn_mfma_f32_32x32x16_bf16(PKLH(l3, h3), pa3, od, 0, 0, 0);
}

__device__ __forceinline__ void attn_unit(const bf16_t* __restrict__ Qb, const bf16_t* __restrict__ Kh, const bf16_t* __restrict__ Vh, bf16_t* __restrict__ Ob, int seq, char* lds, int ldsaddr) {
  const int tid = threadIdx.x, wid = tid >> 6, lane = tid & 63, r32 = lane & 31, hi = lane >> 5;
  char* V_lds = lds; char* K_lds = lds + 2 * SHM_V;
  float* ws = (float*)(lds + 2 * SHM_V + 2 * SHM_K) + wid * 64; float* li_l = ws; float* al_l = ws + 32;
  float m_reg = -1e30f, l_reg = 0; f32x16 o[4] = {}; bf16x8 qr[NQR];
  const bf16_t* Qw = Qb + (long)(wid * QBLK + r32) * LDQ + hi * 8;
  char* Qs = lds + SHM_ATTN + wid * ((12 - NQR) * 1024) + lane * 16;
#pragma unroll
  for (int d0 = 0; d0 < NQR; ++d0) qr[d0] = *reinterpret_cast<const bf16x8*>(Qw + d0 * 16);
#pragma unroll
  for (int d0 = NQR; d0 < 12; ++d0) *(bf16x8*)(Qs + (d0 - NQR) * 1024) = *reinterpret_cast<const bf16x8*>(Qw + d0 * 16);
  const int sr = tid >> 4, sc = (tid & 15) * 8, vst0 = v_st(sr, sc), vst1 = v_st(32 + sr, sc);
  unsigned kg0, kg1, kg2; int kl0, kl1, kl2;
  { int p = tid;        int kr = p / 24, kc = (p % 24) * 8; kg0 = (unsigned)(kr * LDK + kc) * 2u; kl0 = AKSWZ(kr, kc * 2);
    p = tid + 512;      kr = p / 24; kc = (p % 24) * 8;     kg1 = (unsigned)(kr * LDK + kc) * 2u; kl1 = AKSWZ(kr, kc * 2);
    p = tid + 1024;     kr = p / 24; kc = (p % 24) * 8;     kg2 = (unsigned)(kr * LDK + kc) * 2u; kl2 = AKSWZ(kr, kc * 2); }
  const unsigned vg0 = (unsigned)(sr * LDV + sc) * 2u, vg1 = (unsigned)((32 + sr) * LDV + sc) * 2u;
  const int vb0 = ldsaddr + v_rd_base(lane);
  bf16x8 vs0, vs1, ks0, ks1, ks2;
#define SLOAD(k0) do { const GAS char* vb_ = uniform_ptr((const char*)Vh + (size_t)(k0) * (LDV * 2)); const GAS char* kb_ = uniform_ptr((const char*)Kh + (size_t)(k0) * (LDK * 2)); \
    vs0 = *(const GAS bf16x8*)(vb_ + vg0); vs1 = *(const GAS bf16x8*)(vb_ + vg1); \
    ks0 = *(const GAS bf16x8*)(kb_ + kg0); ks1 = *(const GAS bf16x8*)(kb_ + kg1); ks2 = *(const GAS bf16x8*)(kb_ + kg2); } while (0)
#define SWRITE(b) do { *(bf16x8*)(V_lds + (b) * SHM_V + vst0) = vs0; *(bf16x8*)(V_lds + (b) * SHM_V + vst1) = vs1; \
    *(bf16x8*)(K_lds + (b) * SHM_K + kl0) = ks0; *(bf16x8*)(K_lds + (b) * SHM_K + kl1) = ks1; *(bf16x8*)(K_lds + (b) * SHM_K + kl2) = ks2; } while (0)
#define SWAIT() asm volatile("s_waitcnt vmcnt(0)" ::: "memory")
#define RESC(a) do { if (__any((a) < 1.f)) { if (hi == 0) al_l[r32] = (a); asm volatile("s_waitcnt lgkmcnt(0)" ::: "memory"); \
    _Pragma("unroll") for (int d = 0; d < 4; ++d) _Pragma("unroll") for (int r = 0; r < 16; ++r) o[d][r] *= al_l[crow(r, hi)]; } } while (0)
  f32x16 pA0, pA1, pB0, pB1; float mnA, mnB, alA, alB; bf16x8 pa0, pa1, pa2, pa3; const int NT = seq / KVBLK;
  __syncthreads();
  SLOAD(0); SWAIT(); SWRITE(0); __syncthreads();
  qkt192(pA0, pA1, K_lds, qr, Qs, r32, hi); partialSM(pA0, pA1, m_reg, mnA, alA);
  SLOAD(KVBLK);
  SWAIT(); SWRITE(1); __syncthreads();
  for (int j = 1; j + 1 < NT; j += 2) {
    SBAR(); qkt192(pB0, pB1, K_lds + SHM_K, qr, Qs, r32, hi);
    finishSM(pA0, pA1, alA, l_reg, pa0, pa1, pa2, pa3); SBAR();
    SLOAD((j + 1) * KVBLK); SBAR();
    pv_d0(o, vb0, pa0, pa1, pa2, pa3); partialSM(pB0, pB1, m_reg, mnB, alB);
    __syncthreads(); SWAIT(); SWRITE(0);
    RESC(alB); __syncthreads();
    SBAR(); qkt192(pA0, pA1, K_lds, qr, Qs, r32, hi);
    finishSM(pB0, pB1, alB, l_reg, pa0, pa1, pa2, pa3); SBAR();
    SLOAD((j + 2) * KVBLK); SBAR();
    pv_d0(o, vb0 + SHM_V, pa0, pa1, pa2, pa3); partialSM(pA0, pA1, m_reg, mnA, alA);
    __syncthreads(); SWAIT(); SWRITE(1);
    RESC(alA); __syncthreads();
  }
  SBAR(); qkt192(pB0, pB1, K_lds + SHM_K, qr, Qs, r32, hi);
  finishSM(pA0, pA1, alA, l_reg, pa0, pa1, pa2, pa3); SBAR();
  pv_d0(o, vb0, pa0, pa1, pa2, pa3); partialSM(pB0, pB1, m_reg, mnB, alB);
  __syncthreads(); RESC(alB);
  finishSM(pB0, pB1, alB, l_reg, pa0, pa1, pa2, pa3); SBAR();
  pv_d0(o, vb0 + SHM_V, pa0, pa1, pa2, pa3);
  if (hi == 0) li_l[r32] = l_reg; asm volatile("s_waitcnt lgkmcnt(0)" ::: "memory");
  float rli[16];
#pragma unroll
  for (int r = 0; r < 16; ++r) rli[r] = __builtin_amdgcn_rcpf(li_l[crow(r, hi)]);
  bf16_t* Ow = Ob + (long)(wid * QBLK) * LDO;
#pragma unroll
  for (int r = 0; r < 16; ++r) { int orow = crow(r, hi);
#pragma unroll
    for (int d0 = 0; d0 < 4; ++d0) Ow[(long)orow * LDO + d0 * 32 + r32] = (bf16_t)(cvtpk(o[d0][r] * rli[r], 0.f) & 0xffffu); }
#undef SLOAD
#undef SWRITE
#undef SWAIT
#undef RESC
}

__device__ __forceinline__ bf16x8 scale8(bf16x8 v, float s) {
  u32x4 w = *reinterpret_cast<u32x4*>(&v), o;
#pragma unroll
  for (int i = 0; i < 4; ++i) o[i] = cvtpk(__uint_as_float(w[i] << 16) * s, __uint_as_float(w[i] & 0xffff0000u) * s);
  return *reinterpret_cast<bf16x8*>(&o);
}
__device__ __forceinline__ s16x4 trr(int addr) { s16x4 r; asm volatile("ds_read_b64_tr_b16 %0, %1" : "=&v"(r) : "v"(addr) : "memory"); return r; }

__device__ __forceinline__ void chunk_kv_unit(const bf16_t* __restrict__ Kc, const bf16_t* __restrict__ Vc, bf16_t* __restrict__ CKf, bf16_t* __restrict__ CKb, float lgf, float lgb, char* lds, int ldsaddr) {
  const int tid = threadIdx.x, wid = tid >> 6, lane = tid & 63, r32 = lane & 31, hi = lane >> 5;
  const int dir = wid >> 2, db = wid & 3, d = 32 * db + r32;
  __syncthreads();
  { const int sr = tid >> 4, sc = (tid & 15) * 8;
#pragma unroll
    for (int i = 0; i < 4; ++i) { const int row = sr + 32 * i;
      *(bf16x8*)(lds + (row >> 6) * 16384 + v_st(row & 63, sc)) = *reinterpret_cast<const bf16x8*>(Vc + (long)row * 1024 + sc);
      *(bf16x8*)(lds + 32768 + row * 272 + sc * 2) = *reinterpret_cast<const bf16x8*>(Kc + (long)row * 1024 + sc); } }
  __syncthreads();
  bf16x8 kb[8];
  int hio = hi; asm volatile("" : "+v"(hio));
  const char* kl = lds + 32768 + (hio * 8) * 272 + d * 2;
#pragma unroll
  for (int ks = 0; ks < 8; ++ks) { u32x4 w;
#pragma unroll
    for (int i = 0; i < 4; ++i) { const int s0 = ks * 16 + hio * 8 + 2 * i;
      const float k0 = __uint_as_float((unsigned)*(const unsigned short*)(kl + (ks * 16 + 2 * i) * 272) << 16), k1 = __uint_as_float((unsigned)*(const unsigned short*)(kl + (ks * 16 + 2 * i + 1) * 272) << 16);
      const float z0 = __builtin_amdgcn_exp2f(dir ? lgb * (float)s0 : lgf * (float)(127 - s0)), z1 = __builtin_amdgcn_exp2f(dir ? lgb * (float)(s0 + 1) : lgf * (float)(126 - s0));
      w[i] = cvtpk(k0 * z0, k1 * z1); }
    kb[ks] = *reinterpret_cast<bf16x8*>(&w); }
  f32x16 acc[4] = {};
  const int vb = ldsaddr + v_rd_base(lane);
  pvT_one<0>(acc[0], vb, kb[0], kb[1], kb[2], kb[3]); pvT_one<1>(acc[1], vb, kb[0], kb[1], kb[2], kb[3]); pvT_one<2>(acc[2], vb, kb[0], kb[1], kb[2], kb[3]); pvT_one<3>(acc[3], vb, kb[0], kb[1], kb[2], kb[3]);
  pvT_one<0>(acc[0], vb + 16384, kb[4], kb[5], kb[6], kb[7]); pvT_one<1>(acc[1], vb + 16384, kb[4], kb[5], kb[6], kb[7]); pvT_one<2>(acc[2], vb + 16384, kb[4], kb[5], kb[6], kb[7]); pvT_one<3>(acc[3], vb + 16384, kb[4], kb[5], kb[6], kb[7]);
  bf16_t* CK = dir ? CKb : CKf;
#pragma unroll
  for (int eb = 0; eb < 4; ++eb)
#pragma unroll
    for (int r = 0; r < 16; ++r) CK[(32 * eb + crow(r, hi)) * 128 + d] = (bf16_t)(cvtpk(acc[eb][r], 0.f) & 0xffffu);
}

#ifndef PROBE_COMP
#define PROBE_COMP 0
#endif
__device__ __forceinline__ void ret_out_unit(const bf16_t* __restrict__ Qc, const bf16_t* __restrict__ Kc, const bf16_t* __restrict__ Vc, const bf16_t* __restrict__ Gc,
                                             const bf16_t* __restrict__ STf, const bf16_t* __restrict__ STb, const float* __restrict__ gnw, const float* __restrict__ gnb,
                                             bf16_t* __restrict__ Oc, float lgf, float lgb, char* lds, int ldsaddr, float* dump = nullptr) {
  const int tid = threadIdx.x, ht = tid & 255, wq = (tid >> 6) & 3, lane = tid & 63, r32 = lane & 31, hi = lane >> 5;
  __syncthreads();
  { const int sr = ht >> 4, sc = (ht & 15) * 8;
#pragma unroll
    for (int i = 0; i < 8; ++i) { const int row = sr + 16 * i, tile = row >> 6, key = row & 63;
      *(bf16x8*)(lds + tile * 16384 + KSWZ128(key, sc * 2)) = *reinterpret_cast<const bf16x8*>(Kc + (long)row * 1024 + sc);
      *(bf16x8*)(lds + 32768 + tile * 16384 + v_st(key, sc)) = *reinterpret_cast<const bf16x8*>(Vc + (long)row * 1024 + sc); } }
  const int c = 32 * wq + r32;
  bf16x8 qr[8];
#pragma unroll
  for (int d0 = 0; d0 < 8; ++d0) qr[d0] = *reinterpret_cast<const bf16x8*>(Qc + (long)c * 1024 + d0 * 16 + hi * 8);
  __syncthreads();
  f32x16 pA0, pA1, pB0, pB1;
  qkt128(pA0, pA1, lds, qr, r32, hi); qkt128(pB0, pB1, lds + 16384, qr, r32, hi);
  int cdec = c; asm volatile("" : "+v"(cdec));
#define DEC(P, JB) do { _Pragma("unroll") for (int r = 0; r < 16; ++r) { const int dl = cdec - ((JB) + crow(r, hi)); \
    P[r] *= __builtin_amdgcn_exp2f(dl >= 0 ? lgf * (float)dl : lgb * (float)(-dl)); } } while (0)
  DEC(pA0, 0); DEC(pA1, 32); DEC(pB0, 64); DEC(pB1, 96);
#undef DEC
  bf16x8 xa0, xa1, xa2, xa3, xb0, xb1, xb2, xb3;
  PK4(pA0, 0, xa0); PK4(pA0, 8, xa1); PK4(pA1, 0, xa2); PK4(pA1, 8, xa3);
  PK4(pB0, 0, xb0); PK4(pB0, 8, xb1); PK4(pB1, 0, xb2); PK4(pB1, 8, xb3);
  f32x16 o[4] = {};
  const int vb = ldsaddr + 32768 + v_rd_base(lane);
  if (PROBE_COMP == 0 || (PROBE_COMP & 1)) {
  pvT_one<0>(o[0], vb, xa0, xa1, xa2, xa3); pvT_one<1>(o[1], vb, xa0, xa1, xa2, xa3); pvT_one<2>(o[2], vb, xa0, xa1, xa2, xa3); pvT_one<3>(o[3], vb, xa0, xa1, xa2, xa3);
  pvT_one<0>(o[0], vb + 16384, xb0, xb1, xb2, xb3); pvT_one<1>(o[1], vb + 16384, xb0, xb1, xb2, xb3); pvT_one<2>(o[2], vb + 16384, xb0, xb1, xb2, xb3); pvT_one<3>(o[3], vb + 16384, xb0, xb1, xb2, xb3);
  }
#pragma unroll
  for (int dir = 0; dir < 2; ++dir) {
    if (PROBE_COMP != 0 && !((PROBE_COMP >> (1 + dir)) & 1)) continue;
    const float xi = __builtin_amdgcn_exp2f(dir == 0 ? lgf * (float)(c + 1) : lgb * (float)(128 - c));
    const bf16_t* ST = dir == 0 ? STf : STb;
    bf16x8 qs[8];
#pragma unroll
    for (int d0 = 0; d0 < 8; ++d0) qs[d0] = scale8(qr[d0], xi);
    const GAS char* stb = uniform_ptr(ST); const unsigned so = (unsigned)(r32 * 128 + hi * 8) * 2u;
#pragma unroll
    for (int eb = 0; eb < 4; ++eb) {
      bf16x8 A[8];
      SBAR();
#pragma unroll
      for (int d0 = 0; d0 < 8; ++d0) A[d0] = *(const GAS bf16x8*)(stb + so + (eb * 32 * 128 + d0 * 16) * 2);
#pragma unroll
      for (int d0 = 0; d0 < 8; ++d0) o[eb] = __builtin_amdgcn_mfma_f32_32x32x16_bf16(A[d0], qs[d0], o[eb], 0, 0, 0);
      SBAR();
    }
  }
  if (PROBE_COMP != 0) {
#pragma unroll
    for (int eb = 0; eb < 4; ++eb)
#pragma unroll
      for (int g = 0; g < 4; ++g) *(f32x4*)(dump + (long)c * 1024 + 32 * eb + 8 * g + 4 * hi) = (f32x4){o[eb][4 * g], o[eb][4 * g + 1], o[eb][4 * g + 2], o[eb][4 * g + 3]};
    return; }
  float s = 0.f;
#pragma unroll
  for (int eb = 0; eb < 4; ++eb)
#pragma unroll
    for (int r = 0; r < 16; ++r) s += o[eb][r];
  const float mu = swap_sum(s) * (1.f / 128.f);
  float q = 0.f;
#pragma unroll
  for (int eb = 0; eb < 4; ++eb)
#pragma unroll
    for (int r = 0; r < 16; ++r) { const float d = o[eb][r] - mu; q += d * d; }
  const float rstd = rsqrtf(swap_sum(q) * (1.f / 128.f) + 1e-6f);
#pragma unroll
  for (int eb = 0; eb < 4; ++eb)
#pragma unroll
    for (int g = 0; g < 4; ++g) { const int e0 = 32 * eb + 8 * g + 4 * hi;
      const f32x4 w4 = *(const f32x4*)(gnw + e0), b4 = *(const f32x4*)(gnb + e0);
      const u32x2 gg = *(const u32x2*)(Gc + (long)c * 1024 + e0);
      const float g0 = __uint_as_float(gg.x << 16), g1 = __uint_as_float(gg.x & 0xffff0000u), g2 = __uint_as_float(gg.y << 16), g3 = __uint_as_float(gg.y & 0xffff0000u);
      const float y0 = ((o[eb][4 * g] - mu) * rstd * w4[0] + b4[0]) * g0, y1 = ((o[eb][4 * g + 1] - mu) * rstd * w4[1] + b4[1]) * g1;
      const float y2 = ((o[eb][4 * g + 2] - mu) * rstd * w4[2] + b4[2]) * g2, y3 = ((o[eb][4 * g + 3] - mu) * rstd * w4[3] + b4[3]) * g3;
      u32x2 w; w.x = cvtpk(y0, y1); w.y = cvtpk(y2, y3);
      *(u32x2*)(Oc + (long)c * 2048 + e0) = w; }
}

__device__ __forceinline__ void ret_brute_unit(const bf16_t* __restrict__ Qh, const bf16_t* __restrict__ Kh, const bf16_t* __restrict__ Vh, const bf16_t* __restrict__ Gc,
                                               const float* __restrict__ gnw, const float* __restrict__ gnb, bf16_t* __restrict__ Oc, int t0, float lgf, float lgb, char* lds, const float* dump = nullptr) {
  const int tid = threadIdx.x, qi = tid >> 2, part = tid & 3, t = t0 + qi;
  float q[32], acc[32];
#pragma unroll
  for (int i = 0; i < 32; ++i) { q[i] = __uint_as_float((unsigned)Qh[(long)t * 1024 + part * 32 + i] << 16); acc[i] = 0.f; }
  for (int s0 = 0; s0 < 4096; s0 += 64) {
    { const int rel = s0 < t0 ? 1 : (s0 >= t0 + 128 ? 2 : 0); if (PROBE_COMP != 0 && ((PROBE_COMP >> rel) & 1)) continue; }
    __syncthreads();
    for (int c = tid; c < 64 * 16; c += 512) { const int r = c >> 4, c8 = (c & 15) * 8;
      *(bf16x8*)(lds + (r * 128 + c8) * 2) = *reinterpret_cast<const bf16x8*>(Kh + (long)(s0 + r) * 1024 + c8);
      *(bf16x8*)(lds + 16384 + (r * 128 + c8) * 2) = *reinterpret_cast<const bf16x8*>(Vh + (long)(s0 + r) * 1024 + c8); }
    __syncthreads();
    for (int j = 0; j < 64; ++j) { const int s = s0 + j; float d = 0.f;
      const unsigned short* kr = (const unsigned short*)(lds + (j * 128 + part * 32) * 2); const unsigned short* vr = (const unsigned short*)(lds + 16384 + (j * 128 + part * 32) * 2);
#pragma unroll
      for (int i = 0; i < 32; ++i) d += q[i] * __uint_as_float((unsigned)kr[i] << 16);
      d += __shfl_xor(d, 1); d += __shfl_xor(d, 2);
      const int dl = t - s; const float w = d * __builtin_amdgcn_exp2f(dl >= 0 ? lgf * (float)dl : lgb * (float)(-dl));
#pragma unroll
      for (int i = 0; i < 32; ++i) acc[i] += w * __uint_as_float((unsigned)vr[i] << 16); }
  }
  if (PROBE_COMP != 0) {
#pragma unroll
    for (int i = 0; i < 32; ++i) acc[i] += dump[(long)qi * 1024 + part * 32 + i]; }
  float sm = 0.f;
#pragma unroll
  for (int i = 0; i < 32; ++i) sm += acc[i];
  sm += __shfl_xor(sm, 1); sm += __shfl_xor(sm, 2); const float mu = sm * (1.f / 128.f);
  float qq = 0.f;
#pragma unroll
  for (int i = 0; i < 32; ++i) { const float dd = acc[i] - mu; qq += dd * dd; }
  qq += __shfl_xor(qq, 1); qq += __shfl_xor(qq, 2); const float rstd = rsqrtf(qq * (1.f / 128.f) + 1e-6f);
#pragma unroll
  for (int i = 0; i < 32; ++i) { const int e = part * 32 + i; const float g = __uint_as_float((unsigned)Gc[(long)qi * 1024 + e] << 16);
    Oc[(long)qi * 2048 + e] = (bf16_t)(cvtpk(((acc[i] - mu) * rstd * gnw[e] + gnb[e]) * g, 0.f) & 0xffffu); }
}
#undef SBAR
}


#ifndef PROBE_BRUTE_RET
#define PROBE_BRUTE_RET 0
#endif
#ifndef MK_SPLIT
#define MK_SPLIT 0
#endif
#define LAS __attribute__((address_space(3)))
#define GASX __attribute__((address_space(1)))
typedef unsigned short bf16_t;
typedef unsigned v4u __attribute__((ext_vector_type(4)));
typedef unsigned v2u __attribute__((ext_vector_type(2)));
typedef float f32x4 __attribute__((ext_vector_type(4)));
typedef short bf16x8 __attribute__((ext_vector_type(8)));

constexpr int BATCH = 8, SEQ = 4096, DM = 2048, T = BATCH * SEQ;
constexpr int INC = 5184, INCP = 5376, DFF = 5632, NMODC = 6 * DM;
constexpr int NPH = 11;
constexpr size_t MiB = 1u << 20;
constexpr size_t WS_CTL = 0, CTL_ZERO_BYTES = 2 * MiB;
constexpr size_t OFF_MOD = 0, OFF_SSQQ = 512 * 1024, OFF_SSQKV = 640 * 1024;
constexpr size_t WS_COSR = 2 * MiB, WS_SINR = 10 * MiB, WS_COSM = 18 * MiB, WS_SINM = 22 * MiB;
constexpr size_t WS_WIN = 26 * MiB, WS_WUQ = 47 * MiB, WS_WUKV = 49 * MiB, WS_WO = 51 * MiB, WS_WGU = 59 * MiB, WS_WDN = 103 * MiB;
constexpr size_t WS_H = 128 * MiB;
constexpr size_t WS_QR = 256 * MiB, WS_KR = 320 * MiB, WS_VR = 384 * MiB, WS_GR = 448 * MiB;
constexpr size_t WS_CQ = 512 * MiB, WS_CKV = 544 * MiB;
constexpr size_t WS_QM = 576 * MiB, WS_KB = 672 * MiB, WS_VM = 768 * MiB, WS_OAT = 832 * MiB, WS_END = 896 * MiB;
constexpr size_t WS_CAT = 576 * MiB;
constexpr size_t WS_AFF = 256 * MiB;
static_assert(WS_AFF + (size_t)T * DFF * 2 <= WS_END && WS_CAT + (size_t)T * 2048 * 2 <= WS_VM, "d_ws map");
constexpr int LDS_BAR_OFF = 150528;
constexpr size_t OFF_XBAR = 1536 * 1024;
constexpr int LDS_BYTES = 150528 + 64;

#define LDS_WAIT() asm volatile("s_waitcnt lgkmcnt(0)" ::: "memory")
__device__ __forceinline__ unsigned f2bf(float f) { unsigned u = __builtin_bit_cast(unsigned, f); return (u + 0x7fffu + ((u >> 16) & 1u)) >> 16; }
__device__ __forceinline__ unsigned pk2(float lo, float hi) { return f2bf(lo) | (f2bf(hi) << 16); }
__device__ __forceinline__ unsigned pk2a(float lo, float hi) { return pg8::coarse2(pk2(lo, hi)); }
__device__ __forceinline__ float wave_sum(float v) {
#pragma unroll
    for (int o = 1; o < 64; o <<= 1) v += __shfl_xor(v, o);
    return v;
}
__device__ __forceinline__ int dest_row(int mapid, int n) {
    switch (mapid) {
    case 1: if (n < 2048) { const int j = n & 127; return (n & ~127) + (j < 64 ? 2 * j : 2 * (j - 64) + 1); }
            if (n < 5120) return n;
            { const int j = n - 5120; return 5120 + (j < 32 ? 2 * j : 2 * (j - 32) + 1); }
    case 2: { const int d = n % 192; if (d < 128) return n; const int j = d - 128; return n - d + 128 + (j < 32 ? 2 * j : 2 * (j - 32) + 1); }
    case 3: return (n >> 7) * 256 + (n & 127);
    case 4: return (n >> 7) * 256 + 128 + (n & 127);
    default: return n;
    }
}
__device__ __forceinline__ void transpose_item(const float* __restrict__ W, int K, int N, bf16_t* __restrict__ WT, const float* __restrict__ kscale, int mapid, LAS float* scr, int item, int lane) {
    const int nblk = N / 32, kb = item / nblk, nb = item % nblk, k0 = 64 * kb, n0 = 32 * nb;
#pragma unroll 8
    for (int i = 0; i < 32; ++i) { const int kk = 2 * i + (lane >> 5); float v = W[(size_t)(k0 + kk) * N + n0 + (lane & 31)]; if (kscale) v *= kscale[k0 + kk]; scr[kk * 33 + (lane & 31)] = v; }
    LDS_WAIT(); asm volatile("" ::: "memory");
    const int c = lane & 7;
#pragma unroll
    for (int j = 0; j < 4; ++j) { const int n = (lane >> 3) + 8 * j; const LAS float* s = scr + (8 * c) * 33 + n;
        v4u o; o.x = pk2(s[0 * 33], s[1 * 33]); o.y = pk2(s[2 * 33], s[3 * 33]); o.z = pk2(s[4 * 33], s[5 * 33]); o.w = pk2(s[6 * 33], s[7 * 33]);
        *(v4u*)(WT + (size_t)dest_row(mapid, n0 + n) * K + k0 + 8 * c) = o; }
    LDS_WAIT(); asm volatile("" ::: "memory");
}
__device__ __forceinline__ void norm_row(const float* xrow, const float* __restrict__ w, const float* __restrict__ shift, const float* __restrict__ scale, bf16_t* ob, float* of, int lane) {
    const f32x4* xr = (const f32x4*)xrow + lane;
    f32x4 v[8]; float s = 0.f;
#pragma unroll
    for (int j = 0; j < 8; ++j) { v[j] = xr[64 * j]; s += (v[j].x * v[j].x + v[j].y * v[j].y) + (v[j].z * v[j].z + v[j].w * v[j].w); }
    const float rstd = rsqrtf(wave_sum(s) * (1.f / 2048.f) + 1e-6f);
#pragma unroll
    for (int j = 0; j < 8; ++j) { const int col = 4 * lane + 256 * j; f32x4 y = v[j] * rstd * *(const f32x4*)(w + col);
        if (shift) y = y * (*(const f32x4*)(scale + col) + 1.f) + *(const f32x4*)(shift + col);
        if (ob) { v2u o; o.x = pk2a(y.x, y.y); o.y = pk2a(y.z, y.w); *(v2u*)(ob + col) = o; } else *(f32x4*)(of + col) = y; }
}
__device__ __forceinline__ void norm_row2(const float* xa, const float* __restrict__ w, const float* __restrict__ shifta, const float* __restrict__ scalea, bf16_t* oba, float* ofa, int lane) {
    const float* shiftb = shifta; const float* scaleb = scalea; bf16_t* obb = oba + 2048; float* ofb = ofa + 2048;
    const f32x4* ra = (const f32x4*)xa + lane; const f32x4* rb = ra + 512;
    f32x4 va[8], vb[8]; float sa = 0.f, sb = 0.f;
#pragma unroll
    for (int j = 0; j < 8; ++j) va[j] = ra[64 * j];
#pragma unroll
    for (int j = 0; j < 8; ++j) vb[j] = rb[64 * j];
#pragma unroll
    for (int j = 0; j < 8; ++j) { sa += (va[j].x * va[j].x + va[j].y * va[j].y) + (va[j].z * va[j].z + va[j].w * va[j].w); sb += (vb[j].x * vb[j].x + vb[j].y * vb[j].y) + (vb[j].z * vb[j].z + vb[j].w * vb[j].w); }
    const float rsa = rsqrtf(wave_sum(sa) * (1.f / 2048.f) + 1e-6f), rsb = rsqrtf(wave_sum(sb) * (1.f / 2048.f) + 1e-6f);
#pragma unroll
    for (int j = 0; j < 8; ++j) { const int col = 4 * lane + 256 * j; const f32x4 wv = *(const f32x4*)(w + col); f32x4 ya = va[j] * rsa * wv, yb = vb[j] * rsb * wv;
        if (shifta) { ya = ya * (*(const f32x4*)(scalea + col) + 1.f) + *(const f32x4*)(shifta + col); yb = yb * (*(const f32x4*)(scaleb + col) + 1.f) + *(const f32x4*)(shiftb + col); }
        if (oba) { v2u o; o.x = pk2a(ya.x, ya.y); o.y = pk2a(ya.z, ya.w); *(v2u*)(oba + col) = o; o.x = pk2a(yb.x, yb.y); o.y = pk2a(yb.z, yb.w); *(v2u*)(obb + col) = o; }
        else { *(f32x4*)(ofa + col) = ya; *(f32x4*)(ofb + col) = yb; } }
}

#define XB_TMO      128
#define XB_XCNT(j)  (256  + 64 * (j))
#define XB_XSUB(j)  (1280 + 64 * (j))
#define XB_XGEN(j)  (2304 + 64 * (j))
#define XB_TOP      3328
#define XB_TOPGEN   3392
#define XCD_BAR_WORDS 3456
#define XB_SPIN_CAP (1u << 18)

__device__ __forceinline__ unsigned xb_ld(unsigned* p)              { return __hip_atomic_load(p, __ATOMIC_RELAXED, __HIP_MEMORY_SCOPE_AGENT); }
__device__ __forceinline__ unsigned xb_add(unsigned* p, unsigned v) { return __hip_atomic_fetch_add(p, v, __ATOMIC_RELAXED, __HIP_MEMORY_SCOPE_AGENT); }
__device__ __forceinline__ unsigned xb_xcc_id() { return (unsigned)__builtin_amdgcn_s_getreg((3 << 11) | 20) & 0xFu; }
#define XB_SPIN(cond, bar) do { unsigned _sp = 0; while (cond) { __builtin_amdgcn_s_sleep(1); \
    if ((++_sp & 255u) == 0u) { if (xb_ld(&(bar)[XB_TMO])) break; if (_sp > XB_SPIN_CAP) { atomicAdd(&(bar)[XB_TMO], 1u); break; } } } } while (0)

struct XcdBarrier {
    unsigned* bar; unsigned x;
    volatile LAS unsigned* st;
};

__device__ __forceinline__ XcdBarrier xcd_barrier_post(unsigned* bar, volatile LAS unsigned* st) {
    XcdBarrier b; b.bar = bar; b.x = xb_xcc_id(); b.st = st;
    if (threadIdx.x == 0) (void)xb_add(&bar[XB_XCNT(b.x)], 1u);
    return b;
}
__device__ __forceinline__ void xcd_barrier_complete(unsigned* bar, unsigned x, unsigned& nloc, unsigned& nx) {
    const unsigned G = gridDim.x * gridDim.y * gridDim.z;
    unsigned sum, cnt, mine, sp = 0u;
    for (;;) {
        sum = 0u; cnt = 0u; mine = 0u;
#pragma unroll
        for (unsigned j = 0; j < 16; ++j) { const unsigned c = xb_ld(&bar[XB_XCNT(j)]); sum += c; cnt += (c > 0u) ? 1u : 0u; mine = (j == x) ? c : mine; }
        if (sum == G) break;
        __builtin_amdgcn_s_sleep(1);
        if ((++sp & 255u) == 0u) { if (xb_ld(&bar[XB_TMO])) break; if (sp > XB_SPIN_CAP) { atomicAdd(&bar[XB_TMO], 1u); break; } }
    }
    nloc = mine > 0u ? mine : 1u; nx = cnt > 0u ? cnt : 1u;
}

__device__ __forceinline__ void xcd_barrier(const XcdBarrier& b) {
    asm volatile("s_waitcnt vmcnt(0)" ::: "memory");
    __syncthreads();
    if (threadIdx.x == 0) {
        unsigned* bar = b.bar;
        __builtin_amdgcn_s_waitcnt(0);
        unsigned nloc = b.st[0], nx = b.st[1];
        if (nloc == 0u) { xcd_barrier_complete(bar, b.x, nloc, nx); b.st[0] = nloc; b.st[1] = nx; }
        const unsigned old = xb_add(&bar[XB_XSUB(b.x)], 1u);
        const unsigned gen = old / nloc;
        if (old + 1u == (gen + 1u) * nloc) {
            __builtin_amdgcn_fence(__ATOMIC_RELEASE, "agent");
            asm volatile("s_waitcnt vmcnt(0)" ::: "memory");
            const unsigned og = xb_add(&bar[XB_TOP], 1u);
            const unsigned tg = og / nx;
            if (og + 1u == (tg + 1u) * nx) xb_add(&bar[XB_TOPGEN], 1u);
            else XB_SPIN(xb_ld(&bar[XB_TOPGEN]) == tg, bar);
            __builtin_amdgcn_fence(__ATOMIC_ACQUIRE, "agent");
            xb_add(&bar[XB_XGEN(b.x)], 1u);
            asm volatile("s_waitcnt vmcnt(0)" ::: "memory");
        } else {
            XB_SPIN(xb_ld(&bar[XB_XGEN(b.x)]) == gen, bar);
            __builtin_amdgcn_fence(__ATOMIC_ACQUIRE, "agent");
            asm volatile("s_waitcnt vmcnt(0)" ::: "memory");
        }
    }
    __syncthreads();
}

struct Args { const float* in[21]; float* out; unsigned char* ws; float inv_r[64]; float inv_m[32]; int ph_lo, ph_hi; };
static_assert(sizeof(Args) == 21 * 8 + 16 + 96 * 4 + 8, "Args has no padding");

__global__ void __launch_bounds__(512, 2) mk_fwd(Args a) {
    extern __shared__ __attribute__((aligned(16))) unsigned char smem[];
    cg::grid_group grid = cg::this_grid();
    const int tid = threadIdx.x, lane = tid & 63, wave = __builtin_amdgcn_readfirstlane(tid >> 6);
    const int G = gridDim.x, bx = blockIdx.x, vcu = (G % 8 == 0) ? (bx % 8) * (G / 8) + bx / 8 : bx;
    const int gw = vcu * 8 + wave, NGW = G * 8;
    LAS unsigned char* lds3 = (LAS unsigned char*)smem; char* ldsg = (char*)smem; const int ldsaddr = (int)(unsigned)(uintptr_t)lds3;
    float* out = a.out;
#define WSB() size_t wz_ = 0; asm volatile("" : "+s"(wz_)); unsigned char* ws = a.ws + wz_
#define INP(name, k) const float* name = a.in[k] + wz_
#define WSF(name, off) float* name = (float*)(ws + (off))
#define WSH(name, off) bf16_t* name = (bf16_t*)(ws + (off))
    const int lo = a.ph_lo, hi = a.ph_hi;
    if (tid < 16) ((LAS unsigned*)(lds3 + LDS_BAR_OFF))[tid] = 0u;
    __syncthreads();
    XcdBarrier xbar = xcd_barrier_post((unsigned*)(a.ws + WS_CTL + OFF_XBAR), (volatile LAS unsigned*)(lds3 + LDS_BAR_OFF));
#ifndef PH_MASK
#define PH_MASK 0x7ff
#endif
#define IN(k) (((PH_MASK >> (k)) & 1) && lo <= (k) && (k) < hi)
#define SEAM(k) do { if (IN(k) && IN((k) + 1)) { asm volatile("s_waitcnt vmcnt(0) lgkmcnt(0)" ::: "memory"); grid.sync(); \
    __builtin_amdgcn_fence(__ATOMIC_ACQUIRE, "agent"); asm volatile("s_waitcnt vmcnt(0)" ::: "memory"); } } while (0)
#define SEAMX(k) do { if (IN(k) && IN((k) + 1)) xcd_barrier(xbar); } while (0)

    if (IN(0)) {
        WSB(); WSF(mod, WS_CTL + OFF_MOD); WSF(cosr, WS_COSR); WSF(sinr, WS_SINR); WSF(cosm, WS_COSM); WSF(sinm, WS_SINM);
        WSH(Win, WS_WIN); WSH(Wuq, WS_WUQ); WSH(Wukv, WS_WUKV); WSH(Wo, WS_WO); WSH(Wgu, WS_WGU); WSH(Wdn, WS_WDN);
        INP(cin, 1); INP(ada_w, 3); INP(ada_b, 4); INP(w_in, 6); INP(mla_q_norm_w, 10); INP(w_uq, 11); INP(mla_kv_norm_w, 12); INP(w_ukv, 13); INP(w_o, 15); INP(w_gate, 17); INP(w_up, 18); INP(w_down, 19);
        const int* positions = (const int*)a.in[2] + wz_;
        {
            LAS float* cs = (LAS float*)lds3;
            for (int i = tid; i < 8 * 2048; i += 512) { const int b = i >> 11, k = i & 2047; const float v = cin[i]; cs[k * 8 + b] = v / (1.f + __expf(-v)); }
            __syncthreads();
            for (int task = gw; task < 192 * 16; task += NGW) { const int cb = task % 192, ks = task / 192, col = cb * 64 + lane;
                float acc[8]; const float bias = ks == 0 ? ada_b[col] : 0.f;
#pragma unroll
                for (int b = 0; b < 8; ++b) acc[b] = bias;
                const float* wp = ada_w + (size_t)(ks * 128) * NMODC + col;
                for (int k8 = 0; k8 < 128; k8 += 8) { float wv[8];
#pragma unroll
                    for (int i = 0; i < 8; ++i) wv[i] = wp[(size_t)(k8 + i) * NMODC];
#pragma unroll
                    for (int i = 0; i < 8; ++i) { const LAS f32x4* c4 = (const LAS f32x4*)(cs + (ks * 128 + k8 + i) * 8); const f32x4 c0 = c4[0], c1 = c4[1];
                        acc[0] += c0.x * wv[i]; acc[1] += c0.y * wv[i]; acc[2] += c0.z * wv[i]; acc[3] += c0.w * wv[i]; acc[4] += c1.x * wv[i]; acc[5] += c1.y * wv[i]; acc[6] += c1.z * wv[i]; acc[7] += c1.w * wv[i]; } }
#pragma unroll
                for (int b = 0; b < 8; ++b) atomicAdd(mod + (size_t)b * NMODC + col, acc[b]); }
            __syncthreads();
        }
        {
            LAS float* scr = (LAS float*)(lds3 + wave * 16384);
            constexpr int I_IN = 32 * (INC / 32), I_UQ = 8 * 48, I_UKV = 8 * 64, I_O = 32 * 64, I_G = 32 * (DFF / 32), I_D = (DFF / 64) * 64;
            constexpr int NITEMS = I_IN;
            for (int it = gw; it < NITEMS; it += NGW) { int r = it;
                if (r < I_IN) { transpose_item(w_in, 2048, INC, Win, nullptr, 1, scr, r, lane); continue; } r -= I_IN;
                (void)I_D; (void)I_UQ; (void)I_UKV; (void)I_O; (void)r; }
            for (int i = bx * 512 + tid; i < (INCP - INC) * 2048 / 8; i += G * 512) *(v4u*)(Win + (size_t)INC * 2048 + (size_t)i * 8) = (v4u){0u, 0u, 0u, 0u};
        }
        {
            for (int i = bx * 512 + tid; i < T * 96; i += G * 512) { const int t = i / 96, j = i % 96; const float pos = (float)positions[t];
                const float inv = j < 64 ? a.inv_r[j] : a.inv_m[j - 64]; const float ang = pos * inv;
                double rev = (double)ang * 0.15915494309189535; rev -= __builtin_rint(rev);
                const double qd = __builtin_rint(rev * 4.0); const double y = (rev - qd * 0.25) * 6.283185307179586; const double y2 = y * y;
                const double sy = y * (1.0 + y2 * (-1.0 / 6 + y2 * (1.0 / 120 + y2 * (-1.0 / 5040 + y2 * (1.0 / 362880 + y2 * (-1.0 / 39916800 + y2 * (1.0 / 6227020800.0)))))));
                const double cy = 1.0 + y2 * (-0.5 + y2 * (1.0 / 24 + y2 * (-1.0 / 720 + y2 * (1.0 / 40320 + y2 * (-1.0 / 3628800 + y2 * (1.0 / 479001600.0 + y2 * (-1.0 / 87178291200.0)))))));
                const int qi = (int)qd & 3;
                const float cv = (float)(qi == 0 ? cy : qi == 1 ? -sy : qi == 2 ? -cy : sy), sv = (float)(qi == 0 ? sy : qi == 1 ? cy : qi == 2 ? -sy : -cy);
                if (j < 64) { cosr[(size_t)t * 64 + j] = cv; sinr[(size_t)t * 64 + j] = sv; } else { cosm[(size_t)t * 32 + j - 64] = cv; sinm[(size_t)t * 32 + j - 64] = sv; } }
        }
    }
    SEAMX(0);
    if (a.ph_hi > 1000) { SEAM(0); }
    if (IN(1)) { WSB(); WSF(mod, WS_CTL + OFF_MOD); WSH(H, WS_H); INP(x, 0); INP(norm1_w, 5);
        for (int m = 2 * gw; m < T; m += 2 * NGW) { const int b = m >> 12;
            norm_row2(x + (size_t)m * DM, norm1_w, mod + (size_t)b * NMODC, mod + (size_t)b * NMODC + DM, H + (size_t)m * DM, nullptr, lane); } }
    SEAMX(1);
    if (IN(2)) {
        WSB(); WSH(H, WS_H); WSH(Win, WS_WIN); WSH(Qr, WS_QR); WSH(Kr, WS_KR); WSH(Vr, WS_VR); WSH(Gr, WS_GR); WSH(CQ, WS_CQ); WSH(CKV, WS_CKV); WSH(Kbuf, WS_KB);
        WSF(cosr, WS_COSR); WSF(sinr, WS_SINR); WSF(cosm, WS_COSM); WSF(sinm, WS_SINM); WSF(ssq_q, WS_CTL + OFF_SSQQ); WSF(ssq_kv, WS_CTL + OFF_SSQKV);
        pg8::Gemm g{H, Win, T, INCP, DM}; pg8::StaticOrder S; S.init(T, INCP, G, bx);
        pg8::EpiIn E{Qr, Kr, Vr, Gr, CQ, CKV, Kbuf, cosr, sinr, cosm, sinm, ssq_q, ssq_kv};
        pg8::gemm_phase<pg8::EpiIn, pg8::StaticOrder, true, true>(lds3, g, S, E);
        {
            constexpr int I_G = 32 * (DFF / 32); const int first = ((T / 256) * (INCP / 256)) % G, nsw = (G - first) * 8;
            if (bx >= first) { WSH(Wgu, WS_WGU); INP(w_gate, 17); INP(w_up, 18); LAS float* scr = (LAS float*)(lds3 + wave * 16384); const int wi = (bx - first) * 8 + wave;
                constexpr int I_D = (DFF / 64) * 64; WSH(Wdn, WS_WDN); INP(w_down, 19);
                constexpr int I_UQ = 8 * 48, I_UKV = 8 * 64, I_O = 32 * 64; WSH(Wuq, WS_WUQ); WSH(Wukv, WS_WUKV); WSH(Wo, WS_WO); INP(mla_q_norm_w, 10); INP(w_uq, 11); INP(mla_kv_norm_w, 12); INP(w_ukv, 13); INP(w_o, 15);
                for (int it = wi; it < I_UQ + I_UKV + I_O + 2 * I_G + I_D; it += nsw) { int r = it;
                    if (r < I_UQ) { transpose_item(w_uq, 512, 1536, Wuq, mla_q_norm_w, 2, scr, r, lane); continue; } r -= I_UQ;
                    if (r < I_UKV) { transpose_item(w_ukv, 512, 2048, Wukv, mla_kv_norm_w, 0, scr, r, lane); continue; } r -= I_UKV;
                    if (r < I_O) { transpose_item(w_o, 2048, 2048, Wo, nullptr, 0, scr, r, lane); continue; } r -= I_O;
                    if (r < I_G) { transpose_item(w_gate, 2048, DFF, Wgu, nullptr, 3, scr, r, lane); continue; } r -= I_G;
                    if (r < I_G) { transpose_item(w_up, 2048, DFF, Wgu, nullptr, 4, scr, r, lane); continue; } r -= I_G;
                    transpose_item(w_down, DFF, 2048, Wdn, nullptr, 0, scr, r, lane); } }
        }
    }
    SEAMX(2);
    if (IN(3)) {
        WSB(); WSH(CQ, WS_CQ); WSH(CKV, WS_CKV); WSH(Wuq, WS_WUQ); WSH(Wukv, WS_WUKV); WSH(Qm, WS_QM); WSH(Kbuf, WS_KB); WSH(Vm, WS_VM); WSH(Kr, WS_KR); WSH(Vr, WS_VR); WSH(CK, WS_H);
        WSF(cosm, WS_COSM); WSF(sinm, WS_SINM); WSF(ssq_q, WS_CTL + OFF_SSQQ); WSF(ssq_kv, WS_CTL + OFF_SSQKV); INP(ret_decay, 7);
        { pg8::Gemm g{CQ, Wuq, T, 1536, 512}; pg8::StaticOrder S; S.init(T, 1536, G, bx); pg8::EpiUpQ E{ssq_q, Qm, cosm, sinm};
          pg8::gemm_phase<pg8::EpiUpQ, pg8::StaticOrder, true, true>(lds3, g, S, E); }
        { pg8::Gemm g{CKV, Wukv, T, 2048, 512}; pg8::StaticOrder S; S.init(T, 2048, G, bx); pg8::EpiUpKV E{ssq_kv, Kbuf, Vm};
          pg8::gemm_phase<pg8::EpiUpKV, pg8::StaticOrder, true, true>(lds3, g, S, E); }
        for (int u = vcu; u < 2048; u += G) { const int n = u & 31, h = (u >> 5) & 7, b = u >> 8; const size_t t0 = (size_t)b * SEQ + n * 128;
            const float lgf = -__expf(ret_decay[h]) * 1.4426950408889634f, lgb = -__expf(ret_decay[8 + h]) * 1.4426950408889634f;
            att::chunk_kv_unit(Kr + t0 * 1024 + h * 128, Vr + t0 * 1024 + h * 128, CK + ((size_t)(b * 8 + h) * 32 + n) * 16384, CK + ((size_t)(64 + b * 8 + h) * 32 + n) * 16384, lgf, lgb, ldsg, ldsaddr); }
        __syncthreads();
    }
    SEAMX(3);
    if (IN(4)) {
        WSB(); WSH(Qm, WS_QM); WSH(Kbuf, WS_KB); WSH(Vm, WS_VM); WSH(Oat, WS_OAT); WSH(CK, WS_H); INP(ret_decay, 7);
        for (int u = vcu; u < 1024; u += G) { const int qb = u & 15, h = (u >> 4) & 7, b = u >> 7; const size_t r0 = (size_t)b * SEQ;
            att::attn_unit(Qm + (r0 + qb * 256) * 1536 + h * 192, Kbuf + r0 * 1536 + h * 192, Vm + r0 * 1024 + h * 128, Oat + (r0 + qb * 256) * 1024 + h * 128, SEQ, ldsg, ldsaddr); }
#ifndef NO_SCAN
        for (int idx = bx * 512 + tid; idx < 2 * 64 * 2048; idx += G * 512) { const int dir = idx >> 17, bh = (idx >> 11) & 63, e8 = idx & 2047, h = bh & 7;
            const float cd = __builtin_amdgcn_exp2f(-__expf(ret_decay[dir * 8 + h]) * 1.4426950408889634f * 128.f);
            bf16_t* base = CK + ((size_t)(dir * 64 + bh) * 32) * 16384 + e8 * 8; float st[8];
#pragma unroll
            for (int i = 0; i < 8; ++i) st[i] = 0.f;
            for (int s8 = 0; s8 < 32; s8 += 8) { v4u kv[8];
#pragma unroll
                for (int i = 0; i < 8; ++i) { const int m = dir ? 31 - (s8 + i) : s8 + i; kv[i] = *(const v4u*)(base + (size_t)m * 16384); }
#pragma unroll
                for (int i = 0; i < 8; ++i) { const int m = dir ? 31 - (s8 + i) : s8 + i; v4u o;
                    o.x = pk2a(st[0], st[1]); o.y = pk2a(st[2], st[3]); o.z = pk2a(st[4], st[5]); o.w = pk2a(st[6], st[7]);
                    *(v4u*)(base + (size_t)m * 16384) = o;
#pragma unroll
                    for (int q = 0; q < 4; ++q) { const unsigned w = kv[i][q]; st[2 * q] = st[2 * q] * cd + __uint_as_float(w << 16); st[2 * q + 1] = st[2 * q + 1] * cd + __uint_as_float(w & 0xffff0000u); } } }
        }
#endif
    }
    SEAMX(4);
    if (IN(5)) {
        WSB(); WSH(Qr, WS_QR); WSH(Kr, WS_KR); WSH(Vr, WS_VR); WSH(Gr, WS_GR); WSH(CK, WS_H); WSH(Cat, WS_CAT); WSH(Oat, WS_OAT); INP(ret_decay, 7); INP(ret_gn_w, 8); INP(ret_gn_b, 9); INP(mla_out_w, 14);
#if PROBE_BRUTE_RET
        float* dumpb = (float*)(ws + 704 * MiB);
        for (int up = vcu; up < 1024; up += G) {
            if (PROBE_COMP != 0) { const int u = up * 2 + (wave >> 2); const int n = u & 31, h = (u >> 5) & 7, b = u >> 8; const size_t t0 = (size_t)b * SEQ + n * 128;
                const float lgf = -__expf(ret_decay[h]) * 1.4426950408889634f, lgb = -__expf(ret_decay[8 + h]) * 1.4426950408889634f; const int hf = wave >> 2;
                att::ret_out_unit(Qr + t0 * 1024 + h * 128, Kr + t0 * 1024 + h * 128, Vr + t0 * 1024 + h * 128, Gr + t0 * 1024 + h * 128,
                                  CK + ((size_t)(b * 8 + h) * 32 + n) * 16384, CK + ((size_t)(64 + b * 8 + h) * 32 + n) * 16384, ret_gn_w + h * 128, ret_gn_b + h * 128,
                                  Cat + t0 * 2048 + h * 128, lgf, lgb, ldsg + hf * 65536, ldsaddr + hf * 65536, dumpb + t0 * 1024 + h * 128);
                __threadfence(); __syncthreads(); }
            for (int k2 = 0; k2 < 2; ++k2) { const int u = up * 2 + k2; const int n = u & 31, h = (u >> 5) & 7, b = u >> 8; const size_t r0 = (size_t)b * SEQ, t0 = r0 + n * 128;
                const float lgf = -__expf(ret_decay[h]) * 1.4426950408889634f, lgb = -__expf(ret_decay[8 + h]) * 1.4426950408889634f;
                att::ret_brute_unit(Qr + r0 * 1024 + h * 128, Kr + r0 * 1024 + h * 128, Vr + r0 * 1024 + h * 128, Gr + t0 * 1024 + h * 128, ret_gn_w + h * 128, ret_gn_b + h * 128, Cat + t0 * 2048 + h * 128, n * 128, lgf, lgb, ldsg, dumpb + t0 * 1024 + h * 128); } }
        __syncthreads();
        for (int up = vcu; up < 0; up += G) { const int u = up * 2 + (wave >> 2);
#else
        for (int up = vcu; up < 1024; up += G) { const int u = up * 2 + (wave >> 2);
#endif
            const int n = u & 31, h = (u >> 5) & 7, b = u >> 8; const size_t t0 = (size_t)b * SEQ + n * 128;
            const float lgf = -__expf(ret_decay[h]) * 1.4426950408889634f, lgb = -__expf(ret_decay[8 + h]) * 1.4426950408889634f; const int hf = wave >> 2;
            att::ret_out_unit(Qr + t0 * 1024 + h * 128, Kr + t0 * 1024 + h * 128, Vr + t0 * 1024 + h * 128, Gr + t0 * 1024 + h * 128,
                              CK + ((size_t)(b * 8 + h) * 32 + n) * 16384, CK + ((size_t)(64 + b * 8 + h) * 32 + n) * 16384, ret_gn_w + h * 128, ret_gn_b + h * 128,
                              Cat + t0 * 2048 + h * 128, lgf, lgb, ldsg + hf * 65536, ldsaddr + hf * 65536); }
        for (int m = 4 * gw; m < T; m += 4 * NGW) {
            v4u raw[4][2]; float ss[4];
#pragma unroll
            for (int r = 0; r < 4; ++r)
#pragma unroll
                for (int j = 0; j < 2; ++j) raw[r][j] = *(const v4u*)(Oat + (size_t)(m + r) * 1024 + lane * 8 + 512 * j);
#pragma unroll
            for (int r = 0; r < 4; ++r) { float sq = 0.f;
#pragma unroll
                for (int j = 0; j < 2; ++j)
#pragma unroll
                    for (int q = 0; q < 4; ++q) { const float a = __uint_as_float(raw[r][j][q] << 16), b = __uint_as_float(raw[r][j][q] & 0xffff0000u); sq += a * a + b * b; }
                ss[r] = sq; }
#pragma unroll
            for (int r = 0; r < 4; ++r) ss[r] = rsqrtf(wave_sum(ss[r]) * (1.f / 1024.f) + 1e-6f);
#pragma unroll
            for (int j = 0; j < 2; ++j) { const int col = lane * 8 + 512 * j; const f32x4 w0 = *(const f32x4*)(mla_out_w + col), w1 = *(const f32x4*)(mla_out_w + col + 4);
#pragma unroll
                for (int r = 0; r < 4; ++r) { const float rstd = ss[r]; const v4u w = raw[r][j]; v4u o;
                    o.x = pk2a(__uint_as_float(w.x << 16) * rstd * w0.x, __uint_as_float(w.x & 0xffff0000u) * rstd * w0.y); o.y = pk2a(__uint_as_float(w.y << 16) * rstd * w0.z, __uint_as_float(w.y & 0xffff0000u) * rstd * w0.w);
                    o.z = pk2a(__uint_as_float(w.z << 16) * rstd * w1.x, __uint_as_float(w.z & 0xffff0000u) * rstd * w1.y); o.w = pk2a(__uint_as_float(w.w << 16) * rstd * w1.z, __uint_as_float(w.w & 0xffff0000u) * rstd * w1.w);
                    *(v4u*)(Cat + (size_t)(m + r) * 2048 + 1024 + col) = o; } } }
        __syncthreads();
    }
    SEAMX(5);
    if (IN(6)) {
        WSB(); WSH(Cat, WS_CAT); WSH(Wo, WS_WO); WSF(mod, WS_CTL + OFF_MOD); INP(x, 0);
        pg8::Gemm g{Cat, Wo, T, 2048, 2048}; pg8::StaticOrder S; S.init(T, 2048, G, bx); pg8::EpiGateRes E{x, mod + 2 * DM, out};
        pg8::gemm_phase<pg8::EpiGateRes, pg8::StaticOrder, true, true>(lds3, g, S, E);
    }
    SEAMX(6);
    if (IN(7)) { WSB(); WSF(mod, WS_CTL + OFF_MOD); WSH(H, WS_H); INP(norm2_w, 16);
        for (int m = 2 * gw; m < T; m += 2 * NGW) { const int b = m >> 12;
            norm_row2(out + (size_t)m * DM, norm2_w, mod + (size_t)b * NMODC + 3 * DM, mod + (size_t)b * NMODC + 4 * DM, H + (size_t)m * DM, nullptr, lane); } }
    SEAMX(7);
    if (IN(8)) {
        WSB(); WSH(H, WS_H); WSH(Wgu, WS_WGU); WSH(Aff, WS_AFF);
        pg8::Gemm g{H, Wgu, T, 2 * DFF, DM}; pg8::StaticOrder S; S.init(T, 2 * DFF, G, bx); pg8::EpiGU E{Aff};
        pg8::gemm_phase<pg8::EpiGU, pg8::StaticOrder, true, true>(lds3, g, S, E);
    }
    SEAMX(8);
    if (IN(9)) {
        WSB(); WSH(Aff, WS_AFF); WSH(Wdn, WS_WDN); WSF(mod, WS_CTL + OFF_MOD);
        pg8::Gemm g{Aff, Wdn, T, 2048, DFF}; pg8::StaticOrder S; S.init(T, 2048, G, bx); pg8::EpiGateRes E{out, mod + 5 * DM, out};
        pg8::gemm_phase<pg8::EpiGateRes, pg8::StaticOrder, true, true>(lds3, g, S, E);
    }
    SEAMX(9);
    if (IN(10)) { WSB(); (void)ws; INP(final_norm_w, 20);
        for (int m = 2 * gw; m < T; m += 2 * NGW) norm_row2(out + (size_t)m * DM, final_norm_w, nullptr, nullptr, nullptr, out + (size_t)m * DM, lane); }
#undef IN
#undef SEAM
}

extern "C" void kernel_launch(void* const* d_in, const int* in_sizes, int n_in, void* d_out, int out_size, void* d_ws, size_t ws_size, hipStream_t stream) {
    static int grid = 0;
    if (grid == 0) {
        if (n_in != 21 || in_sizes[0] != T * DM || out_size != T * DM || ws_size < WS_END) { fprintf(stderr, "kernel_launch: shape/workspace mismatch (n_in %d, ws %zu < %zu)\n", n_in, ws_size, (size_t)WS_END); grid = -1; return; }
        int dev = 0, cus = 0, per_cu = 0;
        (void)hipGetDevice(&dev); (void)hipDeviceGetAttribute(&cus, hipDeviceAttributeMultiprocessorCount, dev);
        if (hipFuncSetAttribute((const void*)mk_fwd, hipFuncAttributeMaxDynamicSharedMemorySize, LDS_BYTES) != hipSuccess) { fprintf(stderr, "kernel_launch: hipFuncSetAttribute failed\n"); grid = -1; return; }
        if (hipOccupancyMaxActiveBlocksPerMultiprocessor(&per_cu, (const void*)mk_fwd, 512, LDS_BYTES) != hipSuccess || per_cu < 1) { fprintf(stderr, "kernel_launch: occupancy query gave %d\n", per_cu); per_cu = 1; }
        (void)hipGetLastError();
        grid = cus * per_cu;
    }
    if (grid < 0) return;
    (void)hipMemsetAsync((char*)d_ws + WS_CTL, 0, CTL_ZERO_BYTES, stream);
    Args a{};
    for (int i = 0; i < 21; ++i) a.in[i] = (const float*)d_in[i];
    a.out = (float*)d_out; a.ws = (unsigned char*)d_ws;
    for (int i = 0; i < 64; ++i) a.inv_r[i] = powf(10000.0f, -((float)(2 * i)) / 128.0f);
    for (int i = 0; i < 32; ++i) a.inv_m[i] = powf(10000.0f, -((float)(2 * i)) / 64.0f);
#if MK_SPLIT
    for (int p = 0; p < NPH; ++p) { a.ph_lo = p; a.ph_hi = p + 1; hipLaunchKernelGGL(mk_fwd, dim3(grid), dim3(512), LDS_BYTES, stream, a); }
#else
    a.ph_lo = 0; a.ph_hi = NPH;
    void* args[] = {&a};
    hipError_t e = hipLaunchCooperativeKernel((const void*)mk_fwd, dim3(grid), dim3(512), args, LDS_BYTES, stream);
    if (e != hipSuccess) fprintf(stderr, "kernel_launch: cooperative launch failed: %s (grid %d)\n", hipGetErrorString(e), grid);
#endif
}
```

```cpp
#include <hip/hip_runtime.h>
#include <hip/hip_cooperative_groups.h>
#include <cstdio>
#include <cstdint>
#include <cmath>
namespace cg = cooperative_groups;
namespace pg8 {
#define PG8_LAS __attribute__((address_space(3)))
typedef unsigned short bf16_t;
typedef short bf16x8 __attribute__((ext_vector_type(8)));
typedef float f32x4 __attribute__((ext_vector_type(4)));
typedef unsigned u32x4 __attribute__((ext_vector_type(4)));
constexpr int BM = 256, BK = 64, HALF = 128, HTB = HALF * BK * 2  , STAGE_BYTES = 8 * HTB, NXCD = 8, WGM = 8;

__host__ __device__ __forceinline__ int lds_byte(int r, int c) { const int st = (r >> 4) * 2 + (c >> 5), rr = r & 15, cc = c & 31, ob = rr * 64 + cc * 2; return st * 1024 + (ob ^ (((ob >> 9) & 1) << 5)); }
__host__ __device__ __forceinline__ void stage_rc(int b, int& R, int& C) { const int st = b / 1024, sb = b % 1024, swz = sb ^ (((sb >> 9) & 1) << 5); R = (st >> 1) * 16 + swz / 64; C = (st & 1) * 32 + (swz % 64) / 2; }
__host__ __device__ __forceinline__ int perm32(int rho) { const int n = rho >> 4, i = rho & 15; return 8 * (i >> 2) + 4 * n + (i & 3); }

struct Unit { int pm, pn; };
struct Gemm { const bf16_t* A; const bf16_t* Bt; int M, N, K; };

struct StaticOrder {
    int nM, nN, nwg, G, c;
    __host__ __device__ void init(int M, int N, int G_, int c_) { nM = M / BM; nN = N / BM; nwg = nM * nN; G = G_; c = c_; }
    __host__ __device__ bool next(int i, Unit& u) const {
        const long L = (long)i * G + c; if (L >= nwg) return false;
        int wgid = (int)L; { const int q = nwg / NXCD, r = nwg % NXCD, xcd = wgid % NXCD, off = wgid / NXCD; wgid = (xcd < r ? xcd * (q + 1) : r * (q + 1) + (xcd - r) * q) + off; }
        const int nig = WGM * nN, gid = wgid / nig, fm = gid * WGM, gsz = (nM - fm) < WGM ? (nM - fm) : WGM;
        u.pm = fm + ((wgid % nig) % gsz); u.pn = (wgid % nig) / gsz; return true;
    }
    __device__ __forceinline__ void a_ready(const Unit&) const {}
    __device__ __forceinline__ void done(const Unit&) const {}
};

#ifndef PROBE_COARSE_ACT
#define PROBE_COARSE_ACT 0
#endif
__device__ __forceinline__ unsigned coarse2(unsigned w) { return PROBE_COARSE_ACT ? ((w + ((w >> 1) & 0x00010001u)) & 0xfffefffeu) : w; }
__device__ __forceinline__ unsigned cvt_pk_bf16(float lo, float hi) { unsigned r; asm volatile("v_cvt_pk_bf16_f32 %0, %1, %2" : "=v"(r) : "v"(lo), "v"(hi)); return coarse2(r); }
typedef float f32x2 __attribute__((ext_vector_type(2)));

typedef unsigned u32x2 __attribute__((ext_vector_type(2)));
__device__ __forceinline__ float silu_f(float v) { return v * __builtin_amdgcn_rcpf(1.f + __builtin_amdgcn_exp2f(v * -1.4426950408889634f)); }
__device__ __forceinline__ u32x4 pack8(f32x4 a, f32x4 b) { u32x4 w; w.x = cvt_pk_bf16(a[0], a[1]); w.y = cvt_pk_bf16(a[2], a[3]); w.z = cvt_pk_bf16(b[0], b[1]); w.w = cvt_pk_bf16(b[2], b[3]); return w; }
__device__ __forceinline__ void rope8(f32x4& a, f32x4& b, const f32x4 c, const f32x4 s) {
    float t1, t2;
    t1 = a[0]; t2 = a[1]; a[0] = t1 * c[0] - t2 * s[0]; a[1] = t2 * c[0] + t1 * s[0];
    t1 = a[2]; t2 = a[3]; a[2] = t1 * c[1] - t2 * s[1]; a[3] = t2 * c[1] + t1 * s[1];
    t1 = b[0]; t2 = b[1]; b[0] = t1 * c[2] - t2 * s[2]; b[1] = t2 * c[2] + t1 * s[2];
    t1 = b[2]; t2 = b[3]; b[2] = t1 * c[3] - t2 * s[3]; b[3] = t2 * c[3] + t1 * s[3];
}
constexpr float NORM_EPS = 1e-6f;

struct EpiIn {
    static constexpr bool PERM = true, AFTER_DRAIN = false;
    bf16_t *Qr, *Kr, *Vr, *Gr, *CQ, *CKV, *Kbuf; const float *cosr, *sinr, *cosm, *sinm; float *ssq_q, *ssq_kv;
    __device__ __forceinline__ void operator()(const f32x4 (&acc)[2][2][4][2], const Unit& u, int wr, int wc, int fr, int fq) const {
        const int pn = u.pn, row0 = u.pm * BM + wr * 64 + fr, cl = wc * 32 + 8 * fq;
        if (pn < 8) {
            bf16_t* O = pn < 4 ? Qr : Kr; const float sc = pn < 4 ? 1.f : 0.08838834764831845f; const int colt = (pn & 3) * 256 + cl;
#pragma unroll
            for (int ai = 0; ai < 2; ++ai)
#pragma unroll
                for (int m = 0; m < 4; ++m) { const int row = row0 + ai * HALF + m * 16;
                    const f32x4 c4 = *(const f32x4*)(cosr + (size_t)row * 64 + (cl >> 1)), s4 = *(const f32x4*)(sinr + (size_t)row * 64 + (cl >> 1));
#pragma unroll
                    for (int bj = 0; bj < 2; ++bj) { f32x4 a = acc[ai][bj][m][0], b = acc[ai][bj][m][1]; rope8(a, b, c4, s4); a = a * sc; b = b * sc;
                        *(u32x4*)(O + (size_t)row * 1024 + colt + bj * HALF) = pack8(a, b); } }
        } else if (pn < 16) {
            const bool isg = pn >= 12; bf16_t* O = isg ? Gr : Vr; const int colt = (pn & 3) * 256 + cl;
#pragma unroll
            for (int ai = 0; ai < 2; ++ai)
#pragma unroll
                for (int m = 0; m < 4; ++m) { const int row = row0 + ai * HALF + m * 16;
#pragma unroll
                    for (int bj = 0; bj < 2; ++bj) { f32x4 a = acc[ai][bj][m][0], b = acc[ai][bj][m][1];
                        if (isg) {
#pragma unroll
                            for (int i = 0; i < 4; ++i) { a[i] = silu_f(a[i]); b[i] = silu_f(b[i]); } }
                        *(u32x4*)(O + (size_t)row * 1024 + colt + bj * HALF) = pack8(a, b); } }
        } else if (pn < 20) {
            bf16_t* O = pn < 18 ? CQ : CKV; float* sq = pn < 18 ? ssq_q : ssq_kv; const int colt = (pn & 1) * 256 + cl;
#pragma unroll
            for (int ai = 0; ai < 2; ++ai)
#pragma unroll
                for (int m = 0; m < 4; ++m) { const int row = row0 + ai * HALF + m * 16; float s = 0.f;
#pragma unroll
                    for (int bj = 0; bj < 2; ++bj) { const f32x4 a = acc[ai][bj][m][0], b = acc[ai][bj][m][1];
                        s += (a[0] * a[0] + a[1] * a[1]) + (a[2] * a[2] + a[3] * a[3]) + (b[0] * b[0] + b[1] * b[1]) + (b[2] * b[2] + b[3] * b[3]);
                        *(u32x4*)(O + (size_t)row * 512 + colt + bj * HALF) = pack8(a, b); }
                    s += __shfl_xor(s, 16); s += __shfl_xor(s, 32);
                    if (fq == 0) atomicAdd(sq + row, s); }
        } else {
            if (wc < 2) {
#pragma unroll
                for (int ai = 0; ai < 2; ++ai)
#pragma unroll
                    for (int m = 0; m < 4; ++m) { const int row = row0 + ai * HALF + m * 16;
                        const f32x4 c4 = *(const f32x4*)(cosm + (size_t)row * 32 + (cl >> 1)), s4 = *(const f32x4*)(sinm + (size_t)row * 32 + (cl >> 1));
                        f32x4 a = acc[ai][0][m][0], b = acc[ai][0][m][1]; rope8(a, b, c4, s4); const u32x4 w = pack8(a, b);
#pragma unroll
                        for (int h = 0; h < 8; ++h) *(u32x4*)(Kbuf + (size_t)row * 1536 + h * 192 + 128 + cl) = w; }
            }
        }
    }
};
struct EpiUpQ {
    static constexpr bool PERM = true, AFTER_DRAIN = false;
    const float* ssq; bf16_t* Qm; const float *cosm, *sinm;
    __device__ __forceinline__ void operator()(const f32x4 (&acc)[2][2][4][2], const Unit& u, int wr, int wc, int fr, int fq) const {
        const int row0 = u.pm * BM + wr * 64 + fr, cl = wc * 32 + 8 * fq;
#pragma unroll
        for (int ai = 0; ai < 2; ++ai)
#pragma unroll
            for (int m = 0; m < 4; ++m) { const int row = row0 + ai * HALF + m * 16; const float rstd = rsqrtf(ssq[row] * (1.f / 512.f) + NORM_EPS);
#pragma unroll
                for (int bj = 0; bj < 2; ++bj) { const int c = u.pn * 256 + bj * HALF + cl, d = c % 192; f32x4 a = acc[ai][bj][m][0] * rstd, b = acc[ai][bj][m][1] * rstd;
                    if (d >= 128) { const int fi = (d - 128) >> 1; const f32x4 c4 = *(const f32x4*)(cosm + (size_t)row * 32 + fi), s4 = *(const f32x4*)(sinm + (size_t)row * 32 + fi); rope8(a, b, c4, s4); }
                    *(u32x4*)(Qm + (size_t)row * 1536 + c) = pack8(a, b); } }
    }
};
struct EpiUpKV {
    static constexpr bool PERM = true, AFTER_DRAIN = false;
    const float* ssq; bf16_t *Kbuf, *Vm;
    __device__ __forceinline__ void operator()(const f32x4 (&acc)[2][2][4][2], const Unit& u, int wr, int wc, int fr, int fq) const {
        const int row0 = u.pm * BM + wr * 64 + fr, cl = wc * 32 + 8 * fq;
#pragma unroll
        for (int ai = 0; ai < 2; ++ai)
#pragma unroll
            for (int m = 0; m < 4; ++m) { const int row = row0 + ai * HALF + m * 16; const float rstd = rsqrtf(ssq[row] * (1.f / 512.f) + NORM_EPS);
                *(u32x4*)(Kbuf + (size_t)row * 1536 + u.pn * 192 + cl) = pack8(acc[ai][0][m][0] * rstd, acc[ai][0][m][1] * rstd);
                *(u32x4*)(Vm + (size_t)row * 1024 + u.pn * 128 + cl) = pack8(acc[ai][1][m][0] * rstd, acc[ai][1][m][1] * rstd); }
    }
};
struct EpiGateRes {
    static constexpr bool PERM = true, AFTER_DRAIN = false;
    const float* x; const float* gate; float* out;
    __device__ __forceinline__ void operator()(const f32x4 (&acc)[2][2][4][2], const Unit& u, int wr, int wc, int fr, int fq) const {
        const int row0 = u.pm * BM + wr * 64 + fr, cl = wc * 32 + 8 * fq, b = u.pm >> 4;
#pragma unroll
        for (int bj = 0; bj < 2; ++bj) { const int c = u.pn * 256 + bj * HALF + cl;
            const f32x4 g0 = *(const f32x4*)(gate + (size_t)b * 12288 + c), g1 = *(const f32x4*)(gate + (size_t)b * 12288 + c + 4);
#pragma unroll
            for (int ai = 0; ai < 2; ++ai)
#pragma unroll
                for (int m = 0; m < 4; ++m) { const size_t off = (size_t)(row0 + ai * HALF + m * 16) * 2048 + c;
                    const f32x4 x0 = *(const f32x4*)(x + off), x1 = *(const f32x4*)(x + off + 4);
                    *(f32x4*)(out + off) = x0 + g0 * acc[ai][bj][m][0]; *(f32x4*)(out + off + 4) = x1 + g1 * acc[ai][bj][m][1]; } }
    }
};
struct EpiGU {
    static constexpr bool PERM = true, AFTER_DRAIN = false;
    bf16_t* Aff;
    __device__ __forceinline__ void operator()(const f32x4 (&acc)[2][2][4][2], const Unit& u, int wr, int wc, int fr, int fq) const {
        const int row0 = u.pm * BM + wr * 64 + fr, cl = wc * 32 + 8 * fq;
#pragma unroll
        for (int ai = 0; ai < 2; ++ai)
#pragma unroll
            for (int m = 0; m < 4; ++m) { const int row = row0 + ai * HALF + m * 16; f32x4 a, b;
#pragma unroll
                for (int i = 0; i < 4; ++i) { a[i] = silu_f(acc[ai][0][m][0][i]) * acc[ai][1][m][0][i]; b[i] = silu_f(acc[ai][0][m][1][i]) * acc[ai][1][m][1][i]; }
                *(u32x4*)(Aff + (size_t)row * 5632 + u.pn * 128 + cl) = pack8(a, b); }
    }
};

template <class Epi, class Sched, bool ALIGN_EPI = false, bool SP2 = false>
__device__ __forceinline__ void gemm_phase(PG8_LAS unsigned char* lds, const Gemm g, const Sched& S, const Epi& E) {
    const int tid = threadIdx.x, wid = __builtin_amdgcn_readfirstlane(tid >> 6), lane = tid & 63, wr = wid >> 2, wc = wid & 3, fr = lane & 15, fq = lane >> 4;
    const int K = g.K, nt = K / BK;
    unsigned voffA[2], voffB[2];
#pragma unroll
    for (int i = 0; i < 2; ++i) { int R, C; stage_rc(tid * 16 + i * 8192, R, C); const int Rb = Epi::PERM ? ((R & ~31) + perm32(R & 31)) : R;
        voffA[i] = (unsigned)(R * K + C) * 2u; voffB[i] = (unsigned)(Rb * K + C) * 2u; }
    const size_t kstep = (size_t)(BK * 2);
    const size_t hstep = (size_t)HALF * K * 2;
    const size_t tstep = 2 * hstep;
    const unsigned ldsw = (unsigned)wid * 1024u;
    const int aoff = lds_byte(wr * 64 + fr, fq * 8), boff = lds_byte(wc * 32 + fr, fq * 8);
#define PG8_SA(b, h) (((b) * 2 + (h)) * HTB)
#define PG8_SB(b, h) ((4 + (b) * 2 + (h)) * HTB)
#define PG8_STAGE(bufoff, gbase, voff) do { _Pragma("unroll") for (int _i = 0; _i < 2; ++_i) \
        __builtin_amdgcn_global_load_lds((const unsigned*)((const char*)(gbase) + (voff)[_i]), (PG8_LAS unsigned*)(lds + (bufoff) + ldsw + _i * 8192), 16, 0, 0); } while (0)
#define PG8_LDA(dst, b, h) do { _Pragma("unroll") for (int m = 0; m < 4; ++m) _Pragma("unroll") for (int k = 0; k < 2; ++k) dst[m][k] = *(const PG8_LAS bf16x8*)(lds + PG8_SA(b, h) + aoff + m * 2048 + k * 1024); } while (0)
#define PG8_LDB(dst, b, h) do { _Pragma("unroll") for (int n = 0; n < 2; ++n) _Pragma("unroll") for (int k = 0; k < 2; ++k) dst[n][k] = *(const PG8_LAS bf16x8*)(lds + PG8_SB(b, h) + boff + n * 2048 + k * 1024); } while (0)
#define PG8_MMA(ai, bj, At, Bt) do { __builtin_amdgcn_s_setprio(1); _Pragma("unroll") for (int m = 0; m < 4; ++m) _Pragma("unroll") for (int n = 0; n < 2; ++n) _Pragma("unroll") for (int k = 0; k < 2; ++k) \
        acc[ai][bj][m][n] = __builtin_amdgcn_mfma_f32_16x16x32_bf16(Bt[n][k], At[m][k], acc[ai][bj][m][n], 0, 0, 0); __builtin_amdgcn_s_setprio(0); } while (0)
#define PG8_WAIT_V(n) asm volatile("s_waitcnt vmcnt(" #n ")" ::: "memory")
#define PG8_WAIT_L(n) asm volatile("s_waitcnt lgkmcnt(" #n ")" ::: "memory")
#define PG8_BAR __builtin_amdgcn_s_barrier()
#define PG8_SCHED __builtin_amdgcn_sched_barrier(0)
    Unit cur, nxt; int ui = 0;
    if (!S.next(0, cur)) return;
    f32x4 acc[2][2][4][2];
#pragma unroll
    for (int a = 0; a < 2; ++a)
#pragma unroll
        for (int b = 0; b < 2; ++b)
#pragma unroll
            for (int m = 0; m < 4; ++m)
#pragma unroll
                for (int n = 0; n < 2; ++n) acc[a][b][m][n] = (f32x4){0.f, 0.f, 0.f, 0.f};
    bf16x8 At[4][2], B0[2][2], B1[2][2];
    const char* cA = (const char*)g.A + (size_t)cur.pm * tstep; const char* cB = (const char*)g.Bt + (size_t)cur.pn * tstep;
    S.a_ready(cur);
    if constexpr (SP2) {
        PG8_STAGE(PG8_SB(0, 0), cB, voffB); PG8_STAGE(PG8_SB(0, 1), cB + hstep, voffB); PG8_STAGE(PG8_SA(0, 0), cA, voffA); PG8_STAGE(PG8_SA(0, 1), cA + hstep, voffA);
        if (wr == 1) PG8_BAR;
        PG8_WAIT_V(2); PG8_BAR;
        PG8_STAGE(PG8_SB(1, 0), cB + kstep, voffB); PG8_STAGE(PG8_SA(1, 0), cA + kstep, voffA); PG8_STAGE(PG8_SB(1, 1), cB + hstep + kstep, voffB);
        PG8_WAIT_V(6); PG8_BAR;
    } else {
        PG8_STAGE(PG8_SB(0, 0), cB, voffB); PG8_STAGE(PG8_SA(0, 0), cA, voffA); PG8_STAGE(PG8_SB(0, 1), cB + hstep, voffB); PG8_STAGE(PG8_SA(0, 1), cA + hstep, voffA);
        if (wr == 1) PG8_BAR;
        PG8_WAIT_V(4); PG8_BAR;
        PG8_STAGE(PG8_SB(1, 0), cB + kstep, voffB); PG8_STAGE(PG8_SA(1, 0), cA + kstep, voffA); PG8_STAGE(PG8_SB(1, 1), cB + hstep + kstep, voffB);
        PG8_WAIT_V(6); PG8_BAR;
    }
    for (;;) {
        const bool has_next = S.next(ui + 1, nxt);
        const char* nA = has_next ? (const char*)g.A + (size_t)nxt.pm * tstep : cA; const char* nB = has_next ? (const char*)g.Bt + (size_t)nxt.pn * tstep : cB;
        for (int t = 0; t < nt; t += 2) {
            const bool last = (t == nt - 2);
            const char* a1 = cA + (size_t)(t + 1) * kstep;
            const char* a2 = last ? nA : cA + (size_t)(t + 2) * kstep; const char* b2 = last ? nB : cB + (size_t)(t + 2) * kstep;
            const char* a3 = a2 + kstep; const char* b3 = b2 + kstep;
            if (last && has_next) S.a_ready(nxt);
            if constexpr (SP2) {
            PG8_LDB(B0, 0, 0); PG8_LDB(B1, 0, 1); PG8_SCHED; PG8_LDA(At, 0, 0); PG8_STAGE(PG8_SA(1, 1), a1 + hstep, voffA);
            PG8_WAIT_V(8); PG8_WAIT_L(0); PG8_BAR; PG8_MMA(0, 0, At, B0); PG8_MMA(0, 1, At, B1); PG8_BAR; PG8_SCHED;
            PG8_LDA(At, 0, 1); PG8_STAGE(PG8_SB(0, 0), b2, voffB); PG8_STAGE(PG8_SB(0, 1), b2 + hstep, voffB); PG8_STAGE(PG8_SA(0, 0), a2, voffA);
            PG8_WAIT_V(8); PG8_WAIT_L(0); PG8_BAR; PG8_MMA(1, 0, At, B0); PG8_MMA(1, 1, At, B1); PG8_BAR; PG8_SCHED;
            PG8_LDB(B0, 1, 0); PG8_LDB(B1, 1, 1); PG8_SCHED; PG8_LDA(At, 1, 0); PG8_STAGE(PG8_SA(0, 1), a2 + hstep, voffA);
            PG8_WAIT_V(8); PG8_WAIT_L(0); PG8_BAR; PG8_MMA(0, 0, At, B0); PG8_MMA(0, 1, At, B1); PG8_BAR; PG8_SCHED;
            PG8_LDA(At, 1, 1); PG8_STAGE(PG8_SB(1, 0), b3, voffB); PG8_STAGE(PG8_SB(1, 1), b3 + hstep, voffB); PG8_STAGE(PG8_SA(1, 0), a3, voffA);
            PG8_WAIT_V(8); PG8_WAIT_L(0); PG8_BAR; PG8_MMA(1, 0, At, B0); PG8_MMA(1, 1, At, B1); PG8_BAR; PG8_SCHED;
            } else {
            PG8_LDB(B0, 0, 0); PG8_SCHED; PG8_LDA(At, 0, 0); PG8_STAGE(PG8_SA(1, 1), a1 + hstep, voffA);
            PG8_WAIT_L(8); PG8_BAR; PG8_WAIT_L(0); PG8_MMA(0, 0, At, B0); PG8_BAR; PG8_SCHED;
            PG8_LDB(B1, 0, 1); PG8_STAGE(PG8_SB(0, 0), b2, voffB);
            PG8_BAR; PG8_WAIT_L(0); PG8_MMA(0, 1, At, B1); PG8_BAR;
            PG8_LDA(At, 0, 1); PG8_STAGE(PG8_SA(0, 0), a2, voffA);
            PG8_BAR; PG8_WAIT_L(0); PG8_MMA(1, 0, At, B0); PG8_BAR; PG8_SCHED;
            PG8_STAGE(PG8_SB(0, 1), b2 + hstep, voffB);
            PG8_WAIT_V(6); PG8_BAR; PG8_MMA(1, 1, At, B1); PG8_BAR;
            PG8_LDB(B0, 1, 0); PG8_SCHED; PG8_LDA(At, 1, 0); PG8_STAGE(PG8_SA(0, 1), a2 + hstep, voffA);
            PG8_WAIT_L(8); PG8_BAR; PG8_WAIT_L(0); PG8_MMA(0, 0, At, B0); PG8_BAR; PG8_SCHED;
            PG8_LDB(B1, 1, 1); PG8_STAGE(PG8_SB(1, 0), b3, voffB);
            PG8_BAR; PG8_WAIT_L(0); PG8_MMA(0, 1, At, B1); PG8_BAR;
            PG8_LDA(At, 1, 1); PG8_STAGE(PG8_SA(1, 0), a3, voffA);
            PG8_BAR; PG8_WAIT_L(0); PG8_MMA(1, 0, At, B0); PG8_BAR; PG8_SCHED;
            PG8_STAGE(PG8_SB(1, 1), b3 + hstep, voffB);
            PG8_WAIT_V(6); PG8_BAR; PG8_MMA(1, 1, At, B1); PG8_BAR;
            }
        }
        if constexpr (ALIGN_EPI) { if (wr == 0) PG8_BAR; }
        if constexpr (!Epi::AFTER_DRAIN) { E(acc, cur, wr, wc, fr, fq); S.done(cur); }
        if (!has_next) break;
#pragma unroll
        for (int a = 0; a < 2; ++a)
#pragma unroll
            for (int b = 0; b < 2; ++b)
#pragma unroll
                for (int m = 0; m < 4; ++m)
#pragma unroll
                    for (int n = 0; n < 2; ++n) acc[a][b][m][n] = (f32x4){0.f, 0.f, 0.f, 0.f};
        cur = nxt; cA = nA; cB = nB; ++ui;
        if constexpr (ALIGN_EPI) { if (wr == 1) PG8_BAR; }
    }
    PG8_WAIT_V(0);
    if constexpr (!ALIGN_EPI) { if (wr == 0) PG8_BAR; }
    PG8_BAR;
    if constexpr (Epi::AFTER_DRAIN) { E.fused(acc, cur, wr, wc, fr, fq, lds, wid, lane); S.done(cur); }
#undef PG8_SA
#undef PG8_SB
#undef PG8_STAGE
#undef PG8_LDA
#undef PG8_LDB
#undef PG8_MMA
#undef PG8_WAIT_V
#undef PG8_WAIT_L
#undef PG8_BAR
#undef PG8_SCHED
}
}

namespace att {
typedef unsigned short bf16_t;
using bf16x8 = __attribute__((ext_vector_type(8))) short;
using s16x4  = __attribute__((ext_vector_type(4))) short;
using f32x16 = __attribute__((ext_vector_type(16))) float;
using f32x4  = __attribute__((ext_vector_type(4))) float;
using u32x4  = __attribute__((ext_vector_type(4))) unsigned;
using u32x2  = __attribute__((ext_vector_type(2))) unsigned;
constexpr int NW = 8, QBLK = 32, KVBLK = 64;
constexpr int LDQ = 1536, LDK = 1536, LDV = 1024, LDO = 1024;
constexpr float SCALE = 0.07216878364870323f;
constexpr float THR = 8.f;
constexpr int NQR = 8;
constexpr int SHM_V = KVBLK * 128 * 2, SHM_K = KVBLK * 192 * 2, SHM_ATTN = 2 * SHM_V + 2 * SHM_K + NW * 64 * 4;
#define AKSWZ(row, colB) ((row) * 384 + ((colB) ^ (((((row) >> 1) & 3) | (((row) >> 2) & 4)) << 4)))
#define KSWZ128(row, colB) ((row) * 256 + ((colB) ^ (((row) & 15) << 4)))
#define SBAR() __builtin_amdgcn_sched_barrier(0)
#define GAS __attribute__((address_space(1)))
__device__ __forceinline__ const GAS char* uniform_ptr(const void* p) { const unsigned long long v = (unsigned long long)p; const unsigned lo = __builtin_amdgcn_readfirstlane((unsigned)v), hi = __builtin_amdgcn_readfirstlane((unsigned)(v >> 32)); return (const GAS char*)(((unsigned long long)hi << 32) | lo); }
__device__ __forceinline__ int crow(int r, int hi) { return (r & 3) + 8 * (r >> 2) + 4 * hi; }
__device__ __forceinline__ unsigned cvtpk(float lo, float hi) { unsigned r; asm volatile("v_cvt_pk_bf16_f32 %0, %1, %2" : "=v"(r) : "v"(lo), "v"(hi)); return pg8::coarse2(r); }
__device__ __forceinline__ float swap_sum(float v) { auto rr = __builtin_amdgcn_permlane32_swap(__float_as_uint(v), __float_as_uint(v), false, false); return __uint_as_float(rr[0]) + __uint_as_float(rr[1]); }

__device__ __forceinline__ void partialSM(f32x16& p0, f32x16& p1, float& m_reg, float& mn, float& alpha) {
  constexpr float C = SCALE * 1.4426950408889634f;
  float pmax = p0[0];
#pragma unroll
  for (int r = 1; r < 16; ++r) pmax = fmaxf(pmax, p0[r]);
#pragma unroll
  for (int r = 0; r < 16; ++r) pmax = fmaxf(pmax, p1[r]);
  { auto rr = __builtin_amdgcn_permlane32_swap(__float_as_uint(pmax), __float_as_uint(pmax), false, false);
    pmax = fmaxf(__uint_as_float(rr[0]), __uint_as_float(rr[1])); }
  if (__builtin_expect(__all(pmax - m_reg <= THR / SCALE), 1)) { mn = m_reg; alpha = 1.f; }
  else { mn = fmaxf(m_reg, pmax); alpha = __builtin_amdgcn_exp2f((m_reg - mn) * C); m_reg = mn; }
  float mnC = -mn * C;
#pragma unroll
  for (int r = 0; r < 16; ++r) p0[r] = fmaf(p0[r], C, mnC);
#pragma unroll
  for (int r = 0; r < 16; ++r) p1[r] = fmaf(p1[r], C, mnC);
#pragma unroll
  for (int r = 0; r < 16; ++r) p0[r] = __builtin_amdgcn_exp2f(p0[r]);
}
#define PK4(P, BASE, OUT) do { unsigned a0 = cvtpk(P[BASE + 0], P[BASE + 1]), a1 = cvtpk(P[BASE + 2], P[BASE + 3]);   \
    unsigned b0 = cvtpk(P[BASE + 4], P[BASE + 5]), b1 = cvtpk(P[BASE + 6], P[BASE + 7]);                              \
    auto r0 = __builtin_amdgcn_permlane32_swap(a0, b0, false, false); auto r1 = __builtin_amdgcn_permlane32_swap(a1, b1, false, false); \
    u32x4 w = {r0[0], r1[0], r0[1], r1[1]}; OUT = *reinterpret_cast<bf16x8*>(&w); } while (0)
__device__ __forceinline__ void finishSM(f32x16& p0, f32x16& p1, float alpha, float& l_reg, bf16x8& pa0, bf16x8& pa1, bf16x8& pa2, bf16x8& pa3) {
#pragma unroll
  for (int r = 0; r < 16; ++r) p1[r] = __builtin_amdgcn_exp2f(p1[r]);
  float ps = 0;
#pragma unroll
  for (int r = 0; r < 16; ++r) ps += p0[r];
#pragma unroll
  for (int r = 0; r < 16; ++r) ps += p1[r];
  ps = swap_sum(ps);
  l_reg = l_reg * alpha + ps;
  PK4(p0, 0, pa0); PK4(p0, 8, pa1); PK4(p1, 0, pa2); PK4(p1, 8, pa3);
}
__device__ __forceinline__ void qkt192(f32x16& p0, f32x16& p1, const char* Ks, const bf16x8 (&qr)[NQR], const char* Qs, int r32, int hi) {
  p0 = f32x16{}; p1 = f32x16{};
  __builtin_amdgcn_s_setprio(1);
#pragma unroll
  for (int d0 = 0; d0 < 12; ++d0) { int cb = (d0 * 16 + hi * 8) * 2;
    bf16x8 b0 = *reinterpret_cast<const bf16x8*>(Ks + AKSWZ(r32, cb));
    bf16x8 b1 = *reinterpret_cast<const bf16x8*>(Ks + AKSWZ(32 + r32, cb));
    bf16x8 qv; if (d0 < NQR) qv = qr[d0 < NQR ? d0 : 0]; else qv = *reinterpret_cast<const bf16x8*>(Qs + (d0 - NQR) * 1024);
    p0 = __builtin_amdgcn_mfma_f32_32x32x16_bf16(b0, qv, p0, 0, 0, 0);
    p1 = __builtin_amdgcn_mfma_f32_32x32x16_bf16(b1, qv, p1, 0, 0, 0); }
  __builtin_amdgcn_s_setprio(0);
}
__device__ __forceinline__ void qkt128(f32x16& p0, f32x16& p1, const char* Ks, const bf16x8 (&qr)[8], int r32, int hi) {
  p0 = f32x16{}; p1 = f32x16{};
#pragma unroll
  for (int d0 = 0; d0 < 8; ++d0) { int cb = (d0 * 16 + hi * 8) * 2;
    bf16x8 b0 = *reinterpret_cast<const bf16x8*>(Ks + KSWZ128(r32, cb));
    bf16x8 b1 = *reinterpret_cast<const bf16x8*>(Ks + KSWZ128(32 + r32, cb));
    p0 = __builtin_amdgcn_mfma_f32_32x32x16_bf16(b0, qr[d0], p0, 0, 0, 0);
    p1 = __builtin_amdgcn_mfma_f32_32x32x16_bf16(b1, qr[d0], p1, 0, 0, 0); }
}
__device__ __forceinline__ int v_st(int k, int c) { const int kk = (k & ~0xC) | ((k & 4) << 1) | ((k & 8) >> 1); return ((kk >> 3) * 4 + (c >> 5)) * 512 + ((kk & 7) * 32 + (c & 31)) * 2; }
__device__ __forceinline__ int v_rd_base(int lane) { return ((lane & 3) << 3) | (((lane >> 2) & 3) << 6) | (((lane >> 4) & 1) << 5) | (((lane >> 5) & 1) << 8); }
constexpr int v_rd_off(int d0, int ks, int half) { return d0 * 512 + ks * 4096 + half * 2048; }
template <int OFF> __device__ __forceinline__ s16x4 tr_read(int vb) {
  s16x4 r; asm volatile("ds_read_b64_tr_b16 %0, %1 offset:%2" : "=&v"(r) : "v"(vb), "i"(OFF) : "memory"); return r;
}
#define PKLH(L, H) (bf16x8){L[0], L[1], L[2], L[3], H[0], H[1], H[2], H[3]}
template <int D0> __device__ __forceinline__ void pv_one(f32x16& od, int vb, bf16x8 pa0, bf16x8 pa1, bf16x8 pa2, bf16x8 pa3) {
  const s16x4 l0 = tr_read<v_rd_off(D0, 0, 0)>(vb), h0 = tr_read<v_rd_off(D0, 0, 1)>(vb), l1 = tr_read<v_rd_off(D0, 1, 0)>(vb), h1 = tr_read<v_rd_off(D0, 1, 1)>(vb);
  const s16x4 l2 = tr_read<v_rd_off(D0, 2, 0)>(vb), h2 = tr_read<v_rd_off(D0, 2, 1)>(vb), l3 = tr_read<v_rd_off(D0, 3, 0)>(vb), h3 = tr_read<v_rd_off(D0, 3, 1)>(vb);
  asm volatile("s_waitcnt lgkmcnt(0)" ::: "memory"); SBAR();
  __builtin_amdgcn_s_setprio(1);
  od = __builtin_amdgcn_mfma_f32_32x32x16_bf16(pa0, PKLH(l0, h0), od, 0, 0, 0);
  od = __builtin_amdgcn_mfma_f32_32x32x16_bf16(pa1, PKLH(l1, h1), od, 0, 0, 0);
  od = __builtin_amdgcn_mfma_f32_32x32x16_bf16(pa2, PKLH(l2, h2), od, 0, 0, 0);
  od = __builtin_amdgcn_mfma_f32_32x32x16_bf16(pa3, PKLH(l3, h3), od, 0, 0, 0);
  __builtin_amdgcn_s_setprio(0);
}
__device__ __forceinline__ void pv_d0(f32x16* o, int vb, bf16x8 pa0, bf16x8 pa1, bf16x8 pa2, bf16x8 pa3) {
  pv_one<0>(o[0], vb, pa0, pa1, pa2, pa3); pv_one<1>(o[1], vb, pa0, pa1, pa2, pa3); pv_one<2>(o[2], vb, pa0, pa1, pa2, pa3); pv_one<3>(o[3], vb, pa0, pa1, pa2, pa3);
}
template <int D0> __device__ __forceinline__ void pvT_one(f32x16& od, int vb, bf16x8 pa0, bf16x8 pa1, bf16x8 pa2, bf16x8 pa3) {
  const s16x4 l0 = tr_read<v_rd_off(D0, 0, 0)>(vb), h0 = tr_read<v_rd_off(D0, 0, 1)>(vb), l1 = tr_read<v_rd_off(D0, 1, 0)>(vb), h1 = tr_read<v_rd_off(D0, 1, 1)>(vb);
  const s16x4 l2 = tr_read<v_rd_off(D0, 2, 0)>(vb), h2 = tr_read<v_rd_off(D0, 2, 1)>(vb), l3 = tr_read<v_rd_off(D0, 3, 0)>(vb), h3 = tr_read<v_rd_off(D0, 3, 1)>(vb);
  asm volatile("s_waitcnt lgkmcnt(0)" ::: "memory"); SBAR();
  od = __builtin_amdgcn_mfma_f32_32x32x16_bf16(PKLH(l0, h0), pa0, od, 0, 0, 0);
  od = __builtin_amdgcn_mfma_f32_32x32x16_bf16(PKLH(l1, h1), pa1, od, 0, 0, 0);
  od = __builtin_amdgcn_mfma_f32_32x32x16_bf16(PKLH(l2, h2), pa2, od, 0, 0, 0);
  od = __builtin_amdgcn_mfma_f32_32x32x16_bf16(PKLH(l3, h3), pa3, od, 0, 0, 0);
}

__device__ __forceinline__ void attn_unit(const bf16_t* __restrict__ Qb, const bf16_t* __restrict__ Kh, const bf16_t* __restrict__ Vh, bf16_t* __restrict__ Ob, int seq, char* lds, int ldsaddr) {
  const int tid = threadIdx.x, wid = tid >> 6, lane = tid & 63, r32 = lane & 31, hi = lane >> 5;
  char* V_lds = lds; char* K_lds = lds + 2 * SHM_V;
  float* ws = (float*)(lds + 2 * SHM_V + 2 * SHM_K) + wid * 64; float* li_l = ws; float* al_l = ws + 32;
  float m_reg = -1e30f, l_reg = 0; f32x16 o[4] = {}; bf16x8 qr[NQR];
  const bf16_t* Qw = Qb + (long)(wid * QBLK + r32) * LDQ + hi * 8;
  char* Qs = lds + SHM_ATTN + wid * ((12 - NQR) * 1024) + lane * 16;
#pragma unroll
  for (int d0 = 0; d0 < NQR; ++d0) qr[d0] = *reinterpret_cast<const bf16x8*>(Qw + d0 * 16);
#pragma unroll
  for (int d0 = NQR; d0 < 12; ++d0) *(bf16x8*)(Qs + (d0 - NQR) * 1024) = *reinterpret_cast<const bf16x8*>(Qw + d0 * 16);
  const int sr = tid >> 4, sc = (tid & 15) * 8, vst0 = v_st(sr, sc), vst1 = v_st(32 + sr, sc);
  unsigned kg0, kg1, kg2; int kl0, kl1, kl2;
  { int p = tid;        int kr = p / 24, kc = (p % 24) * 8; kg0 = (unsigned)(kr * LDK + kc) * 2u; kl0 = AKSWZ(kr, kc * 2);
    p = tid + 512;      kr = p / 24; kc = (p % 24) * 8;     kg1 = (unsigned)(kr * LDK + kc) * 2u; kl1 = AKSWZ(kr, kc * 2);
    p = tid + 1024;     kr = p / 24; kc = (p % 24) * 8;     kg2 = (unsigned)(kr * LDK + kc) * 2u; kl2 = AKSWZ(kr, kc * 2); }
  const unsigned vg0 = (unsigned)(sr * LDV + sc) * 2u, vg1 = (unsigned)((32 + sr) * LDV + sc) * 2u;
  const int vb0 = ldsaddr + v_rd_base(lane);
  bf16x8 vs0, vs1, ks0, ks1, ks2;
#define SLOAD(k0) do { const GAS char* vb_ = uniform_ptr((const char*)Vh + (size_t)(k0) * (LDV * 2)); const GAS char* kb_ = uniform_ptr((const char*)Kh + (size_t)(k0) * (LDK * 2)); \
    vs0 = *(const GAS bf16x8*)(vb_ + vg0); vs1 = *(const GAS bf16x8*)(vb_ + vg1); \
    ks0 = *(const GAS bf16x8*)(kb_ + kg0); ks1 = *(const GAS bf16x8*)(kb_ + kg1); ks2 = *(const GAS bf16x8*)(kb_ + kg2); } while (0)
#define SWRITE(b) do { *(bf16x8*)(V_lds + (b) * SHM_V + vst0) = vs0; *(bf16x8*)(V_lds + (b) * SHM_V + vst1) = vs1; \
    *(bf16x8*)(K_lds + (b) * SHM_K + kl0) = ks0; *(bf16x8*)(K_lds + (b) * SHM_K + kl1) = ks1; *(bf16x8*)(K_lds + (b) * SHM_K + kl2) = ks2; } while (0)
#define SWAIT() asm volatile("s_waitcnt vmcnt(0)" ::: "memory")
#define RESC(a) do { if (__any((a) < 1.f)) { if (hi == 0) al_l[r32] = (a); asm volatile("s_waitcnt lgkmcnt(0)" ::: "memory"); \
    _Pragma("unroll") for (int d = 0; d < 4; ++d) _Pragma("unroll") for (int r = 0; r < 16; ++r) o[d][r] *= al_l[crow(r, hi)]; } } while (0)
  f32x16 pA0, pA1, pB0, pB1; float mnA, mnB, alA, alB; bf16x8 pa0, pa1, pa2, pa3; const int NT = seq / KVBLK;
  __syncthreads();
  SLOAD(0); SWAIT(); SWRITE(0); __syncthreads();
  qkt192(pA0, pA1, K_lds, qr, Qs, r32, hi); partialSM(pA0, pA1, m_reg, mnA, alA);
  SLOAD(KVBLK);
  SWAIT(); SWRITE(1); __syncthreads();
  for (int j = 1; j + 1 < NT; j += 2) {
    SBAR(); qkt192(pB0, pB1, K_lds + SHM_K, qr, Qs, r32, hi);
    finishSM(pA0, pA1, alA, l_reg, pa0, pa1, pa2, pa3); SBAR();
    SLOAD((j + 1) * KVBLK); SBAR();
    pv_d0(o, vb0, pa0, pa1, pa2, pa3); partialSM(pB0, pB1, m_reg, mnB, alB);
    __syncthreads(); SWAIT(); SWRITE(0);
    RESC(alB); __syncthreads();
    SBAR(); qkt192(pA0, pA1, K_lds, qr, Qs, r32, hi);
    finishSM(pB0, pB1, alB, l_reg, pa0, pa1, pa2, pa3); SBAR();
    SLOAD((j + 2) * KVBLK); SBAR();
    pv_d0(o, vb0 + SHM_V, pa0, pa1, pa2, pa3); partialSM(pA0, pA1, m_reg, mnA, alA);
    __syncthreads(); SWAIT(); SWRITE(1);
    RESC(alA); __syncthreads();
  }
  SBAR(); qkt192(pB0, pB1, K_lds + SHM_K, qr, Qs, r32, hi);
  finishSM(pA0, pA1, alA, l_reg, pa0, pa1, pa2, pa3); SBAR();
  pv_d0(o, vb0, pa0, pa1, pa2, pa3); partialSM(pB0, pB1, m_reg, mnB, alB);
  __syncthreads(); RESC(alB);
  finishSM(pB0, pB1, alB, l_reg, pa0, pa1, pa2, pa3); SBAR();
  pv_d0(o, vb0 + SHM_V, pa0, pa1, pa2, pa3);
  if (hi == 0) li_l[r32] = l_reg; asm volatile("s_waitcnt lgkmcnt(0)" ::: "memory");
  float rli[16];
#pragma unroll
  for (int r = 0; r < 16; ++r) rli[r] = __builtin_amdgcn_rcpf(li_l[crow(r, hi)]);
  bf16_t* Ow = Ob + (long)(wid * QBLK) * LDO;
#pragma unroll
  for (int r = 0; r < 16; ++r) { int orow = crow(r, hi);
#pragma unroll
    for (int d0 = 0; d0 < 4; ++d0) Ow[(long)orow * LDO + d0 * 32 + r32] = (bf16_t)(cvtpk(o[d0][r] * rli[r], 0.f) & 0xffffu); }
#undef SLOAD
#undef SWRITE
#undef SWAIT
#undef RESC
}

__device__ __forceinline__ bf16x8 scale8(bf16x8 v, float s) {
  u32x4 w = *reinterpret_cast<u32x4*>(&v), o;
#pragma unroll
  for (int i = 0; i < 4; ++i) o[i] = cvtpk(__uint_as_float(w[i] << 16) * s, __uint_as_float(w[i] & 0xffff0000u) * s);
  return *reinterpret_cast<bf16x8*>(&o);
}
__device__ __forceinline__ s16x4 trr(int addr) { s16x4 r; asm volatile("ds_read_b64_tr_b16 %0, %1" : "=&v"(r) : "v"(addr) : "memory"); return r; }

__device__ __forceinline__ void chunk_kv_unit(const bf16_t* __restrict__ Kc, const bf16_t* __restrict__ Vc, bf16_t* __restrict__ CKf, bf16_t* __restrict__ CKb, float lgf, float lgb, char* lds, int ldsaddr) {
  const int tid = threadIdx.x, wid = tid >> 6, lane = tid & 63, r32 = lane & 31, hi = lane >> 5;
  const int dir = wid >> 2, db = wid & 3, d = 32 * db + r32;
  __syncthreads();
  { const int sr = tid >> 4, sc = (tid & 15) * 8;
#pragma unroll
    for (int i = 0; i < 4; ++i) { const int row = sr + 32 * i;
      *(bf16x8*)(lds + (row >> 6) * 16384 + v_st(row & 63, sc)) = *reinterpret_cast<const bf16x8*>(Vc + (long)row * 1024 + sc);
      *(bf16x8*)(lds + 32768 + row * 272 + sc * 2) = *reinterpret_cast<const bf16x8*>(Kc + (long)row * 1024 + sc); } }
  __syncthreads();
  bf16x8 kb[8];
  int hio = hi; asm volatile("" : "+v"(hio));
  const char* kl = lds + 32768 + (hio * 8) * 272 + d * 2;
#pragma unroll
  for (int ks = 0; ks < 8; ++ks) { u32x4 w;
#pragma unroll
    for (int i = 0; i < 4; ++i) { const int s0 = ks * 16 + hio * 8 + 2 * i;
      const float k0 = __uint_as_float((unsigned)*(const unsigned short*)(kl + (ks * 16 + 2 * i) * 272) << 16), k1 = __uint_as_float((unsigned)*(const unsigned short*)(kl + (ks * 16 + 2 * i + 1) * 272) << 16);
      const float z0 = __builtin_amdgcn_exp2f(dir ? lgb * (float)s0 : lgf * (float)(127 - s0)), z1 = __builtin_amdgcn_exp2f(dir ? lgb * (float)(s0 + 1) : lgf * (float)(126 - s0));
      w[i] = cvtpk(k0 * z0, k1 * z1); }
    kb[ks] = *reinterpret_cast<bf16x8*>(&w); }
  f32x16 acc[4] = {};
  const int vb = ldsaddr + v_rd_base(lane);
  pvT_one<0>(acc[0], vb, kb[0], kb[1], kb[2], kb[3]); pvT_one<1>(acc[1], vb, kb[0], kb[1], kb[2], kb[3]); pvT_one<2>(acc[2], vb, kb[0], kb[1], kb[2], kb[3]); pvT_one<3>(acc[3], vb, kb[0], kb[1], kb[2], kb[3]);
  pvT_one<0>(acc[0], vb + 16384, kb[4], kb[5], kb[6], kb[7]); pvT_one<1>(acc[1], vb + 16384, kb[4], kb[5], kb[6], kb[7]); pvT_one<2>(acc[2], vb + 16384, kb[4], kb[5], kb[6], kb[7]); pvT_one<3>(acc[3], vb + 16384, kb[4], kb[5], kb[6], kb[7]);
  bf16_t* CK = dir ? CKb : CKf;
#pragma unroll
  for (int eb = 0; eb < 4; ++eb)
#pragma unroll
    for (int r = 0; r < 16; ++r) CK[(32 * eb + crow(r, hi)) * 128 + d] = (bf16_t)(cvtpk(acc[eb][r], 0.f) & 0xffffu);
}

#ifndef PROBE_COMP
#define PROBE_COMP 0
#endif
__device__ __forceinline__ void ret_out_unit(const bf16_t* __restrict__ Qc, const bf16_t* __restrict__ Kc, const bf16_t* __restrict__ Vc, const bf16_t* __restrict__ Gc,
                                             const bf16_t* __restrict__ STf, const bf16_t* __restrict__ STb, const float* __restrict__ gnw, const float* __restrict__ gnb,
                                             bf16_t* __restrict__ Oc, float lgf, float lgb, char* lds, int ldsaddr, float* dump = nullptr) {
  const int tid = threadIdx.x, ht = tid & 255, wq = (tid >> 6) & 3, lane = tid & 63, r32 = lane & 31, hi = lane >> 5;
  __syncthreads();
  { const int sr = ht >> 4, sc = (ht & 15) * 8;
#pragma unroll
    for (int i = 0; i < 8; ++i) { const int row = sr + 16 * i, tile = row >> 6, key = row & 63;
      *(bf16x8*)(lds + tile * 16384 + KSWZ128(key, sc * 2)) = *reinterpret_cast<const bf16x8*>(Kc + (long)row * 1024 + sc);
      *(bf16x8*)(lds + 32768 + tile * 16384 + v_st(key, sc)) = *reinterpret_cast<const bf16x8*>(Vc + (long)row * 1024 + sc); } }
  const int c = 32 * wq + r32;
  bf16x8 qr[8];
#pragma unroll
  for (int d0 = 0; d0 < 8; ++d0) qr[d0] = *reinterpret_cast<const bf16x8*>(Qc + (long)c * 1024 + d0 * 16 + hi * 8);
  __syncthreads();
  f32x16 pA0, pA1, pB0, pB1;
  qkt128(pA0, pA1, lds, qr, r32, hi); qkt128(pB0, pB1, lds + 16384, qr, r32, hi);
  int cdec = c; asm volatile("" : "+v"(cdec));
#define DEC(P, JB) do { _Pragma("unroll") for (int r = 0; r < 16; ++r) { const int dl = cdec - ((JB) + crow(r, hi)); \
    P[r] *= __builtin_amdgcn_exp2f(dl >= 0 ? lgf * (float)dl : lgb * (float)(-dl)); } } while (0)
  DEC(pA0, 0); DEC(pA1, 32); DEC(pB0, 64); DEC(pB1, 96);
#undef DEC
  bf16x8 xa0, xa1, xa2, xa3, xb0, xb1, xb2, xb3;
  PK4(pA0, 0, xa0); PK4(pA0, 8, xa1); PK4(pA1, 0, xa2); PK4(pA1, 8, xa3);
  PK4(pB0, 0, xb0); PK4(pB0, 8, xb1); PK4(pB1, 0, xb2); PK4(pB1, 8, xb3);
  f32x16 o[4] = {};
  const int vb = ldsaddr + 32768 + v_rd_base(lane);
  if (PROBE_COMP == 0 || (PROBE_COMP & 1)) {
  pvT_one<0>(o[0], vb, xa0, xa1, xa2, xa3); pvT_one<1>(o[1], vb, xa0, xa1, xa2, xa3); pvT_one<2>(o[2], vb, xa0, xa1, xa2, xa3); pvT_one<3>(o[3], vb, xa0, xa1, xa2, xa3);
  pvT_one<0>(o[0], vb + 16384, xb0, xb1, xb2, xb3); pvT_one<1>(o[1], vb + 16384, xb0, xb1, xb2, xb3); pvT_one<2>(o[2], vb + 16384, xb0, xb1, xb2, xb3); pvT_one<3>(o[3], vb + 16384, xb0, xb1, xb2, xb3);
  }
#pragma unroll
  for (int dir = 0; dir < 2; ++dir) {
    if (PROBE_COMP != 0 && !((PROBE_COMP >> (1 + dir)) & 1)) continue;
    const float xi = __builtin_amdgcn_exp2f(dir == 0 ? lgf * (float)(c + 1) : lgb * (float)(128 - c));
    const bf16_t* ST = dir == 0 ? STf : STb;
    bf16x8 qs[8];
#pragma unroll
    for (int d0 = 0; d0 < 8; ++d0) qs[d0] = scale8(qr[d0], xi);
    const GAS char* stb = uniform_ptr(ST); const unsigned so = (unsigned)(r32 * 128 + hi * 8) * 2u;
#pragma unroll
    for (int eb = 0; eb < 4; ++eb) {
      bf16x8 A[8];
      SBAR();
#pragma unroll
      for (int d0 = 0; d0 < 8; ++d0) A[d0] = *(const GAS bf16x8*)(stb + so + (eb * 32 * 128 + d0 * 16) * 2);
#pragma unroll
      for (int d0 = 0; d0 < 8; ++d0) o[eb] = __builtin_amdgcn_mfma_f32_32x32x16_bf16(A[d0], qs[d0], o[eb], 0, 0, 0);
      SBAR();
    }
  }
  if (PROBE_COMP != 0) {
#pragma unroll
    for (int eb = 0; eb < 4; ++eb)
#pragma unroll
      for (int g = 0; g < 4; ++g) *(f32x4*)(dump + (long)c * 1024 + 32 * eb + 8 * g + 4 * hi) = (f32x4){o[eb][4 * g], o[eb][4 * g + 1], o[eb][4 * g + 2], o[eb][4 * g + 3]};
    return; }
  float s = 0.f;
#pragma unroll
  for (int eb = 0; eb < 4; ++eb)
#pragma unroll
    for (int r = 0; r < 16; ++r) s += o[eb][r];
  const float mu = swap_sum(s) * (1.f / 128.f);
  float q = 0.f;
#pragma unroll
  for (int eb = 0; eb < 4; ++eb)
#pragma unroll
    for (int r = 0; r < 16; ++r) { const float d = o[eb][r] - mu; q += d * d; }
  const float rstd = rsqrtf(swap_sum(q) * (1.f / 128.f) + 1e-6f);
#pragma unroll
  for (int eb = 0; eb < 4; ++eb)
#pragma unroll
    for (int g = 0; g < 4; ++g) { const int e0 = 32 * eb + 8 * g + 4 * hi;
      const f32x4 w4 = *(const f32x4*)(gnw + e0), b4 = *(const f32x4*)(gnb + e0);
      const u32x2 gg = *(const u32x2*)(Gc + (long)c * 1024 + e0);
      const float g0 = __uint_as_float(gg.x << 16), g1 = __uint_as_float(gg.x & 0xffff0000u), g2 = __uint_as_float(gg.y << 16), g3 = __uint_as_float(gg.y & 0xffff0000u);
      const float y0 = ((o[eb][4 * g] - mu) * rstd * w4[0] + b4[0]) * g0, y1 = ((o[eb][4 * g + 1] - mu) * rstd * w4[1] + b4[1]) * g1;
      const float y2 = ((o[eb][4 * g + 2] - mu) * rstd * w4[2] + b4[2]) * g2, y3 = ((o[eb][4 * g + 3] - mu) * rstd * w4[3] + b4[3]) * g3;
      u32x2 w; w.x = cvtpk(y0, y1); w.y = cvtpk(y2, y3);
      *(u32x2*)(Oc + (long)c * 2048 + e0) = w; }
}

__device__ __forceinline__ void ret_brute_unit(const bf16_t* __restrict__ Qh, const bf16_t* __restrict__ Kh, const bf16_t* __restrict__ Vh, const bf16_t* __restrict__ Gc,
                                               const float* __restrict__ gnw, const float* __restrict__ gnb, bf16_t* __restrict__ Oc, int t0, float lgf, float lgb, char* lds, const float* dump = nullptr) {
  const int tid = threadIdx.x, qi = tid >> 2, part = tid & 3, t = t0 + qi;
  float q[32], acc[32];
#pragma unroll
  for (int i = 0; i < 32; ++i) { q[i] = __uint_as_float((unsigned)Qh[(long)t * 1024 + part * 32 + i] << 16); acc[i] = 0.f; }
  for (int s0 = 0; s0 < 4096; s0 += 64) {
    { const int rel = s0 < t0 ? 1 : (s0 >= t0 + 128 ? 2 : 0); if (PROBE_COMP != 0 && ((PROBE_COMP >> rel) & 1)) continue; }
    __syncthreads();
    for (int c = tid; c < 64 * 16; c += 512) { const int r = c >> 4, c8 = (c & 15) * 8;
      *(bf16x8*)(lds + (r * 128 + c8) * 2) = *reinterpret_cast<const bf16x8*>(Kh + (long)(s0 + r) * 1024 + c8);
      *(bf16x8*)(lds + 16384 + (r * 128 + c8) * 2) = *reinterpret_cast<const bf16x8*>(Vh + (long)(s0 + r) * 1024 + c8); }
    __syncthreads();
    for (int j = 0; j < 64; ++j) { const int s = s0 + j; float d = 0.f;
      const unsigned short* kr = (const unsigned short*)(lds + (j * 128 + part * 32) * 2); const unsigned short* vr = (const unsigned short*)(lds + 16384 + (j * 128 + part * 32) * 2);
#pragma unroll
      for (int i = 0; i < 32; ++i) d += q[i] * __uint_as_float((unsigned)kr[i] << 16);
      d += __shfl_xor(d, 1); d += __shfl_xor(d, 2);
      const int dl = t - s; const float w = d * __builtin_amdgcn_exp2f(dl >= 0 ? lgf * (float)dl : lgb * (float)(-dl));
#pragma unroll
      for (int i = 0; i < 32; ++i) acc[i] += w * __uint_as_float((unsigned)vr[i] << 16); }
  }
  if (PROBE_COMP != 0) {
#pragma unroll
    for (int i = 0; i < 32; ++i) acc[i] += dump[(long)qi * 1024 + part * 32 + i]; }
  float sm = 0.f;
#pragma unroll
  for (int i = 0; i < 32; ++i) sm += acc[i];
  sm += __shfl_xor(sm, 1); sm += __shfl_xor(sm, 2); const float mu = sm * (1.f / 128.f);
  float qq = 0.f;
#pragma unroll
  for (int i = 0; i < 32; ++i) { const float dd = acc[i] - mu; qq += dd * dd; }
  qq += __shfl_xor(qq, 1); qq += __shfl_xor(qq, 2); const float rstd = rsqrtf(qq * (1.f / 128.f) + 1e-6f);
#pragma unroll
  for (int i = 0; i < 32; ++i) { const int e = part * 32 + i; const float g = __uint_as_float((unsigned)Gc[(long)qi * 1024 + e] << 16);
    Oc[(long)qi * 2048 + e] = (bf16_t)(cvtpk(((acc[i] - mu) * rstd * gnw[e] + gnb[e]) * g, 0.f) & 0xffffu); }
}
#undef SBAR
}


#ifndef PROBE_BRUTE_RET
#define PROBE_BRUTE_RET 0
#endif
#ifndef MK_SPLIT
#define MK_SPLIT 0
#endif
#define LAS __attribute__((address_space(3)))
#define GASX __attribute__((address_space(1)))
typedef unsigned short bf16_t;
typedef unsigned v4u __attribute__((ext_vector_type(4)));
typedef unsigned v2u __attribute__((ext_vector_type(2)));
typedef float f32x4 __attribute__((ext_vector_type(4)));
typedef short bf16x8 __attribute__((ext_vector_type(8)));

constexpr int BATCH = 8, SEQ = 4096, DM = 2048, T = BATCH * SEQ;
constexpr int INC = 5184, INCP = 5376, DFF = 5632, NMODC = 6 * DM;
constexpr int NPH = 11;
constexpr size_t MiB = 1u << 20;
constexpr size_t WS_CTL = 0, CTL_ZERO_BYTES = 2 * MiB;
constexpr size_t OFF_MOD = 0, OFF_SSQQ = 512 * 1024, OFF_SSQKV = 640 * 1024;
constexpr size_t WS_COSR = 2 * MiB, WS_SINR = 10 * MiB, WS_COSM = 18 * MiB, WS_SINM = 22 * MiB;
constexpr size_t WS_WIN = 26 * MiB, WS_WUQ = 47 * MiB, WS_WUKV = 49 * MiB, WS_WO = 51 * MiB, WS_WGU = 59 * MiB, WS_WDN = 103 * MiB;
constexpr size_t WS_H = 128 * MiB;
constexpr size_t WS_QR = 256 * MiB, WS_KR = 320 * MiB, WS_VR = 384 * MiB, WS_GR = 448 * MiB;
constexpr size_t WS_CQ = 512 * MiB, WS_CKV = 544 * MiB;
constexpr size_t WS_QM = 576 * MiB, WS_KB = 672 * MiB, WS_VM = 768 * MiB, WS_OAT = 832 * MiB, WS_END = 896 * MiB;
constexpr size_t WS_CAT = 576 * MiB;
constexpr size_t WS_AFF = 256 * MiB;
static_assert(WS_AFF + (size_t)T * DFF * 2 <= WS_END && WS_CAT + (size_t)T * 2048 * 2 <= WS_VM, "d_ws map");
constexpr int LDS_BAR_OFF = 150528;
constexpr size_t OFF_XBAR = 1536 * 1024;
constexpr int LDS_BYTES = 150528 + 64;

#define LDS_WAIT() asm volatile("s_waitcnt lgkmcnt(0)" ::: "memory")
__device__ __forceinline__ unsigned f2bf(float f) { unsigned u = __builtin_bit_cast(unsigned, f); return (u + 0x7fffu + ((u >> 16) & 1u)) >> 16; }
__device__ __forceinline__ unsigned pk2(float lo, float hi) { return f2bf(lo) | (f2bf(hi) << 16); }
__device__ __forceinline__ unsigned pk2a(float lo, float hi) { return pg8::coarse2(pk2(lo, hi)); }
__device__ __forceinline__ float wave_sum(float v) {
#pragma unroll
    for (int o = 1; o < 64; o <<= 1) v += __shfl_xor(v, o);
    return v;
}
__device__ __forceinline__ int dest_row(int mapid, int n) {
    switch (mapid) {
    case 1: if (n < 2048) { const int j = n & 127; return (n & ~127) + (j < 64 ? 2 * j : 2 * (j - 64) + 1); }
            if (n < 5120) return n;
            { const int j = n - 5120; return 5120 + (j < 32 ? 2 * j : 2 * (j - 32) + 1); }
    case 2: { const int d = n % 192; if (d < 128) return n; const int j = d - 128; return n - d + 128 + (j < 32 ? 2 * j : 2 * (j - 32) + 1); }
    case 3: return (n >> 7) * 256 + (n & 127);
    case 4: return (n >> 7) * 256 + 128 + (n & 127);
    default: return n;
    }
}
__device__ __forceinline__ void transpose_item(const float* __restrict__ W, int K, int N, bf16_t* __restrict__ WT, const float* __restrict__ kscale, int mapid, LAS float* scr, int item, int lane) {
    const int nblk = N / 32, kb = item / nblk, nb = item % nblk, k0 = 64 * kb, n0 = 32 * nb;
#pragma unroll 8
    for (int i = 0; i < 32; ++i) { const int kk = 2 * i + (lane >> 5); float v = W[(size_t)(k0 + kk) * N + n0 + (lane & 31)]; if (kscale) v *= kscale[k0 + kk]; scr[kk * 33 + (lane & 31)] = v; }
    LDS_WAIT(); asm volatile("" ::: "memory");
    const int c = lane & 7;
#pragma unroll
    for (int j = 0; j < 4; ++j) { const int n = (lane >> 3) + 8 * j; const LAS float* s = scr + (8 * c) * 33 + n;
        v4u o; o.x = pk2(s[0 * 33], s[1 * 33]); o.y = pk2(s[2 * 33], s[3 * 33]); o.z = pk2(s[4 * 33], s[5 * 33]); o.w = pk2(s[6 * 33], s[7 * 33]);
        *(v4u*)(WT + (size_t)dest_row(mapid, n0 + n) * K + k0 + 8 * c) = o; }
    LDS_WAIT(); asm volatile("" ::: "memory");
}
__device__ __forceinline__ void norm_row(const float* xrow, const float* __restrict__ w, const float* __restrict__ shift, const float* __restrict__ scale, bf16_t* ob, float* of, int lane) {
    const f32x4* xr = (const f32x4*)xrow + lane;
    f32x4 v[8]; float s = 0.f;
#pragma unroll
    for (int j = 0; j < 8; ++j) { v[j] = xr[64 * j]; s += (v[j].x * v[j].x + v[j].y * v[j].y) + (v[j].z * v[j].z + v[j].w * v[j].w); }
    const float rstd = rsqrtf(wave_sum(s) * (1.f / 2048.f) + 1e-6f);
#pragma unroll
    for (int j = 0; j < 8; ++j) { const int col = 4 * lane + 256 * j; f32x4 y = v[j] * rstd * *(const f32x4*)(w + col);
        if (shift) y = y * (*(const f32x4*)(scale + col) + 1.f) + *(const f32x4*)(shift + col);
        if (ob) { v2u o; o.x = pk2a(y.x, y.y); o.y = pk2a(y.z, y.w); *(v2u*)(ob + col) = o; } else *(f32x4*)(of + col) = y; }
}
__device__ __forceinline__ void norm_row2(const float* xa, const float* __restrict__ w, const float* __restrict__ shifta, const float* __restrict__ scalea, bf16_t* oba, float* ofa, int lane) {
    const float* shiftb = shifta; const float* scaleb = scalea; bf16_t* obb = oba + 2048; float* ofb = ofa + 2048;
    const f32x4* ra = (const f32x4*)xa + lane; const f32x4* rb = ra + 512;
    f32x4 va[8], vb[8]; float sa = 0.f, sb = 0.f;
#pragma unroll
    for (int j = 0; j < 8; ++j) va[j] = ra[64 * j];
#pragma unroll
    for (int j = 0; j < 8; ++j) vb[j] = rb[64 * j];
#pragma unroll
    for (int j = 0; j < 8; ++j) { sa += (va[j].x * va[j].x + va[j].y * va[j].y) + (va[j].z * va[j].z + va[j].w * va[j].w); sb += (vb[j].x * vb[j].x + vb[j].y * vb[j].y) + (vb[j].z * vb[j].z + vb[j].w * vb[j].w); }
    const float rsa = rsqrtf(wave_sum(sa) * (1.f / 2048.f) + 1e-6f), rsb = rsqrtf(wave_sum(sb) * (1.f / 2048.f) + 1e-6f);
#pragma unroll
    for (int j = 0; j < 8; ++j) { const int col = 4 * lane + 256 * j; const f32x4 wv = *(const f32x4*)(w + col); f32x4 ya = va[j] * rsa * wv, yb = vb[j] * rsb * wv;
        if (shifta) { ya = ya * (*(const f32x4*)(scalea + col) + 1.f) + *(const f32x4*)(shifta + col); yb = yb * (*(const f32x4*)(scaleb + col) + 1.f) + *(const f32x4*)(shiftb + col); }
        if (oba) { v2u o; o.x = pk2a(ya.x, ya.y); o.y = pk2a(ya.z, ya.w); *(v2u*)(oba + col) = o; o.x = pk2a(yb.x, yb.y); o.y = pk2a(yb.z, yb.w); *(v2u*)(obb + col) = o; }
        else { *(f32x4*)(ofa + col) = ya; *(f32x4*)(ofb + col) = yb; } }
}

#define XB_TMO      128
#define XB_XCNT(j)  (256  + 64 * (j))
#define XB_XSUB(j)  (1280 + 64 * (j))
#define XB_XGEN(j)  (2304 + 64 * (j))
#define XB_TOP      3328
#define XB_TOPGEN   3392
#define XCD_BAR_WORDS 3456
#define XB_SPIN_CAP (1u << 18)

__device__ __forceinline__ unsigned xb_ld(unsigned* p)              { return __hip_atomic_load(p, __ATOMIC_RELAXED, __HIP_MEMORY_SCOPE_AGENT); }
__device__ __forceinline__ unsigned xb_add(unsigned* p, unsigned v) { return __hip_atomic_fetch_add(p, v, __ATOMIC_RELAXED, __HIP_MEMORY_SCOPE_AGENT); }
__device__ __forceinline__ unsigned xb_xcc_id() { return (unsigned)__builtin_amdgcn_s_getreg((3 << 11) | 20) & 0xFu; }
#define XB_SPIN(cond, bar) do { unsigned _sp = 0; while (cond) { __builtin_amdgcn_s_sleep(1); \
    if ((++_sp & 255u) == 0u) { if (xb_ld(&(bar)[XB_TMO])) break; if (_sp > XB_SPIN_CAP) { atomicAdd(&(bar)[XB_TMO], 1u); break; } } } } while (0)

struct XcdBarrier {
    unsigned* bar; unsigned x;
    volatile LAS unsigned* st;
};

__device__ __forceinline__ XcdBarrier xcd_barrier_post(unsigned* bar, volatile LAS unsigned* st) {
    XcdBarrier b; b.bar = bar; b.x = xb_xcc_id(); b.st = st;
    if (threadIdx.x == 0) (void)xb_add(&bar[XB_XCNT(b.x)], 1u);
    return b;
}
__device__ __forceinline__ void xcd_barrier_complete(unsigned* bar, unsigned x, unsigned& nloc, unsigned& nx) {
    const unsigned G = gridDim.x * gridDim.y * gridDim.z;
    unsigned sum, cnt, mine, sp = 0u;
    for (;;) {
        sum = 0u; cnt = 0u; mine = 0u;
#pragma unroll
        for (unsigned j = 0; j < 16; ++j) { const unsigned c = xb_ld(&bar[XB_XCNT(j)]); sum += c; cnt += (c > 0u) ? 1u : 0u; mine = (j == x) ? c : mine; }
        if (sum == G) break;
        __builtin_amdgcn_s_sleep(1);
        if ((++sp & 255u) == 0u) { if (xb_ld(&bar[XB_TMO])) break; if (sp > XB_SPIN_CAP) { atomicAdd(&bar[XB_TMO], 1u); break; } }
    }
    nloc = mine > 0u ? mine : 1u; nx = cnt > 0u ? cnt : 1u;
}

__device__ __forceinline__ void xcd_barrier(const XcdBarrier& b) {
    asm volatile("s_waitcnt vmcnt(0)" ::: "memory");
    __syncthreads();
    if (threadIdx.x == 0) {
        unsigned* bar = b.bar;
        __builtin_amdgcn_s_waitcnt(0);
        unsigned nloc = b.st[0], nx = b.st[1];
        if (nloc == 0u) { xcd_barrier_complete(bar, b.x, nloc, nx); b.st[0] = nloc; b.st[1] = nx; }
        const unsigned old = xb_add(&bar[XB_XSUB(b.x)], 1u);
        const unsigned gen = old / nloc;
        if (old + 1u == (gen + 1u) * nloc) {
            __builtin_amdgcn_fence(__ATOMIC_RELEASE, "agent");
            asm volatile("s_waitcnt vmcnt(0)" ::: "memory");
            const unsigned og = xb_add(&bar[XB_TOP], 1u);
            const unsigned tg = og / nx;
            if (og + 1u == (tg + 1u) * nx) xb_add(&bar[XB_TOPGEN], 1u);
            else XB_SPIN(xb_ld(&bar[XB_TOPGEN]) == tg, bar);
            __builtin_amdgcn_fence(__ATOMIC_ACQUIRE, "agent");
            xb_add(&bar[XB_XGEN(b.x)], 1u);
            asm volatile("s_waitcnt vmcnt(0)" ::: "memory");
        } else {
            XB_SPIN(xb_ld(&bar[XB_XGEN(b.x)]) == gen, bar);
            __builtin_amdgcn_fence(__ATOMIC_ACQUIRE, "agent");
            asm volatile("s_waitcnt vmcnt(0)" ::: "memory");
        }
    }
    __syncthreads();
}

struct Args { const float* in[21]; float* out; unsigned char* ws; float inv_r[64]; float inv_m[32]; int ph_lo, ph_hi; };
static_assert(sizeof(Args) == 21 * 8 + 16 + 96 * 4 + 8, "Args has no padding");

__global__ void __launch_bounds__(512, 2) mk_fwd(Args a) {
    extern __shared__ __attribute__((aligned(16))) unsigned char smem[];
    cg::grid_group grid = cg::this_grid();
    const int tid = threadIdx.x, lane = tid & 63, wave = __builtin_amdgcn_readfirstlane(tid >> 6);
    const int G = gridDim.x, bx = blockIdx.x, vcu = (G % 8 == 0) ? (bx % 8) * (G / 8) + bx / 8 : bx;
    const int gw = vcu * 8 + wave, NGW = G * 8;
    LAS unsigned char* lds3 = (LAS unsigned char*)smem; char* ldsg = (char*)smem; const int ldsaddr = (int)(unsigned)(uintptr_t)lds3;
    float* out = a.out;
#define WSB() size_t wz_ = 0; asm volatile("" : "+s"(wz_)); unsigned char* ws = a.ws + wz_
#define INP(name, k) const float* name = a.in[k] + wz_
#define WSF(name, off) float* name = (float*)(ws + (off))
#define WSH(name, off) bf16_t* name = (bf16_t*)(ws + (off))
    const int lo = a.ph_lo, hi = a.ph_hi;
    if (tid < 16) ((LAS unsigned*)(lds3 + LDS_BAR_OFF))[tid] = 0u;
    __syncthreads();
    XcdBarrier xbar = xcd_barrier_post((unsigned*)(a.ws + WS_CTL + OFF_XBAR), (volatile LAS unsigned*)(lds3 + LDS_BAR_OFF));
#ifndef PH_MASK
#define PH_MASK 0x7ff
#endif
#define IN(k) (((PH_MASK >> (k)) & 1) && lo <= (k) && (k) < hi)
#define SEAM(k) do { if (IN(k) && IN((k) + 1)) { asm volatile("s_waitcnt vmcnt(0) lgkmcnt(0)" ::: "memory"); grid.sync(); \
    __builtin_amdgcn_fence(__ATOMIC_ACQUIRE, "agent"); asm volatile("s_waitcnt vmcnt(0)" ::: "memory"); } } while (0)
#define SEAMX(k) do { if (IN(k) && IN((k) + 1)) xcd_barrier(xbar); } while (0)

    if (IN(0)) {
        WSB(); WSF(mod, WS_CTL + OFF_MOD); WSF(cosr, WS_COSR); WSF(sinr, WS_SINR); WSF(cosm, WS_COSM); WSF(sinm, WS_SINM);
        WSH(Win, WS_WIN); WSH(Wuq, WS_WUQ); WSH(Wukv, WS_WUKV); WSH(Wo, WS_WO); WSH(Wgu, WS_WGU); WSH(Wdn, WS_WDN);
        INP(cin, 1); INP(ada_w, 3); INP(ada_b, 4); INP(w_in, 6); INP(mla_q_norm_w, 10); INP(w_uq, 11); INP(mla_kv_norm_w, 12); INP(w_ukv, 13); INP(w_o, 15); INP(w_gate, 17); INP(w_up, 18); INP(w_down, 19);
        const int* positions = (const int*)a.in[2] + wz_;
        {
            LAS float* cs = (LAS float*)lds3;
            for (int i = tid; i < 8 * 2048; i += 512) { const int b = i >> 11, k = i & 2047; const float v = cin[i]; cs[k * 8 + b] = v / (1.f + __expf(-v)); }
            __syncthreads();
            for (int task = gw; task < 192 * 16; task += NGW) { const int cb = task % 192, ks = task / 192, col = cb * 64 + lane;
                float acc[8]; const float bias = ks == 0 ? ada_b[col] : 0.f;
#pragma unroll
                for (int b = 0; b < 8; ++b) acc[b] = bias;
                const float* wp = ada_w + (size_t)(ks * 128) * NMODC + col;
                for (int k8 = 0; k8 < 128; k8 += 8) { float wv[8];
#pragma unroll
                    for (int i = 0; i < 8; ++i) wv[i] = wp[(size_t)(k8 + i) * NMODC];
#pragma unroll
                    for (int i = 0; i < 8; ++i) { const LAS f32x4* c4 = (const LAS f32x4*)(cs + (ks * 128 + k8 + i) * 8); const f32x4 c0 = c4[0], c1 = c4[1];
                        acc[0] += c0.x * wv[i]; acc[1] += c0.y * wv[i]; acc[2] += c0.z * wv[i]; acc[3] += c0.w * wv[i]; acc[4] += c1.x * wv[i]; acc[5] += c1.y * wv[i]; acc[6] += c1.z * wv[i]; acc[7] += c1.w * wv[i]; } }
#pragma unroll
                for (int b = 0; b < 8; ++b) atomicAdd(mod + (size_t)b * NMODC + col, acc[b]); }
            __syncthreads();
        }
        {
            LAS float* scr = (LAS float*)(lds3 + wave * 16384);
            constexpr int I_IN = 32 * (INC / 32), I_UQ = 8 * 48, I_UKV = 8 * 64, I_O = 32 * 64, I_G = 32 * (DFF / 32), I_D = (DFF / 64) * 64;
            constexpr int NITEMS = I_IN;
            for (int it = gw; it < NITEMS; it += NGW) { int r = it;
                if (r < I_IN) { transpose_item(w_in, 2048, INC, Win, nullptr, 1, scr, r, lane); continue; } r -= I_IN;
                (void)I_D; (void)I_UQ; (void)I_UKV; (void)I_O; (void)r; }
            for (int i = bx * 512 + tid; i < (INCP - INC) * 2048 / 8; i += G * 512) *(v4u*)(Win + (size_t)INC * 2048 + (size_t)i * 8) = (v4u){0u, 0u, 0u, 0u};
        }
        {
            for (int i = bx * 512 + tid; i < T * 96; i += G * 512) { const int t = i / 96, j = i % 96; const float pos = (float)positions[t];
                const float inv = j < 64 ? a.inv_r[j] : a.inv_m[j - 64]; const float ang = pos * inv;
                double rev = (double)ang * 0.15915494309189535; rev -= __builtin_rint(rev);
                const double qd = __builtin_rint(rev * 4.0); const double y = (rev - qd * 0.25) * 6.283185307179586; const double y2 = y * y;
                const double sy = y * (1.0 + y2 * (-1.0 / 6 + y2 * (1.0 / 120 + y2 * (-1.0 / 5040 + y2 * (1.0 / 362880 + y2 * (-1.0 / 39916800 + y2 * (1.0 / 6227020800.0)))))));
                const double cy = 1.0 + y2 * (-0.5 + y2 * (1.0 / 24 + y2 * (-1.0 / 720 + y2 * (1.0 / 40320 + y2 * (-1.0 / 3628800 + y2 * (1.0 / 479001600.0 + y2 * (-1.0 / 87178291200.0)))))));
                const int qi = (int)qd & 3;
                const float cv = (float)(qi == 0 ? cy : qi == 1 ? -sy : qi == 2 ? -cy : sy), sv = (float)(qi == 0 ? sy : qi == 1 ? cy : qi == 2 ? -sy : -cy);
                if (j < 64) { cosr[(size_t)t * 64 + j] = cv; sinr[(size_t)t * 64 + j] = sv; } else { cosm[(size_t)t * 32 + j - 64] = cv; sinm[(size_t)t * 32 + j - 64] = sv; } }
        }
    }
    SEAMX(0);
    if (a.ph_hi > 1000) { SEAM(0); }
    if (IN(1)) { WSB(); WSF(mod, WS_CTL + OFF_MOD); WSH(H, WS_H); INP(x, 0); INP(norm1_w, 5);
        for (int m = 2 * gw; m < T; m += 2 * NGW) { const int b = m >> 12;
            norm_row2(x + (size_t)m * DM, norm1_w, mod + (size_t)b * NMODC, mod + (size_t)b * NMODC + DM, H + (size_t)m * DM, nullptr, lane); } }
    SEAMX(1);
    if (IN(2)) {
        WSB(); WSH(H, WS_H); WSH(Win, WS_WIN); WSH(Qr, WS_QR); WSH(Kr, WS_KR); WSH(Vr, WS_VR); WSH(Gr, WS_GR); WSH(CQ, WS_CQ); WSH(CKV, WS_CKV); WSH(Kbuf, WS_KB);
        WSF(cosr, WS_COSR); WSF(sinr, WS_SINR); WSF(cosm, WS_COSM); WSF(sinm, WS_SINM); WSF(ssq_q, WS_CTL + OFF_SSQQ); WSF(ssq_kv, WS_CTL + OFF_SSQKV);
        pg8::Gemm g{H, Win, T, INCP, DM}; pg8::StaticOrder S; S.init(T, INCP, G, bx);
        pg8::EpiIn E{Qr, Kr, Vr, Gr, CQ, CKV, Kbuf, cosr, sinr, cosm, sinm, ssq_q, ssq_kv};
        pg8::gemm_phase<pg8::EpiIn, pg8::StaticOrder, true, true>(lds3, g, S, E);
        {
            constexpr int I_G = 32 * (DFF / 32); const int first = ((T / 256) * (INCP / 256)) % G, nsw = (G - first) * 8;
            if (bx >= first) { WSH(Wgu, WS_WGU); INP(w_gate, 17); INP(w_up, 18); LAS float* scr = (LAS float*)(lds3 + wave * 16384); const int wi = (bx - first) * 8 + wave;
                constexpr int I_D = (DFF / 64) * 64; WSH(Wdn, WS_WDN); INP(w_down, 19);
                constexpr int I_UQ = 8 * 48, I_UKV = 8 * 64, I_O = 32 * 64; WSH(Wuq, WS_WUQ); WSH(Wukv, WS_WUKV); WSH(Wo, WS_WO); INP(mla_q_norm_w, 10); INP(w_uq, 11); INP(mla_kv_norm_w, 12); INP(w_ukv, 13); INP(w_o, 15);
                for (int it = wi; it < I_UQ + I_UKV + I_O + 2 * I_G + I_D; it += nsw) { int r = it;
                    if (r < I_UQ) { transpose_item(w_uq, 512, 1536, Wuq, mla_q_norm_w, 2, scr, r, lane); continue; } r -= I_UQ;
                    if (r < I_UKV) { transpose_item(w_ukv, 512, 2048, Wukv, mla_kv_norm_w, 0, scr, r, lane); continue; } r -= I_UKV;
                    if (r < I_O) { transpose_item(w_o, 2048, 2048, Wo, nullptr, 0, scr, r, lane); continue; } r -= I_O;
                    if (r < I_G) { transpose_item(w_gate, 2048, DFF, Wgu, nullptr, 3, scr, r, lane); continue; } r -= I_G;
                    if (r < I_G) { transpose_item(w_up, 2048, DFF, Wgu, nullptr, 4, scr, r, lane); continue; } r -= I_G;
                    transpose_item(w_down, DFF, 2048, Wdn, nullptr, 0, scr, r, lane); } }
        }
    }
    SEAMX(2);
    if (IN(3)) {
        WSB(); WSH(CQ, WS_CQ); WSH(CKV, WS_CKV); WSH(Wuq, WS_WUQ); WSH(Wukv, WS_WUKV); WSH(Qm, WS_QM); WSH(Kbuf, WS_KB); WSH(Vm, WS_VM); WSH(Kr, WS_KR); WSH(Vr, WS_VR); WSH(CK, WS_H);
        WSF(cosm, WS_COSM); WSF(sinm, WS_SINM); WSF(ssq_q, WS_CTL + OFF_SSQQ); WSF(ssq_kv, WS_CTL + OFF_SSQKV); INP(ret_decay, 7);
        { pg8::Gemm g{CQ, Wuq, T, 1536, 512}; pg8::StaticOrder S; S.init(T, 1536, G, bx); pg8::EpiUpQ E{ssq_q, Qm, cosm, sinm};
          pg8::gemm_phase<pg8::EpiUpQ, pg8::StaticOrder, true, true>(lds3, g, S, E); }
        { pg8::Gemm g{CKV, Wukv, T, 2048, 512}; pg8::StaticOrder S; S.init(T, 2048, G, bx); pg8::EpiUpKV E{ssq_kv, Kbuf, Vm};
          pg8::gemm_phase<pg8::EpiUpKV, pg8::StaticOrder, true, true>(lds3, g, S, E); }
        for (int u = vcu; u < 2048; u += G) { const int n = u & 31, h = (u >> 5) & 7, b = u >> 8; const size_t t0 = (size_t)b * SEQ + n * 128;
            const float lgf = -__expf(ret_decay[h]) * 1.4426950408889634f, lgb = -__expf(ret_decay[8 + h]) * 1.4426950408889634f;
            att::chunk_kv_unit(Kr + t0 * 1024 + h * 128, Vr + t0 * 1024 + h * 128, CK + ((size_t)(b * 8 + h) * 32 + n) * 16384, CK + ((size_t)(64 + b * 8 + h) * 32 + n) * 16384, lgf, lgb, ldsg, ldsaddr); }
        __syncthreads();
    }
    SEAMX(3);
    if (IN(4)) {
        WSB(); WSH(Qm, WS_QM); WSH(Kbuf, WS_KB); WSH(Vm, WS_VM); WSH(Oat, WS_OAT); WSH(CK, WS_H); INP(ret_decay, 7);
        for (int u = vcu; u < 1024; u += G) { const int qb = u & 15, h = (u >> 4) & 7, b = u >> 7; const size_t r0 = (size_t)b * SEQ;
            att::attn_unit(Qm + (r0 + qb * 256) * 1536 + h * 192, Kbuf + r0 * 1536 + h * 192, Vm + r0 * 1024 + h * 128, Oat + (r0 + qb * 256) * 1024 + h * 128, SEQ, ldsg, ldsaddr); }
#ifndef NO_SCAN
        for (int idx = bx * 512 + tid; idx < 2 * 64 * 2048; idx += G * 512) { const int dir = idx >> 17, bh = (idx >> 11) & 63, e8 = idx & 2047, h = bh & 7;
            const float cd = __builtin_amdgcn_exp2f(-__expf(ret_decay[dir * 8 + h]) * 1.4426950408889634f * 128.f);
            bf16_t* base = CK + ((size_t)(dir * 64 + bh) * 32) * 16384 + e8 * 8; float st[8];
#pragma unroll
            for (int i = 0; i < 8; ++i) st[i] = 0.f;
            { v4u kv[32];
#pragma unroll
                for (int i = 0; i < 32; ++i) { const int m = dir ? 31 - i : i; kv[i] = *(const v4u*)(base + (size_t)m * 16384); }
#pragma unroll
                for (int i = 0; i < 32; ++i) { const int m = dir ? 31 - i : i; v4u o;
                    o.x = pk2a(st[0], st[1]); o.y = pk2a(st[2], st[3]); o.z = pk2a(st[4], st[5]); o.w = pk2a(st[6], st[7]);
                    *(v4u*)(base + (size_t)m * 16384) = o;
#pragma unroll
                    for (int q = 0; q < 4; ++q) { const unsigned w = kv[i][q]; st[2 * q] = st[2 * q] * cd + __uint_as_float(w << 16); st[2 * q + 1] = st[2 * q + 1] * cd + __uint_as_float(w & 0xffff0000u); } } }
        }
#endif
    }
    SEAMX(4);
    if (IN(5)) {
        WSB(); WSH(Qr, WS_QR); WSH(Kr, WS_KR); WSH(Vr, WS_VR); WSH(Gr, WS_GR); WSH(CK, WS_H); WSH(Cat, WS_CAT); WSH(Oat, WS_OAT); INP(ret_decay, 7); INP(ret_gn_w, 8); INP(ret_gn_b, 9); INP(mla_out_w, 14);
#if PROBE_BRUTE_RET
        float* dumpb = (float*)(ws + 704 * MiB);
        for (int up = vcu; up < 1024; up += G) {
            if (PROBE_COMP != 0) { const int u = up * 2 + (wave >> 2); const int n = u & 31, h = (u >> 5) & 7, b = u >> 8; const size_t t0 = (size_t)b * SEQ + n * 128;
                const float lgf = -__expf(ret_decay[h]) * 1.4426950408889634f, lgb = -__expf(ret_decay[8 + h]) * 1.4426950408889634f; const int hf = wave >> 2;
                att::ret_out_unit(Qr + t0 * 1024 + h * 128, Kr + t0 * 1024 + h * 128, Vr + t0 * 1024 + h * 128, Gr + t0 * 1024 + h * 128,
                                  CK + ((size_t)(b * 8 + h) * 32 + n) * 16384, CK + ((size_t)(64 + b * 8 + h) * 32 + n) * 16384, ret_gn_w + h * 128, ret_gn_b + h * 128,
                                  Cat + t0 * 2048 + h * 128, lgf, lgb, ldsg + hf * 65536, ldsaddr + hf * 65536, dumpb + t0 * 1024 + h * 128);
                __threadfence(); __syncthreads(); }
            for (int k2 = 0; k2 < 2; ++k2) { const int u = up * 2 + k2; const int n = u & 31, h = (u >> 5) & 7, b = u >> 8; const size_t r0 = (size_t)b * SEQ, t0 = r0 + n * 128;
                const float lgf = -__expf(ret_decay[h]) * 1.4426950408889634f, lgb = -__expf(ret_decay[8 + h]) * 1.4426950408889634f;
                att::ret_brute_unit(Qr + r0 * 1024 + h * 128, Kr + r0 * 1024 + h * 128, Vr + r0 * 1024 + h * 128, Gr + t0 * 1024 + h * 128, ret_gn_w + h * 128, ret_gn_b + h * 128, Cat + t0 * 2048 + h * 128, n * 128, lgf, lgb, ldsg, dumpb + t0 * 1024 + h * 128); } }
        __syncthreads();
        for (int up = vcu; up < 0; up += G) { const int u = up * 2 + (wave >> 2);
#else
        for (int up = vcu; up < 1024; up += G) { const int u = up * 2 + (wave >> 2);
#endif
            const int n = u & 31, h = (u >> 5) & 7, b = u >> 8; const size_t t0 = (size_t)b * SEQ + n * 128;
            const float lgf = -__expf(ret_decay[h]) * 1.4426950408889634f, lgb = -__expf(ret_decay[8 + h]) * 1.4426950408889634f; const int hf = wave >> 2;
            att::ret_out_unit(Qr + t0 * 1024 + h * 128, Kr + t0 * 1024 + h * 128, Vr + t0 * 1024 + h * 128, Gr + t0 * 1024 + h * 128,
                              CK + ((size_t)(b * 8 + h) * 32 + n) * 16384, CK + ((size_t)(64 + b * 8 + h) * 32 + n) * 16384, ret_gn_w + h * 128, ret_gn_b + h * 128,
                              Cat + t0 * 2048 + h * 128, lgf, lgb, ldsg + hf * 65536, ldsaddr + hf * 65536); }
        for (int m = 4 * gw; m < T; m += 4 * NGW) {
            v4u raw[4][2]; float ss[4];
#pragma unroll
            for (int r = 0; r < 4; ++r)
#pragma unroll
                for (int j = 0; j < 2; ++j) raw[r][j] = *(const v4u*)(Oat + (size_t)(m + r) * 1024 + lane * 8 + 512 * j);
#pragma unroll
            for (int r = 0; r < 4; ++r) { float sq = 0.f;
#pragma unroll
                for (int j = 0; j < 2; ++j)
#pragma unroll
                    for (int q = 0; q < 4; ++q) { const float a = __uint_as_float(raw[r][j][q] << 16), b = __uint_as_float(raw[r][j][q] & 0xffff0000u); sq += a * a + b * b; }
                ss[r] = sq; }
#pragma unroll
            for (int r = 0; r < 4; ++r) ss[r] = rsqrtf(wave_sum(ss[r]) * (1.f / 1024.f) + 1e-6f);
#pragma unroll
            for (int j = 0; j < 2; ++j) { const int col = lane * 8 + 512 * j; const f32x4 w0 = *(const f32x4*)(mla_out_w + col), w1 = *(const f32x4*)(mla_out_w + col + 4);
#pragma unroll
                for (int r = 0; r < 4; ++r) { const float rstd = ss[r]; const v4u w = raw[r][j]; v4u o;
                    o.x = pk2a(__uint_as_float(w.x << 16) * rstd * w0.x, __uint_as_float(w.x & 0xffff0000u) * rstd * w0.y); o.y = pk2a(__uint_as_float(w.y << 16) * rstd * w0.z, __uint_as_float(w.y & 0xffff0000u) * rstd * w0.w);
                    o.z = pk2a(__uint_as_float(w.z << 16) * rstd * w1.x, __uint_as_float(w.z & 0xffff0000u) * rstd * w1.y); o.w = pk2a(__uint_as_float(w.w << 16) * rstd * w1.z, __uint_as_float(w.w & 0xffff0000u) * rstd * w1.w);
                    *(v4u*)(Cat + (size_t)(m + r) * 2048 + 1024 + col) = o; } } }
        __syncthreads();
    }
    SEAMX(5);
    if (IN(6)) {
        WSB(); WSH(Cat, WS_CAT); WSH(Wo, WS_WO); WSF(mod, WS_CTL + OFF_MOD); INP(x, 0);
        pg8::Gemm g{Cat, Wo, T, 2048, 2048}; pg8::StaticOrder S; S.init(T, 2048, G, bx); pg8::EpiGateRes E{x, mod + 2 * DM, out};
        pg8::gemm_phase<pg8::EpiGateRes, pg8::StaticOrder, true, true>(lds3, g, S, E);
    }
    SEAMX(6);
    if (IN(7)) { WSB(); WSF(mod, WS_CTL + OFF_MOD); WSH(H, WS_H); INP(norm2_w, 16);
        for (int m = 2 * gw; m < T; m += 2 * NGW) { const int b = m >> 12;
            norm_row2(out + (size_t)m * DM, norm2_w, mod + (size_t)b * NMODC + 3 * DM, mod + (size_t)b * NMODC + 4 * DM, H + (size_t)m * DM, nullptr, lane); } }
    SEAMX(7);
    if (IN(8)) {
        WSB(); WSH(H, WS_H); WSH(Wgu, WS_WGU); WSH(Aff, WS_AFF);
        pg8::Gemm g{H, Wgu, T, 2 * DFF, DM}; pg8::StaticOrder S; S.init(T, 2 * DFF, G, bx); pg8::EpiGU E{Aff};
        pg8::gemm_phase<pg8::EpiGU, pg8::StaticOrder, true, true>(lds3, g, S, E);
    }
    SEAMX(8);
    if (IN(9)) {
        WSB(); WSH(Aff, WS_AFF); WSH(Wdn, WS_WDN); WSF(mod, WS_CTL + OFF_MOD);
        pg8::Gemm g{Aff, Wdn, T, 2048, DFF}; pg8::StaticOrder S; S.init(T, 2048, G, bx); pg8::EpiGateRes E{out, mod + 5 * DM, out};
        pg8::gemm_phase<pg8::EpiGateRes, pg8::StaticOrder, true, true>(lds3, g, S, E);
    }
    SEAMX(9);
    if (IN(10)) { WSB(); (void)ws; INP(final_norm_w, 20);
        for (int m = 2 * gw; m < T; m += 2 * NGW) norm_row2(out + (size_t)m * DM, final_norm_w, nullptr, nullptr, nullptr, out + (size_t)m * DM, lane); }
#undef IN
#undef SEAM
}

extern "C" void kernel_launch(void* const* d_in, const int* in_sizes, int n_in, void* d_out, int out_size, void* d_ws, size_t ws_size, hipStream_t stream) {
    static int grid = 0;
    if (grid == 0) {
        if (n_in != 21 || in_sizes[0] != T * DM || out_size != T * DM || ws_size < WS_END) { fprintf(stderr, "kernel_launch: shape/workspace mismatch (n_in %d, ws %zu < %zu)\n", n_in, ws_size, (size_t)WS_END); grid = -1; return; }
        int dev = 0, cus = 0, per_cu = 0;
        (void)hipGetDevice(&dev); (void)hipDeviceGetAttribute(&cus, hipDeviceAttributeMultiprocessorCount, dev);
        if (hipFuncSetAttribute((const void*)mk_fwd, hipFuncAttributeMaxDynamicSharedMemorySize, LDS_BYTES) != hipSuccess) { fprintf(stderr, "kernel_launch: hipFuncSetAttribute failed\n"); grid = -1; return; }
        if (hipOccupancyMaxActiveBlocksPerMultiprocessor(&per_cu, (const void*)mk_fwd, 512, LDS_BYTES) != hipSuccess || per_cu < 1) { fprintf(stderr, "kernel_launch: occupancy query gave %d\n", per_cu); per_cu = 1; }
        (void)hipGetLastError();
        grid = cus * per_cu;
    }
    if (grid < 0) return;
    (void)hipMemsetAsync((char*)d_ws + WS_CTL, 0, CTL_ZERO_BYTES, stream);
    Args a{};
    for (int i = 0; i < 21; ++i) a.in[i] = (const float*)d_in[i];
    a.out = (float*)d_out; a.ws = (unsigned char*)d_ws;
    for (int i = 0; i < 64; ++i) a.inv_r[i] = powf(10000.0f, -((float)(2 * i)) / 128.0f);
    for (int i = 0; i < 32; ++i) a.inv_m[i] = powf(10000.0f, -((float)(2 * i)) / 64.0f);
#if MK_SPLIT
    for (int p = 0; p < NPH; ++p) { a.ph_lo = p; a.ph_hi = p + 1; hipLaunchKernelGGL(mk_fwd, dim3(grid), dim3(512), LDS_BYTES, stream, a); }
#else
    a.ph_lo = 0; a.ph_hi = NPH;
    void* args[] = {&a};
    hipError_t e = hipLaunchCooperativeKernel((const void*)mk_fwd, dim3(grid), dim3(512), args, LDS_BYTES, stream);
    if (e != hipSuccess) fprintf(stderr, "kernel_launch: cooperative launch failed: %s (grid %d)\n", hipGetErrorString(e), grid);
#endif
}
```
